# Optimizing an MI355X kernel written in HIP

```python
import jax
import jax.numpy as jnp
from jax import lax
import numpy as np

D_MODEL = 1024
BATCH = 16
SEQ = 2048
DEPTH = 1

POOL_WINDOWS = (2, 4, 8, 16)
POOL_GROUP = 128
POOL_WIDTH = POOL_GROUP * len(POOL_WINDOWS)
HEAD_DIM = 64
ATTN_GROUPS = ((128, 1), (512, 4), (2048, 16))
HEADS_PER_GROUP = 4
N_HEADS = HEADS_PER_GROUP * len(ATTN_GROUPS)
ATTN_WIDTH = N_HEADS * HEAD_DIM
ATTN_OUT_WIDTH = HEADS_PER_GROUP * HEAD_DIM
ATTN_BLOCK = 64
ROPE_THETA = 500000.0
ROPE_DIM = HEAD_DIM // 4
N_BRANCHES = 2
IN_SPLITS = (POOL_WIDTH, POOL_WIDTH + ATTN_WIDTH, POOL_WIDTH + 2 * ATTN_WIDTH, POOL_WIDTH + 3 * ATTN_WIDTH, POOL_WIDTH + 3 * ATTN_WIDTH + D_MODEL)
IN_WIDTH = POOL_WIDTH + 3 * ATTN_WIDTH + N_BRANCHES * D_MODEL
N_EXPERTS = 256
TOP_K = 8
N_EXPERT_GROUPS = 8
TOPK_GROUPS = 4
EXPERT_FF = 256
SHARED_FF = 256
ROUTED_SCALE = 2.5
MOE_BLOCK = 128
N_MOD = 6
EPS = 1e-6
NEG_BIG = -1e30

kernel_name = 'hybrid_pool_dilattn_moe_block'


def rms_norm(x, g):
    xf = x.astype(jnp.float32)
    y = xf * lax.rsqrt(jnp.mean(xf * xf, axis=-1, keepdims=True) + EPS)
    return (y * g.astype(jnp.float32)).astype(x.dtype)


def centred_mean_minus_self(u, radius):
    S = u.shape[1]
    uf = u.astype(jnp.float32)
    cs = jnp.concatenate([jnp.zeros_like(uf[:, :1]), lax.cumsum(uf, axis=1)], axis=1)
    t = jnp.arange(S)
    lo = jnp.maximum(t - radius, 0)
    hi = jnp.minimum(t + radius, S - 1) + 1
    count = (hi - lo).astype(jnp.float32)[None, :, None]
    return ((cs[:, hi] - cs[:, lo]) / count - uf).astype(u.dtype)


def pool_mixer(u, w_grp, ls):
    B, S, _ = u.shape
    ug = u.reshape(B, S, len(POOL_WINDOWS), POOL_GROUP)
    pooled = jnp.stack([centred_mean_minus_self(ug[:, :, i], w // 2) for i, w in enumerate(POOL_WINDOWS)], axis=2)
    y = jnp.einsum('bsgc,gcd->bsgd', pooled, w_grp)
    return y.reshape(B, S, POOL_WIDTH) * ls


def partial_rope(x, positions):
    half = ROPE_DIM // 2
    inv_freq = ROPE_THETA ** (-jnp.arange(half, dtype=jnp.float32) / half)
    ang = positions.astype(jnp.float32)[..., None] * inv_freq
    cos = jnp.cos(ang)[:, :, None, :]
    sin = jnp.sin(ang)[:, :, None, :]
    xr = x[..., :ROPE_DIM].astype(jnp.float32)
    x1, x2 = xr[..., :half], xr[..., half:]
    rot = jnp.concatenate([x1 * cos - x2 * sin, x2 * cos + x1 * sin], axis=-1).astype(x.dtype)
    return jnp.concatenate([rot, x[..., ROPE_DIM:]], axis=-1)


def to_classes(x, dilation, n_blocks):
    B, S, H, X = x.shape
    L = S // dilation
    xc = jnp.transpose(x.reshape(B, L, dilation, H, X), (0, 2, 3, 1, 4))
    xc = jnp.pad(xc, ((0, 0), (0, 0), (0, 0), (0, n_blocks * ATTN_BLOCK - L), (0, 0)))
    return xc.reshape(B, dilation, H, n_blocks, ATTN_BLOCK, X)


def from_classes(xc, seq):
    B, r, H, nb, Q, X = xc.shape
    L = seq // r
    x = xc.reshape(B, r, H, nb * Q, X)[:, :, :, :L]
    return jnp.transpose(x, (0, 3, 1, 2, 4)).reshape(B, seq, H, X)


def neighbour_blocks(xb):
    xp = jnp.pad(xb, ((0, 0), (0, 0), (0, 0), (1, 1), (0, 0), (0, 0)))
    return jnp.concatenate([xp[:, :, :, :-2], xp[:, :, :, 1:-1], xp[:, :, :, 2:]], axis=4)


def dilated_window_attention(q, k, v, window, dilation):
    B, S, H, D = q.shape
    J = window // (2 * dilation)
    L = S // dilation
    nb = -(-L // ATTN_BLOCK)
    qb = to_classes(q, dilation, nb)
    kb = neighbour_blocks(to_classes(k, dilation, nb))
    vb = neighbour_blocks(to_classes(v, dilation, nb))
    qi = jnp.arange(nb)[:, None] * ATTN_BLOCK + jnp.arange(ATTN_BLOCK)[None, :]
    ki = jnp.arange(nb)[:, None] * ATTN_BLOCK - ATTN_BLOCK + jnp.arange(3 * ATTN_BLOCK)[None, :]
    rel = ki[:, None, :] - qi[:, :, None]
    mask = (jnp.abs(rel) <= J) & (ki[:, None, :] >= 0) & (ki[:, None, :] < L)
    s = jnp.einsum('brhnqd,brhnkd->brhnqk', qb, kb, preferred_element_type=jnp.float32) * (HEAD_DIM ** -0.5)
    s = jnp.where(mask, s, NEG_BIG)
    m = jnp.max(s, axis=-1, keepdims=True)
    p = jnp.exp(s - m)
    l = jnp.sum(p, axis=-1, keepdims=True)
    o = jnp.einsum('brhnqk,brhnkd->brhnqd', p, vb.astype(jnp.float32)) / l
    log_den = m + jnp.log(l)
    return from_classes(o, S), from_classes(log_den, S)[..., 0]


def attention_branch(q, k, v, q_norm_g, k_norm_g, positions):
    B, S, _ = q.shape
    q = partial_rope(rms_norm(q.reshape(B, S, N_HEADS, HEAD_DIM), q_norm_g), positions)
    k = partial_rope(rms_norm(k.reshape(B, S, N_HEADS, HEAD_DIM), k_norm_g), positions)
    v = v.reshape(B, S, N_HEADS, HEAD_DIM)
    outs, dens = [], []
    for g, (window, dilation) in enumerate(ATTN_GROUPS):
        hs = slice(g * HEADS_PER_GROUP, (g + 1) * HEADS_PER_GROUP)
        o, ld = dilated_window_attention(q[:, :, hs], k[:, :, hs], v[:, :, hs], window, dilation)
        outs.append(o)
        dens.append(ld)
    wgt = jax.nn.softmax(jnp.stack(dens, axis=0), axis=0)
    o = jnp.sum(wgt[..., None] * jnp.stack(outs, axis=0), axis=0)
    return o.reshape(B, S, ATTN_OUT_WIDTH).astype(v.dtype)


def route(h, w_router, router_bias):
    T = h.shape[0]
    scores = jax.nn.sigmoid(jnp.einsum('td,de->te', h, w_router, preferred_element_type=jnp.float32))
    sel = (scores + router_bias.astype(jnp.float32)).reshape(T, N_EXPERT_GROUPS, N_EXPERTS // N_EXPERT_GROUPS)
    group_score = jnp.sum(lax.top_k(sel, 2)[0], axis=-1)
    _, top_groups = lax.top_k(group_score, TOPK_GROUPS)
    group_mask = jnp.any(top_groups[:, :, None] == jnp.arange(N_EXPERT_GROUPS)[None, None, :], axis=1)
    masked = jnp.where(group_mask[:, :, None], sel, -jnp.inf).reshape(T, N_EXPERTS)
    _, idx = lax.top_k(masked, TOP_K)
    w = jnp.take_along_axis(scores, idx, axis=1)
    gate = w / jnp.sum(w, axis=-1, keepdims=True) * ROUTED_SCALE
    return idx, gate


def routed_experts(h, idx, gate, w_gate, w_up, w_down):
    T, D = h.shape
    TK = T * TOP_K
    flat_e = idx.reshape(TK)
    flat_tok = jnp.arange(TK, dtype=jnp.int32) // TOP_K
    flat_w = gate.reshape(TK)
    order = jnp.argsort(flat_e)
    sorted_e = flat_e[order]
    counts = jnp.zeros((N_EXPERTS,), jnp.int32).at[flat_e].add(1)
    start = jnp.cumsum(counts) - counts
    padded = (counts + MOE_BLOCK - 1) // MOE_BLOCK * MOE_BLOCK
    padded_end = jnp.cumsum(padded)
    padded_start = padded_end - padded
    dest = padded_start[sorted_e] + (jnp.arange(TK, dtype=jnp.int32) - start[sorted_e])
    n_blocks = -(-TK // MOE_BLOCK) + N_EXPERTS
    R = n_blocks * MOE_BLOCK
    row_tok = jnp.full((R,), T, jnp.int32).at[dest].set(flat_tok[order])
    row_w = jnp.zeros((R,), jnp.float32).at[dest].set(flat_w[order])
    block_expert = jnp.minimum(jnp.searchsorted(padded_end, jnp.arange(n_blocks) * MOE_BLOCK, side='right'), N_EXPERTS - 1)
    h_pad = jnp.concatenate([h, jnp.zeros((1, D), h.dtype)], axis=0)

    def block_ffn(args):
        tok, w, e = args
        xb = h_pad[tok]
        a = xb @ w_gate[e]
        b = xb @ w_up[e]
        return ((jax.nn.silu(a) * b) @ w_down[e]).astype(jnp.float32) * w[:, None]

    y = lax.map(block_ffn, (row_tok.reshape(n_blocks, MOE_BLOCK), row_w.reshape(n_blocks, MOE_BLOCK), block_expert))
    out = jax.ops.segment_sum(y.reshape(R, D), row_tok, num_segments=T + 1)[:T]
    return out.astype(h.dtype)


def setup_inputs(seed: int = 0) -> dict:
    key = jax.random.key(seed)
    ks = jax.random.split(key, 24)
    D = D_MODEL

    def nrm(k, shape, scale):
        return jax.random.normal(k, shape, jnp.float32) * scale

    return {
        'x': nrm(ks[0], (BATCH, SEQ, D), 1.0),
        'c': nrm(ks[1], (BATCH, D), 1.0),
        'positions': jnp.broadcast_to(jnp.arange(SEQ, dtype=jnp.int32)[None, :], (BATCH, SEQ)),
        'w_ada': nrm(ks[2], (DEPTH, D, N_MOD * D), 0.5 * D ** -0.5),
        'b_ada': nrm(ks[3], (DEPTH, N_MOD * D), 0.02),
        'norm1_g': 1.0 + nrm(ks[4], (DEPTH, D), 0.02),
        'w_in': nrm(ks[5], (DEPTH, D, IN_WIDTH), D ** -0.5),
        'pool_w_grp': nrm(ks[6], (DEPTH, len(POOL_WINDOWS), POOL_GROUP, POOL_GROUP), POOL_GROUP ** -0.5),
        'pool_scale': 0.5 + nrm(ks[7], (DEPTH, POOL_WIDTH), 0.1),
        'q_norm_g': 1.0 + nrm(ks[8], (DEPTH, HEAD_DIM), 0.02),
        'k_norm_g': 1.0 + nrm(ks[9], (DEPTH, HEAD_DIM), 0.02),
        'w_pool_up': nrm(ks[10], (DEPTH, POOL_WIDTH, D), POOL_WIDTH ** -0.5),
        'w_attn_up': nrm(ks[11], (DEPTH, ATTN_OUT_WIDTH, D), ATTN_OUT_WIDTH ** -0.5),
        'w_out': nrm(ks[12], (DEPTH, D, D), D ** -0.5),
        'norm2_g': 1.0 + nrm(ks[13], (DEPTH, D), 0.02),
        'w_router': nrm(ks[14], (DEPTH, D, N_EXPERTS), D ** -0.5),
        'router_bias': nrm(ks[15], (DEPTH, N_EXPERTS), 0.01),
        'w_shared_gate': nrm(ks[16], (DEPTH, D, SHARED_FF), D ** -0.5),
        'w_shared_up': nrm(ks[17], (DEPTH, D, SHARED_FF), D ** -0.5),
        'w_shared_down': nrm(ks[18], (DEPTH, SHARED_FF, D), SHARED_FF ** -0.5),
        'w_exp_gate': nrm(ks[19], (DEPTH, N_EXPERTS, D, EXPERT_FF), D ** -0.5),
        'w_exp_up': nrm(ks[20], (DEPTH, N_EXPERTS, D, EXPERT_FF), D ** -0.5),
        'w_exp_down': nrm(ks[21], (DEPTH, N_EXPERTS, EXPERT_FF, D), EXPERT_FF ** -0.5),
    }


def reference(x, c, positions, w_ada, b_ada, norm1_g, w_in, pool_w_grp, pool_scale, q_norm_g, k_norm_g, w_pool_up, w_attn_up, w_out, norm2_g, w_router, router_bias, w_shared_gate, w_shared_up, w_shared_down, w_exp_gate, w_exp_up, w_exp_down):
    B, S, D = x.shape
    c_act = jax.nn.silu(c)
    for layer in range(DEPTH):
        mod = jnp.einsum('bd,de->be', c_act, w_ada[layer]) + b_ada[layer]
        shift1, scale1, gate1, shift2, scale2, gate2 = jnp.split(mod[:, None, :], N_MOD, axis=-1)

        h = rms_norm(x, norm1_g[layer]) * (1.0 + scale1) + shift1
        proj = jnp.einsum('bsd,de->bse', h, w_in[layer])
        u, q, k, v, g_pool, g_attn = jnp.split(proj, IN_SPLITS, axis=-1)
        y_pool = jnp.einsum('bsp,pd->bsd', pool_mixer(u, pool_w_grp[layer], pool_scale[layer]), w_pool_up[layer])
        y_attn = jnp.einsum('bsa,ad->bsd', attention_branch(q, k, v, q_norm_g[layer], k_norm_g[layer], positions), w_attn_up[layer])
        merged = jax.nn.sigmoid(g_pool) * y_pool + jax.nn.sigmoid(g_attn) * y_attn
        x = x + gate1 * jnp.einsum('bsd,de->bse', merged, w_out[layer])

        h2 = (rms_norm(x, norm2_g[layer]) * (1.0 + scale2) + shift2).reshape(B * S, D)
        idx, gate = route(h2, w_router[layer], router_bias[layer])
        routed = routed_experts(h2, idx, gate, w_exp_gate[layer], w_exp_up[layer], w_exp_down[layer])
        shared = (jax.nn.silu(h2 @ w_shared_gate[layer]) * (h2 @ w_shared_up[layer])) @ w_shared_down[layer]
        x = x + gate2 * (routed + shared).reshape(B, S, D)
    return x
```

```cpp
#include <hip/hip_runtime.h>
#include <hip/hip_cooperative_groups.h>
#include <stdint.h>
#include <cstdio>
namespace cg = cooperative_groups;

#ifndef ONE_LAUNCH
#define ONE_LAUNCH 0
#endif

typedef unsigned short bf16_t;
#define DEV __device__ __forceinline__

constexpr int NB = 16, SEQ = 2048, DM = 1024, T = NB * SEQ;
constexpr int INW = 4864, NMOD = 6144;
constexpr int NE = 256, EFF = 256;
constexpr int NTHR = 512, NWV = 8;
constexpr int NSLOT = T * 8;
constexpr int RMAX = NSLOT + NE * 256;

DEV float bf2f(bf16_t h) { return __uint_as_float(((unsigned)h) << 16); }
DEV bf16_t f2bf(float f) { unsigned u = __float_as_uint(f); u += 0x7fffu + ((u >> 16) & 1u); return (bf16_t)(u >> 16); }
DEV unsigned pk2(float lo, float hi) { return (unsigned)f2bf(lo) | ((unsigned)f2bf(hi) << 16); }
DEV float sigm(float v) { return 1.f / (1.f + __expf(-v)); }
DEV float silu(float v) { return v / (1.f + __expf(-v)); }
DEV float wave_sum(float v) {
#pragma unroll
    for (int o = 32; o >= 1; o >>= 1) v += __shfl_xor(v, o);
    return v;
}

struct P {
    const float *x, *c; const int* pos;
    const float *w_ada, *b_ada, *norm1_g, *w_in, *pool_w_grp, *pool_scale, *q_norm_g, *k_norm_g, *w_pool_up, *w_attn_up, *w_out, *norm2_g,
        *w_router, *router_bias, *w_sg, *w_su, *w_sd, *w_eg, *w_eu, *w_ed;
    float* out;
    float* mod; int* cnt; int* asg_e; int* asg_pos; float* asg_w; int* rowlist;
    bf16_t *XB, *U, *QKV, *G, *PL, *Y, *O, *ACT, *SLAB, *HS;
    float* LG;
};

constexpr size_t MiB = 1u << 20;
constexpr size_t WS_MOD = 0, WS_CNT = 512 * 1024, WS_ASG_E = 1 * MiB, WS_ASG_POS = 2 * MiB, WS_ASG_W = 3 * MiB, WS_ROWLIST = 4 * MiB;
constexpr size_t WS_XB = 8 * MiB;
constexpr size_t WS_ACT = 72 * MiB;
constexpr size_t WS_SLAB = 232 * MiB;
constexpr size_t WS_U = 232 * MiB, WS_QKV = 264 * MiB, WS_G = 408 * MiB, WS_PL = 536 * MiB, WS_Y = 568 * MiB, WS_O = 600 * MiB;
constexpr size_t WS_END = 744 * MiB;

DEV void ph_mod(const P& p, float* sm, int bid, int nb) {
    const int tid = threadIdx.x;
    if (bid == 0 && tid < NE) p.cnt[tid] = 0;
    for (int item = bid; item < NB * 12; item += nb) {
        const int b = item / 12, ch = item % 12;
        __syncthreads();
        for (int d = tid; d < DM; d += NTHR) sm[d] = silu(p.c[b * DM + d]);
        __syncthreads();
        const int e = ch * 512 + tid;
        float acc = 0.f;
#pragma unroll 8
        for (int d = 0; d < DM; ++d) acc += sm[d] * p.w_ada[(size_t)d * NMOD + e];
        p.mod[b * NMOD + e] = acc + p.b_ada[e];
    }
}

DEV void ph_norm(const float* src, const float* g, const float* mod, int shift_off, int scale_off, bf16_t* dst, int bid, int nb) {
    const int lane = threadIdx.x & 63, wv = threadIdx.x >> 6;
    for (int row = bid * NWV + wv; row < T; row += nb * NWV) {
        const float4* xr = (const float4*)(src + (size_t)row * DM);
        const int b = row / SEQ;
        float4 v[4]; float ss = 0.f;
#pragma unroll
        for (int j = 0; j < 4; ++j) { v[j] = xr[lane + 64 * j]; ss += v[j].x * v[j].x + v[j].y * v[j].y + v[j].z * v[j].z + v[j].w * v[j].w; }
        ss = wave_sum(ss);
        const float r = rsqrtf(ss * (1.f / DM) + 1e-6f);
#pragma unroll
        for (int j = 0; j < 4; ++j) {
            const int col = (lane + 64 * j) * 4;
            const float4 g4 = *(const float4*)(g + col);
            const float4 sc = *(const float4*)(mod + b * NMOD + scale_off + col);
            const float4 sh = *(const float4*)(mod + b * NMOD + shift_off + col);
            const float o0 = v[j].x * r * g4.x * (1.f + sc.x) + sh.x, o1 = v[j].y * r * g4.y * (1.f + sc.y) + sh.y;
            const float o2 = v[j].z * r * g4.z * (1.f + sc.z) + sh.z, o3 = v[j].w * r * g4.w * (1.f + sc.w) + sh.w;
            uint2 w; w.x = pk2(o0, o1); w.y = pk2(o2, o3);
            *(uint2*)(dst + (size_t)row * DM + col) = w;
        }
    }
}

template <bool DUAL, class RowF, class Epi>
DEV void ngemm_tile(const bf16_t* __restrict__ A, int lda, RowF rowf, const float* __restrict__ B, const float* __restrict__ B2, int ldb,
                    int m0, int n0, int K, Epi epi, float* sm) {
    float* As = sm;
    float* Bs = sm + 16 * 132;
    float* Bs2 = Bs + 16 * 64;
    const int tid = threadIdx.x, tm = tid >> 4, tn = tid & 15;
    float acc[4][4], acc2[4][4];
#pragma unroll
    for (int i = 0; i < 4; ++i)
#pragma unroll
        for (int j = 0; j < 4; ++j) { acc[i][j] = 0.f; acc2[i][j] = 0.f; }
    const int ar = tid >> 2, ak = (tid & 3) * 4;
    const int arow = rowf(m0 + ar);
    const bf16_t* ap = A + (size_t)(arow < 0 ? 0 : arow) * lda + ak;
    const int bk = tid >> 5, bn = (tid & 31) * 2;
    for (int k0 = 0; k0 < K; k0 += 16) {
        uint2 av = make_uint2(0u, 0u);
        if (arow >= 0) av = *(const uint2*)(ap + k0);
        const float2 bv = *(const float2*)(B + (size_t)(k0 + bk) * ldb + n0 + bn);
        float2 bv2 = make_float2(0.f, 0.f);
        if (DUAL) bv2 = *(const float2*)(B2 + (size_t)(k0 + bk) * ldb + n0 + bn);
        __syncthreads();
        As[(ak + 0) * 132 + ar] = __uint_as_float(av.x << 16);
        As[(ak + 1) * 132 + ar] = __uint_as_float(av.x & 0xffff0000u);
        As[(ak + 2) * 132 + ar] = __uint_as_float(av.y << 16);
        As[(ak + 3) * 132 + ar] = __uint_as_float(av.y & 0xffff0000u);
        Bs[bk * 64 + bn] = bv.x; Bs[bk * 64 + bn + 1] = bv.y;
        if (DUAL) { Bs2[bk * 64 + bn] = bv2.x; Bs2[bk * 64 + bn + 1] = bv2.y; }
        __syncthreads();
#pragma unroll
        for (int kk = 0; kk < 16; ++kk) {
            const float4 a = *(const float4*)&As[kk * 132 + tm * 4];
            const float4 b = *(const float4*)&Bs[kk * 64 + tn * 4];
            const float aa[4] = {a.x, a.y, a.z, a.w}, bb[4] = {b.x, b.y, b.z, b.w};
#pragma unroll
            for (int i = 0; i < 4; ++i)
#pragma unroll
                for (int j = 0; j < 4; ++j) acc[i][j] += aa[i] * bb[j];
            if (DUAL) {
                const float4 b2 = *(const float4*)&Bs2[kk * 64 + tn * 4];
                const float cc[4] = {b2.x, b2.y, b2.z, b2.w};
#pragma unroll
                for (int i = 0; i < 4; ++i)
#pragma unroll
                    for (int j = 0; j < 4; ++j) acc2[i][j] += aa[i] * cc[j];
            }
        }
    }
#pragma unroll
    for (int i = 0; i < 4; ++i)
#pragma unroll
        for (int j = 0; j < 4; ++j) epi(m0 + tm * 4 + i, n0 + tn * 4 + j, acc[i][j], acc2[i][j]);
}

struct RowId { DEV int operator()(int m) const { return m; } };
struct RowTok { const int* rl; DEV int operator()(int m) const { const int s = rl[m]; return s < 0 ? -1 : (s >> 3); } };

template <bool DUAL, class Epi>
DEV void ngemm_dense(const bf16_t* A, int lda, const float* B, const float* B2, int ldb, int M, int N, int K, Epi epi, float* sm, int bid, int nb) {
    const int tn = N / 64, nt = (M / 128) * tn;
    for (int t = bid; t < nt; t += nb) ngemm_tile<DUAL>(A, lda, RowId(), B, B2, ldb, (t / tn) * 128, (t % tn) * 64, K, epi, sm);
}

struct EpiInProj { bf16_t *U, *QKV, *G;
    DEV void operator()(int r, int c, float v, float) const {
        if (c < 512) U[(size_t)r * 512 + c] = f2bf(v);
        else if (c < 2816) QKV[(size_t)r * 2304 + (c - 512)] = f2bf(v);
        else G[(size_t)r * 2048 + (c - 2816)] = f2bf(sigm(v)); } };
struct EpiPoolGrp { bf16_t* Y; const float* ls; int g;
    DEV void operator()(int r, int c, float v, float) const { Y[(size_t)r * 512 + g * 128 + c] = f2bf(v * ls[g * 128 + c]); } };
struct EpiMergeA { bf16_t* MG; const bf16_t* G;
    DEV void operator()(int r, int c, float v, float) const { MG[(size_t)r * DM + c] = f2bf(bf2f(G[(size_t)r * 2048 + c]) * v); } };
struct EpiMergeB { bf16_t* MG; const bf16_t* G;
    DEV void operator()(int r, int c, float v, float) const { const size_t i = (size_t)r * DM + c; MG[i] = f2bf(bf2f(MG[i]) + bf2f(G[(size_t)r * 2048 + 1024 + c]) * v); } };
struct EpiOutProj { const float* x; float* out; const float* mod;
    DEV void operator()(int r, int c, float v, float) const { const size_t i = (size_t)r * DM + c; out[i] = x[i] + mod[(r / SEQ) * NMOD + 2048 + c] * v; } };
struct EpiLogits { float* LG;
    DEV void operator()(int r, int c, float v, float) const { LG[(size_t)r * NE + c] = v; } };
struct EpiAct { bf16_t* ACT;
    DEV void operator()(int r, int c, float v, float v2) const { ACT[(size_t)r * EFF + c] = f2bf(silu(v) * v2); } };
struct EpiSlab { bf16_t* SLAB; const int* rl; const float* w;
    DEV void operator()(int r, int c, float v, float) const { const int s = rl[r]; if (s >= 0) SLAB[(size_t)s * DM + c] = f2bf(v * w[s]); } };
struct EpiFinal { float* out; const bf16_t* SLAB; const float* mod;
    DEV void operator()(int r, int c, float v, float) const {
        float s = v;
#pragma unroll
        for (int k = 0; k < 8; ++k) s += bf2f(SLAB[((size_t)r * 8 + k) * DM + c]);
        const size_t i = (size_t)r * DM + c; out[i] = out[i] + mod[(r / SEQ) * NMOD + 5120 + c] * s; } };

DEV void ph_qknorm(const P& p, int bid, int nb) {
    const int lane = threadIdx.x & 63, wv = threadIdx.x >> 6;
    const float gq = p.q_norm_g[lane], gk = p.k_norm_g[lane];
    const float invf = exp2f(-(float)(lane & 7) * (1.f / 8.f) * log2f(500000.f));
    for (int it = bid * NWV + wv; it < T * 24; it += nb * NWV) {
        const int t = it / 24, hh = it % 24;
        bf16_t* ptr = p.QKV + (size_t)t * 2304 + hh * 64 + lane;
        const float v = bf2f(*ptr);
        const float ss = wave_sum(v * v);
        float nv = v * rsqrtf(ss * (1.f / 64.f) + 1e-6f) * (hh < 12 ? gq : gk);
        const float partner = __shfl_xor(nv, 8);
        const float ang = (float)p.pos[t] * invf;
        const float cs = cosf(ang), sn = sinf(ang);
        if (lane < 8) nv = nv * cs - partner * sn;
        else if (lane < 16) nv = nv * cs + partner * sn;
        *ptr = f2bf(nv);
    }
}

DEV void ph_pool(const P& p, int bid, int nb) {
    for (size_t i = (size_t)bid * NTHR + threadIdx.x; i < (size_t)T * 512; i += (size_t)nb * NTHR) {
        const int t = (int)(i >> 9), c = (int)(i & 511);
        const int g = c >> 7, r = 1 << g;
        const int s = t & (SEQ - 1), base = t - s;
        const int lo = max(s - r, 0), hi = min(s + r, SEQ - 1);
        float sum = 0.f;
        for (int q = lo; q <= hi; ++q) sum += bf2f(p.U[(size_t)(base + q) * 512 + c]);
        p.PL[i] = f2bf(sum / (float)(hi - lo + 1) - bf2f(p.U[i]));
    }
}

DEV void ph_attn(const P& p, int bid, int nb) {
    const int lane = threadIdx.x & 63, wv = threadIdx.x >> 6;
    for (int it = bid * NWV + wv; it < T * 4; it += nb * NWV) {
        const int t = it >> 2, slot = it & 3;
        const int s = t & (SEQ - 1), base = t - s;
        float M = -1e30f, l = 0.f, acc = 0.f;
#pragma unroll
        for (int g = 0; g < 3; ++g) {
            const int dsh = 2 * g, d = 1 << dsh, L = SEQ >> dsh;
            const int h = 4 * g + slot;
            const int m = s >> dsh, r = s & (d - 1);
            const float q = bf2f(p.QKV[(size_t)t * 2304 + h * 64 + lane]);
            const bf16_t* kb = p.QKV + 768 + h * 64 + lane;
            const bf16_t* vb = p.QKV + 1536 + h * 64 + lane;
#pragma unroll 4
            for (int rel = -64; rel <= 64; ++rel) {
                const int mm = m + rel;
                const bool valid = (mm >= 0) && (mm < L);
                const int mc = valid ? mm : m;
                const size_t tr = (size_t)(base + mc * d + r) * 2304;
                const float kv = bf2f(kb[tr]), vv = bf2f(vb[tr]);
                const float sc = wave_sum(q * kv) * 0.125f;
                if (valid) {
                    const float mn = fmaxf(M, sc);
                    const float f = __expf(M - mn), pe = __expf(sc - mn);
                    l = l * f + pe; acc = acc * f + pe * vv; M = mn;
                }
            }
        }
        p.O[(size_t)t * 256 + slot * 64 + lane] = f2bf(acc / l);
    }
}

DEV void ph_route(const P& p, int bid, int nb) {
    const int lane = threadIdx.x & 63, wv = threadIdx.x >> 6;
    const float4 bias4 = *(const float4*)(p.router_bias + 4 * lane);
    for (int t = bid * NWV + wv; t < T; t += nb * NWV) {
        const float4 lg = *(const float4*)(p.LG + (size_t)t * NE + 4 * lane);
        const float s0 = 1.f / (1.f + expf(-lg.x)), s1 = 1.f / (1.f + expf(-lg.y)), s2 = 1.f / (1.f + expf(-lg.z)), s3 = 1.f / (1.f + expf(-lg.w));
        float v0 = s0 + bias4.x, v1 = s1 + bias4.y, v2 = s2 + bias4.z, v3 = s3 + bias4.w;
        float m1 = fmaxf(v0, v1), m2 = fminf(v0, v1);
        { const float n1 = fmaxf(m1, v2), n2 = fmaxf(fminf(m1, v2), m2); m1 = n1; m2 = n2; }
        { const float n1 = fmaxf(m1, v3), n2 = fmaxf(fminf(m1, v3), m2); m1 = n1; m2 = n2; }
#pragma unroll
        for (int o = 1; o <= 4; o <<= 1) {
            const float b1 = __shfl_xor(m1, o), b2 = __shfl_xor(m2, o);
            const float n1 = fmaxf(m1, b1), n2 = fmaxf(fminf(m1, b1), fmaxf(m2, b2)); m1 = n1; m2 = n2;
        }
        const float gs = m1 + m2; const int G = lane >> 3;
        int rank = 0;
#pragma unroll
        for (int g2 = 0; g2 < 8; ++g2) { const float o = __shfl(gs, g2 * 8); rank += ((o > gs) || (o == gs && g2 < G)) ? 1 : 0; }
        if (rank >= 4) { v0 = -INFINITY; v1 = -INFINITY; v2 = -INFINITY; v3 = -INFINITY; }
        int myidx = 0; float myw = 0.f, wsum = 0.f;
#pragma unroll
        for (int k = 0; k < 8; ++k) {
            float bv = v0; int bi = 0;
            if (v1 > bv) { bv = v1; bi = 1; }
            if (v2 > bv) { bv = v2; bi = 2; }
            if (v3 > bv) { bv = v3; bi = 3; }
            float bs = bi == 0 ? s0 : (bi == 1 ? s1 : (bi == 2 ? s2 : s3));
            int gi = lane * 4 + bi;
#pragma unroll
            for (int o = 1; o < 64; o <<= 1) {
                const float ov = __shfl_xor(bv, o), os = __shfl_xor(bs, o); const int oi = __shfl_xor(gi, o);
                if ((ov > bv) || (ov == bv && oi < gi)) { bv = ov; gi = oi; bs = os; }
            }
            if (gi == lane * 4 + 0) v0 = -INFINITY;
            if (gi == lane * 4 + 1) v1 = -INFINITY;
            if (gi == lane * 4 + 2) v2 = -INFINITY;
            if (gi == lane * 4 + 3) v3 = -INFINITY;
            if (lane == k) { myidx = gi; myw = bs; }
            wsum += bs;
        }
        if (lane < 8) {
            const int slot = t * 8 + lane;
            const int pos = atomicAdd(&p.cnt[myidx], 1);
            p.asg_e[slot] = myidx; p.asg_pos[slot] = pos; p.asg_w[slot] = myw / wsum * 2.5f;
        }
    }
}

DEV void load_offsets(const int* cnt, int* off) {
    const int tid = threadIdx.x;
    __syncthreads();
    if (tid < NE) off[300 + tid] = (cnt[tid] + 255) & ~255;
    __syncthreads();
    if (tid == 0) { int a = 0; for (int e = 0; e < NE; ++e) { off[e] = a; a += off[300 + e]; } off[NE] = a; }
    __syncthreads();
}
DEV int find_expert(const int* off, int m0) {
    int lo = 0, hi = NE;
    while (hi - lo > 1) { const int mid = (lo + hi) >> 1; if (off[mid] <= m0) lo = mid; else hi = mid; }
    return lo;
}

DEV void ph_scatter(const P& p, int* off, int bid, int nb) {
    load_offsets(p.cnt, off);
    for (int slot = bid * NTHR + threadIdx.x; slot < NSLOT; slot += nb * NTHR) p.rowlist[off[p.asg_e[slot]] + p.asg_pos[slot]] = slot;
    for (int e = bid; e < NE; e += nb) {
        const int n = p.cnt[e], pd = (n + 255) & ~255;
        for (int i = n + threadIdx.x; i < pd; i += NTHR) p.rowlist[off[e] + i] = -1;
    }
}

DEV void ph_expert1(const P& p, float* sm, int* off, int bid, int nb) {
    load_offsets(p.cnt, off);
    const int nrt = off[NE] / 128, nt = nrt * 4;
    for (int t = bid; t < nt; t += nb) {
        const int m0 = (t >> 2) * 128, n0 = (t & 3) * 64, e = find_expert(off, m0);
        ngemm_tile<true>(p.XB, DM, RowTok{p.rowlist}, p.w_eg + (size_t)e * DM * EFF, p.w_eu + (size_t)e * DM * EFF, EFF, m0, n0, DM, EpiAct{p.ACT}, sm);
    }
}
DEV void ph_expert2(const P& p, float* sm, int* off, int bid, int nb) {
    load_offsets(p.cnt, off);
    const int nrt = off[NE] / 128, nt = nrt * 16;
    for (int t = bid; t < nt; t += nb) {
        const int m0 = (t >> 4) * 128, n0 = (t & 15) * 64, e = find_expert(off, m0);
        ngemm_tile<false>(p.ACT, EFF, RowId(), p.w_ed + (size_t)e * EFF * DM, nullptr, DM, m0, n0, EFF, EpiSlab{p.SLAB, p.rowlist, p.asg_w}, sm);
    }
}

constexpr int NPH = 17;
DEV void run_phase(const P& p, int ph, float* sm, int* off, int bid, int nb) {
    switch (ph) {
    case 0: ph_mod(p, sm, bid, nb); break;
    case 1: ph_norm(p.x, p.norm1_g, p.mod, 0, 1024, p.XB, bid, nb); break;
    case 2: ngemm_dense<false>(p.XB, DM, p.w_in, nullptr, INW, T, INW, DM, EpiInProj{p.U, p.QKV, p.G}, sm, bid, nb); break;
    case 3: ph_qknorm(p, bid, nb); ph_pool(p, bid, nb); break;
    case 4: ph_attn(p, bid, nb);
#pragma unroll 1
            for (int g = 0; g < 4; ++g) ngemm_dense<false>(p.PL + g * 128, 512, p.pool_w_grp + g * 128 * 128, nullptr, 128, T, 128, 128, EpiPoolGrp{p.Y, p.pool_scale, g}, sm, bid, nb);
            break;
    case 5: ngemm_dense<false>(p.Y, 512, p.w_pool_up, nullptr, DM, T, DM, 512, EpiMergeA{p.XB, p.G}, sm, bid, nb); break;
    case 6: ngemm_dense<false>(p.O, 256, p.w_attn_up, nullptr, DM, T, DM, 256, EpiMergeB{p.XB, p.G}, sm, bid, nb); break;
    case 7: ngemm_dense<false>(p.XB, DM, p.w_out, nullptr, DM, T, DM, DM, EpiOutProj{p.x, p.out, p.mod}, sm, bid, nb); break;
    case 8: ph_norm(p.out, p.norm2_g, p.mod, 3072, 4096, p.XB, bid, nb); break;
    case 9: ngemm_dense<false>(p.XB, DM, p.w_router, nullptr, NE, T, NE, DM, EpiLogits{p.LG}, sm, bid, nb); break;
    case 10: ph_route(p, bid, nb); break;
    case 11: ph_scatter(p, off, bid, nb); break;
    case 12: ph_expert1(p, sm, off, bid, nb); break;
    case 13: ph_expert2(p, sm, off, bid, nb); break;
    case 14: ngemm_dense<true>(p.XB, DM, p.w_sg, p.w_su, EFF, T, EFF, DM, EpiAct{p.HS}, sm, bid, nb); break;
    case 15: ngemm_dense<false>(p.HS, EFF, p.w_sd, nullptr, DM, T, DM, EFF, EpiFinal{p.out, p.SLAB, p.mod}, sm, bid, nb); break;
    default: break;
    }
}

template <int PH>
__global__ void __launch_bounds__(NTHR) phase_kernel(P p) {
    __shared__ __attribute__((aligned(16))) float sm[16 * 132 + 2 * 16 * 64 + 640];
    int* off = (int*)(sm + 16 * 132 + 2 * 16 * 64);
    run_phase(p, PH, sm, off, blockIdx.x, gridDim.x);
}
template <int PH> static void launch_phases(const P& p, int grid, hipStream_t stream) {
    if constexpr (PH < NPH - 1) { hipLaunchKernelGGL(phase_kernel<PH>, dim3(grid), dim3(NTHR), 0, stream, p); launch_phases<PH + 1>(p, grid, stream); }
}

extern "C" void kernel_launch(void* const* d_in, const int* in_sizes, int n_in, void* d_out, int out_size, void* d_ws, size_t ws_size, hipStream_t stream) {
    static int grid = 0;
    if (grid == 0) {
        int dev = 0, cus = 0;
        (void)hipGetDevice(&dev);
        (void)hipDeviceGetAttribute(&cus, hipDeviceAttributeMultiprocessorCount, dev);
        grid = cus;
        if (ws_size < WS_END) { fprintf(stderr, "kernel_launch: workspace too small (%zu < %zu)\n", ws_size, (size_t)WS_END); grid = -1; }
    }
    if (grid < 0) return;
    P p{};
    const float* const* in = (const float* const*)d_in;
    p.x = in[0]; p.c = in[1]; p.pos = (const int*)d_in[2];
    p.w_ada = in[3]; p.b_ada = in[4]; p.norm1_g = in[5]; p.w_in = in[6]; p.pool_w_grp = in[7]; p.pool_scale = in[8]; p.q_norm_g = in[9]; p.k_norm_g = in[10];
    p.w_pool_up = in[11]; p.w_attn_up = in[12]; p.w_out = in[13]; p.norm2_g = in[14]; p.w_router = in[15]; p.router_bias = in[16];
    p.w_sg = in[17]; p.w_su = in[18]; p.w_sd = in[19]; p.w_eg = in[20]; p.w_eu = in[21]; p.w_ed = in[22];
    p.out = (float*)d_out;
    char* ws = (char*)d_ws;
    p.mod = (float*)(ws + WS_MOD); p.cnt = (int*)(ws + WS_CNT); p.asg_e = (int*)(ws + WS_ASG_E); p.asg_pos = (int*)(ws + WS_ASG_POS);
    p.asg_w = (float*)(ws + WS_ASG_W); p.rowlist = (int*)(ws + WS_ROWLIST);
    p.XB = (bf16_t*)(ws + WS_XB); p.U = (bf16_t*)(ws + WS_U); p.QKV = (bf16_t*)(ws + WS_QKV); p.G = (bf16_t*)(ws + WS_G); p.PL = (bf16_t*)(ws + WS_PL);
    p.Y = (bf16_t*)(ws + WS_Y); p.O = (bf16_t*)(ws + WS_O); p.ACT = (bf16_t*)(ws + WS_ACT); p.SLAB = (bf16_t*)(ws + WS_SLAB); p.HS = (bf16_t*)(ws + WS_ACT);
    p.LG = (float*)(ws + WS_ACT);
    launch_phases<0>(p, grid * 4, stream);
}
```

```cpp
#include <hip/hip_runtime.h>
#include <hip/hip_cooperative_groups.h>
#include <stdint.h>
#include <cstdio>
namespace cg = cooperative_groups;

#ifndef ONE_LAUNCH
#define ONE_LAUNCH 0
#endif

typedef unsigned short bf16_t;
#define DEV __device__ __forceinline__

constexpr int NB = 16, SEQ = 2048, DM = 1024, T = NB * SEQ;
constexpr int INW = 4864, NMOD = 6144;
constexpr int NE = 256, EFF = 256;
constexpr int NTHR = 512, NWV = 8;
constexpr int NSLOT = T * 8;
constexpr int RMAX = NSLOT + NE * 256;

DEV float bf2f(bf16_t h) { return __uint_as_float(((unsigned)h) << 16); }
DEV bf16_t f2bf(float f) { unsigned u = __float_as_uint(f); u += 0x7fffu + ((u >> 16) & 1u); return (bf16_t)(u >> 16); }
DEV unsigned pk2(float lo, float hi) { return (unsigned)f2bf(lo) | ((unsigned)f2bf(hi) << 16); }
DEV float sigm(float v) { return 1.f / (1.f + __expf(-v)); }
DEV float silu(float v) { return v / (1.f + __expf(-v)); }
DEV float wave_sum(float v) {
#pragma unroll
    for (int o = 32; o >= 1; o >>= 1) v += __shfl_xor(v, o);
    return v;
}

struct P {
    const float *x, *c; const int* pos;
    const float *w_ada, *b_ada, *norm1_g, *w_in, *pool_w_grp, *pool_scale, *q_norm_g, *k_norm_g, *w_pool_up, *w_attn_up, *w_out, *norm2_g,
        *w_router, *router_bias, *w_sg, *w_su, *w_sd, *w_eg, *w_eu, *w_ed;
    float* out;
    float* mod; int* cnt; int* asg_e; int* asg_pos; float* asg_w; int* rowlist;
    bf16_t *XB, *U, *QKV, *G, *PL, *Y, *O, *ACT, *SLAB, *HS;
    float* LG;
};

constexpr size_t MiB = 1u << 20;
constexpr size_t WS_MOD = 0, WS_CNT = 512 * 1024, WS_ASG_E = 1 * MiB, WS_ASG_POS = 2 * MiB, WS_ASG_W = 3 * MiB, WS_ROWLIST = 4 * MiB;
constexpr size_t WS_XB = 8 * MiB;
constexpr size_t WS_ACT = 72 * MiB;
constexpr size_t WS_SLAB = 232 * MiB;
constexpr size_t WS_U = 232 * MiB, WS_QKV = 264 * MiB, WS_G = 408 * MiB, WS_PL = 536 * MiB, WS_Y = 568 * MiB, WS_O = 600 * MiB;
constexpr size_t WS_END = 744 * MiB;

DEV void ph_mod(const P& p, float* sm, int bid, int nb) {
    const int tid = threadIdx.x;
    if (bid == 0 && tid < NE) p.cnt[tid] = 0;
    for (int item = bid; item < NB * 12; item += nb) {
        const int b = item / 12, ch = item % 12;
        __syncthreads();
        for (int d = tid; d < DM; d += NTHR) sm[d] = silu(p.c[b * DM + d]);
        __syncthreads();
        const int e = ch * 512 + tid;
        float acc = 0.f;
#pragma unroll 8
        for (int d = 0; d < DM; ++d) acc += sm[d] * p.w_ada[(size_t)d * NMOD + e];
        p.mod[b * NMOD + e] = acc + p.b_ada[e];
    }
}

DEV void ph_norm(const float* src, const float* g, const float* mod, int shift_off, int scale_off, bf16_t* dst, int bid, int nb) {
    const int lane = threadIdx.x & 63, wv = threadIdx.x >> 6;
    for (int row = bid * NWV + wv; row < T; row += nb * NWV) {
        const float4* xr = (const float4*)(src + (size_t)row * DM);
        const int b = row / SEQ;
        float4 v[4]; float ss = 0.f;
#pragma unroll
        for (int j = 0; j < 4; ++j) { v[j] = xr[lane + 64 * j]; ss += v[j].x * v[j].x + v[j].y * v[j].y + v[j].z * v[j].z + v[j].w * v[j].w; }
        ss = wave_sum(ss);
        const float r = rsqrtf(ss * (1.f / DM) + 1e-6f);
#pragma unroll
        for (int j = 0; j < 4; ++j) {
            const int col = (lane + 64 * j) * 4;
            const float4 g4 = *(const float4*)(g + col);
            const float4 sc = *(const float4*)(mod + b * NMOD + scale_off + col);
            const float4 sh = *(const float4*)(mod + b * NMOD + shift_off + col);
            const float o0 = v[j].x * r * g4.x * (1.f + sc.x) + sh.x, o1 = v[j].y * r * g4.y * (1.f + sc.y) + sh.y;
            const float o2 = v[j].z * r * g4.z * (1.f + sc.z) + sh.z, o3 = v[j].w * r * g4.w * (1.f + sc.w) + sh.w;
            uint2 w; w.x = pk2(o0, o1); w.y = pk2(o2, o3);
            *(uint2*)(dst + (size_t)row * DM + col) = w;
        }
    }
}

template <bool DUAL, class RowF, class Epi>
DEV void ngemm_tile(const bf16_t* __restrict__ A, int lda, RowF rowf, const float* __restrict__ B, const float* __restrict__ B2, int ldb,
                    int m0, int n0, int K, Epi epi, float* sm) {
    float* As = sm;
    float* Bs = sm + 16 * 132;
    float* Bs2 = Bs + 16 * 64;
    const int tid = threadIdx.x, tm = tid >> 4, tn = tid & 15;
    float acc[4][4], acc2[4][4];
#pragma unroll
    for (int i = 0; i < 4; ++i)
#pragma unroll
        for (int j = 0; j < 4; ++j) { acc[i][j] = 0.f; acc2[i][j] = 0.f; }
    const int ar = tid >> 2, ak = (tid & 3) * 4;
    const int arow = rowf(m0 + ar);
    const bf16_t* ap = A + (size_t)(arow < 0 ? 0 : arow) * lda + ak;
    const int bk = tid >> 5, bn = (tid & 31) * 2;
    for (int k0 = 0; k0 < K; k0 += 16) {
        uint2 av = make_uint2(0u, 0u);
        if (arow >= 0) av = *(const uint2*)(ap + k0);
        const float2 bv = *(const float2*)(B + (size_t)(k0 + bk) * ldb + n0 + bn);
        float2 bv2 = make_float2(0.f, 0.f);
        if (DUAL) bv2 = *(const float2*)(B2 + (size_t)(k0 + bk) * ldb + n0 + bn);
        __syncthreads();
        As[(ak + 0) * 132 + ar] = __uint_as_float(av.x << 16);
        As[(ak + 1) * 132 + ar] = __uint_as_float(av.x & 0xffff0000u);
        As[(ak + 2) * 132 + ar] = __uint_as_float(av.y << 16);
        As[(ak + 3) * 132 + ar] = __uint_as_float(av.y & 0xffff0000u);
        Bs[bk * 64 + bn] = bv.x; Bs[bk * 64 + bn + 1] = bv.y;
        if (DUAL) { Bs2[bk * 64 + bn] = bv2.x; Bs2[bk * 64 + bn + 1] = bv2.y; }
        __syncthreads();
#pragma unroll
        for (int kk = 0; kk < 16; ++kk) {
            const float4 a = *(const float4*)&As[kk * 132 + tm * 4];
            const float4 b = *(const float4*)&Bs[kk * 64 + tn * 4];
            const float aa[4] = {a.x, a.y, a.z, a.w}, bb[4] = {b.x, b.y, b.z, b.w};
#pragma unroll
            for (int i = 0; i < 4; ++i)
#pragma unroll
                for (int j = 0; j < 4; ++j) acc[i][j] += aa[i] * bb[j];
            if (DUAL) {
                const float4 b2 = *(const float4*)&Bs2[kk * 64 + tn * 4];
                const float cc[4] = {b2.x, b2.y, b2.z, b2.w};
#pragma unroll
                for (int i = 0; i < 4; ++i)
#pragma unroll
                    for (int j = 0; j < 4; ++j) acc2[i][j] += aa[i] * cc[j];
            }
        }
    }
#pragma unroll
    for (int i = 0; i < 4; ++i)
#pragma unroll
        for (int j = 0; j < 4; ++j) epi(m0 + tm * 4 + i, n0 + tn * 4 + j, acc[i][j], acc2[i][j]);
}

struct RowId { DEV int operator()(int m) const { return m; } };
struct RowTok { const int* rl; DEV int operator()(int m) const { const int s = rl[m]; return s < 0 ? -1 : (s >> 3); } };

template <bool DUAL, class Epi>
DEV void ngemm_dense(const bf16_t* A, int lda, const float* B, const float* B2, int ldb, int M, int N, int K, Epi epi, float* sm, int bid, int nb) {
    const int tn = N / 64, nt = (M / 128) * tn;
    for (int t = bid; t < nt; t += nb) ngemm_tile<DUAL>(A, lda, RowId(), B, B2, ldb, (t / tn) * 128, (t % tn) * 64, K, epi, sm);
}

struct EpiInProj { bf16_t *U, *QKV, *G;
    DEV void operator()(int r, int c, float v, float) const {
        if (c < 512) U[(size_t)r * 512 + c] = f2bf(v);
        else if (c < 2816) QKV[(size_t)r * 2304 + (c - 512)] = f2bf(v);
        else G[(size_t)r * 2048 + (c - 2816)] = f2bf(sigm(v)); } };
struct EpiPoolGrp { bf16_t* Y; const float* ls; int g;
    DEV void operator()(int r, int c, float v, float) const { Y[(size_t)r * 512 + g * 128 + c] = f2bf(v * ls[g * 128 + c]); } };
struct EpiMergeA { bf16_t* MG; const bf16_t* G;
    DEV void operator()(int r, int c, float v, float) const { MG[(size_t)r * DM + c] = f2bf(bf2f(G[(size_t)r * 2048 + c]) * v); } };
struct EpiMergeB { bf16_t* MG; const bf16_t* G;
    DEV void operator()(int r, int c, float v, float) const { const size_t i = (size_t)r * DM + c; MG[i] = f2bf(bf2f(MG[i]) + bf2f(G[(size_t)r * 2048 + 1024 + c]) * v); } };
struct EpiOutProj { const float* x; float* out; const float* mod;
    DEV void operator()(int r, int c, float v, float) const { const size_t i = (size_t)r * DM + c; out[i] = x[i] + mod[(r / SEQ) * NMOD + 2048 + c] * v; } };
struct EpiLogits { float* LG;
    DEV void operator()(int r, int c, float v, float) const { LG[(size_t)r * NE + c] = v; } };
struct EpiAct { bf16_t* ACT;
    DEV void operator()(int r, int c, float v, float v2) const { ACT[(size_t)r * EFF + c] = f2bf(silu(v) * v2); } };
struct EpiSlab { bf16_t* SLAB; const int* rl; const float* w;
    DEV void operator()(int r, int c, float v, float) const { const int s = rl[r]; if (s >= 0) SLAB[(size_t)s * DM + c] = f2bf(v * w[s]); } };
struct EpiFinal { float* out; const bf16_t* SLAB; const float* mod;
    DEV void operator()(int r, int c, float v, float) const {
        float s = v;
#pragma unroll
        for (int k = 0; k < 8; ++k) s += bf2f(SLAB[((size_t)r * 8 + k) * DM + c]);
        const size_t i = (size_t)r * DM + c; out[i] = out[i] + mod[(r / SEQ) * NMOD + 5120 + c] * s; } };

DEV void ph_qknorm(const P& p, int bid, int nb) {
    const int lane = threadIdx.x & 63, wv = threadIdx.x >> 6;
    const float gq = p.q_norm_g[lane], gk = p.k_norm_g[lane];
    const float invf = exp2f(-(float)(lane & 7) * (1.f / 8.f) * log2f(500000.f));
    for (int it = bid * NWV + wv; it < T * 24; it += nb * NWV) {
        const int t = it / 24, hh = it % 24;
        bf16_t* ptr = p.QKV + (size_t)t * 2304 + hh * 64 + lane;
        const float v = bf2f(*ptr);
        const float ss = wave_sum(v * v);
        float nv = v * rsqrtf(ss * (1.f / 64.f) + 1e-6f) * (hh < 12 ? gq : gk);
        const float partner = __shfl_xor(nv, 8);
        const float ang = (float)p.pos[t] * invf;
        const float cs = cosf(ang), sn = sinf(ang);
        if (lane < 8) nv = nv * cs - partner * sn;
        else if (lane < 16) nv = nv * cs + partner * sn;
        *ptr = f2bf(nv);
    }
}

DEV void ph_pool(const P& p, int bid, int nb) {
    for (size_t i = (size_t)bid * NTHR + threadIdx.x; i < (size_t)T * 512; i += (size_t)nb * NTHR) {
        const int t = (int)(i >> 9), c = (int)(i & 511);
        const int g = c >> 7, r = 1 << g;
        const int s = t & (SEQ - 1), base = t - s;
        const int lo = max(s - r, 0), hi = min(s + r, SEQ - 1);
        float sum = 0.f;
        for (int q = lo; q <= hi; ++q) sum += bf2f(p.U[(size_t)(base + q) * 512 + c]);
        p.PL[i] = f2bf(sum / (float)(hi - lo + 1) - bf2f(p.U[i]));
    }
}

DEV void ph_attn(const P& p, int bid, int nb) {
    const int lane = threadIdx.x & 63, wv = threadIdx.x >> 6;
    for (int it = bid * NWV + wv; it < T * 4; it += nb * NWV) {
        const int t = it >> 2, slot = it & 3;
        const int s = t & (SEQ - 1), base = t - s;
        float M = -1e30f, l = 0.f, acc = 0.f;
#pragma unroll
        for (int g = 0; g < 3; ++g) {
            const int dsh = 2 * g, d = 1 << dsh, L = SEQ >> dsh;
            const int h = 4 * g + slot;
            const int m = s >> dsh, r = s & (d - 1);
            const float q = bf2f(p.QKV[(size_t)t * 2304 + h * 64 + lane]);
            const bf16_t* kb = p.QKV + 768 + h * 64 + lane;
            const bf16_t* vb = p.QKV + 1536 + h * 64 + lane;
#pragma unroll 4
            for (int rel = -64; rel <= 64; ++rel) {
                const int mm = m + rel;
                const bool valid = (mm >= 0) && (mm < L);
                const int mc = valid ? mm : m;
                const size_t tr = (size_t)(base + mc * d + r) * 2304;
                const float kv = bf2f(kb[tr]), vv = bf2f(vb[tr]);
                const float sc = wave_sum(q * kv) * 0.125f;
                if (valid) {
                    const float mn = fmaxf(M, sc);
                    const float f = __expf(M - mn), pe = __expf(sc - mn);
                    l = l * f + pe; acc = acc * f + pe * vv; M = mn;
                }
            }
        }
        p.O[(size_t)t * 256 + slot * 64 + lane] = f2bf(acc / l);
    }
}

DEV void ph_route(const P& p, int bid, int nb) {
    const int lane = threadIdx.x & 63, wv = threadIdx.x >> 6;
    const float4 bias4 = *(const float4*)(p.router_bias + 4 * lane);
    for (int t = bid * NWV + wv; t < T; t += nb * NWV) {
        const float4 lg = *(const float4*)(p.LG + (size_t)t * NE + 4 * lane);
        const float s0 = 1.f / (1.f + expf(-lg.x)), s1 = 1.f / (1.f + expf(-lg.y)), s2 = 1.f / (1.f + expf(-lg.z)), s3 = 1.f / (1.f + expf(-lg.w));
        float v0 = s0 + bias4.x, v1 = s1 + bias4.y, v2 = s2 + bias4.z, v3 = s3 + bias4.w;
        float m1 = fmaxf(v0, v1), m2 = fminf(v0, v1);
        { const float n1 = fmaxf(m1, v2), n2 = fmaxf(fminf(m1, v2), m2); m1 = n1; m2 = n2; }
        { const float n1 = fmaxf(m1, v3), n2 = fmaxf(fminf(m1, v3), m2); m1 = n1; m2 = n2; }
#pragma unroll
        for (int o = 1; o <= 4; o <<= 1) {
            const float b1 = __shfl_xor(m1, o), b2 = __shfl_xor(m2, o);
            const float n1 = fmaxf(m1, b1), n2 = fmaxf(fminf(m1, b1), fmaxf(m2, b2)); m1 = n1; m2 = n2;
        }
        const float gs = m1 + m2; const int G = lane >> 3;
        int rank = 0;
#pragma unroll
        for (int g2 = 0; g2 < 8; ++g2) { const float o = __shfl(gs, g2 * 8); rank += ((o > gs) || (o == gs && g2 < G)) ? 1 : 0; }
        if (rank >= 4) { v0 = -INFINITY; v1 = -INFINITY; v2 = -INFINITY; v3 = -INFINITY; }
        int myidx = 0; float myw = 0.f, wsum = 0.f;
#pragma unroll
        for (int k = 0; k < 8; ++k) {
            float bv = v0; int bi = 0;
            if (v1 > bv) { bv = v1; bi = 1; }
            if (v2 > bv) { bv = v2; bi = 2; }
            if (v3 > bv) { bv = v3; bi = 3; }
            float bs = bi == 0 ? s0 : (bi == 1 ? s1 : (bi == 2 ? s2 : s3));
            int gi = lane * 4 + bi;
#pragma unroll
            for (int o = 1; o < 64; o <<= 1) {
                const float ov = __shfl_xor(bv, o), os = __shfl_xor(bs, o); const int oi = __shfl_xor(gi, o);
                if ((ov > bv) || (ov == bv && oi < gi)) { bv = ov; gi = oi; bs = os; }
            }
            if (gi == lane * 4 + 0) v0 = -INFINITY;
            if (gi == lane * 4 + 1) v1 = -INFINITY;
            if (gi == lane * 4 + 2) v2 = -INFINITY;
            if (gi == lane * 4 + 3) v3 = -INFINITY;
            if (lane == k) { myidx = gi; myw = bs; }
            wsum += bs;
        }
        if (lane < 8) {
            const int slot = t * 8 + lane;
            const int pos = atomicAdd(&p.cnt[myidx], 1);
            p.asg_e[slot] = myidx; p.asg_pos[slot] = pos; p.asg_w[slot] = myw / wsum * 2.5f;
        }
    }
}

DEV void load_offsets(const int* cnt, int* off) {
    const int tid = threadIdx.x;
    __syncthreads();
    if (tid < NE) off[300 + tid] = (cnt[tid] + 255) & ~255;
    __syncthreads();
    if (tid == 0) { int a = 0; for (int e = 0; e < NE; ++e) { off[e] = a; a += off[300 + e]; } off[NE] = a; }
    __syncthreads();
}
DEV int find_expert(const int* off, int m0) {
    int lo = 0, hi = NE;
    while (hi - lo > 1) { const int mid = (lo + hi) >> 1; if (off[mid] <= m0) lo = mid; else hi = mid; }
    return lo;
}

DEV void ph_scatter(const P& p, int* off, int bid, int nb) {
    load_offsets(p.cnt, off);
    for (int slot = bid * NTHR + threadIdx.x; slot < NSLOT; slot += nb * NTHR) p.rowlist[off[p.asg_e[slot]] + p.asg_pos[slot]] = slot;
    for (int e = bid; e < NE; e += nb) {
        const int n = p.cnt[e], pd = (n + 255) & ~255;
        for (int i = n + threadIdx.x; i < pd; i += NTHR) p.rowlist[off[e] + i] = -1;
    }
}

DEV void ph_expert1(const P& p, float* sm, int* off, int bid, int nb) {
    load_offsets(p.cnt, off);
    const int nrt = off[NE] / 128, nt = nrt * 4;
    for (int t = bid; t < nt; t += nb) {
        const int m0 = (t >> 2) * 128, n0 = (t & 3) * 64, e = find_expert(off, m0);
        ngemm_tile<true>(p.XB, DM, RowTok{p.rowlist}, p.w_eg + (size_t)e * DM * EFF, p.w_eu + (size_t)e * DM * EFF, EFF, m0, n0, DM, EpiAct{p.ACT}, sm);
    }
}
DEV void ph_expert2(const P& p, float* sm, int* off, int bid, int nb) {
    load_offsets(p.cnt, off);
    const int nrt = off[NE] / 128, nt = nrt * 16;
    for (int t = bid; t < nt; t += nb) {
        const int m0 = (t >> 4) * 128, n0 = (t & 15) * 64, e = find_expert(off, m0);
        ngemm_tile<false>(p.ACT, EFF, RowId(), p.w_ed + (size_t)e * EFF * DM, nullptr, DM, m0, n0, EFF, EpiSlab{p.SLAB, p.rowlist, p.asg_w}, sm);
    }
}

constexpr int NPH = 17;
DEV void run_phase(const P& p, int ph, float* sm, int* off, int bid, int nb) {
    switch (ph) {
    case 0: ph_mod(p, sm, bid, nb); break;
    case 1: ph_norm(p.x, p.norm1_g, p.mod, 0, 1024, p.XB, bid, nb); break;
    case 2: ngemm_dense<false>(p.XB, DM, p.w_in, nullptr, INW, T, INW, DM, EpiInProj{p.U, p.QKV, p.G}, sm, bid, nb); break;
    case 3: ph_qknorm(p, bid, nb); ph_pool(p, bid, nb); break;
    case 4: ph_attn(p, bid, nb);
#pragma unroll 1
            for (int g = 0; g < 4; ++g) ngemm_dense<false>(p.PL + g * 128, 512, p.pool_w_grp + g * 128 * 128, nullptr, 128, T, 128, 128, EpiPoolGrp{p.Y, p.pool_scale, g}, sm, bid, nb);
            break;
    case 5: ngemm_dense<false>(p.Y, 512, p.w_pool_up, nullptr, DM, T, DM, 512, EpiMergeA{p.XB, p.G}, sm, bid, nb); break;
    case 6: ngemm_dense<false>(p.O, 256, p.w_attn_up, nullptr, DM, T, DM, 256, EpiMergeB{p.XB, p.G}, sm, bid, nb); break;
    case 7: ngemm_dense<false>(p.XB, DM, p.w_out, nullptr, DM, T, DM, DM, EpiOutProj{p.x, p.out, p.mod}, sm, bid, nb); break;
    case 8: ph_norm(p.out, p.norm2_g, p.mod, 3072, 4096, p.XB, bid, nb); break;
    case 9: ngemm_dense<false>(p.XB, DM, p.w_router, nullptr, NE, T, NE, DM, EpiLogits{p.LG}, sm, bid, nb); break;
    case 10: ph_route(p, bid, nb); break;
    case 11: ph_scatter(p, off, bid, nb); break;
    case 12: ph_expert1(p, sm, off, bid, nb); break;
    case 13: ph_expert2(p, sm, off, bid, nb); break;
    case 14: ngemm_dense<true>(p.XB, DM, p.w_sg, p.w_su, EFF, T, EFF, DM, EpiAct{p.HS}, sm, bid, nb); break;
    case 15: ngemm_dense<false>(p.HS, EFF, p.w_sd, nullptr, DM, T, DM, EFF, EpiFinal{p.out, p.SLAB, p.mod}, sm, bid, nb); break;
    default: break;
    }
}

#define GSYNC() cg::this_grid().sync()
__global__ void __launch_bounds__(NTHR) fwd_all(P p) {
    __shared__ __attribute__((aligned(16))) float sm[16 * 132 + 2 * 16 * 64 + 640];
    int* off = (int*)(sm + 16 * 132 + 2 * 16 * 64);
    const int bid = blockIdx.x, nb = gridDim.x;
    run_phase(p, 0, sm, off, bid, nb); GSYNC();
    run_phase(p, 1, sm, off, bid, nb); GSYNC();
    run_phase(p, 2, sm, off, bid, nb); GSYNC();
    run_phase(p, 3, sm, off, bid, nb); GSYNC();
    run_phase(p, 4, sm, off, bid, nb); GSYNC();
    run_phase(p, 5, sm, off, bid, nb); GSYNC();
    run_phase(p, 6, sm, off, bid, nb); GSYNC();
    run_phase(p, 7, sm, off, bid, nb); GSYNC();
    run_phase(p, 8, sm, off, bid, nb); GSYNC();
    run_phase(p, 9, sm, off, bid, nb); GSYNC();
    run_phase(p, 10, sm, off, bid, nb); GSYNC();
    run_phase(p, 11, sm, off, bid, nb); GSYNC();
    run_phase(p, 12, sm, off, bid, nb); GSYNC();
    run_phase(p, 13, sm, off, bid, nb); GSYNC();
    run_phase(p, 14, sm, off, bid, nb); GSYNC();
    run_phase(p, 15, sm, off, bid, nb);
}
extern "C" void kernel_launch(void* const* d_in, const int* in_sizes, int n_in, void* d_out, int out_size, void* d_ws, size_t ws_size, hipStream_t stream) {
    static int grid = 0;
    if (grid == 0) {
        int dev = 0, cus = 0;
        (void)hipGetDevice(&dev);
        (void)hipDeviceGetAttribute(&cus, hipDeviceAttributeMultiprocessorCount, dev);
        int per_cu = 0;
        (void)hipOccupancyMaxActiveBlocksPerMultiprocessor(&per_cu, fwd_all, NTHR, 0);
        if (per_cu < 1) { fprintf(stderr, "kernel_launch: occupancy query says %d blocks/CU\n", per_cu); per_cu = 1; }
        if (per_cu > 2) per_cu = 2;
        grid = cus * per_cu;
        if (ws_size < WS_END) { fprintf(stderr, "kernel_launch: workspace too small (%zu < %zu)\n", ws_size, (size_t)WS_END); grid = -1; }
    }
    if (grid < 0) return;
    P p{};
    const float* const* in = (const float* const*)d_in;
    p.x = in[0]; p.c = in[1]; p.pos = (const int*)d_in[2];
    p.w_ada = in[3]; p.b_ada = in[4]; p.norm1_g = in[5]; p.w_in = in[6]; p.pool_w_grp = in[7]; p.pool_scale = in[8]; p.q_norm_g = in[9]; p.k_norm_g = in[10];
    p.w_pool_up = in[11]; p.w_attn_up = in[12]; p.w_out = in[13]; p.norm2_g = in[14]; p.w_router = in[15]; p.router_bias = in[16];
    p.w_sg = in[17]; p.w_su = in[18]; p.w_sd = in[19]; p.w_eg = in[20]; p.w_eu = in[21]; p.w_ed = in[22];
    p.out = (float*)d_out;
    char* ws = (char*)d_ws;
    p.mod = (float*)(ws + WS_MOD); p.cnt = (int*)(ws + WS_CNT); p.asg_e = (int*)(ws + WS_ASG_E); p.asg_pos = (int*)(ws + WS_ASG_POS);
    p.asg_w = (float*)(ws + WS_ASG_W); p.rowlist = (int*)(ws + WS_ROWLIST);
    p.XB = (bf16_t*)(ws + WS_XB); p.U = (bf16_t*)(ws + WS_U); p.QKV = (bf16_t*)(ws + WS_QKV); p.G = (bf16_t*)(ws + WS_G); p.PL = (bf16_t*)(ws + WS_PL);
    p.Y = (bf16_t*)(ws + WS_Y); p.O = (bf16_t*)(ws + WS_O); p.ACT = (bf16_t*)(ws + WS_ACT); p.SLAB = (bf16_t*)(ws + WS_SLAB); p.HS = (bf16_t*)(ws + WS_ACT);
    p.LG = (float*)(ws + WS_ACT);
    void* args[] = {&p};
    hipError_t e = hipLaunchCooperativeKernel((void*)fwd_all, dim3(grid), dim3(NTHR), args, 0, stream);
    if (e != hipSuccess) fprintf(stderr, "cooperative launch failed: %s (grid %d)\n", hipGetErrorString(e), grid);
}
```

```cpp
#include <hip/hip_runtime.h>
#include <hip/hip_cooperative_groups.h>
#include <stdint.h>
#include <cstdio>
namespace cg = cooperative_groups;

#ifndef ONE_LAUNCH
#define ONE_LAUNCH 0
#endif

typedef unsigned short bf16_t;
#define DEV __device__ __forceinline__
#define LAS __attribute__((address_space(3)))
typedef short bf16x8 __attribute__((ext_vector_type(8)));
typedef float f32x4 __attribute__((ext_vector_type(4)));
typedef unsigned u32x4 __attribute__((ext_vector_type(4)));
typedef unsigned u32x2 __attribute__((ext_vector_type(2)));

#ifndef MF_INPROJ
#define MF_INPROJ 1
#endif
#ifndef MF_MERGE
#define MF_MERGE 1
#endif
#ifndef MF_OUT
#define MF_OUT 1
#endif
#ifndef MF_ROUTER
#define MF_ROUTER 1
#endif
#ifndef MF_EXP1
#define MF_EXP1 1
#endif
#ifndef MF_EXP2
#define MF_EXP2 1
#endif
#ifndef MF_FINAL
#define MF_FINAL 1
#endif

constexpr int NB = 16, SEQ = 2048, DM = 1024, T = NB * SEQ;
constexpr int INW = 4864, NMOD = 6144;
constexpr int NE = 256, EFF = 256;
constexpr int NTHR = 512, NWV = 8;
constexpr int NSLOT = T * 8;
constexpr int RMAX = NSLOT + NE * 256;

DEV float bf2f(bf16_t h) { return __uint_as_float(((unsigned)h) << 16); }
DEV bf16_t f2bf(float f) { unsigned u = __float_as_uint(f); u += 0x7fffu + ((u >> 16) & 1u); return (bf16_t)(u >> 16); }
DEV unsigned pk2(float lo, float hi) { return (unsigned)f2bf(lo) | ((unsigned)f2bf(hi) << 16); }
DEV float sigm(float v) { return 1.f / (1.f + __expf(-v)); }
DEV float silu(float v) { return v / (1.f + __expf(-v)); }
DEV int otid() { int t = threadIdx.x; asm volatile("" : "+v"(t)); return t; }
DEV float wave_sum(float v) {
#pragma unroll
    for (int o = 32; o >= 1; o >>= 1) v += __shfl_xor(v, o);
    return v;
}

struct P {
    const float *x, *c; const int* pos;
    const float *w_ada, *b_ada, *norm1_g, *w_in, *pool_w_grp, *pool_scale, *q_norm_g, *k_norm_g, *w_pool_up, *w_attn_up, *w_out, *norm2_g,
        *w_router, *router_bias, *w_sg, *w_su, *w_sd, *w_eg, *w_eu, *w_ed;
    float* out;
    float* mod; int* cnt; int* asg_e; int* asg_pos; float* asg_w; int* rowlist;
    bf16_t *XB, *U, *QKV, *G, *PL, *Y, *O, *ACT, *SLAB, *HS;
    float* LG;
    bf16_t *WT_IN, *WT_EFF, *WT_AU, *WT_OUT, *WT_RS, *WT_SD, *WT_EGU, *WT_ED;
};

constexpr size_t MiB = 1u << 20;
constexpr size_t WS_MOD = 0, WS_CNT = 512 * 1024, WS_ASG_E = 1 * MiB, WS_ASG_POS = 2 * MiB, WS_ASG_W = 3 * MiB, WS_ROWLIST = 4 * MiB;
constexpr size_t WS_XB = 8 * MiB;
constexpr size_t WS_ACT = 72 * MiB;
constexpr size_t WS_SLAB = 232 * MiB;
constexpr size_t WS_U = 232 * MiB, WS_QKV = 264 * MiB, WS_G = 408 * MiB, WS_PL = 536 * MiB, WS_Y = 568 * MiB, WS_O = 600 * MiB;
constexpr size_t WS_WT_IN = 744 * MiB, WS_WT_EFF = 754 * MiB, WS_WT_AU = 755 * MiB, WS_WT_OUT = 756 * MiB, WS_WT_RS = 758 * MiB, WS_WT_SD = 760 * MiB;
constexpr size_t WS_WT_ED = 762 * MiB;
constexpr size_t WS_WT_EGU = 232 * MiB;
constexpr size_t WS_HS = 890 * MiB;
constexpr size_t WS_END = 906 * MiB;

DEV void ph_mod(const P& p, float* sm, int bid, int nb) {
    const int tid = otid();
    if (bid == 0 && tid < NE) p.cnt[tid] = 0;
    for (int item = bid; item < NB * 12; item += nb) {
        const int b = item / 12, ch = item % 12;
        __syncthreads();
        for (int d = tid; d < DM; d += NTHR) sm[d] = silu(p.c[b * DM + d]);
        __syncthreads();
        const int e = ch * 512 + tid;
        float acc = 0.f;
#pragma unroll 8
        for (int d = 0; d < DM; ++d) acc += sm[d] * p.w_ada[(size_t)d * NMOD + e];
        p.mod[b * NMOD + e] = acc + p.b_ada[e];
    }
}

DEV void ph_norm(const float* src, const float* g, const float* mod, int shift_off, int scale_off, bf16_t* dst, int bid, int nb) {
    const int tid_ = otid(); const int lane = tid_ & 63, wv = tid_ >> 6;
    for (int row = bid * NWV + wv; row < T; row += nb * NWV) {
        const float4* xr = (const float4*)(src + (size_t)row * DM);
        const int b = row / SEQ;
        float4 v[4]; float ss = 0.f;
#pragma unroll
        for (int j = 0; j < 4; ++j) { v[j] = xr[lane + 64 * j]; ss += v[j].x * v[j].x + v[j].y * v[j].y + v[j].z * v[j].z + v[j].w * v[j].w; }
        ss = wave_sum(ss);
        const float r = rsqrtf(ss * (1.f / DM) + 1e-6f);
#pragma unroll
        for (int j = 0; j < 4; ++j) {
            const int col = (lane + 64 * j) * 4;
            const float4 g4 = *(const float4*)(g + col);
            const float4 sc = *(const float4*)(mod + b * NMOD + scale_off + col);
            const float4 sh = *(const float4*)(mod + b * NMOD + shift_off + col);
            const float o0 = v[j].x * r * g4.x * (1.f + sc.x) + sh.x, o1 = v[j].y * r * g4.y * (1.f + sc.y) + sh.y;
            const float o2 = v[j].z * r * g4.z * (1.f + sc.z) + sh.z, o3 = v[j].w * r * g4.w * (1.f + sc.w) + sh.w;
            uint2 w; w.x = pk2(o0, o1); w.y = pk2(o2, o3);
            *(uint2*)(dst + (size_t)row * DM + col) = w;
        }
    }
}

template <bool DUAL, class RowF, class Epi>
DEV void ngemm_tile(const bf16_t* __restrict__ A, int lda, RowF rowf, const float* __restrict__ B, const float* __restrict__ B2, int ldb,
                    int m0, int n0, int K, Epi epi, float* sm) {
    float* As = sm;
    float* Bs = sm + 16 * 132;
    float* Bs2 = Bs + 16 * 64;
    const int tid = otid(), tm = tid >> 4, tn = tid & 15;
    float acc[4][4], acc2[4][4];
#pragma unroll
    for (int i = 0; i < 4; ++i)
#pragma unroll
        for (int j = 0; j < 4; ++j) { acc[i][j] = 0.f; acc2[i][j] = 0.f; }
    const int ar = tid >> 2, ak = (tid & 3) * 4;
    const int arow = rowf(m0 + ar);
    const bf16_t* ap = A + (size_t)(arow < 0 ? 0 : arow) * lda + ak;
    const int bk = tid >> 5, bn = (tid & 31) * 2;
    for (int k0 = 0; k0 < K; k0 += 16) {
        uint2 av = make_uint2(0u, 0u);
        if (arow >= 0) av = *(const uint2*)(ap + k0);
        const float2 bv = *(const float2*)(B + (size_t)(k0 + bk) * ldb + n0 + bn);
        float2 bv2 = make_float2(0.f, 0.f);
        if (DUAL) bv2 = *(const float2*)(B2 + (size_t)(k0 + bk) * ldb + n0 + bn);
        __syncthreads();
        As[(ak + 0) * 132 + ar] = __uint_as_float(av.x << 16);
        As[(ak + 1) * 132 + ar] = __uint_as_float(av.x & 0xffff0000u);
        As[(ak + 2) * 132 + ar] = __uint_as_float(av.y << 16);
        As[(ak + 3) * 132 + ar] = __uint_as_float(av.y & 0xffff0000u);
        Bs[bk * 64 + bn] = bv.x; Bs[bk * 64 + bn + 1] = bv.y;
        if (DUAL) { Bs2[bk * 64 + bn] = bv2.x; Bs2[bk * 64 + bn + 1] = bv2.y; }
        __syncthreads();
#pragma unroll
        for (int kk = 0; kk < 16; ++kk) {
            const float4 a = *(const float4*)&As[kk * 132 + tm * 4];
            const float4 b = *(const float4*)&Bs[kk * 64 + tn * 4];
            const float aa[4] = {a.x, a.y, a.z, a.w}, bb[4] = {b.x, b.y, b.z, b.w};
#pragma unroll
            for (int i = 0; i < 4; ++i)
#pragma unroll
                for (int j = 0; j < 4; ++j) acc[i][j] += aa[i] * bb[j];
            if (DUAL) {
                const float4 b2 = *(const float4*)&Bs2[kk * 64 + tn * 4];
                const float cc[4] = {b2.x, b2.y, b2.z, b2.w};
#pragma unroll
                for (int i = 0; i < 4; ++i)
#pragma unroll
                    for (int j = 0; j < 4; ++j) acc2[i][j] += aa[i] * cc[j];
            }
        }
    }
#pragma unroll
    for (int i = 0; i < 4; ++i)
#pragma unroll
        for (int j = 0; j < 4; ++j) epi(m0 + tm * 4 + i, n0 + tn * 4 + j, acc[i][j], acc2[i][j]);
}

struct RowId { DEV int operator()(int m) const { return m; } };
struct RowTok { const int* rl; DEV int operator()(int m) const { const int s = rl[m]; return s < 0 ? -1 : (s >> 3); } };

template <bool DUAL, class Epi>
DEV void ngemm_dense(const bf16_t* A, int lda, const float* B, const float* B2, int ldb, int M, int N, int K, Epi epi, float* sm, int bid, int nb) {
    const int tn = N / 64, nt = (M / 128) * tn;
    for (int t = bid; t < nt; t += nb) ngemm_tile<DUAL>(A, lda, RowId(), B, B2, ldb, (t / tn) * 128, (t % tn) * 64, K, epi, sm);
}

struct EpiInProj { bf16_t *U, *QKV, *G;
    DEV void operator()(int r, int c, float v, float) const {
        if (c < 512) U[(size_t)r * 512 + c] = f2bf(v);
        else if (c < 2816) QKV[(size_t)r * 2304 + (c - 512)] = f2bf(v);
        else G[(size_t)r * 2048 + (c - 2816)] = f2bf(sigm(v)); } };
struct EpiPoolGrp { bf16_t* Y; const float* ls; int g;
    DEV void operator()(int r, int c, float v, float) const { Y[(size_t)r * 512 + g * 128 + c] = f2bf(v * ls[g * 128 + c]); } };
struct EpiMergeA { bf16_t* MG; const bf16_t* G;
    DEV void operator()(int r, int c, float v, float) const { MG[(size_t)r * DM + c] = f2bf(bf2f(G[(size_t)r * 2048 + c]) * v); } };
struct EpiMergeB { bf16_t* MG; const bf16_t* G;
    DEV void operator()(int r, int c, float v, float) const { const size_t i = (size_t)r * DM + c; MG[i] = f2bf(bf2f(MG[i]) + bf2f(G[(size_t)r * 2048 + 1024 + c]) * v); } };
struct EpiOutProj { const float* x; float* out; const float* mod;
    DEV void operator()(int r, int c, float v, float) const { const size_t i = (size_t)r * DM + c; out[i] = x[i] + mod[(r / SEQ) * NMOD + 2048 + c] * v; } };
struct EpiLogits { float* LG;
    DEV void operator()(int r, int c, float v, float) const { LG[(size_t)r * NE + c] = v; } };
struct EpiAct { bf16_t* ACT;
    DEV void operator()(int r, int c, float v, float v2) const { ACT[(size_t)r * EFF + c] = f2bf(silu(v) * v2); } };
struct EpiSlab { bf16_t* SLAB; const int* rl; const float* w;
    DEV void operator()(int r, int c, float v, float) const { const int s = rl[r]; if (s >= 0) SLAB[(size_t)s * DM + c] = f2bf(v * w[s]); } };
struct EpiFinal { float* out; const bf16_t* SLAB; const float* mod;
    DEV void operator()(int r, int c, float v, float) const {
        float s = v;
#pragma unroll
        for (int k = 0; k < 8; ++k) s += bf2f(SLAB[((size_t)r * 8 + k) * DM + c]);
        const size_t i = (size_t)r * DM + c; out[i] = out[i] + mod[(r / SEQ) * NMOD + 5120 + c] * s; } };

DEV void ph_qknorm(const P& p, int bid, int nb) {
    const int tid_ = otid(); const int lane = tid_ & 63, wv = tid_ >> 6;
    const float gq = p.q_norm_g[lane], gk = p.k_norm_g[lane];
    const float invf = exp2f(-(float)(lane & 7) * (1.f / 8.f) * log2f(500000.f));
    for (int it = bid * NWV + wv; it < T * 24; it += nb * NWV) {
        const int t = it / 24, hh = it % 24;
        bf16_t* ptr = p.QKV + (size_t)t * 2304 + hh * 64 + lane;
        const float v = bf2f(*ptr);
        const float ss = wave_sum(v * v);
        float nv = v * rsqrtf(ss * (1.f / 64.f) + 1e-6f) * (hh < 12 ? gq : gk);
        const float partner = __shfl_xor(nv, 8);
        const float ang = (float)p.pos[t] * invf;
        const float cs = cosf(ang), sn = sinf(ang);
        if (lane < 8) nv = nv * cs - partner * sn;
        else if (lane < 16) nv = nv * cs + partner * sn;
        *ptr = f2bf(nv);
    }
}

DEV void ph_pool(const P& p, int bid, int nb) {
    const int tid_ = otid();
    for (size_t i = (size_t)bid * NTHR + tid_; i < (size_t)T * 512; i += (size_t)nb * NTHR) {
        const int t = (int)(i >> 9), c = (int)(i & 511);
        const int g = c >> 7, r = 1 << g;
        const int s = t & (SEQ - 1), base = t - s;
        const int lo = max(s - r, 0), hi = min(s + r, SEQ - 1);
        float sum = 0.f;
        for (int q = lo; q <= hi; ++q) sum += bf2f(p.U[(size_t)(base + q) * 512 + c]);
        p.PL[i] = f2bf(sum / (float)(hi - lo + 1) - bf2f(p.U[i]));
    }
}

DEV void ph_attn(const P& p, int bid, int nb) {
    const int tid_ = otid(); const int lane = tid_ & 63, wv = tid_ >> 6;
    for (int it = bid * NWV + wv; it < T * 4; it += nb * NWV) {
        const int t = it >> 2, slot = it & 3;
        const int s = t & (SEQ - 1), base = t - s;
        float M = -1e30f, l = 0.f, acc = 0.f;
#pragma unroll
        for (int g = 0; g < 3; ++g) {
            const int dsh = 2 * g, d = 1 << dsh, L = SEQ >> dsh;
            const int h = 4 * g + slot;
            const int m = s >> dsh, r = s & (d - 1);
            const float q = bf2f(p.QKV[(size_t)t * 2304 + h * 64 + lane]);
            const bf16_t* kb = p.QKV + 768 + h * 64 + lane;
            const bf16_t* vb = p.QKV + 1536 + h * 64 + lane;
#pragma unroll 4
            for (int rel = -64; rel <= 64; ++rel) {
                const int mm = m + rel;
                const bool valid = (mm >= 0) && (mm < L);
                const int mc = valid ? mm : m;
                const size_t tr = (size_t)(base + mc * d + r) * 2304;
                const float kv = bf2f(kb[tr]), vv = bf2f(vb[tr]);
                const float sc = wave_sum(q * kv) * 0.125f;
                if (valid) {
                    const float mn = fmaxf(M, sc);
                    const float f = __expf(M - mn), pe = __expf(sc - mn);
                    l = l * f + pe; acc = acc * f + pe * vv; M = mn;
                }
            }
        }
        p.O[(size_t)t * 256 + slot * 64 + lane] = f2bf(acc / l);
    }
}

DEV void ph_route(const P& p, int bid, int nb) {
    const int tid_ = otid(); const int lane = tid_ & 63, wv = tid_ >> 6;
    const float4 bias4 = *(const float4*)(p.router_bias + 4 * lane);
    for (int t = bid * NWV + wv; t < T; t += nb * NWV) {
        const float4 lg = *(const float4*)(p.LG + (size_t)t * NE + 4 * lane);
        const float s0 = 1.f / (1.f + expf(-lg.x)), s1 = 1.f / (1.f + expf(-lg.y)), s2 = 1.f / (1.f + expf(-lg.z)), s3 = 1.f / (1.f + expf(-lg.w));
        float v0 = s0 + bias4.x, v1 = s1 + bias4.y, v2 = s2 + bias4.z, v3 = s3 + bias4.w;
        float m1 = fmaxf(v0, v1), m2 = fminf(v0, v1);
        { const float n1 = fmaxf(m1, v2), n2 = fmaxf(fminf(m1, v2), m2); m1 = n1; m2 = n2; }
        { const float n1 = fmaxf(m1, v3), n2 = fmaxf(fminf(m1, v3), m2); m1 = n1; m2 = n2; }
#pragma unroll
        for (int o = 1; o <= 4; o <<= 1) {
            const float b1 = __shfl_xor(m1, o), b2 = __shfl_xor(m2, o);
            const float n1 = fmaxf(m1, b1), n2 = fmaxf(fminf(m1, b1), fmaxf(m2, b2)); m1 = n1; m2 = n2;
        }
        const float gs = m1 + m2; const int G = lane >> 3;
        int rank = 0;
#pragma unroll
        for (int g2 = 0; g2 < 8; ++g2) { const float o = __shfl(gs, g2 * 8); rank += ((o > gs) || (o == gs && g2 < G)) ? 1 : 0; }
        if (rank >= 4) { v0 = -INFINITY; v1 = -INFINITY; v2 = -INFINITY; v3 = -INFINITY; }
        int myidx = 0; float myw = 0.f, wsum = 0.f;
#pragma unroll
        for (int k = 0; k < 8; ++k) {
            float bv = v0; int bi = 0;
            if (v1 > bv) { bv = v1; bi = 1; }
            if (v2 > bv) { bv = v2; bi = 2; }
            if (v3 > bv) { bv = v3; bi = 3; }
            float bs = bi == 0 ? s0 : (bi == 1 ? s1 : (bi == 2 ? s2 : s3));
            int gi = lane * 4 + bi;
#pragma unroll
            for (int o = 1; o < 64; o <<= 1) {
                const float ov = __shfl_xor(bv, o), os = __shfl_xor(bs, o); const int oi = __shfl_xor(gi, o);
                if ((ov > bv) || (ov == bv && oi < gi)) { bv = ov; gi = oi; bs = os; }
            }
            if (gi == lane * 4 + 0) v0 = -INFINITY;
            if (gi == lane * 4 + 1) v1 = -INFINITY;
            if (gi == lane * 4 + 2) v2 = -INFINITY;
            if (gi == lane * 4 + 3) v3 = -INFINITY;
            if (lane == k) { myidx = gi; myw = bs; }
            wsum += bs;
        }
        if (lane < 8) {
            const int slot = t * 8 + lane;
            const int pos = atomicAdd(&p.cnt[myidx], 1);
            p.asg_e[slot] = myidx; p.asg_pos[slot] = pos; p.asg_w[slot] = myw / wsum * 2.5f;
        }
    }
}

DEV void load_offsets(const int* cnt, int* off) {
    const int tid = otid();
    __syncthreads();
    if (tid < NE) off[300 + tid] = (cnt[tid] + 255) & ~255;
    __syncthreads();
    if (tid == 0) { int a = 0; for (int e = 0; e < NE; ++e) { off[e] = a; a += off[300 + e]; } off[NE] = a; }
    __syncthreads();
}
DEV int find_expert(const int* off, int m0) {
    int lo = 0, hi = NE;
    while (hi - lo > 1) { const int mid = (lo + hi) >> 1; if (off[mid] <= m0) lo = mid; else hi = mid; }
    return lo;
}

DEV void ph_scatter(const P& p, int* off, int bid, int nb) {
    load_offsets(p.cnt, off);
    const int tid_ = otid();
    for (int slot = bid * NTHR + tid_; slot < NSLOT; slot += nb * NTHR) p.rowlist[off[p.asg_e[slot]] + p.asg_pos[slot]] = slot;
    for (int e = bid; e < NE; e += nb) {
        const int n = p.cnt[e], pd = (n + 255) & ~255;
        for (int i = n + tid_; i < pd; i += NTHR) p.rowlist[off[e] + i] = -1;
    }
}

DEV void ph_expert1(const P& p, float* sm, int* off, int bid, int nb) {
    load_offsets(p.cnt, off);
    const int nrt = off[NE] / 128, nt = nrt * 4;
    for (int t = bid; t < nt; t += nb) {
        const int m0 = (t >> 2) * 128, n0 = (t & 3) * 64, e = find_expert(off, m0);
        ngemm_tile<true>(p.XB, DM, RowTok{p.rowlist}, p.w_eg + (size_t)e * DM * EFF, p.w_eu + (size_t)e * DM * EFF, EFF, m0, n0, DM, EpiAct{p.ACT}, sm);
    }
}
DEV void ph_expert2(const P& p, float* sm, int* off, int bid, int nb) {
    load_offsets(p.cnt, off);
    const int nrt = off[NE] / 128, nt = nrt * 16;
    for (int t = bid; t < nt; t += nb) {
        const int m0 = (t >> 4) * 128, n0 = (t & 15) * 64, e = find_expert(off, m0);
        ngemm_tile<false>(p.ACT, EFF, RowId(), p.w_ed + (size_t)e * EFF * DM, nullptr, DM, m0, n0, EFF, EpiSlab{p.SLAB, p.rowlist, p.asg_w}, sm);
    }
}

namespace mg {
constexpr int BM = 256, BK = 64, HALF = 128, HTB = HALF * BK * 2, STAGE_BYTES = 8 * HTB, NXCD = 8, WGM = 8;
__host__ __device__ __forceinline__ int lds_byte(int r, int c) { const int st = (r >> 4) * 2 + (c >> 5), rr = r & 15, cc = c & 31, ob = rr * 64 + cc * 2; return st * 1024 + (ob ^ (((ob >> 9) & 1) << 5)); }
__host__ __device__ __forceinline__ void stage_rc(int b, int& R, int& C) { const int st = b / 1024, sb = b % 1024, swz = sb ^ (((sb >> 9) & 1) << 5); R = (st >> 1) * 16 + swz / 64; C = (st & 1) * 32 + (swz % 64) / 2; }
__host__ __device__ __forceinline__ int perm32(int rho) { const int n = rho >> 4, i = rho & 15; return 8 * (i >> 2) + 4 * n + (i & 3); }

struct Unit { int pm, pn, e, pad; const char* A; const char* B; };

struct DenseOrder {
    int nM, nN, nwg, G, c; const char* A; const char* B; size_t tstep;
    DEV void init(const bf16_t* A_, const bf16_t* B_, int M, int N, int K, int G_, int c_) { nM = M / BM; nN = N / BM; nwg = nM * nN; G = G_; c = c_; A = (const char*)A_; B = (const char*)B_; tstep = (size_t)BM * K * 2; }
    DEV bool next(int i, Unit& u) const {
        const long L = (long)i * G + c; if (L >= nwg) return false;
        int wgid = (int)L; { const int q = nwg / NXCD, r = nwg % NXCD, xcd = wgid % NXCD, off = wgid / NXCD; wgid = (xcd < r ? xcd * (q + 1) : r * (q + 1) + (xcd - r) * q) + off; }
        const int nig = WGM * nN, gid = wgid / nig, fm = gid * WGM, gsz = (nM - fm) < WGM ? (nM - fm) : WGM;
        u.pm = fm + ((wgid % nig) % gsz); u.pn = (wgid % nig) / gsz; u.e = 0; u.pad = 0;
        u.A = A + (size_t)u.pm * tstep; u.B = B + (size_t)u.pn * tstep; return true;
    }
};
struct ExpertOrder {
    const LAS int* off; int nrt, ncol, G, c; const char* A; const char* W; size_t wstride, tstepB, tstepA; bool gather;
    DEV bool next(int i, Unit& u) const {
        const int L = i * G + c; if (L >= nrt * ncol) return false;
        u.pm = L / ncol; u.pn = L % ncol; u.pad = 0;
        int lo = 0, hi = NE; const int m0 = u.pm * BM;
        while (hi - lo > 1) { const int mid = (lo + hi) >> 1; const int ov = __builtin_amdgcn_readfirstlane(off[mid]); if (ov <= m0) lo = mid; else hi = mid; }
        u.e = lo;
        u.A = gather ? A : A + (size_t)u.pm * tstepA; u.B = W + (size_t)lo * wstride + (size_t)u.pn * tstepB; return true;
    }
};

template <class Epi, class Sched, bool GATHER>
DEV void gemm_phase(LAS unsigned char* lds, const LAS unsigned* gtab, const int K, const Sched& S, const Epi& E) {
    const int tid = otid(), wid = __builtin_amdgcn_readfirstlane(tid >> 6), lane = tid & 63, wr = wid >> 2, wc = wid & 3, fr = lane & 15, fq = lane >> 4;
    const int nt = K / BK;
    int Rr[2], Cc[2]; unsigned voffB[2];
#pragma unroll
    for (int i = 0; i < 2; ++i) { stage_rc(tid * 16 + i * 8192, Rr[i], Cc[i]); const int Rb = Epi::PERM ? ((Rr[i] & ~31) + perm32(Rr[i] & 31)) : Rr[i]; voffB[i] = (unsigned)(Rb * K + Cc[i]) * 2u; }
    const size_t kstep = (size_t)(BK * 2);
    const size_t hstep = (size_t)HALF * K * 2;
    const unsigned ldsw = (unsigned)wid * 1024u;
    const int aoff = lds_byte(wr * 64 + fr, fq * 8), boff = lds_byte(wc * 32 + fr, fq * 8);
#define MG_SA(b, h) (((b) * 2 + (h)) * HTB)
#define MG_SB(b, h) ((4 + (b) * 2 + (h)) * HTB)
#define MG_STAGE(bufoff, gbase, voff) do { _Pragma("unroll") for (int _i = 0; _i < 2; ++_i) \
        __builtin_amdgcn_global_load_lds((const unsigned*)((const char*)(gbase) + (voff)[_i]), (LAS unsigned*)(lds + (bufoff) + ldsw + _i * 8192), 16, 0, 0); } while (0)
#define MG_LDA(dst, b, h) do { _Pragma("unroll") for (int m = 0; m < 4; ++m) _Pragma("unroll") for (int k = 0; k < 2; ++k) dst[m][k] = *(const LAS bf16x8*)(lds + MG_SA(b, h) + aoff + m * 2048 + k * 1024); } while (0)
#define MG_LDB(dst, b, h) do { _Pragma("unroll") for (int n = 0; n < 2; ++n) _Pragma("unroll") for (int k = 0; k < 2; ++k) dst[n][k] = *(const LAS bf16x8*)(lds + MG_SB(b, h) + boff + n * 2048 + k * 1024); } while (0)
#define MG_MMA(ai, bj, At, Bt) do { __builtin_amdgcn_s_setprio(1); _Pragma("unroll") for (int m = 0; m < 4; ++m) _Pragma("unroll") for (int n = 0; n < 2; ++n) _Pragma("unroll") for (int k = 0; k < 2; ++k) \
        acc[ai][bj][m][n] = __builtin_amdgcn_mfma_f32_16x16x32_bf16(Bt[n][k], At[m][k], acc[ai][bj][m][n], 0, 0, 0); __builtin_amdgcn_s_setprio(0); } while (0)
#define MG_WAIT_V(n) asm volatile("s_waitcnt vmcnt(" #n ")" ::: "memory")
#define MG_WAIT_L(n) asm volatile("s_waitcnt lgkmcnt(" #n ")" ::: "memory")
#define MG_BAR __builtin_amdgcn_s_barrier()
#define MG_SCHED __builtin_amdgcn_sched_barrier(0)
    Unit cur, nxt; int ui = 0;
    if (!S.next(0, cur)) return;
    f32x4 acc[2][2][4][2];
#pragma unroll
    for (int a = 0; a < 2; ++a)
#pragma unroll
        for (int b = 0; b < 2; ++b)
#pragma unroll
            for (int m = 0; m < 4; ++m)
#pragma unroll
                for (int n = 0; n < 2; ++n) acc[a][b][m][n] = (f32x4){0.f, 0.f, 0.f, 0.f};
    bf16x8 At[4][2], B0[2][2], B1[2][2];
    unsigned va0[2], va1[2], na0[2], na1[2];
#pragma unroll
    for (int i = 0; i < 2; ++i) {
        if (GATHER) { va0[i] = gtab[Rr[i]] + (unsigned)Cc[i] * 2u; va1[i] = gtab[HALF + Rr[i]] + (unsigned)Cc[i] * 2u; }
        else { va0[i] = (unsigned)(Rr[i] * K + Cc[i]) * 2u; va1[i] = va0[i] + (unsigned)hstep; }
        na0[i] = va0[i]; na1[i] = va1[i];
    }
    const char* cA = cur.A; const char* cB = cur.B;
    MG_STAGE(MG_SB(0, 0), cB, voffB); MG_STAGE(MG_SB(0, 1), cB + hstep, voffB); MG_STAGE(MG_SA(0, 0), cA, va0); MG_STAGE(MG_SA(0, 1), cA, va1);
    if (wr == 1) MG_BAR;
    MG_WAIT_V(2); MG_BAR;
    MG_STAGE(MG_SB(1, 0), cB + kstep, voffB); MG_STAGE(MG_SA(1, 0), cA + kstep, va0); MG_STAGE(MG_SB(1, 1), cB + hstep + kstep, voffB);
    MG_WAIT_V(6); MG_BAR;
    for (;;) {
        const bool has_next = S.next(ui + 1, nxt);
        const char* nA = has_next ? nxt.A : cA; const char* nB = has_next ? nxt.B : cB;
        if (GATHER) {
            if (has_next) {
#pragma unroll
                for (int i = 0; i < 2; ++i) { na0[i] = gtab[(ui + 1) * BM + Rr[i]] + (unsigned)Cc[i] * 2u; na1[i] = gtab[(ui + 1) * BM + HALF + Rr[i]] + (unsigned)Cc[i] * 2u; }
            }
        }
#pragma unroll 1
        for (int t = 0; t < nt; t += 2) {
            const bool last = (t == nt - 2);
            const char* a1 = cA + (size_t)(t + 1) * kstep;
            const char* a2 = last ? nA : cA + (size_t)(t + 2) * kstep; const char* b2 = last ? nB : cB + (size_t)(t + 2) * kstep;
            const char* a3 = a2 + kstep; const char* b3 = b2 + kstep;
            unsigned o0[2], o1[2];
#pragma unroll
            for (int i = 0; i < 2; ++i) { o0[i] = (GATHER && last) ? na0[i] : va0[i]; o1[i] = (GATHER && last) ? na1[i] : va1[i]; }
            MG_LDB(B0, 0, 0); MG_LDB(B1, 0, 1); MG_SCHED; MG_LDA(At, 0, 0); MG_STAGE(MG_SA(1, 1), a1, va1);
            MG_WAIT_V(8); MG_WAIT_L(0); MG_BAR; MG_MMA(0, 0, At, B0); MG_MMA(0, 1, At, B1); MG_BAR; MG_SCHED;
            MG_LDA(At, 0, 1); MG_STAGE(MG_SB(0, 0), b2, voffB); MG_STAGE(MG_SB(0, 1), b2 + hstep, voffB); MG_STAGE(MG_SA(0, 0), a2, o0);
            MG_WAIT_V(8); MG_WAIT_L(0); MG_BAR; MG_MMA(1, 0, At, B0); MG_MMA(1, 1, At, B1); MG_BAR; MG_SCHED;
            MG_LDB(B0, 1, 0); MG_LDB(B1, 1, 1); MG_SCHED; MG_LDA(At, 1, 0); MG_STAGE(MG_SA(0, 1), a2, o1);
            MG_WAIT_V(8); MG_WAIT_L(0); MG_BAR; MG_MMA(0, 0, At, B0); MG_MMA(0, 1, At, B1); MG_BAR; MG_SCHED;
            MG_LDA(At, 1, 1); MG_STAGE(MG_SB(1, 0), b3, voffB); MG_STAGE(MG_SB(1, 1), b3 + hstep, voffB); MG_STAGE(MG_SA(1, 0), a3, o0);
            MG_WAIT_V(8); MG_WAIT_L(0); MG_BAR; MG_MMA(1, 0, At, B0); MG_MMA(1, 1, At, B1); MG_BAR; MG_SCHED;
        }
        if (wr == 0) MG_BAR;
        E(acc, cur, wr, wc, fr, fq);
        if (!has_next) break;
#pragma unroll
        for (int a = 0; a < 2; ++a)
#pragma unroll
            for (int b = 0; b < 2; ++b)
#pragma unroll
                for (int m = 0; m < 4; ++m)
#pragma unroll
                    for (int n = 0; n < 2; ++n) acc[a][b][m][n] = (f32x4){0.f, 0.f, 0.f, 0.f};
        cur = nxt; cA = nA; cB = nB; ++ui;
#pragma unroll
        for (int i = 0; i < 2; ++i) { va0[i] = na0[i]; va1[i] = na1[i]; }
        if (wr == 1) MG_BAR;
    }
    MG_WAIT_V(0);
    MG_BAR;
    __syncthreads();
#undef MG_SA
#undef MG_SB
#undef MG_STAGE
#undef MG_LDA
#undef MG_LDB
#undef MG_MMA
#undef MG_WAIT_V
#undef MG_WAIT_L
#undef MG_BAR
#undef MG_SCHED
}

DEV u32x4 pack8(const f32x4 a, const f32x4 b) { u32x4 w; w.x = pk2(a[0], a[1]); w.y = pk2(a[2], a[3]); w.z = pk2(b[0], b[1]); w.w = pk2(b[2], b[3]); return w; }
DEV f32x4 unpack_lo(const u32x4 w) { return (f32x4){__uint_as_float(w.x << 16), __uint_as_float(w.x & 0xffff0000u), __uint_as_float(w.y << 16), __uint_as_float(w.y & 0xffff0000u)}; }
DEV f32x4 unpack_hi(const u32x4 w) { return (f32x4){__uint_as_float(w.z << 16), __uint_as_float(w.z & 0xffff0000u), __uint_as_float(w.w << 16), __uint_as_float(w.w & 0xffff0000u)}; }
DEV f32x4 sig4(const f32x4 v) { return (f32x4){sigm(v[0]), sigm(v[1]), sigm(v[2]), sigm(v[3])}; }
DEV f32x4 silu4(const f32x4 v) { return (f32x4){silu(v[0]), silu(v[1]), silu(v[2]), silu(v[3])}; }
#define ACC_T const f32x4 (&acc)[2][2][4][2]

struct MEpiInProj { static constexpr bool PERM = true; bf16_t *U, *QKV, *G;
    DEV void operator()(ACC_T, const Unit& u, int wr, int wc, int fr, int fq) const {
        int colt = u.pn * BM; bf16_t* base; int ld; bool sg = false;
        if (colt < 512) { base = U; ld = 512; } else if (colt < 2816) { base = QKV; ld = 2304; colt -= 512; } else { base = G; ld = 2048; colt -= 2816; sg = true; }
        const int row0 = u.pm * BM + wr * 64 + fr, col0 = colt + wc * 32 + 8 * fq;
#pragma unroll
        for (int ai = 0; ai < 2; ++ai)
#pragma unroll
            for (int m = 0; m < 4; ++m) { bf16_t* rowp = base + (size_t)(row0 + ai * HALF + m * 16) * ld + col0;
#pragma unroll
                for (int bj = 0; bj < 2; ++bj) { f32x4 v0 = acc[ai][bj][m][0], v1 = acc[ai][bj][m][1]; if (sg) { v0 = sig4(v0); v1 = sig4(v1); }
                    *(u32x4*)(rowp + bj * HALF) = pack8(v0, v1); }
                asm volatile("" ::: "memory"); }
    } };
template <bool SECOND> struct MEpiMerge { static constexpr bool PERM = true; bf16_t* MG; const bf16_t* G;
    DEV void operator()(ACC_T, const Unit& u, int wr, int wc, int fr, int fq) const {
        const int row0 = u.pm * BM + wr * 64 + fr, col0 = u.pn * BM + wc * 32 + 8 * fq;
#pragma unroll
        for (int ai = 0; ai < 2; ++ai)
#pragma unroll
            for (int m = 0; m < 4; ++m) { const size_t r = (size_t)(row0 + ai * HALF + m * 16);
#pragma unroll
                for (int bj = 0; bj < 2; ++bj) { const int c = col0 + bj * HALF;
                    const u32x4 gw = *(const u32x4*)(G + r * 2048 + (SECOND ? 1024 : 0) + c);
                    f32x4 v0 = acc[ai][bj][m][0] * unpack_lo(gw), v1 = acc[ai][bj][m][1] * unpack_hi(gw);
                    if (SECOND) { const u32x4 pw = *(const u32x4*)(MG + r * DM + c); v0 += unpack_lo(pw); v1 += unpack_hi(pw); }
                    *(u32x4*)(MG + r * DM + c) = pack8(v0, v1); }
                asm volatile("" ::: "memory"); }
    } };
struct MEpiOutProj { static constexpr bool PERM = false; const float* x; float* out; const float* mod;
    DEV void operator()(ACC_T, const Unit& u, int wr, int wc, int fr, int fq) const {
        const int row0 = u.pm * BM + wr * 64 + fr, col0 = u.pn * BM + wc * 32 + 4 * fq;
        const float* gm = mod + ((u.pm * BM) / SEQ) * NMOD + 2048;
#pragma unroll
        for (int ai = 0; ai < 2; ++ai)
#pragma unroll
            for (int m = 0; m < 4; ++m) { const size_t r = (size_t)(row0 + ai * HALF + m * 16) * DM;
#pragma unroll
                for (int bj = 0; bj < 2; ++bj)
#pragma unroll
                    for (int n = 0; n < 2; ++n) { const int c = col0 + bj * HALF + n * 16;
                        *(f32x4*)(out + r + c) = *(const f32x4*)(x + r + c) + *(const f32x4*)(gm + c) * acc[ai][bj][m][n]; }
                asm volatile("" ::: "memory"); }
    } };
struct MEpiRouterShared { static constexpr bool PERM = true; float* LG; bf16_t* HS;
    DEV void operator()(ACC_T, const Unit& u, int wr, int wc, int fr, int fq) const {
        const int row0 = u.pm * BM + wr * 64 + fr, cw = wc * 32 + 8 * fq;
#pragma unroll
        for (int ai = 0; ai < 2; ++ai)
#pragma unroll
            for (int m = 0; m < 4; ++m) { const size_t r = (size_t)(row0 + ai * HALF + m * 16);
                if (u.pn == 0) {
#pragma unroll
                    for (int bj = 0; bj < 2; ++bj)
#pragma unroll
                        for (int n = 0; n < 2; ++n) *(f32x4*)(LG + r * NE + bj * HALF + cw + 4 * n) = acc[ai][bj][m][n];
                } else {
                    const f32x4 v0 = silu4(acc[ai][0][m][0]) * acc[ai][1][m][0], v1 = silu4(acc[ai][0][m][1]) * acc[ai][1][m][1];
                    *(u32x4*)(HS + r * EFF + (u.pn - 1) * HALF + cw) = pack8(v0, v1);
                }
                asm volatile("" ::: "memory"); }
    } };
struct MEpiAct { static constexpr bool PERM = true; bf16_t* ACT;
    DEV void operator()(ACC_T, const Unit& u, int wr, int wc, int fr, int fq) const {
        const int row0 = u.pm * BM + wr * 64 + fr, cw = u.pn * HALF + wc * 32 + 8 * fq;
#pragma unroll
        for (int ai = 0; ai < 2; ++ai)
#pragma unroll
            for (int m = 0; m < 4; ++m) { const size_t r = (size_t)(row0 + ai * HALF + m * 16);
                const f32x4 v0 = silu4(acc[ai][0][m][0]) * acc[ai][1][m][0], v1 = silu4(acc[ai][0][m][1]) * acc[ai][1][m][1];
                *(u32x4*)(ACT + r * EFF + cw) = pack8(v0, v1); asm volatile("" ::: "memory"); }
    } };
struct MEpiSlab { static constexpr bool PERM = true; bf16_t* SLAB; const int* rl; const float* w;
    DEV void operator()(ACC_T, const Unit& u, int wr, int wc, int fr, int fq) const {
        const int row0 = u.pm * BM + wr * 64 + fr, col0 = u.pn * BM + wc * 32 + 8 * fq;
#pragma unroll
        for (int ai = 0; ai < 2; ++ai)
#pragma unroll
            for (int m = 0; m < 4; ++m) { const int s = rl[row0 + ai * HALF + m * 16];
                if (s >= 0) { const float g = w[s];
#pragma unroll
                    for (int bj = 0; bj < 2; ++bj) *(u32x4*)(SLAB + (size_t)s * DM + col0 + bj * HALF) = pack8(acc[ai][bj][m][0] * g, acc[ai][bj][m][1] * g); }
                asm volatile("" ::: "memory"); }
    } };
struct MEpiFinal { static constexpr bool PERM = false; float* out; const bf16_t* SLAB; const float* mod;
    DEV void operator()(ACC_T, const Unit& u, int wr, int wc, int fr, int fq) const {
        const int row0 = u.pm * BM + wr * 64 + fr, col0 = u.pn * BM + wc * 32 + 4 * fq;
        const float* gm = mod + ((u.pm * BM) / SEQ) * NMOD + 5120;
#pragma unroll
        for (int ai = 0; ai < 2; ++ai)
#pragma unroll
            for (int m = 0; m < 4; ++m) { const size_t row = (size_t)(row0 + ai * HALF + m * 16);
#pragma unroll
                for (int bj = 0; bj < 2; ++bj)
#pragma unroll
                    for (int n = 0; n < 2; ++n) { const int c = col0 + bj * HALF + n * 16; f32x4 sacc = acc[ai][bj][m][n];
#pragma unroll
                        for (int k = 0; k < 8; ++k) { const u32x2 sw = *(const u32x2*)(SLAB + (row * 8 + k) * DM + c);
                            sacc += (f32x4){__uint_as_float(sw.x << 16), __uint_as_float(sw.x & 0xffff0000u), __uint_as_float(sw.y << 16), __uint_as_float(sw.y & 0xffff0000u)}; }
                        float* op = out + row * DM + c; *(f32x4*)op = *(const f32x4*)op + *(const f32x4*)(gm + c) * sacc; asm volatile("" ::: "memory"); } }
    } };
#undef ACC_T
}

template <class Src>
DEV void transpose_blk(const Src& src, int K, bf16_t* WT0, LAS float* scr, int k0, int lane) {
#pragma unroll 8
    for (int i = 0; i < 32; ++i) { const int kk = 2 * i + (lane >> 5); scr[kk * 33 + (lane & 31)] = src(k0 + kk, lane & 31); }
    asm volatile("s_waitcnt lgkmcnt(0)" ::: "memory");
    const int c = lane & 7;
#pragma unroll
    for (int j = 0; j < 4; ++j) { const int n = (lane >> 3) + 8 * j; const LAS float* s = scr + (8 * c) * 33 + n;
        u32x4 o; o.x = pk2(s[0 * 33], s[1 * 33]); o.y = pk2(s[2 * 33], s[3 * 33]); o.z = pk2(s[4 * 33], s[5 * 33]); o.w = pk2(s[6 * 33], s[7 * 33]);
        *(u32x4*)(WT0 + (size_t)n * K + k0 + 8 * c) = o; }
    asm volatile("s_waitcnt lgkmcnt(0)" ::: "memory");
}
struct SrcCol { const float* W; int ld; DEV float operator()(int k, int j) const { return W[(size_t)k * ld + j]; } };
struct SrcEff { const float *wg, *ls, *wu;
    DEV float operator()(int k, int j) const { const int g = k >> 7; const float* a = wg + (size_t)k * 128; const float* l = ls + g * 128; const float* b = wu + (size_t)(g * 128) * DM + j; float s = 0.f;
#pragma unroll 4
        for (int d = 0; d < 128; ++d) s += a[d] * l[d] * b[(size_t)d * DM]; return s; } };
DEV void tr_plain(const float* W, int K, int N, bf16_t* WT, LAS float* scr, int item, int lane) {
    const int nblk = N / 32, k0 = 64 * (item / nblk), n0 = 32 * (item % nblk);
    transpose_blk(SrcCol{W + n0, N}, K, WT + (size_t)n0 * K, scr, k0, lane);
}
DEV void tr_gu(const float* g, const float* u, int K, bf16_t* WT, LAS float* scr, int k0, int rho0, int lane) {
    const int ch0 = (rho0 >> 8) * 128 + (rho0 & 127);
    const float* m = (rho0 & 128) ? u : g;
    transpose_blk(SrcCol{m + ch0, EFF}, K, WT + (size_t)rho0 * K, scr, k0, lane);
}

DEV void ph_prep_small(const P& p, LAS float* scr, int gw, int ngw, int lane) {
    constexpr int I_IN = 16 * (INW / 32), I_EFF = 8 * 32, I_AU = 4 * 32, I_OUT = 16 * 32, I_R = 16 * 8, I_S = 16 * 16, I_SD = 4 * 32;
    constexpr int NIT = I_IN + I_EFF + I_AU + I_OUT + I_R + I_S + I_SD;
    for (int it = gw; it < NIT; it += ngw) {
        int r = it;
        if (r < I_IN) { tr_plain(p.w_in, DM, INW, p.WT_IN, scr, r, lane); continue; } r -= I_IN;
        if (r < I_EFF) { const int k0 = 64 * (r / 32), n0 = 32 * (r % 32);
            transpose_blk(SrcEff{p.pool_w_grp, p.pool_scale, p.w_pool_up + n0}, 512, p.WT_EFF + (size_t)n0 * 512, scr, k0, lane); continue; } r -= I_EFF;
        if (r < I_AU) { tr_plain(p.w_attn_up, 256, DM, p.WT_AU, scr, r, lane); continue; } r -= I_AU;
        if (r < I_OUT) { tr_plain(p.w_out, DM, DM, p.WT_OUT, scr, r, lane); continue; } r -= I_OUT;
        if (r < I_R) { tr_plain(p.w_router, DM, NE, p.WT_RS, scr, r, lane); continue; } r -= I_R;
        if (r < I_S) { tr_gu(p.w_sg, p.w_su, DM, p.WT_RS + (size_t)256 * DM, scr, 64 * (r / 16), 32 * (r % 16), lane); continue; } r -= I_S;
        tr_plain(p.w_sd, EFF, DM, p.WT_SD, scr, r, lane);
    }
}
DEV void ph_prep_ed(const P& p, LAS float* scr, int gw, int ngw, int lane) {
    constexpr int IPE = 4 * 32;
    for (int it = gw; it < NE * IPE; it += ngw) { const int e = it / IPE;
        tr_plain(p.w_ed + (size_t)e * EFF * DM, EFF, DM, p.WT_ED + (size_t)e * DM * EFF, scr, it % IPE, lane); }
}
DEV void ph_prep_egu(const P& p, LAS float* scr, int gw, int ngw, int lane) {
    constexpr int IPE = 16 * 16;
    for (int it = gw; it < NE * IPE; it += ngw) { const int e = it / IPE, r = it % IPE;
        tr_gu(p.w_eg + (size_t)e * DM * EFF, p.w_eu + (size_t)e * DM * EFF, DM, p.WT_EGU + (size_t)e * 512 * DM, scr, 64 * (r / 16), 32 * (r % 16), lane); }
}

constexpr int LDS_BYTES = 147456;
constexpr int LDS_OFF_TAB = 131072;
constexpr int LDS_GTAB = 131072 + 2560;
constexpr int MAXU = 10;

DEV void fill_gtab(const P& p, const LAS int* off, LAS unsigned* gtab, int ncol, int bid, int nb) {
    const int nrt = off[NE] / 256, tot = nrt * ncol; const int tid_ = otid();
    for (int i = 0; i < MAXU; ++i) { const int L = i * nb + bid; if (L >= tot) break;
        const int pm = L / ncol;
        if (tid_ < 256) { const int s = p.rowlist[pm * 256 + tid_]; gtab[i * 256 + tid_] = (unsigned)(s < 0 ? 0 : (s >> 3)) * (unsigned)(DM * 2); } }
    __syncthreads();
}

#define GSYNC() cg::this_grid().sync()
__global__ void __launch_bounds__(NTHR, 2) fwd_all(P p) {
    extern __shared__ __attribute__((aligned(16))) unsigned char lds_raw[];
    LAS unsigned char* lds = (LAS unsigned char*)lds_raw;
    float* sm = (float*)lds_raw;
    int* off = (int*)(lds_raw + LDS_OFF_TAB);
    const LAS int* offl = (const LAS int*)(lds + LDS_OFF_TAB);
    LAS unsigned* gtab = (LAS unsigned*)(lds + LDS_GTAB);
    const int bid = blockIdx.x, nb = gridDim.x;
    const int tid_ = otid(); const int lane = tid_ & 63, wv = tid_ >> 6;
    LAS float* scr = (LAS float*)(lds + wv * 16384);
    const int gw = bid * NWV + wv, ngw = nb * NWV;

    ph_mod(p, sm, bid, nb);
    __syncthreads();
    ph_prep_small(p, scr, gw, ngw, lane);
#if MF_EXP2
    ph_prep_ed(p, scr, gw, ngw, lane);
#endif
    GSYNC();
    ph_norm(p.x, p.norm1_g, p.mod, 0, 1024, p.XB, bid, nb);
    GSYNC();
#if MF_INPROJ
    { mg::DenseOrder S; S.init(p.XB, p.WT_IN, T, INW, DM, nb, bid);
      mg::gemm_phase<mg::MEpiInProj, mg::DenseOrder, false>(lds, gtab, DM, S, mg::MEpiInProj{p.U, p.QKV, p.G}); }
#else
    ngemm_dense<false>(p.XB, DM, p.w_in, nullptr, INW, T, INW, DM, EpiInProj{p.U, p.QKV, p.G}, sm, bid, nb);
#endif
    GSYNC();
    ph_qknorm(p, bid, nb); ph_pool(p, bid, nb);
    GSYNC();
    ph_attn(p, bid, nb);
#if !MF_MERGE
#pragma unroll 1
    for (int g = 0; g < 4; ++g) ngemm_dense<false>(p.PL + g * 128, 512, p.pool_w_grp + g * 128 * 128, nullptr, 128, T, 128, 128, EpiPoolGrp{p.Y, p.pool_scale, g}, sm, bid, nb);
#endif
    GSYNC();
#if MF_MERGE
    { mg::DenseOrder S; S.init(p.PL, p.WT_EFF, T, DM, 512, nb, bid);
      mg::gemm_phase<mg::MEpiMerge<false>, mg::DenseOrder, false>(lds, gtab, 512, S, mg::MEpiMerge<false>{p.XB, p.G}); }
    { mg::DenseOrder S; S.init(p.O, p.WT_AU, T, DM, 256, nb, bid);
      mg::gemm_phase<mg::MEpiMerge<true>, mg::DenseOrder, false>(lds, gtab, 256, S, mg::MEpiMerge<true>{p.XB, p.G}); }
#else
    ngemm_dense<false>(p.Y, 512, p.w_pool_up, nullptr, DM, T, DM, 512, EpiMergeA{p.XB, p.G}, sm, bid, nb);
    GSYNC();
    ngemm_dense<false>(p.O, 256, p.w_attn_up, nullptr, DM, T, DM, 256, EpiMergeB{p.XB, p.G}, sm, bid, nb);
#endif
    GSYNC();
#if MF_OUT
    { mg::DenseOrder S; S.init(p.XB, p.WT_OUT, T, DM, DM, nb, bid);
      mg::gemm_phase<mg::MEpiOutProj, mg::DenseOrder, false>(lds, gtab, DM, S, mg::MEpiOutProj{p.x, p.out, p.mod}); }
#else
    ngemm_dense<false>(p.XB, DM, p.w_out, nullptr, DM, T, DM, DM, EpiOutProj{p.x, p.out, p.mod}, sm, bid, nb);
#endif
    GSYNC();
    ph_norm(p.out, p.norm2_g, p.mod, 3072, 4096, p.XB, bid, nb);
#if MF_EXP1
    __syncthreads();
    ph_prep_egu(p, scr, gw, ngw, lane);
#endif
    GSYNC();
#if MF_ROUTER
    { mg::DenseOrder S; S.init(p.XB, p.WT_RS, T, 768, DM, nb, bid);
      mg::gemm_phase<mg::MEpiRouterShared, mg::DenseOrder, false>(lds, gtab, DM, S, mg::MEpiRouterShared{p.LG, p.HS}); }
#else
    ngemm_dense<false>(p.XB, DM, p.w_router, nullptr, NE, T, NE, DM, EpiLogits{p.LG}, sm, bid, nb);
#endif
    GSYNC();
    ph_route(p, bid, nb);
    GSYNC();
    ph_scatter(p, off, bid, nb);
    GSYNC();
#if MF_EXP1
    { load_offsets(p.cnt, off); fill_gtab(p, offl, gtab, 2, bid, nb);
      mg::ExpertOrder S{offl, __builtin_amdgcn_readfirstlane(off[NE]) / 256, 2, nb, bid, (const char*)p.XB, (const char*)p.WT_EGU, (size_t)512 * DM * 2, (size_t)256 * DM * 2, 0, true};
      mg::gemm_phase<mg::MEpiAct, mg::ExpertOrder, true>(lds, gtab, DM, S, mg::MEpiAct{p.ACT}); }
#else
    ph_expert1(p, sm, off, bid, nb);
#endif
    GSYNC();
#if MF_EXP2
    { load_offsets(p.cnt, off);
      mg::ExpertOrder S{offl, __builtin_amdgcn_readfirstlane(off[NE]) / 256, 4, nb, bid, (const char*)p.ACT, (const char*)p.WT_ED, (size_t)DM * EFF * 2, (size_t)256 * EFF * 2, (size_t)256 * EFF * 2, false};
      mg::gemm_phase<mg::MEpiSlab, mg::ExpertOrder, false>(lds, gtab, EFF, S, mg::MEpiSlab{p.SLAB, p.rowlist, p.asg_w}); }
#else
    ph_expert2(p, sm, off, bid, nb);
#endif
    GSYNC();
#if !MF_ROUTER
    ngemm_dense<true>(p.XB, DM, p.w_sg, p.w_su, EFF, T, EFF, DM, EpiAct{p.HS}, sm, bid, nb);
    GSYNC();
#endif
#if MF_FINAL
    { mg::DenseOrder S; S.init(p.HS, p.WT_SD, T, DM, EFF, nb, bid);
      mg::gemm_phase<mg::MEpiFinal, mg::DenseOrder, false>(lds, gtab, EFF, S, mg::MEpiFinal{p.out, p.SLAB, p.mod}); }
#else
    ngemm_dense<false>(p.HS, EFF, p.w_sd, nullptr, DM, T, DM, EFF, EpiFinal{p.out, p.SLAB, p.mod}, sm, bid, nb);
#endif
}

extern "C" void kernel_launch(void* const* d_in, const int* in_sizes, int n_in, void* d_out, int out_size, void* d_ws, size_t ws_size, hipStream_t stream) {
    static int grid = 0;
    if (grid == 0) {
        int dev = 0, cus = 0;
        (void)hipGetDevice(&dev);
        (void)hipDeviceGetAttribute(&cus, hipDeviceAttributeMultiprocessorCount, dev);
        int per_cu = 0;
        (void)hipFuncSetAttribute((const void*)fwd_all, hipFuncAttributeMaxDynamicSharedMemorySize, LDS_BYTES);
        (void)hipOccupancyMaxActiveBlocksPerMultiprocessor(&per_cu, fwd_all, NTHR, LDS_BYTES);
        if (per_cu < 1) { fprintf(stderr, "kernel_launch: occupancy query says %d blocks/CU\n", per_cu); per_cu = 1; }
        if (per_cu > 1) per_cu = 1;
        grid = cus * per_cu;
        if (ws_size < WS_END) { fprintf(stderr, "kernel_launch: workspace too small (%zu < %zu)\n", ws_size, (size_t)WS_END); grid = -1; }
    }
    if (grid < 0) return;
    P p{};
    const float* const* in = (const float* const*)d_in;
    p.x = in[0]; p.c = in[1]; p.pos = (const int*)d_in[2];
    p.w_ada = in[3]; p.b_ada = in[4]; p.norm1_g = in[5]; p.w_in = in[6]; p.pool_w_grp = in[7]; p.pool_scale = in[8]; p.q_norm_g = in[9]; p.k_norm_g = in[10];
    p.w_pool_up = in[11]; p.w_attn_up = in[12]; p.w_out = in[13]; p.norm2_g = in[14]; p.w_router = in[15]; p.router_bias = in[16];
    p.w_sg = in[17]; p.w_su = in[18]; p.w_sd = in[19]; p.w_eg = in[20]; p.w_eu = in[21]; p.w_ed = in[22];
    p.out = (float*)d_out;
    char* ws = (char*)d_ws;
    p.mod = (float*)(ws + WS_MOD); p.cnt = (int*)(ws + WS_CNT); p.asg_e = (int*)(ws + WS_ASG_E); p.asg_pos = (int*)(ws + WS_ASG_POS);
    p.asg_w = (float*)(ws + WS_ASG_W); p.rowlist = (int*)(ws + WS_ROWLIST);
    p.XB = (bf16_t*)(ws + WS_XB); p.U = (bf16_t*)(ws + WS_U); p.QKV = (bf16_t*)(ws + WS_QKV); p.G = (bf16_t*)(ws + WS_G); p.PL = (bf16_t*)(ws + WS_PL);
    p.Y = (bf16_t*)(ws + WS_Y); p.O = (bf16_t*)(ws + WS_O); p.ACT = (bf16_t*)(ws + WS_ACT); p.SLAB = (bf16_t*)(ws + WS_SLAB); p.HS = (bf16_t*)(ws + WS_HS);
    p.LG = (float*)(ws + WS_ACT);
    p.WT_IN = (bf16_t*)(ws + WS_WT_IN); p.WT_EFF = (bf16_t*)(ws + WS_WT_EFF); p.WT_AU = (bf16_t*)(ws + WS_WT_AU); p.WT_OUT = (bf16_t*)(ws + WS_WT_OUT);
    p.WT_RS = (bf16_t*)(ws + WS_WT_RS); p.WT_SD = (bf16_t*)(ws + WS_WT_SD); p.WT_EGU = (bf16_t*)(ws + WS_WT_EGU); p.WT_ED = (bf16_t*)(ws + WS_WT_ED);
    void* args[] = {&p};
    hipError_t e = hipLaunchCooperativeKernel((void*)fwd_all, dim3(grid), dim3(NTHR), args, LDS_BYTES, stream);
    if (e != hipSuccess) fprintf(stderr, "cooperative launch failed: %s (grid %d)\n", hipGetErrorString(e), grid);
}
```

```cpp
#include <hip/hip_runtime.h>
#include <hip/hip_cooperative_groups.h>
#include <stdint.h>
#include <cstdio>
namespace cg = cooperative_groups;

#ifndef ONE_LAUNCH
#define ONE_LAUNCH 0
#endif

typedef unsigned short bf16_t;
#define DEV __device__ __forceinline__
#define LAS __attribute__((address_space(3)))
typedef short bf16x8 __attribute__((ext_vector_type(8)));
typedef float f32x4 __attribute__((ext_vector_type(4)));
typedef unsigned u32x4 __attribute__((ext_vector_type(4)));
typedef unsigned u32x2 __attribute__((ext_vector_type(2)));

#ifndef MF_INPROJ
#define MF_INPROJ 1
#endif
#ifndef MF_MERGE
#define MF_MERGE 1
#endif
#ifndef MF_OUT
#define MF_OUT 1
#endif
#ifndef MF_ROUTER
#define MF_ROUTER 1
#endif
#ifndef MF_EXP1
#define MF_EXP1 1
#endif
#ifndef MF_EXP2
#define MF_EXP2 1
#endif
#ifndef MF_ATTN
#define MF_ATTN 1
#endif
#ifndef MF_FINAL
#define MF_FINAL 1
#endif

constexpr int NB = 16, SEQ = 2048, DM = 1024, T = NB * SEQ;
constexpr int INW = 4864, NMOD = 6144;
constexpr int NE = 256, EFF = 256;
constexpr int NTHR = 512, NWV = 8;
constexpr int NSLOT = T * 8;
constexpr int RMAX = NSLOT + NE * 256;

DEV float bf2f(bf16_t h) { return __uint_as_float(((unsigned)h) << 16); }
DEV bf16_t f2bf(float f) { unsigned u = __float_as_uint(f); u += 0x7fffu + ((u >> 16) & 1u); return (bf16_t)(u >> 16); }
DEV unsigned pk2(float lo, float hi) { return (unsigned)f2bf(lo) | ((unsigned)f2bf(hi) << 16); }
DEV float sigm(float v) { return 1.f / (1.f + __expf(-v)); }
DEV float silu(float v) { return v / (1.f + __expf(-v)); }
DEV int otid() { int t = threadIdx.x; asm volatile("" : "+v"(t)); return t; }
DEV float wave_sum(float v) {
#pragma unroll
    for (int o = 32; o >= 1; o >>= 1) v += __shfl_xor(v, o);
    return v;
}

struct P {
    const float *x, *c; const int* pos;
    const float *w_ada, *b_ada, *norm1_g, *w_in, *pool_w_grp, *pool_scale, *q_norm_g, *k_norm_g, *w_pool_up, *w_attn_up, *w_out, *norm2_g,
        *w_router, *router_bias, *w_sg, *w_su, *w_sd, *w_eg, *w_eu, *w_ed;
    float* out;
    float* mod; int* cnt; int* asg_e; int* asg_pos; float* asg_w; int* rowlist;
    bf16_t *XB, *U, *QKV, *G, *PL, *Y, *O, *ACT, *SLAB, *HS;
    float* LG;
    bf16_t* OG; float* LSUM;
    bf16_t *WT_IN, *WT_EFF, *WT_AU, *WT_OUT, *WT_RS, *WT_SD, *WT_EGU, *WT_ED;
};

constexpr size_t MiB = 1u << 20;
constexpr size_t WS_MOD = 0, WS_CNT = 512 * 1024, WS_ASG_E = 1 * MiB, WS_ASG_POS = 2 * MiB, WS_ASG_W = 3 * MiB, WS_ROWLIST = 4 * MiB;
constexpr size_t WS_XB = 8 * MiB;
constexpr size_t WS_ACT = 72 * MiB;
constexpr size_t WS_SLAB = 232 * MiB;
constexpr size_t WS_U = 232 * MiB, WS_QKV = 264 * MiB, WS_G = 408 * MiB, WS_PL = 536 * MiB, WS_Y = 568 * MiB, WS_O = 600 * MiB;
constexpr size_t WS_WT_IN = 744 * MiB, WS_WT_EFF = 754 * MiB, WS_WT_AU = 755 * MiB, WS_WT_OUT = 756 * MiB, WS_WT_RS = 758 * MiB, WS_WT_SD = 760 * MiB;
constexpr size_t WS_WT_ED = 762 * MiB;
constexpr size_t WS_WT_EGU = 232 * MiB;
constexpr size_t WS_OG = 616 * MiB, WS_LSUM = 664 * MiB;
constexpr size_t WS_HS = 890 * MiB;
constexpr size_t WS_END = 906 * MiB;

DEV void ph_mod(const P& p, float* sm, int bid, int nb) {
    const int tid = otid();
    if (bid == 0 && tid < NE) p.cnt[tid] = 0;
    for (int item = bid; item < NB * 12; item += nb) {
        const int b = item / 12, ch = item % 12;
        __syncthreads();
        for (int d = tid; d < DM; d += NTHR) sm[d] = silu(p.c[b * DM + d]);
        __syncthreads();
        const int e = ch * 512 + tid;
        float acc = 0.f;
#pragma unroll 8
        for (int d = 0; d < DM; ++d) acc += sm[d] * p.w_ada[(size_t)d * NMOD + e];
        p.mod[b * NMOD + e] = acc + p.b_ada[e];
    }
}

DEV void ph_norm(const float* src, const float* g, const float* mod, int shift_off, int scale_off, bf16_t* dst, int bid, int nb) {
    const int tid_ = otid(); const int lane = tid_ & 63, wv = tid_ >> 6;
    for (int row = bid * NWV + wv; row < T; row += nb * NWV) {
        const float4* xr = (const float4*)(src + (size_t)row * DM);
        const int b = row / SEQ;
        float4 v[4]; float ss = 0.f;
#pragma unroll
        for (int j = 0; j < 4; ++j) { v[j] = xr[lane + 64 * j]; ss += v[j].x * v[j].x + v[j].y * v[j].y + v[j].z * v[j].z + v[j].w * v[j].w; }
        ss = wave_sum(ss);
        const float r = rsqrtf(ss * (1.f / DM) + 1e-6f);
#pragma unroll
        for (int j = 0; j < 4; ++j) {
            const int col = (lane + 64 * j) * 4;
            const float4 g4 = *(const float4*)(g + col);
            const float4 sc = *(const float4*)(mod + b * NMOD + scale_off + col);
            const float4 sh = *(const float4*)(mod + b * NMOD + shift_off + col);
            const float o0 = v[j].x * r * g4.x * (1.f + sc.x) + sh.x, o1 = v[j].y * r * g4.y * (1.f + sc.y) + sh.y;
            const float o2 = v[j].z * r * g4.z * (1.f + sc.z) + sh.z, o3 = v[j].w * r * g4.w * (1.f + sc.w) + sh.w;
            uint2 w; w.x = pk2(o0, o1); w.y = pk2(o2, o3);
            *(uint2*)(dst + (size_t)row * DM + col) = w;
        }
    }
}

template <bool DUAL, class RowF, class Epi>
DEV void ngemm_tile(const bf16_t* __restrict__ A, int lda, RowF rowf, const float* __restrict__ B, const float* __restrict__ B2, int ldb,
                    int m0, int n0, int K, Epi epi, float* sm) {
    float* As = sm;
    float* Bs = sm + 16 * 132;
    float* Bs2 = Bs + 16 * 64;
    const int tid = otid(), tm = tid >> 4, tn = tid & 15;
    float acc[4][4], acc2[4][4];
#pragma unroll
    for (int i = 0; i < 4; ++i)
#pragma unroll
        for (int j = 0; j < 4; ++j) { acc[i][j] = 0.f; acc2[i][j] = 0.f; }
    const int ar = tid >> 2, ak = (tid & 3) * 4;
    const int arow = rowf(m0 + ar);
    const bf16_t* ap = A + (size_t)(arow < 0 ? 0 : arow) * lda + ak;
    const int bk = tid >> 5, bn = (tid & 31) * 2;
    for (int k0 = 0; k0 < K; k0 += 16) {
        uint2 av = make_uint2(0u, 0u);
        if (arow >= 0) av = *(const uint2*)(ap + k0);
        const float2 bv = *(const float2*)(B + (size_t)(k0 + bk) * ldb + n0 + bn);
        float2 bv2 = make_float2(0.f, 0.f);
        if (DUAL) bv2 = *(const float2*)(B2 + (size_t)(k0 + bk) * ldb + n0 + bn);
        __syncthreads();
        As[(ak + 0) * 132 + ar] = __uint_as_float(av.x << 16);
        As[(ak + 1) * 132 + ar] = __uint_as_float(av.x & 0xffff0000u);
        As[(ak + 2) * 132 + ar] = __uint_as_float(av.y << 16);
        As[(ak + 3) * 132 + ar] = __uint_as_float(av.y & 0xffff0000u);
        Bs[bk * 64 + bn] = bv.x; Bs[bk * 64 + bn + 1] = bv.y;
        if (DUAL) { Bs2[bk * 64 + bn] = bv2.x; Bs2[bk * 64 + bn + 1] = bv2.y; }
        __syncthreads();
#pragma unroll
        for (int kk = 0; kk < 16; ++kk) {
            const float4 a = *(const float4*)&As[kk * 132 + tm * 4];
            const float4 b = *(const float4*)&Bs[kk * 64 + tn * 4];
            const float aa[4] = {a.x, a.y, a.z, a.w}, bb[4] = {b.x, b.y, b.z, b.w};
#pragma unroll
            for (int i = 0; i < 4; ++i)
#pragma unroll
                for (int j = 0; j < 4; ++j) acc[i][j] += aa[i] * bb[j];
            if (DUAL) {
                const float4 b2 = *(const float4*)&Bs2[kk * 64 + tn * 4];
                const float cc[4] = {b2.x, b2.y, b2.z, b2.w};
#pragma unroll
                for (int i = 0; i < 4; ++i)
#pragma unroll
                    for (int j = 0; j < 4; ++j) acc2[i][j] += aa[i] * cc[j];
            }
        }
    }
#pragma unroll
    for (int i = 0; i < 4; ++i)
#pragma unroll
        for (int j = 0; j < 4; ++j) epi(m0 + tm * 4 + i, n0 + tn * 4 + j, acc[i][j], acc2[i][j]);
}

struct RowId { DEV int operator()(int m) const { return m; } };
struct RowTok { const int* rl; DEV int operator()(int m) const { const int s = rl[m]; return s < 0 ? -1 : (s >> 3); } };

template <bool DUAL, class Epi>
DEV void ngemm_dense(const bf16_t* A, int lda, const float* B, const float* B2, int ldb, int M, int N, int K, Epi epi, float* sm, int bid, int nb) {
    const int tn = N / 64, nt = (M / 128) * tn;
    for (int t = bid; t < nt; t += nb) ngemm_tile<DUAL>(A, lda, RowId(), B, B2, ldb, (t / tn) * 128, (t % tn) * 64, K, epi, sm);
}

struct EpiInProj { bf16_t *U, *QKV, *G;
    DEV void operator()(int r, int c, float v, float) const {
        if (c < 512) U[(size_t)r * 512 + c] = f2bf(v);
        else if (c < 2816) QKV[(size_t)r * 2304 + (c - 512)] = f2bf(v);
        else G[(size_t)r * 2048 + (c - 2816)] = f2bf(sigm(v)); } };
struct EpiPoolGrp { bf16_t* Y; const float* ls; int g;
    DEV void operator()(int r, int c, float v, float) const { Y[(size_t)r * 512 + g * 128 + c] = f2bf(v * ls[g * 128 + c]); } };
struct EpiMergeA { bf16_t* MG; const bf16_t* G;
    DEV void operator()(int r, int c, float v, float) const { MG[(size_t)r * DM + c] = f2bf(bf2f(G[(size_t)r * 2048 + c]) * v); } };
struct EpiMergeB { bf16_t* MG; const bf16_t* G;
    DEV void operator()(int r, int c, float v, float) const { const size_t i = (size_t)r * DM + c; MG[i] = f2bf(bf2f(MG[i]) + bf2f(G[(size_t)r * 2048 + 1024 + c]) * v); } };
struct EpiOutProj { const float* x; float* out; const float* mod;
    DEV void operator()(int r, int c, float v, float) const { const size_t i = (size_t)r * DM + c; out[i] = x[i] + mod[(r / SEQ) * NMOD + 2048 + c] * v; } };
struct EpiLogits { float* LG;
    DEV void operator()(int r, int c, float v, float) const { LG[(size_t)r * NE + c] = v; } };
struct EpiAct { bf16_t* ACT;
    DEV void operator()(int r, int c, float v, float v2) const { ACT[(size_t)r * EFF + c] = f2bf(silu(v) * v2); } };
struct EpiSlab { bf16_t* SLAB; const int* rl; const float* w;
    DEV void operator()(int r, int c, float v, float) const { const int s = rl[r]; if (s >= 0) SLAB[(size_t)s * DM + c] = f2bf(v * w[s]); } };
struct EpiFinal { float* out; const bf16_t* SLAB; const float* mod;
    DEV void operator()(int r, int c, float v, float) const {
        float s = v;
#pragma unroll
        for (int k = 0; k < 8; ++k) s += bf2f(SLAB[((size_t)r * 8 + k) * DM + c]);
        const size_t i = (size_t)r * DM + c; out[i] = out[i] + mod[(r / SEQ) * NMOD + 5120 + c] * s; } };

DEV void ph_qknorm(const P& p, int bid, int nb) {
    const int tid_ = otid(); const int lane = tid_ & 63, wv = tid_ >> 6;
    const float gq = p.q_norm_g[lane], gk = p.k_norm_g[lane];
    const float invf = exp2f(-(float)(lane & 7) * (1.f / 8.f) * log2f(500000.f));
    for (int it = bid * NWV + wv; it < T * 24; it += nb * NWV) {
        const int t = it / 24, hh = it % 24;
        bf16_t* ptr = p.QKV + (size_t)t * 2304 + hh * 64 + lane;
        const float v = bf2f(*ptr);
        const float ss = wave_sum(v * v);
        float nv = v * rsqrtf(ss * (1.f / 64.f) + 1e-6f) * (hh < 12 ? gq : gk);
        const float partner = __shfl_xor(nv, 8);
        const float ang = (float)p.pos[t] * invf;
        const float cs = cosf(ang), sn = sinf(ang);
        if (lane < 8) nv = nv * cs - partner * sn;
        else if (lane < 16) nv = nv * cs + partner * sn;
        *ptr = f2bf(nv);
    }
}

DEV void ph_pool(const P& p, int bid, int nb) {
    const int tid_ = otid();
    for (size_t i = (size_t)bid * NTHR + tid_; i < (size_t)T * 512; i += (size_t)nb * NTHR) {
        const int t = (int)(i >> 9), c = (int)(i & 511);
        const int g = c >> 7, r = 1 << g;
        const int s = t & (SEQ - 1), base = t - s;
        const int lo = max(s - r, 0), hi = min(s + r, SEQ - 1);
        float sum = 0.f;
        for (int q = lo; q <= hi; ++q) sum += bf2f(p.U[(size_t)(base + q) * 512 + c]);
        p.PL[i] = f2bf(sum / (float)(hi - lo + 1) - bf2f(p.U[i]));
    }
}

DEV void ph_attn(const P& p, int bid, int nb) {
    const int tid_ = otid(); const int lane = tid_ & 63, wv = tid_ >> 6;
    for (int it = bid * NWV + wv; it < T * 4; it += nb * NWV) {
        const int t = it >> 2, slot = it & 3;
        const int s = t & (SEQ - 1), base = t - s;
        float M = -1e30f, l = 0.f, acc = 0.f;
#pragma unroll
        for (int g = 0; g < 3; ++g) {
            const int dsh = 2 * g, d = 1 << dsh, L = SEQ >> dsh;
            const int h = 4 * g + slot;
            const int m = s >> dsh, r = s & (d - 1);
            const float q = bf2f(p.QKV[(size_t)t * 2304 + h * 64 + lane]);
            const bf16_t* kb = p.QKV + 768 + h * 64 + lane;
            const bf16_t* vb = p.QKV + 1536 + h * 64 + lane;
#pragma unroll 4
            for (int rel = -64; rel <= 64; ++rel) {
                const int mm = m + rel;
                const bool valid = (mm >= 0) && (mm < L);
                const int mc = valid ? mm : m;
                const size_t tr = (size_t)(base + mc * d + r) * 2304;
                const float kv = bf2f(kb[tr]), vv = bf2f(vb[tr]);
                const float sc = wave_sum(q * kv) * 0.125f;
                if (valid) {
                    const float mn = fmaxf(M, sc);
                    const float f = __expf(M - mn), pe = __expf(sc - mn);
                    l = l * f + pe; acc = acc * f + pe * vv; M = mn;
                }
            }
        }
        p.O[(size_t)t * 256 + slot * 64 + lane] = f2bf(acc / l);
    }
}

DEV void ph_route(const P& p, int bid, int nb) {
    const int tid_ = otid(); const int lane = tid_ & 63, wv = tid_ >> 6;
    const float4 bias4 = *(const float4*)(p.router_bias + 4 * lane);
    for (int t = bid * NWV + wv; t < T; t += nb * NWV) {
        const float4 lg = *(const float4*)(p.LG + (size_t)t * NE + 4 * lane);
        const float s0 = 1.f / (1.f + expf(-lg.x)), s1 = 1.f / (1.f + expf(-lg.y)), s2 = 1.f / (1.f + expf(-lg.z)), s3 = 1.f / (1.f + expf(-lg.w));
        float v0 = s0 + bias4.x, v1 = s1 + bias4.y, v2 = s2 + bias4.z, v3 = s3 + bias4.w;
        float m1 = fmaxf(v0, v1), m2 = fminf(v0, v1);
        { const float n1 = fmaxf(m1, v2), n2 = fmaxf(fminf(m1, v2), m2); m1 = n1; m2 = n2; }
        { const float n1 = fmaxf(m1, v3), n2 = fmaxf(fminf(m1, v3), m2); m1 = n1; m2 = n2; }
#pragma unroll
        for (int o = 1; o <= 4; o <<= 1) {
            const float b1 = __shfl_xor(m1, o), b2 = __shfl_xor(m2, o);
            const float n1 = fmaxf(m1, b1), n2 = fmaxf(fminf(m1, b1), fmaxf(m2, b2)); m1 = n1; m2 = n2;
        }
        const float gs = m1 + m2; const int G = lane >> 3;
        int rank = 0;
#pragma unroll
        for (int g2 = 0; g2 < 8; ++g2) { const float o = __shfl(gs, g2 * 8); rank += ((o > gs) || (o == gs && g2 < G)) ? 1 : 0; }
        if (rank >= 4) { v0 = -INFINITY; v1 = -INFINITY; v2 = -INFINITY; v3 = -INFINITY; }
        int myidx = 0; float myw = 0.f, wsum = 0.f;
#pragma unroll
        for (int k = 0; k < 8; ++k) {
            float bv = v0; int bi = 0;
            if (v1 > bv) { bv = v1; bi = 1; }
            if (v2 > bv) { bv = v2; bi = 2; }
            if (v3 > bv) { bv = v3; bi = 3; }
            float bs = bi == 0 ? s0 : (bi == 1 ? s1 : (bi == 2 ? s2 : s3));
            int gi = lane * 4 + bi;
#pragma unroll
            for (int o = 1; o < 64; o <<= 1) {
                const float ov = __shfl_xor(bv, o), os = __shfl_xor(bs, o); const int oi = __shfl_xor(gi, o);
                if ((ov > bv) || (ov == bv && oi < gi)) { bv = ov; gi = oi; bs = os; }
            }
            if (gi == lane * 4 + 0) v0 = -INFINITY;
            if (gi == lane * 4 + 1) v1 = -INFINITY;
            if (gi == lane * 4 + 2) v2 = -INFINITY;
            if (gi == lane * 4 + 3) v3 = -INFINITY;
            if (lane == k) { myidx = gi; myw = bs; }
            wsum += bs;
        }
        if (lane < 8) {
            const int slot = t * 8 + lane;
            const int pos = atomicAdd(&p.cnt[myidx], 1);
            p.asg_e[slot] = myidx; p.asg_pos[slot] = pos; p.asg_w[slot] = myw / wsum * 2.5f;
        }
    }
}

DEV void load_offsets(const int* cnt, int* off) {
    const int tid = otid();
    __syncthreads();
    if (tid < NE) off[300 + tid] = (cnt[tid] + 255) & ~255;
    __syncthreads();
    if (tid == 0) { int a = 0; for (int e = 0; e < NE; ++e) { off[e] = a; a += off[300 + e]; } off[NE] = a; }
    __syncthreads();
}
DEV int find_expert(const int* off, int m0) {
    int lo = 0, hi = NE;
    while (hi - lo > 1) { const int mid = (lo + hi) >> 1; if (off[mid] <= m0) lo = mid; else hi = mid; }
    return lo;
}

DEV void ph_scatter(const P& p, int* off, int bid, int nb) {
    load_offsets(p.cnt, off);
    const int tid_ = otid();
    for (int slot = bid * NTHR + tid_; slot < NSLOT; slot += nb * NTHR) p.rowlist[off[p.asg_e[slot]] + p.asg_pos[slot]] = slot;
    for (int e = bid; e < NE; e += nb) {
        const int n = p.cnt[e], pd = (n + 255) & ~255;
        for (int i = n + tid_; i < pd; i += NTHR) p.rowlist[off[e] + i] = -1;
    }
}

DEV void ph_expert1(const P& p, float* sm, int* off, int bid, int nb) {
    load_offsets(p.cnt, off);
    const int nrt = off[NE] / 128, nt = nrt * 4;
    for (int t = bid; t < nt; t += nb) {
        const int m0 = (t >> 2) * 128, n0 = (t & 3) * 64, e = find_expert(off, m0);
        ngemm_tile<true>(p.XB, DM, RowTok{p.rowlist}, p.w_eg + (size_t)e * DM * EFF, p.w_eu + (size_t)e * DM * EFF, EFF, m0, n0, DM, EpiAct{p.ACT}, sm);
    }
}
DEV void ph_expert2(const P& p, float* sm, int* off, int bid, int nb) {
    load_offsets(p.cnt, off);
    const int nrt = off[NE] / 128, nt = nrt * 16;
    for (int t = bid; t < nt; t += nb) {
        const int m0 = (t >> 4) * 128, n0 = (t & 15) * 64, e = find_expert(off, m0);
        ngemm_tile<false>(p.ACT, EFF, RowId(), p.w_ed + (size_t)e * EFF * DM, nullptr, DM, m0, n0, EFF, EpiSlab{p.SLAB, p.rowlist, p.asg_w}, sm);
    }
}

namespace mg {
constexpr int BM = 256, BK = 64, HALF = 128, HTB = HALF * BK * 2, STAGE_BYTES = 8 * HTB, NXCD = 8, WGM = 8;
__host__ __device__ __forceinline__ int lds_byte(int r, int c) { const int st = (r >> 4) * 2 + (c >> 5), rr = r & 15, cc = c & 31, ob = rr * 64 + cc * 2; return st * 1024 + (ob ^ (((ob >> 9) & 1) << 5)); }
__host__ __device__ __forceinline__ void stage_rc(int b, int& R, int& C) { const int st = b / 1024, sb = b % 1024, swz = sb ^ (((sb >> 9) & 1) << 5); R = (st >> 1) * 16 + swz / 64; C = (st & 1) * 32 + (swz % 64) / 2; }
__host__ __device__ __forceinline__ int perm32(int rho) { const int n = rho >> 4, i = rho & 15; return 8 * (i >> 2) + 4 * n + (i & 3); }

struct Unit { int pm, pn, e, pad; const char* A; const char* B; };

struct DenseOrder {
    int nM, nN, nwg, G, c; const char* A; const char* B; size_t tstep;
    DEV void init(const bf16_t* A_, const bf16_t* B_, int M, int N, int K, int G_, int c_) { nM = M / BM; nN = N / BM; nwg = nM * nN; G = G_; c = c_; A = (const char*)A_; B = (const char*)B_; tstep = (size_t)BM * K * 2; }
    DEV bool next(int i, Unit& u) const {
        const long L = (long)i * G + c; if (L >= nwg) return false;
        int wgid = (int)L; { const int q = nwg / NXCD, r = nwg % NXCD, xcd = wgid % NXCD, off = wgid / NXCD; wgid = (xcd < r ? xcd * (q + 1) : r * (q + 1) + (xcd - r) * q) + off; }
        const int nig = WGM * nN, gid = wgid / nig, fm = gid * WGM, gsz = (nM - fm) < WGM ? (nM - fm) : WGM;
        u.pm = fm + ((wgid % nig) % gsz); u.pn = (wgid % nig) / gsz; u.e = 0; u.pad = 0;
        u.A = A + (size_t)u.pm * tstep; u.B = B + (size_t)u.pn * tstep; return true;
    }
};
struct ExpertOrder {
    const LAS int* off; int nrt, ncol, G, c; const char* A; const char* W; size_t wstride, tstepB, tstepA; bool gather;
    DEV bool next(int i, Unit& u) const {
        const int L = i * G + c; if (L >= nrt * ncol) return false;
        u.pm = L / ncol; u.pn = L % ncol; u.pad = 0;
        int lo = 0, hi = NE; const int m0 = u.pm * BM;
        while (hi - lo > 1) { const int mid = (lo + hi) >> 1; const int ov = __builtin_amdgcn_readfirstlane(off[mid]); if (ov <= m0) lo = mid; else hi = mid; }
        u.e = lo;
        u.A = gather ? A : A + (size_t)u.pm * tstepA; u.B = W + (size_t)lo * wstride + (size_t)u.pn * tstepB; return true;
    }
};

template <class Epi, class Sched, bool GATHER>
DEV void gemm_phase(LAS unsigned char* lds, const LAS unsigned* gtab, const int K, const Sched& S, const Epi& E) {
    const int tid = otid(), wid = __builtin_amdgcn_readfirstlane(tid >> 6), lane = tid & 63, wr = wid >> 2, wc = wid & 3, fr = lane & 15, fq = lane >> 4;
    const int nt = K / BK;
    int Rr[2], Cc[2]; unsigned voffB[2];
#pragma unroll
    for (int i = 0; i < 2; ++i) { stage_rc(tid * 16 + i * 8192, Rr[i], Cc[i]); const int Rb = Epi::PERM ? ((Rr[i] & ~31) + perm32(Rr[i] & 31)) : Rr[i]; voffB[i] = (unsigned)(Rb * K + Cc[i]) * 2u; }
    const size_t kstep = (size_t)(BK * 2);
    const size_t hstep = (size_t)HALF * K * 2;
    const unsigned ldsw = (unsigned)wid * 1024u;
    const int aoff = lds_byte(wr * 64 + fr, fq * 8), boff = lds_byte(wc * 32 + fr, fq * 8);
#define MG_SA(b, h) (((b) * 2 + (h)) * HTB)
#define MG_SB(b, h) ((4 + (b) * 2 + (h)) * HTB)
#define MG_STAGE(bufoff, gbase, voff) do { _Pragma("unroll") for (int _i = 0; _i < 2; ++_i) \
        __builtin_amdgcn_global_load_lds((const unsigned*)((const char*)(gbase) + (voff)[_i]), (LAS unsigned*)(lds + (bufoff) + ldsw + _i * 8192), 16, 0, 0); } while (0)
#define MG_LDA(dst, b, h) do { _Pragma("unroll") for (int m = 0; m < 4; ++m) _Pragma("unroll") for (int k = 0; k < 2; ++k) dst[m][k] = *(const LAS bf16x8*)(lds + MG_SA(b, h) + aoff + m * 2048 + k * 1024); } while (0)
#define MG_LDB(dst, b, h) do { _Pragma("unroll") for (int n = 0; n < 2; ++n) _Pragma("unroll") for (int k = 0; k < 2; ++k) dst[n][k] = *(const LAS bf16x8*)(lds + MG_SB(b, h) + boff + n * 2048 + k * 1024); } while (0)
#define MG_MMA(ai, bj, At, Bt) do { __builtin_amdgcn_s_setprio(1); _Pragma("unroll") for (int m = 0; m < 4; ++m) _Pragma("unroll") for (int n = 0; n < 2; ++n) _Pragma("unroll") for (int k = 0; k < 2; ++k) \
        acc[ai][bj][m][n] = __builtin_amdgcn_mfma_f32_16x16x32_bf16(Bt[n][k], At[m][k], acc[ai][bj][m][n], 0, 0, 0); __builtin_amdgcn_s_setprio(0); } while (0)
#define MG_WAIT_V(n) asm volatile("s_waitcnt vmcnt(" #n ")" ::: "memory")
#define MG_WAIT_L(n) asm volatile("s_waitcnt lgkmcnt(" #n ")" ::: "memory")
#define MG_BAR __builtin_amdgcn_s_barrier()
#define MG_SCHED __builtin_amdgcn_sched_barrier(0)
    Unit cur, nxt; int ui = 0;
    if (!S.next(0, cur)) return;
    f32x4 acc[2][2][4][2];
#pragma unroll
    for (int a = 0; a < 2; ++a)
#pragma unroll
        for (int b = 0; b < 2; ++b)
#pragma unroll
            for (int m = 0; m < 4; ++m)
#pragma unroll
                for (int n = 0; n < 2; ++n) acc[a][b][m][n] = (f32x4){0.f, 0.f, 0.f, 0.f};
    bf16x8 At[4][2], B0[2][2], B1[2][2];
    unsigned va0[2], va1[2], na0[2], na1[2];
#pragma unroll
    for (int i = 0; i < 2; ++i) {
        if (GATHER) { va0[i] = gtab[Rr[i]] + (unsigned)Cc[i] * 2u; va1[i] = gtab[HALF + Rr[i]] + (unsigned)Cc[i] * 2u; }
        else { va0[i] = (unsigned)(Rr[i] * K + Cc[i]) * 2u; va1[i] = va0[i] + (unsigned)hstep; }
        na0[i] = va0[i]; na1[i] = va1[i];
    }
    const char* cA = cur.A; const char* cB = cur.B;
    MG_STAGE(MG_SB(0, 0), cB, voffB); MG_STAGE(MG_SB(0, 1), cB + hstep, voffB); MG_STAGE(MG_SA(0, 0), cA, va0); MG_STAGE(MG_SA(0, 1), cA, va1);
    if (wr == 1) MG_BAR;
    MG_WAIT_V(2); MG_BAR;
    MG_STAGE(MG_SB(1, 0), cB + kstep, voffB); MG_STAGE(MG_SA(1, 0), cA + kstep, va0); MG_STAGE(MG_SB(1, 1), cB + hstep + kstep, voffB);
    MG_WAIT_V(6); MG_BAR;
    for (;;) {
        const bool has_next = S.next(ui + 1, nxt);
        const char* nA = has_next ? nxt.A : cA; const char* nB = has_next ? nxt.B : cB;
        if (GATHER) {
            if (has_next) {
#pragma unroll
                for (int i = 0; i < 2; ++i) { na0[i] = gtab[(ui + 1) * BM + Rr[i]] + (unsigned)Cc[i] * 2u; na1[i] = gtab[(ui + 1) * BM + HALF + Rr[i]] + (unsigned)Cc[i] * 2u; }
            }
        }
#pragma unroll 1
        for (int t = 0; t < nt; t += 2) {
            const bool last = (t == nt - 2);
            const char* a1 = cA + (size_t)(t + 1) * kstep;
            const char* a2 = last ? nA : cA + (size_t)(t + 2) * kstep; const char* b2 = last ? nB : cB + (size_t)(t + 2) * kstep;
            const char* a3 = a2 + kstep; const char* b3 = b2 + kstep;
            unsigned o0[2], o1[2];
#pragma unroll
            for (int i = 0; i < 2; ++i) { o0[i] = (GATHER && last) ? na0[i] : va0[i]; o1[i] = (GATHER && last) ? na1[i] : va1[i]; }
            MG_LDB(B0, 0, 0); MG_LDB(B1, 0, 1); MG_SCHED; MG_LDA(At, 0, 0); MG_STAGE(MG_SA(1, 1), a1, va1);
            MG_WAIT_V(8); MG_WAIT_L(0); MG_BAR; MG_MMA(0, 0, At, B0); MG_MMA(0, 1, At, B1); MG_BAR; MG_SCHED;
            MG_LDA(At, 0, 1); MG_STAGE(MG_SB(0, 0), b2, voffB); MG_STAGE(MG_SB(0, 1), b2 + hstep, voffB); MG_STAGE(MG_SA(0, 0), a2, o0);
            MG_WAIT_V(8); MG_WAIT_L(0); MG_BAR; MG_MMA(1, 0, At, B0); MG_MMA(1, 1, At, B1); MG_BAR; MG_SCHED;
            MG_LDB(B0, 1, 0); MG_LDB(B1, 1, 1); MG_SCHED; MG_LDA(At, 1, 0); MG_STAGE(MG_SA(0, 1), a2, o1);
            MG_WAIT_V(8); MG_WAIT_L(0); MG_BAR; MG_MMA(0, 0, At, B0); MG_MMA(0, 1, At, B1); MG_BAR; MG_SCHED;
            MG_LDA(At, 1, 1); MG_STAGE(MG_SB(1, 0), b3, voffB); MG_STAGE(MG_SB(1, 1), b3 + hstep, voffB); MG_STAGE(MG_SA(1, 0), a3, o0);
            MG_WAIT_V(8); MG_WAIT_L(0); MG_BAR; MG_MMA(1, 0, At, B0); MG_MMA(1, 1, At, B1); MG_BAR; MG_SCHED;
        }
        if (wr == 0) MG_BAR;
        E(acc, cur, wr, wc, fr, fq);
        if (!has_next) break;
#pragma unroll
        for (int a = 0; a < 2; ++a)
#pragma unroll
            for (int b = 0; b < 2; ++b)
#pragma unroll
                for (int m = 0; m < 4; ++m)
#pragma unroll
                    for (int n = 0; n < 2; ++n) acc[a][b][m][n] = (f32x4){0.f, 0.f, 0.f, 0.f};
        cur = nxt; cA = nA; cB = nB; ++ui;
#pragma unroll
        for (int i = 0; i < 2; ++i) { va0[i] = na0[i]; va1[i] = na1[i]; }
        if (wr == 1) MG_BAR;
    }
    MG_WAIT_V(0);
    MG_BAR;
    __syncthreads();
#undef MG_SA
#undef MG_SB
#undef MG_STAGE
#undef MG_LDA
#undef MG_LDB
#undef MG_MMA
#undef MG_WAIT_V
#undef MG_WAIT_L
#undef MG_BAR
#undef MG_SCHED
}

DEV u32x4 pack8(const f32x4 a, const f32x4 b) { u32x4 w; w.x = pk2(a[0], a[1]); w.y = pk2(a[2], a[3]); w.z = pk2(b[0], b[1]); w.w = pk2(b[2], b[3]); return w; }
DEV f32x4 unpack_lo(const u32x4 w) { return (f32x4){__uint_as_float(w.x << 16), __uint_as_float(w.x & 0xffff0000u), __uint_as_float(w.y << 16), __uint_as_float(w.y & 0xffff0000u)}; }
DEV f32x4 unpack_hi(const u32x4 w) { return (f32x4){__uint_as_float(w.z << 16), __uint_as_float(w.z & 0xffff0000u), __uint_as_float(w.w << 16), __uint_as_float(w.w & 0xffff0000u)}; }
DEV f32x4 sig4(const f32x4 v) { return (f32x4){sigm(v[0]), sigm(v[1]), sigm(v[2]), sigm(v[3])}; }
DEV f32x4 silu4(const f32x4 v) { return (f32x4){silu(v[0]), silu(v[1]), silu(v[2]), silu(v[3])}; }
#define ACC_T const f32x4 (&acc)[2][2][4][2]

struct MEpiInProj { static constexpr bool PERM = true; bf16_t *U, *QKV, *G;
    DEV void operator()(ACC_T, const Unit& u, int wr, int wc, int fr, int fq) const {
        int colt = u.pn * BM; bf16_t* base; int ld; bool sg = false;
        if (colt < 512) { base = U; ld = 512; } else if (colt < 2816) { base = QKV; ld = 2304; colt -= 512; } else { base = G; ld = 2048; colt -= 2816; sg = true; }
        const int row0 = u.pm * BM + wr * 64 + fr, col0 = colt + wc * 32 + 8 * fq;
#pragma unroll
        for (int ai = 0; ai < 2; ++ai)
#pragma unroll
            for (int m = 0; m < 4; ++m) { bf16_t* rowp = base + (size_t)(row0 + ai * HALF + m * 16) * ld + col0;
#pragma unroll
                for (int bj = 0; bj < 2; ++bj) { f32x4 v0 = acc[ai][bj][m][0], v1 = acc[ai][bj][m][1]; if (sg) { v0 = sig4(v0); v1 = sig4(v1); }
                    *(u32x4*)(rowp + bj * HALF) = pack8(v0, v1); }
                asm volatile("" ::: "memory"); }
    } };
template <bool SECOND> struct MEpiMerge { static constexpr bool PERM = true; bf16_t* MG; const bf16_t* G;
    DEV void operator()(ACC_T, const Unit& u, int wr, int wc, int fr, int fq) const {
        const int row0 = u.pm * BM + wr * 64 + fr, col0 = u.pn * BM + wc * 32 + 8 * fq;
#pragma unroll
        for (int ai = 0; ai < 2; ++ai)
#pragma unroll
            for (int m = 0; m < 4; ++m) { const size_t r = (size_t)(row0 + ai * HALF + m * 16);
#pragma unroll
                for (int bj = 0; bj < 2; ++bj) { const int c = col0 + bj * HALF;
                    const u32x4 gw = *(const u32x4*)(G + r * 2048 + (SECOND ? 1024 : 0) + c);
                    f32x4 v0 = acc[ai][bj][m][0] * unpack_lo(gw), v1 = acc[ai][bj][m][1] * unpack_hi(gw);
                    if (SECOND) { const u32x4 pw = *(const u32x4*)(MG + r * DM + c); v0 += unpack_lo(pw); v1 += unpack_hi(pw); }
                    *(u32x4*)(MG + r * DM + c) = pack8(v0, v1); }
                asm volatile("" ::: "memory"); }
    } };
struct MEpiOutProj { static constexpr bool PERM = false; const float* x; float* out; const float* mod;
    DEV void operator()(ACC_T, const Unit& u, int wr, int wc, int fr, int fq) const {
        const int row0 = u.pm * BM + wr * 64 + fr, col0 = u.pn * BM + wc * 32 + 4 * fq;
        const float* gm = mod + ((u.pm * BM) / SEQ) * NMOD + 2048;
#pragma unroll
        for (int ai = 0; ai < 2; ++ai)
#pragma unroll
            for (int m = 0; m < 4; ++m) { const size_t r = (size_t)(row0 + ai * HALF + m * 16) * DM;
#pragma unroll
                for (int bj = 0; bj < 2; ++bj)
#pragma unroll
                    for (int n = 0; n < 2; ++n) { const int c = col0 + bj * HALF + n * 16;
                        *(f32x4*)(out + r + c) = *(const f32x4*)(x + r + c) + *(const f32x4*)(gm + c) * acc[ai][bj][m][n]; }
                asm volatile("" ::: "memory"); }
    } };
struct MEpiRouterShared { static constexpr bool PERM = true; float* LG; bf16_t* HS;
    DEV void operator()(ACC_T, const Unit& u, int wr, int wc, int fr, int fq) const {
        const int row0 = u.pm * BM + wr * 64 + fr, cw = wc * 32 + 8 * fq;
#pragma unroll
        for (int ai = 0; ai < 2; ++ai)
#pragma unroll
            for (int m = 0; m < 4; ++m) { const size_t r = (size_t)(row0 + ai * HALF + m * 16);
                if (u.pn == 0) {
#pragma unroll
                    for (int bj = 0; bj < 2; ++bj)
#pragma unroll
                        for (int n = 0; n < 2; ++n) *(f32x4*)(LG + r * NE + bj * HALF + cw + 4 * n) = acc[ai][bj][m][n];
                } else {
                    const f32x4 v0 = silu4(acc[ai][0][m][0]) * acc[ai][1][m][0], v1 = silu4(acc[ai][0][m][1]) * acc[ai][1][m][1];
                    *(u32x4*)(HS + r * EFF + (u.pn - 1) * HALF + cw) = pack8(v0, v1);
                }
                asm volatile("" ::: "memory"); }
    } };
struct MEpiAct { static constexpr bool PERM = true; bf16_t* ACT;
    DEV void operator()(ACC_T, const Unit& u, int wr, int wc, int fr, int fq) const {
        const int row0 = u.pm * BM + wr * 64 + fr, cw = u.pn * HALF + wc * 32 + 8 * fq;
#pragma unroll
        for (int ai = 0; ai < 2; ++ai)
#pragma unroll
            for (int m = 0; m < 4; ++m) { const size_t r = (size_t)(row0 + ai * HALF + m * 16);
                const f32x4 v0 = silu4(acc[ai][0][m][0]) * acc[ai][1][m][0], v1 = silu4(acc[ai][0][m][1]) * acc[ai][1][m][1];
                *(u32x4*)(ACT + r * EFF + cw) = pack8(v0, v1); asm volatile("" ::: "memory"); }
    } };
struct MEpiSlab { static constexpr bool PERM = true; bf16_t* SLAB; const int* rl; const float* w;
    DEV void operator()(ACC_T, const Unit& u, int wr, int wc, int fr, int fq) const {
        const int row0 = u.pm * BM + wr * 64 + fr, col0 = u.pn * BM + wc * 32 + 8 * fq;
#pragma unroll
        for (int ai = 0; ai < 2; ++ai)
#pragma unroll
            for (int m = 0; m < 4; ++m) { const int s = rl[row0 + ai * HALF + m * 16];
                if (s >= 0) { const float g = w[s];
#pragma unroll
                    for (int bj = 0; bj < 2; ++bj) *(u32x4*)(SLAB + (size_t)s * DM + col0 + bj * HALF) = pack8(acc[ai][bj][m][0] * g, acc[ai][bj][m][1] * g); }
                asm volatile("" ::: "memory"); }
    } };
struct MEpiFinal { static constexpr bool PERM = false; float* out; const bf16_t* SLAB; const float* mod;
    DEV void operator()(ACC_T, const Unit& u, int wr, int wc, int fr, int fq) const {
        const int row0 = u.pm * BM + wr * 64 + fr, col0 = u.pn * BM + wc * 32 + 4 * fq;
        const float* gm = mod + ((u.pm * BM) / SEQ) * NMOD + 5120;
#pragma unroll
        for (int ai = 0; ai < 2; ++ai)
#pragma unroll
            for (int m = 0; m < 4; ++m) { const size_t row = (size_t)(row0 + ai * HALF + m * 16);
#pragma unroll
                for (int bj = 0; bj < 2; ++bj)
#pragma unroll
                    for (int n = 0; n < 2; ++n) { const int c = col0 + bj * HALF + n * 16; f32x4 sacc = acc[ai][bj][m][n];
#pragma unroll
                        for (int k = 0; k < 8; ++k) { const u32x2 sw = *(const u32x2*)(SLAB + (row * 8 + k) * DM + c);
                            sacc += (f32x4){__uint_as_float(sw.x << 16), __uint_as_float(sw.x & 0xffff0000u), __uint_as_float(sw.y << 16), __uint_as_float(sw.y & 0xffff0000u)}; }
                        float* op = out + row * DM + c; *(f32x4*)op = *(const f32x4*)op + *(const f32x4*)(gm + c) * sacc; asm volatile("" ::: "memory"); } }
    } };
#undef ACC_T
}

typedef float f32x16 __attribute__((ext_vector_type(16)));
typedef short s16x4 __attribute__((ext_vector_type(4)));
DEV int crow(int r, int hi) { return (r & 3) + 8 * (r >> 2) + 4 * hi; }
DEV unsigned cvtpk(float lo, float hi) { unsigned r; asm("v_cvt_pk_bf16_f32 %0, %1, %2" : "=v"(r) : "v"(lo), "v"(hi)); return r; }
DEV s16x4 vtr(const LAS unsigned char* p) { return __builtin_bit_cast(s16x4, __builtin_amdgcn_ds_read_tr16_b64_v4i16((LAS s16x4*)p)); }
DEV float swap32(float v) { return __shfl_xor(v, 32); }

DEV void ph_attn_mfma(const P& p, LAS unsigned char* lds, int bid, int nb) {
    const int tid = otid(); const int lane = tid & 63, wid = __builtin_amdgcn_readfirstlane(tid >> 6), r32 = lane & 31, hi = lane >> 5;
    LAS unsigned char* vl = lds + wid * 8192;
    LAS float* wsf = (LAS float*)(lds + wid * 8192 + 4096);
    float gq = fabsf(p.q_norm_g[lane]), gk = fabsf(p.k_norm_g[lane]);
#pragma unroll
    for (int o = 32; o >= 1; o >>= 1) { gq = fmaxf(gq, __shfl_xor(gq, o)); gk = fmaxf(gk, __shfl_xor(gk, o)); }
    constexpr float LOG2E = 1.4426950408889634f, C2 = 0.125f * LOG2E;
    const float nmref = -(8.f * gq * gk * LOG2E);
    const int head = wid >> 1, qh = wid & 1;
    const int tq = (lane & 15) >> 2, tp = lane & 3, tcb = (lane >> 4) & 1;
    const LAS unsigned char* vrd = vl + (4 * hi + tq) * 128 + (16 * tcb + 4 * tp) * 2;
    for (int it = bid; it < NB * 96; it += nb) {
        const int cb = it & 31, g = (it >> 5) % 3, b = it / 96;
        const int dsh = 2 * g, d = 1 << dsh, L = SEQ >> dsh, nbk = L >> 6;
        const int r = cb / nbk, blk = cb % nbk;
        const int h = 4 * g + head, base = b * SEQ;
        const int q0 = 64 * blk + 32 * qh;
        const int mq = q0 + r32;
        const bf16_t* qp = p.QKV + (size_t)(base + mq * d + r) * 2304 + h * 64 + hi * 8;
        bf16x8 qr[4];
#pragma unroll
        for (int d0 = 0; d0 < 4; ++d0) qr[d0] = *(const bf16x8*)(qp + d0 * 16);
        f32x16 o0, o1;
#pragma unroll
        for (int i = 0; i < 16; ++i) { o0[i] = 0.f; o1[i] = 0.f; }
        float lsum = 0.f;
        const int kb0 = q0 - 64;
#pragma unroll 1
        for (int st = 0; st < 5; ++st) {
            const int k0 = kb0 + 32 * st;
            if (k0 + 31 < 0 || k0 >= L) continue;
            const int mkc = min(max(k0 + r32, 0), L - 1);
            const bf16_t* kp = p.QKV + (size_t)(base + mkc * d + r) * 2304 + 768 + h * 64 + hi * 8;
            bf16x8 kf[4];
#pragma unroll
            for (int d0 = 0; d0 < 4; ++d0) kf[d0] = *(const bf16x8*)(kp + d0 * 16);
            u32x4 vreg[4];
#pragma unroll
            for (int i = 0; i < 4; ++i) { const int c = lane + 64 * i, row = c >> 3, ch = c & 7; const int mv = min(max(k0 + row, 0), L - 1);
                vreg[i] = *(const u32x4*)(p.QKV + (size_t)(base + mv * d + r) * 2304 + 1536 + h * 64 + ch * 8); }
            f32x16 s;
#pragma unroll
            for (int i = 0; i < 16; ++i) s[i] = 0.f;
#pragma unroll
            for (int d0 = 0; d0 < 4; ++d0) s = __builtin_amdgcn_mfma_f32_32x32x16_bf16(kf[d0], qr[d0], s, 0, 0, 0);
#pragma unroll
            for (int i = 0; i < 16; ++i) { const int key = k0 + crow(i, hi); const int df = key - mq;
                const bool valid = (key >= 0) && (key < L) && (df <= 64) && (df >= -64);
                const float pv = valid ? __builtin_amdgcn_exp2f(__builtin_fmaf(s[i], C2, nmref)) : 0.f; lsum += pv; s[i] = pv; }
            bf16x8 pf0, pf1;
            { u32x4 w0, w1; w0.x = cvtpk(s[0], s[1]); w0.y = cvtpk(s[2], s[3]); w0.z = cvtpk(s[4], s[5]); w0.w = cvtpk(s[6], s[7]);
              w1.x = cvtpk(s[8], s[9]); w1.y = cvtpk(s[10], s[11]); w1.z = cvtpk(s[12], s[13]); w1.w = cvtpk(s[14], s[15]);
              pf0 = __builtin_bit_cast(bf16x8, w0); pf1 = __builtin_bit_cast(bf16x8, w1); }
#pragma unroll
            for (int i = 0; i < 4; ++i) { const int c = lane + 64 * i, row = c >> 3, ch = c & 7; *(LAS u32x4*)(vl + row * 128 + ch * 16) = vreg[i]; }
            asm volatile("s_waitcnt lgkmcnt(0)" ::: "memory");
#pragma unroll
            for (int n = 0; n < 2; ++n)
#pragma unroll
                for (int ks = 0; ks < 2; ++ks) {
                    const s16x4 lo = vtr(vrd + (16 * ks) * 128 + 64 * n), hi4 = vtr(vrd + (16 * ks + 8) * 128 + 64 * n);
                    bf16x8 vf; vf[0] = lo[0]; vf[1] = lo[1]; vf[2] = lo[2]; vf[3] = lo[3]; vf[4] = hi4[0]; vf[5] = hi4[1]; vf[6] = hi4[2]; vf[7] = hi4[3];
                    if (n == 0) o0 = __builtin_amdgcn_mfma_f32_32x32x16_bf16(ks == 0 ? pf0 : pf1, vf, o0, 0, 0, 0);
                    else o1 = __builtin_amdgcn_mfma_f32_32x32x16_bf16(ks == 0 ? pf0 : pf1, vf, o1, 0, 0, 0);
                }
            asm volatile("s_waitcnt lgkmcnt(0)" ::: "memory");
        }
        const float lt = lsum + swap32(lsum);
        if (hi == 0) { wsf[r32] = 1.f / lt; p.LSUM[((size_t)g * T + (base + mq * d + r)) * 4 + head] = lt; }
        asm volatile("s_waitcnt lgkmcnt(0)" ::: "memory");
        bf16_t* og = p.OG + (size_t)g * T * 256 + head * 64 + r32;
#pragma unroll
        for (int i = 0; i < 16; ++i) { const int qq = crow(i, hi); const float inv = wsf[qq]; const size_t tok = (size_t)(base + (q0 + qq) * d + r);
            og[tok * 256] = f2bf(o0[i] * inv); og[tok * 256 + 32] = f2bf(o1[i] * inv); }
        asm volatile("s_waitcnt lgkmcnt(0)" ::: "memory");
    }
}
DEV void ph_attn_combine(const P& p, int bid, int nb) {
    const int tid_ = otid();
    for (int i = bid * NTHR + tid_; i < T * 32; i += nb * NTHR) {
        const int t = i >> 5, ch = i & 31, slot = ch >> 3;
        const float l0 = p.LSUM[(size_t)t * 4 + slot], l1 = p.LSUM[((size_t)T + t) * 4 + slot], l2 = p.LSUM[((size_t)2 * T + t) * 4 + slot];
        const float inv = 1.f / (l0 + l1 + l2);
        const u32x4 a = *(const u32x4*)(p.OG + (size_t)t * 256 + ch * 8), b = *(const u32x4*)(p.OG + ((size_t)T + t) * 256 + ch * 8), c = *(const u32x4*)(p.OG + ((size_t)2 * T + t) * 256 + ch * 8);
        const f32x4 lo = (mg::unpack_lo(a) * l0 + mg::unpack_lo(b) * l1 + mg::unpack_lo(c) * l2) * inv;
        const f32x4 hi = (mg::unpack_hi(a) * l0 + mg::unpack_hi(b) * l1 + mg::unpack_hi(c) * l2) * inv;
        *(u32x4*)(p.O + (size_t)t * 256 + ch * 8) = mg::pack8(lo, hi);
    }
}

template <class Src>
DEV void transpose_blk(const Src& src, int K, bf16_t* WT0, LAS float* scr, int k0, int lane) {
#pragma unroll 8
    for (int i = 0; i < 32; ++i) { const int kk = 2 * i + (lane >> 5); scr[kk * 33 + (lane & 31)] = src(k0 + kk, lane & 31); }
    asm volatile("s_waitcnt lgkmcnt(0)" ::: "memory");
    const int c = lane & 7;
#pragma unroll
    for (int j = 0; j < 4; ++j) { const int n = (lane >> 3) + 8 * j; const LAS float* s = scr + (8 * c) * 33 + n;
        u32x4 o; o.x = pk2(s[0 * 33], s[1 * 33]); o.y = pk2(s[2 * 33], s[3 * 33]); o.z = pk2(s[4 * 33], s[5 * 33]); o.w = pk2(s[6 * 33], s[7 * 33]);
        *(u32x4*)(WT0 + (size_t)n * K + k0 + 8 * c) = o; }
    asm volatile("s_waitcnt lgkmcnt(0)" ::: "memory");
}
struct SrcCol { const float* W; int ld; DEV float operator()(int k, int j) const { return W[(size_t)k * ld + j]; } };
struct SrcEff { const float *wg, *ls, *wu;
    DEV float operator()(int k, int j) const { const int g = k >> 7; const float* a = wg + (size_t)k * 128; const float* l = ls + g * 128; const float* b = wu + (size_t)(g * 128) * DM + j; float s = 0.f;
#pragma unroll 4
        for (int d = 0; d < 128; ++d) s += a[d] * l[d] * b[(size_t)d * DM]; return s; } };
DEV void tr_plain(const float* W, int K, int N, bf16_t* WT, LAS float* scr, int item, int lane) {
    const int nblk = N / 32, k0 = 64 * (item / nblk), n0 = 32 * (item % nblk);
    transpose_blk(SrcCol{W + n0, N}, K, WT + (size_t)n0 * K, scr, k0, lane);
}
DEV void tr_gu(const float* g, const float* u, int K, bf16_t* WT, LAS float* scr, int k0, int rho0, int lane) {
    const int ch0 = (rho0 >> 8) * 128 + (rho0 & 127);
    const float* m = (rho0 & 128) ? u : g;
    transpose_blk(SrcCol{m + ch0, EFF}, K, WT + (size_t)rho0 * K, scr, k0, lane);
}

DEV void ph_prep_small(const P& p, LAS float* scr, int gw, int ngw, int lane) {
    constexpr int I_IN = 16 * (INW / 32), I_EFF = 8 * 32, I_AU = 4 * 32, I_OUT = 16 * 32, I_R = 16 * 8, I_S = 16 * 16, I_SD = 4 * 32;
    constexpr int NIT = I_IN + I_EFF + I_AU + I_OUT + I_R + I_S + I_SD;
    for (int it = gw; it < NIT; it += ngw) {
        int r = it;
        if (r < I_IN) { tr_plain(p.w_in, DM, INW, p.WT_IN, scr, r, lane); continue; } r -= I_IN;
        if (r < I_EFF) { const int k0 = 64 * (r / 32), n0 = 32 * (r % 32);
            transpose_blk(SrcEff{p.pool_w_grp, p.pool_scale, p.w_pool_up + n0}, 512, p.WT_EFF + (size_t)n0 * 512, scr, k0, lane); continue; } r -= I_EFF;
        if (r < I_AU) { tr_plain(p.w_attn_up, 256, DM, p.WT_AU, scr, r, lane); continue; } r -= I_AU;
        if (r < I_OUT) { tr_plain(p.w_out, DM, DM, p.WT_OUT, scr, r, lane); continue; } r -= I_OUT;
        if (r < I_R) { tr_plain(p.w_router, DM, NE, p.WT_RS, scr, r, lane); continue; } r -= I_R;
        if (r < I_S) { tr_gu(p.w_sg, p.w_su, DM, p.WT_RS + (size_t)256 * DM, scr, 64 * (r / 16), 32 * (r % 16), lane); continue; } r -= I_S;
        tr_plain(p.w_sd, EFF, DM, p.WT_SD, scr, r, lane);
    }
}
DEV void ph_prep_ed(const P& p, LAS float* scr, int gw, int ngw, int lane) {
    constexpr int IPE = 4 * 32;
    for (int it = gw; it < NE * IPE; it += ngw) { const int e = it / IPE;
        tr_plain(p.w_ed + (size_t)e * EFF * DM, EFF, DM, p.WT_ED + (size_t)e * DM * EFF, scr, it % IPE, lane); }
}
DEV void ph_prep_egu(const P& p, LAS float* scr, int gw, int ngw, int lane) {
    constexpr int IPE = 16 * 16;
    for (int it = gw; it < NE * IPE; it += ngw) { const int e = it / IPE, r = it % IPE;
        tr_gu(p.w_eg + (size_t)e * DM * EFF, p.w_eu + (size_t)e * DM * EFF, DM, p.WT_EGU + (size_t)e * 512 * DM, scr, 64 * (r / 16), 32 * (r % 16), lane); }
}

constexpr int LDS_BYTES = 147456;
constexpr int LDS_OFF_TAB = 131072;
constexpr int LDS_GTAB = 131072 + 2560;
constexpr int MAXU = 10;

DEV void fill_gtab(const P& p, const LAS int* off, LAS unsigned* gtab, int ncol, int bid, int nb) {
    const int nrt = off[NE] / 256, tot = nrt * ncol; const int tid_ = otid();
    for (int i = 0; i < MAXU; ++i) { const int L = i * nb + bid; if (L >= tot) break;
        const int pm = L / ncol;
        if (tid_ < 256) { const int s = p.rowlist[pm * 256 + tid_]; gtab[i * 256 + tid_] = (unsigned)(s < 0 ? 0 : (s >> 3)) * (unsigned)(DM * 2); } }
    __syncthreads();
}

#define GSYNC() cg::this_grid().sync()
__global__ void __launch_bounds__(NTHR, 2) fwd_all(P p) {
    extern __shared__ __attribute__((aligned(16))) unsigned char lds_raw[];
    LAS unsigned char* lds = (LAS unsigned char*)lds_raw;
    float* sm = (float*)lds_raw;
    int* off = (int*)(lds_raw + LDS_OFF_TAB);
    const LAS int* offl = (const LAS int*)(lds + LDS_OFF_TAB);
    LAS unsigned* gtab = (LAS unsigned*)(lds + LDS_GTAB);
    const int bid = blockIdx.x, nb = gridDim.x;
    const int tid_ = otid(); const int lane = tid_ & 63, wv = tid_ >> 6;
    LAS float* scr = (LAS float*)(lds + wv * 16384);
    const int gw = bid * NWV + wv, ngw = nb * NWV;

    ph_mod(p, sm, bid, nb);
    __syncthreads();
    ph_prep_small(p, scr, gw, ngw, lane);
#if MF_EXP2
    ph_prep_ed(p, scr, gw, ngw, lane);
#endif
    GSYNC();
    ph_norm(p.x, p.norm1_g, p.mod, 0, 1024, p.XB, bid, nb);
    GSYNC();
#if MF_INPROJ
    { mg::DenseOrder S; S.init(p.XB, p.WT_IN, T, INW, DM, nb, bid);
      mg::gemm_phase<mg::MEpiInProj, mg::DenseOrder, false>(lds, gtab, DM, S, mg::MEpiInProj{p.U, p.QKV, p.G}); }
#else
    ngemm_dense<false>(p.XB, DM, p.w_in, nullptr, INW, T, INW, DM, EpiInProj{p.U, p.QKV, p.G}, sm, bid, nb);
#endif
    GSYNC();
    ph_qknorm(p, bid, nb); ph_pool(p, bid, nb);
    GSYNC();
#if MF_ATTN
    ph_attn_mfma(p, lds, bid, nb);
    GSYNC();
    ph_attn_combine(p, bid, nb);
#else
    ph_attn(p, bid, nb);
#endif
#if !MF_MERGE
#pragma unroll 1
    for (int g = 0; g < 4; ++g) ngemm_dense<false>(p.PL + g * 128, 512, p.pool_w_grp + g * 128 * 128, nullptr, 128, T, 128, 128, EpiPoolGrp{p.Y, p.pool_scale, g}, sm, bid, nb);
#endif
    GSYNC();
#if MF_MERGE
    { mg::DenseOrder S; S.init(p.PL, p.WT_EFF, T, DM, 512, nb, bid);
      mg::gemm_phase<mg::MEpiMerge<false>, mg::DenseOrder, false>(lds, gtab, 512, S, mg::MEpiMerge<false>{p.XB, p.G}); }
    { mg::DenseOrder S; S.init(p.O, p.WT_AU, T, DM, 256, nb, bid);
      mg::gemm_phase<mg::MEpiMerge<true>, mg::DenseOrder, false>(lds, gtab, 256, S, mg::MEpiMerge<true>{p.XB, p.G}); }
#else
    ngemm_dense<false>(p.Y, 512, p.w_pool_up, nullptr, DM, T, DM, 512, EpiMergeA{p.XB, p.G}, sm, bid, nb);
    GSYNC();
    ngemm_dense<false>(p.O, 256, p.w_attn_up, nullptr, DM, T, DM, 256, EpiMergeB{p.XB, p.G}, sm, bid, nb);
#endif
    GSYNC();
#if MF_OUT
    { mg::DenseOrder S; S.init(p.XB, p.WT_OUT, T, DM, DM, nb, bid);
      mg::gemm_phase<mg::MEpiOutProj, mg::DenseOrder, false>(lds, gtab, DM, S, mg::MEpiOutProj{p.x, p.out, p.mod}); }
#else
    ngemm_dense<false>(p.XB, DM, p.w_out, nullptr, DM, T, DM, DM, EpiOutProj{p.x, p.out, p.mod}, sm, bid, nb);
#endif
    GSYNC();
    ph_norm(p.out, p.norm2_g, p.mod, 3072, 4096, p.XB, bid, nb);
#if MF_EXP1
    __syncthreads();
    ph_prep_egu(p, scr, gw, ngw, lane);
#endif
    GSYNC();
#if MF_ROUTER
    { mg::DenseOrder S; S.init(p.XB, p.WT_RS, T, 768, DM, nb, bid);
      mg::gemm_phase<mg::MEpiRouterShared, mg::DenseOrder, false>(lds, gtab, DM, S, mg::MEpiRouterShared{p.LG, p.HS}); }
#else
    ngemm_dense<false>(p.XB, DM, p.w_router, nullptr, NE, T, NE, DM, EpiLogits{p.LG}, sm, bid, nb);
#endif
    GSYNC();
    ph_route(p, bid, nb);
    GSYNC();
    ph_scatter(p, off, bid, nb);
    GSYNC();
#if MF_EXP1
    { load_offsets(p.cnt, off); fill_gtab(p, offl, gtab, 2, bid, nb);
      mg::ExpertOrder S{offl, __builtin_amdgcn_readfirstlane(off[NE]) / 256, 2, nb, bid, (const char*)p.XB, (const char*)p.WT_EGU, (size_t)512 * DM * 2, (size_t)256 * DM * 2, 0, true};
      mg::gemm_phase<mg::MEpiAct, mg::ExpertOrder, true>(lds, gtab, DM, S, mg::MEpiAct{p.ACT}); }
#else
    ph_expert1(p, sm, off, bid, nb);
#endif
    GSYNC();
#if MF_EXP2
    { load_offsets(p.cnt, off);
      mg::ExpertOrder S{offl, __builtin_amdgcn_readfirstlane(off[NE]) / 256, 4, nb, bid, (const char*)p.ACT, (const char*)p.WT_ED, (size_t)DM * EFF * 2, (size_t)256 * EFF * 2, (size_t)256 * EFF * 2, false};
      mg::gemm_phase<mg::MEpiSlab, mg::ExpertOrder, false>(lds, gtab, EFF, S, mg::MEpiSlab{p.SLAB, p.rowlist, p.asg_w}); }
#else
    ph_expert2(p, sm, off, bid, nb);
#endif
    GSYNC();
#if !MF_ROUTER
    ngemm_dense<true>(p.XB, DM, p.w_sg, p.w_su, EFF, T, EFF, DM, EpiAct{p.HS}, sm, bid, nb);
    GSYNC();
#endif
#if MF_FINAL
    { mg::DenseOrder S; S.init(p.HS, p.WT_SD, T, DM, EFF, nb, bid);
      mg::gemm_phase<mg::MEpiFinal, mg::DenseOrder, false>(lds, gtab, EFF, S, mg::MEpiFinal{p.out, p.SLAB, p.mod}); }
#else
    ngemm_dense<false>(p.HS, EFF, p.w_sd, nullptr, DM, T, DM, EFF, EpiFinal{p.out, p.SLAB, p.mod}, sm, bid, nb);
#endif
}

extern "C" void kernel_launch(void* const* d_in, const int* in_sizes, int n_in, void* d_out, int out_size, void* d_ws, size_t ws_size, hipStream_t stream) {
    static int grid = 0;
    if (grid == 0) {
        int dev = 0, cus = 0;
        (void)hipGetDevice(&dev);
        (void)hipDeviceGetAttribute(&cus, hipDeviceAttributeMultiprocessorCount, dev);
        int per_cu = 0;
        (void)hipFuncSetAttribute((const void*)fwd_all, hipFuncAttributeMaxDynamicSharedMemorySize, LDS_BYTES);
        (void)hipOccupancyMaxActiveBlocksPerMultiprocessor(&per_cu, fwd_all, NTHR, LDS_BYTES);
        if (per_cu < 1) { fprintf(stderr, "kernel_launch: occupancy query says %d blocks/CU\n", per_cu); per_cu = 1; }
        if (per_cu > 1) per_cu = 1;
        grid = cus * per_cu;
        if (ws_size < WS_END) { fprintf(stderr, "kernel_launch: workspace too small (%zu < %zu)\n", ws_size, (size_t)WS_END); grid = -1; }
    }
    if (grid < 0) return;
    P p{};
    const float* const* in = (const float* const*)d_in;
    p.x = in[0]; p.c = in[1]; p.pos = (const int*)d_in[2];
    p.w_ada = in[3]; p.b_ada = in[4]; p.norm1_g = in[5]; p.w_in = in[6]; p.pool_w_grp = in[7]; p.pool_scale = in[8]; p.q_norm_g = in[9]; p.k_norm_g = in[10];
    p.w_pool_up = in[11]; p.w_attn_up = in[12]; p.w_out = in[13]; p.norm2_g = in[14]; p.w_router = in[15]; p.router_bias = in[16];
    p.w_sg = in[17]; p.w_su = in[18]; p.w_sd = in[19]; p.w_eg = in[20]; p.w_eu = in[21]; p.w_ed = in[22];
    p.out = (float*)d_out;
    char* ws = (char*)d_ws;
    p.mod = (float*)(ws + WS_MOD); p.cnt = (int*)(ws + WS_CNT); p.asg_e = (int*)(ws + WS_ASG_E); p.asg_pos = (int*)(ws + WS_ASG_POS);
    p.asg_w = (float*)(ws + WS_ASG_W); p.rowlist = (int*)(ws + WS_ROWLIST);
    p.XB = (bf16_t*)(ws + WS_XB); p.U = (bf16_t*)(ws + WS_U); p.QKV = (bf16_t*)(ws + WS_QKV); p.G = (bf16_t*)(ws + WS_G); p.PL = (bf16_t*)(ws + WS_PL);
    p.Y = (bf16_t*)(ws + WS_Y); p.O = (bf16_t*)(ws + WS_O); p.ACT = (bf16_t*)(ws + WS_ACT); p.SLAB = (bf16_t*)(ws + WS_SLAB); p.HS = (bf16_t*)(ws + WS_HS);
    p.LG = (float*)(ws + WS_ACT);
    p.OG = (bf16_t*)(ws + WS_OG); p.LSUM = (float*)(ws + WS_LSUM);
    p.WT_IN = (bf16_t*)(ws + WS_WT_IN); p.WT_EFF = (bf16_t*)(ws + WS_WT_EFF); p.WT_AU = (bf16_t*)(ws + WS_WT_AU); p.WT_OUT = (bf16_t*)(ws + WS_WT_OUT);
    p.WT_RS = (bf16_t*)(ws + WS_WT_RS); p.WT_SD = (bf16_t*)(ws + WS_WT_SD); p.WT_EGU = (bf16_t*)(ws + WS_WT_EGU); p.WT_ED = (bf16_t*)(ws + WS_WT_ED);
    void* args[] = {&p};
    hipError_t e = hipLaunchCooperativeKernel((void*)fwd_all, dim3(grid), dim3(NTHR), args, LDS_BYTES, stream);
    if (e != hipSuccess) fprintf(stderr, "cooperative launch failed: %s (grid %d)\n", hipGetErrorString(e), grid);
}
```

```cpp
#include <hip/hip_runtime.h>
#include <hip/hip_cooperative_groups.h>
#include <stdint.h>
#include <cstdio>
namespace cg = cooperative_groups;

#ifndef ONE_LAUNCH
#define ONE_LAUNCH 0
#endif

typedef unsigned short bf16_t;
#define DEV __device__ __forceinline__
#define LAS __attribute__((address_space(3)))
typedef short bf16x8 __attribute__((ext_vector_type(8)));
typedef float f32x4 __attribute__((ext_vector_type(4)));
typedef unsigned u32x4 __attribute__((ext_vector_type(4)));
typedef unsigned u32x2 __attribute__((ext_vector_type(2)));

#ifndef MF_INPROJ
#define MF_INPROJ 1
#endif
#ifndef MF_MERGE
#define MF_MERGE 1
#endif
#ifndef MF_OUT
#define MF_OUT 1
#endif
#ifndef MF_ROUTER
#define MF_ROUTER 1
#endif
#ifndef MF_EXP1
#define MF_EXP1 1
#endif
#ifndef MF_EXP2
#define MF_EXP2 1
#endif
#ifndef MF_ATTN
#define MF_ATTN 1
#endif
#ifndef DUP
#define DUP 0
#endif
#define REPEAT(n) _Pragma("unroll 1") for (int rep_ = 0; rep_ < ((DUP == (n)) ? 2 : 1); ++rep_)
#ifndef MF_FINAL
#define MF_FINAL 1
#endif

constexpr int NB = 16, SEQ = 2048, DM = 1024, T = NB * SEQ;
constexpr int INW = 4864, NMOD = 6144;
constexpr int NE = 256, EFF = 256;
constexpr int NTHR = 512, NWV = 8;
constexpr int NSLOT = T * 8;
constexpr int RMAX = NSLOT + NE * 256;

DEV float bf2f(bf16_t h) { return __uint_as_float(((unsigned)h) << 16); }
DEV bf16_t f2bf(float f) { unsigned u = __float_as_uint(f); u += 0x7fffu + ((u >> 16) & 1u); return (bf16_t)(u >> 16); }
DEV unsigned pk2(float lo, float hi) { return (unsigned)f2bf(lo) | ((unsigned)f2bf(hi) << 16); }
DEV float sigm(float v) { return 1.f / (1.f + __expf(-v)); }
DEV float silu(float v) { return v / (1.f + __expf(-v)); }
DEV int otid() { int t = threadIdx.x; asm volatile("" : "+v"(t)); return t; }
DEV float wave_sum(float v) {
#pragma unroll
    for (int o = 32; o >= 1; o >>= 1) v += __shfl_xor(v, o);
    return v;
}

struct P {
    const float *x, *c; const int* pos;
    const float *w_ada, *b_ada, *norm1_g, *w_in, *pool_w_grp, *pool_scale, *q_norm_g, *k_norm_g, *w_pool_up, *w_attn_up, *w_out, *norm2_g,
        *w_router, *router_bias, *w_sg, *w_su, *w_sd, *w_eg, *w_eu, *w_ed;
    float* out;
    float* mod; int* cnt; int* asg_e; int* asg_pos; float* asg_w; int* rowlist;
    bf16_t *XB, *U, *QKV, *G, *PL, *Y, *O, *ACT, *SLAB, *HS;
    float* LG;
    bf16_t* OG; float* LSUM; unsigned* bar;
    bf16_t *WT_IN, *WT_EFF, *WT_AU, *WT_OUT, *WT_RS, *WT_SD, *WT_EGU, *WT_ED;
};

constexpr size_t MiB = 1u << 20;
constexpr size_t WS_BAR = 640 * 1024, WS_BAR_BYTES = 16384;
constexpr size_t WS_MOD = 0, WS_CNT = 512 * 1024, WS_ASG_E = 1 * MiB, WS_ASG_POS = 2 * MiB, WS_ASG_W = 3 * MiB, WS_ROWLIST = 4 * MiB;
constexpr size_t WS_XB = 8 * MiB;
constexpr size_t WS_ACT = 72 * MiB;
constexpr size_t WS_SLAB = 232 * MiB;
constexpr size_t WS_U = 232 * MiB, WS_QKV = 264 * MiB, WS_G = 408 * MiB, WS_PL = 536 * MiB, WS_Y = 568 * MiB, WS_O = 600 * MiB;
constexpr size_t WS_WT_IN = 744 * MiB, WS_WT_EFF = 754 * MiB, WS_WT_AU = 755 * MiB, WS_WT_OUT = 756 * MiB, WS_WT_RS = 758 * MiB, WS_WT_SD = 760 * MiB;
constexpr size_t WS_WT_ED = 762 * MiB;
constexpr size_t WS_WT_EGU = 232 * MiB;
constexpr size_t WS_OG = 616 * MiB, WS_LSUM = 664 * MiB;
constexpr size_t WS_HS = 890 * MiB;
constexpr size_t WS_END = 906 * MiB;

DEV void ph_mod(const P& p, float* sm, int bid, int nb) {
    const int tid = otid();
    if (bid == 0 && tid < NE) p.cnt[tid] = 0;
    for (int item = bid; item < NB * 12; item += nb) {
        const int b = item / 12, ch = item % 12;
        __syncthreads();
        for (int d = tid; d < DM; d += NTHR) sm[d] = silu(p.c[b * DM + d]);
        __syncthreads();
        const int e = ch * 512 + tid;
        float acc = 0.f;
#pragma unroll 8
        for (int d = 0; d < DM; ++d) acc += sm[d] * p.w_ada[(size_t)d * NMOD + e];
        p.mod[b * NMOD + e] = acc + p.b_ada[e];
    }
}

DEV void ph_norm(const float* src, const float* g, const float* mod, int shift_off, int scale_off, bf16_t* dst, int bid, int nb) {
    const int tid_ = otid(); const int lane = tid_ & 63, wv = tid_ >> 6;
    for (int row = bid * NWV + wv; row < T; row += nb * NWV) {
        const float4* xr = (const float4*)(src + (size_t)row * DM);
        const int b = row / SEQ;
        float4 v[4]; float ss = 0.f;
#pragma unroll
        for (int j = 0; j < 4; ++j) { v[j] = xr[lane + 64 * j]; ss += v[j].x * v[j].x + v[j].y * v[j].y + v[j].z * v[j].z + v[j].w * v[j].w; }
        ss = wave_sum(ss);
        const float r = rsqrtf(ss * (1.f / DM) + 1e-6f);
#pragma unroll
        for (int j = 0; j < 4; ++j) {
            const int col = (lane + 64 * j) * 4;
            const float4 g4 = *(const float4*)(g + col);
            const float4 sc = *(const float4*)(mod + b * NMOD + scale_off + col);
            const float4 sh = *(const float4*)(mod + b * NMOD + shift_off + col);
            const float o0 = v[j].x * r * g4.x * (1.f + sc.x) + sh.x, o1 = v[j].y * r * g4.y * (1.f + sc.y) + sh.y;
            const float o2 = v[j].z * r * g4.z * (1.f + sc.z) + sh.z, o3 = v[j].w * r * g4.w * (1.f + sc.w) + sh.w;
            uint2 w; w.x = pk2(o0, o1); w.y = pk2(o2, o3);
            *(uint2*)(dst + (size_t)row * DM + col) = w;
        }
    }
}

template <bool DUAL, class RowF, class Epi>
DEV void ngemm_tile(const bf16_t* __restrict__ A, int lda, RowF rowf, const float* __restrict__ B, const float* __restrict__ B2, int ldb,
                    int m0, int n0, int K, Epi epi, float* sm) {
    float* As = sm;
    float* Bs = sm + 16 * 132;
    float* Bs2 = Bs + 16 * 64;
    const int tid = otid(), tm = tid >> 4, tn = tid & 15;
    float acc[4][4], acc2[4][4];
#pragma unroll
    for (int i = 0; i < 4; ++i)
#pragma unroll
        for (int j = 0; j < 4; ++j) { acc[i][j] = 0.f; acc2[i][j] = 0.f; }
    const int ar = tid >> 2, ak = (tid & 3) * 4;
    const int arow = rowf(m0 + ar);
    const bf16_t* ap = A + (size_t)(arow < 0 ? 0 : arow) * lda + ak;
    const int bk = tid >> 5, bn = (tid & 31) * 2;
    for (int k0 = 0; k0 < K; k0 += 16) {
        uint2 av = make_uint2(0u, 0u);
        if (arow >= 0) av = *(const uint2*)(ap + k0);
        const float2 bv = *(const float2*)(B + (size_t)(k0 + bk) * ldb + n0 + bn);
        float2 bv2 = make_float2(0.f, 0.f);
        if (DUAL) bv2 = *(const float2*)(B2 + (size_t)(k0 + bk) * ldb + n0 + bn);
        __syncthreads();
        As[(ak + 0) * 132 + ar] = __uint_as_float(av.x << 16);
        As[(ak + 1) * 132 + ar] = __uint_as_float(av.x & 0xffff0000u);
        As[(ak + 2) * 132 + ar] = __uint_as_float(av.y << 16);
        As[(ak + 3) * 132 + ar] = __uint_as_float(av.y & 0xffff0000u);
        Bs[bk * 64 + bn] = bv.x; Bs[bk * 64 + bn + 1] = bv.y;
        if (DUAL) { Bs2[bk * 64 + bn] = bv2.x; Bs2[bk * 64 + bn + 1] = bv2.y; }
        __syncthreads();
#pragma unroll
        for (int kk = 0; kk < 16; ++kk) {
            const float4 a = *(const float4*)&As[kk * 132 + tm * 4];
            const float4 b = *(const float4*)&Bs[kk * 64 + tn * 4];
            const float aa[4] = {a.x, a.y, a.z, a.w}, bb[4] = {b.x, b.y, b.z, b.w};
#pragma unroll
            for (int i = 0; i < 4; ++i)
#pragma unroll
                for (int j = 0; j < 4; ++j) acc[i][j] += aa[i] * bb[j];
            if (DUAL) {
                const float4 b2 = *(const float4*)&Bs2[kk * 64 + tn * 4];
                const float cc[4] = {b2.x, b2.y, b2.z, b2.w};
#pragma unroll
                for (int i = 0; i < 4; ++i)
#pragma unroll
                    for (int j = 0; j < 4; ++j) acc2[i][j] += aa[i] * cc[j];
            }
        }
    }
#pragma unroll
    for (int i = 0; i < 4; ++i)
#pragma unroll
        for (int j = 0; j < 4; ++j) epi(m0 + tm * 4 + i, n0 + tn * 4 + j, acc[i][j], acc2[i][j]);
}

struct RowId { DEV int operator()(int m) const { return m; } };
struct RowTok { const int* rl; DEV int operator()(int m) const { const int s = rl[m]; return s < 0 ? -1 : (s >> 3); } };

template <bool DUAL, class Epi>
DEV void ngemm_dense(const bf16_t* A, int lda, const float* B, const float* B2, int ldb, int M, int N, int K, Epi epi, float* sm, int bid, int nb) {
    const int tn = N / 64, nt = (M / 128) * tn;
    for (int t = bid; t < nt; t += nb) ngemm_tile<DUAL>(A, lda, RowId(), B, B2, ldb, (t / tn) * 128, (t % tn) * 64, K, epi, sm);
}

struct EpiInProj { bf16_t *U, *QKV, *G;
    DEV void operator()(int r, int c, float v, float) const {
        if (c < 512) U[(size_t)r * 512 + c] = f2bf(v);
        else if (c < 2816) QKV[(size_t)r * 2304 + (c - 512)] = f2bf(v);
        else G[(size_t)r * 2048 + (c - 2816)] = f2bf(sigm(v)); } };
struct EpiPoolGrp { bf16_t* Y; const float* ls; int g;
    DEV void operator()(int r, int c, float v, float) const { Y[(size_t)r * 512 + g * 128 + c] = f2bf(v * ls[g * 128 + c]); } };
struct EpiMergeA { bf16_t* MG; const bf16_t* G;
    DEV void operator()(int r, int c, float v, float) const { MG[(size_t)r * DM + c] = f2bf(bf2f(G[(size_t)r * 2048 + c]) * v); } };
struct EpiMergeB { bf16_t* MG; const bf16_t* G;
    DEV void operator()(int r, int c, float v, float) const { const size_t i = (size_t)r * DM + c; MG[i] = f2bf(bf2f(MG[i]) + bf2f(G[(size_t)r * 2048 + 1024 + c]) * v); } };
struct EpiOutProj { const float* x; float* out; const float* mod;
    DEV void operator()(int r, int c, float v, float) const { const size_t i = (size_t)r * DM + c; out[i] = x[i] + mod[(r / SEQ) * NMOD + 2048 + c] * v; } };
struct EpiLogits { float* LG;
    DEV void operator()(int r, int c, float v, float) const { LG[(size_t)r * NE + c] = v; } };
struct EpiAct { bf16_t* ACT;
    DEV void operator()(int r, int c, float v, float v2) const { ACT[(size_t)r * EFF + c] = f2bf(silu(v) * v2); } };
struct EpiSlab { bf16_t* SLAB; const int* rl; const float* w;
    DEV void operator()(int r, int c, float v, float) const { const int s = rl[r]; if (s >= 0) SLAB[(size_t)s * DM + c] = f2bf(v * w[s]); } };
struct EpiFinal { float* out; const bf16_t* SLAB; const float* mod;
    DEV void operator()(int r, int c, float v, float) const {
        float s = v;
#pragma unroll
        for (int k = 0; k < 8; ++k) s += bf2f(SLAB[((size_t)r * 8 + k) * DM + c]);
        const size_t i = (size_t)r * DM + c; out[i] = out[i] + mod[(r / SEQ) * NMOD + 5120 + c] * s; } };

DEV void ph_qknorm(const P& p, int bid, int nb) {
    const int tid_ = otid(); const int lane = tid_ & 63, wv = tid_ >> 6;
    const float gq = p.q_norm_g[lane], gk = p.k_norm_g[lane];
    const float invf = exp2f(-(float)(lane & 7) * (1.f / 8.f) * log2f(500000.f));
    for (int it = bid * NWV + wv; it < T * 24; it += nb * NWV) {
        const int t = it / 24, hh = it % 24;
        bf16_t* ptr = p.QKV + (size_t)t * 2304 + hh * 64 + lane;
        const float v = bf2f(*ptr);
        const float ss = wave_sum(v * v);
        float nv = v * rsqrtf(ss * (1.f / 64.f) + 1e-6f) * (hh < 12 ? gq : gk);
        const float partner = __shfl_xor(nv, 8);
        const float ang = (float)p.pos[t] * invf;
        const float cs = cosf(ang), sn = sinf(ang);
        if (lane < 8) nv = nv * cs - partner * sn;
        else if (lane < 16) nv = nv * cs + partner * sn;
        *ptr = f2bf(nv);
    }
}

DEV void ph_pool(const P& p, int bid, int nb) {
    const int tid_ = otid();
    for (int i = bid * NTHR + tid_; i < NB * 32 * 256; i += nb * NTHR) {
        const int cp = i & 255, chunk = (i >> 8) & 31, b = i >> 13;
        const int g = cp >> 6, r = 1 << g;
        const int s0 = chunk * 64;
        const unsigned* up = (const unsigned*)(p.U + (size_t)b * SEQ * 512) + cp;
        unsigned* op = (unsigned*)(p.PL + (size_t)b * SEQ * 512) + cp;
        float a0 = 0.f, a1 = 0.f;
        const int lo0 = max(s0 - r, 0), hi0 = min(s0 + r, SEQ - 1);
        for (int q = lo0; q <= hi0; ++q) { const unsigned w = up[(size_t)q * 256]; a0 += __uint_as_float(w << 16); a1 += __uint_as_float(w & 0xffff0000u); }
#pragma unroll 4
        for (int s = s0; s < s0 + 64; ++s) {
            const int lo = max(s - r, 0), hi = min(s + r, SEQ - 1);
            const float inv = 1.f / (float)(hi - lo + 1);
            const unsigned w = up[(size_t)s * 256];
            op[(size_t)s * 256] = pk2(a0 * inv - __uint_as_float(w << 16), a1 * inv - __uint_as_float(w & 0xffff0000u));
            if (s + 1 + r <= SEQ - 1) { const unsigned wn = up[(size_t)(s + 1 + r) * 256]; a0 += __uint_as_float(wn << 16); a1 += __uint_as_float(wn & 0xffff0000u); }
            if (s - r >= 0) { const unsigned wo = up[(size_t)(s - r) * 256]; a0 -= __uint_as_float(wo << 16); a1 -= __uint_as_float(wo & 0xffff0000u); }
        }
    }
}

DEV void ph_attn(const P& p, int bid, int nb) {
    const int tid_ = otid(); const int lane = tid_ & 63, wv = tid_ >> 6;
    for (int it = bid * NWV + wv; it < T * 4; it += nb * NWV) {
        const int t = it >> 2, slot = it & 3;
        const int s = t & (SEQ - 1), base = t - s;
        float M = -1e30f, l = 0.f, acc = 0.f;
#pragma unroll
        for (int g = 0; g < 3; ++g) {
            const int dsh = 2 * g, d = 1 << dsh, L = SEQ >> dsh;
            const int h = 4 * g + slot;
            const int m = s >> dsh, r = s & (d - 1);
            const float q = bf2f(p.QKV[(size_t)t * 2304 + h * 64 + lane]);
            const bf16_t* kb = p.QKV + 768 + h * 64 + lane;
            const bf16_t* vb = p.QKV + 1536 + h * 64 + lane;
#pragma unroll 4
            for (int rel = -64; rel <= 64; ++rel) {
                const int mm = m + rel;
                const bool valid = (mm >= 0) && (mm < L);
                const int mc = valid ? mm : m;
                const size_t tr = (size_t)(base + mc * d + r) * 2304;
                const float kv = bf2f(kb[tr]), vv = bf2f(vb[tr]);
                const float sc = wave_sum(q * kv) * 0.125f;
                if (valid) {
                    const float mn = fmaxf(M, sc);
                    const float f = __expf(M - mn), pe = __expf(sc - mn);
                    l = l * f + pe; acc = acc * f + pe * vv; M = mn;
                }
            }
        }
        p.O[(size_t)t * 256 + slot * 64 + lane] = f2bf(acc / l);
    }
}

DEV void ph_route(const P& p, int bid, int nb) {
    const int tid_ = otid(); const int lane = tid_ & 63, wv = tid_ >> 6;
    const float4 bias4 = *(const float4*)(p.router_bias + 4 * lane);
    for (int t = bid * NWV + wv; t < T; t += nb * NWV) {
        const float4 lg = *(const float4*)(p.LG + (size_t)t * NE + 4 * lane);
        const float s0 = 1.f / (1.f + expf(-lg.x)), s1 = 1.f / (1.f + expf(-lg.y)), s2 = 1.f / (1.f + expf(-lg.z)), s3 = 1.f / (1.f + expf(-lg.w));
        float v0 = s0 + bias4.x, v1 = s1 + bias4.y, v2 = s2 + bias4.z, v3 = s3 + bias4.w;
        float m1 = fmaxf(v0, v1), m2 = fminf(v0, v1);
        { const float n1 = fmaxf(m1, v2), n2 = fmaxf(fminf(m1, v2), m2); m1 = n1; m2 = n2; }
        { const float n1 = fmaxf(m1, v3), n2 = fmaxf(fminf(m1, v3), m2); m1 = n1; m2 = n2; }
#pragma unroll
        for (int o = 1; o <= 4; o <<= 1) {
            const float b1 = __shfl_xor(m1, o), b2 = __shfl_xor(m2, o);
            const float n1 = fmaxf(m1, b1), n2 = fmaxf(fminf(m1, b1), fmaxf(m2, b2)); m1 = n1; m2 = n2;
        }
        const float gs = m1 + m2; const int G = lane >> 3;
        int rank = 0;
#pragma unroll
        for (int g2 = 0; g2 < 8; ++g2) { const float o = __shfl(gs, g2 * 8); rank += ((o > gs) || (o == gs && g2 < G)) ? 1 : 0; }
        if (rank >= 4) { v0 = -INFINITY; v1 = -INFINITY; v2 = -INFINITY; v3 = -INFINITY; }
        int myidx = 0; float myw = 0.f, wsum = 0.f;
#pragma unroll
        for (int k = 0; k < 8; ++k) {
            float bv = v0; int bi = 0;
            if (v1 > bv) { bv = v1; bi = 1; }
            if (v2 > bv) { bv = v2; bi = 2; }
            if (v3 > bv) { bv = v3; bi = 3; }
            float bs = bi == 0 ? s0 : (bi == 1 ? s1 : (bi == 2 ? s2 : s3));
            int gi = lane * 4 + bi;
#pragma unroll
            for (int o = 1; o < 64; o <<= 1) {
                const float ov = __shfl_xor(bv, o), os = __shfl_xor(bs, o); const int oi = __shfl_xor(gi, o);
                if ((ov > bv) || (ov == bv && oi < gi)) { bv = ov; gi = oi; bs = os; }
            }
            if (gi == lane * 4 + 0) v0 = -INFINITY;
            if (gi == lane * 4 + 1) v1 = -INFINITY;
            if (gi == lane * 4 + 2) v2 = -INFINITY;
            if (gi == lane * 4 + 3) v3 = -INFINITY;
            if (lane == k) { myidx = gi; myw = bs; }
            wsum += bs;
        }
        if (lane < 8) {
            const int slot = t * 8 + lane;
            const int pos = atomicAdd(&p.cnt[myidx], 1);
            p.asg_e[slot] = myidx; p.asg_pos[slot] = pos; p.asg_w[slot] = myw / wsum * 2.5f;
        }
    }
}

DEV void load_offsets(const int* cnt, int* off) {
    const int tid = otid();
    __syncthreads();
    if (tid < NE) off[300 + tid] = (cnt[tid] + 255) & ~255;
    __syncthreads();
    if (tid == 0) { int a = 0; for (int e = 0; e < NE; ++e) { off[e] = a; a += off[300 + e]; } off[NE] = a; }
    __syncthreads();
}
DEV int find_expert(const int* off, int m0) {
    int lo = 0, hi = NE;
    while (hi - lo > 1) { const int mid = (lo + hi) >> 1; if (off[mid] <= m0) lo = mid; else hi = mid; }
    return lo;
}

DEV void ph_scatter(const P& p, int* off, int bid, int nb) {
    load_offsets(p.cnt, off);
    const int tid_ = otid();
    for (int slot = bid * NTHR + tid_; slot < NSLOT; slot += nb * NTHR) p.rowlist[off[p.asg_e[slot]] + p.asg_pos[slot]] = slot;
    for (int e = bid; e < NE; e += nb) {
        const int n = p.cnt[e], pd = (n + 255) & ~255;
        for (int i = n + tid_; i < pd; i += NTHR) p.rowlist[off[e] + i] = -1;
    }
}

DEV void ph_expert1(const P& p, float* sm, int* off, int bid, int nb) {
    load_offsets(p.cnt, off);
    const int nrt = off[NE] / 128, nt = nrt * 4;
    for (int t = bid; t < nt; t += nb) {
        const int m0 = (t >> 2) * 128, n0 = (t & 3) * 64, e = find_expert(off, m0);
        ngemm_tile<true>(p.XB, DM, RowTok{p.rowlist}, p.w_eg + (size_t)e * DM * EFF, p.w_eu + (size_t)e * DM * EFF, EFF, m0, n0, DM, EpiAct{p.ACT}, sm);
    }
}
DEV void ph_expert2(const P& p, float* sm, int* off, int bid, int nb) {
    load_offsets(p.cnt, off);
    const int nrt = off[NE] / 128, nt = nrt * 16;
    for (int t = bid; t < nt; t += nb) {
        const int m0 = (t >> 4) * 128, n0 = (t & 15) * 64, e = find_expert(off, m0);
        ngemm_tile<false>(p.ACT, EFF, RowId(), p.w_ed + (size_t)e * EFF * DM, nullptr, DM, m0, n0, EFF, EpiSlab{p.SLAB, p.rowlist, p.asg_w}, sm);
    }
}

namespace mg {
constexpr int BM = 256, BK = 64, HALF = 128, HTB = HALF * BK * 2, STAGE_BYTES = 8 * HTB, NXCD = 8, WGM = 8;
__host__ __device__ __forceinline__ int lds_byte(int r, int c) { const int st = (r >> 4) * 2 + (c >> 5), rr = r & 15, cc = c & 31, ob = rr * 64 + cc * 2; return st * 1024 + (ob ^ (((ob >> 9) & 1) << 5)); }
__host__ __device__ __forceinline__ void stage_rc(int b, int& R, int& C) { const int st = b / 1024, sb = b % 1024, swz = sb ^ (((sb >> 9) & 1) << 5); R = (st >> 1) * 16 + swz / 64; C = (st & 1) * 32 + (swz % 64) / 2; }
__host__ __device__ __forceinline__ int perm32(int rho) { const int n = rho >> 4, i = rho & 15; return 8 * (i >> 2) + 4 * n + (i & 3); }

struct Unit { int pm, pn, e, pad; const char* A; const char* B; };

struct DenseOrder {
    int nM, nN, nwg, G, c; const char* A; const char* B; size_t tstep;
    DEV void init(const bf16_t* A_, const bf16_t* B_, int M, int N, int K, int G_, int c_) { nM = M / BM; nN = N / BM; nwg = nM * nN; G = G_; c = c_; A = (const char*)A_; B = (const char*)B_; tstep = (size_t)BM * K * 2; }
    DEV bool next(int i, Unit& u) const {
        const long L = (long)i * G + c; if (L >= nwg) return false;
        int wgid = (int)L; { const int q = nwg / NXCD, r = nwg % NXCD, xcd = wgid % NXCD, off = wgid / NXCD; wgid = (xcd < r ? xcd * (q + 1) : r * (q + 1) + (xcd - r) * q) + off; }
        const int nig = WGM * nN, gid = wgid / nig, fm = gid * WGM, gsz = (nM - fm) < WGM ? (nM - fm) : WGM;
        u.pm = fm + ((wgid % nig) % gsz); u.pn = (wgid % nig) / gsz; u.e = 0; u.pad = 0;
        u.A = A + (size_t)u.pm * tstep; u.B = B + (size_t)u.pn * tstep; return true;
    }
};
struct ExpertOrder {
    const LAS int* off; int nrt, ncol, G, c; const char* A; const char* W; size_t wstride, tstepB, tstepA; bool gather;
    DEV bool next(int i, Unit& u) const {
        const int L = i * G + c; if (L >= nrt * ncol) return false;
        u.pm = L / ncol; u.pn = L % ncol; u.pad = 0;
        int lo = 0, hi = NE; const int m0 = u.pm * BM;
        while (hi - lo > 1) { const int mid = (lo + hi) >> 1; const int ov = __builtin_amdgcn_readfirstlane(off[mid]); if (ov <= m0) lo = mid; else hi = mid; }
        u.e = lo;
        u.A = gather ? A : A + (size_t)u.pm * tstepA; u.B = W + (size_t)lo * wstride + (size_t)u.pn * tstepB; return true;
    }
};

template <class Epi, class Sched, bool GATHER>
DEV void gemm_phase(LAS unsigned char* lds, const LAS unsigned* gtab, const int K, const Sched& S, const Epi& E) {
    const int tid = otid(), wid = __builtin_amdgcn_readfirstlane(tid >> 6), lane = tid & 63, wr = wid >> 2, wc = wid & 3, fr = lane & 15, fq = lane >> 4;
    const int nt = K / BK;
    int Rr[2], Cc[2]; unsigned voffB[2];
#pragma unroll
    for (int i = 0; i < 2; ++i) { stage_rc(tid * 16 + i * 8192, Rr[i], Cc[i]); const int Rb = Epi::PERM ? ((Rr[i] & ~31) + perm32(Rr[i] & 31)) : Rr[i]; voffB[i] = (unsigned)(Rb * K + Cc[i]) * 2u; }
    const size_t kstep = (size_t)(BK * 2);
    const size_t hstep = (size_t)HALF * K * 2;
    const unsigned ldsw = (unsigned)wid * 1024u;
    const int aoff = lds_byte(wr * 64 + fr, fq * 8), boff = lds_byte(wc * 32 + fr, fq * 8);
#define MG_SA(b, h) (((b) * 2 + (h)) * HTB)
#define MG_SB(b, h) ((4 + (b) * 2 + (h)) * HTB)
#define MG_STAGE(bufoff, gbase, voff) do { _Pragma("unroll") for (int _i = 0; _i < 2; ++_i) \
        __builtin_amdgcn_global_load_lds((const unsigned*)((const char*)(gbase) + (voff)[_i]), (LAS unsigned*)(lds + (bufoff) + ldsw + _i * 8192), 16, 0, 0); } while (0)
#define MG_LDA(dst, b, h) do { _Pragma("unroll") for (int m = 0; m < 4; ++m) _Pragma("unroll") for (int k = 0; k < 2; ++k) dst[m][k] = *(const LAS bf16x8*)(lds + MG_SA(b, h) + aoff + m * 2048 + k * 1024); } while (0)
#define MG_LDB(dst, b, h) do { _Pragma("unroll") for (int n = 0; n < 2; ++n) _Pragma("unroll") for (int k = 0; k < 2; ++k) dst[n][k] = *(const LAS bf16x8*)(lds + MG_SB(b, h) + boff + n * 2048 + k * 1024); } while (0)
#define MG_MMA(ai, bj, At, Bt) do { __builtin_amdgcn_s_setprio(1); _Pragma("unroll") for (int m = 0; m < 4; ++m) _Pragma("unroll") for (int n = 0; n < 2; ++n) _Pragma("unroll") for (int k = 0; k < 2; ++k) \
        acc[ai][bj][m][n] = __builtin_amdgcn_mfma_f32_16x16x32_bf16(Bt[n][k], At[m][k], acc[ai][bj][m][n], 0, 0, 0); __builtin_amdgcn_s_setprio(0); } while (0)
#define MG_WAIT_V(n) asm volatile("s_waitcnt vmcnt(" #n ")" ::: "memory")
#define MG_WAIT_L(n) asm volatile("s_waitcnt lgkmcnt(" #n ")" ::: "memory")
#define MG_BAR __builtin_amdgcn_s_barrier()
#define MG_SCHED __builtin_amdgcn_sched_barrier(0)
    Unit cur, nxt; int ui = 0;
    if (!S.next(0, cur)) return;
    f32x4 acc[2][2][4][2];
#pragma unroll
    for (int a = 0; a < 2; ++a)
#pragma unroll
        for (int b = 0; b < 2; ++b)
#pragma unroll
            for (int m = 0; m < 4; ++m)
#pragma unroll
                for (int n = 0; n < 2; ++n) acc[a][b][m][n] = (f32x4){0.f, 0.f, 0.f, 0.f};
    bf16x8 At[4][2], B0[2][2], B1[2][2];
    unsigned va0[2], va1[2], na0[2], na1[2];
#pragma unroll
    for (int i = 0; i < 2; ++i) {
        if (GATHER) { va0[i] = gtab[Rr[i]] + (unsigned)Cc[i] * 2u; va1[i] = gtab[HALF + Rr[i]] + (unsigned)Cc[i] * 2u; }
        else { va0[i] = (unsigned)(Rr[i] * K + Cc[i]) * 2u; va1[i] = va0[i] + (unsigned)hstep; }
        na0[i] = va0[i]; na1[i] = va1[i];
    }
    const char* cA = cur.A; const char* cB = cur.B;
    MG_STAGE(MG_SB(0, 0), cB, voffB); MG_STAGE(MG_SB(0, 1), cB + hstep, voffB); MG_STAGE(MG_SA(0, 0), cA, va0); MG_STAGE(MG_SA(0, 1), cA, va1);
    if (wr == 1) MG_BAR;
    MG_WAIT_V(2); MG_BAR;
    MG_STAGE(MG_SB(1, 0), cB + kstep, voffB); MG_STAGE(MG_SA(1, 0), cA + kstep, va0); MG_STAGE(MG_SB(1, 1), cB + hstep + kstep, voffB);
    MG_WAIT_V(6); MG_BAR;
    for (;;) {
        const bool has_next = S.next(ui + 1, nxt);
        const char* nA = has_next ? nxt.A : cA; const char* nB = has_next ? nxt.B : cB;
        if (GATHER) {
            if (has_next) {
#pragma unroll
                for (int i = 0; i < 2; ++i) { na0[i] = gtab[(ui + 1) * BM + Rr[i]] + (unsigned)Cc[i] * 2u; na1[i] = gtab[(ui + 1) * BM + HALF + Rr[i]] + (unsigned)Cc[i] * 2u; }
            }
        }
#pragma unroll 1
        for (int t = 0; t < nt; t += 2) {
            const bool last = (t == nt - 2);
            const char* a1 = cA + (size_t)(t + 1) * kstep;
            const char* a2 = last ? nA : cA + (size_t)(t + 2) * kstep; const char* b2 = last ? nB : cB + (size_t)(t + 2) * kstep;
            const char* a3 = a2 + kstep; const char* b3 = b2 + kstep;
            unsigned o0[2], o1[2];
#pragma unroll
            for (int i = 0; i < 2; ++i) { o0[i] = (GATHER && last) ? na0[i] : va0[i]; o1[i] = (GATHER && last) ? na1[i] : va1[i]; }
            MG_LDB(B0, 0, 0); MG_LDB(B1, 0, 1); MG_SCHED; MG_LDA(At, 0, 0); MG_STAGE(MG_SA(1, 1), a1, va1);
            MG_WAIT_V(8); MG_WAIT_L(0); MG_BAR; MG_MMA(0, 0, At, B0); MG_MMA(0, 1, At, B1); MG_BAR; MG_SCHED;
            MG_LDA(At, 0, 1); MG_STAGE(MG_SB(0, 0), b2, voffB); MG_STAGE(MG_SB(0, 1), b2 + hstep, voffB); MG_STAGE(MG_SA(0, 0), a2, o0);
            MG_WAIT_V(8); MG_WAIT_L(0); MG_BAR; MG_MMA(1, 0, At, B0); MG_MMA(1, 1, At, B1); MG_BAR; MG_SCHED;
            MG_LDB(B0, 1, 0); MG_LDB(B1, 1, 1); MG_SCHED; MG_LDA(At, 1, 0); MG_STAGE(MG_SA(0, 1), a2, o1);
            MG_WAIT_V(8); MG_WAIT_L(0); MG_BAR; MG_MMA(0, 0, At, B0); MG_MMA(0, 1, At, B1); MG_BAR; MG_SCHED;
            MG_LDA(At, 1, 1); MG_STAGE(MG_SB(1, 0), b3, voffB); MG_STAGE(MG_SB(1, 1), b3 + hstep, voffB); MG_STAGE(MG_SA(1, 0), a3, o0);
            MG_WAIT_V(8); MG_WAIT_L(0); MG_BAR; MG_MMA(1, 0, At, B0); MG_MMA(1, 1, At, B1); MG_BAR; MG_SCHED;
        }
        if (wr == 0) MG_BAR;
        E(acc, cur, wr, wc, fr, fq);
        if (!has_next) break;
#pragma unroll
        for (int a = 0; a < 2; ++a)
#pragma unroll
            for (int b = 0; b < 2; ++b)
#pragma unroll
                for (int m = 0; m < 4; ++m)
#pragma unroll
                    for (int n = 0; n < 2; ++n) acc[a][b][m][n] = (f32x4){0.f, 0.f, 0.f, 0.f};
        cur = nxt; cA = nA; cB = nB; ++ui;
#pragma unroll
        for (int i = 0; i < 2; ++i) { va0[i] = na0[i]; va1[i] = na1[i]; }
        if (wr == 1) MG_BAR;
    }
    MG_WAIT_V(0);
    MG_BAR;
    __syncthreads();
#undef MG_SA
#undef MG_SB
#undef MG_STAGE
#undef MG_LDA
#undef MG_LDB
#undef MG_MMA
#undef MG_WAIT_V
#undef MG_WAIT_L
#undef MG_BAR
#undef MG_SCHED
}

DEV u32x4 pack8(const f32x4 a, const f32x4 b) { u32x4 w; w.x = pk2(a[0], a[1]); w.y = pk2(a[2], a[3]); w.z = pk2(b[0], b[1]); w.w = pk2(b[2], b[3]); return w; }
DEV f32x4 unpack_lo(const u32x4 w) { return (f32x4){__uint_as_float(w.x << 16), __uint_as_float(w.x & 0xffff0000u), __uint_as_float(w.y << 16), __uint_as_float(w.y & 0xffff0000u)}; }
DEV f32x4 unpack_hi(const u32x4 w) { return (f32x4){__uint_as_float(w.z << 16), __uint_as_float(w.z & 0xffff0000u), __uint_as_float(w.w << 16), __uint_as_float(w.w & 0xffff0000u)}; }
DEV f32x4 sig4(const f32x4 v) { return (f32x4){sigm(v[0]), sigm(v[1]), sigm(v[2]), sigm(v[3])}; }
DEV f32x4 silu4(const f32x4 v) { return (f32x4){silu(v[0]), silu(v[1]), silu(v[2]), silu(v[3])}; }
#define ACC_T const f32x4 (&acc)[2][2][4][2]

struct MEpiInProj { static constexpr bool PERM = true; bf16_t *U, *QKV, *G;
    DEV void operator()(ACC_T, const Unit& u, int wr, int wc, int fr, int fq) const {
        int colt = u.pn * BM; bf16_t* base; int ld; bool sg = false;
        if (colt < 512) { base = U; ld = 512; } else if (colt < 2816) { base = QKV; ld = 2304; colt -= 512; } else { base = G; ld = 2048; colt -= 2816; sg = true; }
        const int row0 = u.pm * BM + wr * 64 + fr, col0 = colt + wc * 32 + 8 * fq;
#pragma unroll
        for (int ai = 0; ai < 2; ++ai)
#pragma unroll
            for (int m = 0; m < 4; ++m) { bf16_t* rowp = base + (size_t)(row0 + ai * HALF + m * 16) * ld + col0;
#pragma unroll
                for (int bj = 0; bj < 2; ++bj) { f32x4 v0 = acc[ai][bj][m][0], v1 = acc[ai][bj][m][1]; if (sg) { v0 = sig4(v0); v1 = sig4(v1); }
                    *(u32x4*)(rowp + bj * HALF) = pack8(v0, v1); }
                asm volatile("" ::: "memory"); }
    } };
template <bool SECOND> struct MEpiMerge { static constexpr bool PERM = true; bf16_t* MG; const bf16_t* G;
    DEV void operator()(ACC_T, const Unit& u, int wr, int wc, int fr, int fq) const {
        const int row0 = u.pm * BM + wr * 64 + fr, col0 = u.pn * BM + wc * 32 + 8 * fq;
#pragma unroll
        for (int ai = 0; ai < 2; ++ai)
#pragma unroll
            for (int m = 0; m < 4; ++m) { const size_t r = (size_t)(row0 + ai * HALF + m * 16);
#pragma unroll
                for (int bj = 0; bj < 2; ++bj) { const int c = col0 + bj * HALF;
                    const u32x4 gw = *(const u32x4*)(G + r * 2048 + (SECOND ? 1024 : 0) + c);
                    f32x4 v0 = acc[ai][bj][m][0] * unpack_lo(gw), v1 = acc[ai][bj][m][1] * unpack_hi(gw);
                    if (SECOND) { const u32x4 pw = *(const u32x4*)(MG + r * DM + c); v0 += unpack_lo(pw); v1 += unpack_hi(pw); }
                    *(u32x4*)(MG + r * DM + c) = pack8(v0, v1); }
                asm volatile("" ::: "memory"); }
    } };
struct MEpiOutProj { static constexpr bool PERM = false; const float* x; float* out; const float* mod;
    DEV void operator()(ACC_T, const Unit& u, int wr, int wc, int fr, int fq) const {
        const int row0 = u.pm * BM + wr * 64 + fr, col0 = u.pn * BM + wc * 32 + 4 * fq;
        const float* gm = mod + ((u.pm * BM) / SEQ) * NMOD + 2048;
#pragma unroll
        for (int ai = 0; ai < 2; ++ai)
#pragma unroll
            for (int m = 0; m < 4; ++m) { const size_t r = (size_t)(row0 + ai * HALF + m * 16) * DM;
#pragma unroll
                for (int bj = 0; bj < 2; ++bj)
#pragma unroll
                    for (int n = 0; n < 2; ++n) { const int c = col0 + bj * HALF + n * 16;
                        *(f32x4*)(out + r + c) = *(const f32x4*)(x + r + c) + *(const f32x4*)(gm + c) * acc[ai][bj][m][n]; }
                asm volatile("" ::: "memory"); }
    } };
struct MEpiRouterShared { static constexpr bool PERM = true; float* LG; bf16_t* HS;
    DEV void operator()(ACC_T, const Unit& u, int wr, int wc, int fr, int fq) const {
        const int row0 = u.pm * BM + wr * 64 + fr, cw = wc * 32 + 8 * fq;
#pragma unroll
        for (int ai = 0; ai < 2; ++ai)
#pragma unroll
            for (int m = 0; m < 4; ++m) { const size_t r = (size_t)(row0 + ai * HALF + m * 16);
                if (u.pn == 0) {
#pragma unroll
                    for (int bj = 0; bj < 2; ++bj)
#pragma unroll
                        for (int n = 0; n < 2; ++n) *(f32x4*)(LG + r * NE + bj * HALF + cw + 4 * n) = acc[ai][bj][m][n];
                } else {
                    const f32x4 v0 = silu4(acc[ai][0][m][0]) * acc[ai][1][m][0], v1 = silu4(acc[ai][0][m][1]) * acc[ai][1][m][1];
                    *(u32x4*)(HS + r * EFF + (u.pn - 1) * HALF + cw) = pack8(v0, v1);
                }
                asm volatile("" ::: "memory"); }
    } };
struct MEpiAct { static constexpr bool PERM = true; bf16_t* ACT;
    DEV void operator()(ACC_T, const Unit& u, int wr, int wc, int fr, int fq) const {
        const int row0 = u.pm * BM + wr * 64 + fr, cw = u.pn * HALF + wc * 32 + 8 * fq;
#pragma unroll
        for (int ai = 0; ai < 2; ++ai)
#pragma unroll
            for (int m = 0; m < 4; ++m) { const size_t r = (size_t)(row0 + ai * HALF + m * 16);
                const f32x4 v0 = silu4(acc[ai][0][m][0]) * acc[ai][1][m][0], v1 = silu4(acc[ai][0][m][1]) * acc[ai][1][m][1];
                *(u32x4*)(ACT + r * EFF + cw) = pack8(v0, v1); asm volatile("" ::: "memory"); }
    } };
struct MEpiSlab { static constexpr bool PERM = true; bf16_t* SLAB; const int* rl; const float* w;
    DEV void operator()(ACC_T, const Unit& u, int wr, int wc, int fr, int fq) const {
        const int row0 = u.pm * BM + wr * 64 + fr, col0 = u.pn * BM + wc * 32 + 8 * fq;
#pragma unroll
        for (int ai = 0; ai < 2; ++ai)
#pragma unroll
            for (int m = 0; m < 4; ++m) { const int s = rl[row0 + ai * HALF + m * 16];
                if (s >= 0) { const float g = w[s];
#pragma unroll
                    for (int bj = 0; bj < 2; ++bj) *(u32x4*)(SLAB + (size_t)s * DM + col0 + bj * HALF) = pack8(acc[ai][bj][m][0] * g, acc[ai][bj][m][1] * g); }
                asm volatile("" ::: "memory"); }
    } };
struct MEpiFinal { static constexpr bool PERM = false; float* out; const bf16_t* SLAB; const float* mod;
    DEV void operator()(ACC_T, const Unit& u, int wr, int wc, int fr, int fq) const {
        const int row0 = u.pm * BM + wr * 64 + fr, col0 = u.pn * BM + wc * 32 + 4 * fq;
        const float* gm = mod + ((u.pm * BM) / SEQ) * NMOD + 5120;
#pragma unroll
        for (int ai = 0; ai < 2; ++ai)
#pragma unroll
            for (int m = 0; m < 4; ++m) { const size_t row = (size_t)(row0 + ai * HALF + m * 16);
#pragma unroll
                for (int bj = 0; bj < 2; ++bj)
#pragma unroll
                    for (int n = 0; n < 2; ++n) { const int c = col0 + bj * HALF + n * 16; f32x4 sacc = acc[ai][bj][m][n];
#pragma unroll
                        for (int k = 0; k < 8; ++k) { const u32x2 sw = *(const u32x2*)(SLAB + (row * 8 + k) * DM + c);
                            sacc += (f32x4){__uint_as_float(sw.x << 16), __uint_as_float(sw.x & 0xffff0000u), __uint_as_float(sw.y << 16), __uint_as_float(sw.y & 0xffff0000u)}; }
                        float* op = out + row * DM + c; *(f32x4*)op = *(const f32x4*)op + *(const f32x4*)(gm + c) * sacc; asm volatile("" ::: "memory"); } }
    } };
#undef ACC_T
}

typedef float f32x16 __attribute__((ext_vector_type(16)));
typedef short s16x4 __attribute__((ext_vector_type(4)));
DEV int crow(int r, int hi) { return (r & 3) + 8 * (r >> 2) + 4 * hi; }
DEV unsigned cvtpk(float lo, float hi) { unsigned r; asm("v_cvt_pk_bf16_f32 %0, %1, %2" : "=v"(r) : "v"(lo), "v"(hi)); return r; }
DEV s16x4 vtr(const LAS unsigned char* p) { return __builtin_bit_cast(s16x4, __builtin_amdgcn_ds_read_tr16_b64_v4i16((LAS s16x4*)p)); }
DEV float swap32(float v) { return __shfl_xor(v, 32); }

DEV void ph_attn_mfma(const P& p, LAS unsigned char* lds, int bid, int nb) {
    const int tid = otid(); const int lane = tid & 63, wid = __builtin_amdgcn_readfirstlane(tid >> 6), r32 = lane & 31, hi = lane >> 5;
    LAS unsigned char* vl = lds + wid * 8192;
    LAS float* wsf = (LAS float*)(lds + wid * 8192 + 4096);
    float gq = fabsf(p.q_norm_g[lane]), gk = fabsf(p.k_norm_g[lane]);
#pragma unroll
    for (int o = 32; o >= 1; o >>= 1) { gq = fmaxf(gq, __shfl_xor(gq, o)); gk = fmaxf(gk, __shfl_xor(gk, o)); }
    constexpr float LOG2E = 1.4426950408889634f, C2 = 0.125f * LOG2E;
    const float nmref = -(8.f * gq * gk * LOG2E);
    const int head = wid >> 1, qh = wid & 1;
    const int tq = (lane & 15) >> 2, tp = lane & 3, tcb = (lane >> 4) & 1;
    const LAS unsigned char* vrd = vl + (4 * hi + tq) * 128 + (16 * tcb + 4 * tp) * 2;
    for (int it = bid; it < NB * 96; it += nb) {
        const int cb = it & 31, g = (it >> 5) % 3, b = it / 96;
        const int dsh = 2 * g, d = 1 << dsh, L = SEQ >> dsh, nbk = L >> 6;
        const int r = cb / nbk, blk = cb % nbk;
        const int h = 4 * g + head, base = b * SEQ;
        const int q0 = 64 * blk + 32 * qh;
        const int mq = q0 + r32;
        const bf16_t* qp = p.QKV + (size_t)(base + mq * d + r) * 2304 + h * 64 + hi * 8;
        bf16x8 qr[4];
#pragma unroll
        for (int d0 = 0; d0 < 4; ++d0) qr[d0] = *(const bf16x8*)(qp + d0 * 16);
        f32x16 o0, o1;
#pragma unroll
        for (int i = 0; i < 16; ++i) { o0[i] = 0.f; o1[i] = 0.f; }
        float lsum = 0.f;
        const int kb0 = q0 - 64;
#pragma unroll 1
        for (int st = 0; st < 5; ++st) {
            const int k0 = kb0 + 32 * st;
            if (k0 + 31 < 0 || k0 >= L) continue;
            const int mkc = min(max(k0 + r32, 0), L - 1);
            const bf16_t* kp = p.QKV + (size_t)(base + mkc * d + r) * 2304 + 768 + h * 64 + hi * 8;
            bf16x8 kf[4];
#pragma unroll
            for (int d0 = 0; d0 < 4; ++d0) kf[d0] = *(const bf16x8*)(kp + d0 * 16);
            u32x4 vreg[4];
#pragma unroll
            for (int i = 0; i < 4; ++i) { const int c = lane + 64 * i, row = c >> 3, ch = c & 7; const int mv = min(max(k0 + row, 0), L - 1);
                vreg[i] = *(const u32x4*)(p.QKV + (size_t)(base + mv * d + r) * 2304 + 1536 + h * 64 + ch * 8); }
            f32x16 s;
#pragma unroll
            for (int i = 0; i < 16; ++i) s[i] = 0.f;
#pragma unroll
            for (int d0 = 0; d0 < 4; ++d0) s = __builtin_amdgcn_mfma_f32_32x32x16_bf16(kf[d0], qr[d0], s, 0, 0, 0);
#pragma unroll
            for (int i = 0; i < 16; ++i) { const int key = k0 + crow(i, hi); const int df = key - mq;
                const bool valid = (key >= 0) && (key < L) && (df <= 64) && (df >= -64);
                const float pv = valid ? __builtin_amdgcn_exp2f(__builtin_fmaf(s[i], C2, nmref)) : 0.f; lsum += pv; s[i] = pv; }
            bf16x8 pf0, pf1;
            { u32x4 w0, w1; w0.x = cvtpk(s[0], s[1]); w0.y = cvtpk(s[2], s[3]); w0.z = cvtpk(s[4], s[5]); w0.w = cvtpk(s[6], s[7]);
              w1.x = cvtpk(s[8], s[9]); w1.y = cvtpk(s[10], s[11]); w1.z = cvtpk(s[12], s[13]); w1.w = cvtpk(s[14], s[15]);
              pf0 = __builtin_bit_cast(bf16x8, w0); pf1 = __builtin_bit_cast(bf16x8, w1); }
#pragma unroll
            for (int i = 0; i < 4; ++i) { const int c = lane + 64 * i, row = c >> 3, ch = c & 7; *(LAS u32x4*)(vl + row * 128 + ch * 16) = vreg[i]; }
            asm volatile("s_waitcnt lgkmcnt(0)" ::: "memory");
#pragma unroll
            for (int n = 0; n < 2; ++n)
#pragma unroll
                for (int ks = 0; ks < 2; ++ks) {
                    const s16x4 lo = vtr(vrd + (16 * ks) * 128 + 64 * n), hi4 = vtr(vrd + (16 * ks + 8) * 128 + 64 * n);
                    bf16x8 vf; vf[0] = lo[0]; vf[1] = lo[1]; vf[2] = lo[2]; vf[3] = lo[3]; vf[4] = hi4[0]; vf[5] = hi4[1]; vf[6] = hi4[2]; vf[7] = hi4[3];
                    if (n == 0) o0 = __builtin_amdgcn_mfma_f32_32x32x16_bf16(ks == 0 ? pf0 : pf1, vf, o0, 0, 0, 0);
                    else o1 = __builtin_amdgcn_mfma_f32_32x32x16_bf16(ks == 0 ? pf0 : pf1, vf, o1, 0, 0, 0);
                }
            asm volatile("s_waitcnt lgkmcnt(0)" ::: "memory");
        }
        const float lt = lsum + swap32(lsum);
        if (hi == 0) { wsf[r32] = 1.f / lt; p.LSUM[((size_t)g * T + (base + mq * d + r)) * 4 + head] = lt; }
        asm volatile("s_waitcnt lgkmcnt(0)" ::: "memory");
        bf16_t* og = p.OG + (size_t)g * T * 256 + head * 64 + r32;
#pragma unroll
        for (int i = 0; i < 16; ++i) { const int qq = crow(i, hi); const float inv = wsf[qq]; const size_t tok = (size_t)(base + (q0 + qq) * d + r);
            og[tok * 256] = f2bf(o0[i] * inv); og[tok * 256 + 32] = f2bf(o1[i] * inv); }
        asm volatile("s_waitcnt lgkmcnt(0)" ::: "memory");
    }
}
DEV void ph_attn_combine(const P& p, int bid, int nb) {
    const int tid_ = otid();
    for (int i = bid * NTHR + tid_; i < T * 32; i += nb * NTHR) {
        const int t = i >> 5, ch = i & 31, slot = ch >> 3;
        const float l0 = p.LSUM[(size_t)t * 4 + slot], l1 = p.LSUM[((size_t)T + t) * 4 + slot], l2 = p.LSUM[((size_t)2 * T + t) * 4 + slot];
        const float inv = 1.f / (l0 + l1 + l2);
        const u32x4 a = *(const u32x4*)(p.OG + (size_t)t * 256 + ch * 8), b = *(const u32x4*)(p.OG + ((size_t)T + t) * 256 + ch * 8), c = *(const u32x4*)(p.OG + ((size_t)2 * T + t) * 256 + ch * 8);
        const f32x4 lo = (mg::unpack_lo(a) * l0 + mg::unpack_lo(b) * l1 + mg::unpack_lo(c) * l2) * inv;
        const f32x4 hi = (mg::unpack_hi(a) * l0 + mg::unpack_hi(b) * l1 + mg::unpack_hi(c) * l2) * inv;
        *(u32x4*)(p.O + (size_t)t * 256 + ch * 8) = mg::pack8(lo, hi);
    }
}

template <class Src>
DEV void transpose_blk(const Src& src, int K, bf16_t* WT0, LAS float* scr, int k0, int lane) {
#pragma unroll 8
    for (int i = 0; i < 32; ++i) { const int kk = 2 * i + (lane >> 5); scr[kk * 33 + (lane & 31)] = src(k0 + kk, lane & 31); }
    asm volatile("s_waitcnt lgkmcnt(0)" ::: "memory");
    const int c = lane & 7;
#pragma unroll
    for (int j = 0; j < 4; ++j) { const int n = (lane >> 3) + 8 * j; const LAS float* s = scr + (8 * c) * 33 + n;
        u32x4 o; o.x = pk2(s[0 * 33], s[1 * 33]); o.y = pk2(s[2 * 33], s[3 * 33]); o.z = pk2(s[4 * 33], s[5 * 33]); o.w = pk2(s[6 * 33], s[7 * 33]);
        *(u32x4*)(WT0 + (size_t)n * K + k0 + 8 * c) = o; }
    asm volatile("s_waitcnt lgkmcnt(0)" ::: "memory");
}
struct SrcCol { const float* W; int ld; DEV float operator()(int k, int j) const { return W[(size_t)k * ld + j]; } };
struct SrcEff { const float *wg, *ls, *wu;
    DEV float operator()(int k, int j) const { const int g = k >> 7; const float* a = wg + (size_t)k * 128; const float* l = ls + g * 128; const float* b = wu + (size_t)(g * 128) * DM + j; float s = 0.f;
#pragma unroll 4
        for (int d = 0; d < 128; ++d) s += a[d] * l[d] * b[(size_t)d * DM]; return s; } };
DEV void tr_plain(const float* W, int K, int N, bf16_t* WT, LAS float* scr, int item, int lane) {
    const int nblk = N / 32, k0 = 64 * (item / nblk), n0 = 32 * (item % nblk);
    transpose_blk(SrcCol{W + n0, N}, K, WT + (size_t)n0 * K, scr, k0, lane);
}
DEV void tr_gu(const float* g, const float* u, int K, bf16_t* WT, LAS float* scr, int k0, int rho0, int lane) {
    const int ch0 = (rho0 >> 8) * 128 + (rho0 & 127);
    const float* m = (rho0 & 128) ? u : g;
    transpose_blk(SrcCol{m + ch0, EFF}, K, WT + (size_t)rho0 * K, scr, k0, lane);
}

DEV void ph_prep_small(const P& p, LAS float* scr, int gw, int ngw, int lane) {
    constexpr int I_IN = 16 * (INW / 32), I_EFF = 64 * 16, I_AU = 4 * 32, I_OUT = 16 * 32, I_R = 16 * 8, I_S = 16 * 16, I_SD = 4 * 32;
    constexpr int NIT = I_IN + I_EFF + I_AU + I_OUT + I_R + I_S + I_SD;
    for (int it = gw; it < NIT; it += ngw) {
        int r = it;
        if (r < I_IN) { tr_plain(p.w_in, DM, INW, p.WT_IN, scr, r, lane); continue; } r -= I_IN;
        if (r < I_EFF) {
            const int n = 64 * (r & 15) + lane, k0 = 8 * (r >> 4), g = k0 >> 7;
            const float* a = p.pool_w_grp + (size_t)k0 * 128; const float* l = p.pool_scale + g * 128; const float* b = p.w_pool_up + (size_t)(g * 128) * DM + n;
            float acc[8];
#pragma unroll
            for (int j = 0; j < 8; ++j) acc[j] = 0.f;
#pragma unroll 4
            for (int d = 0; d < 128; ++d) { const float bl = b[(size_t)d * DM] * l[d];
#pragma unroll
                for (int j = 0; j < 8; ++j) acc[j] += a[j * 128 + d] * bl; }
            u32x4 o; o.x = pk2(acc[0], acc[1]); o.y = pk2(acc[2], acc[3]); o.z = pk2(acc[4], acc[5]); o.w = pk2(acc[6], acc[7]);
            *(u32x4*)(p.WT_EFF + (size_t)n * 512 + k0) = o; continue; } r -= I_EFF;
        if (r < I_AU) { tr_plain(p.w_attn_up, 256, DM, p.WT_AU, scr, r, lane); continue; } r -= I_AU;
        if (r < I_OUT) { tr_plain(p.w_out, DM, DM, p.WT_OUT, scr, r, lane); continue; } r -= I_OUT;
        if (r < I_R) { tr_plain(p.w_router, DM, NE, p.WT_RS, scr, r, lane); continue; } r -= I_R;
        if (r < I_S) { tr_gu(p.w_sg, p.w_su, DM, p.WT_RS + (size_t)256 * DM, scr, 64 * (r / 16), 32 * (r % 16), lane); continue; } r -= I_S;
        tr_plain(p.w_sd, EFF, DM, p.WT_SD, scr, r, lane);
    }
}
DEV void ph_prep_ed(const P& p, LAS float* scr, int gw, int ngw, int lane) {
    constexpr int IPE = 4 * 32;
    for (int it = gw; it < NE * IPE; it += ngw) { const int e = it / IPE;
        tr_plain(p.w_ed + (size_t)e * EFF * DM, EFF, DM, p.WT_ED + (size_t)e * DM * EFF, scr, it % IPE, lane); }
}
DEV void ph_prep_egu(const P& p, LAS float* scr, int gw, int ngw, int lane) {
    constexpr int IPE = 16 * 16;
    for (int it = gw; it < NE * IPE; it += ngw) { const int e = it / IPE, r = it % IPE;
        tr_gu(p.w_eg + (size_t)e * DM * EFF, p.w_eu + (size_t)e * DM * EFF, DM, p.WT_EGU + (size_t)e * 512 * DM, scr, 64 * (r / 16), 32 * (r % 16), lane); }
}

constexpr int LDS_BYTES = 147456;
constexpr int LDS_OFF_TAB = 131072;
constexpr int LDS_GTAB = 131072 + 2560;
constexpr int MAXU = 10;
constexpr int LDS_MISC = LDS_GTAB + MAXU * 1024;

DEV void fill_gtab(const P& p, const LAS int* off, LAS unsigned* gtab, int ncol, int bid, int nb) {
    const int nrt = off[NE] / 256, tot = nrt * ncol; const int tid_ = otid();
    for (int i = 0; i < MAXU; ++i) { const int L = i * nb + bid; if (L >= tot) break;
        const int pm = L / ncol;
        if (tid_ < 256) { const int s = p.rowlist[pm * 256 + tid_]; gtab[i * 256 + tid_] = (unsigned)(s < 0 ? 0 : (s >> 3)) * (unsigned)(DM * 2); } }
    __syncthreads();
}


#define GAS __attribute__((address_space(1)))
#define XB_TMO      128
#define XB_XCNT(j)  (256  + 64 * (j))
#define XB_XSUB(j)  (1280 + 64 * (j))
#define XB_XGEN(j)  (2304 + 64 * (j))
#define XB_TOP      3328
#define XB_TOPGEN   3392
#define XCD_BAR_WORDS 3456
#define XB_SPIN_CAP (1u << 18)
DEV unsigned xb_ld(unsigned* p)              { return __hip_atomic_load(p, __ATOMIC_RELAXED, __HIP_MEMORY_SCOPE_AGENT); }
DEV unsigned xb_add(unsigned* p, unsigned v) { return __hip_atomic_fetch_add(p, v, __ATOMIC_RELAXED, __HIP_MEMORY_SCOPE_AGENT); }
DEV unsigned xb_xcc_id() { return (unsigned)__builtin_amdgcn_s_getreg((3 << 11) | 20) & 0xFu; }
#define XB_SPIN(cond, bar) do { unsigned _sp = 0; while (cond) { __builtin_amdgcn_s_sleep(1); \
    if ((++_sp & 255u) == 0u) { if (xb_ld(&(bar)[XB_TMO])) break; if (_sp > XB_SPIN_CAP) { atomicAdd(&(bar)[XB_TMO], 1u); break; } } } } while (0)
struct XcdBarrier { unsigned* bar; unsigned x; volatile LAS unsigned* st; };
DEV XcdBarrier xcd_barrier_post(unsigned* bar, volatile LAS unsigned* st) {
    XcdBarrier b; b.bar = bar; b.x = xb_xcc_id(); b.st = st;
    if (threadIdx.x == 0) (void)xb_add(&bar[XB_XCNT(b.x)], 1u);
    return b;
}
DEV void xcd_barrier_complete(unsigned* bar, unsigned x, unsigned& nloc, unsigned& nx) {
    const unsigned G = gridDim.x * gridDim.y * gridDim.z;
    unsigned sum, cnt, mine, sp = 0u;
    for (;;) {
        sum = 0u; cnt = 0u; mine = 0u;
#pragma unroll
        for (unsigned j = 0; j < 16; ++j) { const unsigned c = xb_ld(&bar[XB_XCNT(j)]); sum += c; cnt += (c > 0u) ? 1u : 0u; mine = (j == x) ? c : mine; }
        if (sum == G) break;
        __builtin_amdgcn_s_sleep(1);
        if ((++sp & 255u) == 0u) { if (xb_ld(&bar[XB_TMO])) break; if (sp > XB_SPIN_CAP) { atomicAdd(&bar[XB_TMO], 1u); break; } }
    }
    nloc = mine > 0u ? mine : 1u; nx = cnt > 0u ? cnt : 1u;
}
DEV void xcd_barrier(const XcdBarrier& b) {
    asm volatile("s_waitcnt vmcnt(0)" ::: "memory");
    __syncthreads();
    if (threadIdx.x == 0) {
        unsigned* bar = b.bar;
        __builtin_amdgcn_s_waitcnt(0);
        unsigned nloc = b.st[0], nx = b.st[1];
        if (nloc == 0u) { xcd_barrier_complete(bar, b.x, nloc, nx); b.st[0] = nloc; b.st[1] = nx; }
        const unsigned old = xb_add(&bar[XB_XSUB(b.x)], 1u);
        const unsigned gen = old / nloc;
        if (old + 1u == (gen + 1u) * nloc) {
            __builtin_amdgcn_fence(__ATOMIC_RELEASE, "agent");
            asm volatile("s_waitcnt vmcnt(0)" ::: "memory");
            const unsigned og = xb_add(&bar[XB_TOP], 1u);
            const unsigned tg = og / nx;
            if (og + 1u == (tg + 1u) * nx) xb_add(&bar[XB_TOPGEN], 1u);
            else XB_SPIN(xb_ld(&bar[XB_TOPGEN]) == tg, bar);
            __builtin_amdgcn_fence(__ATOMIC_ACQUIRE, "agent");
            xb_add(&bar[XB_XGEN(b.x)], 1u);
            asm volatile("s_waitcnt vmcnt(0)" ::: "memory");
        } else {
            XB_SPIN(xb_ld(&bar[XB_XGEN(b.x)]) == gen, bar);
            __builtin_amdgcn_fence(__ATOMIC_ACQUIRE, "agent");
            asm volatile("s_waitcnt vmcnt(0)" ::: "memory");
        }
    }
    __syncthreads();
}

#define GSYNC_CG() cg::this_grid().sync()
#define GSYNC() xcd_barrier(xbar)
__global__ void __launch_bounds__(NTHR, 2) fwd_all(P p) {
    extern __shared__ __attribute__((aligned(16))) unsigned char lds_raw[];
    LAS unsigned char* lds = (LAS unsigned char*)lds_raw;
    float* sm = (float*)lds_raw;
    int* off = (int*)(lds_raw + LDS_OFF_TAB);
    const LAS int* offl = (const LAS int*)(lds + LDS_OFF_TAB);
    LAS unsigned* gtab = (LAS unsigned*)(lds + LDS_GTAB);
    const int bid = blockIdx.x, nb = gridDim.x;
    const int tid_ = otid(); const int lane = tid_ & 63, wv = tid_ >> 6;
    LAS float* scr = (LAS float*)(lds + wv * 16384);
    const int gw = bid * NWV + wv, ngw = nb * NWV;
    volatile LAS unsigned* misc = (volatile LAS unsigned*)(lds + LDS_MISC);
    if (threadIdx.x < 2) misc[threadIdx.x] = 0u;
    __syncthreads();
    const XcdBarrier xbar = xcd_barrier_post(p.bar, misc);

    ph_mod(p, sm, bid, nb);
    __syncthreads();
    REPEAT(1) ph_prep_small(p, scr, gw, ngw, lane);
#if MF_EXP2
    REPEAT(2) ph_prep_ed(p, scr, gw, ngw, lane);
#endif
    GSYNC_CG();
    REPEAT(3) ph_norm(p.x, p.norm1_g, p.mod, 0, 1024, p.XB, bid, nb);
    GSYNC();
#if MF_INPROJ
    REPEAT(4) { mg::DenseOrder S; S.init(p.XB, p.WT_IN, T, INW, DM, nb, bid);
      mg::gemm_phase<mg::MEpiInProj, mg::DenseOrder, false>(lds, gtab, DM, S, mg::MEpiInProj{p.U, p.QKV, p.G}); }
#else
    ngemm_dense<false>(p.XB, DM, p.w_in, nullptr, INW, T, INW, DM, EpiInProj{p.U, p.QKV, p.G}, sm, bid, nb);
#endif
    GSYNC();
    ph_qknorm(p, bid, nb); REPEAT(5) ph_pool(p, bid, nb);
    GSYNC();
#if MF_ATTN
    REPEAT(6) ph_attn_mfma(p, lds, bid, nb);
    GSYNC();
    REPEAT(7) ph_attn_combine(p, bid, nb);
#else
    ph_attn(p, bid, nb);
#endif
#if !MF_MERGE
#pragma unroll 1
    for (int g = 0; g < 4; ++g) ngemm_dense<false>(p.PL + g * 128, 512, p.pool_w_grp + g * 128 * 128, nullptr, 128, T, 128, 128, EpiPoolGrp{p.Y, p.pool_scale, g}, sm, bid, nb);
#endif
    GSYNC();
#if MF_MERGE
    REPEAT(8) { mg::DenseOrder S; S.init(p.PL, p.WT_EFF, T, DM, 512, nb, bid);
      mg::gemm_phase<mg::MEpiMerge<false>, mg::DenseOrder, false>(lds, gtab, 512, S, mg::MEpiMerge<false>{p.XB, p.G}); }
    { mg::DenseOrder S; S.init(p.O, p.WT_AU, T, DM, 256, nb, bid);
      mg::gemm_phase<mg::MEpiMerge<true>, mg::DenseOrder, false>(lds, gtab, 256, S, mg::MEpiMerge<true>{p.XB, p.G}); }
#else
    ngemm_dense<false>(p.Y, 512, p.w_pool_up, nullptr, DM, T, DM, 512, EpiMergeA{p.XB, p.G}, sm, bid, nb);
    GSYNC();
    ngemm_dense<false>(p.O, 256, p.w_attn_up, nullptr, DM, T, DM, 256, EpiMergeB{p.XB, p.G}, sm, bid, nb);
#endif
    GSYNC();
#if MF_OUT
    REPEAT(9) { mg::DenseOrder S; S.init(p.XB, p.WT_OUT, T, DM, DM, nb, bid);
      mg::gemm_phase<mg::MEpiOutProj, mg::DenseOrder, false>(lds, gtab, DM, S, mg::MEpiOutProj{p.x, p.out, p.mod}); }
#else
    ngemm_dense<false>(p.XB, DM, p.w_out, nullptr, DM, T, DM, DM, EpiOutProj{p.x, p.out, p.mod}, sm, bid, nb);
#endif
    GSYNC();
    REPEAT(10) ph_norm(p.out, p.norm2_g, p.mod, 3072, 4096, p.XB, bid, nb);
#if MF_EXP1
    __syncthreads();
    REPEAT(11) ph_prep_egu(p, scr, gw, ngw, lane);
#endif
    GSYNC();
#if MF_ROUTER
    REPEAT(12) { mg::DenseOrder S; S.init(p.XB, p.WT_RS, T, 768, DM, nb, bid);
      mg::gemm_phase<mg::MEpiRouterShared, mg::DenseOrder, false>(lds, gtab, DM, S, mg::MEpiRouterShared{p.LG, p.HS}); }
#else
    ngemm_dense<false>(p.XB, DM, p.w_router, nullptr, NE, T, NE, DM, EpiLogits{p.LG}, sm, bid, nb);
#endif
    GSYNC();
    ph_route(p, bid, nb);
    GSYNC();
    ph_scatter(p, off, bid, nb);
    GSYNC();
#if MF_EXP1
    REPEAT(13) { load_offsets(p.cnt, off); fill_gtab(p, offl, gtab, 2, bid, nb);
      mg::ExpertOrder S{offl, __builtin_amdgcn_readfirstlane(off[NE]) / 256, 2, nb, bid, (const char*)p.XB, (const char*)p.WT_EGU, (size_t)512 * DM * 2, (size_t)256 * DM * 2, 0, true};
      mg::gemm_phase<mg::MEpiAct, mg::ExpertOrder, true>(lds, gtab, DM, S, mg::MEpiAct{p.ACT}); }
#else
    ph_expert1(p, sm, off, bid, nb);
#endif
    GSYNC();
#if MF_EXP2
    REPEAT(14) { load_offsets(p.cnt, off);
      mg::ExpertOrder S{offl, __builtin_amdgcn_readfirstlane(off[NE]) / 256, 4, nb, bid, (const char*)p.ACT, (const char*)p.WT_ED, (size_t)DM * EFF * 2, (size_t)256 * EFF * 2, (size_t)256 * EFF * 2, false};
      mg::gemm_phase<mg::MEpiSlab, mg::ExpertOrder, false>(lds, gtab, EFF, S, mg::MEpiSlab{p.SLAB, p.rowlist, p.asg_w}); }
#else
    ph_expert2(p, sm, off, bid, nb);
#endif
    GSYNC();
#if !MF_ROUTER
    ngemm_dense<true>(p.XB, DM, p.w_sg, p.w_su, EFF, T, EFF, DM, EpiAct{p.HS}, sm, bid, nb);
    GSYNC();
#endif
#if MF_FINAL
    { mg::DenseOrder S; S.init(p.HS, p.WT_SD, T, DM, EFF, nb, bid);
      mg::gemm_phase<mg::MEpiFinal, mg::DenseOrder, false>(lds, gtab, EFF, S, mg::MEpiFinal{p.out, p.SLAB, p.mod}); }
#else
    ngemm_dense<false>(p.HS, EFF, p.w_sd, nullptr, DM, T, DM, EFF, EpiFinal{p.out, p.SLAB, p.mod}, sm, bid, nb);
#endif
}

extern "C" void kernel_launch(void* const* d_in, const int* in_sizes, int n_in, void* d_out, int out_size, void* d_ws, size_t ws_size, hipStream_t stream) {
    static int grid = 0;
    if (grid == 0) {
        int dev = 0, cus = 0;
        (void)hipGetDevice(&dev);
        (void)hipDeviceGetAttribute(&cus, hipDeviceAttributeMultiprocessorCount, dev);
        int per_cu = 0;
        (void)hipFuncSetAttribute((const void*)fwd_all, hipFuncAttributeMaxDynamicSharedMemorySize, LDS_BYTES);
        (void)hipOccupancyMaxActiveBlocksPerMultiprocessor(&per_cu, fwd_all, NTHR, LDS_BYTES);
        if (per_cu < 1) { fprintf(stderr, "kernel_launch: occupancy query says %d blocks/CU\n", per_cu); per_cu = 1; }
        if (per_cu > 1) per_cu = 1;
        grid = cus * per_cu;
        if (ws_size < WS_END) { fprintf(stderr, "kernel_launch: workspace too small (%zu < %zu)\n", ws_size, (size_t)WS_END); grid = -1; }
    }
    if (grid < 0) return;
    P p{};
    const float* const* in = (const float* const*)d_in;
    p.x = in[0]; p.c = in[1]; p.pos = (const int*)d_in[2];
    p.w_ada = in[3]; p.b_ada = in[4]; p.norm1_g = in[5]; p.w_in = in[6]; p.pool_w_grp = in[7]; p.pool_scale = in[8]; p.q_norm_g = in[9]; p.k_norm_g = in[10];
    p.w_pool_up = in[11]; p.w_attn_up = in[12]; p.w_out = in[13]; p.norm2_g = in[14]; p.w_router = in[15]; p.router_bias = in[16];
    p.w_sg = in[17]; p.w_su = in[18]; p.w_sd = in[19]; p.w_eg = in[20]; p.w_eu = in[21]; p.w_ed = in[22];
    p.out = (float*)d_out;
    char* ws = (char*)d_ws;
    p.mod = (float*)(ws + WS_MOD); p.cnt = (int*)(ws + WS_CNT); p.asg_e = (int*)(ws + WS_ASG_E); p.asg_pos = (int*)(ws + WS_ASG_POS);
    p.asg_w = (float*)(ws + WS_ASG_W); p.rowlist = (int*)(ws + WS_ROWLIST);
    p.XB = (bf16_t*)(ws + WS_XB); p.U = (bf16_t*)(ws + WS_U); p.QKV = (bf16_t*)(ws + WS_QKV); p.G = (bf16_t*)(ws + WS_G); p.PL = (bf16_t*)(ws + WS_PL);
    p.Y = (bf16_t*)(ws + WS_Y); p.O = (bf16_t*)(ws + WS_O); p.ACT = (bf16_t*)(ws + WS_ACT); p.SLAB = (bf16_t*)(ws + WS_SLAB); p.HS = (bf16_t*)(ws + WS_HS);
    p.LG = (float*)(ws + WS_ACT);
    p.bar = (unsigned*)(ws + WS_BAR);
    p.OG = (bf16_t*)(ws + WS_OG); p.LSUM = (float*)(ws + WS_LSUM);
    p.WT_IN = (bf16_t*)(ws + WS_WT_IN); p.WT_EFF = (bf16_t*)(ws + WS_WT_EFF); p.WT_AU = (bf16_t*)(ws + WS_WT_AU); p.WT_OUT = (bf16_t*)(ws + WS_WT_OUT);
    p.WT_RS = (bf16_t*)(ws + WS_WT_RS); p.WT_SD = (bf16_t*)(ws + WS_WT_SD); p.WT_EGU = (bf16_t*)(ws + WS_WT_EGU); p.WT_ED = (bf16_t*)(ws + WS_WT_ED);
    (void)hipMemsetAsync(ws + WS_BAR, 0, WS_BAR_BYTES, stream);
    void* args[] = {&p};
    hipError_t e = hipLaunchCooperativeKernel((void*)fwd_all, dim3(grid), dim3(NTHR), args, LDS_BYTES, stream);
    if (e != hipSuccess) fprintf(stderr, "cooperative launch failed: %s (grid %d)\n", hipGetErrorString(e), grid);
}
```

```cpp
#include <hip/hip_runtime.h>
#include <hip/hip_cooperative_groups.h>
#include <stdint.h>
#include <cstdio>
namespace cg = cooperative_groups;

#ifndef ONE_LAUNCH
#define ONE_LAUNCH 0
#endif

typedef unsigned short bf16_t;
#define DEV __device__ __forceinline__
#define LAS __attribute__((address_space(3)))
typedef short bf16x8 __attribute__((ext_vector_type(8)));
typedef float f32x4 __attribute__((ext_vector_type(4)));
typedef unsigned u32x4 __attribute__((ext_vector_type(4)));
typedef unsigned u32x2 __attribute__((ext_vector_type(2)));

#ifndef MF_INPROJ
#define MF_INPROJ 1
#endif
#ifndef MF_MERGE
#define MF_MERGE 1
#endif
#ifndef MF_OUT
#define MF_OUT 1
#endif
#ifndef MF_ROUTER
#define MF_ROUTER 1
#endif
#ifndef MF_EXP1
#define MF_EXP1 1
#endif
#ifndef MF_EXP2
#define MF_EXP2 1
#endif
#ifndef MF_ATTN
#define MF_ATTN 1
#endif
#ifndef DUP
#define DUP 0
#endif
#ifndef TPROBE
#define TPROBE -1
#endif
#ifndef TSCALE
#define TSCALE 10.0f
#endif
#define REPEAT(n) _Pragma("unroll 1") for (int rep_ = 0; rep_ < ((DUP == (n)) ? 2 : 1); ++rep_)
#ifndef MF_FINAL
#define MF_FINAL 1
#endif

constexpr int NB = 16, SEQ = 2048, DM = 1024, T = NB * SEQ;
constexpr int INW = 4864, NMOD = 6144;
constexpr int NE = 256, EFF = 256;
constexpr int NTHR = 512, NWV = 8;
constexpr int NSLOT = T * 8;
constexpr int RMAX = NSLOT + NE * 256;

DEV float bf2f(bf16_t h) { return __uint_as_float(((unsigned)h) << 16); }
DEV bf16_t f2bf(float f) { unsigned u = __float_as_uint(f); u += 0x7fffu + ((u >> 16) & 1u); return (bf16_t)(u >> 16); }
DEV unsigned pk2(float lo, float hi) { return (unsigned)f2bf(lo) | ((unsigned)f2bf(hi) << 16); }
DEV float sigm(float v) { return 1.f / (1.f + __expf(-v)); }
DEV float silu(float v) { return v / (1.f + __expf(-v)); }
DEV int otid() { int t = threadIdx.x; asm volatile("" : "+v"(t)); return t; }
DEV float wave_sum(float v) {
#pragma unroll
    for (int o = 32; o >= 1; o >>= 1) v += __shfl_xor(v, o);
    return v;
}

struct P {
    const float *x, *c; const int* pos;
    const float *w_ada, *b_ada, *norm1_g, *w_in, *pool_w_grp, *pool_scale, *q_norm_g, *k_norm_g, *w_pool_up, *w_attn_up, *w_out, *norm2_g,
        *w_router, *router_bias, *w_sg, *w_su, *w_sd, *w_eg, *w_eu, *w_ed;
    float* out;
    float* mod; int* cnt; int* asg_e; int* asg_pos; float* asg_w; int* rowlist;
    bf16_t *XB, *U, *QKV, *G, *PL, *Y, *O, *ACT, *SLAB, *HS;
    float* LG;
    bf16_t* OG; float* LSUM; unsigned* bar; unsigned long long* ts;
    bf16_t *WT_IN, *WT_EFF, *WT_AU, *WT_OUT, *WT_RS, *WT_SD, *WT_EGU, *WT_ED;
};

constexpr size_t MiB = 1u << 20;
constexpr size_t WS_BAR = 640 * 1024, WS_BAR_BYTES = 16384, WS_ZERO_BYTES = 16384 + 65536;
constexpr size_t WS_TS = 800 * 1024;
constexpr size_t WS_MOD = 0, WS_CNT = WS_BAR + WS_BAR_BYTES, WS_ASG_E = 1 * MiB, WS_ASG_POS = 2 * MiB, WS_ASG_W = 3 * MiB, WS_ROWLIST = 4 * MiB;
constexpr size_t WS_XB = 8 * MiB;
constexpr size_t WS_ACT = 72 * MiB;
constexpr size_t WS_SLAB = 232 * MiB;
constexpr size_t WS_U = 232 * MiB, WS_QKV = 264 * MiB, WS_G = 408 * MiB, WS_PL = 536 * MiB, WS_Y = 568 * MiB, WS_O = 600 * MiB;
constexpr size_t WS_WT_IN = 744 * MiB, WS_WT_EFF = 754 * MiB, WS_WT_AU = 755 * MiB, WS_WT_OUT = 756 * MiB, WS_WT_RS = 758 * MiB, WS_WT_SD = 760 * MiB;
constexpr size_t WS_WT_ED = 762 * MiB;
constexpr size_t WS_WT_EGU = 232 * MiB;
constexpr size_t WS_OG = 616 * MiB, WS_LSUM = 664 * MiB;
constexpr size_t WS_HS = 890 * MiB;
constexpr size_t WS_END = 906 * MiB;

DEV void ph_mod(const P& p, float* sm, int bid, int nb) {
    const int tid = otid();
    for (int item = bid; item < NB * 12; item += nb) {
        const int b = item / 12, ch = item % 12;
        __syncthreads();
        for (int d = tid; d < DM; d += NTHR) sm[d] = silu(p.c[b * DM + d]);
        __syncthreads();
        const int e = ch * 512 + tid;
        float acc = 0.f;
#pragma unroll 8
        for (int d = 0; d < DM; ++d) acc += sm[d] * p.w_ada[(size_t)d * NMOD + e];
        p.mod[b * NMOD + e] = acc + p.b_ada[e];
    }
}

DEV void ph_norm(const float* src, const float* g, const float* mod, int shift_off, int scale_off, bf16_t* dst, int bid, int nb) {
    const int tid_ = otid(); const int lane = tid_ & 63, wv = tid_ >> 6;
    for (int row = bid * NWV + wv; row < T; row += nb * NWV) {
        const float4* xr = (const float4*)(src + (size_t)row * DM);
        const int b = row / SEQ;
        float4 v[4]; float ss = 0.f;
#pragma unroll
        for (int j = 0; j < 4; ++j) { v[j] = xr[lane + 64 * j]; ss += v[j].x * v[j].x + v[j].y * v[j].y + v[j].z * v[j].z + v[j].w * v[j].w; }
        ss = wave_sum(ss);
        const float r = rsqrtf(ss * (1.f / DM) + 1e-6f);
#pragma unroll
        for (int j = 0; j < 4; ++j) {
            const int col = (lane + 64 * j) * 4;
            const float4 g4 = *(const float4*)(g + col);
            const float4 sc = *(const float4*)(mod + b * NMOD + scale_off + col);
            const float4 sh = *(const float4*)(mod + b * NMOD + shift_off + col);
            const float o0 = v[j].x * r * g4.x * (1.f + sc.x) + sh.x, o1 = v[j].y * r * g4.y * (1.f + sc.y) + sh.y;
            const float o2 = v[j].z * r * g4.z * (1.f + sc.z) + sh.z, o3 = v[j].w * r * g4.w * (1.f + sc.w) + sh.w;
            uint2 w; w.x = pk2(o0, o1); w.y = pk2(o2, o3);
            *(uint2*)(dst + (size_t)row * DM + col) = w;
        }
    }
}

template <bool DUAL, class RowF, class Epi>
DEV void ngemm_tile(const bf16_t* __restrict__ A, int lda, RowF rowf, const float* __restrict__ B, const float* __restrict__ B2, int ldb,
                    int m0, int n0, int K, Epi epi, float* sm) {
    float* As = sm;
    float* Bs = sm + 16 * 132;
    float* Bs2 = Bs + 16 * 64;
    const int tid = otid(), tm = tid >> 4, tn = tid & 15;
    float acc[4][4], acc2[4][4];
#pragma unroll
    for (int i = 0; i < 4; ++i)
#pragma unroll
        for (int j = 0; j < 4; ++j) { acc[i][j] = 0.f; acc2[i][j] = 0.f; }
    const int ar = tid >> 2, ak = (tid & 3) * 4;
    const int arow = rowf(m0 + ar);
    const bf16_t* ap = A + (size_t)(arow < 0 ? 0 : arow) * lda + ak;
    const int bk = tid >> 5, bn = (tid & 31) * 2;
    for (int k0 = 0; k0 < K; k0 += 16) {
        uint2 av = make_uint2(0u, 0u);
        if (arow >= 0) av = *(const uint2*)(ap + k0);
        const float2 bv = *(const float2*)(B + (size_t)(k0 + bk) * ldb + n0 + bn);
        float2 bv2 = make_float2(0.f, 0.f);
        if (DUAL) bv2 = *(const float2*)(B2 + (size_t)(k0 + bk) * ldb + n0 + bn);
        __syncthreads();
        As[(ak + 0) * 132 + ar] = __uint_as_float(av.x << 16);
        As[(ak + 1) * 132 + ar] = __uint_as_float(av.x & 0xffff0000u);
        As[(ak + 2) * 132 + ar] = __uint_as_float(av.y << 16);
        As[(ak + 3) * 132 + ar] = __uint_as_float(av.y & 0xffff0000u);
        Bs[bk * 64 + bn] = bv.x; Bs[bk * 64 + bn + 1] = bv.y;
        if (DUAL) { Bs2[bk * 64 + bn] = bv2.x; Bs2[bk * 64 + bn + 1] = bv2.y; }
        __syncthreads();
#pragma unroll
        for (int kk = 0; kk < 16; ++kk) {
            const float4 a = *(const float4*)&As[kk * 132 + tm * 4];
            const float4 b = *(const float4*)&Bs[kk * 64 + tn * 4];
            const float aa[4] = {a.x, a.y, a.z, a.w}, bb[4] = {b.x, b.y, b.z, b.w};
#pragma unroll
            for (int i = 0; i < 4; ++i)
#pragma unroll
                for (int j = 0; j < 4; ++j) acc[i][j] += aa[i] * bb[j];
            if (DUAL) {
                const float4 b2 = *(const float4*)&Bs2[kk * 64 + tn * 4];
                const float cc[4] = {b2.x, b2.y, b2.z, b2.w};
#pragma unroll
                for (int i = 0; i < 4; ++i)
#pragma unroll
                    for (int j = 0; j < 4; ++j) acc2[i][j] += aa[i] * cc[j];
            }
        }
    }
#pragma unroll
    for (int i = 0; i < 4; ++i)
#pragma unroll
        for (int j = 0; j < 4; ++j) epi(m0 + tm * 4 + i, n0 + tn * 4 + j, acc[i][j], acc2[i][j]);
}

struct RowId { DEV int operator()(int m) const { return m; } };
struct RowTok { const int* rl; DEV int operator()(int m) const { const int s = rl[m]; return s < 0 ? -1 : (s >> 3); } };

template <bool DUAL, class Epi>
DEV void ngemm_dense(const bf16_t* A, int lda, const float* B, const float* B2, int ldb, int M, int N, int K, Epi epi, float* sm, int bid, int nb) {
    const int tn = N / 64, nt = (M / 128) * tn;
    for (int t = bid; t < nt; t += nb) ngemm_tile<DUAL>(A, lda, RowId(), B, B2, ldb, (t / tn) * 128, (t % tn) * 64, K, epi, sm);
}

struct EpiInProj { bf16_t *U, *QKV, *G;
    DEV void operator()(int r, int c, float v, float) const {
        if (c < 512) U[(size_t)r * 512 + c] = f2bf(v);
        else if (c < 2816) QKV[(size_t)r * 2304 + (c - 512)] = f2bf(v);
        else G[(size_t)r * 2048 + (c - 2816)] = f2bf(sigm(v)); } };
struct EpiPoolGrp { bf16_t* Y; const float* ls; int g;
    DEV void operator()(int r, int c, float v, float) const { Y[(size_t)r * 512 + g * 128 + c] = f2bf(v * ls[g * 128 + c]); } };
struct EpiMergeA { bf16_t* MG; const bf16_t* G;
    DEV void operator()(int r, int c, float v, float) const { MG[(size_t)r * DM + c] = f2bf(bf2f(G[(size_t)r * 2048 + c]) * v); } };
struct EpiMergeB { bf16_t* MG; const bf16_t* G;
    DEV void operator()(int r, int c, float v, float) const { const size_t i = (size_t)r * DM + c; MG[i] = f2bf(bf2f(MG[i]) + bf2f(G[(size_t)r * 2048 + 1024 + c]) * v); } };
struct EpiOutProj { const float* x; float* out; const float* mod;
    DEV void operator()(int r, int c, float v, float) const { const size_t i = (size_t)r * DM + c; out[i] = x[i] + mod[(r / SEQ) * NMOD + 2048 + c] * v; } };
struct EpiLogits { float* LG;
    DEV void operator()(int r, int c, float v, float) const { LG[(size_t)r * NE + c] = v; } };
struct EpiAct { bf16_t* ACT;
    DEV void operator()(int r, int c, float v, float v2) const { ACT[(size_t)r * EFF + c] = f2bf(silu(v) * v2); } };
struct EpiSlab { bf16_t* SLAB; const int* rl; const float* w;
    DEV void operator()(int r, int c, float v, float) const { const int s = rl[r]; if (s >= 0) SLAB[(size_t)s * DM + c] = f2bf(v * w[s]); } };
struct EpiFinal { float* out; const bf16_t* SLAB; const float* mod;
    DEV void operator()(int r, int c, float v, float) const {
        float s = v;
#pragma unroll
        for (int k = 0; k < 8; ++k) s += bf2f(SLAB[((size_t)r * 8 + k) * DM + c]);
        const size_t i = (size_t)r * DM + c; out[i] = out[i] + mod[(r / SEQ) * NMOD + 5120 + c] * s; } };

DEV void ph_qknorm(const P& p, int bid, int nb) {
    const int tid_ = otid(); const int lane = tid_ & 63, wv = tid_ >> 6;
    const float gq = p.q_norm_g[lane], gk = p.k_norm_g[lane];
    const float invf = exp2f(-(float)(lane & 7) * (1.f / 8.f) * log2f(500000.f));
    for (int t = bid * NWV + wv; t < T; t += nb * NWV) {
        const float ang = (float)p.pos[t] * invf;
        const float cs = cosf(ang), sn = sinf(ang);
        bf16_t* ptr = p.QKV + (size_t)t * 2304 + lane;
        float v[24];
#pragma unroll
        for (int hh = 0; hh < 24; ++hh) v[hh] = bf2f(ptr[hh * 64]);
#pragma unroll
        for (int hh = 0; hh < 24; ++hh) {
            const float ss = wave_sum(v[hh] * v[hh]);
            float nv = v[hh] * rsqrtf(ss * (1.f / 64.f) + 1e-6f) * (hh < 12 ? gq : gk);
            const float partner = __shfl_xor(nv, 8);
            if (lane < 8) nv = nv * cs - partner * sn;
            else if (lane < 16) nv = nv * cs + partner * sn;
            ptr[hh * 64] = f2bf(nv);
        }
    }
}

DEV void ph_pool(const P& p, int bid, int nb) {
    const int tid_ = otid();
    for (int i = bid * NTHR + tid_; i < NB * 32 * 256; i += nb * NTHR) {
        const int cp = i & 255, chunk = (i >> 8) & 31, b = i >> 13;
        const int g = cp >> 6, r = 1 << g;
        const int s0 = chunk * 64;
        const unsigned* up = (const unsigned*)(p.U + (size_t)b * SEQ * 512) + cp;
        unsigned* op = (unsigned*)(p.PL + (size_t)b * SEQ * 512) + cp;
        float a0 = 0.f, a1 = 0.f;
        const int lo0 = max(s0 - r, 0), hi0 = min(s0 + r, SEQ - 1);
        for (int q = lo0; q <= hi0; ++q) { const unsigned w = up[(size_t)q * 256]; a0 += __uint_as_float(w << 16); a1 += __uint_as_float(w & 0xffff0000u); }
#pragma unroll 4
        for (int s = s0; s < s0 + 64; ++s) {
            const int lo = max(s - r, 0), hi = min(s + r, SEQ - 1);
            const float inv = 1.f / (float)(hi - lo + 1);
            const unsigned w = up[(size_t)s * 256];
            op[(size_t)s * 256] = pk2(a0 * inv - __uint_as_float(w << 16), a1 * inv - __uint_as_float(w & 0xffff0000u));
            if (s + 1 + r <= SEQ - 1) { const unsigned wn = up[(size_t)(s + 1 + r) * 256]; a0 += __uint_as_float(wn << 16); a1 += __uint_as_float(wn & 0xffff0000u); }
            if (s - r >= 0) { const unsigned wo = up[(size_t)(s - r) * 256]; a0 -= __uint_as_float(wo << 16); a1 -= __uint_as_float(wo & 0xffff0000u); }
        }
    }
}

DEV void ph_attn(const P& p, int bid, int nb) {
    const int tid_ = otid(); const int lane = tid_ & 63, wv = tid_ >> 6;
    for (int it = bid * NWV + wv; it < T * 4; it += nb * NWV) {
        const int t = it >> 2, slot = it & 3;
        const int s = t & (SEQ - 1), base = t - s;
        float M = -1e30f, l = 0.f, acc = 0.f;
#pragma unroll
        for (int g = 0; g < 3; ++g) {
            const int dsh = 2 * g, d = 1 << dsh, L = SEQ >> dsh;
            const int h = 4 * g + slot;
            const int m = s >> dsh, r = s & (d - 1);
            const float q = bf2f(p.QKV[(size_t)t * 2304 + h * 64 + lane]);
            const bf16_t* kb = p.QKV + 768 + h * 64 + lane;
            const bf16_t* vb = p.QKV + 1536 + h * 64 + lane;
#pragma unroll 4
            for (int rel = -64; rel <= 64; ++rel) {
                const int mm = m + rel;
                const bool valid = (mm >= 0) && (mm < L);
                const int mc = valid ? mm : m;
                const size_t tr = (size_t)(base + mc * d + r) * 2304;
                const float kv = bf2f(kb[tr]), vv = bf2f(vb[tr]);
                const float sc = wave_sum(q * kv) * 0.125f;
                if (valid) {
                    const float mn = fmaxf(M, sc);
                    const float f = __expf(M - mn), pe = __expf(sc - mn);
                    l = l * f + pe; acc = acc * f + pe * vv; M = mn;
                }
            }
        }
        p.O[(size_t)t * 256 + slot * 64 + lane] = f2bf(acc / l);
    }
}

DEV void ph_route(const P& p, int bid, int nb) {
    const int tid_ = otid(); const int lane = tid_ & 63, wv = tid_ >> 6;
    const int G = lane & 7, tl = lane >> 3;
    float bias[32];
#pragma unroll
    for (int j = 0; j < 8; ++j) { const float4 b4 = *(const float4*)(p.router_bias + G * 32 + 4 * j); bias[4 * j] = b4.x; bias[4 * j + 1] = b4.y; bias[4 * j + 2] = b4.z; bias[4 * j + 3] = b4.w; }
    for (int t0 = (bid * NWV + wv) * 8; t0 < T; t0 += nb * NWV * 8) {
        const int t = t0 + tl;
        float sc[32], v[32];
#pragma unroll
        for (int j = 0; j < 8; ++j) { const float4 lg = *(const float4*)(p.LG + (size_t)t * NE + G * 32 + 4 * j);
            sc[4 * j] = 1.f / (1.f + expf(-lg.x)); sc[4 * j + 1] = 1.f / (1.f + expf(-lg.y)); sc[4 * j + 2] = 1.f / (1.f + expf(-lg.z)); sc[4 * j + 3] = 1.f / (1.f + expf(-lg.w)); }
        float m1 = -INFINITY, m2 = -INFINITY;
#pragma unroll
        for (int j = 0; j < 32; ++j) { v[j] = sc[j] + bias[j]; const float n1 = fmaxf(m1, v[j]), n2 = fmaxf(fminf(m1, v[j]), m2); m1 = n1; m2 = n2; }
        const float gs = m1 + m2;
        int rank = 0;
#pragma unroll
        for (int g2 = 0; g2 < 8; ++g2) { const float o = __shfl(gs, (lane & 56) + g2); rank += ((o > gs) || (o == gs && g2 < G)) ? 1 : 0; }
        const bool gsel = rank < 4;
        int myidx = 0; float myw = 0.f, wsum = 0.f;
#pragma unroll 1
        for (int k = 0; k < 8; ++k) {
            float bv = -INFINITY, bs = 0.f; int bi = 0;
#pragma unroll
            for (int j = 0; j < 32; ++j) { const bool tk = gsel && (v[j] > bv); bv = tk ? v[j] : bv; bs = tk ? sc[j] : bs; bi = tk ? j : bi; }
            int gi = G * 32 + bi;
#pragma unroll
            for (int o = 1; o < 8; o <<= 1) {
                const float ov = __shfl_xor(bv, o), os = __shfl_xor(bs, o); const int oi = __shfl_xor(gi, o);
                if ((ov > bv) || (ov == bv && oi < gi)) { bv = ov; gi = oi; bs = os; }
            }
            const int wj = (gi >> 5) == G ? (gi & 31) : -1;
#pragma unroll
            for (int j = 0; j < 32; ++j) v[j] = (j == wj) ? -INFINITY : v[j];
            if (G == k) { myidx = gi; myw = bs; }
            wsum += bs;
        }
        const int slot = t * 8 + G;
        const int pos = atomicAdd(&p.cnt[myidx * 64], 1);
        p.asg_e[slot] = myidx; p.asg_pos[slot] = pos; p.asg_w[slot] = myw / wsum * 2.5f;
    }
}

DEV void load_offsets(const int* cnt, int* off) {
    const int tid = otid();
    __syncthreads();
    if (tid < NE) off[300 + tid] = (cnt[tid * 64] + 255) & ~255;
    __syncthreads();
    if (tid == 0) { int a = 0; for (int e = 0; e < NE; ++e) { off[e] = a; a += off[300 + e]; } off[NE] = a; }
    __syncthreads();
}
DEV int find_expert(const int* off, int m0) {
    int lo = 0, hi = NE;
    while (hi - lo > 1) { const int mid = (lo + hi) >> 1; if (off[mid] <= m0) lo = mid; else hi = mid; }
    return lo;
}

DEV void ph_scatter(const P& p, int* off, int bid, int nb) {
    load_offsets(p.cnt, off);
    const int tid_ = otid();
    for (int slot = bid * NTHR + tid_; slot < NSLOT; slot += nb * NTHR) p.rowlist[off[p.asg_e[slot]] + p.asg_pos[slot]] = slot;
    for (int e = bid; e < NE; e += nb) {
        const int n = p.cnt[e * 64], pd = (n + 255) & ~255;
        for (int i = n + tid_; i < pd; i += NTHR) p.rowlist[off[e] + i] = -1;
    }
}

DEV void ph_expert1(const P& p, float* sm, int* off, int bid, int nb) {
    load_offsets(p.cnt, off);
    const int nrt = off[NE] / 128, nt = nrt * 4;
    for (int t = bid; t < nt; t += nb) {
        const int m0 = (t >> 2) * 128, n0 = (t & 3) * 64, e = find_expert(off, m0);
        ngemm_tile<true>(p.XB, DM, RowTok{p.rowlist}, p.w_eg + (size_t)e * DM * EFF, p.w_eu + (size_t)e * DM * EFF, EFF, m0, n0, DM, EpiAct{p.ACT}, sm);
    }
}
DEV void ph_expert2(const P& p, float* sm, int* off, int bid, int nb) {
    load_offsets(p.cnt, off);
    const int nrt = off[NE] / 128, nt = nrt * 16;
    for (int t = bid; t < nt; t += nb) {
        const int m0 = (t >> 4) * 128, n0 = (t & 15) * 64, e = find_expert(off, m0);
        ngemm_tile<false>(p.ACT, EFF, RowId(), p.w_ed + (size_t)e * EFF * DM, nullptr, DM, m0, n0, EFF, EpiSlab{p.SLAB, p.rowlist, p.asg_w}, sm);
    }
}

namespace mg {
constexpr int BM = 256, BK = 64, HALF = 128, HTB = HALF * BK * 2, STAGE_BYTES = 8 * HTB, NXCD = 8, WGM = 8;
__host__ __device__ __forceinline__ int lds_byte(int r, int c) { const int st = (r >> 4) * 2 + (c >> 5), rr = r & 15, cc = c & 31, ob = rr * 64 + cc * 2; return st * 1024 + (ob ^ (((ob >> 9) & 1) << 5)); }
__host__ __device__ __forceinline__ void stage_rc(int b, int& R, int& C) { const int st = b / 1024, sb = b % 1024, swz = sb ^ (((sb >> 9) & 1) << 5); R = (st >> 1) * 16 + swz / 64; C = (st & 1) * 32 + (swz % 64) / 2; }
__host__ __device__ __forceinline__ int perm32(int rho) { const int n = rho >> 4, i = rho & 15; return 8 * (i >> 2) + 4 * n + (i & 3); }

struct Unit { int pm, pn, e, pad; const char* A; const char* B; };

struct DenseOrder {
    int nM, nN, nwg, G, c; const char* A; const char* B; size_t tstep;
    DEV void init(const bf16_t* A_, const bf16_t* B_, int M, int N, int K, int G_, int c_) { nM = M / BM; nN = N / BM; nwg = nM * nN; G = G_; c = c_; A = (const char*)A_; B = (const char*)B_; tstep = (size_t)BM * K * 2; }
    DEV bool next(int i, Unit& u) const {
        const long L = (long)i * G + c; if (L >= nwg) return false;
        int wgid = (int)L; { const int q = nwg / NXCD, r = nwg % NXCD, xcd = wgid % NXCD, off = wgid / NXCD; wgid = (xcd < r ? xcd * (q + 1) : r * (q + 1) + (xcd - r) * q) + off; }
        const int nig = WGM * nN, gid = wgid / nig, fm = gid * WGM, gsz = (nM - fm) < WGM ? (nM - fm) : WGM;
        u.pm = fm + ((wgid % nig) % gsz); u.pn = (wgid % nig) / gsz; u.e = 0; u.pad = 0;
        u.A = A + (size_t)u.pm * tstep; u.B = B + (size_t)u.pn * tstep; return true;
    }
};
struct ExpertOrder {
    const LAS int* off; int nrt, ncol, G, c; const char* A; const char* W; size_t wstride, tstepB, tstepA; bool gather;
    DEV bool next(int i, Unit& u) const {
        const int L = i * G + c; if (L >= nrt * ncol) return false;
        u.pm = L / ncol; u.pn = L % ncol; u.pad = 0;
        int lo = 0, hi = NE; const int m0 = u.pm * BM;
        while (hi - lo > 1) { const int mid = (lo + hi) >> 1; const int ov = __builtin_amdgcn_readfirstlane(off[mid]); if (ov <= m0) lo = mid; else hi = mid; }
        u.e = lo;
        u.A = gather ? A : A + (size_t)u.pm * tstepA; u.B = W + (size_t)lo * wstride + (size_t)u.pn * tstepB; return true;
    }
};

template <class Epi, class Sched, bool GATHER>
DEV void gemm_phase(LAS unsigned char* lds, const LAS unsigned* gtab, const int K, const Sched& S, const Epi& E) {
    const int tid = otid(), wid = __builtin_amdgcn_readfirstlane(tid >> 6), lane = tid & 63, wr = wid >> 2, wc = wid & 3, fr = lane & 15, fq = lane >> 4;
    const int nt = K / BK;
    int Rr[2], Cc[2]; unsigned voffB[2];
#pragma unroll
    for (int i = 0; i < 2; ++i) { stage_rc(tid * 16 + i * 8192, Rr[i], Cc[i]); const int Rb = Epi::PERM ? ((Rr[i] & ~31) + perm32(Rr[i] & 31)) : Rr[i]; voffB[i] = (unsigned)(Rb * K + Cc[i]) * 2u; }
    const size_t kstep = (size_t)(BK * 2);
    const size_t hstep = (size_t)HALF * K * 2;
    const unsigned ldsw = (unsigned)wid * 1024u;
    const int aoff = lds_byte(wr * 64 + fr, fq * 8), boff = lds_byte(wc * 32 + fr, fq * 8);
#define MG_SA(b, h) (((b) * 2 + (h)) * HTB)
#define MG_SB(b, h) ((4 + (b) * 2 + (h)) * HTB)
#define MG_STAGE(bufoff, gbase, voff) do { _Pragma("unroll") for (int _i = 0; _i < 2; ++_i) \
        __builtin_amdgcn_global_load_lds((const unsigned*)((const char*)(gbase) + (voff)[_i]), (LAS unsigned*)(lds + (bufoff) + ldsw + _i * 8192), 16, 0, 0); } while (0)
#define MG_LDA(dst, b, h) do { _Pragma("unroll") for (int m = 0; m < 4; ++m) _Pragma("unroll") for (int k = 0; k < 2; ++k) dst[m][k] = *(const LAS bf16x8*)(lds + MG_SA(b, h) + aoff + m * 2048 + k * 1024); } while (0)
#define MG_LDB(dst, b, h) do { _Pragma("unroll") for (int n = 0; n < 2; ++n) _Pragma("unroll") for (int k = 0; k < 2; ++k) dst[n][k] = *(const LAS bf16x8*)(lds + MG_SB(b, h) + boff + n * 2048 + k * 1024); } while (0)
#define MG_MMA(ai, bj, At, Bt) do { __builtin_amdgcn_s_setprio(1); _Pragma("unroll") for (int m = 0; m < 4; ++m) _Pragma("unroll") for (int n = 0; n < 2; ++n) _Pragma("unroll") for (int k = 0; k < 2; ++k) \
        acc[ai][bj][m][n] = __builtin_amdgcn_mfma_f32_16x16x32_bf16(Bt[n][k], At[m][k], acc[ai][bj][m][n], 0, 0, 0); __builtin_amdgcn_s_setprio(0); } while (0)
#define MG_WAIT_V(n) asm volatile("s_waitcnt vmcnt(" #n ")" ::: "memory")
#define MG_WAIT_L(n) asm volatile("s_waitcnt lgkmcnt(" #n ")" ::: "memory")
#define MG_BAR __builtin_amdgcn_s_barrier()
#define MG_SCHED __builtin_amdgcn_sched_barrier(0)
    Unit cur, nxt; int ui = 0;
    if (!S.next(0, cur)) return;
    f32x4 acc[2][2][4][2];
#pragma unroll
    for (int a = 0; a < 2; ++a)
#pragma unroll
        for (int b = 0; b < 2; ++b)
#pragma unroll
            for (int m = 0; m < 4; ++m)
#pragma unroll
                for (int n = 0; n < 2; ++n) acc[a][b][m][n] = (f32x4){0.f, 0.f, 0.f, 0.f};
    bf16x8 At[4][2], B0[2][2], B1[2][2];
    unsigned va0[2], va1[2], na0[2], na1[2];
#pragma unroll
    for (int i = 0; i < 2; ++i) {
        if (GATHER) { va0[i] = gtab[Rr[i]] + (unsigned)Cc[i] * 2u; va1[i] = gtab[HALF + Rr[i]] + (unsigned)Cc[i] * 2u; }
        else { va0[i] = (unsigned)(Rr[i] * K + Cc[i]) * 2u; va1[i] = va0[i] + (unsigned)hstep; }
        na0[i] = va0[i]; na1[i] = va1[i];
    }
    const char* cA = cur.A; const char* cB = cur.B;
    MG_STAGE(MG_SB(0, 0), cB, voffB); MG_STAGE(MG_SB(0, 1), cB + hstep, voffB); MG_STAGE(MG_SA(0, 0), cA, va0); MG_STAGE(MG_SA(0, 1), cA, va1);
    if (wr == 1) MG_BAR;
    MG_WAIT_V(2); MG_BAR;
    MG_STAGE(MG_SB(1, 0), cB + kstep, voffB); MG_STAGE(MG_SA(1, 0), cA + kstep, va0); MG_STAGE(MG_SB(1, 1), cB + hstep + kstep, voffB);
    MG_WAIT_V(6); MG_BAR;
    for (;;) {
        const bool has_next = S.next(ui + 1, nxt);
        const char* nA = has_next ? nxt.A : cA; const char* nB = has_next ? nxt.B : cB;
        if (GATHER) {
            if (has_next) {
#pragma unroll
                for (int i = 0; i < 2; ++i) { na0[i] = gtab[(ui + 1) * BM + Rr[i]] + (unsigned)Cc[i] * 2u; na1[i] = gtab[(ui + 1) * BM + HALF + Rr[i]] + (unsigned)Cc[i] * 2u; }
            }
        }
#pragma unroll 1
        for (int t = 0; t < nt; t += 2) {
            const bool last = (t == nt - 2);
            const char* a1 = cA + (size_t)(t + 1) * kstep;
            const char* a2 = last ? nA : cA + (size_t)(t + 2) * kstep; const char* b2 = last ? nB : cB + (size_t)(t + 2) * kstep;
            const char* a3 = a2 + kstep; const char* b3 = b2 + kstep;
            unsigned o0[2], o1[2];
#pragma unroll
            for (int i = 0; i < 2; ++i) { o0[i] = (GATHER && last) ? na0[i] : va0[i]; o1[i] = (GATHER && last) ? na1[i] : va1[i]; }
            MG_LDB(B0, 0, 0); MG_LDB(B1, 0, 1); MG_SCHED; MG_LDA(At, 0, 0); MG_STAGE(MG_SA(1, 1), a1, va1);
            MG_WAIT_V(8); MG_WAIT_L(0); MG_BAR; MG_MMA(0, 0, At, B0); MG_MMA(0, 1, At, B1); MG_BAR; MG_SCHED;
            MG_LDA(At, 0, 1); MG_STAGE(MG_SB(0, 0), b2, voffB); MG_STAGE(MG_SB(0, 1), b2 + hstep, voffB); MG_STAGE(MG_SA(0, 0), a2, o0);
            MG_WAIT_V(8); MG_WAIT_L(0); MG_BAR; MG_MMA(1, 0, At, B0); MG_MMA(1, 1, At, B1); MG_BAR; MG_SCHED;
            MG_LDB(B0, 1, 0); MG_LDB(B1, 1, 1); MG_SCHED; MG_LDA(At, 1, 0); MG_STAGE(MG_SA(0, 1), a2, o1);
            MG_WAIT_V(8); MG_WAIT_L(0); MG_BAR; MG_MMA(0, 0, At, B0); MG_MMA(0, 1, At, B1); MG_BAR; MG_SCHED;
            MG_LDA(At, 1, 1); MG_STAGE(MG_SB(1, 0), b3, voffB); MG_STAGE(MG_SB(1, 1), b3 + hstep, voffB); MG_STAGE(MG_SA(1, 0), a3, o0);
            MG_WAIT_V(8); MG_WAIT_L(0); MG_BAR; MG_MMA(1, 0, At, B0); MG_MMA(1, 1, At, B1); MG_BAR; MG_SCHED;
        }
        if (wr == 0) MG_BAR;
        E(acc, cur, wr, wc, fr, fq);
        if (!has_next) break;
#pragma unroll
        for (int a = 0; a < 2; ++a)
#pragma unroll
            for (int b = 0; b < 2; ++b)
#pragma unroll
                for (int m = 0; m < 4; ++m)
#pragma unroll
                    for (int n = 0; n < 2; ++n) acc[a][b][m][n] = (f32x4){0.f, 0.f, 0.f, 0.f};
        cur = nxt; cA = nA; cB = nB; ++ui;
#pragma unroll
        for (int i = 0; i < 2; ++i) { va0[i] = na0[i]; va1[i] = na1[i]; }
        if (wr == 1) MG_BAR;
    }
    MG_WAIT_V(0);
    MG_BAR;
    __syncthreads();
#undef MG_SA
#undef MG_SB
#undef MG_STAGE
#undef MG_LDA
#undef MG_LDB
#undef MG_MMA
#undef MG_WAIT_V
#undef MG_WAIT_L
#undef MG_BAR
#undef MG_SCHED
}

DEV u32x4 pack8(const f32x4 a, const f32x4 b) { u32x4 w; w.x = pk2(a[0], a[1]); w.y = pk2(a[2], a[3]); w.z = pk2(b[0], b[1]); w.w = pk2(b[2], b[3]); return w; }
DEV f32x4 unpack_lo(const u32x4 w) { return (f32x4){__uint_as_float(w.x << 16), __uint_as_float(w.x & 0xffff0000u), __uint_as_float(w.y << 16), __uint_as_float(w.y & 0xffff0000u)}; }
DEV f32x4 unpack_hi(const u32x4 w) { return (f32x4){__uint_as_float(w.z << 16), __uint_as_float(w.z & 0xffff0000u), __uint_as_float(w.w << 16), __uint_as_float(w.w & 0xffff0000u)}; }
DEV f32x4 sig4(const f32x4 v) { return (f32x4){sigm(v[0]), sigm(v[1]), sigm(v[2]), sigm(v[3])}; }
DEV f32x4 silu4(const f32x4 v) { return (f32x4){silu(v[0]), silu(v[1]), silu(v[2]), silu(v[3])}; }
#define ACC_T const f32x4 (&acc)[2][2][4][2]

struct MEpiInProj { static constexpr bool PERM = true; bf16_t *U, *QKV, *G;
    DEV void operator()(ACC_T, const Unit& u, int wr, int wc, int fr, int fq) const {
        int colt = u.pn * BM; bf16_t* base; int ld; bool sg = false;
        if (colt < 512) { base = U; ld = 512; } else if (colt < 2816) { base = QKV; ld = 2304; colt -= 512; } else { base = G; ld = 2048; colt -= 2816; sg = true; }
        const int row0 = u.pm * BM + wr * 64 + fr, col0 = colt + wc * 32 + 8 * fq;
#pragma unroll
        for (int ai = 0; ai < 2; ++ai)
#pragma unroll
            for (int m = 0; m < 4; ++m) { bf16_t* rowp = base + (size_t)(row0 + ai * HALF + m * 16) * ld + col0;
#pragma unroll
                for (int bj = 0; bj < 2; ++bj) { f32x4 v0 = acc[ai][bj][m][0], v1 = acc[ai][bj][m][1]; if (sg) { v0 = sig4(v0); v1 = sig4(v1); }
                    *(u32x4*)(rowp + bj * HALF) = pack8(v0, v1); }
                asm volatile("" ::: "memory"); }
    } };
template <bool SECOND> struct MEpiMerge { static constexpr bool PERM = true; bf16_t* MG; const bf16_t* G;
    DEV void operator()(ACC_T, const Unit& u, int wr, int wc, int fr, int fq) const {
        const int row0 = u.pm * BM + wr * 64 + fr, col0 = u.pn * BM + wc * 32 + 8 * fq;
#pragma unroll
        for (int ai = 0; ai < 2; ++ai)
#pragma unroll
            for (int m = 0; m < 4; ++m) { const size_t r = (size_t)(row0 + ai * HALF + m * 16);
#pragma unroll
                for (int bj = 0; bj < 2; ++bj) { const int c = col0 + bj * HALF;
                    const u32x4 gw = *(const u32x4*)(G + r * 2048 + (SECOND ? 1024 : 0) + c);
                    f32x4 v0 = acc[ai][bj][m][0] * unpack_lo(gw), v1 = acc[ai][bj][m][1] * unpack_hi(gw);
                    if (SECOND) { const u32x4 pw = *(const u32x4*)(MG + r * DM + c); v0 += unpack_lo(pw); v1 += unpack_hi(pw); }
                    *(u32x4*)(MG + r * DM + c) = pack8(v0, v1); }
                asm volatile("" ::: "memory"); }
    } };
struct MEpiOutProj { static constexpr bool PERM = false; const float* x; float* out; const float* mod;
    DEV void operator()(ACC_T, const Unit& u, int wr, int wc, int fr, int fq) const {
        const int row0 = u.pm * BM + wr * 64 + fr, col0 = u.pn * BM + wc * 32 + 4 * fq;
        const float* gm = mod + ((u.pm * BM) / SEQ) * NMOD + 2048;
#pragma unroll
        for (int ai = 0; ai < 2; ++ai)
#pragma unroll
            for (int m = 0; m < 4; ++m) { const size_t r = (size_t)(row0 + ai * HALF + m * 16) * DM;
#pragma unroll
                for (int bj = 0; bj < 2; ++bj)
#pragma unroll
                    for (int n = 0; n < 2; ++n) { const int c = col0 + bj * HALF + n * 16;
                        *(f32x4*)(out + r + c) = *(const f32x4*)(x + r + c) + *(const f32x4*)(gm + c) * acc[ai][bj][m][n]; }
                asm volatile("" ::: "memory"); }
    } };
struct MEpiRouterShared { static constexpr bool PERM = true; float* LG; bf16_t* HS;
    DEV void operator()(ACC_T, const Unit& u, int wr, int wc, int fr, int fq) const {
        const int row0 = u.pm * BM + wr * 64 + fr, cw = wc * 32 + 8 * fq;
#pragma unroll
        for (int ai = 0; ai < 2; ++ai)
#pragma unroll
            for (int m = 0; m < 4; ++m) { const size_t r = (size_t)(row0 + ai * HALF + m * 16);
                if (u.pn == 0) {
#pragma unroll
                    for (int bj = 0; bj < 2; ++bj)
#pragma unroll
                        for (int n = 0; n < 2; ++n) *(f32x4*)(LG + r * NE + bj * HALF + cw + 4 * n) = acc[ai][bj][m][n];
                } else {
                    const f32x4 v0 = silu4(acc[ai][0][m][0]) * acc[ai][1][m][0], v1 = silu4(acc[ai][0][m][1]) * acc[ai][1][m][1];
                    *(u32x4*)(HS + r * EFF + (u.pn - 1) * HALF + cw) = pack8(v0, v1);
                }
                asm volatile("" ::: "memory"); }
    } };
struct MEpiAct { static constexpr bool PERM = true; bf16_t* ACT;
    DEV void operator()(ACC_T, const Unit& u, int wr, int wc, int fr, int fq) const {
        const int row0 = u.pm * BM + wr * 64 + fr, cw = u.pn * HALF + wc * 32 + 8 * fq;
#pragma unroll
        for (int ai = 0; ai < 2; ++ai)
#pragma unroll
            for (int m = 0; m < 4; ++m) { const size_t r = (size_t)(row0 + ai * HALF + m * 16);
                const f32x4 v0 = silu4(acc[ai][0][m][0]) * acc[ai][1][m][0], v1 = silu4(acc[ai][0][m][1]) * acc[ai][1][m][1];
                *(u32x4*)(ACT + r * EFF + cw) = pack8(v0, v1); asm volatile("" ::: "memory"); }
    } };
struct MEpiSlab { static constexpr bool PERM = true; bf16_t* SLAB; const int* rl; const float* w;
    DEV void operator()(ACC_T, const Unit& u, int wr, int wc, int fr, int fq) const {
        const int row0 = u.pm * BM + wr * 64 + fr, col0 = u.pn * BM + wc * 32 + 8 * fq;
#pragma unroll
        for (int ai = 0; ai < 2; ++ai)
#pragma unroll
            for (int m = 0; m < 4; ++m) { const int s = rl[row0 + ai * HALF + m * 16];
                if (s >= 0) { const float g = w[s];
#pragma unroll
                    for (int bj = 0; bj < 2; ++bj) *(u32x4*)(SLAB + (size_t)s * DM + col0 + bj * HALF) = pack8(acc[ai][bj][m][0] * g, acc[ai][bj][m][1] * g); }
                asm volatile("" ::: "memory"); }
    } };
struct MEpiFinal { static constexpr bool PERM = false; float* out; const bf16_t* SLAB; const float* mod;
    DEV void operator()(ACC_T, const Unit& u, int wr, int wc, int fr, int fq) const {
        const int row0 = u.pm * BM + wr * 64 + fr, col0 = u.pn * BM + wc * 32 + 4 * fq;
        const float* gm = mod + ((u.pm * BM) / SEQ) * NMOD + 5120;
#pragma unroll
        for (int ai = 0; ai < 2; ++ai)
#pragma unroll
            for (int m = 0; m < 4; ++m) { const size_t row = (size_t)(row0 + ai * HALF + m * 16);
#pragma unroll
                for (int bj = 0; bj < 2; ++bj)
#pragma unroll
                    for (int n = 0; n < 2; ++n) { const int c = col0 + bj * HALF + n * 16; f32x4 sacc = acc[ai][bj][m][n];
#pragma unroll
                        for (int k = 0; k < 8; ++k) { const u32x2 sw = *(const u32x2*)(SLAB + (row * 8 + k) * DM + c);
                            sacc += (f32x4){__uint_as_float(sw.x << 16), __uint_as_float(sw.x & 0xffff0000u), __uint_as_float(sw.y << 16), __uint_as_float(sw.y & 0xffff0000u)}; }
                        float* op = out + row * DM + c; *(f32x4*)op = *(const f32x4*)op + *(const f32x4*)(gm + c) * sacc; asm volatile("" ::: "memory"); } }
    } };
#undef ACC_T
}

typedef float f32x16 __attribute__((ext_vector_type(16)));
typedef short s16x4 __attribute__((ext_vector_type(4)));
DEV int crow(int r, int hi) { return (r & 3) + 8 * (r >> 2) + 4 * hi; }
DEV unsigned cvtpk(float lo, float hi) { unsigned r; asm("v_cvt_pk_bf16_f32 %0, %1, %2" : "=v"(r) : "v"(lo), "v"(hi)); return r; }
DEV s16x4 vtr(const LAS unsigned char* p) { return __builtin_bit_cast(s16x4, __builtin_amdgcn_ds_read_tr16_b64_v4i16((LAS s16x4*)p)); }
DEV float swap32(float v) { return __shfl_xor(v, 32); }

DEV void normrope_frag(bf16x8 (&f)[4], const LAS float* gt, int hi, float posf) {
    float x[32]; float ss = 0.f;
#pragma unroll
    for (int d0 = 0; d0 < 4; ++d0) { const u32x4 w = __builtin_bit_cast(u32x4, f[d0]);
        x[8 * d0 + 0] = __uint_as_float(w.x << 16); x[8 * d0 + 1] = __uint_as_float(w.x & 0xffff0000u); x[8 * d0 + 2] = __uint_as_float(w.y << 16); x[8 * d0 + 3] = __uint_as_float(w.y & 0xffff0000u);
        x[8 * d0 + 4] = __uint_as_float(w.z << 16); x[8 * d0 + 5] = __uint_as_float(w.z & 0xffff0000u); x[8 * d0 + 6] = __uint_as_float(w.w << 16); x[8 * d0 + 7] = __uint_as_float(w.w & 0xffff0000u); }
#pragma unroll
    for (int i = 0; i < 32; ++i) ss += x[i] * x[i];
    ss += __shfl_xor(ss, 32);
    const float rs = rsqrtf(ss * (1.f / 64.f) + 1e-6f);
#pragma unroll
    for (int d0 = 0; d0 < 4; ++d0) { const f32x4 g0 = *(const LAS f32x4*)(gt + 16 * d0 + 8 * hi), g1 = *(const LAS f32x4*)(gt + 16 * d0 + 8 * hi + 4);
#pragma unroll
        for (int j = 0; j < 4; ++j) { x[8 * d0 + j] *= rs * g0[j]; x[8 * d0 + 4 + j] *= rs * g1[j]; } }
    constexpr float INVF[8] = {1.0f, 0.19392274474868576f, 0.03760603093086393f, 0.007292664737217109f, 0.001414213562373095f, 0.0002742481756762073f, 5.318295896944988e-05f, 1.031338537721246e-05f};
#pragma unroll
    for (int i = 0; i < 8; ++i) {
        const float rev = posf * (INVF[i] * 0.15915494309189535f);
        const float fr = rev - floorf(rev);
        const float cs = __builtin_amdgcn_cosf(fr), sn = __builtin_amdgcn_sinf(fr);
        const float partner = __shfl_xor(x[i], 32);
        x[i] = hi ? (x[i] * cs + partner * sn) : (x[i] * cs - partner * sn);
    }
#pragma unroll
    for (int d0 = 0; d0 < 4; ++d0) { u32x4 w; w.x = cvtpk(x[8 * d0], x[8 * d0 + 1]); w.y = cvtpk(x[8 * d0 + 2], x[8 * d0 + 3]); w.z = cvtpk(x[8 * d0 + 4], x[8 * d0 + 5]); w.w = cvtpk(x[8 * d0 + 6], x[8 * d0 + 7]);
        f[d0] = __builtin_bit_cast(bf16x8, w); }
}

DEV void ph_attn_mfma(const P& p, LAS unsigned char* lds, int bid, int nb) {
    const int tid = otid(); const int lane = tid & 63, wid = __builtin_amdgcn_readfirstlane(tid >> 6), r32 = lane & 31, hi = lane >> 5;
    LAS unsigned char* vl = lds + wid * 8192;
    LAS float* wsf = (LAS float*)(lds + wid * 8192 + 4096);
    LAS float* gtab_q = (LAS float*)(lds + wid * 8192 + 4352);
    LAS float* gtab_k = gtab_q + 64;
    gtab_q[lane] = p.q_norm_g[lane]; gtab_k[lane] = p.k_norm_g[lane];
    asm volatile("s_waitcnt lgkmcnt(0)" ::: "memory");
    float gq = fabsf(p.q_norm_g[lane]), gk = fabsf(p.k_norm_g[lane]);
#pragma unroll
    for (int o = 32; o >= 1; o >>= 1) { gq = fmaxf(gq, __shfl_xor(gq, o)); gk = fmaxf(gk, __shfl_xor(gk, o)); }
    constexpr float LOG2E = 1.4426950408889634f, C2 = 0.125f * LOG2E;
    const float nmref = -(8.f * gq * gk * LOG2E);
    const int head = wid >> 1, qh = wid & 1;
    const int tq = (lane & 15) >> 2, tp = lane & 3, tcb = (lane >> 4) & 1;
    const LAS unsigned char* vrd = vl + (4 * hi + tq) * 128 + (16 * tcb + 4 * tp) * 2;
    for (int it = bid; it < NB * 96; it += nb) {
        const int cb = it & 31, g = (it >> 5) % 3, b = it / 96;
        const int dsh = 2 * g, d = 1 << dsh, L = SEQ >> dsh, nbk = L >> 6;
        const int r = cb / nbk, blk = cb % nbk;
        const int h = 4 * g + head, base = b * SEQ;
        const int q0 = 64 * blk + 32 * qh;
        const int mq = q0 + r32;
        const bf16_t* qp = p.QKV + (size_t)(base + mq * d + r) * 2304 + h * 64 + hi * 8;
        bf16x8 qr[4];
#pragma unroll
        for (int d0 = 0; d0 < 4; ++d0) qr[d0] = *(const bf16x8*)(qp + d0 * 16);
        normrope_frag(qr, gtab_q, hi, (float)p.pos[base + mq * d + r]);
        f32x16 o0, o1;
#pragma unroll
        for (int i = 0; i < 16; ++i) { o0[i] = 0.f; o1[i] = 0.f; }
        float lsum = 0.f;
        const int kb0 = q0 - 64;
#pragma unroll 1
        for (int st = 0; st < 5; ++st) {
            const int k0 = kb0 + 32 * st;
            if (k0 + 31 < 0 || k0 >= L) continue;
            const int mkc = min(max(k0 + r32, 0), L - 1);
            const bf16_t* kp = p.QKV + (size_t)(base + mkc * d + r) * 2304 + 768 + h * 64 + hi * 8;
            bf16x8 kf[4];
#pragma unroll
            for (int d0 = 0; d0 < 4; ++d0) kf[d0] = *(const bf16x8*)(kp + d0 * 16);
            const float kposf = (float)p.pos[base + mkc * d + r];
            u32x4 vreg[4];
#pragma unroll
            for (int i = 0; i < 4; ++i) { const int c = lane + 64 * i, row = c >> 3, ch = c & 7; const int mv = min(max(k0 + row, 0), L - 1);
                vreg[i] = *(const u32x4*)(p.QKV + (size_t)(base + mv * d + r) * 2304 + 1536 + h * 64 + ch * 8); }
            normrope_frag(kf, gtab_k, hi, kposf);
            f32x16 s;
#pragma unroll
            for (int i = 0; i < 16; ++i) s[i] = 0.f;
#pragma unroll
            for (int d0 = 0; d0 < 4; ++d0) s = __builtin_amdgcn_mfma_f32_32x32x16_bf16(kf[d0], qr[d0], s, 0, 0, 0);
#pragma unroll
            for (int i = 0; i < 16; ++i) { const int key = k0 + crow(i, hi); const int df = key - mq;
                const bool valid = (key >= 0) && (key < L) && (df <= 64) && (df >= -64);
                const float pv = valid ? __builtin_amdgcn_exp2f(__builtin_fmaf(s[i], C2, nmref)) : 0.f; lsum += pv; s[i] = pv; }
            bf16x8 pf0, pf1;
            { u32x4 w0, w1; w0.x = cvtpk(s[0], s[1]); w0.y = cvtpk(s[2], s[3]); w0.z = cvtpk(s[4], s[5]); w0.w = cvtpk(s[6], s[7]);
              w1.x = cvtpk(s[8], s[9]); w1.y = cvtpk(s[10], s[11]); w1.z = cvtpk(s[12], s[13]); w1.w = cvtpk(s[14], s[15]);
              pf0 = __builtin_bit_cast(bf16x8, w0); pf1 = __builtin_bit_cast(bf16x8, w1); }
#pragma unroll
            for (int i = 0; i < 4; ++i) { const int c = lane + 64 * i, row = c >> 3, ch = c & 7; *(LAS u32x4*)(vl + row * 128 + ch * 16) = vreg[i]; }
            asm volatile("s_waitcnt lgkmcnt(0)" ::: "memory");
#pragma unroll
            for (int n = 0; n < 2; ++n)
#pragma unroll
                for (int ks = 0; ks < 2; ++ks) {
                    const s16x4 lo = vtr(vrd + (16 * ks) * 128 + 64 * n), hi4 = vtr(vrd + (16 * ks + 8) * 128 + 64 * n);
                    bf16x8 vf; vf[0] = lo[0]; vf[1] = lo[1]; vf[2] = lo[2]; vf[3] = lo[3]; vf[4] = hi4[0]; vf[5] = hi4[1]; vf[6] = hi4[2]; vf[7] = hi4[3];
                    if (n == 0) o0 = __builtin_amdgcn_mfma_f32_32x32x16_bf16(ks == 0 ? pf0 : pf1, vf, o0, 0, 0, 0);
                    else o1 = __builtin_amdgcn_mfma_f32_32x32x16_bf16(ks == 0 ? pf0 : pf1, vf, o1, 0, 0, 0);
                }
            asm volatile("s_waitcnt lgkmcnt(0)" ::: "memory");
        }
        const float lt = lsum + swap32(lsum);
        if (hi == 0) { wsf[r32] = 1.f / lt; p.LSUM[((size_t)g * T + (base + mq * d + r)) * 4 + head] = lt; }
        asm volatile("s_waitcnt lgkmcnt(0)" ::: "memory");
        bf16_t* og = p.OG + (size_t)g * T * 256 + head * 64 + r32;
#pragma unroll
        for (int i = 0; i < 16; ++i) { const int qq = crow(i, hi); const float inv = wsf[qq]; const size_t tok = (size_t)(base + (q0 + qq) * d + r);
            og[tok * 256] = f2bf(o0[i] * inv); og[tok * 256 + 32] = f2bf(o1[i] * inv); }
        asm volatile("s_waitcnt lgkmcnt(0)" ::: "memory");
    }
}
DEV void ph_attn_combine(const P& p, int bid, int nb) {
    const int tid_ = otid();
    for (int i = bid * NTHR + tid_; i < T * 32; i += nb * NTHR) {
        const int t = i >> 5, ch = i & 31, slot = ch >> 3;
        const float l0 = p.LSUM[(size_t)t * 4 + slot], l1 = p.LSUM[((size_t)T + t) * 4 + slot], l2 = p.LSUM[((size_t)2 * T + t) * 4 + slot];
        const float inv = 1.f / (l0 + l1 + l2);
        const u32x4 a = *(const u32x4*)(p.OG + (size_t)t * 256 + ch * 8), b = *(const u32x4*)(p.OG + ((size_t)T + t) * 256 + ch * 8), c = *(const u32x4*)(p.OG + ((size_t)2 * T + t) * 256 + ch * 8);
        const f32x4 lo = (mg::unpack_lo(a) * l0 + mg::unpack_lo(b) * l1 + mg::unpack_lo(c) * l2) * inv;
        const f32x4 hi = (mg::unpack_hi(a) * l0 + mg::unpack_hi(b) * l1 + mg::unpack_hi(c) * l2) * inv;
        *(u32x4*)(p.O + (size_t)t * 256 + ch * 8) = mg::pack8(lo, hi);
    }
}

template <class Src>
DEV void transpose_blk(const Src& src, int K, bf16_t* WT0, LAS float* scr, int k0, int lane) {
#pragma unroll 8
    for (int i = 0; i < 32; ++i) { const int kk = 2 * i + (lane >> 5); scr[kk * 33 + (lane & 31)] = src(k0 + kk, lane & 31); }
    asm volatile("s_waitcnt lgkmcnt(0)" ::: "memory");
    const int c = lane & 7;
#pragma unroll
    for (int j = 0; j < 4; ++j) { const int n = (lane >> 3) + 8 * j; const LAS float* s = scr + (8 * c) * 33 + n;
        u32x4 o; o.x = pk2(s[0 * 33], s[1 * 33]); o.y = pk2(s[2 * 33], s[3 * 33]); o.z = pk2(s[4 * 33], s[5 * 33]); o.w = pk2(s[6 * 33], s[7 * 33]);
        *(u32x4*)(WT0 + (size_t)n * K + k0 + 8 * c) = o; }
    asm volatile("s_waitcnt lgkmcnt(0)" ::: "memory");
}
struct SrcCol { const float* W; int ld; DEV float operator()(int k, int j) const { return W[(size_t)k * ld + j]; } };
struct SrcEff { const float *wg, *ls, *wu;
    DEV float operator()(int k, int j) const { const int g = k >> 7; const float* a = wg + (size_t)k * 128; const float* l = ls + g * 128; const float* b = wu + (size_t)(g * 128) * DM + j; float s = 0.f;
#pragma unroll 4
        for (int d = 0; d < 128; ++d) s += a[d] * l[d] * b[(size_t)d * DM]; return s; } };
DEV void tr_plain(const float* W, int K, int N, bf16_t* WT, LAS float* scr, int item, int lane) {
    const int nblk = N / 32, k0 = 64 * (item / nblk), n0 = 32 * (item % nblk);
    transpose_blk(SrcCol{W + n0, N}, K, WT + (size_t)n0 * K, scr, k0, lane);
}
DEV void tr_gu(const float* g, const float* u, int K, bf16_t* WT, LAS float* scr, int k0, int rho0, int lane) {
    const int ch0 = (rho0 >> 8) * 128 + (rho0 & 127);
    const float* m = (rho0 & 128) ? u : g;
    transpose_blk(SrcCol{m + ch0, EFF}, K, WT + (size_t)rho0 * K, scr, k0, lane);
}

DEV void ph_prep_small(const P& p, LAS float* scr, int gw, int ngw, int lane) {
    constexpr int I_IN = 16 * (INW / 32), I_EFF = 64 * 16, I_AU = 4 * 32, I_OUT = 16 * 32, I_R = 16 * 8, I_S = 16 * 16, I_SD = 4 * 32;
    constexpr int NIT = I_IN + I_EFF + I_AU + I_OUT + I_R + I_S + I_SD;
    for (int it = gw; it < NIT; it += ngw) {
        int r = it;
        if (r < I_IN) { tr_plain(p.w_in, DM, INW, p.WT_IN, scr, r, lane); continue; } r -= I_IN;
        if (r < I_EFF) {
            const int n = 64 * (r & 15) + lane, k0 = 8 * (r >> 4), g = k0 >> 7;
            const float* a = p.pool_w_grp + (size_t)k0 * 128; const float* l = p.pool_scale + g * 128; const float* b = p.w_pool_up + (size_t)(g * 128) * DM + n;
            float acc[8];
#pragma unroll
            for (int j = 0; j < 8; ++j) acc[j] = 0.f;
#pragma unroll 4
            for (int d = 0; d < 128; ++d) { const float bl = b[(size_t)d * DM] * l[d];
#pragma unroll
                for (int j = 0; j < 8; ++j) acc[j] += a[j * 128 + d] * bl; }
            u32x4 o; o.x = pk2(acc[0], acc[1]); o.y = pk2(acc[2], acc[3]); o.z = pk2(acc[4], acc[5]); o.w = pk2(acc[6], acc[7]);
            *(u32x4*)(p.WT_EFF + (size_t)n * 512 + k0) = o; continue; } r -= I_EFF;
        if (r < I_AU) { tr_plain(p.w_attn_up, 256, DM, p.WT_AU, scr, r, lane); continue; } r -= I_AU;
        if (r < I_OUT) { tr_plain(p.w_out, DM, DM, p.WT_OUT, scr, r, lane); continue; } r -= I_OUT;
        if (r < I_R) { tr_plain(p.w_router, DM, NE, p.WT_RS, scr, r, lane); continue; } r -= I_R;
        if (r < I_S) { tr_gu(p.w_sg, p.w_su, DM, p.WT_RS + (size_t)256 * DM, scr, 64 * (r / 16), 32 * (r % 16), lane); continue; } r -= I_S;
        tr_plain(p.w_sd, EFF, DM, p.WT_SD, scr, r, lane);
    }
}
DEV void ph_prep_ed(const P& p, LAS float* scr, int gw, int ngw, int lane) {
    constexpr int IPE = 4 * 32;
    for (int it = gw; it < NE * IPE; it += ngw) { const int e = it / IPE;
        tr_plain(p.w_ed + (size_t)e * EFF * DM, EFF, DM, p.WT_ED + (size_t)e * DM * EFF, scr, it % IPE, lane); }
}
DEV void ph_prep_egu(const P& p, LAS float* scr, int gw, int ngw, int lane) {
    constexpr int IPE = 16 * 16;
    for (int it = gw; it < NE * IPE; it += ngw) { const int e = it / IPE, r = it % IPE;
        tr_gu(p.w_eg + (size_t)e * DM * EFF, p.w_eu + (size_t)e * DM * EFF, DM, p.WT_EGU + (size_t)e * 512 * DM, scr, 64 * (r / 16), 32 * (r % 16), lane); }
}

constexpr int LDS_BYTES = 147456;
constexpr int LDS_OFF_TAB = 131072;
constexpr int LDS_GTAB = 131072 + 2560;
constexpr int MAXU = 10;
constexpr int LDS_MISC = LDS_GTAB + MAXU * 1024;

DEV void fill_gtab(const P& p, const LAS int* off, LAS unsigned* gtab, int ncol, int bid, int nb) {
    const int nrt = off[NE] / 256, tot = nrt * ncol; const int tid_ = otid();
    for (int i = 0; i < MAXU; ++i) { const int L = i * nb + bid; if (L >= tot) break;
        const int pm = L / ncol;
        if (tid_ < 256) { const int s = p.rowlist[pm * 256 + tid_]; gtab[i * 256 + tid_] = (unsigned)(s < 0 ? 0 : (s >> 3)) * (unsigned)(DM * 2); } }
    __syncthreads();
}


#define GAS __attribute__((address_space(1)))
#define XB_TMO      128
#define XB_XCNT(j)  (256  + 64 * (j))
#define XB_XSUB(j)  (1280 + 64 * (j))
#define XB_XGEN(j)  (2304 + 64 * (j))
#define XB_TOP      3328
#define XB_TOPGEN   3392
#define XCD_BAR_WORDS 3456
#define XB_SPIN_CAP (1u << 18)
DEV unsigned xb_ld(unsigned* p)              { return __hip_atomic_load(p, __ATOMIC_RELAXED, __HIP_MEMORY_SCOPE_AGENT); }
DEV unsigned xb_add(unsigned* p, unsigned v) { return __hip_atomic_fetch_add(p, v, __ATOMIC_RELAXED, __HIP_MEMORY_SCOPE_AGENT); }
DEV unsigned xb_xcc_id() { return (unsigned)__builtin_amdgcn_s_getreg((3 << 11) | 20) & 0xFu; }
#define XB_SPIN(cond, bar) do { unsigned _sp = 0; while (cond) { __builtin_amdgcn_s_sleep(1); \
    if ((++_sp & 255u) == 0u) { if (xb_ld(&(bar)[XB_TMO])) break; if (_sp > XB_SPIN_CAP) { atomicAdd(&(bar)[XB_TMO], 1u); break; } } } } while (0)
struct XcdBarrier { unsigned* bar; unsigned x; volatile LAS unsigned* st; };
DEV XcdBarrier xcd_barrier_post(unsigned* bar, volatile LAS unsigned* st) {
    XcdBarrier b; b.bar = bar; b.x = xb_xcc_id(); b.st = st;
    if (threadIdx.x == 0) (void)xb_add(&bar[XB_XCNT(b.x)], 1u);
    return b;
}
DEV void xcd_barrier_complete(unsigned* bar, unsigned x, unsigned& nloc, unsigned& nx) {
    const unsigned G = gridDim.x * gridDim.y * gridDim.z;
    unsigned sum, cnt, mine, sp = 0u;
    for (;;) {
        sum = 0u; cnt = 0u; mine = 0u;
#pragma unroll
        for (unsigned j = 0; j < 16; ++j) { const unsigned c = xb_ld(&bar[XB_XCNT(j)]); sum += c; cnt += (c > 0u) ? 1u : 0u; mine = (j == x) ? c : mine; }
        if (sum == G) break;
        __builtin_amdgcn_s_sleep(1);
        if ((++sp & 255u) == 0u) { if (xb_ld(&bar[XB_TMO])) break; if (sp > XB_SPIN_CAP) { atomicAdd(&bar[XB_TMO], 1u); break; } }
    }
    nloc = mine > 0u ? mine : 1u; nx = cnt > 0u ? cnt : 1u;
}
DEV void xcd_barrier(const XcdBarrier& b) {
    asm volatile("s_waitcnt vmcnt(0)" ::: "memory");
    __syncthreads();
    if (threadIdx.x == 0) {
        unsigned* bar = b.bar;
        __builtin_amdgcn_s_waitcnt(0);
        unsigned nloc = b.st[0], nx = b.st[1];
        if (nloc == 0u) { xcd_barrier_complete(bar, b.x, nloc, nx); b.st[0] = nloc; b.st[1] = nx; }
        const unsigned old = xb_add(&bar[XB_XSUB(b.x)], 1u);
        const unsigned gen = old / nloc;
        if (old + 1u == (gen + 1u) * nloc) {
            __builtin_amdgcn_fence(__ATOMIC_RELEASE, "agent");
            asm volatile("s_waitcnt vmcnt(0)" ::: "memory");
            const unsigned og = xb_add(&bar[XB_TOP], 1u);
            const unsigned tg = og / nx;
            if (og + 1u == (tg + 1u) * nx) xb_add(&bar[XB_TOPGEN], 1u);
            else XB_SPIN(xb_ld(&bar[XB_TOPGEN]) == tg, bar);
            __builtin_amdgcn_fence(__ATOMIC_ACQUIRE, "agent");
            xb_add(&bar[XB_XGEN(b.x)], 1u);
            asm volatile("s_waitcnt vmcnt(0)" ::: "memory");
        } else {
            XB_SPIN(xb_ld(&bar[XB_XGEN(b.x)]) == gen, bar);
            __builtin_amdgcn_fence(__ATOMIC_ACQUIRE, "agent");
            asm volatile("s_waitcnt vmcnt(0)" ::: "memory");
        }
    }
    __syncthreads();
}

#define STAMP() do { if (TPROBE >= 0) { if (bid == 0 && threadIdx.x == 0) p.ts[nst] = __builtin_amdgcn_s_memrealtime(); ++nst; } } while (0)
#define GSYNC_CG() do { cg::this_grid().sync(); STAMP(); } while (0)
#define GSYNC() do { xcd_barrier(xbar); STAMP(); } while (0)
__global__ void __launch_bounds__(NTHR, 2) fwd_all(P p) {
    extern __shared__ __attribute__((aligned(16))) unsigned char lds_raw[];
    LAS unsigned char* lds = (LAS unsigned char*)lds_raw;
    float* sm = (float*)lds_raw;
    int* off = (int*)(lds_raw + LDS_OFF_TAB);
    const LAS int* offl = (const LAS int*)(lds + LDS_OFF_TAB);
    LAS unsigned* gtab = (LAS unsigned*)(lds + LDS_GTAB);
    const int bid = blockIdx.x, nb = gridDim.x;
    const int tid_ = otid(); const int lane = tid_ & 63, wv = tid_ >> 6;
    LAS float* scr = (LAS float*)(lds + wv * 16384);
    const int gw = bid * NWV + wv, ngw = nb * NWV;
    volatile LAS unsigned* misc = (volatile LAS unsigned*)(lds + LDS_MISC);
    if (threadIdx.x < 2) misc[threadIdx.x] = 0u;
    __syncthreads();
    const XcdBarrier xbar = xcd_barrier_post(p.bar, misc);
    int nst = 0; STAMP();

    ph_mod(p, sm, bid, nb);
    __syncthreads();
    REPEAT(1) ph_prep_small(p, scr, gw, ngw, lane);
#if MF_EXP2
    REPEAT(2) ph_prep_ed(p, scr, gw, ngw, lane);
#endif
    GSYNC_CG();
    REPEAT(3) ph_norm(p.x, p.norm1_g, p.mod, 0, 1024, p.XB, bid, nb);
    GSYNC();
#if MF_INPROJ
    REPEAT(4) { mg::DenseOrder S; S.init(p.XB, p.WT_IN, T, INW, DM, nb, bid);
      mg::gemm_phase<mg::MEpiInProj, mg::DenseOrder, false>(lds, gtab, DM, S, mg::MEpiInProj{p.U, p.QKV, p.G}); }
#else
    ngemm_dense<false>(p.XB, DM, p.w_in, nullptr, INW, T, INW, DM, EpiInProj{p.U, p.QKV, p.G}, sm, bid, nb);
#endif
    GSYNC();
#if !MF_ATTN
    ph_qknorm(p, bid, nb);
#endif
    REPEAT(5) ph_pool(p, bid, nb);
    GSYNC();
#if MF_ATTN
    REPEAT(6) ph_attn_mfma(p, lds, bid, nb);
    GSYNC();
    REPEAT(7) ph_attn_combine(p, bid, nb);
#else
    ph_attn(p, bid, nb);
#endif
#if !MF_MERGE
#pragma unroll 1
    for (int g = 0; g < 4; ++g) ngemm_dense<false>(p.PL + g * 128, 512, p.pool_w_grp + g * 128 * 128, nullptr, 128, T, 128, 128, EpiPoolGrp{p.Y, p.pool_scale, g}, sm, bid, nb);
#endif
    GSYNC();
#if MF_MERGE
    REPEAT(8) { mg::DenseOrder S; S.init(p.PL, p.WT_EFF, T, DM, 512, nb, bid);
      mg::gemm_phase<mg::MEpiMerge<false>, mg::DenseOrder, false>(lds, gtab, 512, S, mg::MEpiMerge<false>{p.XB, p.G}); }
    { mg::DenseOrder S; S.init(p.O, p.WT_AU, T, DM, 256, nb, bid);
      mg::gemm_phase<mg::MEpiMerge<true>, mg::DenseOrder, false>(lds, gtab, 256, S, mg::MEpiMerge<true>{p.XB, p.G}); }
#else
    ngemm_dense<false>(p.Y, 512, p.w_pool_up, nullptr, DM, T, DM, 512, EpiMergeA{p.XB, p.G}, sm, bid, nb);
    GSYNC();
    ngemm_dense<false>(p.O, 256, p.w_attn_up, nullptr, DM, T, DM, 256, EpiMergeB{p.XB, p.G}, sm, bid, nb);
#endif
    GSYNC();
#if MF_OUT
    REPEAT(9) { mg::DenseOrder S; S.init(p.XB, p.WT_OUT, T, DM, DM, nb, bid);
      mg::gemm_phase<mg::MEpiOutProj, mg::DenseOrder, false>(lds, gtab, DM, S, mg::MEpiOutProj{p.x, p.out, p.mod}); }
#else
    ngemm_dense<false>(p.XB, DM, p.w_out, nullptr, DM, T, DM, DM, EpiOutProj{p.x, p.out, p.mod}, sm, bid, nb);
#endif
    GSYNC();
    REPEAT(10) ph_norm(p.out, p.norm2_g, p.mod, 3072, 4096, p.XB, bid, nb);
#if MF_EXP1
    __syncthreads();
    REPEAT(11) ph_prep_egu(p, scr, gw, ngw, lane);
#endif
    GSYNC();
#if MF_ROUTER
    REPEAT(12) { mg::DenseOrder S; S.init(p.XB, p.WT_RS, T, 768, DM, nb, bid);
      mg::gemm_phase<mg::MEpiRouterShared, mg::DenseOrder, false>(lds, gtab, DM, S, mg::MEpiRouterShared{p.LG, p.HS}); }
#else
    ngemm_dense<false>(p.XB, DM, p.w_router, nullptr, NE, T, NE, DM, EpiLogits{p.LG}, sm, bid, nb);
#endif
    GSYNC();
    ph_route(p, bid, nb);
    GSYNC();
    ph_scatter(p, off, bid, nb);
    GSYNC();
#if MF_EXP1
    REPEAT(13) { load_offsets(p.cnt, off); fill_gtab(p, offl, gtab, 2, bid, nb);
      mg::ExpertOrder S{offl, __builtin_amdgcn_readfirstlane(off[NE]) / 256, 2, nb, bid, (const char*)p.XB, (const char*)p.WT_EGU, (size_t)512 * DM * 2, (size_t)256 * DM * 2, 0, true};
      mg::gemm_phase<mg::MEpiAct, mg::ExpertOrder, true>(lds, gtab, DM, S, mg::MEpiAct{p.ACT}); }
#else
    ph_expert1(p, sm, off, bid, nb);
#endif
    GSYNC();
#if MF_EXP2
    REPEAT(14) { load_offsets(p.cnt, off);
      mg::ExpertOrder S{offl, __builtin_amdgcn_readfirstlane(off[NE]) / 256, 4, nb, bid, (const char*)p.ACT, (const char*)p.WT_ED, (size_t)DM * EFF * 2, (size_t)256 * EFF * 2, (size_t)256 * EFF * 2, false};
      mg::gemm_phase<mg::MEpiSlab, mg::ExpertOrder, false>(lds, gtab, EFF, S, mg::MEpiSlab{p.SLAB, p.rowlist, p.asg_w}); }
#else
    ph_expert2(p, sm, off, bid, nb);
#endif
    GSYNC();
#if !MF_ROUTER
    ngemm_dense<true>(p.XB, DM, p.w_sg, p.w_su, EFF, T, EFF, DM, EpiAct{p.HS}, sm, bid, nb);
    GSYNC();
#endif
#if MF_FINAL
    { mg::DenseOrder S; S.init(p.HS, p.WT_SD, T, DM, EFF, nb, bid);
      mg::gemm_phase<mg::MEpiFinal, mg::DenseOrder, false>(lds, gtab, EFF, S, mg::MEpiFinal{p.out, p.SLAB, p.mod}); }
#else
    ngemm_dense<false>(p.HS, EFF, p.w_sd, nullptr, DM, T, DM, EFF, EpiFinal{p.out, p.SLAB, p.mod}, sm, bid, nb);
#endif
#if TPROBE >= 0
    GSYNC();
    if (bid == 0 && threadIdx.x == 0) { const unsigned long long dt = p.ts[TPROBE + 1] - p.ts[TPROBE]; p.out[0] += (float)dt * 0.01f / TSCALE; }
#endif
}

extern "C" void kernel_launch(void* const* d_in, const int* in_sizes, int n_in, void* d_out, int out_size, void* d_ws, size_t ws_size, hipStream_t stream) {
    static int grid = 0;
    if (grid == 0) {
        int dev = 0, cus = 0;
        (void)hipGetDevice(&dev);
        (void)hipDeviceGetAttribute(&cus, hipDeviceAttributeMultiprocessorCount, dev);
        int per_cu = 0;
        (void)hipFuncSetAttribute((const void*)fwd_all, hipFuncAttributeMaxDynamicSharedMemorySize, LDS_BYTES);
        (void)hipOccupancyMaxActiveBlocksPerMultiprocessor(&per_cu, fwd_all, NTHR, LDS_BYTES);
        if (per_cu < 1) { fprintf(stderr, "kernel_launch: occupancy query says %d blocks/CU\n", per_cu); per_cu = 1; }
        if (per_cu > 1) per_cu = 1;
        grid = cus * per_cu;
        if (ws_size < WS_END) { fprintf(stderr, "kernel_launch: workspace too small (%zu < %zu)\n", ws_size, (size_t)WS_END); grid = -1; }
    }
    if (grid < 0) return;
    P p{};
    const float* const* in = (const float* const*)d_in;
    p.x = in[0]; p.c = in[1]; p.pos = (const int*)d_in[2];
    p.w_ada = in[3]; p.b_ada = in[4]; p.norm1_g = in[5]; p.w_in = in[6]; p.pool_w_grp = in[7]; p.pool_scale = in[8]; p.q_norm_g = in[9]; p.k_norm_g = in[10];
    p.w_pool_up = in[11]; p.w_attn_up = in[12]; p.w_out = in[13]; p.norm2_g = in[14]; p.w_router = in[15]; p.router_bias = in[16];
    p.w_sg = in[17]; p.w_su = in[18]; p.w_sd = in[19]; p.w_eg = in[20]; p.w_eu = in[21]; p.w_ed = in[22];
    p.out = (float*)d_out;
    char* ws = (char*)d_ws;
    p.mod = (float*)(ws + WS_MOD); p.cnt = (int*)(ws + WS_CNT); p.asg_e = (int*)(ws + WS_ASG_E); p.asg_pos = (int*)(ws + WS_ASG_POS);
    p.asg_w = (float*)(ws + WS_ASG_W); p.rowlist = (int*)(ws + WS_ROWLIST);
    p.XB = (bf16_t*)(ws + WS_XB); p.U = (bf16_t*)(ws + WS_U); p.QKV = (bf16_t*)(ws + WS_QKV); p.G = (bf16_t*)(ws + WS_G); p.PL = (bf16_t*)(ws + WS_PL);
    p.Y = (bf16_t*)(ws + WS_Y); p.O = (bf16_t*)(ws + WS_O); p.ACT = (bf16_t*)(ws + WS_ACT); p.SLAB = (bf16_t*)(ws + WS_SLAB); p.HS = (bf16_t*)(ws + WS_HS);
    p.LG = (float*)(ws + WS_ACT);
    p.bar = (unsigned*)(ws + WS_BAR); p.ts = (unsigned long long*)(ws + WS_TS);
    p.OG = (bf16_t*)(ws + WS_OG); p.LSUM = (float*)(ws + WS_LSUM);
    p.WT_IN = (bf16_t*)(ws + WS_WT_IN); p.WT_EFF = (bf16_t*)(ws + WS_WT_EFF); p.WT_AU = (bf16_t*)(ws + WS_WT_AU); p.WT_OUT = (bf16_t*)(ws + WS_WT_OUT);
    p.WT_RS = (bf16_t*)(ws + WS_WT_RS); p.WT_SD = (bf16_t*)(ws + WS_WT_SD); p.WT_EGU = (bf16_t*)(ws + WS_WT_EGU); p.WT_ED = (bf16_t*)(ws + WS_WT_ED);
    (void)hipMemsetAsync(ws + WS_BAR, 0, WS_ZERO_BYTES, stream);
    void* args[] = {&p};
    hipError_t e = hipLaunchCooperativeKernel((void*)fwd_all, dim3(grid), dim3(NTHR), args, LDS_BYTES, stream);
    if (e != hipSuccess) fprintf(stderr, "cooperative launch failed: %s (grid %d)\n", hipGetErrorString(e), grid);
}
```

```cpp
#include <hip/hip_runtime.h>
#include <hip/hip_cooperative_groups.h>
#include <stdint.h>
#include <cstdio>
namespace cg = cooperative_groups;

#ifndef ONE_LAUNCH
#define ONE_LAUNCH 0
#endif

typedef unsigned short bf16_t;
#define DEV __device__ __forceinline__
#define LAS __attribute__((address_space(3)))
typedef short bf16x8 __attribute__((ext_vector_type(8)));
typedef float f32x4 __attribute__((ext_vector_type(4)));
typedef unsigned u32x4 __attribute__((ext_vector_type(4)));
typedef unsigned u32x2 __attribute__((ext_vector_type(2)));

#ifndef MF_INPROJ
#define MF_INPROJ 1
#endif
#ifndef MF_MERGE
#define MF_MERGE 1
#endif
#ifndef MF_OUT
#define MF_OUT 1
#endif
#ifndef MF_ROUTER
#define MF_ROUTER 1
#endif
#ifndef MF_EXP1
#define MF_EXP1 1
#endif
#ifndef MF_EXP2
#define MF_EXP2 1
#endif
#ifndef MF_ATTN
#define MF_ATTN 1
#endif
#ifndef DUP
#define DUP 0
#endif
#ifndef TPROBE
#define TPROBE -1
#endif
#ifndef TSCALE
#define TSCALE 10.0f
#endif
#define REPEAT(n) _Pragma("unroll 1") for (int rep_ = 0; rep_ < ((DUP == (n)) ? 2 : 1); ++rep_)
#ifndef MF_FINAL
#define MF_FINAL 1
#endif

constexpr int NB = 16, SEQ = 2048, DM = 1024, T = NB * SEQ;
constexpr int INW = 4864, NMOD = 6144;
constexpr int NE = 256, EFF = 256;
constexpr int NTHR = 512, NWV = 8;
constexpr int NSLOT = T * 8;
constexpr int RMAX = NSLOT + NE * 256;

DEV float bf2f(bf16_t h) { return __uint_as_float(((unsigned)h) << 16); }
DEV bf16_t f2bf(float f) { unsigned u = __float_as_uint(f); u += 0x7fffu + ((u >> 16) & 1u); return (bf16_t)(u >> 16); }
DEV unsigned pk2(float lo, float hi) { return (unsigned)f2bf(lo) | ((unsigned)f2bf(hi) << 16); }
DEV float sigm(float v) { return 1.f / (1.f + __expf(-v)); }
DEV float silu(float v) { return v / (1.f + __expf(-v)); }
DEV int otid() { int t = threadIdx.x; asm volatile("" : "+v"(t)); return t; }
DEV float wave_sum(float v) {
#pragma unroll
    for (int o = 32; o >= 1; o >>= 1) v += __shfl_xor(v, o);
    return v;
}

struct P {
    const float *x, *c; const int* pos;
    const float *w_ada, *b_ada, *norm1_g, *w_in, *pool_w_grp, *pool_scale, *q_norm_g, *k_norm_g, *w_pool_up, *w_attn_up, *w_out, *norm2_g,
        *w_router, *router_bias, *w_sg, *w_su, *w_sd, *w_eg, *w_eu, *w_ed;
    float* out;
    float* mod; int* cnt; int* asg_e; int* asg_pos; float* asg_w; int* rowlist;
    bf16_t *XB, *U, *QKV, *G, *PL, *Y, *O, *ACT, *SLAB, *HS;
    float* LG;
    bf16_t* OG; float* LSUM; unsigned* bar; unsigned long long* ts; float* roww;
    bf16_t *WT_IN, *WT_EFF, *WT_AU, *WT_OUT, *WT_RS, *WT_SD, *WT_EGU, *WT_ED;
};

constexpr size_t MiB = 1u << 20;
constexpr size_t WS_BAR = 640 * 1024, WS_BAR_BYTES = 16384, WS_ZERO_BYTES = 16384 + 65536;
constexpr size_t WS_TS = 800 * 1024;
constexpr size_t WS_MOD = 0, WS_CNT = WS_BAR + WS_BAR_BYTES, WS_ASG_E = 1 * MiB, WS_ASG_POS = 2 * MiB, WS_ASG_W = 3 * MiB, WS_ROWLIST = 4 * MiB, WS_ROWW = 6 * MiB;
constexpr size_t WS_XB = 8 * MiB;
constexpr size_t WS_ACT = 72 * MiB;
constexpr size_t WS_SLAB = 232 * MiB;
constexpr size_t WS_U = 232 * MiB, WS_QKV = 264 * MiB, WS_G = 408 * MiB, WS_PL = 536 * MiB, WS_Y = 568 * MiB, WS_O = 600 * MiB;
constexpr size_t WS_WT_IN = 744 * MiB, WS_WT_EFF = 754 * MiB, WS_WT_AU = 755 * MiB, WS_WT_OUT = 756 * MiB, WS_WT_RS = 758 * MiB, WS_WT_SD = 760 * MiB;
constexpr size_t WS_WT_ED = 762 * MiB;
constexpr size_t WS_WT_EGU = 232 * MiB;
constexpr size_t WS_OG = 616 * MiB, WS_LSUM = 664 * MiB;
constexpr size_t WS_HS = 890 * MiB;
constexpr size_t WS_END = 906 * MiB;

DEV void ph_mod(const P& p, float* sm, int bid, int nb) {
    const int tid_ = otid(); const int lane = tid_ & 63, wv = tid_ >> 6;
    for (int it = bid; it < 96; it += nb) {
        const int k0 = wv * 128, e = it * 64 + lane;
        float acc[16];
#pragma unroll
        for (int b = 0; b < 16; ++b) acc[b] = 0.f;
#pragma unroll 1
        for (int kh = 0; kh < 2; ++kh) {
            float sc[16];
#pragma unroll
            for (int b = 0; b < 16; ++b) sc[b] = silu(p.c[b * DM + k0 + kh * 64 + lane]);
            const float* wp = p.w_ada + (size_t)(k0 + kh * 64) * NMOD + e;
#pragma unroll 8
            for (int kk = 0; kk < 64; ++kk) { const float w = wp[(size_t)kk * NMOD];
#pragma unroll
                for (int b = 0; b < 16; ++b) acc[b] += __uint_as_float(__builtin_amdgcn_readlane(__float_as_uint(sc[b]), kk)) * w; }
        }
        __syncthreads();
#pragma unroll
        for (int b = 0; b < 16; ++b) sm[(wv * 16 + b) * 64 + lane] = acc[b];
        __syncthreads();
#pragma unroll
        for (int j = 0; j < 2; ++j) { const int idx = tid_ + j * NTHR, b = idx >> 6, col = idx & 63; float s = p.b_ada[it * 64 + col];
#pragma unroll
            for (int w = 0; w < 8; ++w) s += sm[(w * 16 + b) * 64 + col];
            p.mod[b * NMOD + it * 64 + col] = s; }
    }
}

DEV void ph_norm(const float* src, const float* g, const float* mod, int shift_off, int scale_off, bf16_t* dst, int bid, int nb) {
    const int tid_ = otid(); const int lane = tid_ & 63, wv = tid_ >> 6;
    for (int row = bid * NWV + wv; row < T; row += nb * NWV) {
        const float4* xr = (const float4*)(src + (size_t)row * DM);
        const int b = row / SEQ;
        float4 v[4]; float ss = 0.f;
#pragma unroll
        for (int j = 0; j < 4; ++j) { v[j] = xr[lane + 64 * j]; ss += v[j].x * v[j].x + v[j].y * v[j].y + v[j].z * v[j].z + v[j].w * v[j].w; }
        ss = wave_sum(ss);
        const float r = rsqrtf(ss * (1.f / DM) + 1e-6f);
#pragma unroll
        for (int j = 0; j < 4; ++j) {
            const int col = (lane + 64 * j) * 4;
            const float4 g4 = *(const float4*)(g + col);
            const float4 sc = *(const float4*)(mod + b * NMOD + scale_off + col);
            const float4 sh = *(const float4*)(mod + b * NMOD + shift_off + col);
            const float o0 = v[j].x * r * g4.x * (1.f + sc.x) + sh.x, o1 = v[j].y * r * g4.y * (1.f + sc.y) + sh.y;
            const float o2 = v[j].z * r * g4.z * (1.f + sc.z) + sh.z, o3 = v[j].w * r * g4.w * (1.f + sc.w) + sh.w;
            uint2 w; w.x = pk2(o0, o1); w.y = pk2(o2, o3);
            *(uint2*)(dst + (size_t)row * DM + col) = w;
        }
    }
}

template <bool DUAL, class RowF, class Epi>
DEV void ngemm_tile(const bf16_t* __restrict__ A, int lda, RowF rowf, const float* __restrict__ B, const float* __restrict__ B2, int ldb,
                    int m0, int n0, int K, Epi epi, float* sm) {
    float* As = sm;
    float* Bs = sm + 16 * 132;
    float* Bs2 = Bs + 16 * 64;
    const int tid = otid(), tm = tid >> 4, tn = tid & 15;
    float acc[4][4], acc2[4][4];
#pragma unroll
    for (int i = 0; i < 4; ++i)
#pragma unroll
        for (int j = 0; j < 4; ++j) { acc[i][j] = 0.f; acc2[i][j] = 0.f; }
    const int ar = tid >> 2, ak = (tid & 3) * 4;
    const int arow = rowf(m0 + ar);
    const bf16_t* ap = A + (size_t)(arow < 0 ? 0 : arow) * lda + ak;
    const int bk = tid >> 5, bn = (tid & 31) * 2;
    for (int k0 = 0; k0 < K; k0 += 16) {
        uint2 av = make_uint2(0u, 0u);
        if (arow >= 0) av = *(const uint2*)(ap + k0);
        const float2 bv = *(const float2*)(B + (size_t)(k0 + bk) * ldb + n0 + bn);
        float2 bv2 = make_float2(0.f, 0.f);
        if (DUAL) bv2 = *(const float2*)(B2 + (size_t)(k0 + bk) * ldb + n0 + bn);
        __syncthreads();
        As[(ak + 0) * 132 + ar] = __uint_as_float(av.x << 16);
        As[(ak + 1) * 132 + ar] = __uint_as_float(av.x & 0xffff0000u);
        As[(ak + 2) * 132 + ar] = __uint_as_float(av.y << 16);
        As[(ak + 3) * 132 + ar] = __uint_as_float(av.y & 0xffff0000u);
        Bs[bk * 64 + bn] = bv.x; Bs[bk * 64 + bn + 1] = bv.y;
        if (DUAL) { Bs2[bk * 64 + bn] = bv2.x; Bs2[bk * 64 + bn + 1] = bv2.y; }
        __syncthreads();
#pragma unroll
        for (int kk = 0; kk < 16; ++kk) {
            const float4 a = *(const float4*)&As[kk * 132 + tm * 4];
            const float4 b = *(const float4*)&Bs[kk * 64 + tn * 4];
            const float aa[4] = {a.x, a.y, a.z, a.w}, bb[4] = {b.x, b.y, b.z, b.w};
#pragma unroll
            for (int i = 0; i < 4; ++i)
#pragma unroll
                for (int j = 0; j < 4; ++j) acc[i][j] += aa[i] * bb[j];
            if (DUAL) {
                const float4 b2 = *(const float4*)&Bs2[kk * 64 + tn * 4];
                const float cc[4] = {b2.x, b2.y, b2.z, b2.w};
#pragma unroll
                for (int i = 0; i < 4; ++i)
#pragma unroll
                    for (int j = 0; j < 4; ++j) acc2[i][j] += aa[i] * cc[j];
            }
        }
    }
#pragma unroll
    for (int i = 0; i < 4; ++i)
#pragma unroll
        for (int j = 0; j < 4; ++j) epi(m0 + tm * 4 + i, n0 + tn * 4 + j, acc[i][j], acc2[i][j]);
}

struct RowId { DEV int operator()(int m) const { return m; } };
struct RowTok { const int* rl; DEV int operator()(int m) const { const int s = rl[m]; return s < 0 ? -1 : (s >> 3); } };

template <bool DUAL, class Epi>
DEV void ngemm_dense(const bf16_t* A, int lda, const float* B, const float* B2, int ldb, int M, int N, int K, Epi epi, float* sm, int bid, int nb) {
    const int tn = N / 64, nt = (M / 128) * tn;
    for (int t = bid; t < nt; t += nb) ngemm_tile<DUAL>(A, lda, RowId(), B, B2, ldb, (t / tn) * 128, (t % tn) * 64, K, epi, sm);
}

struct EpiInProj { bf16_t *U, *QKV, *G;
    DEV void operator()(int r, int c, float v, float) const {
        if (c < 512) U[(size_t)r * 512 + c] = f2bf(v);
        else if (c < 2816) QKV[(size_t)r * 2304 + (c - 512)] = f2bf(v);
        else G[(size_t)r * 2048 + (c - 2816)] = f2bf(sigm(v)); } };
struct EpiPoolGrp { bf16_t* Y; const float* ls; int g;
    DEV void operator()(int r, int c, float v, float) const { Y[(size_t)r * 512 + g * 128 + c] = f2bf(v * ls[g * 128 + c]); } };
struct EpiMergeA { bf16_t* MG; const bf16_t* G;
    DEV void operator()(int r, int c, float v, float) const { MG[(size_t)r * DM + c] = f2bf(bf2f(G[(size_t)r * 2048 + c]) * v); } };
struct EpiMergeB { bf16_t* MG; const bf16_t* G;
    DEV void operator()(int r, int c, float v, float) const { const size_t i = (size_t)r * DM + c; MG[i] = f2bf(bf2f(MG[i]) + bf2f(G[(size_t)r * 2048 + 1024 + c]) * v); } };
struct EpiOutProj { const float* x; float* out; const float* mod;
    DEV void operator()(int r, int c, float v, float) const { const size_t i = (size_t)r * DM + c; out[i] = x[i] + mod[(r / SEQ) * NMOD + 2048 + c] * v; } };
struct EpiLogits { float* LG;
    DEV void operator()(int r, int c, float v, float) const { LG[(size_t)r * NE + c] = v; } };
struct EpiAct { bf16_t* ACT;
    DEV void operator()(int r, int c, float v, float v2) const { ACT[(size_t)r * EFF + c] = f2bf(silu(v) * v2); } };
struct EpiSlab { bf16_t* SLAB; const int* rl; const float* w;
    DEV void operator()(int r, int c, float v, float) const { const int s = rl[r]; if (s >= 0) SLAB[(size_t)s * DM + c] = f2bf(v * w[s]); } };
struct EpiFinal { float* out; const bf16_t* SLAB; const float* mod;
    DEV void operator()(int r, int c, float v, float) const {
        float s = v;
#pragma unroll
        for (int k = 0; k < 8; ++k) s += bf2f(SLAB[((size_t)r * 8 + k) * DM + c]);
        const size_t i = (size_t)r * DM + c; out[i] = out[i] + mod[(r / SEQ) * NMOD + 5120 + c] * s; } };

DEV void ph_qknorm(const P& p, int bid, int nb) {
    const int tid_ = otid(); const int lane = tid_ & 63, wv = tid_ >> 6;
    const float gq = p.q_norm_g[lane], gk = p.k_norm_g[lane];
    const float invf = exp2f(-(float)(lane & 7) * (1.f / 8.f) * log2f(500000.f));
    for (int t = bid * NWV + wv; t < T; t += nb * NWV) {
        const float ang = (float)p.pos[t] * invf;
        const float cs = cosf(ang), sn = sinf(ang);
        bf16_t* ptr = p.QKV + (size_t)t * 2304 + lane;
        float v[24];
#pragma unroll
        for (int hh = 0; hh < 24; ++hh) v[hh] = bf2f(ptr[hh * 64]);
#pragma unroll
        for (int hh = 0; hh < 24; ++hh) {
            const float ss = wave_sum(v[hh] * v[hh]);
            float nv = v[hh] * rsqrtf(ss * (1.f / 64.f) + 1e-6f) * (hh < 12 ? gq : gk);
            const float partner = __shfl_xor(nv, 8);
            if (lane < 8) nv = nv * cs - partner * sn;
            else if (lane < 16) nv = nv * cs + partner * sn;
            ptr[hh * 64] = f2bf(nv);
        }
    }
}

DEV void ph_pool(const P& p, int bid, int nb) {
    const int tid_ = otid();
    for (int i = bid * NTHR + tid_; i < NB * 32 * 256; i += nb * NTHR) {
        const int cp = i & 255, chunk = (i >> 8) & 31, b = i >> 13;
        const int g = cp >> 6, r = 1 << g;
        const int s0 = chunk * 64;
        const unsigned* up = (const unsigned*)(p.U + (size_t)b * SEQ * 512) + cp;
        unsigned* op = (unsigned*)(p.PL + (size_t)b * SEQ * 512) + cp;
        float a0 = 0.f, a1 = 0.f;
        const int lo0 = max(s0 - r, 0), hi0 = min(s0 + r, SEQ - 1);
        for (int q = lo0; q <= hi0; ++q) { const unsigned w = up[(size_t)q * 256]; a0 += __uint_as_float(w << 16); a1 += __uint_as_float(w & 0xffff0000u); }
#pragma unroll 4
        for (int s = s0; s < s0 + 64; ++s) {
            const int lo = max(s - r, 0), hi = min(s + r, SEQ - 1);
            const float inv = 1.f / (float)(hi - lo + 1);
            const unsigned w = up[(size_t)s * 256];
            op[(size_t)s * 256] = pk2(a0 * inv - __uint_as_float(w << 16), a1 * inv - __uint_as_float(w & 0xffff0000u));
            if (s + 1 + r <= SEQ - 1) { const unsigned wn = up[(size_t)(s + 1 + r) * 256]; a0 += __uint_as_float(wn << 16); a1 += __uint_as_float(wn & 0xffff0000u); }
            if (s - r >= 0) { const unsigned wo = up[(size_t)(s - r) * 256]; a0 -= __uint_as_float(wo << 16); a1 -= __uint_as_float(wo & 0xffff0000u); }
        }
    }
}

DEV void ph_attn(const P& p, int bid, int nb) {
    const int tid_ = otid(); const int lane = tid_ & 63, wv = tid_ >> 6;
    for (int it = bid * NWV + wv; it < T * 4; it += nb * NWV) {
        const int t = it >> 2, slot = it & 3;
        const int s = t & (SEQ - 1), base = t - s;
        float M = -1e30f, l = 0.f, acc = 0.f;
#pragma unroll
        for (int g = 0; g < 3; ++g) {
            const int dsh = 2 * g, d = 1 << dsh, L = SEQ >> dsh;
            const int h = 4 * g + slot;
            const int m = s >> dsh, r = s & (d - 1);
            const float q = bf2f(p.QKV[(size_t)t * 2304 + h * 64 + lane]);
            const bf16_t* kb = p.QKV + 768 + h * 64 + lane;
            const bf16_t* vb = p.QKV + 1536 + h * 64 + lane;
#pragma unroll 4
            for (int rel = -64; rel <= 64; ++rel) {
                const int mm = m + rel;
                const bool valid = (mm >= 0) && (mm < L);
                const int mc = valid ? mm : m;
                const size_t tr = (size_t)(base + mc * d + r) * 2304;
                const float kv = bf2f(kb[tr]), vv = bf2f(vb[tr]);
                const float sc = wave_sum(q * kv) * 0.125f;
                if (valid) {
                    const float mn = fmaxf(M, sc);
                    const float f = __expf(M - mn), pe = __expf(sc - mn);
                    l = l * f + pe; acc = acc * f + pe * vv; M = mn;
                }
            }
        }
        p.O[(size_t)t * 256 + slot * 64 + lane] = f2bf(acc / l);
    }
}

DEV void ph_route(const P& p, int bid, int nb) {
    const int tid_ = otid(); const int lane = tid_ & 63, wv = tid_ >> 6;
    const int G = lane & 7, tl = lane >> 3;
    float bias[32];
#pragma unroll
    for (int j = 0; j < 8; ++j) { const float4 b4 = *(const float4*)(p.router_bias + G * 32 + 4 * j); bias[4 * j] = b4.x; bias[4 * j + 1] = b4.y; bias[4 * j + 2] = b4.z; bias[4 * j + 3] = b4.w; }
    for (int t0 = (bid * NWV + wv) * 8; t0 < T; t0 += nb * NWV * 8) {
        const int t = t0 + tl;
        float sc[32], v[32];
#pragma unroll
        for (int j = 0; j < 8; ++j) { const float4 lg = *(const float4*)(p.LG + (size_t)t * NE + G * 32 + 4 * j);
            sc[4 * j] = 1.f / (1.f + expf(-lg.x)); sc[4 * j + 1] = 1.f / (1.f + expf(-lg.y)); sc[4 * j + 2] = 1.f / (1.f + expf(-lg.z)); sc[4 * j + 3] = 1.f / (1.f + expf(-lg.w)); }
        float m1 = -INFINITY, m2 = -INFINITY;
#pragma unroll
        for (int j = 0; j < 32; ++j) { v[j] = sc[j] + bias[j]; const float n1 = fmaxf(m1, v[j]), n2 = fmaxf(fminf(m1, v[j]), m2); m1 = n1; m2 = n2; }
        const float gs = m1 + m2;
        int rank = 0;
#pragma unroll
        for (int g2 = 0; g2 < 8; ++g2) { const float o = __shfl(gs, (lane & 56) + g2); rank += ((o > gs) || (o == gs && g2 < G)) ? 1 : 0; }
        const bool gsel = rank < 4;
        int myidx = 0; float myw = 0.f, wsum = 0.f;
#pragma unroll 1
        for (int k = 0; k < 8; ++k) {
            float bv = -INFINITY, bs = 0.f; int bi = 0;
#pragma unroll
            for (int j = 0; j < 32; ++j) { const bool tk = gsel && (v[j] > bv); bv = tk ? v[j] : bv; bs = tk ? sc[j] : bs; bi = tk ? j : bi; }
            int gi = G * 32 + bi;
#pragma unroll
            for (int o = 1; o < 8; o <<= 1) {
                const float ov = __shfl_xor(bv, o), os = __shfl_xor(bs, o); const int oi = __shfl_xor(gi, o);
                if ((ov > bv) || (ov == bv && oi < gi)) { bv = ov; gi = oi; bs = os; }
            }
            const int wj = (gi >> 5) == G ? (gi & 31) : -1;
#pragma unroll
            for (int j = 0; j < 32; ++j) v[j] = (j == wj) ? -INFINITY : v[j];
            if (G == k) { myidx = gi; myw = bs; }
            wsum += bs;
        }
        const int slot = t * 8 + G;
        const int pos = atomicAdd(&p.cnt[myidx * 64], 1);
        p.asg_e[slot] = myidx; p.asg_pos[slot] = pos; p.asg_w[slot] = myw / wsum * 2.5f;
    }
}

DEV void load_offsets(const int* cnt, int* off) {
    const int tid = otid();
    __syncthreads();
    if (tid < NE) off[300 + tid] = (cnt[tid * 64] + 255) & ~255;
    __syncthreads();
    if (tid == 0) { int a = 0; for (int e = 0; e < NE; ++e) { off[e] = a; a += off[300 + e]; } off[NE] = a; }
    __syncthreads();
}
DEV int find_expert(const int* off, int m0) {
    int lo = 0, hi = NE;
    while (hi - lo > 1) { const int mid = (lo + hi) >> 1; if (off[mid] <= m0) lo = mid; else hi = mid; }
    return lo;
}

DEV void ph_scatter(const P& p, int* off, int bid, int nb) {
    load_offsets(p.cnt, off);
    const int tid_ = otid();
    for (int slot = bid * NTHR + tid_; slot < NSLOT; slot += nb * NTHR) { const int r = off[p.asg_e[slot]] + p.asg_pos[slot]; p.rowlist[r] = slot; p.roww[r] = p.asg_w[slot]; }
    for (int e = bid; e < NE; e += nb) {
        const int n = p.cnt[e * 64], pd = (n + 255) & ~255;
        for (int i = n + tid_; i < pd; i += NTHR) { p.rowlist[off[e] + i] = -1; p.roww[off[e] + i] = 0.f; }
    }
}

DEV void ph_expert1(const P& p, float* sm, int* off, int bid, int nb) {
    load_offsets(p.cnt, off);
    const int nrt = off[NE] / 128, nt = nrt * 4;
    for (int t = bid; t < nt; t += nb) {
        const int m0 = (t >> 2) * 128, n0 = (t & 3) * 64, e = find_expert(off, m0);
        ngemm_tile<true>(p.XB, DM, RowTok{p.rowlist}, p.w_eg + (size_t)e * DM * EFF, p.w_eu + (size_t)e * DM * EFF, EFF, m0, n0, DM, EpiAct{p.ACT}, sm);
    }
}
DEV void ph_expert2(const P& p, float* sm, int* off, int bid, int nb) {
    load_offsets(p.cnt, off);
    const int nrt = off[NE] / 128, nt = nrt * 16;
    for (int t = bid; t < nt; t += nb) {
        const int m0 = (t >> 4) * 128, n0 = (t & 15) * 64, e = find_expert(off, m0);
        ngemm_tile<false>(p.ACT, EFF, RowId(), p.w_ed + (size_t)e * EFF * DM, nullptr, DM, m0, n0, EFF, EpiSlab{p.SLAB, p.rowlist, p.asg_w}, sm);
    }
}

namespace mg {
constexpr int BM = 256, BK = 64, HALF = 128, HTB = HALF * BK * 2, STAGE_BYTES = 8 * HTB, NXCD = 8, WGM = 8;
__host__ __device__ __forceinline__ int lds_byte(int r, int c) { const int st = (r >> 4) * 2 + (c >> 5), rr = r & 15, cc = c & 31, ob = rr * 64 + cc * 2; return st * 1024 + (ob ^ (((ob >> 9) & 1) << 5)); }
__host__ __device__ __forceinline__ void stage_rc(int b, int& R, int& C) { const int st = b / 1024, sb = b % 1024, swz = sb ^ (((sb >> 9) & 1) << 5); R = (st >> 1) * 16 + swz / 64; C = (st & 1) * 32 + (swz % 64) / 2; }
__host__ __device__ __forceinline__ int perm32(int rho) { const int n = rho >> 4, i = rho & 15; return 8 * (i >> 2) + 4 * n + (i & 3); }

struct Unit { int pm, pn, e, pad; const char* A; const char* B; };

struct DenseOrder {
    int nM, nN, nwg, G, c; const char* A; const char* B; size_t tstep;
    DEV void init(const bf16_t* A_, const bf16_t* B_, int M, int N, int K, int G_, int c_) { nM = M / BM; nN = N / BM; nwg = nM * nN; G = G_; c = c_; A = (const char*)A_; B = (const char*)B_; tstep = (size_t)BM * K * 2; }
    DEV bool next(int i, Unit& u) const {
        const long L = (long)i * G + c; if (L >= nwg) return false;
        int wgid = (int)L; { const int q = nwg / NXCD, r = nwg % NXCD, xcd = wgid % NXCD, off = wgid / NXCD; wgid = (xcd < r ? xcd * (q + 1) : r * (q + 1) + (xcd - r) * q) + off; }
        const int nig = WGM * nN, gid = wgid / nig, fm = gid * WGM, gsz = (nM - fm) < WGM ? (nM - fm) : WGM;
        u.pm = fm + ((wgid % nig) % gsz); u.pn = (wgid % nig) / gsz; u.e = 0; u.pad = 0;
        u.A = A + (size_t)u.pm * tstep; u.B = B + (size_t)u.pn * tstep; return true;
    }
};
struct ExpertOrder {
    const LAS int* off; int nrt, ncol, G, c; const char* A; const char* W; size_t wstride, tstepB, tstepA; bool gather;
    DEV bool next(int i, Unit& u) const {
        const int L = i * G + c; if (L >= nrt * ncol) return false;
        u.pm = L / ncol; u.pn = L % ncol; u.pad = 0;
        int lo = 0, hi = NE; const int m0 = u.pm * BM;
        while (hi - lo > 1) { const int mid = (lo + hi) >> 1; const int ov = __builtin_amdgcn_readfirstlane(off[mid]); if (ov <= m0) lo = mid; else hi = mid; }
        u.e = lo;
        u.A = gather ? A : A + (size_t)u.pm * tstepA; u.B = W + (size_t)lo * wstride + (size_t)u.pn * tstepB; return true;
    }
};

template <class Epi, class Sched, bool GATHER>
DEV void gemm_phase(LAS unsigned char* lds, const LAS unsigned* gtab, const int K, const Sched& S, const Epi& E) {
    const int tid = otid(), wid = __builtin_amdgcn_readfirstlane(tid >> 6), lane = tid & 63, wr = wid >> 2, wc = wid & 3, fr = lane & 15, fq = lane >> 4;
    const int nt = K / BK;
    int Rr[2], Cc[2]; unsigned voffB[2];
#pragma unroll
    for (int i = 0; i < 2; ++i) { stage_rc(tid * 16 + i * 8192, Rr[i], Cc[i]); const int Rb = Epi::PERM ? ((Rr[i] & ~31) + perm32(Rr[i] & 31)) : Rr[i]; voffB[i] = (unsigned)(Rb * K + Cc[i]) * 2u; }
    const size_t kstep = (size_t)(BK * 2);
    const size_t hstep = (size_t)HALF * K * 2;
    const unsigned ldsw = (unsigned)wid * 1024u;
    const int aoff = lds_byte(wr * 64 + fr, fq * 8), boff = lds_byte(wc * 32 + fr, fq * 8);
#define MG_SA(b, h) (((b) * 2 + (h)) * HTB)
#define MG_SB(b, h) ((4 + (b) * 2 + (h)) * HTB)
#define MG_STAGE(bufoff, gbase, voff) do { _Pragma("unroll") for (int _i = 0; _i < 2; ++_i) \
        __builtin_amdgcn_global_load_lds((const unsigned*)((const char*)(gbase) + (voff)[_i]), (LAS unsigned*)(lds + (bufoff) + ldsw + _i * 8192), 16, 0, 0); } while (0)
#define MG_LDA(dst, b, h) do { _Pragma("unroll") for (int m = 0; m < 4; ++m) _Pragma("unroll") for (int k = 0; k < 2; ++k) dst[m][k] = *(const LAS bf16x8*)(lds + MG_SA(b, h) + aoff + m * 2048 + k * 1024); } while (0)
#define MG_LDB(dst, b, h) do { _Pragma("unroll") for (int n = 0; n < 2; ++n) _Pragma("unroll") for (int k = 0; k < 2; ++k) dst[n][k] = *(const LAS bf16x8*)(lds + MG_SB(b, h) + boff + n * 2048 + k * 1024); } while (0)
#define MG_MMA(ai, bj, At, Bt) do { __builtin_amdgcn_s_setprio(1); _Pragma("unroll") for (int m = 0; m < 4; ++m) _Pragma("unroll") for (int n = 0; n < 2; ++n) _Pragma("unroll") for (int k = 0; k < 2; ++k) \
        acc[ai][bj][m][n] = __builtin_amdgcn_mfma_f32_16x16x32_bf16(Bt[n][k], At[m][k], acc[ai][bj][m][n], 0, 0, 0); __builtin_amdgcn_s_setprio(0); } while (0)
#define MG_WAIT_V(n) asm volatile("s_waitcnt vmcnt(" #n ")" ::: "memory")
#define MG_WAIT_L(n) asm volatile("s_waitcnt lgkmcnt(" #n ")" ::: "memory")
#define MG_BAR __builtin_amdgcn_s_barrier()
#define MG_SCHED __builtin_amdgcn_sched_barrier(0)
    Unit cur, nxt; int ui = 0;
    if (!S.next(0, cur)) return;
    f32x4 acc[2][2][4][2];
#pragma unroll
    for (int a = 0; a < 2; ++a)
#pragma unroll
        for (int b = 0; b < 2; ++b)
#pragma unroll
            for (int m = 0; m < 4; ++m)
#pragma unroll
                for (int n = 0; n < 2; ++n) acc[a][b][m][n] = (f32x4){0.f, 0.f, 0.f, 0.f};
    bf16x8 At[4][2], B0[2][2], B1[2][2];
    unsigned va0[2], va1[2], na0[2], na1[2];
#pragma unroll
    for (int i = 0; i < 2; ++i) {
        if (GATHER) { va0[i] = gtab[Rr[i]] + (unsigned)Cc[i] * 2u; va1[i] = gtab[HALF + Rr[i]] + (unsigned)Cc[i] * 2u; }
        else { va0[i] = (unsigned)(Rr[i] * K + Cc[i]) * 2u; va1[i] = va0[i] + (unsigned)hstep; }
        na0[i] = va0[i]; na1[i] = va1[i];
    }
    const char* cA = cur.A; const char* cB = cur.B;
    MG_STAGE(MG_SB(0, 0), cB, voffB); MG_STAGE(MG_SB(0, 1), cB + hstep, voffB); MG_STAGE(MG_SA(0, 0), cA, va0); MG_STAGE(MG_SA(0, 1), cA, va1);
    if (wr == 1) MG_BAR;
    MG_WAIT_V(2); MG_BAR;
    MG_STAGE(MG_SB(1, 0), cB + kstep, voffB); MG_STAGE(MG_SA(1, 0), cA + kstep, va0); MG_STAGE(MG_SB(1, 1), cB + hstep + kstep, voffB);
    MG_WAIT_V(6); MG_BAR;
    for (;;) {
        const bool has_next = S.next(ui + 1, nxt);
        const char* nA = has_next ? nxt.A : cA; const char* nB = has_next ? nxt.B : cB;
        if (GATHER) {
            if (has_next) {
#pragma unroll
                for (int i = 0; i < 2; ++i) { na0[i] = gtab[(ui + 1) * BM + Rr[i]] + (unsigned)Cc[i] * 2u; na1[i] = gtab[(ui + 1) * BM + HALF + Rr[i]] + (unsigned)Cc[i] * 2u; }
            }
        }
#pragma unroll 1
        for (int t = 0; t < nt; t += 2) {
            const bool last = (t == nt - 2);
            const char* a1 = cA + (size_t)(t + 1) * kstep;
            const char* a2 = last ? nA : cA + (size_t)(t + 2) * kstep; const char* b2 = last ? nB : cB + (size_t)(t + 2) * kstep;
            const char* a3 = a2 + kstep; const char* b3 = b2 + kstep;
            unsigned o0[2], o1[2];
#pragma unroll
            for (int i = 0; i < 2; ++i) { o0[i] = (GATHER && last) ? na0[i] : va0[i]; o1[i] = (GATHER && last) ? na1[i] : va1[i]; }
            MG_LDB(B0, 0, 0); MG_LDB(B1, 0, 1); MG_SCHED; MG_LDA(At, 0, 0); MG_STAGE(MG_SA(1, 1), a1, va1);
            MG_WAIT_V(8); MG_WAIT_L(0); MG_BAR; MG_MMA(0, 0, At, B0); MG_MMA(0, 1, At, B1); MG_BAR; MG_SCHED;
            MG_LDA(At, 0, 1); MG_STAGE(MG_SB(0, 0), b2, voffB); MG_STAGE(MG_SB(0, 1), b2 + hstep, voffB); MG_STAGE(MG_SA(0, 0), a2, o0);
            MG_WAIT_V(8); MG_WAIT_L(0); MG_BAR; MG_MMA(1, 0, At, B0); MG_MMA(1, 1, At, B1); MG_BAR; MG_SCHED;
            MG_LDB(B0, 1, 0); MG_LDB(B1, 1, 1); MG_SCHED; MG_LDA(At, 1, 0); MG_STAGE(MG_SA(0, 1), a2, o1);
            MG_WAIT_V(8); MG_WAIT_L(0); MG_BAR; MG_MMA(0, 0, At, B0); MG_MMA(0, 1, At, B1); MG_BAR; MG_SCHED;
            MG_LDA(At, 1, 1); MG_STAGE(MG_SB(1, 0), b3, voffB); MG_STAGE(MG_SB(1, 1), b3 + hstep, voffB); MG_STAGE(MG_SA(1, 0), a3, o0);
            MG_WAIT_V(8); MG_WAIT_L(0); MG_BAR; MG_MMA(1, 0, At, B0); MG_MMA(1, 1, At, B1); MG_BAR; MG_SCHED;
        }
        if (wr == 0) MG_BAR;
        E(acc, cur, wr, wc, fr, fq);
        if (!has_next) break;
#pragma unroll
        for (int a = 0; a < 2; ++a)
#pragma unroll
            for (int b = 0; b < 2; ++b)
#pragma unroll
                for (int m = 0; m < 4; ++m)
#pragma unroll
                    for (int n = 0; n < 2; ++n) acc[a][b][m][n] = (f32x4){0.f, 0.f, 0.f, 0.f};
        cur = nxt; cA = nA; cB = nB; ++ui;
#pragma unroll
        for (int i = 0; i < 2; ++i) { va0[i] = na0[i]; va1[i] = na1[i]; }
        if (wr == 1) MG_BAR;
    }
    MG_WAIT_V(0);
    MG_BAR;
    __syncthreads();
#undef MG_SA
#undef MG_SB
#undef MG_STAGE
#undef MG_LDA
#undef MG_LDB
#undef MG_MMA
#undef MG_WAIT_V
#undef MG_WAIT_L
#undef MG_BAR
#undef MG_SCHED
}

DEV u32x4 pack8(const f32x4 a, const f32x4 b) { u32x4 w; w.x = pk2(a[0], a[1]); w.y = pk2(a[2], a[3]); w.z = pk2(b[0], b[1]); w.w = pk2(b[2], b[3]); return w; }
DEV f32x4 unpack_lo(const u32x4 w) { return (f32x4){__uint_as_float(w.x << 16), __uint_as_float(w.x & 0xffff0000u), __uint_as_float(w.y << 16), __uint_as_float(w.y & 0xffff0000u)}; }
DEV f32x4 unpack_hi(const u32x4 w) { return (f32x4){__uint_as_float(w.z << 16), __uint_as_float(w.z & 0xffff0000u), __uint_as_float(w.w << 16), __uint_as_float(w.w & 0xffff0000u)}; }
DEV f32x4 sig4(const f32x4 v) { return (f32x4){sigm(v[0]), sigm(v[1]), sigm(v[2]), sigm(v[3])}; }
DEV f32x4 silu4(const f32x4 v) { return (f32x4){silu(v[0]), silu(v[1]), silu(v[2]), silu(v[3])}; }
#define ACC_T const f32x4 (&acc)[2][2][4][2]

struct MEpiInProj { static constexpr bool PERM = true; bf16_t *U, *QKV, *G;
    DEV void operator()(ACC_T, const Unit& u, int wr, int wc, int fr, int fq) const {
        int colt = u.pn * BM; bf16_t* base; int ld; bool sg = false;
        if (colt < 512) { base = U; ld = 512; } else if (colt < 2816) { base = QKV; ld = 2304; colt -= 512; } else { base = G; ld = 2048; colt -= 2816; sg = true; }
        const int row0 = u.pm * BM + wr * 64 + fr, col0 = colt + wc * 32 + 8 * fq;
#pragma unroll
        for (int ai = 0; ai < 2; ++ai)
#pragma unroll
            for (int m = 0; m < 4; ++m) { bf16_t* rowp = base + (size_t)(row0 + ai * HALF + m * 16) * ld + col0;
#pragma unroll
                for (int bj = 0; bj < 2; ++bj) { f32x4 v0 = acc[ai][bj][m][0], v1 = acc[ai][bj][m][1]; if (sg) { v0 = sig4(v0); v1 = sig4(v1); }
                    *(u32x4*)(rowp + bj * HALF) = pack8(v0, v1); }
                asm volatile("" ::: "memory"); }
    } };
template <bool SECOND> struct MEpiMerge { static constexpr bool PERM = true; bf16_t* MG; const bf16_t* G;
    DEV void operator()(ACC_T, const Unit& u, int wr, int wc, int fr, int fq) const {
        const int row0 = u.pm * BM + wr * 64 + fr, col0 = u.pn * BM + wc * 32 + 8 * fq;
#pragma unroll
        for (int ai = 0; ai < 2; ++ai)
#pragma unroll
            for (int m = 0; m < 4; ++m) { const size_t r = (size_t)(row0 + ai * HALF + m * 16);
#pragma unroll
                for (int bj = 0; bj < 2; ++bj) { const int c = col0 + bj * HALF;
                    const u32x4 gw = *(const u32x4*)(G + r * 2048 + (SECOND ? 1024 : 0) + c);
                    f32x4 v0 = acc[ai][bj][m][0] * unpack_lo(gw), v1 = acc[ai][bj][m][1] * unpack_hi(gw);
                    if (SECOND) { const u32x4 pw = *(const u32x4*)(MG + r * DM + c); v0 += unpack_lo(pw); v1 += unpack_hi(pw); }
                    *(u32x4*)(MG + r * DM + c) = pack8(v0, v1); }
                asm volatile("" ::: "memory"); }
    } };
struct MEpiOutProj { static constexpr bool PERM = false; const float* x; float* out; const float* mod;
    DEV void operator()(ACC_T, const Unit& u, int wr, int wc, int fr, int fq) const {
        const int row0 = u.pm * BM + wr * 64 + fr, col0 = u.pn * BM + wc * 32 + 4 * fq;
        const float* gm = mod + ((u.pm * BM) / SEQ) * NMOD + 2048;
#pragma unroll
        for (int ai = 0; ai < 2; ++ai)
#pragma unroll
            for (int m = 0; m < 4; ++m) { const size_t r = (size_t)(row0 + ai * HALF + m * 16) * DM;
#pragma unroll
                for (int bj = 0; bj < 2; ++bj)
#pragma unroll
                    for (int n = 0; n < 2; ++n) { const int c = col0 + bj * HALF + n * 16;
                        *(f32x4*)(out + r + c) = *(const f32x4*)(x + r + c) + *(const f32x4*)(gm + c) * acc[ai][bj][m][n]; }
                asm volatile("" ::: "memory"); }
    } };
struct MEpiRouterShared { static constexpr bool PERM = true; float* LG; bf16_t* HS;
    DEV void operator()(ACC_T, const Unit& u, int wr, int wc, int fr, int fq) const {
        const int row0 = u.pm * BM + wr * 64 + fr, cw = wc * 32 + 8 * fq;
#pragma unroll
        for (int ai = 0; ai < 2; ++ai)
#pragma unroll
            for (int m = 0; m < 4; ++m) { const size_t r = (size_t)(row0 + ai * HALF + m * 16);
                if (u.pn == 0) {
#pragma unroll
                    for (int bj = 0; bj < 2; ++bj)
#pragma unroll
                        for (int n = 0; n < 2; ++n) *(f32x4*)(LG + r * NE + bj * HALF + cw + 4 * n) = acc[ai][bj][m][n];
                } else {
                    const f32x4 v0 = silu4(acc[ai][0][m][0]) * acc[ai][1][m][0], v1 = silu4(acc[ai][0][m][1]) * acc[ai][1][m][1];
                    *(u32x4*)(HS + r * EFF + (u.pn - 1) * HALF + cw) = pack8(v0, v1);
                }
                asm volatile("" ::: "memory"); }
    } };
struct MEpiAct { static constexpr bool PERM = true; bf16_t* ACT;
    DEV void operator()(ACC_T, const Unit& u, int wr, int wc, int fr, int fq) const {
        const int row0 = u.pm * BM + wr * 64 + fr, cw = u.pn * HALF + wc * 32 + 8 * fq;
#pragma unroll
        for (int ai = 0; ai < 2; ++ai)
#pragma unroll
            for (int m = 0; m < 4; ++m) { const size_t r = (size_t)(row0 + ai * HALF + m * 16);
                const f32x4 v0 = silu4(acc[ai][0][m][0]) * acc[ai][1][m][0], v1 = silu4(acc[ai][0][m][1]) * acc[ai][1][m][1];
                *(u32x4*)(ACT + r * EFF + cw) = pack8(v0, v1); asm volatile("" ::: "memory"); }
    } };
constexpr float SLAB_SCALE = 8.f, SLAB_INV = 0.125f;
DEV unsigned pk4_fp8(float a, float b, float c, float d) {
    a = fminf(fmaxf(a, -440.f), 440.f); b = fminf(fmaxf(b, -440.f), 440.f); c = fminf(fmaxf(c, -440.f), 440.f); d = fminf(fmaxf(d, -440.f), 440.f);
    int w = 0; w = __builtin_amdgcn_cvt_pk_fp8_f32(a, b, w, false); w = __builtin_amdgcn_cvt_pk_fp8_f32(c, d, w, true); return (unsigned)w; }
struct MEpiSlab { static constexpr bool PERM = true; unsigned char* SLAB; const int* rl; const float* w;
    DEV void operator()(ACC_T, const Unit& u, int wr, int wc, int fr, int fq) const {
        const int row0 = u.pm * BM + wr * 64 + fr, c16 = u.pn * BM + wc * 64 + 16 * fq;
#pragma unroll
        for (int ai = 0; ai < 2; ++ai)
#pragma unroll
            for (int m = 0; m < 4; ++m) { const int s = rl[row0 + ai * HALF + m * 16]; const float g = w[row0 + ai * HALF + m * 16] * SLAB_SCALE;
                if (s >= 0) { u32x4 o;
                    { const f32x4 a = acc[ai][0][m][0] * g, b = acc[ai][0][m][1] * g; o.x = pk4_fp8(a[0], a[1], a[2], a[3]); o.y = pk4_fp8(b[0], b[1], b[2], b[3]); }
                    { const f32x4 a = acc[ai][1][m][0] * g, b = acc[ai][1][m][1] * g; o.z = pk4_fp8(a[0], a[1], a[2], a[3]); o.w = pk4_fp8(b[0], b[1], b[2], b[3]); }
                    *(u32x4*)(SLAB + (size_t)s * DM + c16) = o; }
                asm volatile("" ::: "memory"); }
    } };
DEV void acc4_fp8(f32x4& a, unsigned w) { const auto lo = __builtin_amdgcn_cvt_pk_f32_fp8((int)w, false), hi = __builtin_amdgcn_cvt_pk_f32_fp8((int)w, true); a[0] += lo[0]; a[1] += lo[1]; a[2] += hi[0]; a[3] += hi[1]; }
struct MEpiFinal { static constexpr bool PERM = true; float* out; const unsigned char* SLAB; const float* mod;
    DEV void operator()(ACC_T, const Unit& u, int wr, int wc, int fr, int fq) const {
        const int row0 = u.pm * BM + wr * 64 + fr, c16 = u.pn * BM + wc * 64 + 16 * fq;
        const float* gm = mod + ((u.pm * BM) / SEQ) * NMOD + 5120 + c16;
#pragma unroll
        for (int ai = 0; ai < 2; ++ai)
#pragma unroll
            for (int m = 0; m < 4; ++m) { const size_t row = (size_t)(row0 + ai * HALF + m * 16);
                const unsigned char* sp = SLAB + row * 8 * DM + c16;
                float* op = out + row * DM + c16;
                f32x4 s4[4];
#pragma unroll
                for (int q = 0; q < 4; ++q) s4[q] = (f32x4){0.f, 0.f, 0.f, 0.f};
#pragma unroll
                for (int kh = 0; kh < 2; ++kh) { u32x4 sw[4];
#pragma unroll
                    for (int k = 0; k < 4; ++k) sw[k] = *(const u32x4*)(sp + (size_t)(kh * 4 + k) * DM);
#pragma unroll
                    for (int k = 0; k < 4; ++k) { acc4_fp8(s4[0], sw[k].x); acc4_fp8(s4[1], sw[k].y); acc4_fp8(s4[2], sw[k].z); acc4_fp8(s4[3], sw[k].w); } }
                s4[0] = s4[0] * SLAB_INV + acc[ai][0][m][0]; s4[1] = s4[1] * SLAB_INV + acc[ai][0][m][1]; s4[2] = s4[2] * SLAB_INV + acc[ai][1][m][0]; s4[3] = s4[3] * SLAB_INV + acc[ai][1][m][1];
#pragma unroll
                for (int q = 0; q < 4; ++q) *(f32x4*)(op + 4 * q) = *(const f32x4*)(op + 4 * q) + *(const f32x4*)(gm + 4 * q) * s4[q];
                asm volatile("" ::: "memory"); }
    } };
#undef ACC_T
}

typedef float f32x16 __attribute__((ext_vector_type(16)));
typedef short s16x4 __attribute__((ext_vector_type(4)));
DEV int crow(int r, int hi) { return (r & 3) + 8 * (r >> 2) + 4 * hi; }
DEV unsigned cvtpk(float lo, float hi) { unsigned r; asm("v_cvt_pk_bf16_f32 %0, %1, %2" : "=v"(r) : "v"(lo), "v"(hi)); return r; }
DEV s16x4 vtr(const LAS unsigned char* p) { return __builtin_bit_cast(s16x4, __builtin_amdgcn_ds_read_tr16_b64_v4i16((LAS s16x4*)p)); }
DEV float swap32(float v) { return __shfl_xor(v, 32); }

DEV void normrope_frag(bf16x8 (&f)[4], const LAS float* gt, int hi, float posf) {
    float x[32]; float ss = 0.f;
#pragma unroll
    for (int d0 = 0; d0 < 4; ++d0) { const u32x4 w = __builtin_bit_cast(u32x4, f[d0]);
        x[8 * d0 + 0] = __uint_as_float(w.x << 16); x[8 * d0 + 1] = __uint_as_float(w.x & 0xffff0000u); x[8 * d0 + 2] = __uint_as_float(w.y << 16); x[8 * d0 + 3] = __uint_as_float(w.y & 0xffff0000u);
        x[8 * d0 + 4] = __uint_as_float(w.z << 16); x[8 * d0 + 5] = __uint_as_float(w.z & 0xffff0000u); x[8 * d0 + 6] = __uint_as_float(w.w << 16); x[8 * d0 + 7] = __uint_as_float(w.w & 0xffff0000u); }
#pragma unroll
    for (int i = 0; i < 32; ++i) ss += x[i] * x[i];
    ss += __shfl_xor(ss, 32);
    const float rs = rsqrtf(ss * (1.f / 64.f) + 1e-6f);
#pragma unroll
    for (int d0 = 0; d0 < 4; ++d0) { const f32x4 g0 = *(const LAS f32x4*)(gt + 16 * d0 + 8 * hi), g1 = *(const LAS f32x4*)(gt + 16 * d0 + 8 * hi + 4);
#pragma unroll
        for (int j = 0; j < 4; ++j) { x[8 * d0 + j] *= rs * g0[j]; x[8 * d0 + 4 + j] *= rs * g1[j]; } }
    constexpr float INVF[8] = {1.0f, 0.19392274474868576f, 0.03760603093086393f, 0.007292664737217109f, 0.001414213562373095f, 0.0002742481756762073f, 5.318295896944988e-05f, 1.031338537721246e-05f};
#pragma unroll
    for (int i = 0; i < 8; ++i) {
        const float rev = posf * (INVF[i] * 0.15915494309189535f);
        const float fr = rev - floorf(rev);
        const float cs = __builtin_amdgcn_cosf(fr), sn = __builtin_amdgcn_sinf(fr);
        const float partner = __shfl_xor(x[i], 32);
        x[i] = hi ? (x[i] * cs + partner * sn) : (x[i] * cs - partner * sn);
    }
#pragma unroll
    for (int d0 = 0; d0 < 4; ++d0) { u32x4 w; w.x = cvtpk(x[8 * d0], x[8 * d0 + 1]); w.y = cvtpk(x[8 * d0 + 2], x[8 * d0 + 3]); w.z = cvtpk(x[8 * d0 + 4], x[8 * d0 + 5]); w.w = cvtpk(x[8 * d0 + 6], x[8 * d0 + 7]);
        f[d0] = __builtin_bit_cast(bf16x8, w); }
}

DEV void ph_attn_mfma(const P& p, LAS unsigned char* lds, int bid, int nb) {
    const int tid = otid(); const int lane = tid & 63, wid = __builtin_amdgcn_readfirstlane(tid >> 6), r32 = lane & 31, hi = lane >> 5;
    LAS unsigned char* vl = lds + wid * 8192;
    LAS float* wsf = (LAS float*)(lds + wid * 8192 + 4096);
    LAS float* gtab_q = (LAS float*)(lds + wid * 8192 + 4352);
    LAS float* gtab_k = gtab_q + 64;
    gtab_q[lane] = p.q_norm_g[lane]; gtab_k[lane] = p.k_norm_g[lane];
    asm volatile("s_waitcnt lgkmcnt(0)" ::: "memory");
    float gq = fabsf(p.q_norm_g[lane]), gk = fabsf(p.k_norm_g[lane]);
#pragma unroll
    for (int o = 32; o >= 1; o >>= 1) { gq = fmaxf(gq, __shfl_xor(gq, o)); gk = fmaxf(gk, __shfl_xor(gk, o)); }
    constexpr float LOG2E = 1.4426950408889634f, C2 = 0.125f * LOG2E;
    const float nmref = -(8.f * gq * gk * LOG2E);
    const int head = wid >> 1, qh = wid & 1;
    const int tq = (lane & 15) >> 2, tp = lane & 3, tcb = (lane >> 4) & 1;
    const LAS unsigned char* vrd = vl + (4 * hi + tq) * 128 + (16 * tcb + 4 * tp) * 2;
    for (int it = bid; it < NB * 96; it += nb) {
        const int cb = it & 31, g = (it >> 5) % 3, b = it / 96;
        const int dsh = 2 * g, d = 1 << dsh, L = SEQ >> dsh, nbk = L >> 6;
        const int r = cb / nbk, blk = cb % nbk;
        const int h = 4 * g + head, base = b * SEQ;
        const int q0 = 64 * blk + 32 * qh;
        const int mq = q0 + r32;
        const bf16_t* qp = p.QKV + (size_t)(base + mq * d + r) * 2304 + h * 64 + hi * 8;
        bf16x8 qr[4];
#pragma unroll
        for (int d0 = 0; d0 < 4; ++d0) qr[d0] = *(const bf16x8*)(qp + d0 * 16);
        normrope_frag(qr, gtab_q, hi, (float)p.pos[base + mq * d + r]);
        f32x16 o0, o1;
#pragma unroll
        for (int i = 0; i < 16; ++i) { o0[i] = 0.f; o1[i] = 0.f; }
        float lsum = 0.f;
        const int kb0 = q0 - 64;
#pragma unroll 1
        for (int st = 0; st < 5; ++st) {
            const int k0 = kb0 + 32 * st;
            if (k0 + 31 < 0 || k0 >= L) continue;
            const int mkc = min(max(k0 + r32, 0), L - 1);
            const bf16_t* kp = p.QKV + (size_t)(base + mkc * d + r) * 2304 + 768 + h * 64 + hi * 8;
            bf16x8 kf[4];
#pragma unroll
            for (int d0 = 0; d0 < 4; ++d0) kf[d0] = *(const bf16x8*)(kp + d0 * 16);
            const float kposf = (float)p.pos[base + mkc * d + r];
            u32x4 vreg[4];
#pragma unroll
            for (int i = 0; i < 4; ++i) { const int c = lane + 64 * i, row = c >> 3, ch = c & 7; const int mv = min(max(k0 + row, 0), L - 1);
                vreg[i] = *(const u32x4*)(p.QKV + (size_t)(base + mv * d + r) * 2304 + 1536 + h * 64 + ch * 8); }
            normrope_frag(kf, gtab_k, hi, kposf);
            f32x16 s;
#pragma unroll
            for (int i = 0; i < 16; ++i) s[i] = 0.f;
#pragma unroll
            for (int d0 = 0; d0 < 4; ++d0) s = __builtin_amdgcn_mfma_f32_32x32x16_bf16(kf[d0], qr[d0], s, 0, 0, 0);
#pragma unroll
            for (int i = 0; i < 16; ++i) { const int key = k0 + crow(i, hi); const int df = key - mq;
                const bool valid = (key >= 0) && (key < L) && (df <= 64) && (df >= -64);
                const float pv = valid ? __builtin_amdgcn_exp2f(__builtin_fmaf(s[i], C2, nmref)) : 0.f; lsum += pv; s[i] = pv; }
            bf16x8 pf0, pf1;
            { u32x4 w0, w1; w0.x = cvtpk(s[0], s[1]); w0.y = cvtpk(s[2], s[3]); w0.z = cvtpk(s[4], s[5]); w0.w = cvtpk(s[6], s[7]);
              w1.x = cvtpk(s[8], s[9]); w1.y = cvtpk(s[10], s[11]); w1.z = cvtpk(s[12], s[13]); w1.w = cvtpk(s[14], s[15]);
              pf0 = __builtin_bit_cast(bf16x8, w0); pf1 = __builtin_bit_cast(bf16x8, w1); }
#pragma unroll
            for (int i = 0; i < 4; ++i) { const int c = lane + 64 * i, row = c >> 3, ch = c & 7; *(LAS u32x4*)(vl + row * 128 + ch * 16) = vreg[i]; }
            asm volatile("s_waitcnt lgkmcnt(0)" ::: "memory");
#pragma unroll
            for (int n = 0; n < 2; ++n)
#pragma unroll
                for (int ks = 0; ks < 2; ++ks) {
                    const s16x4 lo = vtr(vrd + (16 * ks) * 128 + 64 * n), hi4 = vtr(vrd + (16 * ks + 8) * 128 + 64 * n);
                    bf16x8 vf; vf[0] = lo[0]; vf[1] = lo[1]; vf[2] = lo[2]; vf[3] = lo[3]; vf[4] = hi4[0]; vf[5] = hi4[1]; vf[6] = hi4[2]; vf[7] = hi4[3];
                    if (n == 0) o0 = __builtin_amdgcn_mfma_f32_32x32x16_bf16(ks == 0 ? pf0 : pf1, vf, o0, 0, 0, 0);
                    else o1 = __builtin_amdgcn_mfma_f32_32x32x16_bf16(ks == 0 ? pf0 : pf1, vf, o1, 0, 0, 0);
                }
            asm volatile("s_waitcnt lgkmcnt(0)" ::: "memory");
        }
        const float lt = lsum + swap32(lsum);
        if (hi == 0) { wsf[r32] = 1.f / lt; p.LSUM[((size_t)g * T + (base + mq * d + r)) * 4 + head] = lt; }
        asm volatile("s_waitcnt lgkmcnt(0)" ::: "memory");
        bf16_t* og = p.OG + (size_t)g * T * 256 + head * 64 + r32;
#pragma unroll
        for (int i = 0; i < 16; ++i) { const int qq = crow(i, hi); const float inv = wsf[qq]; const size_t tok = (size_t)(base + (q0 + qq) * d + r);
            og[tok * 256] = f2bf(o0[i] * inv); og[tok * 256 + 32] = f2bf(o1[i] * inv); }
        asm volatile("s_waitcnt lgkmcnt(0)" ::: "memory");
    }
}
DEV void ph_attn_combine(const P& p, int bid, int nb) {
    const int tid_ = otid();
    for (int i = bid * NTHR + tid_; i < T * 32; i += nb * NTHR) {
        const int t = i >> 5, ch = i & 31, slot = ch >> 3;
        const float l0 = p.LSUM[(size_t)t * 4 + slot], l1 = p.LSUM[((size_t)T + t) * 4 + slot], l2 = p.LSUM[((size_t)2 * T + t) * 4 + slot];
        const float inv = 1.f / (l0 + l1 + l2);
        const u32x4 a = *(const u32x4*)(p.OG + (size_t)t * 256 + ch * 8), b = *(const u32x4*)(p.OG + ((size_t)T + t) * 256 + ch * 8), c = *(const u32x4*)(p.OG + ((size_t)2 * T + t) * 256 + ch * 8);
        const f32x4 lo = (mg::unpack_lo(a) * l0 + mg::unpack_lo(b) * l1 + mg::unpack_lo(c) * l2) * inv;
        const f32x4 hi = (mg::unpack_hi(a) * l0 + mg::unpack_hi(b) * l1 + mg::unpack_hi(c) * l2) * inv;
        *(u32x4*)(p.O + (size_t)t * 256 + ch * 8) = mg::pack8(lo, hi);
    }
}

template <class Src>
DEV void transpose_blk(const Src& src, int K, bf16_t* WT0, LAS float* scr, int k0, int lane) {
#pragma unroll 8
    for (int i = 0; i < 32; ++i) { const int kk = 2 * i + (lane >> 5); scr[kk * 33 + (lane & 31)] = src(k0 + kk, lane & 31); }
    asm volatile("s_waitcnt lgkmcnt(0)" ::: "memory");
    const int c = lane & 7;
#pragma unroll
    for (int j = 0; j < 4; ++j) { const int n = (lane >> 3) + 8 * j; const LAS float* s = scr + (8 * c) * 33 + n;
        u32x4 o; o.x = pk2(s[0 * 33], s[1 * 33]); o.y = pk2(s[2 * 33], s[3 * 33]); o.z = pk2(s[4 * 33], s[5 * 33]); o.w = pk2(s[6 * 33], s[7 * 33]);
        *(u32x4*)(WT0 + (size_t)n * K + k0 + 8 * c) = o; }
    asm volatile("s_waitcnt lgkmcnt(0)" ::: "memory");
}
struct SrcCol { const float* W; int ld; DEV float operator()(int k, int j) const { return W[(size_t)k * ld + j]; } };
struct SrcEff { const float *wg, *ls, *wu;
    DEV float operator()(int k, int j) const { const int g = k >> 7; const float* a = wg + (size_t)k * 128; const float* l = ls + g * 128; const float* b = wu + (size_t)(g * 128) * DM + j; float s = 0.f;
#pragma unroll 4
        for (int d = 0; d < 128; ++d) s += a[d] * l[d] * b[(size_t)d * DM]; return s; } };
DEV void tr_plain(const float* W, int K, int N, bf16_t* WT, LAS float* scr, int item, int lane) {
    const int nblk = N / 32, k0 = 64 * (item / nblk), n0 = 32 * (item % nblk);
    transpose_blk(SrcCol{W + n0, N}, K, WT + (size_t)n0 * K, scr, k0, lane);
}
DEV void tr_perm16(const float* W, int K, int N, bf16_t* WT, LAS float* scr, int item, int lane) {
    const int nblk = N / 32, k0 = 64 * (item / nblk), rho0 = 32 * (item % nblk);
    const int tile = rho0 >> 8, bj = (rho0 >> 7) & 1, wc = (rho0 >> 5) & 3;
    const int n0 = tile * 256 + 64 * wc + 8 * bj;
    struct SrcP { const float* W; int ld; DEV float operator()(int k, int dr) const { return W[(size_t)k * ld + 16 * (dr >> 3) + (dr & 7)]; } };
    transpose_blk(SrcP{W + n0, N}, K, WT + (size_t)rho0 * K, scr, k0, lane);
}
DEV void tr_gu(const float* g, const float* u, int K, bf16_t* WT, LAS float* scr, int k0, int rho0, int lane) {
    const int ch0 = (rho0 >> 8) * 128 + (rho0 & 127);
    const float* m = (rho0 & 128) ? u : g;
    transpose_blk(SrcCol{m + ch0, EFF}, K, WT + (size_t)rho0 * K, scr, k0, lane);
}

DEV void ph_prep_small(const P& p, LAS float* scr, int gw, int ngw, int lane) {
    constexpr int I_IN = 16 * (INW / 32), I_EFF = 64 * 16, I_AU = 4 * 32, I_OUT = 16 * 32, I_R = 16 * 8, I_S = 16 * 16, I_SD = 4 * 32;
    constexpr int NIT = I_IN + I_EFF + I_AU + I_OUT + I_R + I_S + I_SD;
    for (int it = gw; it < NIT; it += ngw) {
        int r = it;
        if (r < I_IN) { tr_plain(p.w_in, DM, INW, p.WT_IN, scr, r, lane); continue; } r -= I_IN;
        if (r < I_EFF) {
            const int n = 64 * (r & 15) + lane, k0 = 8 * (r >> 4), g = k0 >> 7;
            const float* a = p.pool_w_grp + (size_t)k0 * 128; const float* l = p.pool_scale + g * 128; const float* b = p.w_pool_up + (size_t)(g * 128) * DM + n;
            float acc[8];
#pragma unroll
            for (int j = 0; j < 8; ++j) acc[j] = 0.f;
#pragma unroll 4
            for (int d = 0; d < 128; ++d) { const float bl = b[(size_t)d * DM] * l[d];
#pragma unroll
                for (int j = 0; j < 8; ++j) acc[j] += a[j * 128 + d] * bl; }
            u32x4 o; o.x = pk2(acc[0], acc[1]); o.y = pk2(acc[2], acc[3]); o.z = pk2(acc[4], acc[5]); o.w = pk2(acc[6], acc[7]);
            *(u32x4*)(p.WT_EFF + (size_t)n * 512 + k0) = o; continue; } r -= I_EFF;
        if (r < I_AU) { tr_plain(p.w_attn_up, 256, DM, p.WT_AU, scr, r, lane); continue; } r -= I_AU;
        if (r < I_OUT) { tr_plain(p.w_out, DM, DM, p.WT_OUT, scr, r, lane); continue; } r -= I_OUT;
        if (r < I_R) { tr_plain(p.w_router, DM, NE, p.WT_RS, scr, r, lane); continue; } r -= I_R;
        if (r < I_S) { tr_gu(p.w_sg, p.w_su, DM, p.WT_RS + (size_t)256 * DM, scr, 64 * (r / 16), 32 * (r % 16), lane); continue; } r -= I_S;
        tr_perm16(p.w_sd, EFF, DM, p.WT_SD, scr, r, lane);
    }
}
DEV void ph_prep_ed(const P& p, LAS float* scr, int gw, int ngw, int lane) {
    constexpr int IPE = 4 * 32;
    for (int it = gw; it < NE * IPE; it += ngw) { const int e = it / IPE;
        tr_perm16(p.w_ed + (size_t)e * EFF * DM, EFF, DM, p.WT_ED + (size_t)e * DM * EFF, scr, it % IPE, lane); }
}
DEV void ph_prep_egu(const P& p, LAS float* scr, int gw, int ngw, int lane) {
    constexpr int IPE = 16 * 16;
    for (int it = gw; it < NE * IPE; it += ngw) { const int e = it / IPE, r = it % IPE;
        tr_gu(p.w_eg + (size_t)e * DM * EFF, p.w_eu + (size_t)e * DM * EFF, DM, p.WT_EGU + (size_t)e * 512 * DM, scr, 64 * (r / 16), 32 * (r % 16), lane); }
}

constexpr int LDS_BYTES = 147456;
constexpr int LDS_OFF_TAB = 131072;
constexpr int LDS_GTAB = 131072 + 2560;
constexpr int MAXU = 10;
constexpr int LDS_MISC = LDS_GTAB + MAXU * 1024;

DEV void fill_gtab(const P& p, const LAS int* off, LAS unsigned* gtab, int ncol, int bid, int nb) {
    const int nrt = off[NE] / 256, tot = nrt * ncol; const int tid_ = otid();
    for (int i = 0; i < MAXU; ++i) { const int L = i * nb + bid; if (L >= tot) break;
        const int pm = L / ncol;
        if (tid_ < 256) { const int s = p.rowlist[pm * 256 + tid_]; gtab[i * 256 + tid_] = (unsigned)(s < 0 ? 0 : (s >> 3)) * (unsigned)(DM * 2); } }
    __syncthreads();
}


#define GAS __attribute__((address_space(1)))
#define XB_TMO      128
#define XB_XCNT(j)  (256  + 64 * (j))
#define XB_XSUB(j)  (1280 + 64 * (j))
#define XB_XGEN(j)  (2304 + 64 * (j))
#define XB_TOP      3328
#define XB_TOPGEN   3392
#define XCD_BAR_WORDS 3456
#define XB_SPIN_CAP (1u << 18)
DEV unsigned xb_ld(unsigned* p)              { return __hip_atomic_load(p, __ATOMIC_RELAXED, __HIP_MEMORY_SCOPE_AGENT); }
DEV unsigned xb_add(unsigned* p, unsigned v) { return __hip_atomic_fetch_add(p, v, __ATOMIC_RELAXED, __HIP_MEMORY_SCOPE_AGENT); }
DEV unsigned xb_xcc_id() { return (unsigned)__builtin_amdgcn_s_getreg((3 << 11) | 20) & 0xFu; }
#define XB_SPIN(cond, bar) do { unsigned _sp = 0; while (cond) { __builtin_amdgcn_s_sleep(1); \
    if ((++_sp & 255u) == 0u) { if (xb_ld(&(bar)[XB_TMO])) break; if (_sp > XB_SPIN_CAP) { atomicAdd(&(bar)[XB_TMO], 1u); break; } } } } while (0)
struct XcdBarrier { unsigned* bar; unsigned x; volatile LAS unsigned* st; };
DEV XcdBarrier xcd_barrier_post(unsigned* bar, volatile LAS unsigned* st) {
    XcdBarrier b; b.bar = bar; b.x = xb_xcc_id(); b.st = st;
    if (threadIdx.x == 0) (void)xb_add(&bar[XB_XCNT(b.x)], 1u);
    return b;
}
DEV void xcd_barrier_complete(unsigned* bar, unsigned x, unsigned& nloc, unsigned& nx) {
    const unsigned G = gridDim.x * gridDim.y * gridDim.z;
    unsigned sum, cnt, mine, sp = 0u;
    for (;;) {
        sum = 0u; cnt = 0u; mine = 0u;
#pragma unroll
        for (unsigned j = 0; j < 16; ++j) { const unsigned c = xb_ld(&bar[XB_XCNT(j)]); sum += c; cnt += (c > 0u) ? 1u : 0u; mine = (j == x) ? c : mine; }
        if (sum == G) break;
        __builtin_amdgcn_s_sleep(1);
        if ((++sp & 255u) == 0u) { if (xb_ld(&bar[XB_TMO])) break; if (sp > XB_SPIN_CAP) { atomicAdd(&bar[XB_TMO], 1u); break; } }
    }
    nloc = mine > 0u ? mine : 1u; nx = cnt > 0u ? cnt : 1u;
}
DEV void xcd_barrier(const XcdBarrier& b) {
    asm volatile("s_waitcnt vmcnt(0)" ::: "memory");
    __syncthreads();
    if (threadIdx.x == 0) {
        unsigned* bar = b.bar;
        __builtin_amdgcn_s_waitcnt(0);
        unsigned nloc = b.st[0], nx = b.st[1];
        if (nloc == 0u) { xcd_barrier_complete(bar, b.x, nloc, nx); b.st[0] = nloc; b.st[1] = nx; }
        const unsigned old = xb_add(&bar[XB_XSUB(b.x)], 1u);
        const unsigned gen = old / nloc;
        if (old + 1u == (gen + 1u) * nloc) {
            __builtin_amdgcn_fence(__ATOMIC_RELEASE, "agent");
            asm volatile("s_waitcnt vmcnt(0)" ::: "memory");
            const unsigned og = xb_add(&bar[XB_TOP], 1u);
            const unsigned tg = og / nx;
            if (og + 1u == (tg + 1u) * nx) xb_add(&bar[XB_TOPGEN], 1u);
            else XB_SPIN(xb_ld(&bar[XB_TOPGEN]) == tg, bar);
            __builtin_amdgcn_fence(__ATOMIC_ACQUIRE, "agent");
            xb_add(&bar[XB_XGEN(b.x)], 1u);
            asm volatile("s_waitcnt vmcnt(0)" ::: "memory");
        } else {
            XB_SPIN(xb_ld(&bar[XB_XGEN(b.x)]) == gen, bar);
            __builtin_amdgcn_fence(__ATOMIC_ACQUIRE, "agent");
            asm volatile("s_waitcnt vmcnt(0)" ::: "memory");
        }
    }
    __syncthreads();
}

#define STAMP() do { if (TPROBE >= 0) { if (bid == 0 && threadIdx.x == 0) p.ts[nst] = __builtin_amdgcn_s_memrealtime(); ++nst; } } while (0)
#define GSYNC_CG() do { cg::this_grid().sync(); STAMP(); } while (0)
#define GSYNC() do { xcd_barrier(xbar); STAMP(); } while (0)
__global__ void __launch_bounds__(NTHR, 2) fwd_all(P p) {
    extern __shared__ __attribute__((aligned(16))) unsigned char lds_raw[];
    LAS unsigned char* lds = (LAS unsigned char*)lds_raw;
    float* sm = (float*)lds_raw;
    int* off = (int*)(lds_raw + LDS_OFF_TAB);
    const LAS int* offl = (const LAS int*)(lds + LDS_OFF_TAB);
    LAS unsigned* gtab = (LAS unsigned*)(lds + LDS_GTAB);
    const int bid = blockIdx.x, nb = gridDim.x;
    const int tid_ = otid(); const int lane = tid_ & 63, wv = tid_ >> 6;
    LAS float* scr = (LAS float*)(lds + wv * 16384);
    const int gw = bid * NWV + wv, ngw = nb * NWV;
    volatile LAS unsigned* misc = (volatile LAS unsigned*)(lds + LDS_MISC);
    if (threadIdx.x < 2) misc[threadIdx.x] = 0u;
    __syncthreads();
    const XcdBarrier xbar = xcd_barrier_post(p.bar, misc);
    int nst = 0; STAMP();

    ph_mod(p, sm, bid, nb);
    __syncthreads();
    REPEAT(1) ph_prep_small(p, scr, gw, ngw, lane);
#if MF_EXP2
    REPEAT(2) ph_prep_ed(p, scr, gw, ngw, lane);
#endif
    GSYNC_CG();
    REPEAT(3) ph_norm(p.x, p.norm1_g, p.mod, 0, 1024, p.XB, bid, nb);
    GSYNC();
#if MF_INPROJ
    REPEAT(4) { mg::DenseOrder S; S.init(p.XB, p.WT_IN, T, INW, DM, nb, bid);
      mg::gemm_phase<mg::MEpiInProj, mg::DenseOrder, false>(lds, gtab, DM, S, mg::MEpiInProj{p.U, p.QKV, p.G}); }
#else
    ngemm_dense<false>(p.XB, DM, p.w_in, nullptr, INW, T, INW, DM, EpiInProj{p.U, p.QKV, p.G}, sm, bid, nb);
#endif
    GSYNC();
#if !MF_ATTN
    ph_qknorm(p, bid, nb);
#endif
    REPEAT(5) ph_pool(p, bid, nb);
    GSYNC();
#if MF_ATTN
    REPEAT(6) ph_attn_mfma(p, lds, bid, nb);
    GSYNC();
    REPEAT(7) ph_attn_combine(p, bid, nb);
#else
    ph_attn(p, bid, nb);
#endif
#if !MF_MERGE
#pragma unroll 1
    for (int g = 0; g < 4; ++g) ngemm_dense<false>(p.PL + g * 128, 512, p.pool_w_grp + g * 128 * 128, nullptr, 128, T, 128, 128, EpiPoolGrp{p.Y, p.pool_scale, g}, sm, bid, nb);
#endif
    GSYNC();
#if MF_MERGE
    REPEAT(8) { mg::DenseOrder S; S.init(p.PL, p.WT_EFF, T, DM, 512, nb, bid);
      mg::gemm_phase<mg::MEpiMerge<false>, mg::DenseOrder, false>(lds, gtab, 512, S, mg::MEpiMerge<false>{p.XB, p.G}); }
    { mg::DenseOrder S; S.init(p.O, p.WT_AU, T, DM, 256, nb, bid);
      mg::gemm_phase<mg::MEpiMerge<true>, mg::DenseOrder, false>(lds, gtab, 256, S, mg::MEpiMerge<true>{p.XB, p.G}); }
#else
    ngemm_dense<false>(p.Y, 512, p.w_pool_up, nullptr, DM, T, DM, 512, EpiMergeA{p.XB, p.G}, sm, bid, nb);
    GSYNC();
    ngemm_dense<false>(p.O, 256, p.w_attn_up, nullptr, DM, T, DM, 256, EpiMergeB{p.XB, p.G}, sm, bid, nb);
#endif
    GSYNC();
#if MF_OUT
    REPEAT(9) { mg::DenseOrder S; S.init(p.XB, p.WT_OUT, T, DM, DM, nb, bid);
      mg::gemm_phase<mg::MEpiOutProj, mg::DenseOrder, false>(lds, gtab, DM, S, mg::MEpiOutProj{p.x, p.out, p.mod}); }
#else
    ngemm_dense<false>(p.XB, DM, p.w_out, nullptr, DM, T, DM, DM, EpiOutProj{p.x, p.out, p.mod}, sm, bid, nb);
#endif
    GSYNC();
    REPEAT(10) ph_norm(p.out, p.norm2_g, p.mod, 3072, 4096, p.XB, bid, nb);
#if MF_EXP1
    __syncthreads();
    REPEAT(11) ph_prep_egu(p, scr, gw, ngw, lane);
#endif
    GSYNC();
#if MF_ROUTER
    REPEAT(12) { mg::DenseOrder S; S.init(p.XB, p.WT_RS, T, 768, DM, nb, bid);
      mg::gemm_phase<mg::MEpiRouterShared, mg::DenseOrder, false>(lds, gtab, DM, S, mg::MEpiRouterShared{p.LG, p.HS}); }
#else
    ngemm_dense<false>(p.XB, DM, p.w_router, nullptr, NE, T, NE, DM, EpiLogits{p.LG}, sm, bid, nb);
#endif
    GSYNC();
    ph_route(p, bid, nb);
    GSYNC();
    ph_scatter(p, off, bid, nb);
    GSYNC();
#if MF_EXP1
    REPEAT(13) { load_offsets(p.cnt, off); fill_gtab(p, offl, gtab, 2, bid, nb);
      mg::ExpertOrder S{offl, __builtin_amdgcn_readfirstlane(off[NE]) / 256, 2, nb, bid, (const char*)p.XB, (const char*)p.WT_EGU, (size_t)512 * DM * 2, (size_t)256 * DM * 2, 0, true};
      mg::gemm_phase<mg::MEpiAct, mg::ExpertOrder, true>(lds, gtab, DM, S, mg::MEpiAct{p.ACT}); }
#else
    ph_expert1(p, sm, off, bid, nb);
#endif
    GSYNC();
#if MF_EXP2
    REPEAT(14) { load_offsets(p.cnt, off);
      mg::ExpertOrder S{offl, __builtin_amdgcn_readfirstlane(off[NE]) / 256, 4, nb, bid, (const char*)p.ACT, (const char*)p.WT_ED, (size_t)DM * EFF * 2, (size_t)256 * EFF * 2, (size_t)256 * EFF * 2, false};
      mg::gemm_phase<mg::MEpiSlab, mg::ExpertOrder, false>(lds, gtab, EFF, S, mg::MEpiSlab{(unsigned char*)p.SLAB, p.rowlist, p.roww}); }
#else
    ph_expert2(p, sm, off, bid, nb);
#endif
    GSYNC();
#if !MF_ROUTER
    ngemm_dense<true>(p.XB, DM, p.w_sg, p.w_su, EFF, T, EFF, DM, EpiAct{p.HS}, sm, bid, nb);
    GSYNC();
#endif
#if MF_FINAL
    { mg::DenseOrder S; S.init(p.HS, p.WT_SD, T, DM, EFF, nb, bid);
      mg::gemm_phase<mg::MEpiFinal, mg::DenseOrder, false>(lds, gtab, EFF, S, mg::MEpiFinal{p.out, (const unsigned char*)p.SLAB, p.mod}); }
#else
    ngemm_dense<false>(p.HS, EFF, p.w_sd, nullptr, DM, T, DM, EFF, EpiFinal{p.out, p.SLAB, p.mod}, sm, bid, nb);
#endif
#if TPROBE >= 0
    GSYNC();
    if (bid == 0 && threadIdx.x == 0) { const unsigned long long dt = p.ts[TPROBE + 1] - p.ts[TPROBE]; p.out[0] += (float)dt * 0.01f / TSCALE; }
#endif
}

extern "C" void kernel_launch(void* const* d_in, const int* in_sizes, int n_in, void* d_out, int out_size, void* d_ws, size_t ws_size, hipStream_t stream) {
    static int grid = 0;
    if (grid == 0) {
        int dev = 0, cus = 0;
        (void)hipGetDevice(&dev);
        (void)hipDeviceGetAttribute(&cus, hipDeviceAttributeMultiprocessorCount, dev);
        int per_cu = 0;
        (void)hipFuncSetAttribute((const void*)fwd_all, hipFuncAttributeMaxDynamicSharedMemorySize, LDS_BYTES);
        (void)hipOccupancyMaxActiveBlocksPerMultiprocessor(&per_cu, fwd_all, NTHR, LDS_BYTES);
        if (per_cu < 1) { fprintf(stderr, "kernel_launch: occupancy query says %d blocks/CU\n", per_cu); per_cu = 1; }
        if (per_cu > 1) per_cu = 1;
        grid = cus * per_cu;
        if (ws_size < WS_END) { fprintf(stderr, "kernel_launch: workspace too small (%zu < %zu)\n", ws_size, (size_t)WS_END); grid = -1; }
    }
    if (grid < 0) return;
    P p{};
    const float* const* in = (const float* const*)d_in;
    p.x = in[0]; p.c = in[1]; p.pos = (const int*)d_in[2];
    p.w_ada = in[3]; p.b_ada = in[4]; p.norm1_g = in[5]; p.w_in = in[6]; p.pool_w_grp = in[7]; p.pool_scale = in[8]; p.q_norm_g = in[9]; p.k_norm_g = in[10];
    p.w_pool_up = in[11]; p.w_attn_up = in[12]; p.w_out = in[13]; p.norm2_g = in[14]; p.w_router = in[15]; p.router_bias = in[16];
    p.w_sg = in[17]; p.w_su = in[18]; p.w_sd = in[19]; p.w_eg = in[20]; p.w_eu = in[21]; p.w_ed = in[22];
    p.out = (float*)d_out;
    char* ws = (char*)d_ws;
    p.mod = (float*)(ws + WS_MOD); p.cnt = (int*)(ws + WS_CNT); p.asg_e = (int*)(ws + WS_ASG_E); p.asg_pos = (int*)(ws + WS_ASG_POS);
    p.asg_w = (float*)(ws + WS_ASG_W); p.rowlist = (int*)(ws + WS_ROWLIST);
    p.XB = (bf16_t*)(ws + WS_XB); p.U = (bf16_t*)(ws + WS_U); p.QKV = (bf16_t*)(ws + WS_QKV); p.G = (bf16_t*)(ws + WS_G); p.PL = (bf16_t*)(ws + WS_PL);
    p.Y = (bf16_t*)(ws + WS_Y); p.O = (bf16_t*)(ws + WS_O); p.ACT = (bf16_t*)(ws + WS_ACT); p.SLAB = (bf16_t*)(ws + WS_SLAB); p.HS = (bf16_t*)(ws + WS_HS);
    p.LG = (float*)(ws + WS_ACT);
    p.roww = (float*)(ws + WS_ROWW);
    p.bar = (unsigned*)(ws + WS_BAR); p.ts = (unsigned long long*)(ws + WS_TS);
    p.OG = (bf16_t*)(ws + WS_OG); p.LSUM = (float*)(ws + WS_LSUM);
    p.WT_IN = (bf16_t*)(ws + WS_WT_IN); p.WT_EFF = (bf16_t*)(ws + WS_WT_EFF); p.WT_AU = (bf16_t*)(ws + WS_WT_AU); p.WT_OUT = (bf16_t*)(ws + WS_WT_OUT);
    p.WT_RS = (bf16_t*)(ws + WS_WT_RS); p.WT_SD = (bf16_t*)(ws + WS_WT_SD); p.WT_EGU = (bf16_t*)(ws + WS_WT_EGU); p.WT_ED = (bf16_t*)(ws + WS_WT_ED);
    (void)hipMemsetAsync(ws + WS_BAR, 0, WS_ZERO_BYTES, stream);
    void* args[] = {&p};
    hipError_t e = hipLaunchCooperativeKernel((void*)fwd_all, dim3(grid), dim3(NTHR), args, LDS_BYTES, stream);
    if (e != hipSuccess) fprintf(stderr, "cooperative launch failed: %s (grid %d)\n", hipGetErrorString(e), grid);
}
```

```cpp
#include <hip/hip_runtime.h>
#include <hip/hip_cooperative_groups.h>
#include <stdint.h>
#include <cstdio>
namespace cg = cooperative_groups;

#ifndef ONE_LAUNCH
#define ONE_LAUNCH 0
#endif

typedef unsigned short bf16_t;
#define DEV __device__ __forceinline__
#define LAS __attribute__((address_space(3)))
typedef short bf16x8 __attribute__((ext_vector_type(8)));
typedef float f32x4 __attribute__((ext_vector_type(4)));
typedef unsigned u32x4 __attribute__((ext_vector_type(4)));
typedef unsigned u32x2 __attribute__((ext_vector_type(2)));

#ifndef MF_INPROJ
#define MF_INPROJ 1
#endif
#ifndef MF_MERGE
#define MF_MERGE 1
#endif
#ifndef MF_OUT
#define MF_OUT 1
#endif
#ifndef MF_ROUTER
#define MF_ROUTER 1
#endif
#ifndef MF_EXP1
#define MF_EXP1 1
#endif
#ifndef MF_EXP2
#define MF_EXP2 1
#endif
#ifndef MF_ATTN
#define MF_ATTN 1
#endif
#ifndef DUP
#define DUP 0
#endif
#ifndef TPROBE
#define TPROBE -1
#endif
#ifndef TSCALE
#define TSCALE 10.0f
#endif
#define REPEAT(n) _Pragma("unroll 1") for (int rep_ = 0; rep_ < ((DUP == (n)) ? 2 : 1); ++rep_)
#ifndef MF_FINAL
#define MF_FINAL 1
#endif

constexpr int NB = 16, SEQ = 2048, DM = 1024, T = NB * SEQ;
constexpr int INW = 4864, NMOD = 6144;
constexpr int NE = 256, EFF = 256;
constexpr int NTHR = 512, NWV = 8;
constexpr int NSLOT = T * 8;
constexpr int RMAX = NSLOT + NE * 256;

DEV float bf2f(bf16_t h) { return __uint_as_float(((unsigned)h) << 16); }
DEV bf16_t f2bf(float f) { unsigned u = __float_as_uint(f); u += 0x7fffu + ((u >> 16) & 1u); return (bf16_t)(u >> 16); }
DEV unsigned pk2(float lo, float hi) { return (unsigned)f2bf(lo) | ((unsigned)f2bf(hi) << 16); }
DEV float sigm(float v) { return 1.f / (1.f + __expf(-v)); }
DEV float silu(float v) { return v / (1.f + __expf(-v)); }
DEV int otid() { int t = threadIdx.x; asm volatile("" : "+v"(t)); return t; }
DEV float wave_sum(float v) {
#pragma unroll
    for (int o = 32; o >= 1; o >>= 1) v += __shfl_xor(v, o);
    return v;
}

struct P {
    const float *x, *c; const int* pos;
    const float *w_ada, *b_ada, *norm1_g, *w_in, *pool_w_grp, *pool_scale, *q_norm_g, *k_norm_g, *w_pool_up, *w_attn_up, *w_out, *norm2_g,
        *w_router, *router_bias, *w_sg, *w_su, *w_sd, *w_eg, *w_eu, *w_ed;
    float* out;
    float* mod; int* cnt; int* asg_e; int* asg_pos; float* asg_w; int* rowlist;
    bf16_t *XB, *U, *QKV, *G, *PL, *Y, *O, *ACT, *SLAB, *HS;
    float* LG;
    bf16_t* OG; float* LSUM; unsigned* bar; unsigned long long* ts; float* roww;
    bf16_t *WT_IN, *WT_EFF, *WT_AU, *WT_OUT, *WT_RS, *WT_SD, *WT_EGU, *WT_ED;
};

constexpr size_t MiB = 1u << 20;
constexpr size_t WS_BAR = 640 * 1024, WS_BAR_BYTES = 16384, WS_ZERO_BYTES = 16384 + 65536;
constexpr size_t WS_TS = 800 * 1024;
constexpr size_t WS_MOD = 0, WS_CNT = WS_BAR + WS_BAR_BYTES, WS_ASG_E = 1 * MiB, WS_ASG_POS = 2 * MiB, WS_ASG_W = 3 * MiB, WS_ROWLIST = 4 * MiB, WS_ROWW = 6 * MiB;
constexpr size_t WS_XB = 8 * MiB;
constexpr size_t WS_ACT = 72 * MiB;
constexpr size_t WS_SLAB = 232 * MiB;
constexpr size_t WS_U = 232 * MiB, WS_QKV = 264 * MiB, WS_G = 408 * MiB, WS_PL = 536 * MiB, WS_Y = 568 * MiB, WS_O = 600 * MiB;
constexpr size_t WS_WT_IN = 744 * MiB, WS_WT_EFF = 754 * MiB, WS_WT_AU = 755 * MiB, WS_WT_OUT = 756 * MiB, WS_WT_RS = 758 * MiB, WS_WT_SD = 760 * MiB;
constexpr size_t WS_WT_ED = 762 * MiB;
constexpr size_t WS_WT_EGU = 232 * MiB;
constexpr size_t WS_OG = 616 * MiB, WS_LSUM = 664 * MiB;
constexpr size_t WS_HS = 890 * MiB;
constexpr size_t WS_END = 906 * MiB;

DEV void ph_mod(const P& p, float* sm, int bid, int nb) {
    const int tid_ = otid(); const int lane = tid_ & 63, wv = tid_ >> 6;
    for (int it = bid; it < 96; it += nb) {
        const int k0 = wv * 128, e = it * 64 + lane;
        float acc[16];
#pragma unroll
        for (int b = 0; b < 16; ++b) acc[b] = 0.f;
#pragma unroll 1
        for (int kh = 0; kh < 2; ++kh) {
            float sc[16];
#pragma unroll
            for (int b = 0; b < 16; ++b) sc[b] = silu(p.c[b * DM + k0 + kh * 64 + lane]);
            const float* wp = p.w_ada + (size_t)(k0 + kh * 64) * NMOD + e;
#pragma unroll 8
            for (int kk = 0; kk < 64; ++kk) { const float w = wp[(size_t)kk * NMOD];
#pragma unroll
                for (int b = 0; b < 16; ++b) acc[b] += __uint_as_float(__builtin_amdgcn_readlane(__float_as_uint(sc[b]), kk)) * w; }
        }
        __syncthreads();
#pragma unroll
        for (int b = 0; b < 16; ++b) sm[(wv * 16 + b) * 64 + lane] = acc[b];
        __syncthreads();
#pragma unroll
        for (int j = 0; j < 2; ++j) { const int idx = tid_ + j * NTHR, b = idx >> 6, col = idx & 63; float s = p.b_ada[it * 64 + col];
#pragma unroll
            for (int w = 0; w < 8; ++w) s += sm[(w * 16 + b) * 64 + col];
            p.mod[b * NMOD + it * 64 + col] = s; }
    }
}

DEV void ph_norm(const float* src, const float* g, const float* mod, int shift_off, int scale_off, bf16_t* dst, int bid, int nb) {
    const int tid_ = otid(); const int lane = tid_ & 63, wv = tid_ >> 6;
    for (int row0 = (bid * NWV + wv) * 2; row0 < T; row0 += nb * NWV * 2) {
        float4 v[2][4]; float ss[2] = {0.f, 0.f};
#pragma unroll
        for (int q = 0; q < 2; ++q) { const float4* xr = (const float4*)(src + (size_t)(row0 + q) * DM);
#pragma unroll
            for (int j = 0; j < 4; ++j) v[q][j] = xr[lane + 64 * j]; }
#pragma unroll
        for (int q = 0; q < 2; ++q)
#pragma unroll
            for (int j = 0; j < 4; ++j) ss[q] += v[q][j].x * v[q][j].x + v[q][j].y * v[q][j].y + v[q][j].z * v[q][j].z + v[q][j].w * v[q][j].w;
        const int b = row0 / SEQ;
#pragma unroll
        for (int q = 0; q < 2; ++q) {
            const float r = rsqrtf(wave_sum(ss[q]) * (1.f / DM) + 1e-6f);
#pragma unroll
            for (int j = 0; j < 4; ++j) {
                const int col = (lane + 64 * j) * 4;
                const float4 g4 = *(const float4*)(g + col);
                const float4 sc = *(const float4*)(mod + b * NMOD + scale_off + col);
                const float4 sh = *(const float4*)(mod + b * NMOD + shift_off + col);
                const float o0 = v[q][j].x * r * g4.x * (1.f + sc.x) + sh.x, o1 = v[q][j].y * r * g4.y * (1.f + sc.y) + sh.y;
                const float o2 = v[q][j].z * r * g4.z * (1.f + sc.z) + sh.z, o3 = v[q][j].w * r * g4.w * (1.f + sc.w) + sh.w;
                uint2 w; w.x = pk2(o0, o1); w.y = pk2(o2, o3);
                *(uint2*)(dst + (size_t)(row0 + q) * DM + col) = w;
            }
        }
    }
}

template <bool DUAL, class RowF, class Epi>
DEV void ngemm_tile(const bf16_t* __restrict__ A, int lda, RowF rowf, const float* __restrict__ B, const float* __restrict__ B2, int ldb,
                    int m0, int n0, int K, Epi epi, float* sm) {
    float* As = sm;
    float* Bs = sm + 16 * 132;
    float* Bs2 = Bs + 16 * 64;
    const int tid = otid(), tm = tid >> 4, tn = tid & 15;
    float acc[4][4], acc2[4][4];
#pragma unroll
    for (int i = 0; i < 4; ++i)
#pragma unroll
        for (int j = 0; j < 4; ++j) { acc[i][j] = 0.f; acc2[i][j] = 0.f; }
    const int ar = tid >> 2, ak = (tid & 3) * 4;
    const int arow = rowf(m0 + ar);
    const bf16_t* ap = A + (size_t)(arow < 0 ? 0 : arow) * lda + ak;
    const int bk = tid >> 5, bn = (tid & 31) * 2;
    for (int k0 = 0; k0 < K; k0 += 16) {
        uint2 av = make_uint2(0u, 0u);
        if (arow >= 0) av = *(const uint2*)(ap + k0);
        const float2 bv = *(const float2*)(B + (size_t)(k0 + bk) * ldb + n0 + bn);
        float2 bv2 = make_float2(0.f, 0.f);
        if (DUAL) bv2 = *(const float2*)(B2 + (size_t)(k0 + bk) * ldb + n0 + bn);
        __syncthreads();
        As[(ak + 0) * 132 + ar] = __uint_as_float(av.x << 16);
        As[(ak + 1) * 132 + ar] = __uint_as_float(av.x & 0xffff0000u);
        As[(ak + 2) * 132 + ar] = __uint_as_float(av.y << 16);
        As[(ak + 3) * 132 + ar] = __uint_as_float(av.y & 0xffff0000u);
        Bs[bk * 64 + bn] = bv.x; Bs[bk * 64 + bn + 1] = bv.y;
        if (DUAL) { Bs2[bk * 64 + bn] = bv2.x; Bs2[bk * 64 + bn + 1] = bv2.y; }
        __syncthreads();
#pragma unroll
        for (int kk = 0; kk < 16; ++kk) {
            const float4 a = *(const float4*)&As[kk * 132 + tm * 4];
            const float4 b = *(const float4*)&Bs[kk * 64 + tn * 4];
            const float aa[4] = {a.x, a.y, a.z, a.w}, bb[4] = {b.x, b.y, b.z, b.w};
#pragma unroll
            for (int i = 0; i < 4; ++i)
#pragma unroll
                for (int j = 0; j < 4; ++j) acc[i][j] += aa[i] * bb[j];
            if (DUAL) {
                const float4 b2 = *(const float4*)&Bs2[kk * 64 + tn * 4];
                const float cc[4] = {b2.x, b2.y, b2.z, b2.w};
#pragma unroll
                for (int i = 0; i < 4; ++i)
#pragma unroll
                    for (int j = 0; j < 4; ++j) acc2[i][j] += aa[i] * cc[j];
            }
        }
    }
#pragma unroll
    for (int i = 0; i < 4; ++i)
#pragma unroll
        for (int j = 0; j < 4; ++j) epi(m0 + tm * 4 + i, n0 + tn * 4 + j, acc[i][j], acc2[i][j]);
}

struct RowId { DEV int operator()(int m) const { return m; } };
struct RowTok { const int* rl; DEV int operator()(int m) const { const int s = rl[m]; return s < 0 ? -1 : (s >> 3); } };

template <bool DUAL, class Epi>
DEV void ngemm_dense(const bf16_t* A, int lda, const float* B, const float* B2, int ldb, int M, int N, int K, Epi epi, float* sm, int bid, int nb) {
    const int tn = N / 64, nt = (M / 128) * tn;
    for (int t = bid; t < nt; t += nb) ngemm_tile<DUAL>(A, lda, RowId(), B, B2, ldb, (t / tn) * 128, (t % tn) * 64, K, epi, sm);
}

struct EpiInProj { bf16_t *U, *QKV, *G;
    DEV void operator()(int r, int c, float v, float) const {
        if (c < 512) U[(size_t)r * 512 + c] = f2bf(v);
        else if (c < 2816) QKV[(size_t)r * 2304 + (c - 512)] = f2bf(v);
        else G[(size_t)r * 2048 + (c - 2816)] = f2bf(sigm(v)); } };
struct EpiPoolGrp { bf16_t* Y; const float* ls; int g;
    DEV void operator()(int r, int c, float v, float) const { Y[(size_t)r * 512 + g * 128 + c] = f2bf(v * ls[g * 128 + c]); } };
struct EpiMergeA { bf16_t* MG; const bf16_t* G;
    DEV void operator()(int r, int c, float v, float) const { MG[(size_t)r * DM + c] = f2bf(bf2f(G[(size_t)r * 2048 + c]) * v); } };
struct EpiMergeB { bf16_t* MG; const bf16_t* G;
    DEV void operator()(int r, int c, float v, float) const { const size_t i = (size_t)r * DM + c; MG[i] = f2bf(bf2f(MG[i]) + bf2f(G[(size_t)r * 2048 + 1024 + c]) * v); } };
struct EpiOutProj { const float* x; float* out; const float* mod;
    DEV void operator()(int r, int c, float v, float) const { const size_t i = (size_t)r * DM + c; out[i] = x[i] + mod[(r / SEQ) * NMOD + 2048 + c] * v; } };
struct EpiLogits { float* LG;
    DEV void operator()(int r, int c, float v, float) const { LG[(size_t)r * NE + c] = v; } };
struct EpiAct { bf16_t* ACT;
    DEV void operator()(int r, int c, float v, float v2) const { ACT[(size_t)r * EFF + c] = f2bf(silu(v) * v2); } };
struct EpiSlab { bf16_t* SLAB; const int* rl; const float* w;
    DEV void operator()(int r, int c, float v, float) const { const int s = rl[r]; if (s >= 0) SLAB[(size_t)s * DM + c] = f2bf(v * w[s]); } };
struct EpiFinal { float* out; const bf16_t* SLAB; const float* mod;
    DEV void operator()(int r, int c, float v, float) const {
        float s = v;
#pragma unroll
        for (int k = 0; k < 8; ++k) s += bf2f(SLAB[((size_t)r * 8 + k) * DM + c]);
        const size_t i = (size_t)r * DM + c; out[i] = out[i] + mod[(r / SEQ) * NMOD + 5120 + c] * s; } };

DEV void ph_qknorm(const P& p, int bid, int nb) {
    const int tid_ = otid(); const int lane = tid_ & 63, wv = tid_ >> 6;
    const float gq = p.q_norm_g[lane], gk = p.k_norm_g[lane];
    const float invf = exp2f(-(float)(lane & 7) * (1.f / 8.f) * log2f(500000.f));
    for (int t = bid * NWV + wv; t < T; t += nb * NWV) {
        const float ang = (float)p.pos[t] * invf;
        const float cs = cosf(ang), sn = sinf(ang);
        bf16_t* ptr = p.QKV + (size_t)t * 2304 + lane;
        float v[24];
#pragma unroll
        for (int hh = 0; hh < 24; ++hh) v[hh] = bf2f(ptr[hh * 64]);
#pragma unroll
        for (int hh = 0; hh < 24; ++hh) {
            const float ss = wave_sum(v[hh] * v[hh]);
            float nv = v[hh] * rsqrtf(ss * (1.f / 64.f) + 1e-6f) * (hh < 12 ? gq : gk);
            const float partner = __shfl_xor(nv, 8);
            if (lane < 8) nv = nv * cs - partner * sn;
            else if (lane < 16) nv = nv * cs + partner * sn;
            ptr[hh * 64] = f2bf(nv);
        }
    }
}

DEV void ph_pool(const P& p, int bid, int nb) {
    const int tid_ = otid();
    for (int i = bid * NTHR + tid_; i < NB * 32 * 256; i += nb * NTHR) {
        const int cp = i & 255, chunk = (i >> 8) & 31, b = i >> 13;
        const int g = cp >> 6, r = 1 << g;
        const int s0 = chunk * 64;
        const unsigned* up = (const unsigned*)(p.U + (size_t)b * SEQ * 512) + cp;
        unsigned* op = (unsigned*)(p.PL + (size_t)b * SEQ * 768) + cp;
        float a0 = 0.f, a1 = 0.f;
        const int lo0 = max(s0 - r, 0), hi0 = min(s0 + r, SEQ - 1);
        for (int q = lo0; q <= hi0; ++q) { const unsigned w = up[(size_t)q * 256]; a0 += __uint_as_float(w << 16); a1 += __uint_as_float(w & 0xffff0000u); }
#pragma unroll 4
        for (int s = s0; s < s0 + 64; ++s) {
            const int lo = max(s - r, 0), hi = min(s + r, SEQ - 1);
            const float inv = 1.f / (float)(hi - lo + 1);
            const unsigned w = up[(size_t)s * 256];
            op[(size_t)s * 384] = pk2(a0 * inv - __uint_as_float(w << 16), a1 * inv - __uint_as_float(w & 0xffff0000u));
            if (s + 1 + r <= SEQ - 1) { const unsigned wn = up[(size_t)(s + 1 + r) * 256]; a0 += __uint_as_float(wn << 16); a1 += __uint_as_float(wn & 0xffff0000u); }
            if (s - r >= 0) { const unsigned wo = up[(size_t)(s - r) * 256]; a0 -= __uint_as_float(wo << 16); a1 -= __uint_as_float(wo & 0xffff0000u); }
        }
    }
}

DEV void ph_attn(const P& p, int bid, int nb) {
    const int tid_ = otid(); const int lane = tid_ & 63, wv = tid_ >> 6;
    for (int it = bid * NWV + wv; it < T * 4; it += nb * NWV) {
        const int t = it >> 2, slot = it & 3;
        const int s = t & (SEQ - 1), base = t - s;
        float M = -1e30f, l = 0.f, acc = 0.f;
#pragma unroll
        for (int g = 0; g < 3; ++g) {
            const int dsh = 2 * g, d = 1 << dsh, L = SEQ >> dsh;
            const int h = 4 * g + slot;
            const int m = s >> dsh, r = s & (d - 1);
            const float q = bf2f(p.QKV[(size_t)t * 2304 + h * 64 + lane]);
            const bf16_t* kb = p.QKV + 768 + h * 64 + lane;
            const bf16_t* vb = p.QKV + 1536 + h * 64 + lane;
#pragma unroll 4
            for (int rel = -64; rel <= 64; ++rel) {
                const int mm = m + rel;
                const bool valid = (mm >= 0) && (mm < L);
                const int mc = valid ? mm : m;
                const size_t tr = (size_t)(base + mc * d + r) * 2304;
                const float kv = bf2f(kb[tr]), vv = bf2f(vb[tr]);
                const float sc = wave_sum(q * kv) * 0.125f;
                if (valid) {
                    const float mn = fmaxf(M, sc);
                    const float f = __expf(M - mn), pe = __expf(sc - mn);
                    l = l * f + pe; acc = acc * f + pe * vv; M = mn;
                }
            }
        }
        p.O[(size_t)t * 256 + slot * 64 + lane] = f2bf(acc / l);
    }
}

DEV void ph_route(const P& p, int* hist, int bid, int nb) {
    const int tid_ = otid(); const int lane = tid_ & 63, wv = tid_ >> 6;
    const int G = lane & 7, tl = lane >> 3;
    float bias[32];
#pragma unroll
    for (int j = 0; j < 8; ++j) { const float4 b4 = *(const float4*)(p.router_bias + G * 32 + 4 * j); bias[4 * j] = b4.x; bias[4 * j + 1] = b4.y; bias[4 * j + 2] = b4.z; bias[4 * j + 3] = b4.w; }
    for (int t0 = (bid * NWV + wv) * 8; t0 < T; t0 += nb * NWV * 8) {
        const int t = t0 + tl;
        float sc[32], v[32];
#pragma unroll
        for (int j = 0; j < 8; ++j) { const float4 lg = *(const float4*)(p.LG + (size_t)t * NE + G * 32 + 4 * j);
            sc[4 * j] = 1.f / (1.f + expf(-lg.x)); sc[4 * j + 1] = 1.f / (1.f + expf(-lg.y)); sc[4 * j + 2] = 1.f / (1.f + expf(-lg.z)); sc[4 * j + 3] = 1.f / (1.f + expf(-lg.w)); }
        float m1 = -INFINITY, m2 = -INFINITY;
#pragma unroll
        for (int j = 0; j < 32; ++j) { v[j] = sc[j] + bias[j]; const float n1 = fmaxf(m1, v[j]), n2 = fmaxf(fminf(m1, v[j]), m2); m1 = n1; m2 = n2; }
        const float gs = m1 + m2;
        int rank = 0;
#pragma unroll
        for (int g2 = 0; g2 < 8; ++g2) { const float o = __shfl(gs, (lane & 56) + g2); rank += ((o > gs) || (o == gs && g2 < G)) ? 1 : 0; }
        const bool gsel = rank < 4;
        int myidx = 0; float myw = 0.f, wsum = 0.f;
#pragma unroll 1
        for (int k = 0; k < 8; ++k) {
            float bv = -INFINITY, bs = 0.f; int bi = 0;
#pragma unroll
            for (int j = 0; j < 32; ++j) { const bool tk = gsel && (v[j] > bv); bv = tk ? v[j] : bv; bs = tk ? sc[j] : bs; bi = tk ? j : bi; }
            int gi = G * 32 + bi;
#pragma unroll
            for (int o = 1; o < 8; o <<= 1) {
                const float ov = __shfl_xor(bv, o), os = __shfl_xor(bs, o); const int oi = __shfl_xor(gi, o);
                if ((ov > bv) || (ov == bv && oi < gi)) { bv = ov; gi = oi; bs = os; }
            }
            const int wj = (gi >> 5) == G ? (gi & 31) : -1;
#pragma unroll
            for (int j = 0; j < 32; ++j) v[j] = (j == wj) ? -INFINITY : v[j];
            if (G == k) { myidx = gi; myw = bs; }
            wsum += bs;
        }
        __syncthreads();
        if (tid_ < NE) hist[tid_] = 0;
        __syncthreads();
        const int lpos = atomicAdd(&hist[myidx], 1);
        __syncthreads();
        if (tid_ < NE) { const int c_ = hist[tid_]; hist[NE + tid_] = c_ ? atomicAdd(&p.cnt[tid_ * 64], c_) : 0; }
        __syncthreads();
        const int slot = t * 8 + G;
        p.asg_e[slot] = myidx; p.asg_pos[slot] = hist[NE + myidx] + lpos; p.asg_w[slot] = myw / wsum * 2.5f;
    }
}

DEV void load_offsets(const int* cnt, int* off) {
    const int tid = otid();
    __syncthreads();
    if (tid < NE) { const int c_ = cnt[tid * 64]; off[300 + tid] = (c_ + 255) & ~255; off[600 + tid] = c_; }
    __syncthreads();
    if (tid == 0) { int a = 0; for (int e = 0; e < NE; ++e) { off[e] = a; a += off[300 + e]; } off[NE] = a; }
    __syncthreads();
}
DEV int find_expert(const int* off, int m0) {
    int lo = 0, hi = NE;
    while (hi - lo > 1) { const int mid = (lo + hi) >> 1; if (off[mid] <= m0) lo = mid; else hi = mid; }
    return lo;
}

DEV void ph_scatter(const P& p, int* off, int bid, int nb) {
    load_offsets(p.cnt, off);
    const int tid_ = otid();
    for (int slot = bid * NTHR + tid_; slot < NSLOT; slot += nb * NTHR) { const int r = off[p.asg_e[slot]] + p.asg_pos[slot]; p.rowlist[r] = slot; p.roww[r] = p.asg_w[slot]; }
    for (int e = bid; e < NE; e += nb) {
        const int n = p.cnt[e * 64], pd = (n + 255) & ~255;
        for (int i = n + tid_; i < pd; i += NTHR) { p.rowlist[off[e] + i] = -1; p.roww[off[e] + i] = 0.f; }
    }
}

DEV void ph_expert1(const P& p, float* sm, int* off, int bid, int nb) {
    load_offsets(p.cnt, off);
    const int nrt = off[NE] / 128, nt = nrt * 4;
    for (int t = bid; t < nt; t += nb) {
        const int m0 = (t >> 2) * 128, n0 = (t & 3) * 64, e = find_expert(off, m0);
        ngemm_tile<true>(p.XB, DM, RowTok{p.rowlist}, p.w_eg + (size_t)e * DM * EFF, p.w_eu + (size_t)e * DM * EFF, EFF, m0, n0, DM, EpiAct{p.ACT}, sm);
    }
}
DEV void ph_expert2(const P& p, float* sm, int* off, int bid, int nb) {
    load_offsets(p.cnt, off);
    const int nrt = off[NE] / 128, nt = nrt * 16;
    for (int t = bid; t < nt; t += nb) {
        const int m0 = (t >> 4) * 128, n0 = (t & 15) * 64, e = find_expert(off, m0);
        ngemm_tile<false>(p.ACT, EFF, RowId(), p.w_ed + (size_t)e * EFF * DM, nullptr, DM, m0, n0, EFF, EpiSlab{p.SLAB, p.rowlist, p.asg_w}, sm);
    }
}

namespace mg {
constexpr int BM = 256, BK = 64, HALF = 128, HTB = HALF * BK * 2, STAGE_BYTES = 8 * HTB, NXCD = 8, WGM = 8;
__host__ __device__ __forceinline__ int lds_byte(int r, int c) { const int st = (r >> 4) * 2 + (c >> 5), rr = r & 15, cc = c & 31, ob = rr * 64 + cc * 2; return st * 1024 + (ob ^ (((ob >> 9) & 1) << 5)); }
__host__ __device__ __forceinline__ void stage_rc(int b, int& R, int& C) { const int st = b / 1024, sb = b % 1024, swz = sb ^ (((sb >> 9) & 1) << 5); R = (st >> 1) * 16 + swz / 64; C = (st & 1) * 32 + (swz % 64) / 2; }
__host__ __device__ __forceinline__ int perm32(int rho) { const int n = rho >> 4, i = rho & 15; return 8 * (i >> 2) + 4 * n + (i & 3); }

struct Unit { int pm, pn, e, pad, half, pad2; const char* A; const char* B; };

struct DenseOrder { static constexpr bool HAS_HALF = false;
    int nM, nN, nwg, G, c; const char* A; const char* B; size_t tstep;
    DEV void init(const bf16_t* A_, const bf16_t* B_, int M, int N, int K, int G_, int c_) { nM = M / BM; nN = N / BM; nwg = nM * nN; G = G_; c = c_; A = (const char*)A_; B = (const char*)B_; tstep = (size_t)BM * K * 2; }
    DEV bool next(int i, Unit& u) const {
        const long L = (long)i * G + c; if (L >= nwg) return false;
        int wgid = (int)L; { const int q = nwg / NXCD, r = nwg % NXCD, xcd = wgid % NXCD, off = wgid / NXCD; wgid = (xcd < r ? xcd * (q + 1) : r * (q + 1) + (xcd - r) * q) + off; }
        const int nig = WGM * nN, gid = wgid / nig, fm = gid * WGM, gsz = (nM - fm) < WGM ? (nM - fm) : WGM;
        u.pm = fm + ((wgid % nig) % gsz); u.pn = (wgid % nig) / gsz; u.e = 0; u.pad = 0; u.half = 0; u.pad2 = 0;
        u.A = A + (size_t)u.pm * tstep; u.B = B + (size_t)u.pn * tstep; return true;
    }
};
struct PairOrder { static constexpr bool HAS_HALF = false; DenseOrder D; int kt0, kt1;
    DEV bool next(int i, Unit& u) const { if (!D.next(i >> 1, u)) return false; const int part = i & 1; u.e = part; u.pad = part ? kt1 : kt0;
        if (part) { u.A += (size_t)kt0 * 128; u.B += (size_t)kt0 * 128; } return true; }
};
struct ExpertOrder { static constexpr bool HAS_HALF = true;
    const LAS int* off; int nrt, ncol, G, c; const char* A; const char* W; size_t wstride, tstepB, tstepA; bool gather;
    DEV bool next(int i, Unit& u) const {
        const int L = i * G + c; if (L >= nrt * ncol) return false;
        u.pm = L / ncol; u.pn = L % ncol; u.pad = 0; u.pad2 = 0;
        int lo = 0, hi = NE; const int m0 = u.pm * BM;
        while (hi - lo > 1) { const int mid = (lo + hi) >> 1; const int ov = __builtin_amdgcn_readfirstlane(off[mid]); if (ov <= m0) lo = mid; else hi = mid; }
        u.e = lo;
        u.half = (__builtin_amdgcn_readfirstlane(off[600 + lo]) - (m0 - __builtin_amdgcn_readfirstlane(off[lo])) <= HALF) ? 1 : 0;
        u.A = gather ? A : A + (size_t)u.pm * tstepA; u.B = W + (size_t)lo * wstride + (size_t)u.pn * tstepB; return true;
    }
};

template <class Epi, class Sched, bool GATHER>
DEV void gemm_phase(LAS unsigned char* lds, const LAS unsigned* gtab, const int K, const Sched& S, const Epi& E) {
    const int tid = otid(), wid = __builtin_amdgcn_readfirstlane(tid >> 6), lane = tid & 63, wr = wid >> 2, wc = wid & 3, fr = lane & 15, fq = lane >> 4;
    const int nt = K / BK;
    int Rr[2], Cc[2]; unsigned voffB[2];
#pragma unroll
    for (int i = 0; i < 2; ++i) { stage_rc(tid * 16 + i * 8192, Rr[i], Cc[i]); const int Rb = Epi::PERM ? ((Rr[i] & ~31) + perm32(Rr[i] & 31)) : Rr[i]; voffB[i] = (unsigned)(Rb * K + Cc[i]) * 2u; }
    const size_t kstep = (size_t)(BK * 2);
    const size_t hstep = (size_t)HALF * K * 2;
    const unsigned ldsw = (unsigned)wid * 1024u;
    const int aoff = lds_byte(wr * 64 + fr, fq * 8), boff = lds_byte(wc * 32 + fr, fq * 8);
#define MG_SA(b, h) (((b) * 2 + (h)) * HTB)
#define MG_SB(b, h) ((4 + (b) * 2 + (h)) * HTB)
#define MG_STAGE(bufoff, gbase, voff) do { _Pragma("unroll") for (int _i = 0; _i < 2; ++_i) \
        __builtin_amdgcn_global_load_lds((const unsigned*)((const char*)(gbase) + (voff)[_i]), (LAS unsigned*)(lds + (bufoff) + ldsw + _i * 8192), 16, 0, 0); } while (0)
#define MG_LDA(dst, b, h) do { _Pragma("unroll") for (int m = 0; m < 4; ++m) _Pragma("unroll") for (int k = 0; k < 2; ++k) dst[m][k] = *(const LAS bf16x8*)(lds + MG_SA(b, h) + aoff + m * 2048 + k * 1024); } while (0)
#define MG_LDB(dst, b, h) do { _Pragma("unroll") for (int n = 0; n < 2; ++n) _Pragma("unroll") for (int k = 0; k < 2; ++k) dst[n][k] = *(const LAS bf16x8*)(lds + MG_SB(b, h) + boff + n * 2048 + k * 1024); } while (0)
#define MG_MMA(ai, bj, At, Bt) do { __builtin_amdgcn_s_setprio(1); _Pragma("unroll") for (int m = 0; m < 4; ++m) _Pragma("unroll") for (int n = 0; n < 2; ++n) _Pragma("unroll") for (int k = 0; k < 2; ++k) \
        acc[ai][bj][m][n] = __builtin_amdgcn_mfma_f32_16x16x32_bf16(Bt[n][k], At[m][k], acc[ai][bj][m][n], 0, 0, 0); __builtin_amdgcn_s_setprio(0); } while (0)
#define MG_WAIT_V(n) asm volatile("s_waitcnt vmcnt(" #n ")" ::: "memory")
#define MG_WAIT_L(n) asm volatile("s_waitcnt lgkmcnt(" #n ")" ::: "memory")
#define MG_BAR __builtin_amdgcn_s_barrier()
#define MG_SCHED __builtin_amdgcn_sched_barrier(0)
    Unit cur, nxt; int ui = 0;
    if (!S.next(0, cur)) return;
    int ntc = cur.pad > 0 ? cur.pad : nt;
    bool hf = Sched::HAS_HALF && (cur.half != 0);
    f32x4 acc[2][2][4][2];
#pragma unroll
    for (int a = 0; a < 2; ++a)
#pragma unroll
        for (int b = 0; b < 2; ++b)
#pragma unroll
            for (int m = 0; m < 4; ++m)
#pragma unroll
                for (int n = 0; n < 2; ++n) acc[a][b][m][n] = (f32x4){0.f, 0.f, 0.f, 0.f};
    bf16x8 At[4][2], B0[2][2], B1[2][2];
    unsigned va0[2], va1[2], na0[2], na1[2];
#pragma unroll
    for (int i = 0; i < 2; ++i) {
        if (GATHER) { va0[i] = gtab[Rr[i]] + (unsigned)Cc[i] * 2u; va1[i] = gtab[HALF + Rr[i]] + (unsigned)Cc[i] * 2u; }
        else { va0[i] = (unsigned)(Rr[i] * K + Cc[i]) * 2u; va1[i] = va0[i] + (unsigned)hstep; }
        na0[i] = va0[i]; na1[i] = va1[i];
    }
    const char* cA = cur.A; const char* cB = cur.B;
    MG_STAGE(MG_SB(0, 0), cB, voffB); MG_STAGE(MG_SB(0, 1), cB + hstep, voffB); MG_STAGE(MG_SA(0, 0), cA, va0); MG_STAGE(MG_SA(0, 1), cA, va1);
    if (wr == 1) MG_BAR;
    MG_WAIT_V(2); MG_BAR;
    MG_STAGE(MG_SB(1, 0), cB + kstep, voffB); MG_STAGE(MG_SA(1, 0), cA + kstep, va0); MG_STAGE(MG_SB(1, 1), cB + hstep + kstep, voffB);
    MG_WAIT_V(6); MG_BAR;
    for (;;) {
        const bool has_next = S.next(ui + 1, nxt);
        const char* nA = has_next ? nxt.A : cA; const char* nB = has_next ? nxt.B : cB;
        if (GATHER) {
            if (has_next) {
#pragma unroll
                for (int i = 0; i < 2; ++i) { na0[i] = gtab[(ui + 1) * BM + Rr[i]] + (unsigned)Cc[i] * 2u; na1[i] = gtab[(ui + 1) * BM + HALF + Rr[i]] + (unsigned)Cc[i] * 2u; }
            }
        }
#pragma unroll 1
        for (int t = 0; t < ntc; t += 2) {
            const bool last = (t == ntc - 2);
            const char* a1 = cA + (size_t)(t + 1) * kstep;
            const char* a2 = last ? nA : cA + (size_t)(t + 2) * kstep; const char* b2 = last ? nB : cB + (size_t)(t + 2) * kstep;
            const char* a3 = a2 + kstep; const char* b3 = b2 + kstep;
            unsigned o0[2], o1[2];
#pragma unroll
            for (int i = 0; i < 2; ++i) { o0[i] = (GATHER && last) ? na0[i] : va0[i]; o1[i] = (GATHER && last) ? na1[i] : va1[i]; }
            MG_LDB(B0, 0, 0); MG_LDB(B1, 0, 1); MG_SCHED; MG_LDA(At, 0, 0); MG_STAGE(MG_SA(1, 1), a1, va1);
            MG_WAIT_V(8); MG_WAIT_L(0); MG_BAR; MG_MMA(0, 0, At, B0); MG_MMA(0, 1, At, B1); MG_BAR; MG_SCHED;
            if (!hf) MG_LDA(At, 0, 1); MG_STAGE(MG_SB(0, 0), b2, voffB); MG_STAGE(MG_SB(0, 1), b2 + hstep, voffB); MG_STAGE(MG_SA(0, 0), a2, o0);
            MG_WAIT_V(8); MG_WAIT_L(0); MG_BAR; if (!hf) { MG_MMA(1, 0, At, B0); MG_MMA(1, 1, At, B1); } MG_BAR; MG_SCHED;
            MG_LDB(B0, 1, 0); MG_LDB(B1, 1, 1); MG_SCHED; MG_LDA(At, 1, 0); MG_STAGE(MG_SA(0, 1), a2, o1);
            MG_WAIT_V(8); MG_WAIT_L(0); MG_BAR; MG_MMA(0, 0, At, B0); MG_MMA(0, 1, At, B1); MG_BAR; MG_SCHED;
            if (!hf) MG_LDA(At, 1, 1); MG_STAGE(MG_SB(1, 0), b3, voffB); MG_STAGE(MG_SB(1, 1), b3 + hstep, voffB); MG_STAGE(MG_SA(1, 0), a3, o0);
            MG_WAIT_V(8); MG_WAIT_L(0); MG_BAR; if (!hf) { MG_MMA(1, 0, At, B0); MG_MMA(1, 1, At, B1); } MG_BAR; MG_SCHED;
        }
        if (wr == 0) MG_BAR;
        E(acc, cur, wr, wc, fr, fq);
        if (!has_next) break;
        if (!(Epi::KEEP_ACC && cur.e == 0)) {
#pragma unroll
        for (int a = 0; a < 2; ++a)
#pragma unroll
            for (int b = 0; b < 2; ++b)
#pragma unroll
                for (int m = 0; m < 4; ++m)
#pragma unroll
                    for (int n = 0; n < 2; ++n) acc[a][b][m][n] = (f32x4){0.f, 0.f, 0.f, 0.f};
        }
        cur = nxt; cA = nA; cB = nB; ++ui; ntc = cur.pad > 0 ? cur.pad : nt; hf = Sched::HAS_HALF && (cur.half != 0);
#pragma unroll
        for (int i = 0; i < 2; ++i) { va0[i] = na0[i]; va1[i] = na1[i]; }
        if (wr == 1) MG_BAR;
    }
    MG_WAIT_V(0);
    MG_BAR;
    __syncthreads();
#undef MG_SA
#undef MG_SB
#undef MG_STAGE
#undef MG_LDA
#undef MG_LDB
#undef MG_MMA
#undef MG_WAIT_V
#undef MG_WAIT_L
#undef MG_BAR
#undef MG_SCHED
}

DEV u32x4 pack8(const f32x4 a, const f32x4 b) { u32x4 w; w.x = pk2(a[0], a[1]); w.y = pk2(a[2], a[3]); w.z = pk2(b[0], b[1]); w.w = pk2(b[2], b[3]); return w; }
DEV f32x4 unpack_lo(const u32x4 w) { return (f32x4){__uint_as_float(w.x << 16), __uint_as_float(w.x & 0xffff0000u), __uint_as_float(w.y << 16), __uint_as_float(w.y & 0xffff0000u)}; }
DEV f32x4 unpack_hi(const u32x4 w) { return (f32x4){__uint_as_float(w.z << 16), __uint_as_float(w.z & 0xffff0000u), __uint_as_float(w.w << 16), __uint_as_float(w.w & 0xffff0000u)}; }
DEV f32x4 sig4(const f32x4 v) { return (f32x4){sigm(v[0]), sigm(v[1]), sigm(v[2]), sigm(v[3])}; }
DEV f32x4 silu4(const f32x4 v) { return (f32x4){silu(v[0]), silu(v[1]), silu(v[2]), silu(v[3])}; }
#define ACC_T f32x4 (&acc)[2][2][4][2]

struct MEpiInProj { static constexpr bool PERM = true; static constexpr bool KEEP_ACC = false; bf16_t *U, *QKV, *G;
    DEV void operator()(ACC_T, const Unit& u, int wr, int wc, int fr, int fq) const {
        int colt = u.pn * BM; bf16_t* base; int ld; bool sg = false;
        if (colt < 512) { base = U; ld = 512; } else if (colt < 2816) { base = QKV; ld = 2304; colt -= 512; } else { base = G; ld = 2048; colt -= 2816; sg = true; }
        const int row0 = u.pm * BM + wr * 64 + fr, col0 = colt + wc * 32 + 8 * fq;
#pragma unroll
        for (int ai = 0; ai < 2; ++ai)
#pragma unroll
            for (int m = 0; m < 4; ++m) { bf16_t* rowp = base + (size_t)(row0 + ai * HALF + m * 16) * ld + col0;
#pragma unroll
                for (int bj = 0; bj < 2; ++bj) { f32x4 v0 = acc[ai][bj][m][0], v1 = acc[ai][bj][m][1]; if (sg) { v0 = sig4(v0); v1 = sig4(v1); }
                    *(u32x4*)(rowp + bj * HALF) = pack8(v0, v1); }
                asm volatile("" ::: "memory"); }
    } };
struct MEpiMergeF { static constexpr bool PERM = true; static constexpr bool KEEP_ACC = true; bf16_t* MG; const bf16_t* G;
    DEV void mid(f32x4 (&acc)[2][2][4][2], const Unit& u, int wr, int wc, int fr, int fq) const {
        const int row0 = u.pm * BM + wr * 64 + fr, col0 = u.pn * BM + wc * 32 + 8 * fq;
#pragma unroll
        for (int ai = 0; ai < 2; ++ai)
#pragma unroll
            for (int m = 0; m < 4; ++m) { const bf16_t* gr = G + (size_t)(row0 + ai * HALF + m * 16) * 2048 + col0;
#pragma unroll
                for (int bj = 0; bj < 2; ++bj)
#pragma unroll
                    for (int n = 0; n < 2; ++n) { const u32x2 gp = *(const u32x2*)(gr + bj * HALF + 4 * n), ga = *(const u32x2*)(gr + 1024 + bj * HALF + 4 * n);
                        acc[ai][bj][m][n] *= (f32x4){__uint_as_float(gp.x << 16) * __builtin_amdgcn_rcpf(__uint_as_float(ga.x << 16)), __uint_as_float(gp.x & 0xffff0000u) * __builtin_amdgcn_rcpf(__uint_as_float(ga.x & 0xffff0000u)),
                                                     __uint_as_float(gp.y << 16) * __builtin_amdgcn_rcpf(__uint_as_float(ga.y << 16)), __uint_as_float(gp.y & 0xffff0000u) * __builtin_amdgcn_rcpf(__uint_as_float(ga.y & 0xffff0000u))};
                        asm volatile("" ::: "memory"); } }
    }
    DEV void operator()(f32x4 (&acc)[2][2][4][2], const Unit& u, int wr, int wc, int fr, int fq) const {
        if (u.e == 0) { mid(acc, u, wr, wc, fr, fq); return; }
        const int row0 = u.pm * BM + wr * 64 + fr, col0 = u.pn * BM + wc * 32 + 8 * fq;
#pragma unroll
        for (int ai = 0; ai < 2; ++ai)
#pragma unroll
            for (int m = 0; m < 4; ++m) { const size_t r = (size_t)(row0 + ai * HALF + m * 16);
#pragma unroll
                for (int bj = 0; bj < 2; ++bj) { const int c = col0 + bj * HALF;
                    const u32x4 ga = *(const u32x4*)(G + r * 2048 + 1024 + c);
                    *(u32x4*)(MG + r * DM + c) = pack8(acc[ai][bj][m][0] * unpack_lo(ga), acc[ai][bj][m][1] * unpack_hi(ga)); }
                asm volatile("" ::: "memory"); }
    } };
struct MEpiOutProj { static constexpr bool PERM = false; static constexpr bool KEEP_ACC = false; const float* x; float* out; const float* mod;
    DEV void operator()(ACC_T, const Unit& u, int wr, int wc, int fr, int fq) const {
        const int row0 = u.pm * BM + wr * 64 + fr, col0 = u.pn * BM + wc * 32 + 4 * fq;
        const float* gm = mod + ((u.pm * BM) / SEQ) * NMOD + 2048;
#pragma unroll
        for (int ai = 0; ai < 2; ++ai)
#pragma unroll
            for (int m = 0; m < 4; ++m) { const size_t r = (size_t)(row0 + ai * HALF + m * 16) * DM;
#pragma unroll
                for (int bj = 0; bj < 2; ++bj)
#pragma unroll
                    for (int n = 0; n < 2; ++n) { const int c = col0 + bj * HALF + n * 16;
                        *(f32x4*)(out + r + c) = *(const f32x4*)(x + r + c) + *(const f32x4*)(gm + c) * acc[ai][bj][m][n]; }
                asm volatile("" ::: "memory"); }
    } };
struct MEpiRouterShared { static constexpr bool PERM = true; static constexpr bool KEEP_ACC = false; float* LG; bf16_t* HS;
    DEV void operator()(ACC_T, const Unit& u, int wr, int wc, int fr, int fq) const {
        const int row0 = u.pm * BM + wr * 64 + fr, cw = wc * 32 + 8 * fq;
#pragma unroll
        for (int ai = 0; ai < 2; ++ai)
#pragma unroll
            for (int m = 0; m < 4; ++m) { const size_t r = (size_t)(row0 + ai * HALF + m * 16);
                if (u.pn == 0) {
#pragma unroll
                    for (int bj = 0; bj < 2; ++bj)
#pragma unroll
                        for (int n = 0; n < 2; ++n) *(f32x4*)(LG + r * NE + bj * HALF + cw + 4 * n) = acc[ai][bj][m][n];
                } else {
                    const f32x4 v0 = silu4(acc[ai][0][m][0]) * acc[ai][1][m][0], v1 = silu4(acc[ai][0][m][1]) * acc[ai][1][m][1];
                    *(u32x4*)(HS + r * EFF + (u.pn - 1) * HALF + cw) = pack8(v0, v1);
                }
                asm volatile("" ::: "memory"); }
    } };
struct MEpiAct { static constexpr bool PERM = true; static constexpr bool KEEP_ACC = false; bf16_t* ACT;
    DEV void operator()(ACC_T, const Unit& u, int wr, int wc, int fr, int fq) const {
        const int row0 = u.pm * BM + wr * 64 + fr, cw = u.pn * HALF + wc * 32 + 8 * fq;
#pragma unroll
        for (int ai = 0; ai < 2; ++ai) { if (ai == 1 && u.half) break;
#pragma unroll
            for (int m = 0; m < 4; ++m) { const size_t r = (size_t)(row0 + ai * HALF + m * 16);
                const f32x4 v0 = silu4(acc[ai][0][m][0]) * acc[ai][1][m][0], v1 = silu4(acc[ai][0][m][1]) * acc[ai][1][m][1];
                *(u32x4*)(ACT + r * EFF + cw) = pack8(v0, v1); asm volatile("" ::: "memory"); } }
    } };
constexpr float SLAB_SCALE = 8.f, SLAB_INV = 0.125f;
DEV unsigned pk4_fp8(float a, float b, float c, float d) {
    a = fminf(fmaxf(a, -440.f), 440.f); b = fminf(fmaxf(b, -440.f), 440.f); c = fminf(fmaxf(c, -440.f), 440.f); d = fminf(fmaxf(d, -440.f), 440.f);
    int w = 0; w = __builtin_amdgcn_cvt_pk_fp8_f32(a, b, w, false); w = __builtin_amdgcn_cvt_pk_fp8_f32(c, d, w, true); return (unsigned)w; }
struct MEpiSlab { static constexpr bool PERM = true; static constexpr bool KEEP_ACC = false; unsigned char* SLAB; const int* rl; const float* w;
    DEV void operator()(ACC_T, const Unit& u, int wr, int wc, int fr, int fq) const {
        const int row0 = u.pm * BM + wr * 64 + fr, c16 = u.pn * BM + wc * 64 + 16 * fq;
#pragma unroll
        for (int ai = 0; ai < 2; ++ai) { if (ai == 1 && u.half) break;
#pragma unroll
            for (int m = 0; m < 4; ++m) { const int s = rl[row0 + ai * HALF + m * 16]; const float g = w[row0 + ai * HALF + m * 16] * SLAB_SCALE;
                if (s >= 0) { u32x4 o;
                    { const f32x4 a = acc[ai][0][m][0] * g, b = acc[ai][0][m][1] * g; o.x = pk4_fp8(a[0], a[1], a[2], a[3]); o.y = pk4_fp8(b[0], b[1], b[2], b[3]); }
                    { const f32x4 a = acc[ai][1][m][0] * g, b = acc[ai][1][m][1] * g; o.z = pk4_fp8(a[0], a[1], a[2], a[3]); o.w = pk4_fp8(b[0], b[1], b[2], b[3]); }
                    *(u32x4*)(SLAB + (size_t)s * DM + c16) = o; }
                asm volatile("" ::: "memory"); } }
    } };
DEV void acc4_fp8(f32x4& a, unsigned w) { const auto lo = __builtin_amdgcn_cvt_pk_f32_fp8((int)w, false), hi = __builtin_amdgcn_cvt_pk_f32_fp8((int)w, true); a[0] += lo[0]; a[1] += lo[1]; a[2] += hi[0]; a[3] += hi[1]; }
struct MEpiFinal { static constexpr bool PERM = true; static constexpr bool KEEP_ACC = false; float* out; const unsigned char* SLAB; const float* mod;
    DEV void operator()(ACC_T, const Unit& u, int wr, int wc, int fr, int fq) const {
        const int row0 = u.pm * BM + wr * 64 + fr, c16 = u.pn * BM + wc * 64 + 16 * fq;
        const float* gm = mod + ((u.pm * BM) / SEQ) * NMOD + 5120 + c16;
#pragma unroll
        for (int ai = 0; ai < 2; ++ai)
#pragma unroll
            for (int m = 0; m < 4; ++m) { const size_t row = (size_t)(row0 + ai * HALF + m * 16);
                const unsigned char* sp = SLAB + row * 8 * DM + c16;
                float* op = out + row * DM + c16;
                f32x4 s4[4];
#pragma unroll
                for (int q = 0; q < 4; ++q) s4[q] = (f32x4){0.f, 0.f, 0.f, 0.f};
#pragma unroll
                for (int kh = 0; kh < 2; ++kh) { u32x4 sw[4];
#pragma unroll
                    for (int k = 0; k < 4; ++k) sw[k] = *(const u32x4*)(sp + (size_t)(kh * 4 + k) * DM);
#pragma unroll
                    for (int k = 0; k < 4; ++k) { acc4_fp8(s4[0], sw[k].x); acc4_fp8(s4[1], sw[k].y); acc4_fp8(s4[2], sw[k].z); acc4_fp8(s4[3], sw[k].w); } }
                s4[0] = s4[0] * SLAB_INV + acc[ai][0][m][0]; s4[1] = s4[1] * SLAB_INV + acc[ai][0][m][1]; s4[2] = s4[2] * SLAB_INV + acc[ai][1][m][0]; s4[3] = s4[3] * SLAB_INV + acc[ai][1][m][1];
#pragma unroll
                for (int q = 0; q < 4; ++q) *(f32x4*)(op + 4 * q) = *(const f32x4*)(op + 4 * q) + *(const f32x4*)(gm + 4 * q) * s4[q];
                asm volatile("" ::: "memory"); }
    } };
#undef ACC_T
}

typedef float f32x16 __attribute__((ext_vector_type(16)));
typedef short s16x4 __attribute__((ext_vector_type(4)));
DEV int crow(int r, int hi) { return (r & 3) + 8 * (r >> 2) + 4 * hi; }
DEV unsigned cvtpk(float lo, float hi) { unsigned r; asm("v_cvt_pk_bf16_f32 %0, %1, %2" : "=v"(r) : "v"(lo), "v"(hi)); return r; }
DEV s16x4 vtr(const LAS unsigned char* p) { return __builtin_bit_cast(s16x4, __builtin_amdgcn_ds_read_tr16_b64_v4i16((LAS s16x4*)p)); }
DEV float swap32(float v) { return __shfl_xor(v, 32); }

DEV void normrope_frag(bf16x8 (&f)[4], const LAS float* gt, int hi, float posf) {
    float x[32]; float ss = 0.f;
#pragma unroll
    for (int d0 = 0; d0 < 4; ++d0) { const u32x4 w = __builtin_bit_cast(u32x4, f[d0]);
        x[8 * d0 + 0] = __uint_as_float(w.x << 16); x[8 * d0 + 1] = __uint_as_float(w.x & 0xffff0000u); x[8 * d0 + 2] = __uint_as_float(w.y << 16); x[8 * d0 + 3] = __uint_as_float(w.y & 0xffff0000u);
        x[8 * d0 + 4] = __uint_as_float(w.z << 16); x[8 * d0 + 5] = __uint_as_float(w.z & 0xffff0000u); x[8 * d0 + 6] = __uint_as_float(w.w << 16); x[8 * d0 + 7] = __uint_as_float(w.w & 0xffff0000u); }
#pragma unroll
    for (int i = 0; i < 32; ++i) ss += x[i] * x[i];
    ss += __shfl_xor(ss, 32);
    const float rs = rsqrtf(ss * (1.f / 64.f) + 1e-6f);
#pragma unroll
    for (int d0 = 0; d0 < 4; ++d0) { const f32x4 g0 = *(const LAS f32x4*)(gt + 16 * d0 + 8 * hi), g1 = *(const LAS f32x4*)(gt + 16 * d0 + 8 * hi + 4);
#pragma unroll
        for (int j = 0; j < 4; ++j) { x[8 * d0 + j] *= rs * g0[j]; x[8 * d0 + 4 + j] *= rs * g1[j]; } }
    constexpr float INVF[8] = {1.0f, 0.19392274474868576f, 0.03760603093086393f, 0.007292664737217109f, 0.001414213562373095f, 0.0002742481756762073f, 5.318295896944988e-05f, 1.031338537721246e-05f};
#pragma unroll
    for (int i = 0; i < 8; ++i) {
        const float rev = posf * (INVF[i] * 0.15915494309189535f);
        const float fr = rev - floorf(rev);
        const float cs = __builtin_amdgcn_cosf(fr), sn = __builtin_amdgcn_sinf(fr);
        const float partner = __shfl_xor(x[i], 32);
        x[i] = hi ? (x[i] * cs + partner * sn) : (x[i] * cs - partner * sn);
    }
#pragma unroll
    for (int d0 = 0; d0 < 4; ++d0) { u32x4 w; w.x = cvtpk(x[8 * d0], x[8 * d0 + 1]); w.y = cvtpk(x[8 * d0 + 2], x[8 * d0 + 3]); w.z = cvtpk(x[8 * d0 + 4], x[8 * d0 + 5]); w.w = cvtpk(x[8 * d0 + 6], x[8 * d0 + 7]);
        f[d0] = __builtin_bit_cast(bf16x8, w); }
}

DEV void ph_attn_mfma(const P& p, LAS unsigned char* lds, int bid, int nb) {
    const int tid = otid(); const int lane = tid & 63, wid = __builtin_amdgcn_readfirstlane(tid >> 6), r32 = lane & 31, hi = lane >> 5;
    LAS unsigned char* vl = lds + wid * 8192;
    LAS float* wsf = (LAS float*)(lds + wid * 8192 + 4096);
    LAS float* gtab_q = (LAS float*)(lds + wid * 8192 + 4352);
    LAS float* gtab_k = gtab_q + 64;
    gtab_q[lane] = p.q_norm_g[lane]; gtab_k[lane] = p.k_norm_g[lane];
    asm volatile("s_waitcnt lgkmcnt(0)" ::: "memory");
    float gq = fabsf(p.q_norm_g[lane]), gk = fabsf(p.k_norm_g[lane]);
#pragma unroll
    for (int o = 32; o >= 1; o >>= 1) { gq = fmaxf(gq, __shfl_xor(gq, o)); gk = fmaxf(gk, __shfl_xor(gk, o)); }
    constexpr float LOG2E = 1.4426950408889634f, C2 = 0.125f * LOG2E;
    const float nmref = -(8.f * gq * gk * LOG2E);
    const int head = wid >> 1, qh = wid & 1;
    const int tq = (lane & 15) >> 2, tp = lane & 3, tcb = (lane >> 4) & 1;
    const LAS unsigned char* vrd = vl + (4 * hi + tq) * 128 + (16 * tcb + 4 * tp) * 2;
    for (int it = bid; it < NB * 96; it += nb) {
        const int cb = it & 31, g = (it >> 5) % 3, b = it / 96;
        const int dsh = 2 * g, d = 1 << dsh, L = SEQ >> dsh, nbk = L >> 6;
        const int r = cb / nbk, blk = cb % nbk;
        const int h = 4 * g + head, base = b * SEQ;
        const int q0 = 64 * blk + 32 * qh;
        const int mq = q0 + r32;
        const bf16_t* qp = p.QKV + (size_t)(base + mq * d + r) * 2304 + h * 64 + hi * 8;
        bf16x8 qr[4];
#pragma unroll
        for (int d0 = 0; d0 < 4; ++d0) qr[d0] = *(const bf16x8*)(qp + d0 * 16);
        normrope_frag(qr, gtab_q, hi, (float)p.pos[base + mq * d + r]);
        f32x16 o0, o1;
#pragma unroll
        for (int i = 0; i < 16; ++i) { o0[i] = 0.f; o1[i] = 0.f; }
        float lsum = 0.f;
        const int kb0 = q0 - 64;
        const int st_lo = max(0, (-kb0) >> 5), st_hi = min(5, (L - kb0) >> 5);
        bf16x8 kf[4], kfn[4]; u32x4 vreg[4], vregn[4]; float kposf, kposn;
#define ATT_LOAD(KF, VR, KP, st_) do { const int k0_ = kb0 + 32 * (st_); const int mkc_ = min(max(k0_ + r32, 0), L - 1); \
            const bf16_t* kp_ = p.QKV + (size_t)(base + mkc_ * d + r) * 2304 + 768 + h * 64 + hi * 8; \
            _Pragma("unroll") for (int d0 = 0; d0 < 4; ++d0) KF[d0] = *(const bf16x8*)(kp_ + d0 * 16); \
            KP = (float)p.pos[base + mkc_ * d + r]; \
            _Pragma("unroll") for (int i = 0; i < 4; ++i) { const int c = lane + 64 * i, row = c >> 3, ch = c & 7; const int mv = min(max(k0_ + row, 0), L - 1); \
                VR[i] = *(const u32x4*)(p.QKV + (size_t)(base + mv * d + r) * 2304 + 1536 + h * 64 + ch * 8); } } while (0)
        ATT_LOAD(kf, vreg, kposf, st_lo);
#pragma unroll 1
        for (int st = st_lo; st < st_hi; ++st) {
            const int k0 = kb0 + 32 * st;
            if (st + 1 < st_hi) ATT_LOAD(kfn, vregn, kposn, st + 1);
            normrope_frag(kf, gtab_k, hi, kposf);
            f32x16 s;
#pragma unroll
            for (int i = 0; i < 16; ++i) s[i] = 0.f;
#pragma unroll
            for (int d0 = 0; d0 < 4; ++d0) s = __builtin_amdgcn_mfma_f32_32x32x16_bf16(kf[d0], qr[d0], s, 0, 0, 0);
#pragma unroll
            for (int i = 0; i < 16; ++i) { const int key = k0 + crow(i, hi); const int df = key - mq;
                const bool valid = (key >= 0) && (key < L) && (df <= 64) && (df >= -64);
                const float pv = valid ? __builtin_amdgcn_exp2f(__builtin_fmaf(s[i], C2, nmref)) : 0.f; lsum += pv; s[i] = pv; }
            bf16x8 pf0, pf1;
            { u32x4 w0, w1; w0.x = cvtpk(s[0], s[1]); w0.y = cvtpk(s[2], s[3]); w0.z = cvtpk(s[4], s[5]); w0.w = cvtpk(s[6], s[7]);
              w1.x = cvtpk(s[8], s[9]); w1.y = cvtpk(s[10], s[11]); w1.z = cvtpk(s[12], s[13]); w1.w = cvtpk(s[14], s[15]);
              pf0 = __builtin_bit_cast(bf16x8, w0); pf1 = __builtin_bit_cast(bf16x8, w1); }
#pragma unroll
            for (int i = 0; i < 4; ++i) { const int c = lane + 64 * i, row = c >> 3, ch = c & 7; *(LAS u32x4*)(vl + row * 128 + ch * 16) = vreg[i]; }
            asm volatile("s_waitcnt lgkmcnt(0)" ::: "memory");
#pragma unroll
            for (int n = 0; n < 2; ++n)
#pragma unroll
                for (int ks = 0; ks < 2; ++ks) {
                    const s16x4 lo = vtr(vrd + (16 * ks) * 128 + 64 * n), hi4 = vtr(vrd + (16 * ks + 8) * 128 + 64 * n);
                    bf16x8 vf; vf[0] = lo[0]; vf[1] = lo[1]; vf[2] = lo[2]; vf[3] = lo[3]; vf[4] = hi4[0]; vf[5] = hi4[1]; vf[6] = hi4[2]; vf[7] = hi4[3];
                    if (n == 0) o0 = __builtin_amdgcn_mfma_f32_32x32x16_bf16(ks == 0 ? pf0 : pf1, vf, o0, 0, 0, 0);
                    else o1 = __builtin_amdgcn_mfma_f32_32x32x16_bf16(ks == 0 ? pf0 : pf1, vf, o1, 0, 0, 0);
                }
            asm volatile("s_waitcnt lgkmcnt(0)" ::: "memory");
#pragma unroll
            for (int i = 0; i < 4; ++i) { kf[i] = kfn[i]; vreg[i] = vregn[i]; }
            kposf = kposn;
        }
#undef ATT_LOAD
        const float lt = lsum + swap32(lsum);
        if (hi == 0) { wsf[r32] = 1.f / lt; p.LSUM[((size_t)g * T + (base + mq * d + r)) * 4 + head] = lt; }
        asm volatile("s_waitcnt lgkmcnt(0)" ::: "memory");
        bf16_t* og = p.OG + (size_t)g * T * 256 + head * 64 + r32;
#pragma unroll
        for (int i = 0; i < 16; ++i) { const int qq = crow(i, hi); const float inv = wsf[qq]; const size_t tok = (size_t)(base + (q0 + qq) * d + r);
            og[tok * 256] = f2bf(o0[i] * inv); og[tok * 256 + 32] = f2bf(o1[i] * inv); }
        asm volatile("s_waitcnt lgkmcnt(0)" ::: "memory");
    }
}
DEV void ph_attn_combine(const P& p, int bid, int nb) {
    const int tid_ = otid();
    for (int i = bid * NTHR + tid_; i < T * 32; i += nb * NTHR) {
        const int t = i >> 5, ch = i & 31, slot = ch >> 3;
        const float l0 = p.LSUM[(size_t)t * 4 + slot], l1 = p.LSUM[((size_t)T + t) * 4 + slot], l2 = p.LSUM[((size_t)2 * T + t) * 4 + slot];
        const float inv = 1.f / (l0 + l1 + l2);
        const u32x4 a = *(const u32x4*)(p.OG + (size_t)t * 256 + ch * 8), b = *(const u32x4*)(p.OG + ((size_t)T + t) * 256 + ch * 8), c = *(const u32x4*)(p.OG + ((size_t)2 * T + t) * 256 + ch * 8);
        const f32x4 lo = (mg::unpack_lo(a) * l0 + mg::unpack_lo(b) * l1 + mg::unpack_lo(c) * l2) * inv;
        const f32x4 hi = (mg::unpack_hi(a) * l0 + mg::unpack_hi(b) * l1 + mg::unpack_hi(c) * l2) * inv;
        *(u32x4*)(p.PL + (size_t)t * 768 + 512 + ch * 8) = mg::pack8(lo, hi);
    }
}

template <class Src>
DEV void transpose_blk(const Src& src, int K, bf16_t* WT0, LAS float* scr, int k0, int lane) {
#pragma unroll 8
    for (int i = 0; i < 32; ++i) { const int kk = 2 * i + (lane >> 5); scr[kk * 33 + (lane & 31)] = src(k0 + kk, lane & 31); }
    asm volatile("s_waitcnt lgkmcnt(0)" ::: "memory");
    const int c = lane & 7;
#pragma unroll
    for (int j = 0; j < 4; ++j) { const int n = (lane >> 3) + 8 * j; const LAS float* s = scr + (8 * c) * 33 + n;
        u32x4 o; o.x = pk2(s[0 * 33], s[1 * 33]); o.y = pk2(s[2 * 33], s[3 * 33]); o.z = pk2(s[4 * 33], s[5 * 33]); o.w = pk2(s[6 * 33], s[7 * 33]);
        *(u32x4*)(WT0 + (size_t)n * K + k0 + 8 * c) = o; }
    asm volatile("s_waitcnt lgkmcnt(0)" ::: "memory");
}
struct SrcCol { const float* W; int ld; DEV float operator()(int k, int j) const { return W[(size_t)k * ld + j]; } };
struct SrcEff { const float *wg, *ls, *wu;
    DEV float operator()(int k, int j) const { const int g = k >> 7; const float* a = wg + (size_t)k * 128; const float* l = ls + g * 128; const float* b = wu + (size_t)(g * 128) * DM + j; float s = 0.f;
#pragma unroll 4
        for (int d = 0; d < 128; ++d) s += a[d] * l[d] * b[(size_t)d * DM]; return s; } };
DEV void tr_plain(const float* W, int K, int N, bf16_t* WT, LAS float* scr, int item, int lane) {
    const int nblk = N / 32, k0 = 64 * (item / nblk), n0 = 32 * (item % nblk);
    transpose_blk(SrcCol{W + n0, N}, K, WT + (size_t)n0 * K, scr, k0, lane);
}
DEV void tr_perm16(const float* W, int K, int N, bf16_t* WT, LAS float* scr, int item, int lane) {
    const int nblk = N / 32, k0 = 64 * (item / nblk), rho0 = 32 * (item % nblk);
    const int tile = rho0 >> 8, bj = (rho0 >> 7) & 1, wc = (rho0 >> 5) & 3;
    const int n0 = tile * 256 + 64 * wc + 8 * bj;
    struct SrcP { const float* W; int ld; DEV float operator()(int k, int dr) const { return W[(size_t)k * ld + 16 * (dr >> 3) + (dr & 7)]; } };
    transpose_blk(SrcP{W + n0, N}, K, WT + (size_t)rho0 * K, scr, k0, lane);
}
DEV void tr_gu(const float* g, const float* u, int K, bf16_t* WT, LAS float* scr, int k0, int rho0, int lane) {
    const int ch0 = (rho0 >> 8) * 128 + (rho0 & 127);
    const float* m = (rho0 & 128) ? u : g;
    transpose_blk(SrcCol{m + ch0, EFF}, K, WT + (size_t)rho0 * K, scr, k0, lane);
}

DEV void ph_prep_small(const P& p, LAS float* scr, int gw, int ngw, int lane) {
    constexpr int I_IN = 16 * (INW / 32), I_EFF = 64 * 16, I_AU = 4 * 32, I_OUT = 16 * 32, I_R = 16 * 8, I_S = 16 * 16, I_SD = 4 * 32;
    constexpr int NIT = I_IN + I_EFF + I_AU + I_OUT + I_R + I_S + I_SD;
    for (int it = gw; it < NIT; it += ngw) {
        int r = it;
        if (r < I_IN) { tr_plain(p.w_in, DM, INW, p.WT_IN, scr, r, lane); continue; } r -= I_IN;
        if (r < I_EFF) {
            const int n = 64 * (r & 15) + lane, k0 = 8 * (r >> 4), g = k0 >> 7;
            const float* a = p.pool_w_grp + (size_t)k0 * 128; const float* l = p.pool_scale + g * 128; const float* b = p.w_pool_up + (size_t)(g * 128) * DM + n;
            float acc[8];
#pragma unroll
            for (int j = 0; j < 8; ++j) acc[j] = 0.f;
#pragma unroll 4
            for (int d = 0; d < 128; ++d) { const float bl = b[(size_t)d * DM] * l[d];
#pragma unroll
                for (int j = 0; j < 8; ++j) acc[j] += a[j * 128 + d] * bl; }
            u32x4 o; o.x = pk2(acc[0], acc[1]); o.y = pk2(acc[2], acc[3]); o.z = pk2(acc[4], acc[5]); o.w = pk2(acc[6], acc[7]);
            *(u32x4*)(p.WT_EFF + (size_t)n * 768 + k0) = o; continue; } r -= I_EFF;
        if (r < I_AU) { const int k0 = 64 * (r / 32), n0 = 32 * (r % 32);
            transpose_blk(SrcCol{p.w_attn_up + n0, DM}, 768, p.WT_EFF + (size_t)n0 * 768 + 512, scr, k0, lane); continue; } r -= I_AU;
        if (r < I_OUT) { tr_plain(p.w_out, DM, DM, p.WT_OUT, scr, r, lane); continue; } r -= I_OUT;
        if (r < I_R) { tr_plain(p.w_router, DM, NE, p.WT_RS, scr, r, lane); continue; } r -= I_R;
        if (r < I_S) { tr_gu(p.w_sg, p.w_su, DM, p.WT_RS + (size_t)256 * DM, scr, 64 * (r / 16), 32 * (r % 16), lane); continue; } r -= I_S;
        tr_perm16(p.w_sd, EFF, DM, p.WT_SD, scr, r, lane);
    }
}
DEV void ph_prep_ed(const P& p, LAS float* scr, int gw, int ngw, int lane) {
    constexpr int IPE = 4 * 32;
    for (int it = gw; it < NE * IPE; it += ngw) { const int e = it / IPE;
        tr_perm16(p.w_ed + (size_t)e * EFF * DM, EFF, DM, p.WT_ED + (size_t)e * DM * EFF, scr, it % IPE, lane); }
}
DEV void ph_prep_egu(const P& p, LAS float* scr, int gw, int ngw, int lane) {
    constexpr int IPE = 16 * 16;
    for (int it = gw; it < NE * IPE; it += ngw) { const int e = it / IPE, r = it % IPE;
        tr_gu(p.w_eg + (size_t)e * DM * EFF, p.w_eu + (size_t)e * DM * EFF, DM, p.WT_EGU + (size_t)e * 512 * DM, scr, 64 * (r / 16), 32 * (r % 16), lane); }
}

constexpr int LDS_BYTES = 147456;
constexpr int LDS_OFF_TAB = 131072;
constexpr int LDS_GTAB = 131072 + 4096;
constexpr int MAXU = 10;
constexpr int LDS_MISC = LDS_GTAB + MAXU * 1024;

DEV void fill_gtab(const P& p, const LAS int* off, LAS unsigned* gtab, int ncol, int bid, int nb) {
    const int nrt = off[NE] / 256, tot = nrt * ncol; const int tid_ = otid();
    for (int i = 0; i < MAXU; ++i) { const int L = i * nb + bid; if (L >= tot) break;
        const int pm = L / ncol;
        if (tid_ < 256) { const int s = p.rowlist[pm * 256 + tid_]; gtab[i * 256 + tid_] = (unsigned)(s < 0 ? 0 : (s >> 3)) * (unsigned)(DM * 2); } }
    __syncthreads();
}


#define GAS __attribute__((address_space(1)))
#define XB_TMO      128
#define XB_XCNT(j)  (256  + 64 * (j))
#define XB_XSUB(j)  (1280 + 64 * (j))
#define XB_XGEN(j)  (2304 + 64 * (j))
#define XB_TOP      3328
#define XB_TOPGEN   3392
#define XCD_BAR_WORDS 3456
#define XB_SPIN_CAP (1u << 18)
DEV unsigned xb_ld(unsigned* p)              { return __hip_atomic_load(p, __ATOMIC_RELAXED, __HIP_MEMORY_SCOPE_AGENT); }
DEV unsigned xb_add(unsigned* p, unsigned v) { return __hip_atomic_fetch_add(p, v, __ATOMIC_RELAXED, __HIP_MEMORY_SCOPE_AGENT); }
DEV unsigned xb_xcc_id() { return (unsigned)__builtin_amdgcn_s_getreg((3 << 11) | 20) & 0xFu; }
#define XB_SPIN(cond, bar) do { unsigned _sp = 0; while (cond) { __builtin_amdgcn_s_sleep(1); \
    if ((++_sp & 255u) == 0u) { if (xb_ld(&(bar)[XB_TMO])) break; if (_sp > XB_SPIN_CAP) { atomicAdd(&(bar)[XB_TMO], 1u); break; } } } } while (0)
struct XcdBarrier { unsigned* bar; unsigned x; volatile LAS unsigned* st; };
DEV XcdBarrier xcd_barrier_post(unsigned* bar, volatile LAS unsigned* st) {
    XcdBarrier b; b.bar = bar; b.x = xb_xcc_id(); b.st = st;
    if (threadIdx.x == 0) (void)xb_add(&bar[XB_XCNT(b.x)], 1u);
    return b;
}
DEV void xcd_barrier_complete(unsigned* bar, unsigned x, unsigned& nloc, unsigned& nx) {
    const unsigned G = gridDim.x * gridDim.y * gridDim.z;
    unsigned sum, cnt, mine, sp = 0u;
    for (;;) {
        sum = 0u; cnt = 0u; mine = 0u;
#pragma unroll
        for (unsigned j = 0; j < 16; ++j) { const unsigned c = xb_ld(&bar[XB_XCNT(j)]); sum += c; cnt += (c > 0u) ? 1u : 0u; mine = (j == x) ? c : mine; }
        if (sum == G) break;
        __builtin_amdgcn_s_sleep(1);
        if ((++sp & 255u) == 0u) { if (xb_ld(&bar[XB_TMO])) break; if (sp > XB_SPIN_CAP) { atomicAdd(&bar[XB_TMO], 1u); break; } }
    }
    nloc = mine > 0u ? mine : 1u; nx = cnt > 0u ? cnt : 1u;
}
DEV void xcd_barrier(const XcdBarrier& b) {
    asm volatile("s_waitcnt vmcnt(0)" ::: "memory");
    __syncthreads();
    if (threadIdx.x == 0) {
        unsigned* bar = b.bar;
        __builtin_amdgcn_s_waitcnt(0);
        unsigned nloc = b.st[0], nx = b.st[1];
        if (nloc == 0u) { xcd_barrier_complete(bar, b.x, nloc, nx); b.st[0] = nloc; b.st[1] = nx; }
        const unsigned old = xb_add(&bar[XB_XSUB(b.x)], 1u);
        const unsigned gen = old / nloc;
        if (old + 1u == (gen + 1u) * nloc) {
            __builtin_amdgcn_fence(__ATOMIC_RELEASE, "agent");
            asm volatile("s_waitcnt vmcnt(0)" ::: "memory");
            const unsigned og = xb_add(&bar[XB_TOP], 1u);
            const unsigned tg = og / nx;
            if (og + 1u == (tg + 1u) * nx) xb_add(&bar[XB_TOPGEN], 1u);
            else XB_SPIN(xb_ld(&bar[XB_TOPGEN]) == tg, bar);
            __builtin_amdgcn_fence(__ATOMIC_ACQUIRE, "agent");
            xb_add(&bar[XB_XGEN(b.x)], 1u);
            asm volatile("s_waitcnt vmcnt(0)" ::: "memory");
        } else {
            XB_SPIN(xb_ld(&bar[XB_XGEN(b.x)]) == gen, bar);
            __builtin_amdgcn_fence(__ATOMIC_ACQUIRE, "agent");
            asm volatile("s_waitcnt vmcnt(0)" ::: "memory");
        }
    }
    __syncthreads();
}

#define STAMP() do { if (TPROBE >= 0) { if (bid == 0 && threadIdx.x == 0) p.ts[nst] = __builtin_amdgcn_s_memrealtime(); ++nst; } } while (0)
#define GSYNC_CG() do { cg::this_grid().sync(); STAMP(); } while (0)
#define GSYNC() do { xcd_barrier(xbar); STAMP(); } while (0)
__global__ void __launch_bounds__(NTHR, 2) fwd_all(P p) {
    extern __shared__ __attribute__((aligned(16))) unsigned char lds_raw[];
    LAS unsigned char* lds = (LAS unsigned char*)lds_raw;
    float* sm = (float*)lds_raw;
    int* off = (int*)(lds_raw + LDS_OFF_TAB);
    const LAS int* offl = (const LAS int*)(lds + LDS_OFF_TAB);
    LAS unsigned* gtab = (LAS unsigned*)(lds + LDS_GTAB);
    const int bid = blockIdx.x, nb = gridDim.x;
    const int tid_ = otid(); const int lane = tid_ & 63, wv = tid_ >> 6;
    LAS float* scr = (LAS float*)(lds + wv * 16384);
    const int gw = bid * NWV + wv, ngw = nb * NWV;
    volatile LAS unsigned* misc = (volatile LAS unsigned*)(lds + LDS_MISC);
    if (threadIdx.x < 2) misc[threadIdx.x] = 0u;
    __syncthreads();
    const XcdBarrier xbar = xcd_barrier_post(p.bar, misc);
    int nst = 0; STAMP();

    ph_mod(p, sm, bid, nb);
    __syncthreads();
    REPEAT(1) ph_prep_small(p, scr, gw, ngw, lane);
#if MF_EXP2
    REPEAT(2) ph_prep_ed(p, scr, gw, ngw, lane);
#endif
    GSYNC_CG();
    REPEAT(3) ph_norm(p.x, p.norm1_g, p.mod, 0, 1024, p.XB, bid, nb);
    GSYNC();
#if MF_INPROJ
    REPEAT(4) { mg::DenseOrder S; S.init(p.XB, p.WT_IN, T, INW, DM, nb, bid);
      mg::gemm_phase<mg::MEpiInProj, mg::DenseOrder, false>(lds, gtab, DM, S, mg::MEpiInProj{p.U, p.QKV, p.G}); }
#else
    ngemm_dense<false>(p.XB, DM, p.w_in, nullptr, INW, T, INW, DM, EpiInProj{p.U, p.QKV, p.G}, sm, bid, nb);
#endif
    GSYNC();
#if !MF_ATTN
    ph_qknorm(p, bid, nb);
#endif
    REPEAT(5) ph_pool(p, bid, nb);
#if !MF_ATTN
    GSYNC();
#endif
#if MF_ATTN
    REPEAT(6) ph_attn_mfma(p, lds, bid, nb);
    GSYNC();
    REPEAT(7) ph_attn_combine(p, bid, nb);
#else
    ph_attn(p, bid, nb);
#endif
#if !MF_MERGE
#pragma unroll 1
    for (int g = 0; g < 4; ++g) ngemm_dense<false>(p.PL + g * 128, 512, p.pool_w_grp + g * 128 * 128, nullptr, 128, T, 128, 128, EpiPoolGrp{p.Y, p.pool_scale, g}, sm, bid, nb);
#endif
    GSYNC();
#if MF_MERGE
    REPEAT(8) { mg::PairOrder S; S.D.init(p.PL, p.WT_EFF, T, DM, 768, nb, bid); S.kt0 = 8; S.kt1 = 4;
      mg::gemm_phase<mg::MEpiMergeF, mg::PairOrder, false>(lds, gtab, 768, S, mg::MEpiMergeF{p.XB, p.G}); }
#else
    ngemm_dense<false>(p.Y, 512, p.w_pool_up, nullptr, DM, T, DM, 512, EpiMergeA{p.XB, p.G}, sm, bid, nb);
    GSYNC();
    ngemm_dense<false>(p.O, 256, p.w_attn_up, nullptr, DM, T, DM, 256, EpiMergeB{p.XB, p.G}, sm, bid, nb);
#endif
    GSYNC();
#if MF_OUT
    REPEAT(9) { mg::DenseOrder S; S.init(p.XB, p.WT_OUT, T, DM, DM, nb, bid);
      mg::gemm_phase<mg::MEpiOutProj, mg::DenseOrder, false>(lds, gtab, DM, S, mg::MEpiOutProj{p.x, p.out, p.mod}); }
#else
    ngemm_dense<false>(p.XB, DM, p.w_out, nullptr, DM, T, DM, DM, EpiOutProj{p.x, p.out, p.mod}, sm, bid, nb);
#endif
    GSYNC();
    REPEAT(10) ph_norm(p.out, p.norm2_g, p.mod, 3072, 4096, p.XB, bid, nb);
#if MF_EXP1
    __syncthreads();
    REPEAT(11) ph_prep_egu(p, scr, gw, ngw, lane);
#endif
    GSYNC();
#if MF_ROUTER
    REPEAT(12) { mg::DenseOrder S; S.init(p.XB, p.WT_RS, T, 768, DM, nb, bid);
      mg::gemm_phase<mg::MEpiRouterShared, mg::DenseOrder, false>(lds, gtab, DM, S, mg::MEpiRouterShared{p.LG, p.HS}); }
#else
    ngemm_dense<false>(p.XB, DM, p.w_router, nullptr, NE, T, NE, DM, EpiLogits{p.LG}, sm, bid, nb);
#endif
    GSYNC();
    ph_route(p, (int*)lds_raw, bid, nb);
    GSYNC();
    ph_scatter(p, off, bid, nb);
    GSYNC();
#if MF_EXP1
    REPEAT(13) { load_offsets(p.cnt, off); fill_gtab(p, offl, gtab, 2, bid, nb);
      mg::ExpertOrder S{offl, __builtin_amdgcn_readfirstlane(off[NE]) / 256, 2, nb, bid, (const char*)p.XB, (const char*)p.WT_EGU, (size_t)512 * DM * 2, (size_t)256 * DM * 2, 0, true};
      mg::gemm_phase<mg::MEpiAct, mg::ExpertOrder, true>(lds, gtab, DM, S, mg::MEpiAct{p.ACT}); }
#else
    ph_expert1(p, sm, off, bid, nb);
#endif
    GSYNC();
#if MF_EXP2
    REPEAT(14) { load_offsets(p.cnt, off);
      mg::ExpertOrder S{offl, __builtin_amdgcn_readfirstlane(off[NE]) / 256, 4, nb, bid, (const char*)p.ACT, (const char*)p.WT_ED, (size_t)DM * EFF * 2, (size_t)256 * EFF * 2, (size_t)256 * EFF * 2, false};
      mg::gemm_phase<mg::MEpiSlab, mg::ExpertOrder, false>(lds, gtab, EFF, S, mg::MEpiSlab{(unsigned char*)p.SLAB, p.rowlist, p.roww}); }
#else
    ph_expert2(p, sm, off, bid, nb);
#endif
    GSYNC();
#if !MF_ROUTER
    ngemm_dense<true>(p.XB, DM, p.w_sg, p.w_su, EFF, T, EFF, DM, EpiAct{p.HS}, sm, bid, nb);
    GSYNC();
#endif
#if MF_FINAL
    { mg::DenseOrder S; S.init(p.HS, p.WT_SD, T, DM, EFF, nb, bid);
      mg::gemm_phase<mg::MEpiFinal, mg::DenseOrder, false>(lds, gtab, EFF, S, mg::MEpiFinal{p.out, (const unsigned char*)p.SLAB, p.mod}); }
#else
    ngemm_dense<false>(p.HS, EFF, p.w_sd, nullptr, DM, T, DM, EFF, EpiFinal{p.out, p.SLAB, p.mod}, sm, bid, nb);
#endif
#if TPROBE >= 0
    GSYNC();
    if (bid == 0 && threadIdx.x == 0) { const unsigned long long dt = p.ts[TPROBE + 1] - p.ts[TPROBE]; p.out[0] += (float)dt * 0.01f / TSCALE; }
#endif
}

extern "C" void kernel_launch(void* const* d_in, const int* in_sizes, int n_in, void* d_out, int out_size, void* d_ws, size_t ws_size, hipStream_t stream) {
    static int grid = 0;
    if (grid == 0) {
        int dev = 0, cus = 0;
        (void)hipGetDevice(&dev);
        (void)hipDeviceGetAttribute(&cus, hipDeviceAttributeMultiprocessorCount, dev);
        int per_cu = 0;
        (void)hipFuncSetAttribute((const void*)fwd_all, hipFuncAttributeMaxDynamicSharedMemorySize, LDS_BYTES);
        (void)hipOccupancyMaxActiveBlocksPerMultiprocessor(&per_cu, fwd_all, NTHR, LDS_BYTES);
        if (per_cu < 1) { fprintf(stderr, "kernel_launch: occupancy query says %d blocks/CU\n", per_cu); per_cu = 1; }
        if (per_cu > 1) per_cu = 1;
        grid = cus * per_cu;
        if (ws_size < WS_END) { fprintf(stderr, "kernel_launch: workspace too small (%zu < %zu)\n", ws_size, (size_t)WS_END); grid = -1; }
    }
    if (grid < 0) return;
    P p{};
    const float* const* in = (const float* const*)d_in;
    p.x = in[0]; p.c = in[1]; p.pos = (const int*)d_in[2];
    p.w_ada = in[3]; p.b_ada = in[4]; p.norm1_g = in[5]; p.w_in = in[6]; p.pool_w_grp = in[7]; p.pool_scale = in[8]; p.q_norm_g = in[9]; p.k_norm_g = in[10];
    p.w_pool_up = in[11]; p.w_attn_up = in[12]; p.w_out = in[13]; p.norm2_g = in[14]; p.w_router = in[15]; p.router_bias = in[16];
    p.w_sg = in[17]; p.w_su = in[18]; p.w_sd = in[19]; p.w_eg = in[20]; p.w_eu = in[21]; p.w_ed = in[22];
    p.out = (float*)d_out;
    char* ws = (char*)d_ws;
    p.mod = (float*)(ws + WS_MOD); p.cnt = (int*)(ws + WS_CNT); p.asg_e = (int*)(ws + WS_ASG_E); p.asg_pos = (int*)(ws + WS_ASG_POS);
    p.asg_w = (float*)(ws + WS_ASG_W); p.rowlist = (int*)(ws + WS_ROWLIST);
    p.XB = (bf16_t*)(ws + WS_XB); p.U = (bf16_t*)(ws + WS_U); p.QKV = (bf16_t*)(ws + WS_QKV); p.G = (bf16_t*)(ws + WS_G); p.PL = (bf16_t*)(ws + WS_PL);
    p.Y = (bf16_t*)(ws + WS_Y); p.O = (bf16_t*)(ws + WS_O); p.ACT = (bf16_t*)(ws + WS_ACT); p.SLAB = (bf16_t*)(ws + WS_SLAB); p.HS = (bf16_t*)(ws + WS_HS);
    p.LG = (float*)(ws + WS_ACT);
    p.roww = (float*)(ws + WS_ROWW);
    p.bar = (unsigned*)(ws + WS_BAR); p.ts = (unsigned long long*)(ws + WS_TS);
    p.OG = (bf16_t*)(ws + WS_OG); p.LSUM = (float*)(ws + WS_LSUM);
    p.WT_IN = (bf16_t*)(ws + WS_WT_IN); p.WT_EFF = (bf16_t*)(ws + WS_WT_EFF); p.WT_AU = (bf16_t*)(ws + WS_WT_AU); p.WT_OUT = (bf16_t*)(ws + WS_WT_OUT);
    p.WT_RS = (bf16_t*)(ws + WS_WT_RS); p.WT_SD = (bf16_t*)(ws + WS_WT_SD); p.WT_EGU = (bf16_t*)(ws + WS_WT_EGU); p.WT_ED = (bf16_t*)(ws + WS_WT_ED);
    (void)hipMemsetAsync(ws + WS_BAR, 0, WS_ZERO_BYTES, stream);
    void* args[] = {&p};
    hipError_t e = hipLaunchCooperativeKernel((void*)fwd_all, dim3(grid), dim3(NTHR), args, LDS_BYTES, stream);
    if (e != hipSuccess) fprintf(stderr, "cooperative launch failed: %s (grid %d)\n", hipGetErrorString(e), grid);
}
```

```cpp
#include <hip/hip_runtime.h>
#include <hip/hip_cooperative_groups.h>
#include <stdint.h>
#include <cstdio>
namespace cg = cooperative_groups;

#ifndef ONE_LAUNCH
#define ONE_LAUNCH 0
#endif

typedef unsigned short bf16_t;
#define DEV __device__ __forceinline__
#define LAS __attribute__((address_space(3)))
typedef short bf16x8 __attribute__((ext_vector_type(8)));
typedef float f32x4 __attribute__((ext_vector_type(4)));
typedef unsigned u32x4 __attribute__((ext_vector_type(4)));
typedef unsigned u32x2 __attribute__((ext_vector_type(2)));

#ifndef MF_INPROJ
#define MF_INPROJ 1
#endif
#ifndef MF_MERGE
#define MF_MERGE 1
#endif
#ifndef MF_OUT
#define MF_OUT 1
#endif
#ifndef MF_ROUTER
#define MF_ROUTER 1
#endif
#ifndef MF_EXP1
#define MF_EXP1 1
#endif
#ifndef MF_EXP2
#define MF_EXP2 1
#endif
#ifndef MF_ATTN
#define MF_ATTN 1
#endif
#ifndef DUP
#define DUP 0
#endif
#ifndef TPROBE
#define TPROBE -1
#endif
#ifndef TSCALE
#define TSCALE 10.0f
#endif
#define REPEAT(n) _Pragma("unroll 1") for (int rep_ = 0; rep_ < ((DUP == (n)) ? 2 : 1); ++rep_)
#ifndef MF_FINAL
#define MF_FINAL 1
#endif

constexpr int NB = 16, SEQ = 2048, DM = 1024, T = NB * SEQ;
constexpr int INW = 4864, NMOD = 6144;
constexpr int NE = 256, EFF = 256;
constexpr int NTHR = 512, NWV = 8;
constexpr int NSLOT = T * 8;
constexpr int RMAX = NSLOT + NE * 256;

DEV float bf2f(bf16_t h) { return __uint_as_float(((unsigned)h) << 16); }
DEV bf16_t f2bf(float f) { unsigned u = __float_as_uint(f); u += 0x7fffu + ((u >> 16) & 1u); return (bf16_t)(u >> 16); }
DEV unsigned pk2(float lo, float hi) { return (unsigned)f2bf(lo) | ((unsigned)f2bf(hi) << 16); }
DEV float sigm(float v) { return 1.f / (1.f + __expf(-v)); }
DEV float silu(float v) { return v / (1.f + __expf(-v)); }
DEV int otid() { int t = threadIdx.x; asm volatile("" : "+v"(t)); return t; }
DEV float wave_sum(float v) {
#pragma unroll
    for (int o = 32; o >= 1; o >>= 1) v += __shfl_xor(v, o);
    return v;
}

struct P {
    const float *x, *c; const int* pos;
    const float *w_ada, *b_ada, *norm1_g, *w_in, *pool_w_grp, *pool_scale, *q_norm_g, *k_norm_g, *w_pool_up, *w_attn_up, *w_out, *norm2_g,
        *w_router, *router_bias, *w_sg, *w_su, *w_sd, *w_eg, *w_eu, *w_ed;
    float* out;
    float* mod; int* cnt; int* asg_e; int* asg_pos; float* asg_w; int* rowlist;
    bf16_t *XB, *U, *QKV, *G, *PL, *Y, *O, *ACT, *SLAB, *HS;
    float* LG;
    bf16_t* OG; float* LSUM; unsigned* bar; unsigned long long* ts; float* roww;
    bf16_t *WT_IN, *WT_EFF, *WT_AU, *WT_OUT, *WT_RS, *WT_SD, *WT_EGU, *WT_ED;
};

constexpr size_t MiB = 1u << 20;
constexpr size_t WS_BAR = 640 * 1024, WS_BAR_BYTES = 16384, WS_ZERO_BYTES = 16384 + 65536;
constexpr size_t WS_TS = 800 * 1024;
constexpr size_t WS_MOD = 0, WS_CNT = WS_BAR + WS_BAR_BYTES, WS_ASG_E = 1 * MiB, WS_ASG_POS = 2 * MiB, WS_ASG_W = 3 * MiB, WS_ROWLIST = 4 * MiB, WS_ROWW = 6 * MiB;
constexpr size_t WS_XB = 8 * MiB;
constexpr size_t WS_ACT = 72 * MiB;
constexpr size_t WS_SLAB = 232 * MiB;
constexpr size_t WS_U = 232 * MiB, WS_QKV = 264 * MiB, WS_G = 408 * MiB, WS_PL = 536 * MiB, WS_Y = 568 * MiB, WS_O = 600 * MiB;
constexpr size_t WS_WT_IN = 744 * MiB, WS_WT_EFF = 754 * MiB, WS_WT_AU = 755 * MiB, WS_WT_OUT = 756 * MiB, WS_WT_RS = 758 * MiB, WS_WT_SD = 760 * MiB;
constexpr size_t WS_WT_ED = 762 * MiB;
constexpr size_t WS_WT_EGU = 232 * MiB;
constexpr size_t WS_OG = 616 * MiB, WS_LSUM = 664 * MiB;
constexpr size_t WS_HS = 890 * MiB;
constexpr size_t WS_END = 906 * MiB;

DEV void ph_mod(const P& p, float* sm, int bid, int nb) {
    const int tid_ = otid(); const int lane = tid_ & 63, wv = tid_ >> 6;
    for (int it = bid; it < 96; it += nb) {
        const int k0 = wv * 128, e = it * 64 + lane;
        float acc[16];
#pragma unroll
        for (int b = 0; b < 16; ++b) acc[b] = 0.f;
#pragma unroll 1
        for (int kh = 0; kh < 2; ++kh) {
            float sc[16];
#pragma unroll
            for (int b = 0; b < 16; ++b) sc[b] = silu(p.c[b * DM + k0 + kh * 64 + lane]);
            const float* wp = p.w_ada + (size_t)(k0 + kh * 64) * NMOD + e;
#pragma unroll 8
            for (int kk = 0; kk < 64; ++kk) { const float w = wp[(size_t)kk * NMOD];
#pragma unroll
                for (int b = 0; b < 16; ++b) acc[b] += __uint_as_float(__builtin_amdgcn_readlane(__float_as_uint(sc[b]), kk)) * w; }
        }
        __syncthreads();
#pragma unroll
        for (int b = 0; b < 16; ++b) sm[(wv * 16 + b) * 64 + lane] = acc[b];
        __syncthreads();
#pragma unroll
        for (int j = 0; j < 2; ++j) { const int idx = tid_ + j * NTHR, b = idx >> 6, col = idx & 63; float s = p.b_ada[it * 64 + col];
#pragma unroll
            for (int w = 0; w < 8; ++w) s += sm[(w * 16 + b) * 64 + col];
            p.mod[b * NMOD + it * 64 + col] = s; }
    }
}

DEV void ph_norm(const float* src, const float* g, const float* mod, int shift_off, int scale_off, bf16_t* dst, int bid, int nb) {
    const int tid_ = otid(); const int lane = tid_ & 63, wv = tid_ >> 6;
    for (int row0 = (bid * NWV + wv) * 2; row0 < T; row0 += nb * NWV * 2) {
        float4 v[2][4]; float ss[2] = {0.f, 0.f};
#pragma unroll
        for (int q = 0; q < 2; ++q) { const float4* xr = (const float4*)(src + (size_t)(row0 + q) * DM);
#pragma unroll
            for (int j = 0; j < 4; ++j) v[q][j] = xr[lane + 64 * j]; }
#pragma unroll
        for (int q = 0; q < 2; ++q)
#pragma unroll
            for (int j = 0; j < 4; ++j) ss[q] += v[q][j].x * v[q][j].x + v[q][j].y * v[q][j].y + v[q][j].z * v[q][j].z + v[q][j].w * v[q][j].w;
        const int b = row0 / SEQ;
#pragma unroll
        for (int q = 0; q < 2; ++q) {
            const float r = rsqrtf(wave_sum(ss[q]) * (1.f / DM) + 1e-6f);
#pragma unroll
            for (int j = 0; j < 4; ++j) {
                const int col = (lane + 64 * j) * 4;
                const float4 g4 = *(const float4*)(g + col);
                const float4 sc = *(const float4*)(mod + b * NMOD + scale_off + col);
                const float4 sh = *(const float4*)(mod + b * NMOD + shift_off + col);
                const float o0 = v[q][j].x * r * g4.x * (1.f + sc.x) + sh.x, o1 = v[q][j].y * r * g4.y * (1.f + sc.y) + sh.y;
                const float o2 = v[q][j].z * r * g4.z * (1.f + sc.z) + sh.z, o3 = v[q][j].w * r * g4.w * (1.f + sc.w) + sh.w;
                uint2 w; w.x = pk2(o0, o1); w.y = pk2(o2, o3);
                *(uint2*)(dst + (size_t)(row0 + q) * DM + col) = w;
            }
        }
    }
}

template <bool DUAL, class RowF, class Epi>
DEV void ngemm_tile(const bf16_t* __restrict__ A, int lda, RowF rowf, const float* __restrict__ B, const float* __restrict__ B2, int ldb,
                    int m0, int n0, int K, Epi epi, float* sm) {
    float* As = sm;
    float* Bs = sm + 16 * 132;
    float* Bs2 = Bs + 16 * 64;
    const int tid = otid(), tm = tid >> 4, tn = tid & 15;
    float acc[4][4], acc2[4][4];
#pragma unroll
    for (int i = 0; i < 4; ++i)
#pragma unroll
        for (int j = 0; j < 4; ++j) { acc[i][j] = 0.f; acc2[i][j] = 0.f; }
    const int ar = tid >> 2, ak = (tid & 3) * 4;
    const int arow = rowf(m0 + ar);
    const bf16_t* ap = A + (size_t)(arow < 0 ? 0 : arow) * lda + ak;
    const int bk = tid >> 5, bn = (tid & 31) * 2;
    for (int k0 = 0; k0 < K; k0 += 16) {
        uint2 av = make_uint2(0u, 0u);
        if (arow >= 0) av = *(const uint2*)(ap + k0);
        const float2 bv = *(const float2*)(B + (size_t)(k0 + bk) * ldb + n0 + bn);
        float2 bv2 = make_float2(0.f, 0.f);
        if (DUAL) bv2 = *(const float2*)(B2 + (size_t)(k0 + bk) * ldb + n0 + bn);
        __syncthreads();
        As[(ak + 0) * 132 + ar] = __uint_as_float(av.x << 16);
        As[(ak + 1) * 132 + ar] = __uint_as_float(av.x & 0xffff0000u);
        As[(ak + 2) * 132 + ar] = __uint_as_float(av.y << 16);
        As[(ak + 3) * 132 + ar] = __uint_as_float(av.y & 0xffff0000u);
        Bs[bk * 64 + bn] = bv.x; Bs[bk * 64 + bn + 1] = bv.y;
        if (DUAL) { Bs2[bk * 64 + bn] = bv2.x; Bs2[bk * 64 + bn + 1] = bv2.y; }
        __syncthreads();
#pragma unroll
        for (int kk = 0; kk < 16; ++kk) {
            const float4 a = *(const float4*)&As[kk * 132 + tm * 4];
            const float4 b = *(const float4*)&Bs[kk * 64 + tn * 4];
            const float aa[4] = {a.x, a.y, a.z, a.w}, bb[4] = {b.x, b.y, b.z, b.w};
#pragma unroll
            for (int i = 0; i < 4; ++i)
#pragma unroll
                for (int j = 0; j < 4; ++j) acc[i][j] += aa[i] * bb[j];
            if (DUAL) {
                const float4 b2 = *(const float4*)&Bs2[kk * 64 + tn * 4];
                const float cc[4] = {b2.x, b2.y, b2.z, b2.w};
#pragma unroll
                for (int i = 0; i < 4; ++i)
#pragma unroll
                    for (int j = 0; j < 4; ++j) acc2[i][j] += aa[i] * cc[j];
            }
        }
    }
#pragma unroll
    for (int i = 0; i < 4; ++i)
#pragma unroll
        for (int j = 0; j < 4; ++j) epi(m0 + tm * 4 + i, n0 + tn * 4 + j, acc[i][j], acc2[i][j]);
}

struct RowId { DEV int operator()(int m) const { return m; } };
struct RowTok { const int* rl; DEV int operator()(int m) const { const int s = rl[m]; return s < 0 ? -1 : (s >> 3); } };

template <bool DUAL, class Epi>
DEV void ngemm_dense(const bf16_t* A, int lda, const float* B, const float* B2, int ldb, int M, int N, int K, Epi epi, float* sm, int bid, int nb) {
    const int tn = N / 64, nt = (M / 128) * tn;
    for (int t = bid; t < nt; t += nb) ngemm_tile<DUAL>(A, lda, RowId(), B, B2, ldb, (t / tn) * 128, (t % tn) * 64, K, epi, sm);
}

struct EpiInProj { bf16_t *U, *QKV, *G;
    DEV void operator()(int r, int c, float v, float) const {
        if (c < 512) U[(size_t)r * 512 + c] = f2bf(v);
        else if (c < 2816) QKV[(size_t)r * 2304 + (c - 512)] = f2bf(v);
        else G[(size_t)r * 2048 + (c - 2816)] = f2bf(sigm(v)); } };
struct EpiPoolGrp { bf16_t* Y; const float* ls; int g;
    DEV void operator()(int r, int c, float v, float) const { Y[(size_t)r * 512 + g * 128 + c] = f2bf(v * ls[g * 128 + c]); } };
struct EpiMergeA { bf16_t* MG; const bf16_t* G;
    DEV void operator()(int r, int c, float v, float) const { MG[(size_t)r * DM + c] = f2bf(bf2f(G[(size_t)r * 2048 + c]) * v); } };
struct EpiMergeB { bf16_t* MG; const bf16_t* G;
    DEV void operator()(int r, int c, float v, float) const { const size_t i = (size_t)r * DM + c; MG[i] = f2bf(bf2f(MG[i]) + bf2f(G[(size_t)r * 2048 + 1024 + c]) * v); } };
struct EpiOutProj { const float* x; float* out; const float* mod;
    DEV void operator()(int r, int c, float v, float) const { const size_t i = (size_t)r * DM + c; out[i] = x[i] + mod[(r / SEQ) * NMOD + 2048 + c] * v; } };
struct EpiLogits { float* LG;
    DEV void operator()(int r, int c, float v, float) const { LG[(size_t)r * NE + c] = v; } };
struct EpiAct { bf16_t* ACT;
    DEV void operator()(int r, int c, float v, float v2) const { ACT[(size_t)r * EFF + c] = f2bf(silu(v) * v2); } };
struct EpiSlab { bf16_t* SLAB; const int* rl; const float* w;
    DEV void operator()(int r, int c, float v, float) const { const int s = rl[r]; if (s >= 0) SLAB[(size_t)s * DM + c] = f2bf(v * w[s]); } };
struct EpiFinal { float* out; const bf16_t* SLAB; const float* mod;
    DEV void operator()(int r, int c, float v, float) const {
        float s = v;
#pragma unroll
        for (int k = 0; k < 8; ++k) s += bf2f(SLAB[((size_t)r * 8 + k) * DM + c]);
        const size_t i = (size_t)r * DM + c; out[i] = out[i] + mod[(r / SEQ) * NMOD + 5120 + c] * s; } };

DEV void ph_qknorm(const P& p, int bid, int nb) {
    const int tid_ = otid(); const int lane = tid_ & 63, wv = tid_ >> 6;
    const float gq = p.q_norm_g[lane], gk = p.k_norm_g[lane];
    const float invf = exp2f(-(float)(lane & 7) * (1.f / 8.f) * log2f(500000.f));
    for (int t = bid * NWV + wv; t < T; t += nb * NWV) {
        const float ang = (float)p.pos[t] * invf;
        const float cs = cosf(ang), sn = sinf(ang);
        bf16_t* ptr = p.QKV + (size_t)t * 2304 + lane;
        float v[24];
#pragma unroll
        for (int hh = 0; hh < 24; ++hh) v[hh] = bf2f(ptr[hh * 64]);
#pragma unroll
        for (int hh = 0; hh < 24; ++hh) {
            const float ss = wave_sum(v[hh] * v[hh]);
            float nv = v[hh] * rsqrtf(ss * (1.f / 64.f) + 1e-6f) * (hh < 12 ? gq : gk);
            const float partner = __shfl_xor(nv, 8);
            if (lane < 8) nv = nv * cs - partner * sn;
            else if (lane < 16) nv = nv * cs + partner * sn;
            ptr[hh * 64] = f2bf(nv);
        }
    }
}

template <int R>
DEV void pool_chunk(const unsigned* up, unsigned* op, int s0) {
    constexpr int W = 32 + 2 * R;
    float w0[W], w1[W];
#pragma unroll
    for (int i = 0; i < W; ++i) { const int q = s0 - R + i; const bool ok = (q >= 0) && (q < SEQ); const unsigned w = up[(size_t)min(max(q, 0), SEQ - 1) * 256];
        w0[i] = ok ? __uint_as_float(w << 16) : 0.f; w1[i] = ok ? __uint_as_float(w & 0xffff0000u) : 0.f; }
    float a0 = 0.f, a1 = 0.f;
#pragma unroll
    for (int i = 0; i < 2 * R + 1; ++i) { a0 += w0[i]; a1 += w1[i]; }
#pragma unroll
    for (int j = 0; j < 32; ++j) {
        const int s = s0 + j;
        const int lo = max(s - R, 0), hi = min(s + R, SEQ - 1);
        const float inv = 1.f / (float)(hi - lo + 1);
        op[(size_t)s * 384] = pk2(a0 * inv - w0[j + R], a1 * inv - w1[j + R]);
        if (j < 31) { a0 += w0[j + 2 * R + 1] - w0[j]; a1 += w1[j + 2 * R + 1] - w1[j]; }
    }
}
DEV void ph_pool(const P& p, int bid, int nb) {
    const int tid_ = otid();
    for (int i = bid * NTHR + tid_; i < NB * 64 * 256; i += nb * NTHR) {
        const int cp = i & 255, chunk = (i >> 8) & 63, b = i >> 14;
        const int g = cp >> 6;
        const unsigned* up = (const unsigned*)(p.U + (size_t)b * SEQ * 512) + cp;
        unsigned* op = (unsigned*)(p.PL + (size_t)b * SEQ * 768) + cp;
        const int s0 = chunk * 32;
        if (g == 0) pool_chunk<1>(up, op, s0); else if (g == 1) pool_chunk<2>(up, op, s0); else if (g == 2) pool_chunk<4>(up, op, s0); else pool_chunk<8>(up, op, s0);
    }
}

DEV void ph_attn(const P& p, int bid, int nb) {
    const int tid_ = otid(); const int lane = tid_ & 63, wv = tid_ >> 6;
    for (int it = bid * NWV + wv; it < T * 4; it += nb * NWV) {
        const int t = it >> 2, slot = it & 3;
        const int s = t & (SEQ - 1), base = t - s;
        float M = -1e30f, l = 0.f, acc = 0.f;
#pragma unroll
        for (int g = 0; g < 3; ++g) {
            const int dsh = 2 * g, d = 1 << dsh, L = SEQ >> dsh;
            const int h = 4 * g + slot;
            const int m = s >> dsh, r = s & (d - 1);
            const float q = bf2f(p.QKV[(size_t)t * 2304 + h * 64 + lane]);
            const bf16_t* kb = p.QKV + 768 + h * 64 + lane;
            const bf16_t* vb = p.QKV + 1536 + h * 64 + lane;
#pragma unroll 4
            for (int rel = -64; rel <= 64; ++rel) {
                const int mm = m + rel;
                const bool valid = (mm >= 0) && (mm < L);
                const int mc = valid ? mm : m;
                const size_t tr = (size_t)(base + mc * d + r) * 2304;
                const float kv = bf2f(kb[tr]), vv = bf2f(vb[tr]);
                const float sc = wave_sum(q * kv) * 0.125f;
                if (valid) {
                    const float mn = fmaxf(M, sc);
                    const float f = __expf(M - mn), pe = __expf(sc - mn);
                    l = l * f + pe; acc = acc * f + pe * vv; M = mn;
                }
            }
        }
        p.O[(size_t)t * 256 + slot * 64 + lane] = f2bf(acc / l);
    }
}

DEV void ph_route(const P& p, int* hist, int bid, int nb) {
    const int tid_ = otid(); const int lane = tid_ & 63, wv = tid_ >> 6;
    const int G = lane & 7, tl = lane >> 3;
    float bias[32];
#pragma unroll
    for (int j = 0; j < 8; ++j) { const float4 b4 = *(const float4*)(p.router_bias + G * 32 + 4 * j); bias[4 * j] = b4.x; bias[4 * j + 1] = b4.y; bias[4 * j + 2] = b4.z; bias[4 * j + 3] = b4.w; }
    for (int t0 = (bid * NWV + wv) * 8; t0 < T; t0 += nb * NWV * 8) {
        const int t = t0 + tl;
        float sc[32], v[32];
#pragma unroll
        for (int j = 0; j < 8; ++j) { const float4 lg = *(const float4*)(p.LG + (size_t)t * NE + G * 32 + 4 * j);
            sc[4 * j] = 1.f / (1.f + expf(-lg.x)); sc[4 * j + 1] = 1.f / (1.f + expf(-lg.y)); sc[4 * j + 2] = 1.f / (1.f + expf(-lg.z)); sc[4 * j + 3] = 1.f / (1.f + expf(-lg.w)); }
        float m1 = -INFINITY, m2 = -INFINITY;
#pragma unroll
        for (int j = 0; j < 32; ++j) { v[j] = sc[j] + bias[j]; const float n1 = fmaxf(m1, v[j]), n2 = fmaxf(fminf(m1, v[j]), m2); m1 = n1; m2 = n2; }
        const float gs = m1 + m2;
        int rank = 0;
#pragma unroll
        for (int g2 = 0; g2 < 8; ++g2) { const float o = __shfl(gs, (lane & 56) + g2); rank += ((o > gs) || (o == gs && g2 < G)) ? 1 : 0; }
        const bool gsel = rank < 4;
        int myidx = 0; float myw = 0.f, wsum = 0.f;
#pragma unroll 1
        for (int k = 0; k < 8; ++k) {
            float bv = -INFINITY, bs = 0.f; int bi = 0;
#pragma unroll
            for (int j = 0; j < 32; ++j) { const bool tk = gsel && (v[j] > bv); bv = tk ? v[j] : bv; bs = tk ? sc[j] : bs; bi = tk ? j : bi; }
            int gi = G * 32 + bi;
#pragma unroll
            for (int o = 1; o < 8; o <<= 1) {
                const float ov = __shfl_xor(bv, o), os = __shfl_xor(bs, o); const int oi = __shfl_xor(gi, o);
                if ((ov > bv) || (ov == bv && oi < gi)) { bv = ov; gi = oi; bs = os; }
            }
            const int wj = (gi >> 5) == G ? (gi & 31) : -1;
#pragma unroll
            for (int j = 0; j < 32; ++j) v[j] = (j == wj) ? -INFINITY : v[j];
            if (G == k) { myidx = gi; myw = bs; }
            wsum += bs;
        }
        __syncthreads();
        if (tid_ < NE) hist[tid_] = 0;
        __syncthreads();
        const int lpos = atomicAdd(&hist[myidx], 1);
        __syncthreads();
        if (tid_ < NE) { const int c_ = hist[tid_]; hist[NE + tid_] = c_ ? atomicAdd(&p.cnt[tid_ * 64], c_) : 0; }
        __syncthreads();
        const int slot = t * 8 + G;
        p.asg_e[slot] = myidx; p.asg_pos[slot] = hist[NE + myidx] + lpos; p.asg_w[slot] = myw / wsum * 2.5f;
    }
}

DEV void load_offsets(const int* cnt, int* off) {
    const int tid = otid();
    __syncthreads();
    if (tid < NE) { const int c_ = cnt[tid * 64]; off[300 + tid] = (c_ + 255) & ~255; off[600 + tid] = c_; }
    __syncthreads();
    if (tid == 0) { int a = 0; for (int e = 0; e < NE; ++e) { off[e] = a; a += off[300 + e]; } off[NE] = a;
        const int x = blockIdx.x & 7; int tf = 0, th = 0;
        for (int j = 0; j < 32; ++j) { const int n_ = off[600 + x + 8 * j], nt_ = (n_ + 255) >> 8, hh = (nt_ > 0 && n_ - (nt_ - 1) * 256 <= 128) ? 1 : 0;
            off[860 + j] = tf; off[900 + j] = th; tf += nt_ - hh; th += hh; }
        off[860 + 32] = tf; off[900 + 32] = th; }
    __syncthreads();
}
DEV int find_expert(const int* off, int m0) {
    int lo = 0, hi = NE;
    while (hi - lo > 1) { const int mid = (lo + hi) >> 1; if (off[mid] <= m0) lo = mid; else hi = mid; }
    return lo;
}

DEV void ph_scatter(const P& p, int* off, int bid, int nb) {
    load_offsets(p.cnt, off);
    const int tid_ = otid();
    for (int slot = bid * NTHR + tid_; slot < NSLOT; slot += nb * NTHR) { const int r = off[p.asg_e[slot]] + p.asg_pos[slot]; p.rowlist[r] = slot; p.roww[r] = p.asg_w[slot]; }
    for (int e = bid; e < NE; e += nb) {
        const int n = p.cnt[e * 64], pd = (n + 255) & ~255;
        for (int i = n + tid_; i < pd; i += NTHR) { p.rowlist[off[e] + i] = -1; p.roww[off[e] + i] = 0.f; }
    }
}

DEV void ph_expert1(const P& p, float* sm, int* off, int bid, int nb) {
    load_offsets(p.cnt, off);
    const int nrt = off[NE] / 128, nt = nrt * 4;
    for (int t = bid; t < nt; t += nb) {
        const int m0 = (t >> 2) * 128, n0 = (t & 3) * 64, e = find_expert(off, m0);
        ngemm_tile<true>(p.XB, DM, RowTok{p.rowlist}, p.w_eg + (size_t)e * DM * EFF, p.w_eu + (size_t)e * DM * EFF, EFF, m0, n0, DM, EpiAct{p.ACT}, sm);
    }
}
DEV void ph_expert2(const P& p, float* sm, int* off, int bid, int nb) {
    load_offsets(p.cnt, off);
    const int nrt = off[NE] / 128, nt = nrt * 16;
    for (int t = bid; t < nt; t += nb) {
        const int m0 = (t >> 4) * 128, n0 = (t & 15) * 64, e = find_expert(off, m0);
        ngemm_tile<false>(p.ACT, EFF, RowId(), p.w_ed + (size_t)e * EFF * DM, nullptr, DM, m0, n0, EFF, EpiSlab{p.SLAB, p.rowlist, p.asg_w}, sm);
    }
}

namespace mg {
constexpr int BM = 256, BK = 64, HALF = 128, HTB = HALF * BK * 2, STAGE_BYTES = 8 * HTB, NXCD = 8, WGM = 8;
__host__ __device__ __forceinline__ int lds_byte(int r, int c) { const int st = (r >> 4) * 2 + (c >> 5), rr = r & 15, cc = c & 31, ob = rr * 64 + cc * 2; return st * 1024 + (ob ^ (((ob >> 9) & 1) << 5)); }
__host__ __device__ __forceinline__ void stage_rc(int b, int& R, int& C) { const int st = b / 1024, sb = b % 1024, swz = sb ^ (((sb >> 9) & 1) << 5); R = (st >> 1) * 16 + swz / 64; C = (st & 1) * 32 + (swz % 64) / 2; }
__host__ __device__ __forceinline__ int perm32(int rho) { const int n = rho >> 4, i = rho & 15; return 8 * (i >> 2) + 4 * n + (i & 3); }

struct Unit { int pm, pn, e, pad, half, pad2; const char* A; const char* B; };

struct DenseOrder { static constexpr bool HAS_HALF = false;
    int nM, nN, nwg, G, c; const char* A; const char* B; size_t tstep;
    DEV void init(const bf16_t* A_, const bf16_t* B_, int M, int N, int K, int G_, int c_) { nM = M / BM; nN = N / BM; nwg = nM * nN; G = G_; c = c_; A = (const char*)A_; B = (const char*)B_; tstep = (size_t)BM * K * 2; }
    DEV bool next(int i, Unit& u) const {
        const long L = (long)i * G + c; if (L >= nwg) return false;
        int wgid = (int)L; { const int q = nwg / NXCD, r = nwg % NXCD, xcd = wgid % NXCD, off = wgid / NXCD; wgid = (xcd < r ? xcd * (q + 1) : r * (q + 1) + (xcd - r) * q) + off; }
        const int nig = WGM * nN, gid = wgid / nig, fm = gid * WGM, gsz = (nM - fm) < WGM ? (nM - fm) : WGM;
        u.pm = fm + ((wgid % nig) % gsz); u.pn = (wgid % nig) / gsz; u.e = 0; u.pad = 0; u.half = 0; u.pad2 = 0;
        u.A = A + (size_t)u.pm * tstep; u.B = B + (size_t)u.pn * tstep; return true;
    }
};
struct PairOrder { static constexpr bool HAS_HALF = false; DenseOrder D; int kt0, kt1;
    DEV bool next(int i, Unit& u) const { if (!D.next(i >> 1, u)) return false; const int part = i & 1; u.e = part; u.pad = part ? kt1 : kt0;
        if (part) { u.A += (size_t)kt0 * 128; u.B += (size_t)kt0 * 128; } return true; }
};
struct ExpertOrder { static constexpr bool HAS_HALF = true;
    const LAS int* off; int ncol, G, c; const char* A; const char* W; size_t wstride, tstepB, tstepA; bool gather;
    DEV bool tile_of(int i, int& pm, int& pn, int& e) const {
        const int x = c & 7, cl = c >> 3, nbx = G >> 3;
        const int Lx = i * nbx + cl; int tx = Lx / ncol; pn = Lx % ncol;
        const int ftot = __builtin_amdgcn_readfirstlane(off[860 + 32]), htot = __builtin_amdgcn_readfirstlane(off[900 + 32]);
        if (tx >= ftot + htot) return false;
        const bool isf = tx < ftot; const int tb = isf ? 860 : 900; if (!isf) tx -= ftot;
        int lo = 0, hi = 32;
        while (hi - lo > 1) { const int mid = (lo + hi) >> 1; const int ov = __builtin_amdgcn_readfirstlane(off[tb + mid]); if (ov <= tx) lo = mid; else hi = mid; }
        e = x + 8 * lo;
        const int nfull = __builtin_amdgcn_readfirstlane(off[860 + lo + 1]) - __builtin_amdgcn_readfirstlane(off[860 + lo]);
        pm = (__builtin_amdgcn_readfirstlane(off[e]) >> 8) + (isf ? (tx - __builtin_amdgcn_readfirstlane(off[860 + lo])) : nfull);
        return true;
    }
    DEV bool next(int i, Unit& u) const {
        int pm, pn, e; if (!tile_of(i, pm, pn, e)) return false;
        u.pm = pm; u.pn = pn; u.e = e; u.pad = 0; u.pad2 = 0;
        u.half = (__builtin_amdgcn_readfirstlane(off[600 + e]) - (pm * BM - __builtin_amdgcn_readfirstlane(off[e])) <= HALF) ? 1 : 0;
        u.A = gather ? A : A + (size_t)pm * tstepA; u.B = W + (size_t)e * wstride + (size_t)pn * tstepB; return true;
    }
};

template <class Epi, class Sched, bool GATHER>
DEV void gemm_phase(LAS unsigned char* lds, const LAS unsigned* gtab, const int K, const Sched& S, const Epi& E) {
    const int tid = otid(), wid = __builtin_amdgcn_readfirstlane(tid >> 6), lane = tid & 63, wr = wid >> 2, wc = wid & 3, fr = lane & 15, fq = lane >> 4;
    const int nt = K / BK;
    int Rr[2], Cc[2]; unsigned voffB[2];
#pragma unroll
    for (int i = 0; i < 2; ++i) { stage_rc(tid * 16 + i * 8192, Rr[i], Cc[i]); const int Rb = Epi::PERM ? ((Rr[i] & ~31) + perm32(Rr[i] & 31)) : Rr[i]; voffB[i] = (unsigned)(Rb * K + Cc[i]) * 2u; }
    const size_t kstep = (size_t)(BK * 2);
    const size_t hstep = (size_t)HALF * K * 2;
    const unsigned ldsw = (unsigned)wid * 1024u;
    const int aoff = lds_byte(wr * 64 + fr, fq * 8), boff = lds_byte(wc * 32 + fr, fq * 8);
#define MG_SA(b, h) (((b) * 2 + (h)) * HTB)
#define MG_SB(b, h) ((4 + (b) * 2 + (h)) * HTB)
#define MG_STAGE(bufoff, gbase, voff) do { _Pragma("unroll") for (int _i = 0; _i < 2; ++_i) \
        __builtin_amdgcn_global_load_lds((const unsigned*)((const char*)(gbase) + (voff)[_i]), (LAS unsigned*)(lds + (bufoff) + ldsw + _i * 8192), 16, 0, 0); } while (0)
#define MG_LDA(dst, b, h) do { _Pragma("unroll") for (int m = 0; m < 4; ++m) _Pragma("unroll") for (int k = 0; k < 2; ++k) dst[m][k] = *(const LAS bf16x8*)(lds + MG_SA(b, h) + aoff + m * 2048 + k * 1024); } while (0)
#define MG_LDB(dst, b, h) do { _Pragma("unroll") for (int n = 0; n < 2; ++n) _Pragma("unroll") for (int k = 0; k < 2; ++k) dst[n][k] = *(const LAS bf16x8*)(lds + MG_SB(b, h) + boff + n * 2048 + k * 1024); } while (0)
#define MG_MMA(ai, bj, At, Bt) do { __builtin_amdgcn_s_setprio(1); _Pragma("unroll") for (int m = 0; m < 4; ++m) _Pragma("unroll") for (int n = 0; n < 2; ++n) _Pragma("unroll") for (int k = 0; k < 2; ++k) \
        acc[ai][bj][m][n] = __builtin_amdgcn_mfma_f32_16x16x32_bf16(Bt[n][k], At[m][k], acc[ai][bj][m][n], 0, 0, 0); __builtin_amdgcn_s_setprio(0); } while (0)
#define MG_WAIT_V(n) asm volatile("s_waitcnt vmcnt(" #n ")" ::: "memory")
#define MG_WAIT_L(n) asm volatile("s_waitcnt lgkmcnt(" #n ")" ::: "memory")
#define MG_BAR __builtin_amdgcn_s_barrier()
#define MG_SCHED __builtin_amdgcn_sched_barrier(0)
    Unit cur, nxt; int ui = 0;
    if (!S.next(0, cur)) return;
    int ntc = cur.pad > 0 ? cur.pad : nt;
    bool hf = Sched::HAS_HALF && (cur.half != 0);
    f32x4 acc[2][2][4][2];
#pragma unroll
    for (int a = 0; a < 2; ++a)
#pragma unroll
        for (int b = 0; b < 2; ++b)
#pragma unroll
            for (int m = 0; m < 4; ++m)
#pragma unroll
                for (int n = 0; n < 2; ++n) acc[a][b][m][n] = (f32x4){0.f, 0.f, 0.f, 0.f};
    bf16x8 At[4][2], B0[2][2], B1[2][2];
    unsigned va0[2], va1[2], na0[2], na1[2];
#pragma unroll
    for (int i = 0; i < 2; ++i) {
        if (GATHER) { va0[i] = gtab[Rr[i]] + (unsigned)Cc[i] * 2u; va1[i] = gtab[HALF + Rr[i]] + (unsigned)Cc[i] * 2u; }
        else { va0[i] = (unsigned)(Rr[i] * K + Cc[i]) * 2u; va1[i] = va0[i] + (unsigned)hstep; }
        na0[i] = va0[i]; na1[i] = va1[i];
    }
    const char* cA = cur.A; const char* cB = cur.B;
    MG_STAGE(MG_SB(0, 0), cB, voffB); MG_STAGE(MG_SB(0, 1), cB + hstep, voffB); MG_STAGE(MG_SA(0, 0), cA, va0); MG_STAGE(MG_SA(0, 1), cA, va1);
    if (wr == 1) MG_BAR;
    MG_WAIT_V(2); MG_BAR;
    MG_STAGE(MG_SB(1, 0), cB + kstep, voffB); MG_STAGE(MG_SA(1, 0), cA + kstep, va0); MG_STAGE(MG_SB(1, 1), cB + hstep + kstep, voffB);
    MG_WAIT_V(6); MG_BAR;
    for (;;) {
        const bool has_next = S.next(ui + 1, nxt);
        const char* nA = has_next ? nxt.A : cA; const char* nB = has_next ? nxt.B : cB;
        if (GATHER) {
            if (has_next) {
#pragma unroll
                for (int i = 0; i < 2; ++i) { na0[i] = gtab[(ui + 1) * BM + Rr[i]] + (unsigned)Cc[i] * 2u; na1[i] = gtab[(ui + 1) * BM + HALF + Rr[i]] + (unsigned)Cc[i] * 2u; }
            }
        }
#pragma unroll 1
        for (int t = 0; t < ntc; t += 2) {
            const bool last = (t == ntc - 2);
            const char* a1 = cA + (size_t)(t + 1) * kstep;
            const char* a2 = last ? nA : cA + (size_t)(t + 2) * kstep; const char* b2 = last ? nB : cB + (size_t)(t + 2) * kstep;
            const char* a3 = a2 + kstep; const char* b3 = b2 + kstep;
            unsigned o0[2], o1[2];
#pragma unroll
            for (int i = 0; i < 2; ++i) { o0[i] = (GATHER && last) ? na0[i] : va0[i]; o1[i] = (GATHER && last) ? na1[i] : va1[i]; }
            MG_LDB(B0, 0, 0); MG_LDB(B1, 0, 1); MG_SCHED; MG_LDA(At, 0, 0); MG_STAGE(MG_SA(1, 1), a1, va1);
            MG_WAIT_V(8); MG_WAIT_L(0); MG_BAR; MG_MMA(0, 0, At, B0); MG_MMA(0, 1, At, B1); MG_BAR; MG_SCHED;
            if (!hf) MG_LDA(At, 0, 1); MG_STAGE(MG_SB(0, 0), b2, voffB); MG_STAGE(MG_SB(0, 1), b2 + hstep, voffB); MG_STAGE(MG_SA(0, 0), a2, o0);
            MG_WAIT_V(8); MG_WAIT_L(0); MG_BAR; if (!hf) { MG_MMA(1, 0, At, B0); MG_MMA(1, 1, At, B1); } MG_BAR; MG_SCHED;
            MG_LDB(B0, 1, 0); MG_LDB(B1, 1, 1); MG_SCHED; MG_LDA(At, 1, 0); MG_STAGE(MG_SA(0, 1), a2, o1);
            MG_WAIT_V(8); MG_WAIT_L(0); MG_BAR; MG_MMA(0, 0, At, B0); MG_MMA(0, 1, At, B1); MG_BAR; MG_SCHED;
            if (!hf) MG_LDA(At, 1, 1); MG_STAGE(MG_SB(1, 0), b3, voffB); MG_STAGE(MG_SB(1, 1), b3 + hstep, voffB); MG_STAGE(MG_SA(1, 0), a3, o0);
            MG_WAIT_V(8); MG_WAIT_L(0); MG_BAR; if (!hf) { MG_MMA(1, 0, At, B0); MG_MMA(1, 1, At, B1); } MG_BAR; MG_SCHED;
        }
        if (wr == 0) MG_BAR;
        E(acc, cur, wr, wc, fr, fq);
        if (!has_next) break;
        if (!(Epi::KEEP_ACC && cur.e == 0)) {
#pragma unroll
        for (int a = 0; a < 2; ++a)
#pragma unroll
            for (int b = 0; b < 2; ++b)
#pragma unroll
                for (int m = 0; m < 4; ++m)
#pragma unroll
                    for (int n = 0; n < 2; ++n) acc[a][b][m][n] = (f32x4){0.f, 0.f, 0.f, 0.f};
        }
        cur = nxt; cA = nA; cB = nB; ++ui; ntc = cur.pad > 0 ? cur.pad : nt; hf = Sched::HAS_HALF && (cur.half != 0);
#pragma unroll
        for (int i = 0; i < 2; ++i) { va0[i] = na0[i]; va1[i] = na1[i]; }
        if (wr == 1) MG_BAR;
    }
    MG_WAIT_V(0);
    MG_BAR;
    __syncthreads();
#undef MG_SA
#undef MG_SB
#undef MG_STAGE
#undef MG_LDA
#undef MG_LDB
#undef MG_MMA
#undef MG_WAIT_V
#undef MG_WAIT_L
#undef MG_BAR
#undef MG_SCHED
}

DEV u32x4 pack8(const f32x4 a, const f32x4 b) { u32x4 w; w.x = pk2(a[0], a[1]); w.y = pk2(a[2], a[3]); w.z = pk2(b[0], b[1]); w.w = pk2(b[2], b[3]); return w; }
DEV f32x4 unpack_lo(const u32x4 w) { return (f32x4){__uint_as_float(w.x << 16), __uint_as_float(w.x & 0xffff0000u), __uint_as_float(w.y << 16), __uint_as_float(w.y & 0xffff0000u)}; }
DEV f32x4 unpack_hi(const u32x4 w) { return (f32x4){__uint_as_float(w.z << 16), __uint_as_float(w.z & 0xffff0000u), __uint_as_float(w.w << 16), __uint_as_float(w.w & 0xffff0000u)}; }
DEV f32x4 sig4(const f32x4 v) { return (f32x4){sigm(v[0]), sigm(v[1]), sigm(v[2]), sigm(v[3])}; }
DEV f32x4 silu4(const f32x4 v) { return (f32x4){silu(v[0]), silu(v[1]), silu(v[2]), silu(v[3])}; }
#define ACC_T f32x4 (&acc)[2][2][4][2]

struct MEpiInProj { static constexpr bool PERM = true; static constexpr bool KEEP_ACC = false; bf16_t *U, *QKV, *G;
    DEV void operator()(ACC_T, const Unit& u, int wr, int wc, int fr, int fq) const {
        int colt = u.pn * BM; bf16_t* base; int ld; bool sg = false;
        if (colt < 512) { base = U; ld = 512; } else if (colt < 2816) { base = QKV; ld = 2304; colt -= 512; } else { base = G; ld = 2048; colt -= 2816; sg = true; }
        const int row0 = u.pm * BM + wr * 64 + fr, col0 = colt + wc * 32 + 8 * fq;
#pragma unroll
        for (int ai = 0; ai < 2; ++ai)
#pragma unroll
            for (int m = 0; m < 4; ++m) { bf16_t* rowp = base + (size_t)(row0 + ai * HALF + m * 16) * ld + col0;
#pragma unroll
                for (int bj = 0; bj < 2; ++bj) { f32x4 v0 = acc[ai][bj][m][0], v1 = acc[ai][bj][m][1]; if (sg) { v0 = sig4(v0); v1 = sig4(v1); }
                    *(u32x4*)(rowp + bj * HALF) = pack8(v0, v1); }
                asm volatile("" ::: "memory"); }
    } };
struct MEpiMergeF { static constexpr bool PERM = true; static constexpr bool KEEP_ACC = true; bf16_t* MG; const bf16_t* G;
    DEV void mid(f32x4 (&acc)[2][2][4][2], const Unit& u, int wr, int wc, int fr, int fq) const {
        const int row0 = u.pm * BM + wr * 64 + fr, col0 = u.pn * BM + wc * 32 + 8 * fq;
#pragma unroll
        for (int ai = 0; ai < 2; ++ai)
#pragma unroll
            for (int m = 0; m < 4; ++m) { const bf16_t* gr = G + (size_t)(row0 + ai * HALF + m * 16) * 2048 + col0;
#pragma unroll
                for (int bj = 0; bj < 2; ++bj)
#pragma unroll
                    for (int n = 0; n < 2; ++n) { const u32x2 gp = *(const u32x2*)(gr + bj * HALF + 4 * n), ga = *(const u32x2*)(gr + 1024 + bj * HALF + 4 * n);
                        acc[ai][bj][m][n] *= (f32x4){__uint_as_float(gp.x << 16) * __builtin_amdgcn_rcpf(__uint_as_float(ga.x << 16)), __uint_as_float(gp.x & 0xffff0000u) * __builtin_amdgcn_rcpf(__uint_as_float(ga.x & 0xffff0000u)),
                                                     __uint_as_float(gp.y << 16) * __builtin_amdgcn_rcpf(__uint_as_float(ga.y << 16)), __uint_as_float(gp.y & 0xffff0000u) * __builtin_amdgcn_rcpf(__uint_as_float(ga.y & 0xffff0000u))};
                        asm volatile("" ::: "memory"); } }
    }
    DEV void operator()(f32x4 (&acc)[2][2][4][2], const Unit& u, int wr, int wc, int fr, int fq) const {
        if (u.e == 0) { mid(acc, u, wr, wc, fr, fq); return; }
        const int row0 = u.pm * BM + wr * 64 + fr, col0 = u.pn * BM + wc * 32 + 8 * fq;
#pragma unroll
        for (int ai = 0; ai < 2; ++ai)
#pragma unroll
            for (int m = 0; m < 4; ++m) { const size_t r = (size_t)(row0 + ai * HALF + m * 16);
#pragma unroll
                for (int bj = 0; bj < 2; ++bj) { const int c = col0 + bj * HALF;
                    const u32x4 ga = *(const u32x4*)(G + r * 2048 + 1024 + c);
                    *(u32x4*)(MG + r * DM + c) = pack8(acc[ai][bj][m][0] * unpack_lo(ga), acc[ai][bj][m][1] * unpack_hi(ga)); }
                asm volatile("" ::: "memory"); }
    } };
struct MEpiOutProj { static constexpr bool PERM = false; static constexpr bool KEEP_ACC = false; const float* x; float* out; const float* mod;
    DEV void operator()(ACC_T, const Unit& u, int wr, int wc, int fr, int fq) const {
        const int row0 = u.pm * BM + wr * 64 + fr, col0 = u.pn * BM + wc * 32 + 4 * fq;
        const float* gm = mod + ((u.pm * BM) / SEQ) * NMOD + 2048;
#pragma unroll
        for (int ai = 0; ai < 2; ++ai)
#pragma unroll
            for (int m = 0; m < 4; ++m) { const size_t r = (size_t)(row0 + ai * HALF + m * 16) * DM;
#pragma unroll
                for (int bj = 0; bj < 2; ++bj)
#pragma unroll
                    for (int n = 0; n < 2; ++n) { const int c = col0 + bj * HALF + n * 16;
                        *(f32x4*)(out + r + c) = *(const f32x4*)(x + r + c) + *(const f32x4*)(gm + c) * acc[ai][bj][m][n]; }
                asm volatile("" ::: "memory"); }
    } };
struct MEpiRouterShared { static constexpr bool PERM = true; static constexpr bool KEEP_ACC = false; float* LG; bf16_t* HS;
    DEV void operator()(ACC_T, const Unit& u, int wr, int wc, int fr, int fq) const {
        const int row0 = u.pm * BM + wr * 64 + fr, cw = wc * 32 + 8 * fq;
#pragma unroll
        for (int ai = 0; ai < 2; ++ai)
#pragma unroll
            for (int m = 0; m < 4; ++m) { const size_t r = (size_t)(row0 + ai * HALF + m * 16);
                if (u.pn == 0) {
#pragma unroll
                    for (int bj = 0; bj < 2; ++bj)
#pragma unroll
                        for (int n = 0; n < 2; ++n) *(f32x4*)(LG + r * NE + bj * HALF + cw + 4 * n) = acc[ai][bj][m][n];
                } else {
                    const f32x4 v0 = silu4(acc[ai][0][m][0]) * acc[ai][1][m][0], v1 = silu4(acc[ai][0][m][1]) * acc[ai][1][m][1];
                    *(u32x4*)(HS + r * EFF + (u.pn - 1) * HALF + cw) = pack8(v0, v1);
                }
                asm volatile("" ::: "memory"); }
    } };
struct MEpiAct { static constexpr bool PERM = true; static constexpr bool KEEP_ACC = false; bf16_t* ACT;
    DEV void operator()(ACC_T, const Unit& u, int wr, int wc, int fr, int fq) const {
        const int row0 = u.pm * BM + wr * 64 + fr, cw = u.pn * HALF + wc * 32 + 8 * fq;
#pragma unroll
        for (int ai = 0; ai < 2; ++ai) { if (ai == 1 && u.half) break;
#pragma unroll
            for (int m = 0; m < 4; ++m) { const size_t r = (size_t)(row0 + ai * HALF + m * 16);
                const f32x4 v0 = silu4(acc[ai][0][m][0]) * acc[ai][1][m][0], v1 = silu4(acc[ai][0][m][1]) * acc[ai][1][m][1];
                *(u32x4*)(ACT + r * EFF + cw) = pack8(v0, v1); asm volatile("" ::: "memory"); } }
    } };
constexpr float SLAB_SCALE = 8.f, SLAB_INV = 0.125f;
DEV unsigned pk4_fp8(float a, float b, float c, float d) {
    a = fminf(fmaxf(a, -440.f), 440.f); b = fminf(fmaxf(b, -440.f), 440.f); c = fminf(fmaxf(c, -440.f), 440.f); d = fminf(fmaxf(d, -440.f), 440.f);
    int w = 0; w = __builtin_amdgcn_cvt_pk_fp8_f32(a, b, w, false); w = __builtin_amdgcn_cvt_pk_fp8_f32(c, d, w, true); return (unsigned)w; }
struct MEpiSlab { static constexpr bool PERM = true; static constexpr bool KEEP_ACC = false; unsigned char* SLAB; const int* rl; const float* w;
    DEV void operator()(ACC_T, const Unit& u, int wr, int wc, int fr, int fq) const {
        const int row0 = u.pm * BM + wr * 64 + fr, c16 = u.pn * BM + wc * 64 + 16 * fq;
#pragma unroll
        for (int ai = 0; ai < 2; ++ai) { if (ai == 1 && u.half) break;
#pragma unroll
            for (int m = 0; m < 4; ++m) { const int s = rl[row0 + ai * HALF + m * 16]; const float g = w[row0 + ai * HALF + m * 16] * SLAB_SCALE;
                if (s >= 0) { u32x4 o;
                    { const f32x4 a = acc[ai][0][m][0] * g, b = acc[ai][0][m][1] * g; o.x = pk4_fp8(a[0], a[1], a[2], a[3]); o.y = pk4_fp8(b[0], b[1], b[2], b[3]); }
                    { const f32x4 a = acc[ai][1][m][0] * g, b = acc[ai][1][m][1] * g; o.z = pk4_fp8(a[0], a[1], a[2], a[3]); o.w = pk4_fp8(b[0], b[1], b[2], b[3]); }
                    *(u32x4*)(SLAB + (size_t)s * DM + c16) = o; }
                asm volatile("" ::: "memory"); } }
    } };
DEV void acc4_fp8(f32x4& a, unsigned w) { const auto lo = __builtin_amdgcn_cvt_pk_f32_fp8((int)w, false), hi = __builtin_amdgcn_cvt_pk_f32_fp8((int)w, true); a[0] += lo[0]; a[1] += lo[1]; a[2] += hi[0]; a[3] += hi[1]; }
struct MEpiFinal { static constexpr bool PERM = true; static constexpr bool KEEP_ACC = false; float* out; const unsigned char* SLAB; const float* mod;
    DEV void operator()(ACC_T, const Unit& u, int wr, int wc, int fr, int fq) const {
        const int row0 = u.pm * BM + wr * 64 + fr, c16 = u.pn * BM + wc * 64 + 16 * fq;
        const float* gm = mod + ((u.pm * BM) / SEQ) * NMOD + 5120 + c16;
#pragma unroll
        for (int ai = 0; ai < 2; ++ai)
#pragma unroll
            for (int m = 0; m < 4; ++m) { const size_t row = (size_t)(row0 + ai * HALF + m * 16);
                const unsigned char* sp = SLAB + row * 8 * DM + c16;
                float* op = out + row * DM + c16;
                f32x4 s4[4];
#pragma unroll
                for (int q = 0; q < 4; ++q) s4[q] = (f32x4){0.f, 0.f, 0.f, 0.f};
#pragma unroll
                for (int kh = 0; kh < 2; ++kh) { u32x4 sw[4];
#pragma unroll
                    for (int k = 0; k < 4; ++k) sw[k] = *(const u32x4*)(sp + (size_t)(kh * 4 + k) * DM);
#pragma unroll
                    for (int k = 0; k < 4; ++k) { acc4_fp8(s4[0], sw[k].x); acc4_fp8(s4[1], sw[k].y); acc4_fp8(s4[2], sw[k].z); acc4_fp8(s4[3], sw[k].w); } }
                s4[0] = s4[0] * SLAB_INV + acc[ai][0][m][0]; s4[1] = s4[1] * SLAB_INV + acc[ai][0][m][1]; s4[2] = s4[2] * SLAB_INV + acc[ai][1][m][0]; s4[3] = s4[3] * SLAB_INV + acc[ai][1][m][1];
#pragma unroll
                for (int q = 0; q < 4; ++q) *(f32x4*)(op + 4 * q) = *(const f32x4*)(op + 4 * q) + *(const f32x4*)(gm + 4 * q) * s4[q];
                asm volatile("" ::: "memory"); }
    } };
#undef ACC_T
}

typedef float f32x16 __attribute__((ext_vector_type(16)));
typedef short s16x4 __attribute__((ext_vector_type(4)));
DEV int crow(int r, int hi) { return (r & 3) + 8 * (r >> 2) + 4 * hi; }
DEV unsigned cvtpk(float lo, float hi) { unsigned r; asm("v_cvt_pk_bf16_f32 %0, %1, %2" : "=v"(r) : "v"(lo), "v"(hi)); return r; }
DEV s16x4 vtr(const LAS unsigned char* p) { return __builtin_bit_cast(s16x4, __builtin_amdgcn_ds_read_tr16_b64_v4i16((LAS s16x4*)p)); }
DEV float swap32(float v) { return __shfl_xor(v, 32); }

DEV void normrope_frag(bf16x8 (&f)[4], const LAS float* gt, int hi, float posf) {
    float x[32]; float ss = 0.f;
#pragma unroll
    for (int d0 = 0; d0 < 4; ++d0) { const u32x4 w = __builtin_bit_cast(u32x4, f[d0]);
        x[8 * d0 + 0] = __uint_as_float(w.x << 16); x[8 * d0 + 1] = __uint_as_float(w.x & 0xffff0000u); x[8 * d0 + 2] = __uint_as_float(w.y << 16); x[8 * d0 + 3] = __uint_as_float(w.y & 0xffff0000u);
        x[8 * d0 + 4] = __uint_as_float(w.z << 16); x[8 * d0 + 5] = __uint_as_float(w.z & 0xffff0000u); x[8 * d0 + 6] = __uint_as_float(w.w << 16); x[8 * d0 + 7] = __uint_as_float(w.w & 0xffff0000u); }
#pragma unroll
    for (int i = 0; i < 32; ++i) ss += x[i] * x[i];
    ss += __shfl_xor(ss, 32);
    const float rs = rsqrtf(ss * (1.f / 64.f) + 1e-6f);
#pragma unroll
    for (int d0 = 0; d0 < 4; ++d0) { const f32x4 g0 = *(const LAS f32x4*)(gt + 16 * d0 + 8 * hi), g1 = *(const LAS f32x4*)(gt + 16 * d0 + 8 * hi + 4);
#pragma unroll
        for (int j = 0; j < 4; ++j) { x[8 * d0 + j] *= rs * g0[j]; x[8 * d0 + 4 + j] *= rs * g1[j]; } }
    constexpr float INVF[8] = {1.0f, 0.19392274474868576f, 0.03760603093086393f, 0.007292664737217109f, 0.001414213562373095f, 0.0002742481756762073f, 5.318295896944988e-05f, 1.031338537721246e-05f};
#pragma unroll
    for (int i = 0; i < 8; ++i) {
        const float rev = posf * (INVF[i] * 0.15915494309189535f);
        const float fr = rev - floorf(rev);
        const float cs = __builtin_amdgcn_cosf(fr), sn = __builtin_amdgcn_sinf(fr);
        const float partner = __shfl_xor(x[i], 32);
        x[i] = hi ? (x[i] * cs + partner * sn) : (x[i] * cs - partner * sn);
    }
#pragma unroll
    for (int d0 = 0; d0 < 4; ++d0) { u32x4 w; w.x = cvtpk(x[8 * d0], x[8 * d0 + 1]); w.y = cvtpk(x[8 * d0 + 2], x[8 * d0 + 3]); w.z = cvtpk(x[8 * d0 + 4], x[8 * d0 + 5]); w.w = cvtpk(x[8 * d0 + 6], x[8 * d0 + 7]);
        f[d0] = __builtin_bit_cast(bf16x8, w); }
}

DEV void ph_attn_mfma(const P& p, LAS unsigned char* lds, int bid, int nb) {
    const int tid = otid(); const int lane = tid & 63, wid = __builtin_amdgcn_readfirstlane(tid >> 6), r32 = lane & 31, hi = lane >> 5;
    LAS unsigned char* vl = lds + wid * 8192;
    LAS float* wsf = (LAS float*)(lds + wid * 8192 + 4096);
    LAS float* gtab_q = (LAS float*)(lds + wid * 8192 + 4352);
    LAS float* gtab_k = gtab_q + 64;
    gtab_q[lane] = p.q_norm_g[lane]; gtab_k[lane] = p.k_norm_g[lane];
    asm volatile("s_waitcnt lgkmcnt(0)" ::: "memory");
    float gq = fabsf(p.q_norm_g[lane]), gk = fabsf(p.k_norm_g[lane]);
#pragma unroll
    for (int o = 32; o >= 1; o >>= 1) { gq = fmaxf(gq, __shfl_xor(gq, o)); gk = fmaxf(gk, __shfl_xor(gk, o)); }
    constexpr float LOG2E = 1.4426950408889634f, C2 = 0.125f * LOG2E;
    const float nmref = -(8.f * gq * gk * LOG2E);
    const int head = wid >> 1, qh = wid & 1;
    const int tq = (lane & 15) >> 2, tp = lane & 3, tcb = (lane >> 4) & 1;
    const LAS unsigned char* vrd = vl + (4 * hi + tq) * 128 + (16 * tcb + 4 * tp) * 2;
    for (int it = bid; it < NB * 96; it += nb) {
        const int cb = it & 31, g = (it >> 5) % 3, b = it / 96;
        const int dsh = 2 * g, d = 1 << dsh, L = SEQ >> dsh, nbk = L >> 6;
        const int r = cb / nbk, blk = cb % nbk;
        const int h = 4 * g + head, base = b * SEQ;
        const int q0 = 64 * blk + 32 * qh;
        const int mq = q0 + r32;
        const bf16_t* qp = p.QKV + (size_t)(base + mq * d + r) * 2304 + h * 64 + hi * 8;
        bf16x8 qr[4];
#pragma unroll
        for (int d0 = 0; d0 < 4; ++d0) qr[d0] = *(const bf16x8*)(qp + d0 * 16);
        normrope_frag(qr, gtab_q, hi, (float)p.pos[base + mq * d + r]);
        f32x16 o0, o1;
#pragma unroll
        for (int i = 0; i < 16; ++i) { o0[i] = 0.f; o1[i] = 0.f; }
        float lsum = 0.f;
        const int kb0 = q0 - 64;
#pragma unroll 1
        for (int st = 0; st < 5; ++st) {
            const int k0 = kb0 + 32 * st;
            if (k0 + 31 < 0 || k0 >= L) continue;
            const int mkc = min(max(k0 + r32, 0), L - 1);
            const bf16_t* kp = p.QKV + (size_t)(base + mkc * d + r) * 2304 + 768 + h * 64 + hi * 8;
            bf16x8 kf[4];
#pragma unroll
            for (int d0 = 0; d0 < 4; ++d0) kf[d0] = *(const bf16x8*)(kp + d0 * 16);
            const float kposf = (float)p.pos[base + mkc * d + r];
            u32x4 vreg[4];
#pragma unroll
            for (int i = 0; i < 4; ++i) { const int c = lane + 64 * i, row = c >> 3, ch = c & 7; const int mv = min(max(k0 + row, 0), L - 1);
                vreg[i] = *(const u32x4*)(p.QKV + (size_t)(base + mv * d + r) * 2304 + 1536 + h * 64 + ch * 8); }
            normrope_frag(kf, gtab_k, hi, kposf);
            f32x16 s;
#pragma unroll
            for (int i = 0; i < 16; ++i) s[i] = 0.f;
#pragma unroll
            for (int d0 = 0; d0 < 4; ++d0) s = __builtin_amdgcn_mfma_f32_32x32x16_bf16(kf[d0], qr[d0], s, 0, 0, 0);
#pragma unroll
            for (int i = 0; i < 16; ++i) { const int key = k0 + crow(i, hi); const int df = key - mq;
                const bool valid = (key >= 0) && (key < L) && (df <= 64) && (df >= -64);
                const float pv = valid ? __builtin_amdgcn_exp2f(__builtin_fmaf(s[i], C2, nmref)) : 0.f; lsum += pv; s[i] = pv; }
            bf16x8 pf0, pf1;
            { u32x4 w0, w1; w0.x = cvtpk(s[0], s[1]); w0.y = cvtpk(s[2], s[3]); w0.z = cvtpk(s[4], s[5]); w0.w = cvtpk(s[6], s[7]);
              w1.x = cvtpk(s[8], s[9]); w1.y = cvtpk(s[10], s[11]); w1.z = cvtpk(s[12], s[13]); w1.w = cvtpk(s[14], s[15]);
              pf0 = __builtin_bit_cast(bf16x8, w0); pf1 = __builtin_bit_cast(bf16x8, w1); }
#pragma unroll
            for (int i = 0; i < 4; ++i) { const int c = lane + 64 * i, row = c >> 3, ch = c & 7; *(LAS u32x4*)(vl + row * 128 + ch * 16) = vreg[i]; }
            asm volatile("s_waitcnt lgkmcnt(0)" ::: "memory");
#pragma unroll
            for (int n = 0; n < 2; ++n)
#pragma unroll
                for (int ks = 0; ks < 2; ++ks) {
                    const s16x4 lo = vtr(vrd + (16 * ks) * 128 + 64 * n), hi4 = vtr(vrd + (16 * ks + 8) * 128 + 64 * n);
                    bf16x8 vf; vf[0] = lo[0]; vf[1] = lo[1]; vf[2] = lo[2]; vf[3] = lo[3]; vf[4] = hi4[0]; vf[5] = hi4[1]; vf[6] = hi4[2]; vf[7] = hi4[3];
                    if (n == 0) o0 = __builtin_amdgcn_mfma_f32_32x32x16_bf16(ks == 0 ? pf0 : pf1, vf, o0, 0, 0, 0);
                    else o1 = __builtin_amdgcn_mfma_f32_32x32x16_bf16(ks == 0 ? pf0 : pf1, vf, o1, 0, 0, 0);
                }
            asm volatile("s_waitcnt lgkmcnt(0)" ::: "memory");
        }
        const float lt = lsum + swap32(lsum);
        if (hi == 0) { wsf[r32] = 1.f / lt; p.LSUM[((size_t)g * T + (base + mq * d + r)) * 4 + head] = lt; }
        asm volatile("s_waitcnt lgkmcnt(0)" ::: "memory");
        bf16_t* og = p.OG + (size_t)g * T * 256 + head * 64 + r32;
#pragma unroll
        for (int i = 0; i < 16; ++i) { const int qq = crow(i, hi); const float inv = wsf[qq]; const size_t tok = (size_t)(base + (q0 + qq) * d + r);
            og[tok * 256] = f2bf(o0[i] * inv); og[tok * 256 + 32] = f2bf(o1[i] * inv); }
        asm volatile("s_waitcnt lgkmcnt(0)" ::: "memory");
    }
}
DEV void ph_attn_combine(const P& p, int bid, int nb) {
    const int tid_ = otid();
    for (int i = bid * NTHR + tid_; i < T * 32; i += nb * NTHR) {
        const int t = i >> 5, ch = i & 31, slot = ch >> 3;
        const float l0 = p.LSUM[(size_t)t * 4 + slot], l1 = p.LSUM[((size_t)T + t) * 4 + slot], l2 = p.LSUM[((size_t)2 * T + t) * 4 + slot];
        const float inv = 1.f / (l0 + l1 + l2);
        const u32x4 a = *(const u32x4*)(p.OG + (size_t)t * 256 + ch * 8), b = *(const u32x4*)(p.OG + ((size_t)T + t) * 256 + ch * 8), c = *(const u32x4*)(p.OG + ((size_t)2 * T + t) * 256 + ch * 8);
        const f32x4 lo = (mg::unpack_lo(a) * l0 + mg::unpack_lo(b) * l1 + mg::unpack_lo(c) * l2) * inv;
        const f32x4 hi = (mg::unpack_hi(a) * l0 + mg::unpack_hi(b) * l1 + mg::unpack_hi(c) * l2) * inv;
        *(u32x4*)(p.PL + (size_t)t * 768 + 512 + ch * 8) = mg::pack8(lo, hi);
    }
}

template <class Src>
DEV void transpose_blk(const Src& src, int K, bf16_t* WT0, LAS float* scr, int k0, int lane) {
#pragma unroll 8
    for (int i = 0; i < 32; ++i) { const int kk = 2 * i + (lane >> 5); scr[kk * 33 + (lane & 31)] = src(k0 + kk, lane & 31); }
    asm volatile("s_waitcnt lgkmcnt(0)" ::: "memory");
    const int c = lane & 7;
#pragma unroll
    for (int j = 0; j < 4; ++j) { const int n = (lane >> 3) + 8 * j; const LAS float* s = scr + (8 * c) * 33 + n;
        u32x4 o; o.x = pk2(s[0 * 33], s[1 * 33]); o.y = pk2(s[2 * 33], s[3 * 33]); o.z = pk2(s[4 * 33], s[5 * 33]); o.w = pk2(s[6 * 33], s[7 * 33]);
        *(u32x4*)(WT0 + (size_t)n * K + k0 + 8 * c) = o; }
    asm volatile("s_waitcnt lgkmcnt(0)" ::: "memory");
}
struct SrcCol { const float* W; int ld; DEV float operator()(int k, int j) const { return W[(size_t)k * ld + j]; } };
struct SrcEff { const float *wg, *ls, *wu;
    DEV float operator()(int k, int j) const { const int g = k >> 7; const float* a = wg + (size_t)k * 128; const float* l = ls + g * 128; const float* b = wu + (size_t)(g * 128) * DM + j; float s = 0.f;
#pragma unroll 4
        for (int d = 0; d < 128; ++d) s += a[d] * l[d] * b[(size_t)d * DM]; return s; } };
DEV void tr_plain(const float* W, int K, int N, bf16_t* WT, LAS float* scr, int item, int lane) {
    const int nblk = N / 32, k0 = 64 * (item / nblk), n0 = 32 * (item % nblk);
    transpose_blk(SrcCol{W + n0, N}, K, WT + (size_t)n0 * K, scr, k0, lane);
}
DEV void tr_perm16(const float* W, int K, int N, bf16_t* WT, LAS float* scr, int item, int lane) {
    const int nblk = N / 32, k0 = 64 * (item / nblk), rho0 = 32 * (item % nblk);
    const int tile = rho0 >> 8, bj = (rho0 >> 7) & 1, wc = (rho0 >> 5) & 3;
    const int n0 = tile * 256 + 64 * wc + 8 * bj;
    struct SrcP { const float* W; int ld; DEV float operator()(int k, int dr) const { return W[(size_t)k * ld + 16 * (dr >> 3) + (dr & 7)]; } };
    transpose_blk(SrcP{W + n0, N}, K, WT + (size_t)rho0 * K, scr, k0, lane);
}
DEV void tr_gu(const float* g, const float* u, int K, bf16_t* WT, LAS float* scr, int k0, int rho0, int lane) {
    const int ch0 = (rho0 >> 8) * 128 + (rho0 & 127);
    const float* m = (rho0 & 128) ? u : g;
    transpose_blk(SrcCol{m + ch0, EFF}, K, WT + (size_t)rho0 * K, scr, k0, lane);
}

DEV void ph_prep_small(const P& p, LAS float* scr, int gw, int ngw, int lane) {
    constexpr int I_IN = 16 * (INW / 32), I_EFF = 64 * 16, I_AU = 4 * 32, I_OUT = 16 * 32, I_R = 16 * 8, I_S = 16 * 16, I_SD = 4 * 32;
    constexpr int NIT = I_IN + I_EFF + I_AU + I_OUT + I_R + I_S + I_SD;
    for (int it = gw; it < NIT; it += ngw) {
        int r = it;
        if (r < I_IN) { tr_plain(p.w_in, DM, INW, p.WT_IN, scr, r, lane); continue; } r -= I_IN;
        if (r < I_EFF) {
            const int n = 64 * (r & 15) + lane, k0 = 8 * (r >> 4), g = k0 >> 7;
            const float* a = p.pool_w_grp + (size_t)k0 * 128; const float* l = p.pool_scale + g * 128; const float* b = p.w_pool_up + (size_t)(g * 128) * DM + n;
            float acc[8];
#pragma unroll
            for (int j = 0; j < 8; ++j) acc[j] = 0.f;
#pragma unroll 4
            for (int d = 0; d < 128; ++d) { const float bl = b[(size_t)d * DM] * l[d];
#pragma unroll
                for (int j = 0; j < 8; ++j) acc[j] += a[j * 128 + d] * bl; }
            u32x4 o; o.x = pk2(acc[0], acc[1]); o.y = pk2(acc[2], acc[3]); o.z = pk2(acc[4], acc[5]); o.w = pk2(acc[6], acc[7]);
            *(u32x4*)(p.WT_EFF + (size_t)n * 768 + k0) = o; continue; } r -= I_EFF;
        if (r < I_AU) { const int k0 = 64 * (r / 32), n0 = 32 * (r % 32);
            transpose_blk(SrcCol{p.w_attn_up + n0, DM}, 768, p.WT_EFF + (size_t)n0 * 768 + 512, scr, k0, lane); continue; } r -= I_AU;
        if (r < I_OUT) { tr_plain(p.w_out, DM, DM, p.WT_OUT, scr, r, lane); continue; } r -= I_OUT;
        if (r < I_R) { tr_plain(p.w_router, DM, NE, p.WT_RS, scr, r, lane); continue; } r -= I_R;
        if (r < I_S) { tr_gu(p.w_sg, p.w_su, DM, p.WT_RS + (size_t)256 * DM, scr, 64 * (r / 16), 32 * (r % 16), lane); continue; } r -= I_S;
        tr_perm16(p.w_sd, EFF, DM, p.WT_SD, scr, r, lane);
    }
}
DEV void ph_prep_ed(const P& p, LAS float* scr, int gw, int ngw, int lane) {
    constexpr int IPE = 4 * 32;
    for (int it = gw; it < NE * IPE; it += ngw) { const int e = it / IPE;
        tr_perm16(p.w_ed + (size_t)e * EFF * DM, EFF, DM, p.WT_ED + (size_t)e * DM * EFF, scr, it % IPE, lane); }
}
DEV void ph_prep_egu(const P& p, LAS float* scr, int gw, int ngw, int lane) {
    constexpr int IPE = 16 * 16;
    for (int it = gw; it < NE * IPE; it += ngw) { const int e = it / IPE, r = it % IPE;
        tr_gu(p.w_eg + (size_t)e * DM * EFF, p.w_eu + (size_t)e * DM * EFF, DM, p.WT_EGU + (size_t)e * 512 * DM, scr, 64 * (r / 16), 32 * (r % 16), lane); }
}

constexpr int LDS_BYTES = 155648;
constexpr int LDS_OFF_TAB = 131072;
constexpr int LDS_GTAB = 131072 + 4096;
constexpr int MAXU = 16;
constexpr int LDS_MISC = LDS_GTAB + MAXU * 1024;

DEV void fill_gtab(const P& p, const mg::ExpertOrder& S, LAS unsigned* gtab) {
    const int tid_ = otid();
    for (int i = 0; i < MAXU; ++i) { int pm, pn, e; if (!S.tile_of(i, pm, pn, e)) break;
        if (tid_ < 256) { const int s = p.rowlist[pm * 256 + tid_]; gtab[i * 256 + tid_] = (unsigned)(s < 0 ? 0 : (s >> 3)) * (unsigned)(DM * 2); } }
    __syncthreads();
}

#define GAS __attribute__((address_space(1)))
#define XB_TMO      128
#define XB_XCNT(j)  (256  + 64 * (j))
#define XB_XSUB(j)  (1280 + 64 * (j))
#define XB_XGEN(j)  (2304 + 64 * (j))
#define XB_TOP      3328
#define XB_TOPGEN   3392
#define XCD_BAR_WORDS 3456
#define XB_SPIN_CAP (1u << 18)
DEV unsigned xb_ld(unsigned* p)              { return __hip_atomic_load(p, __ATOMIC_RELAXED, __HIP_MEMORY_SCOPE_AGENT); }
DEV unsigned xb_add(unsigned* p, unsigned v) { return __hip_atomic_fetch_add(p, v, __ATOMIC_RELAXED, __HIP_MEMORY_SCOPE_AGENT); }
DEV unsigned xb_xcc_id() { return (unsigned)__builtin_amdgcn_s_getreg((3 << 11) | 20) & 0xFu; }
#define XB_SPIN(cond, bar) do { unsigned _sp = 0; while (cond) { __builtin_amdgcn_s_sleep(1); \
    if ((++_sp & 255u) == 0u) { if (xb_ld(&(bar)[XB_TMO])) break; if (_sp > XB_SPIN_CAP) { atomicAdd(&(bar)[XB_TMO], 1u); break; } } } } while (0)
struct XcdBarrier { unsigned* bar; unsigned x; volatile LAS unsigned* st; };
DEV XcdBarrier xcd_barrier_post(unsigned* bar, volatile LAS unsigned* st) {
    XcdBarrier b; b.bar = bar; b.x = xb_xcc_id(); b.st = st;
    if (threadIdx.x == 0) (void)xb_add(&bar[XB_XCNT(b.x)], 1u);
    return b;
}
DEV void xcd_barrier_complete(unsigned* bar, unsigned x, unsigned& nloc, unsigned& nx) {
    const unsigned G = gridDim.x * gridDim.y * gridDim.z;
    unsigned sum, cnt, mine, sp = 0u;
    for (;;) {
        sum = 0u; cnt = 0u; mine = 0u;
#pragma unroll
        for (unsigned j = 0; j < 16; ++j) { const unsigned c = xb_ld(&bar[XB_XCNT(j)]); sum += c; cnt += (c > 0u) ? 1u : 0u; mine = (j == x) ? c : mine; }
        if (sum == G) break;
        __builtin_amdgcn_s_sleep(1);
        if ((++sp & 255u) == 0u) { if (xb_ld(&bar[XB_TMO])) break; if (sp > XB_SPIN_CAP) { atomicAdd(&bar[XB_TMO], 1u); break; } }
    }
    nloc = mine > 0u ? mine : 1u; nx = cnt > 0u ? cnt : 1u;
}
DEV void xcd_barrier(const XcdBarrier& b) {
    asm volatile("s_waitcnt vmcnt(0)" ::: "memory");
    __syncthreads();
    if (threadIdx.x == 0) {
        unsigned* bar = b.bar;
        __builtin_amdgcn_s_waitcnt(0);
        unsigned nloc = b.st[0], nx = b.st[1];
        if (nloc == 0u) { xcd_barrier_complete(bar, b.x, nloc, nx); b.st[0] = nloc; b.st[1] = nx; }
        const unsigned old = xb_add(&bar[XB_XSUB(b.x)], 1u);
        const unsigned gen = old / nloc;
        if (old + 1u == (gen + 1u) * nloc) {
            __builtin_amdgcn_fence(__ATOMIC_RELEASE, "agent");
            asm volatile("s_waitcnt vmcnt(0)" ::: "memory");
            const unsigned og = xb_add(&bar[XB_TOP], 1u);
            const unsigned tg = og / nx;
            if (og + 1u == (tg + 1u) * nx) xb_add(&bar[XB_TOPGEN], 1u);
            else XB_SPIN(xb_ld(&bar[XB_TOPGEN]) == tg, bar);
            __builtin_amdgcn_fence(__ATOMIC_ACQUIRE, "agent");
            xb_add(&bar[XB_XGEN(b.x)], 1u);
            asm volatile("s_waitcnt vmcnt(0)" ::: "memory");
        } else {
            XB_SPIN(xb_ld(&bar[XB_XGEN(b.x)]) == gen, bar);
            __builtin_amdgcn_fence(__ATOMIC_ACQUIRE, "agent");
            asm volatile("s_waitcnt vmcnt(0)" ::: "memory");
        }
    }
    __syncthreads();
}

#define STAMP() do { if (TPROBE >= 0) { if (bid == 0 && threadIdx.x == 0) p.ts[nst] = __builtin_amdgcn_s_memrealtime(); ++nst; } } while (0)
#define GSYNC_CG() do { cg::this_grid().sync(); STAMP(); } while (0)
#define GSYNC() do { xcd_barrier(xbar); STAMP(); } while (0)
__global__ void __launch_bounds__(NTHR, 2) fwd_all(P p) {
    extern __shared__ __attribute__((aligned(16))) unsigned char lds_raw[];
    LAS unsigned char* lds = (LAS unsigned char*)lds_raw;
    float* sm = (float*)lds_raw;
    int* off = (int*)(lds_raw + LDS_OFF_TAB);
    const LAS int* offl = (const LAS int*)(lds + LDS_OFF_TAB);
    LAS unsigned* gtab = (LAS unsigned*)(lds + LDS_GTAB);
    const int bid = blockIdx.x, nb = gridDim.x;
    const int tid_ = otid(); const int lane = tid_ & 63, wv = tid_ >> 6;
    LAS float* scr = (LAS float*)(lds + wv * 16384);
    const int gw = bid * NWV + wv, ngw = nb * NWV;
    volatile LAS unsigned* misc = (volatile LAS unsigned*)(lds + LDS_MISC);
    if (threadIdx.x < 2) misc[threadIdx.x] = 0u;
    __syncthreads();
    const XcdBarrier xbar = xcd_barrier_post(p.bar, misc);
    int nst = 0; STAMP();

    ph_mod(p, sm, bid, nb);
    __syncthreads();
    REPEAT(1) ph_prep_small(p, scr, gw, ngw, lane);
#if MF_EXP2
    REPEAT(2) ph_prep_ed(p, scr, gw, ngw, lane);
#endif
    GSYNC_CG();
    REPEAT(3) ph_norm(p.x, p.norm1_g, p.mod, 0, 1024, p.XB, bid, nb);
    GSYNC();
#if MF_INPROJ
    REPEAT(4) { mg::DenseOrder S; S.init(p.XB, p.WT_IN, T, INW, DM, nb, bid);
      mg::gemm_phase<mg::MEpiInProj, mg::DenseOrder, false>(lds, gtab, DM, S, mg::MEpiInProj{p.U, p.QKV, p.G}); }
#else
    ngemm_dense<false>(p.XB, DM, p.w_in, nullptr, INW, T, INW, DM, EpiInProj{p.U, p.QKV, p.G}, sm, bid, nb);
#endif
    GSYNC();
#if !MF_ATTN
    ph_qknorm(p, bid, nb);
#endif
    REPEAT(5) ph_pool(p, bid, nb);
#if !MF_ATTN
    GSYNC();
#endif
#if MF_ATTN
    REPEAT(6) ph_attn_mfma(p, lds, bid, nb);
    GSYNC();
    REPEAT(7) ph_attn_combine(p, bid, nb);
#else
    ph_attn(p, bid, nb);
#endif
#if !MF_MERGE
#pragma unroll 1
    for (int g = 0; g < 4; ++g) ngemm_dense<false>(p.PL + g * 128, 512, p.pool_w_grp + g * 128 * 128, nullptr, 128, T, 128, 128, EpiPoolGrp{p.Y, p.pool_scale, g}, sm, bid, nb);
#endif
    GSYNC();
#if MF_MERGE
    REPEAT(8) { mg::PairOrder S; S.D.init(p.PL, p.WT_EFF, T, DM, 768, nb, bid); S.kt0 = 8; S.kt1 = 4;
      mg::gemm_phase<mg::MEpiMergeF, mg::PairOrder, false>(lds, gtab, 768, S, mg::MEpiMergeF{p.XB, p.G}); }
#else
    ngemm_dense<false>(p.Y, 512, p.w_pool_up, nullptr, DM, T, DM, 512, EpiMergeA{p.XB, p.G}, sm, bid, nb);
    GSYNC();
    ngemm_dense<false>(p.O, 256, p.w_attn_up, nullptr, DM, T, DM, 256, EpiMergeB{p.XB, p.G}, sm, bid, nb);
#endif
    GSYNC();
#if MF_OUT
    REPEAT(9) { mg::DenseOrder S; S.init(p.XB, p.WT_OUT, T, DM, DM, nb, bid);
      mg::gemm_phase<mg::MEpiOutProj, mg::DenseOrder, false>(lds, gtab, DM, S, mg::MEpiOutProj{p.x, p.out, p.mod}); }
#else
    ngemm_dense<false>(p.XB, DM, p.w_out, nullptr, DM, T, DM, DM, EpiOutProj{p.x, p.out, p.mod}, sm, bid, nb);
#endif
    GSYNC();
    REPEAT(10) ph_norm(p.out, p.norm2_g, p.mod, 3072, 4096, p.XB, bid, nb);
#if MF_EXP1
    __syncthreads();
    REPEAT(11) ph_prep_egu(p, scr, gw, ngw, lane);
#endif
    GSYNC();
#if MF_ROUTER
    REPEAT(12) { mg::DenseOrder S; S.init(p.XB, p.WT_RS, T, 768, DM, nb, bid);
      mg::gemm_phase<mg::MEpiRouterShared, mg::DenseOrder, false>(lds, gtab, DM, S, mg::MEpiRouterShared{p.LG, p.HS}); }
#else
    ngemm_dense<false>(p.XB, DM, p.w_router, nullptr, NE, T, NE, DM, EpiLogits{p.LG}, sm, bid, nb);
#endif
    GSYNC();
    ph_route(p, (int*)lds_raw, bid, nb);
    GSYNC();
    ph_scatter(p, off, bid, nb);
    GSYNC();
#if MF_EXP1
    REPEAT(13) { load_offsets(p.cnt, off);
      mg::ExpertOrder S{offl, 2, nb, bid, (const char*)p.XB, (const char*)p.WT_EGU, (size_t)512 * DM * 2, (size_t)256 * DM * 2, 0, true};
      fill_gtab(p, S, gtab);
      mg::gemm_phase<mg::MEpiAct, mg::ExpertOrder, true>(lds, gtab, DM, S, mg::MEpiAct{p.ACT}); }
#else
    ph_expert1(p, sm, off, bid, nb);
#endif
    GSYNC();
#if MF_EXP2
    REPEAT(14) { load_offsets(p.cnt, off);
      mg::ExpertOrder S{offl, 4, nb, bid, (const char*)p.ACT, (const char*)p.WT_ED, (size_t)DM * EFF * 2, (size_t)256 * EFF * 2, (size_t)256 * EFF * 2, false};
      mg::gemm_phase<mg::MEpiSlab, mg::ExpertOrder, false>(lds, gtab, EFF, S, mg::MEpiSlab{(unsigned char*)p.SLAB, p.rowlist, p.roww}); }
#else
    ph_expert2(p, sm, off, bid, nb);
#endif
    GSYNC();
#if !MF_ROUTER
    ngemm_dense<true>(p.XB, DM, p.w_sg, p.w_su, EFF, T, EFF, DM, EpiAct{p.HS}, sm, bid, nb);
    GSYNC();
#endif
#if MF_FINAL
    { mg::DenseOrder S; S.init(p.HS, p.WT_SD, T, DM, EFF, nb, bid);
      mg::gemm_phase<mg::MEpiFinal, mg::DenseOrder, false>(lds, gtab, EFF, S, mg::MEpiFinal{p.out, (const unsigned char*)p.SLAB, p.mod}); }
#else
    ngemm_dense<false>(p.HS, EFF, p.w_sd, nullptr, DM, T, DM, EFF, EpiFinal{p.out, p.SLAB, p.mod}, sm, bid, nb);
#endif
#if TPROBE >= 0
    GSYNC();
    if (bid == 0 && threadIdx.x == 0) { const unsigned long long dt = p.ts[TPROBE + 1] - p.ts[TPROBE]; p.out[0] += (float)dt * 0.01f / TSCALE; }
#endif
}

extern "C" void kernel_launch(void* const* d_in, const int* in_sizes, int n_in, void* d_out, int out_size, void* d_ws, size_t ws_size, hipStream_t stream) {
    static int grid = 0;
    if (grid == 0) {
        int dev = 0, cus = 0;
        (void)hipGetDevice(&dev);
        (void)hipDeviceGetAttribute(&cus, hipDeviceAttributeMultiprocessorCount, dev);
        int per_cu = 0;
        (void)hipFuncSetAttribute((const void*)fwd_all, hipFuncAttributeMaxDynamicSharedMemorySize, LDS_BYTES);
        (void)hipOccupancyMaxActiveBlocksPerMultiprocessor(&per_cu, fwd_all, NTHR, LDS_BYTES);
        if (per_cu < 1) { fprintf(stderr, "kernel_launch: occupancy query says %d blocks/CU\n", per_cu); per_cu = 1; }
        if (per_cu > 1) per_cu = 1;
        grid = cus * per_cu;
        if (ws_size < WS_END) { fprintf(stderr, "kernel_launch: workspace too small (%zu < %zu)\n", ws_size, (size_t)WS_END); grid = -1; }
    }
    if (grid < 0) return;
    P p{};
    const float* const* in = (const float* const*)d_in;
    p.x = in[0]; p.c = in[1]; p.pos = (const int*)d_in[2];
    p.w_ada = in[3]; p.b_ada = in[4]; p.norm1_g = in[5]; p.w_in = in[6]; p.pool_w_grp = in[7]; p.pool_scale = in[8]; p.q_norm_g = in[9]; p.k_norm_g = in[10];
    p.w_pool_up = in[11]; p.w_attn_up = in[12]; p.w_out = in[13]; p.norm2_g = in[14]; p.w_router = in[15]; p.router_bias = in[16];
    p.w_sg = in[17]; p.w_su = in[18]; p.w_sd = in[19]; p.w_eg = in[20]; p.w_eu = in[21]; p.w_ed = in[22];
    p.out = (float*)d_out;
    char* ws = (char*)d_ws;
    p.mod = (float*)(ws + WS_MOD); p.cnt = (int*)(ws + WS_CNT); p.asg_e = (int*)(ws + WS_ASG_E); p.asg_pos = (int*)(ws + WS_ASG_POS);
    p.asg_w = (float*)(ws + WS_ASG_W); p.rowlist = (int*)(ws + WS_ROWLIST);
    p.XB = (bf16_t*)(ws + WS_XB); p.U = (bf16_t*)(ws + WS_U); p.QKV = (bf16_t*)(ws + WS_QKV); p.G = (bf16_t*)(ws + WS_G); p.PL = (bf16_t*)(ws + WS_PL);
    p.Y = (bf16_t*)(ws + WS_Y); p.O = (bf16_t*)(ws + WS_O); p.ACT = (bf16_t*)(ws + WS_ACT); p.SLAB = (bf16_t*)(ws + WS_SLAB); p.HS = (bf16_t*)(ws + WS_HS);
    p.LG = (float*)(ws + WS_ACT);
    p.roww = (float*)(ws + WS_ROWW);
    p.bar = (unsigned*)(ws + WS_BAR); p.ts = (unsigned long long*)(ws + WS_TS);
    p.OG = (bf16_t*)(ws + WS_OG); p.LSUM = (float*)(ws + WS_LSUM);
    p.WT_IN = (bf16_t*)(ws + WS_WT_IN); p.WT_EFF = (bf16_t*)(ws + WS_WT_EFF); p.WT_AU = (bf16_t*)(ws + WS_WT_AU); p.WT_OUT = (bf16_t*)(ws + WS_WT_OUT);
    p.WT_RS = (bf16_t*)(ws + WS_WT_RS); p.WT_SD = (bf16_t*)(ws + WS_WT_SD); p.WT_EGU = (bf16_t*)(ws + WS_WT_EGU); p.WT_ED = (bf16_t*)(ws + WS_WT_ED);
    (void)hipMemsetAsync(ws + WS_BAR, 0, WS_ZERO_BYTES, stream);
    void* args[] = {&p};
    hipError_t e = hipLaunchCooperativeKernel((void*)fwd_all, dim3(grid), dim3(NTHR), args, LDS_BYTES, stream);
    if (e != hipSuccess) fprintf(stderr, "cooperative launch failed: %s (grid %d)\n", hipGetErrorString(e), grid);
}
```

```cpp
#include <hip/hip_runtime.h>
#include <hip/hip_cooperative_groups.h>
#include <stdint.h>
#include <cstdio>
namespace cg = cooperative_groups;

#ifndef ONE_LAUNCH
#define ONE_LAUNCH 0
#endif

typedef unsigned short bf16_t;
#define DEV __device__ __forceinline__
#define LAS __attribute__((address_space(3)))
typedef short bf16x8 __attribute__((ext_vector_type(8)));
typedef float f32x4 __attribute__((ext_vector_type(4)));
typedef unsigned u32x4 __attribute__((ext_vector_type(4)));
typedef unsigned u32x2 __attribute__((ext_vector_type(2)));

#ifndef MF_INPROJ
#define MF_INPROJ 1
#endif
#ifndef MF_MERGE
#define MF_MERGE 1
#endif
#ifndef MF_OUT
#define MF_OUT 1
#endif
#ifndef MF_ROUTER
#define MF_ROUTER 1
#endif
#ifndef MF_EXP1
#define MF_EXP1 1
#endif
#ifndef MF_EXP2
#define MF_EXP2 1
#endif
#ifndef MF_ATTN
#define MF_ATTN 1
#endif
#ifndef DUP
#define DUP 0
#endif
#ifndef TPROBE
#define TPROBE -1
#endif
#ifndef TSCALE
#define TSCALE 10.0f
#endif
#define REPEAT(n) _Pragma("unroll 1") for (int rep_ = 0; rep_ < ((DUP == (n)) ? 2 : 1); ++rep_)
#ifndef MF_FINAL
#define MF_FINAL 1
#endif

constexpr int NB = 16, SEQ = 2048, DM = 1024, T = NB * SEQ;
constexpr int INW = 4864, NMOD = 6144;
constexpr int NE = 256, EFF = 256;
constexpr int NTHR = 512, NWV = 8;
constexpr int NSLOT = T * 8;
constexpr int RMAX = NSLOT + NE * 256;

DEV float bf2f(bf16_t h) { return __uint_as_float(((unsigned)h) << 16); }
DEV bf16_t f2bf(float f) { unsigned u = __float_as_uint(f); u += 0x7fffu + ((u >> 16) & 1u); return (bf16_t)(u >> 16); }
DEV unsigned pk2(float lo, float hi) { return (unsigned)f2bf(lo) | ((unsigned)f2bf(hi) << 16); }
DEV float sigm(float v) { return 1.f / (1.f + __expf(-v)); }
DEV float silu(float v) { return v / (1.f + __expf(-v)); }
DEV int otid() { int t = threadIdx.x; asm volatile("" : "+v"(t)); return t; }
DEV float wave_sum(float v) {
#pragma unroll
    for (int o = 32; o >= 1; o >>= 1) v += __shfl_xor(v, o);
    return v;
}

struct P {
    const float *x, *c; const int* pos;
    const float *w_ada, *b_ada, *norm1_g, *w_in, *pool_w_grp, *pool_scale, *q_norm_g, *k_norm_g, *w_pool_up, *w_attn_up, *w_out, *norm2_g,
        *w_router, *router_bias, *w_sg, *w_su, *w_sd, *w_eg, *w_eu, *w_ed;
    float* out;
    float* mod; int* cnt; int* asg_e; int* asg_pos; float* asg_w; int* rowlist;
    bf16_t *XB, *U, *QKV, *G, *PL, *Y, *O, *ACT, *SLAB, *HS;
    float* LG;
    bf16_t* OG; float* LSUM; unsigned* bar; unsigned long long* ts; float* roww;
    bf16_t *WT_IN, *WT_EFF, *WT_AU, *WT_OUT, *WT_RS, *WT_SD, *WT_EGU, *WT_ED;
};

constexpr size_t MiB = 1u << 20;
constexpr size_t WS_BAR = 640 * 1024, WS_BAR_BYTES = 16384, WS_ZERO_BYTES = 16384 + 65536;
constexpr size_t WS_TS = 800 * 1024;
constexpr size_t WS_MOD = 0, WS_CNT = WS_BAR + WS_BAR_BYTES, WS_ASG_E = 1 * MiB, WS_ASG_POS = 2 * MiB, WS_ASG_W = 3 * MiB, WS_ROWLIST = 4 * MiB, WS_ROWW = 6 * MiB;
constexpr size_t WS_XB = 8 * MiB;
constexpr size_t WS_ACT = 72 * MiB;
constexpr size_t WS_SLAB = 232 * MiB;
constexpr size_t WS_U = 232 * MiB, WS_QKV = 264 * MiB, WS_G = 408 * MiB, WS_PL = 536 * MiB, WS_Y = 568 * MiB, WS_O = 600 * MiB;
constexpr size_t WS_WT_IN = 744 * MiB, WS_WT_EFF = 754 * MiB, WS_WT_AU = 755 * MiB, WS_WT_OUT = 756 * MiB, WS_WT_RS = 758 * MiB, WS_WT_SD = 760 * MiB;
constexpr size_t WS_WT_ED = 762 * MiB;
constexpr size_t WS_WT_EGU = 232 * MiB;
constexpr size_t WS_OG = 616 * MiB, WS_LSUM = 664 * MiB;
constexpr size_t WS_HS = 890 * MiB;
constexpr size_t WS_END = 906 * MiB;

DEV void ph_mod(const P& p, float* sm, int bid, int nb) {
    const int tid_ = otid(); const int lane = tid_ & 63, wv = tid_ >> 6;
    for (int it = bid; it < 96; it += nb) {
        const int k0 = wv * 128, e = it * 64 + lane;
        float acc[16];
#pragma unroll
        for (int b = 0; b < 16; ++b) acc[b] = 0.f;
#pragma unroll 1
        for (int kh = 0; kh < 2; ++kh) {
            float sc[16];
#pragma unroll
            for (int b = 0; b < 16; ++b) sc[b] = silu(p.c[b * DM + k0 + kh * 64 + lane]);
            const float* wp = p.w_ada + (size_t)(k0 + kh * 64) * NMOD + e;
#pragma unroll 8
            for (int kk = 0; kk < 64; ++kk) { const float w = wp[(size_t)kk * NMOD];
#pragma unroll
                for (int b = 0; b < 16; ++b) acc[b] += __uint_as_float(__builtin_amdgcn_readlane(__float_as_uint(sc[b]), kk)) * w; }
        }
        __syncthreads();
#pragma unroll
        for (int b = 0; b < 16; ++b) sm[(wv * 16 + b) * 64 + lane] = acc[b];
        __syncthreads();
#pragma unroll
        for (int j = 0; j < 2; ++j) { const int idx = tid_ + j * NTHR, b = idx >> 6, col = idx & 63; float s = p.b_ada[it * 64 + col];
#pragma unroll
            for (int w = 0; w < 8; ++w) s += sm[(w * 16 + b) * 64 + col];
            p.mod[b * NMOD + it * 64 + col] = s; }
    }
}

DEV void ph_norm(const float* src, const float* g, const float* mod, int shift_off, int scale_off, bf16_t* dst, int bid, int nb) {
    const int tid_ = otid(); const int lane = tid_ & 63, wv = tid_ >> 6;
    for (int row0 = (bid * NWV + wv) * 2; row0 < T; row0 += nb * NWV * 2) {
        float4 v[2][4]; float ss[2] = {0.f, 0.f};
#pragma unroll
        for (int q = 0; q < 2; ++q) { const float4* xr = (const float4*)(src + (size_t)(row0 + q) * DM);
#pragma unroll
            for (int j = 0; j < 4; ++j) v[q][j] = xr[lane + 64 * j]; }
#pragma unroll
        for (int q = 0; q < 2; ++q)
#pragma unroll
            for (int j = 0; j < 4; ++j) ss[q] += v[q][j].x * v[q][j].x + v[q][j].y * v[q][j].y + v[q][j].z * v[q][j].z + v[q][j].w * v[q][j].w;
        const int b = row0 / SEQ;
#pragma unroll
        for (int q = 0; q < 2; ++q) {
            const float r = rsqrtf(wave_sum(ss[q]) * (1.f / DM) + 1e-6f);
#pragma unroll
            for (int j = 0; j < 4; ++j) {
                const int col = (lane + 64 * j) * 4;
                const float4 g4 = *(const float4*)(g + col);
                const float4 sc = *(const float4*)(mod + b * NMOD + scale_off + col);
                const float4 sh = *(const float4*)(mod + b * NMOD + shift_off + col);
                const float o0 = v[q][j].x * r * g4.x * (1.f + sc.x) + sh.x, o1 = v[q][j].y * r * g4.y * (1.f + sc.y) + sh.y;
                const float o2 = v[q][j].z * r * g4.z * (1.f + sc.z) + sh.z, o3 = v[q][j].w * r * g4.w * (1.f + sc.w) + sh.w;
                uint2 w; w.x = pk2(o0, o1); w.y = pk2(o2, o3);
                *(uint2*)(dst + (size_t)(row0 + q) * DM + col) = w;
            }
        }
    }
}

template <bool DUAL, class RowF, class Epi>
DEV void ngemm_tile(const bf16_t* __restrict__ A, int lda, RowF rowf, const float* __restrict__ B, const float* __restrict__ B2, int ldb,
                    int m0, int n0, int K, Epi epi, float* sm) {
    float* As = sm;
    float* Bs = sm + 16 * 132;
    float* Bs2 = Bs + 16 * 64;
    const int tid = otid(), tm = tid >> 4, tn = tid & 15;
    float acc[4][4], acc2[4][4];
#pragma unroll
    for (int i = 0; i < 4; ++i)
#pragma unroll
        for (int j = 0; j < 4; ++j) { acc[i][j] = 0.f; acc2[i][j] = 0.f; }
    const int ar = tid >> 2, ak = (tid & 3) * 4;
    const int arow = rowf(m0 + ar);
    const bf16_t* ap = A + (size_t)(arow < 0 ? 0 : arow) * lda + ak;
    const int bk = tid >> 5, bn = (tid & 31) * 2;
    for (int k0 = 0; k0 < K; k0 += 16) {
        uint2 av = make_uint2(0u, 0u);
        if (arow >= 0) av = *(const uint2*)(ap + k0);
        const float2 bv = *(const float2*)(B + (size_t)(k0 + bk) * ldb + n0 + bn);
        float2 bv2 = make_float2(0.f, 0.f);
        if (DUAL) bv2 = *(const float2*)(B2 + (size_t)(k0 + bk) * ldb + n0 + bn);
        __syncthreads();
        As[(ak + 0) * 132 + ar] = __uint_as_float(av.x << 16);
        As[(ak + 1) * 132 + ar] = __uint_as_float(av.x & 0xffff0000u);
        As[(ak + 2) * 132 + ar] = __uint_as_float(av.y << 16);
        As[(ak + 3) * 132 + ar] = __uint_as_float(av.y & 0xffff0000u);
        Bs[bk * 64 + bn] = bv.x; Bs[bk * 64 + bn + 1] = bv.y;
        if (DUAL) { Bs2[bk * 64 + bn] = bv2.x; Bs2[bk * 64 + bn + 1] = bv2.y; }
        __syncthreads();
#pragma unroll
        for (int kk = 0; kk < 16; ++kk) {
            const float4 a = *(const float4*)&As[kk * 132 + tm * 4];
            const float4 b = *(const float4*)&Bs[kk * 64 + tn * 4];
            const float aa[4] = {a.x, a.y, a.z, a.w}, bb[4] = {b.x, b.y, b.z, b.w};
#pragma unroll
            for (int i = 0; i < 4; ++i)
#pragma unroll
                for (int j = 0; j < 4; ++j) acc[i][j] += aa[i] * bb[j];
            if (DUAL) {
                const float4 b2 = *(const float4*)&Bs2[kk * 64 + tn * 4];
                const float cc[4] = {b2.x, b2.y, b2.z, b2.w};
#pragma unroll
                for (int i = 0; i < 4; ++i)
#pragma unroll
                    for (int j = 0; j < 4; ++j) acc2[i][j] += aa[i] * cc[j];
            }
        }
    }
#pragma unroll
    for (int i = 0; i < 4; ++i)
#pragma unroll
        for (int j = 0; j < 4; ++j) epi(m0 + tm * 4 + i, n0 + tn * 4 + j, acc[i][j], acc2[i][j]);
}

struct RowId { DEV int operator()(int m) const { return m; } };
struct RowTok { const int* rl; DEV int operator()(int m) const { const int s = rl[m]; return s < 0 ? -1 : (s >> 3); } };

template <bool DUAL, class Epi>
DEV void ngemm_dense(const bf16_t* A, int lda, const float* B, const float* B2, int ldb, int M, int N, int K, Epi epi, float* sm, int bid, int nb) {
    const int tn = N / 64, nt = (M / 128) * tn;
    for (int t = bid; t < nt; t += nb) ngemm_tile<DUAL>(A, lda, RowId(), B, B2, ldb, (t / tn) * 128, (t % tn) * 64, K, epi, sm);
}

struct EpiInProj { bf16_t *U, *QKV, *G;
    DEV void operator()(int r, int c, float v, float) const {
        if (c < 512) U[(size_t)r * 512 + c] = f2bf(v);
        else if (c < 2816) QKV[(size_t)r * 2304 + (c - 512)] = f2bf(v);
        else G[(size_t)r * 2048 + (c - 2816)] = f2bf(sigm(v)); } };
struct EpiPoolGrp { bf16_t* Y; const float* ls; int g;
    DEV void operator()(int r, int c, float v, float) const { Y[(size_t)r * 512 + g * 128 + c] = f2bf(v * ls[g * 128 + c]); } };
struct EpiMergeA { bf16_t* MG; const bf16_t* G;
    DEV void operator()(int r, int c, float v, float) const { MG[(size_t)r * DM + c] = f2bf(bf2f(G[(size_t)r * 2048 + c]) * v); } };
struct EpiMergeB { bf16_t* MG; const bf16_t* G;
    DEV void operator()(int r, int c, float v, float) const { const size_t i = (size_t)r * DM + c; MG[i] = f2bf(bf2f(MG[i]) + bf2f(G[(size_t)r * 2048 + 1024 + c]) * v); } };
struct EpiOutProj { const float* x; float* out; const float* mod;
    DEV void operator()(int r, int c, float v, float) const { const size_t i = (size_t)r * DM + c; out[i] = x[i] + mod[(r / SEQ) * NMOD + 2048 + c] * v; } };
struct EpiLogits { float* LG;
    DEV void operator()(int r, int c, float v, float) const { LG[(size_t)r * NE + c] = v; } };
struct EpiAct { bf16_t* ACT;
    DEV void operator()(int r, int c, float v, float v2) const { ACT[(size_t)r * EFF + c] = f2bf(silu(v) * v2); } };
struct EpiSlab { bf16_t* SLAB; const int* rl; const float* w;
    DEV void operator()(int r, int c, float v, float) const { const int s = rl[r]; if (s >= 0) SLAB[(size_t)s * DM + c] = f2bf(v * w[s]); } };
struct EpiFinal { float* out; const bf16_t* SLAB; const float* mod;
    DEV void operator()(int r, int c, float v, float) const {
        float s = v;
#pragma unroll
        for (int k = 0; k < 8; ++k) s += bf2f(SLAB[((size_t)r * 8 + k) * DM + c]);
        const size_t i = (size_t)r * DM + c; out[i] = out[i] + mod[(r / SEQ) * NMOD + 5120 + c] * s; } };

DEV void ph_qknorm(const P& p, int bid, int nb) {
    const int tid_ = otid(); const int lane = tid_ & 63, wv = tid_ >> 6;
    const float gq = p.q_norm_g[lane], gk = p.k_norm_g[lane];
    const float invf = exp2f(-(float)(lane & 7) * (1.f / 8.f) * log2f(500000.f));
    for (int t = bid * NWV + wv; t < T; t += nb * NWV) {
        const float ang = (float)p.pos[t] * invf;
        const float cs = cosf(ang), sn = sinf(ang);
        bf16_t* ptr = p.QKV + (size_t)t * 2304 + lane;
        float v[24];
#pragma unroll
        for (int hh = 0; hh < 24; ++hh) v[hh] = bf2f(ptr[hh * 64]);
#pragma unroll
        for (int hh = 0; hh < 24; ++hh) {
            const float ss = wave_sum(v[hh] * v[hh]);
            float nv = v[hh] * rsqrtf(ss * (1.f / 64.f) + 1e-6f) * (hh < 12 ? gq : gk);
            const float partner = __shfl_xor(nv, 8);
            if (lane < 8) nv = nv * cs - partner * sn;
            else if (lane < 16) nv = nv * cs + partner * sn;
            ptr[hh * 64] = f2bf(nv);
        }
    }
}

template <int R>
DEV void pool_chunk(const unsigned* up, unsigned* op, int s0) {
    constexpr int W = 32 + 2 * R;
    float w0[W], w1[W];
#pragma unroll
    for (int i = 0; i < W; ++i) { const int q = s0 - R + i; const bool ok = (q >= 0) && (q < SEQ); const unsigned w = up[(size_t)min(max(q, 0), SEQ - 1) * 256];
        w0[i] = ok ? __uint_as_float(w << 16) : 0.f; w1[i] = ok ? __uint_as_float(w & 0xffff0000u) : 0.f; }
    float a0 = 0.f, a1 = 0.f;
#pragma unroll
    for (int i = 0; i < 2 * R + 1; ++i) { a0 += w0[i]; a1 += w1[i]; }
#pragma unroll
    for (int j = 0; j < 32; ++j) {
        const int s = s0 + j;
        const int lo = max(s - R, 0), hi = min(s + R, SEQ - 1);
        const float inv = 1.f / (float)(hi - lo + 1);
        op[(size_t)s * 384] = pk2(a0 * inv - w0[j + R], a1 * inv - w1[j + R]);
        if (j < 31) { a0 += w0[j + 2 * R + 1] - w0[j]; a1 += w1[j + 2 * R + 1] - w1[j]; }
    }
}
DEV void ph_pool(const P& p, int bid, int nb) {
    const int tid_ = otid();
    for (int i = bid * NTHR + tid_; i < NB * 64 * 256; i += nb * NTHR) {
        const int cp = i & 255, chunk = (i >> 8) & 63, b = i >> 14;
        const int g = cp >> 6;
        const unsigned* up = (const unsigned*)(p.U + (size_t)b * SEQ * 512) + cp;
        unsigned* op = (unsigned*)(p.PL + (size_t)b * SEQ * 768) + cp;
        const int s0 = chunk * 32;
        if (g == 0) pool_chunk<1>(up, op, s0); else if (g == 1) pool_chunk<2>(up, op, s0); else if (g == 2) pool_chunk<4>(up, op, s0); else pool_chunk<8>(up, op, s0);
    }
}

DEV void ph_attn(const P& p, int bid, int nb) {
    const int tid_ = otid(); const int lane = tid_ & 63, wv = tid_ >> 6;
    for (int it = bid * NWV + wv; it < T * 4; it += nb * NWV) {
        const int t = it >> 2, slot = it & 3;
        const int s = t & (SEQ - 1), base = t - s;
        float M = -1e30f, l = 0.f, acc = 0.f;
#pragma unroll
        for (int g = 0; g < 3; ++g) {
            const int dsh = 2 * g, d = 1 << dsh, L = SEQ >> dsh;
            const int h = 4 * g + slot;
            const int m = s >> dsh, r = s & (d - 1);
            const float q = bf2f(p.QKV[(size_t)t * 2304 + h * 64 + lane]);
            const bf16_t* kb = p.QKV + 768 + h * 64 + lane;
            const bf16_t* vb = p.QKV + 1536 + h * 64 + lane;
#pragma unroll 4
            for (int rel = -64; rel <= 64; ++rel) {
                const int mm = m + rel;
                const bool valid = (mm >= 0) && (mm < L);
                const int mc = valid ? mm : m;
                const size_t tr = (size_t)(base + mc * d + r) * 2304;
                const float kv = bf2f(kb[tr]), vv = bf2f(vb[tr]);
                const float sc = wave_sum(q * kv) * 0.125f;
                if (valid) {
                    const float mn = fmaxf(M, sc);
                    const float f = __expf(M - mn), pe = __expf(sc - mn);
                    l = l * f + pe; acc = acc * f + pe * vv; M = mn;
                }
            }
        }
        p.O[(size_t)t * 256 + slot * 64 + lane] = f2bf(acc / l);
    }
}

DEV void ph_route(const P& p, int* hist, int bid, int nb) {
    const int tid_ = otid(); const int lane = tid_ & 63, wv = tid_ >> 6;
    const int G = lane & 7, tl = lane >> 3;
    float bias[32];
#pragma unroll
    for (int j = 0; j < 8; ++j) { const float4 b4 = *(const float4*)(p.router_bias + G * 32 + 4 * j); bias[4 * j] = b4.x; bias[4 * j + 1] = b4.y; bias[4 * j + 2] = b4.z; bias[4 * j + 3] = b4.w; }
    for (int t0 = (bid * NWV + wv) * 8; t0 < T; t0 += nb * NWV * 8) {
        const int t = t0 + tl;
        float sc[32], v[32];
#pragma unroll
        for (int j = 0; j < 8; ++j) { const float4 lg = *(const float4*)(p.LG + (size_t)t * NE + G * 32 + 4 * j);
            sc[4 * j] = 1.f / (1.f + expf(-lg.x)); sc[4 * j + 1] = 1.f / (1.f + expf(-lg.y)); sc[4 * j + 2] = 1.f / (1.f + expf(-lg.z)); sc[4 * j + 3] = 1.f / (1.f + expf(-lg.w)); }
        float m1 = -INFINITY, m2 = -INFINITY;
#pragma unroll
        for (int j = 0; j < 32; ++j) { v[j] = sc[j] + bias[j]; const float n1 = fmaxf(m1, v[j]), n2 = fmaxf(fminf(m1, v[j]), m2); m1 = n1; m2 = n2; }
        const float gs = m1 + m2;
        int rank = 0;
#pragma unroll
        for (int g2 = 0; g2 < 8; ++g2) { const float o = __shfl(gs, (lane & 56) + g2); rank += ((o > gs) || (o == gs && g2 < G)) ? 1 : 0; }
        const bool gsel = rank < 4;
        int myidx = 0; float myw = 0.f, wsum = 0.f;
#pragma unroll 1
        for (int k = 0; k < 8; ++k) {
            float bv = -INFINITY, bs = 0.f; int bi = 0;
#pragma unroll
            for (int j = 0; j < 32; ++j) { const bool tk = gsel && (v[j] > bv); bv = tk ? v[j] : bv; bs = tk ? sc[j] : bs; bi = tk ? j : bi; }
            int gi = G * 32 + bi;
#pragma unroll
            for (int o = 1; o < 8; o <<= 1) {
                const float ov = __shfl_xor(bv, o), os = __shfl_xor(bs, o); const int oi = __shfl_xor(gi, o);
                if ((ov > bv) || (ov == bv && oi < gi)) { bv = ov; gi = oi; bs = os; }
            }
            const int wj = (gi >> 5) == G ? (gi & 31) : -1;
#pragma unroll
            for (int j = 0; j < 32; ++j) v[j] = (j == wj) ? -INFINITY : v[j];
            if (G == k) { myidx = gi; myw = bs; }
            wsum += bs;
        }
        __syncthreads();
        if (tid_ < NE) hist[tid_] = 0;
        __syncthreads();
        const int lpos = atomicAdd(&hist[myidx], 1);
        __syncthreads();
        if (tid_ < NE) { const int c_ = hist[tid_]; hist[NE + tid_] = c_ ? atomicAdd(&p.cnt[tid_ * 64], c_) : 0; }
        __syncthreads();
        const int slot = t * 8 + G;
        p.asg_e[slot] = myidx; p.asg_pos[slot] = hist[NE + myidx] + lpos; p.asg_w[slot] = myw / wsum * 2.5f;
    }
}

DEV void load_offsets(const int* cnt, int* off) {
    const int tid = otid();
    __syncthreads();
    if (tid < NE) { const int c_ = cnt[tid * 64]; off[300 + tid] = (c_ + 255) & ~255; off[600 + tid] = c_; }
    __syncthreads();
    if (tid == 0) { int a = 0; for (int e = 0; e < NE; ++e) { off[e] = a; a += off[300 + e]; } off[NE] = a;
        const int x = blockIdx.x & 7; int tf = 0, th = 0;
        for (int j = 0; j < 32; ++j) { const int n_ = off[600 + x + 8 * j], nt_ = (n_ + 255) >> 8, hh = (nt_ > 0 && n_ - (nt_ - 1) * 256 <= 128) ? 1 : 0;
            off[860 + j] = tf; off[900 + j] = th; tf += nt_ - hh; th += hh; }
        off[860 + 32] = tf; off[900 + 32] = th; }
    __syncthreads();
}
DEV int find_expert(const int* off, int m0) {
    int lo = 0, hi = NE;
    while (hi - lo > 1) { const int mid = (lo + hi) >> 1; if (off[mid] <= m0) lo = mid; else hi = mid; }
    return lo;
}

DEV void ph_scatter(const P& p, int* off, int bid, int nb) {
    load_offsets(p.cnt, off);
    const int tid_ = otid();
    for (int slot = bid * NTHR + tid_; slot < NSLOT; slot += nb * NTHR) { const int r = off[p.asg_e[slot]] + p.asg_pos[slot]; p.rowlist[r] = slot; p.roww[r] = p.asg_w[slot]; }
    for (int e = bid; e < NE; e += nb) {
        const int n = p.cnt[e * 64], pd = (n + 255) & ~255;
        for (int i = n + tid_; i < pd; i += NTHR) { p.rowlist[off[e] + i] = -1; p.roww[off[e] + i] = 0.f; }
    }
}

DEV void ph_expert1(const P& p, float* sm, int* off, int bid, int nb) {
    load_offsets(p.cnt, off);
    const int nrt = off[NE] / 128, nt = nrt * 4;
    for (int t = bid; t < nt; t += nb) {
        const int m0 = (t >> 2) * 128, n0 = (t & 3) * 64, e = find_expert(off, m0);
        ngemm_tile<true>(p.XB, DM, RowTok{p.rowlist}, p.w_eg + (size_t)e * DM * EFF, p.w_eu + (size_t)e * DM * EFF, EFF, m0, n0, DM, EpiAct{p.ACT}, sm);
    }
}
DEV void ph_expert2(const P& p, float* sm, int* off, int bid, int nb) {
    load_offsets(p.cnt, off);
    const int nrt = off[NE] / 128, nt = nrt * 16;
    for (int t = bid; t < nt; t += nb) {
        const int m0 = (t >> 4) * 128, n0 = (t & 15) * 64, e = find_expert(off, m0);
        ngemm_tile<false>(p.ACT, EFF, RowId(), p.w_ed + (size_t)e * EFF * DM, nullptr, DM, m0, n0, EFF, EpiSlab{p.SLAB, p.rowlist, p.asg_w}, sm);
    }
}

namespace mg {
constexpr int BM = 256, BK = 64, HALF = 128, HTB = HALF * BK * 2, STAGE_BYTES = 8 * HTB, NXCD = 8, WGM = 8;
__host__ __device__ __forceinline__ int lds_byte(int r, int c) { const int st = (r >> 4) * 2 + (c >> 5), rr = r & 15, cc = c & 31, ob = rr * 64 + cc * 2; return st * 1024 + (ob ^ (((ob >> 9) & 1) << 5)); }
__host__ __device__ __forceinline__ void stage_rc(int b, int& R, int& C) { const int st = b / 1024, sb = b % 1024, swz = sb ^ (((sb >> 9) & 1) << 5); R = (st >> 1) * 16 + swz / 64; C = (st & 1) * 32 + (swz % 64) / 2; }
__host__ __device__ __forceinline__ int perm32(int rho) { const int n = rho >> 4, i = rho & 15; return 8 * (i >> 2) + 4 * n + (i & 3); }

struct Unit { int pm, pn, e, pad, half, pad2; const char* A; const char* B; };

struct DenseOrder { static constexpr bool HAS_HALF = false;
    int nM, nN, nwg, G, c; const char* A; const char* B; size_t tstep;
    DEV void init(const bf16_t* A_, const bf16_t* B_, int M, int N, int K, int G_, int c_) { nM = M / BM; nN = N / BM; nwg = nM * nN; G = G_; c = c_; A = (const char*)A_; B = (const char*)B_; tstep = (size_t)BM * K * 2; }
    DEV bool next(int i, Unit& u) const {
        const long L = (long)i * G + c; if (L >= nwg) return false;
        int wgid = (int)L; { const int q = nwg / NXCD, r = nwg % NXCD, xcd = wgid % NXCD, off = wgid / NXCD; wgid = (xcd < r ? xcd * (q + 1) : r * (q + 1) + (xcd - r) * q) + off; }
        const int nig = WGM * nN, gid = wgid / nig, fm = gid * WGM, gsz = (nM - fm) < WGM ? (nM - fm) : WGM;
        u.pm = fm + ((wgid % nig) % gsz); u.pn = (wgid % nig) / gsz; u.e = 0; u.pad = 0; u.half = 0; u.pad2 = 0;
        u.A = A + (size_t)u.pm * tstep; u.B = B + (size_t)u.pn * tstep; return true;
    }
};
struct PairOrder { static constexpr bool HAS_HALF = false; DenseOrder D; int kt0, kt1;
    DEV bool next(int i, Unit& u) const { if (!D.next(i >> 1, u)) return false; const int part = i & 1; u.e = part; u.pad = part ? kt1 : kt0;
        if (part) { u.A += (size_t)kt0 * 128; u.B += (size_t)kt0 * 128; } return true; }
};
struct ExpertOrder { static constexpr bool HAS_HALF = true;
    const LAS int* off; int ncol, G, c; const char* A; const char* W; size_t wstride, tstepB, tstepA; bool gather;
    DEV bool tile_of(int i, int& pm, int& pn, int& e) const {
        const int x = c & 7, cl = c >> 3, nbx = G >> 3;
        const int Lx = i * nbx + cl; int tx = Lx / ncol; pn = Lx % ncol;
        const int ftot = __builtin_amdgcn_readfirstlane(off[860 + 32]), htot = __builtin_amdgcn_readfirstlane(off[900 + 32]);
        if (tx >= ftot + htot) return false;
        const bool isf = tx < ftot; const int tb = isf ? 860 : 900; if (!isf) tx -= ftot;
        int lo = 0, hi = 32;
        while (hi - lo > 1) { const int mid = (lo + hi) >> 1; const int ov = __builtin_amdgcn_readfirstlane(off[tb + mid]); if (ov <= tx) lo = mid; else hi = mid; }
        e = x + 8 * lo;
        const int nfull = __builtin_amdgcn_readfirstlane(off[860 + lo + 1]) - __builtin_amdgcn_readfirstlane(off[860 + lo]);
        pm = (__builtin_amdgcn_readfirstlane(off[e]) >> 8) + (isf ? (tx - __builtin_amdgcn_readfirstlane(off[860 + lo])) : nfull);
        return true;
    }
    DEV bool next(int i, Unit& u) const {
        int pm, pn, e; if (!tile_of(i, pm, pn, e)) return false;
        u.pm = pm; u.pn = pn; u.e = e; u.pad = 0; u.pad2 = 0;
        u.half = (__builtin_amdgcn_readfirstlane(off[600 + e]) - (pm * BM - __builtin_amdgcn_readfirstlane(off[e])) <= HALF) ? 1 : 0;
        u.A = gather ? A : A + (size_t)pm * tstepA; u.B = W + (size_t)e * wstride + (size_t)pn * tstepB; return true;
    }
};

template <class Epi, class Sched, bool GATHER>
DEV void gemm_phase(LAS unsigned char* lds, const LAS unsigned* gtab, const int K, const Sched& S, const Epi& E) {
    const int tid = otid(), wid = __builtin_amdgcn_readfirstlane(tid >> 6), lane = tid & 63, wr = wid >> 2, wc = wid & 3, fr = lane & 15, fq = lane >> 4;
    const int nt = K / BK;
    int Rr[2], Cc[2]; unsigned voffB[2];
#pragma unroll
    for (int i = 0; i < 2; ++i) { stage_rc(tid * 16 + i * 8192, Rr[i], Cc[i]); const int Rb = Epi::PERM ? ((Rr[i] & ~31) + perm32(Rr[i] & 31)) : Rr[i]; voffB[i] = (unsigned)(Rb * K + Cc[i]) * 2u; }
    const size_t kstep = (size_t)(BK * 2);
    const size_t hstep = (size_t)HALF * K * 2;
    const unsigned ldsw = (unsigned)wid * 1024u;
    const int aoff = lds_byte(wr * 64 + fr, fq * 8), boff = lds_byte(wc * 32 + fr, fq * 8);
#define MG_SA(b, h) (((b) * 2 + (h)) * HTB)
#define MG_SB(b, h) ((4 + (b) * 2 + (h)) * HTB)
#define MG_STAGE(bufoff, gbase, voff) do { _Pragma("unroll") for (int _i = 0; _i < 2; ++_i) \
        __builtin_amdgcn_global_load_lds((const unsigned*)((const char*)(gbase) + (voff)[_i]), (LAS unsigned*)(lds + (bufoff) + ldsw + _i * 8192), 16, 0, 0); } while (0)
#define MG_LDA(dst, b, h) do { _Pragma("unroll") for (int m = 0; m < 4; ++m) _Pragma("unroll") for (int k = 0; k < 2; ++k) dst[m][k] = *(const LAS bf16x8*)(lds + MG_SA(b, h) + aoff + m * 2048 + k * 1024); } while (0)
#define MG_LDB(dst, b, h) do { _Pragma("unroll") for (int n = 0; n < 2; ++n) _Pragma("unroll") for (int k = 0; k < 2; ++k) dst[n][k] = *(const LAS bf16x8*)(lds + MG_SB(b, h) + boff + n * 2048 + k * 1024); } while (0)
#define MG_MMA(ai, bj, At, Bt) do { __builtin_amdgcn_s_setprio(1); _Pragma("unroll") for (int m = 0; m < 4; ++m) _Pragma("unroll") for (int n = 0; n < 2; ++n) _Pragma("unroll") for (int k = 0; k < 2; ++k) \
        acc[ai][bj][m][n] = __builtin_amdgcn_mfma_f32_16x16x32_bf16(Bt[n][k], At[m][k], acc[ai][bj][m][n], 0, 0, 0); __builtin_amdgcn_s_setprio(0); } while (0)
#define MG_WAIT_V(n) asm volatile("s_waitcnt vmcnt(" #n ")" ::: "memory")
#define MG_WAIT_L(n) asm volatile("s_waitcnt lgkmcnt(" #n ")" ::: "memory")
#define MG_BAR __builtin_amdgcn_s_barrier()
#define MG_SCHED __builtin_amdgcn_sched_barrier(0)
    Unit cur, nxt; int ui = 0;
    if (!S.next(0, cur)) return;
    int ntc = cur.pad > 0 ? cur.pad : nt;
    bool hf = Sched::HAS_HALF && (cur.half != 0);
    f32x4 acc[2][2][4][2];
#pragma unroll
    for (int a = 0; a < 2; ++a)
#pragma unroll
        for (int b = 0; b < 2; ++b)
#pragma unroll
            for (int m = 0; m < 4; ++m)
#pragma unroll
                for (int n = 0; n < 2; ++n) acc[a][b][m][n] = (f32x4){0.f, 0.f, 0.f, 0.f};
    bf16x8 At[4][2], B0[2][2], B1[2][2];
    unsigned va0[2], va1[2], na0[2], na1[2];
#pragma unroll
    for (int i = 0; i < 2; ++i) {
        if (GATHER) { va0[i] = gtab[Rr[i]] + (unsigned)Cc[i] * 2u; va1[i] = gtab[HALF + Rr[i]] + (unsigned)Cc[i] * 2u; }
        else { va0[i] = (unsigned)(Rr[i] * K + Cc[i]) * 2u; va1[i] = va0[i] + (unsigned)hstep; }
        na0[i] = va0[i]; na1[i] = va1[i];
    }
    const char* cA = cur.A; const char* cB = cur.B;
    MG_STAGE(MG_SB(0, 0), cB, voffB); MG_STAGE(MG_SB(0, 1), cB + hstep, voffB); MG_STAGE(MG_SA(0, 0), cA, va0); MG_STAGE(MG_SA(0, 1), cA, va1);
    if (wr == 1) MG_BAR;
    MG_WAIT_V(2); MG_BAR;
    MG_STAGE(MG_SB(1, 0), cB + kstep, voffB); MG_STAGE(MG_SA(1, 0), cA + kstep, va0); MG_STAGE(MG_SB(1, 1), cB + hstep + kstep, voffB);
    MG_WAIT_V(6); MG_BAR;
    for (;;) {
        const bool has_next = S.next(ui + 1, nxt);
        const char* nA = has_next ? nxt.A : cA; const char* nB = has_next ? nxt.B : cB;
        if (GATHER) {
            if (has_next) {
#pragma unroll
                for (int i = 0; i < 2; ++i) { na0[i] = gtab[(ui + 1) * BM + Rr[i]] + (unsigned)Cc[i] * 2u; na1[i] = gtab[(ui + 1) * BM + HALF + Rr[i]] + (unsigned)Cc[i] * 2u; }
            }
        }
#pragma unroll 1
        for (int t = 0; t < ntc; t += 2) {
            const bool last = (t == ntc - 2);
            const char* a1 = cA + (size_t)(t + 1) * kstep;
            const char* a2 = last ? nA : cA + (size_t)(t + 2) * kstep; const char* b2 = last ? nB : cB + (size_t)(t + 2) * kstep;
            const char* a3 = a2 + kstep; const char* b3 = b2 + kstep;
            unsigned o0[2], o1[2];
#pragma unroll
            for (int i = 0; i < 2; ++i) { o0[i] = (GATHER && last) ? na0[i] : va0[i]; o1[i] = (GATHER && last) ? na1[i] : va1[i]; }
            MG_LDB(B0, 0, 0); MG_LDB(B1, 0, 1); MG_SCHED; MG_LDA(At, 0, 0); MG_STAGE(MG_SA(1, 1), a1, va1);
            MG_WAIT_V(8); MG_WAIT_L(0); MG_BAR; MG_MMA(0, 0, At, B0); MG_MMA(0, 1, At, B1); MG_BAR; MG_SCHED;
            if (!hf) MG_LDA(At, 0, 1); MG_STAGE(MG_SB(0, 0), b2, voffB); MG_STAGE(MG_SB(0, 1), b2 + hstep, voffB); MG_STAGE(MG_SA(0, 0), a2, o0);
            MG_WAIT_V(8); MG_WAIT_L(0); MG_BAR; if (!hf) { MG_MMA(1, 0, At, B0); MG_MMA(1, 1, At, B1); } MG_BAR; MG_SCHED;
            MG_LDB(B0, 1, 0); MG_LDB(B1, 1, 1); MG_SCHED; MG_LDA(At, 1, 0); MG_STAGE(MG_SA(0, 1), a2, o1);
            MG_WAIT_V(8); MG_WAIT_L(0); MG_BAR; MG_MMA(0, 0, At, B0); MG_MMA(0, 1, At, B1); MG_BAR; MG_SCHED;
            if (!hf) MG_LDA(At, 1, 1); MG_STAGE(MG_SB(1, 0), b3, voffB); MG_STAGE(MG_SB(1, 1), b3 + hstep, voffB); MG_STAGE(MG_SA(1, 0), a3, o0);
            MG_WAIT_V(8); MG_WAIT_L(0); MG_BAR; if (!hf) { MG_MMA(1, 0, At, B0); MG_MMA(1, 1, At, B1); } MG_BAR; MG_SCHED;
        }
        if (wr == 0) MG_BAR;
        E(acc, cur, wr, wc, fr, fq);
        if (!has_next) break;
        if (!(Epi::KEEP_ACC && cur.e == 0)) {
#pragma unroll
        for (int a = 0; a < 2; ++a)
#pragma unroll
            for (int b = 0; b < 2; ++b)
#pragma unroll
                for (int m = 0; m < 4; ++m)
#pragma unroll
                    for (int n = 0; n < 2; ++n) acc[a][b][m][n] = (f32x4){0.f, 0.f, 0.f, 0.f};
        }
        cur = nxt; cA = nA; cB = nB; ++ui; ntc = cur.pad > 0 ? cur.pad : nt; hf = Sched::HAS_HALF && (cur.half != 0);
#pragma unroll
        for (int i = 0; i < 2; ++i) { va0[i] = na0[i]; va1[i] = na1[i]; }
        if (wr == 1) MG_BAR;
    }
    MG_WAIT_V(0);
    MG_BAR;
    __syncthreads();
#undef MG_SA
#undef MG_SB
#undef MG_STAGE
#undef MG_LDA
#undef MG_LDB
#undef MG_MMA
#undef MG_WAIT_V
#undef MG_WAIT_L
#undef MG_BAR
#undef MG_SCHED
}

DEV u32x4 pack8(const f32x4 a, const f32x4 b) { u32x4 w; w.x = pk2(a[0], a[1]); w.y = pk2(a[2], a[3]); w.z = pk2(b[0], b[1]); w.w = pk2(b[2], b[3]); return w; }
DEV f32x4 unpack_lo(const u32x4 w) { return (f32x4){__uint_as_float(w.x << 16), __uint_as_float(w.x & 0xffff0000u), __uint_as_float(w.y << 16), __uint_as_float(w.y & 0xffff0000u)}; }
DEV f32x4 unpack_hi(const u32x4 w) { return (f32x4){__uint_as_float(w.z << 16), __uint_as_float(w.z & 0xffff0000u), __uint_as_float(w.w << 16), __uint_as_float(w.w & 0xffff0000u)}; }
DEV f32x4 sig4(const f32x4 v) { return (f32x4){sigm(v[0]), sigm(v[1]), sigm(v[2]), sigm(v[3])}; }
DEV f32x4 silu4(const f32x4 v) { return (f32x4){silu(v[0]), silu(v[1]), silu(v[2]), silu(v[3])}; }
#define ACC_T f32x4 (&acc)[2][2][4][2]

struct MEpiInProj { static constexpr bool PERM = true; static constexpr bool KEEP_ACC = false; bf16_t *U, *QKV, *G;
    DEV void operator()(ACC_T, const Unit& u, int wr, int wc, int fr, int fq) const {
        int colt = u.pn * BM; bf16_t* base; int ld; bool sg = false;
        if (colt < 512) { base = U; ld = 512; } else if (colt < 2816) { base = QKV; ld = 2304; colt -= 512; } else { base = G; ld = 2048; colt -= 2816; sg = true; }
        const int row0 = u.pm * BM + wr * 64 + fr, col0 = colt + wc * 32 + 8 * fq;
#pragma unroll
        for (int ai = 0; ai < 2; ++ai)
#pragma unroll
            for (int m = 0; m < 4; ++m) { bf16_t* rowp = base + (size_t)(row0 + ai * HALF + m * 16) * ld + col0;
#pragma unroll
                for (int bj = 0; bj < 2; ++bj) { f32x4 v0 = acc[ai][bj][m][0], v1 = acc[ai][bj][m][1]; if (sg) { v0 = sig4(v0); v1 = sig4(v1); }
                    *(u32x4*)(rowp + bj * HALF) = pack8(v0, v1); }
                asm volatile("" ::: "memory"); }
    } };
struct MEpiMergeF { static constexpr bool PERM = true; static constexpr bool KEEP_ACC = true; bf16_t* MG; const bf16_t* G;
    DEV void mid(f32x4 (&acc)[2][2][4][2], const Unit& u, int wr, int wc, int fr, int fq) const {
        const int row0 = u.pm * BM + wr * 64 + fr, col0 = u.pn * BM + wc * 32 + 8 * fq;
#pragma unroll
        for (int ai = 0; ai < 2; ++ai)
#pragma unroll
            for (int m = 0; m < 4; ++m) { const bf16_t* gr = G + (size_t)(row0 + ai * HALF + m * 16) * 2048 + col0;
#pragma unroll
                for (int bj = 0; bj < 2; ++bj)
#pragma unroll
                    for (int n = 0; n < 2; ++n) { const u32x2 gp = *(const u32x2*)(gr + bj * HALF + 4 * n), ga = *(const u32x2*)(gr + 1024 + bj * HALF + 4 * n);
                        acc[ai][bj][m][n] *= (f32x4){__uint_as_float(gp.x << 16) * __builtin_amdgcn_rcpf(__uint_as_float(ga.x << 16)), __uint_as_float(gp.x & 0xffff0000u) * __builtin_amdgcn_rcpf(__uint_as_float(ga.x & 0xffff0000u)),
                                                     __uint_as_float(gp.y << 16) * __builtin_amdgcn_rcpf(__uint_as_float(ga.y << 16)), __uint_as_float(gp.y & 0xffff0000u) * __builtin_amdgcn_rcpf(__uint_as_float(ga.y & 0xffff0000u))};
                        asm volatile("" ::: "memory"); } }
    }
    DEV void operator()(f32x4 (&acc)[2][2][4][2], const Unit& u, int wr, int wc, int fr, int fq) const {
        if (u.e == 0) { mid(acc, u, wr, wc, fr, fq); return; }
        const int row0 = u.pm * BM + wr * 64 + fr, col0 = u.pn * BM + wc * 32 + 8 * fq;
#pragma unroll
        for (int ai = 0; ai < 2; ++ai)
#pragma unroll
            for (int m = 0; m < 4; ++m) { const size_t r = (size_t)(row0 + ai * HALF + m * 16);
#pragma unroll
                for (int bj = 0; bj < 2; ++bj) { const int c = col0 + bj * HALF;
                    const u32x4 ga = *(const u32x4*)(G + r * 2048 + 1024 + c);
                    *(u32x4*)(MG + r * DM + c) = pack8(acc[ai][bj][m][0] * unpack_lo(ga), acc[ai][bj][m][1] * unpack_hi(ga)); }
                asm volatile("" ::: "memory"); }
    } };
struct MEpiOutProj { static constexpr bool PERM = false; static constexpr bool KEEP_ACC = false; const float* x; float* out; const float* mod;
    DEV void operator()(ACC_T, const Unit& u, int wr, int wc, int fr, int fq) const {
        const int row0 = u.pm * BM + wr * 64 + fr, col0 = u.pn * BM + wc * 32 + 4 * fq;
        const float* gm = mod + ((u.pm * BM) / SEQ) * NMOD + 2048;
#pragma unroll
        for (int ai = 0; ai < 2; ++ai)
#pragma unroll
            for (int m = 0; m < 4; ++m) { const size_t r = (size_t)(row0 + ai * HALF + m * 16) * DM;
#pragma unroll
                for (int bj = 0; bj < 2; ++bj)
#pragma unroll
                    for (int n = 0; n < 2; ++n) { const int c = col0 + bj * HALF + n * 16;
                        *(f32x4*)(out + r + c) = *(const f32x4*)(x + r + c) + *(const f32x4*)(gm + c) * acc[ai][bj][m][n]; }
                asm volatile("" ::: "memory"); }
    } };
struct MEpiRouterShared { static constexpr bool PERM = true; static constexpr bool KEEP_ACC = false; float* LG; bf16_t* HS;
    DEV void operator()(ACC_T, const Unit& u, int wr, int wc, int fr, int fq) const {
        const int row0 = u.pm * BM + wr * 64 + fr, cw = wc * 32 + 8 * fq;
#pragma unroll
        for (int ai = 0; ai < 2; ++ai)
#pragma unroll
            for (int m = 0; m < 4; ++m) { const size_t r = (size_t)(row0 + ai * HALF + m * 16);
                if (u.pn == 0) {
#pragma unroll
                    for (int bj = 0; bj < 2; ++bj)
#pragma unroll
                        for (int n = 0; n < 2; ++n) *(f32x4*)(LG + r * NE + bj * HALF + cw + 4 * n) = acc[ai][bj][m][n];
                } else {
                    const f32x4 v0 = silu4(acc[ai][0][m][0]) * acc[ai][1][m][0], v1 = silu4(acc[ai][0][m][1]) * acc[ai][1][m][1];
                    *(u32x4*)(HS + r * EFF + (u.pn - 1) * HALF + cw) = pack8(v0, v1);
                }
                asm volatile("" ::: "memory"); }
    } };
struct MEpiAct { static constexpr bool PERM = true; static constexpr bool KEEP_ACC = false; bf16_t* ACT;
    DEV void operator()(ACC_T, const Unit& u, int wr, int wc, int fr, int fq) const {
        const int row0 = u.pm * BM + wr * 64 + fr, cw = u.pn * HALF + wc * 32 + 8 * fq;
#pragma unroll
        for (int ai = 0; ai < 2; ++ai) { if (ai == 1 && u.half) break;
#pragma unroll
            for (int m = 0; m < 4; ++m) { const size_t r = (size_t)(row0 + ai * HALF + m * 16);
                const f32x4 v0 = silu4(acc[ai][0][m][0]) * acc[ai][1][m][0], v1 = silu4(acc[ai][0][m][1]) * acc[ai][1][m][1];
                *(u32x4*)(ACT + r * EFF + cw) = pack8(v0, v1); asm volatile("" ::: "memory"); } }
    } };
constexpr float SLAB_SCALE = 8.f, SLAB_INV = 0.125f;
DEV unsigned pk4_fp8(float a, float b, float c, float d) {
    a = fminf(fmaxf(a, -440.f), 440.f); b = fminf(fmaxf(b, -440.f), 440.f); c = fminf(fmaxf(c, -440.f), 440.f); d = fminf(fmaxf(d, -440.f), 440.f);
    int w = 0; w = __builtin_amdgcn_cvt_pk_fp8_f32(a, b, w, false); w = __builtin_amdgcn_cvt_pk_fp8_f32(c, d, w, true); return (unsigned)w; }
struct MEpiSlab { static constexpr bool PERM = true; static constexpr bool KEEP_ACC = false; unsigned char* SLAB; const int* rl; const float* w;
    DEV void operator()(ACC_T, const Unit& u, int wr, int wc, int fr, int fq) const {
        const int row0 = u.pm * BM + wr * 64 + fr, c16 = u.pn * BM + wc * 64 + 16 * fq;
#pragma unroll
        for (int ai = 0; ai < 2; ++ai) { if (ai == 1 && u.half) break;
#pragma unroll
            for (int m = 0; m < 4; ++m) { const int s = rl[row0 + ai * HALF + m * 16]; const float g = w[row0 + ai * HALF + m * 16] * SLAB_SCALE;
                if (s >= 0) { u32x4 o;
                    { const f32x4 a = acc[ai][0][m][0] * g, b = acc[ai][0][m][1] * g; o.x = pk4_fp8(a[0], a[1], a[2], a[3]); o.y = pk4_fp8(b[0], b[1], b[2], b[3]); }
                    { const f32x4 a = acc[ai][1][m][0] * g, b = acc[ai][1][m][1] * g; o.z = pk4_fp8(a[0], a[1], a[2], a[3]); o.w = pk4_fp8(b[0], b[1], b[2], b[3]); }
                    *(u32x4*)(SLAB + (size_t)s * DM + c16) = o; }
                asm volatile("" ::: "memory"); } }
    } };
DEV void acc4_fp8(f32x4& a, unsigned w) { const auto lo = __builtin_amdgcn_cvt_pk_f32_fp8((int)w, false), hi = __builtin_amdgcn_cvt_pk_f32_fp8((int)w, true); a[0] += lo[0]; a[1] += lo[1]; a[2] += hi[0]; a[3] += hi[1]; }
struct MEpiFinal { static constexpr bool PERM = true; static constexpr bool KEEP_ACC = false; float* out; const unsigned char* SLAB; const float* mod;
    DEV void operator()(ACC_T, const Unit& u, int wr, int wc, int fr, int fq) const {
        const int row0 = u.pm * BM + wr * 64 + fr, c16 = u.pn * BM + wc * 64 + 16 * fq;
        const float* gm = mod + ((u.pm * BM) / SEQ) * NMOD + 5120 + c16;
#pragma unroll
        for (int ai = 0; ai < 2; ++ai)
#pragma unroll
            for (int m = 0; m < 4; ++m) { const size_t row = (size_t)(row0 + ai * HALF + m * 16);
                const unsigned char* sp = SLAB + row * 8 * DM + c16;
                float* op = out + row * DM + c16;
                u32x4 sw[8]; f32x4 x[4];
#pragma unroll
                for (int k = 0; k < 8; ++k) sw[k] = *(const u32x4*)(sp + (size_t)k * DM);
#pragma unroll
                for (int q = 0; q < 4; ++q) x[q] = *(const f32x4*)(op + 4 * q);
                f32x4 s4[4];
#pragma unroll
                for (int q = 0; q < 4; ++q) s4[q] = (f32x4){0.f, 0.f, 0.f, 0.f};
#pragma unroll
                for (int k = 0; k < 8; ++k) { acc4_fp8(s4[0], sw[k].x); acc4_fp8(s4[1], sw[k].y); acc4_fp8(s4[2], sw[k].z); acc4_fp8(s4[3], sw[k].w); }
                s4[0] = s4[0] * SLAB_INV + acc[ai][0][m][0]; s4[1] = s4[1] * SLAB_INV + acc[ai][0][m][1]; s4[2] = s4[2] * SLAB_INV + acc[ai][1][m][0]; s4[3] = s4[3] * SLAB_INV + acc[ai][1][m][1];
#pragma unroll
                for (int q = 0; q < 4; ++q) *(f32x4*)(op + 4 * q) = x[q] + *(const f32x4*)(gm + 4 * q) * s4[q];
                asm volatile("" ::: "memory"); }
    } };
#undef ACC_T
}

typedef float f32x16 __attribute__((ext_vector_type(16)));
typedef short s16x4 __attribute__((ext_vector_type(4)));
DEV int crow(int r, int hi) { return (r & 3) + 8 * (r >> 2) + 4 * hi; }
DEV unsigned cvtpk(float lo, float hi) { unsigned r; asm("v_cvt_pk_bf16_f32 %0, %1, %2" : "=v"(r) : "v"(lo), "v"(hi)); return r; }
DEV s16x4 vtr(const LAS unsigned char* p) { return __builtin_bit_cast(s16x4, __builtin_amdgcn_ds_read_tr16_b64_v4i16((LAS s16x4*)p)); }
DEV float swap32(float v) { return __shfl_xor(v, 32); }

DEV void normrope_frag(bf16x8 (&f)[4], const LAS float* gt, int hi, float posf) {
    float x[32]; float ss = 0.f;
#pragma unroll
    for (int d0 = 0; d0 < 4; ++d0) { const u32x4 w = __builtin_bit_cast(u32x4, f[d0]);
        x[8 * d0 + 0] = __uint_as_float(w.x << 16); x[8 * d0 + 1] = __uint_as_float(w.x & 0xffff0000u); x[8 * d0 + 2] = __uint_as_float(w.y << 16); x[8 * d0 + 3] = __uint_as_float(w.y & 0xffff0000u);
        x[8 * d0 + 4] = __uint_as_float(w.z << 16); x[8 * d0 + 5] = __uint_as_float(w.z & 0xffff0000u); x[8 * d0 + 6] = __uint_as_float(w.w << 16); x[8 * d0 + 7] = __uint_as_float(w.w & 0xffff0000u); }
#pragma unroll
    for (int i = 0; i < 32; ++i) ss += x[i] * x[i];
    ss += __shfl_xor(ss, 32);
    const float rs = rsqrtf(ss * (1.f / 64.f) + 1e-6f);
#pragma unroll
    for (int d0 = 0; d0 < 4; ++d0) { const f32x4 g0 = *(const LAS f32x4*)(gt + 16 * d0 + 8 * hi), g1 = *(const LAS f32x4*)(gt + 16 * d0 + 8 * hi + 4);
#pragma unroll
        for (int j = 0; j < 4; ++j) { x[8 * d0 + j] *= rs * g0[j]; x[8 * d0 + 4 + j] *= rs * g1[j]; } }
    constexpr float INVF[8] = {1.0f, 0.19392274474868576f, 0.03760603093086393f, 0.007292664737217109f, 0.001414213562373095f, 0.0002742481756762073f, 5.318295896944988e-05f, 1.031338537721246e-05f};
#pragma unroll
    for (int i = 0; i < 8; ++i) {
        const float rev = posf * (INVF[i] * 0.15915494309189535f);
        const float fr = rev - floorf(rev);
        const float cs = __builtin_amdgcn_cosf(fr), sn = __builtin_amdgcn_sinf(fr);
        const float partner = __shfl_xor(x[i], 32);
        x[i] = hi ? (x[i] * cs + partner * sn) : (x[i] * cs - partner * sn);
    }
#pragma unroll
    for (int d0 = 0; d0 < 4; ++d0) { u32x4 w; w.x = cvtpk(x[8 * d0], x[8 * d0 + 1]); w.y = cvtpk(x[8 * d0 + 2], x[8 * d0 + 3]); w.z = cvtpk(x[8 * d0 + 4], x[8 * d0 + 5]); w.w = cvtpk(x[8 * d0 + 6], x[8 * d0 + 7]);
        f[d0] = __builtin_bit_cast(bf16x8, w); }
}

DEV void ph_attn_mfma(const P& p, LAS unsigned char* lds, int bid, int nb) {
    const int tid = otid(); const int lane = tid & 63, wid = __builtin_amdgcn_readfirstlane(tid >> 6), r32 = lane & 31, hi = lane >> 5;
    LAS unsigned char* vl = lds + wid * 8192;
    LAS float* wsf = (LAS float*)(lds + wid * 8192 + 4096);
    LAS float* gtab_q = (LAS float*)(lds + wid * 8192 + 4352);
    LAS float* gtab_k = gtab_q + 64;
    gtab_q[lane] = p.q_norm_g[lane]; gtab_k[lane] = p.k_norm_g[lane];
    asm volatile("s_waitcnt lgkmcnt(0)" ::: "memory");
    float gq = fabsf(p.q_norm_g[lane]), gk = fabsf(p.k_norm_g[lane]);
#pragma unroll
    for (int o = 32; o >= 1; o >>= 1) { gq = fmaxf(gq, __shfl_xor(gq, o)); gk = fmaxf(gk, __shfl_xor(gk, o)); }
    constexpr float LOG2E = 1.4426950408889634f, C2 = 0.125f * LOG2E;
    const float nmref = -(8.f * gq * gk * LOG2E);
    const int head = wid >> 1, qh = wid & 1;
    const int tq = (lane & 15) >> 2, tp = lane & 3, tcb = (lane >> 4) & 1;
    const LAS unsigned char* vrd = vl + (4 * hi + tq) * 128 + (16 * tcb + 4 * tp) * 2;
    for (int it = bid; it < NB * 96; it += nb) {
        const int cb = it & 31, g = (it >> 5) % 3, b = it / 96;
        const int dsh = 2 * g, d = 1 << dsh, L = SEQ >> dsh, nbk = L >> 6;
        const int r = cb / nbk, blk = cb % nbk;
        const int h = 4 * g + head, base = b * SEQ;
        const int q0 = 64 * blk + 32 * qh;
        const int mq = q0 + r32;
        const bf16_t* qp = p.QKV + (size_t)(base + mq * d + r) * 2304 + h * 64 + hi * 8;
        bf16x8 qr[4];
#pragma unroll
        for (int d0 = 0; d0 < 4; ++d0) qr[d0] = *(const bf16x8*)(qp + d0 * 16);
        normrope_frag(qr, gtab_q, hi, (float)p.pos[base + mq * d + r]);
        f32x16 o0, o1;
#pragma unroll
        for (int i = 0; i < 16; ++i) { o0[i] = 0.f; o1[i] = 0.f; }
        float lsum = 0.f;
        const int kb0 = q0 - 64;
#pragma unroll 1
        for (int st = 0; st < 5; ++st) {
            const int k0 = kb0 + 32 * st;
            if (k0 + 31 < 0 || k0 >= L) continue;
            const int mkc = min(max(k0 + r32, 0), L - 1);
            const bf16_t* kp = p.QKV + (size_t)(base + mkc * d + r) * 2304 + 768 + h * 64 + hi * 8;
            bf16x8 kf[4];
#pragma unroll
            for (int d0 = 0; d0 < 4; ++d0) kf[d0] = *(const bf16x8*)(kp + d0 * 16);
            const float kposf = (float)p.pos[base + mkc * d + r];
            u32x4 vreg[4];
#pragma unroll
            for (int i = 0; i < 4; ++i) { const int c = lane + 64 * i, row = c >> 3, ch = c & 7; const int mv = min(max(k0 + row, 0), L - 1);
                vreg[i] = *(const u32x4*)(p.QKV + (size_t)(base + mv * d + r) * 2304 + 1536 + h * 64 + ch * 8); }
            normrope_frag(kf, gtab_k, hi, kposf);
            f32x16 s;
#pragma unroll
            for (int i = 0; i < 16; ++i) s[i] = 0.f;
#pragma unroll
            for (int d0 = 0; d0 < 4; ++d0) s = __builtin_amdgcn_mfma_f32_32x32x16_bf16(kf[d0], qr[d0], s, 0, 0, 0);
#pragma unroll
            for (int i = 0; i < 16; ++i) { const int key = k0 + crow(i, hi); const int df = key - mq;
                const bool valid = (key >= 0) && (key < L) && (df <= 64) && (df >= -64);
                const float pv = valid ? __builtin_amdgcn_exp2f(__builtin_fmaf(s[i], C2, nmref)) : 0.f; lsum += pv; s[i] = pv; }
            bf16x8 pf0, pf1;
            { u32x4 w0, w1; w0.x = cvtpk(s[0], s[1]); w0.y = cvtpk(s[2], s[3]); w0.z = cvtpk(s[4], s[5]); w0.w = cvtpk(s[6], s[7]);
              w1.x = cvtpk(s[8], s[9]); w1.y = cvtpk(s[10], s[11]); w1.z = cvtpk(s[12], s[13]); w1.w = cvtpk(s[14], s[15]);
              pf0 = __builtin_bit_cast(bf16x8, w0); pf1 = __builtin_bit_cast(bf16x8, w1); }
#pragma unroll
            for (int i = 0; i < 4; ++i) { const int c = lane + 64 * i, row = c >> 3, ch = c & 7; *(LAS u32x4*)(vl + row * 128 + ch * 16) = vreg[i]; }
            asm volatile("s_waitcnt lgkmcnt(0)" ::: "memory");
#pragma unroll
            for (int n = 0; n < 2; ++n)
#pragma unroll
                for (int ks = 0; ks < 2; ++ks) {
                    const s16x4 lo = vtr(vrd + (16 * ks) * 128 + 64 * n), hi4 = vtr(vrd + (16 * ks + 8) * 128 + 64 * n);
                    bf16x8 vf; vf[0] = lo[0]; vf[1] = lo[1]; vf[2] = lo[2]; vf[3] = lo[3]; vf[4] = hi4[0]; vf[5] = hi4[1]; vf[6] = hi4[2]; vf[7] = hi4[3];
                    if (n == 0) o0 = __builtin_amdgcn_mfma_f32_32x32x16_bf16(ks == 0 ? pf0 : pf1, vf, o0, 0, 0, 0);
                    else o1 = __builtin_amdgcn_mfma_f32_32x32x16_bf16(ks == 0 ? pf0 : pf1, vf, o1, 0, 0, 0);
                }
            asm volatile("s_waitcnt lgkmcnt(0)" ::: "memory");
        }
        const float lt = lsum + swap32(lsum);
        if (hi == 0) { wsf[r32] = 1.f / lt; p.LSUM[((size_t)g * T + (base + mq * d + r)) * 4 + head] = lt; }
        asm volatile("s_waitcnt lgkmcnt(0)" ::: "memory");
        bf16_t* og = p.OG + (size_t)g * T * 256 + head * 64 + r32;
#pragma unroll
        for (int i = 0; i < 16; ++i) { const int qq = crow(i, hi); const float inv = wsf[qq]; const size_t tok = (size_t)(base + (q0 + qq) * d + r);
            og[tok * 256] = f2bf(o0[i] * inv); og[tok * 256 + 32] = f2bf(o1[i] * inv); }
        asm volatile("s_waitcnt lgkmcnt(0)" ::: "memory");
    }
}
DEV void ph_attn_combine(const P& p, int bid, int nb) {
    const int tid_ = otid();
    for (int i = bid * NTHR + tid_; i < T * 32; i += nb * NTHR) {
        const int t = i >> 5, ch = i & 31, slot = ch >> 3;
        const float l0 = p.LSUM[(size_t)t * 4 + slot], l1 = p.LSUM[((size_t)T + t) * 4 + slot], l2 = p.LSUM[((size_t)2 * T + t) * 4 + slot];
        const float inv = 1.f / (l0 + l1 + l2);
        const u32x4 a = *(const u32x4*)(p.OG + (size_t)t * 256 + ch * 8), b = *(const u32x4*)(p.OG + ((size_t)T + t) * 256 + ch * 8), c = *(const u32x4*)(p.OG + ((size_t)2 * T + t) * 256 + ch * 8);
        const f32x4 lo = (mg::unpack_lo(a) * l0 + mg::unpack_lo(b) * l1 + mg::unpack_lo(c) * l2) * inv;
        const f32x4 hi = (mg::unpack_hi(a) * l0 + mg::unpack_hi(b) * l1 + mg::unpack_hi(c) * l2) * inv;
        *(u32x4*)(p.PL + (size_t)t * 768 + 512 + ch * 8) = mg::pack8(lo, hi);
    }
}

template <class Src>
DEV void transpose_blk(const Src& src, int K, bf16_t* WT0, LAS float* scr, int k0, int lane) {
#pragma unroll 8
    for (int i = 0; i < 32; ++i) { const int kk = 2 * i + (lane >> 5); scr[kk * 33 + (lane & 31)] = src(k0 + kk, lane & 31); }
    asm volatile("s_waitcnt lgkmcnt(0)" ::: "memory");
    const int c = lane & 7;
#pragma unroll
    for (int j = 0; j < 4; ++j) { const int n = (lane >> 3) + 8 * j; const LAS float* s = scr + (8 * c) * 33 + n;
        u32x4 o; o.x = pk2(s[0 * 33], s[1 * 33]); o.y = pk2(s[2 * 33], s[3 * 33]); o.z = pk2(s[4 * 33], s[5 * 33]); o.w = pk2(s[6 * 33], s[7 * 33]);
        *(u32x4*)(WT0 + (size_t)n * K + k0 + 8 * c) = o; }
    asm volatile("s_waitcnt lgkmcnt(0)" ::: "memory");
}
struct SrcCol { const float* W; int ld; DEV float operator()(int k, int j) const { return W[(size_t)k * ld + j]; } };
struct SrcEff { const float *wg, *ls, *wu;
    DEV float operator()(int k, int j) const { const int g = k >> 7; const float* a = wg + (size_t)k * 128; const float* l = ls + g * 128; const float* b = wu + (size_t)(g * 128) * DM + j; float s = 0.f;
#pragma unroll 4
        for (int d = 0; d < 128; ++d) s += a[d] * l[d] * b[(size_t)d * DM]; return s; } };
DEV void tr_plain(const float* W, int K, int N, bf16_t* WT, LAS float* scr, int item, int lane) {
    const int nblk = N / 32, k0 = 64 * (item / nblk), n0 = 32 * (item % nblk);
    transpose_blk(SrcCol{W + n0, N}, K, WT + (size_t)n0 * K, scr, k0, lane);
}
DEV void tr_perm16(const float* W, int K, int N, bf16_t* WT, LAS float* scr, int item, int lane) {
    const int nblk = N / 32, k0 = 64 * (item / nblk), rho0 = 32 * (item % nblk);
    const int tile = rho0 >> 8, bj = (rho0 >> 7) & 1, wc = (rho0 >> 5) & 3;
    const int n0 = tile * 256 + 64 * wc + 8 * bj;
    struct SrcP { const float* W; int ld; DEV float operator()(int k, int dr) const { return W[(size_t)k * ld + 16 * (dr >> 3) + (dr & 7)]; } };
    transpose_blk(SrcP{W + n0, N}, K, WT + (size_t)rho0 * K, scr, k0, lane);
}
DEV void tr_gu(const float* g, const float* u, int K, bf16_t* WT, LAS float* scr, int k0, int rho0, int lane) {
    const int ch0 = (rho0 >> 8) * 128 + (rho0 & 127);
    const float* m = (rho0 & 128) ? u : g;
    transpose_blk(SrcCol{m + ch0, EFF}, K, WT + (size_t)rho0 * K, scr, k0, lane);
}

DEV void ph_prep_small(const P& p, LAS float* scr, int gw, int ngw, int lane) {
    constexpr int I_IN = 16 * (INW / 32), I_EFF = 64 * 16, I_AU = 4 * 32, I_OUT = 16 * 32, I_R = 16 * 8, I_S = 16 * 16, I_SD = 4 * 32;
    constexpr int NIT = I_IN + I_EFF + I_AU + I_OUT + I_R + I_S + I_SD;
    for (int it = gw; it < NIT; it += ngw) {
        int r = it;
        if (r < I_IN) { tr_plain(p.w_in, DM, INW, p.WT_IN, scr, r, lane); continue; } r -= I_IN;
        if (r < I_EFF) {
            const int n = 64 * (r & 15) + lane, k0 = 8 * (r >> 4), g = k0 >> 7;
            const float* a = p.pool_w_grp + (size_t)k0 * 128; const float* l = p.pool_scale + g * 128; const float* b = p.w_pool_up + (size_t)(g * 128) * DM + n;
            float acc[8];
#pragma unroll
            for (int j = 0; j < 8; ++j) acc[j] = 0.f;
#pragma unroll 4
            for (int d = 0; d < 128; ++d) { const float bl = b[(size_t)d * DM] * l[d];
#pragma unroll
                for (int j = 0; j < 8; ++j) acc[j] += a[j * 128 + d] * bl; }
            u32x4 o; o.x = pk2(acc[0], acc[1]); o.y = pk2(acc[2], acc[3]); o.z = pk2(acc[4], acc[5]); o.w = pk2(acc[6], acc[7]);
            *(u32x4*)(p.WT_EFF + (size_t)n * 768 + k0) = o; continue; } r -= I_EFF;
        if (r < I_AU) { const int k0 = 64 * (r / 32), n0 = 32 * (r % 32);
            transpose_blk(SrcCol{p.w_attn_up + n0, DM}, 768, p.WT_EFF + (size_t)n0 * 768 + 512, scr, k0, lane); continue; } r -= I_AU;
        if (r < I_OUT) { tr_plain(p.w_out, DM, DM, p.WT_OUT, scr, r, lane); continue; } r -= I_OUT;
        if (r < I_R) { tr_plain(p.w_router, DM, NE, p.WT_RS, scr, r, lane); continue; } r -= I_R;
        if (r < I_S) { tr_gu(p.w_sg, p.w_su, DM, p.WT_RS + (size_t)256 * DM, scr, 64 * (r / 16), 32 * (r % 16), lane); continue; } r -= I_S;
        tr_perm16(p.w_sd, EFF, DM, p.WT_SD, scr, r, lane);
    }
}
DEV void ph_prep_ed(const P& p, LAS float* scr, int gw, int ngw, int lane) {
    constexpr int IPE = 4 * 32;
    for (int it = gw; it < NE * IPE; it += ngw) { const int e = it / IPE;
        tr_perm16(p.w_ed + (size_t)e * EFF * DM, EFF, DM, p.WT_ED + (size_t)e * DM * EFF, scr, it % IPE, lane); }
}
DEV void ph_prep_egu(const P& p, LAS float* scr, int gw, int ngw, int lane) {
    constexpr int IPE = 16 * 16;
    for (int it = gw; it < NE * IPE; it += ngw) { const int e = it / IPE, r = it % IPE;
        tr_gu(p.w_eg + (size_t)e * DM * EFF, p.w_eu + (size_t)e * DM * EFF, DM, p.WT_EGU + (size_t)e * 512 * DM, scr, 64 * (r / 16), 32 * (r % 16), lane); }
}

constexpr int LDS_BYTES = 155648;
constexpr int LDS_OFF_TAB = 131072;
constexpr int LDS_GTAB = 131072 + 4096;
constexpr int MAXU = 16;
constexpr int LDS_MISC = LDS_GTAB + MAXU * 1024;

DEV void fill_gtab(const P& p, const mg::ExpertOrder& S, LAS unsigned* gtab) {
    const int tid_ = otid();
    for (int i = 0; i < MAXU; ++i) { int pm, pn, e; if (!S.tile_of(i, pm, pn, e)) break;
        if (tid_ < 256) { const int s = p.rowlist[pm * 256 + tid_]; gtab[i * 256 + tid_] = (unsigned)(s < 0 ? 0 : (s >> 3)) * (unsigned)(DM * 2); } }
    __syncthreads();
}

#define GAS __attribute__((address_space(1)))
#define XB_TMO      128
#define XB_XCNT(j)  (256  + 64 * (j))
#define XB_XSUB(j)  (1280 + 64 * (j))
#define XB_XGEN(j)  (2304 + 64 * (j))
#define XB_TOP      3328
#define XB_TOPGEN   3392
#define XCD_BAR_WORDS 3456
#define XB_SPIN_CAP (1u << 18)
DEV unsigned xb_ld(unsigned* p)              { return __hip_atomic_load(p, __ATOMIC_RELAXED, __HIP_MEMORY_SCOPE_AGENT); }
DEV unsigned xb_add(unsigned* p, unsigned v) { return __hip_atomic_fetch_add(p, v, __ATOMIC_RELAXED, __HIP_MEMORY_SCOPE_AGENT); }
DEV unsigned xb_xcc_id() { return (unsigned)__builtin_amdgcn_s_getreg((3 << 11) | 20) & 0xFu; }
#define XB_SPIN(cond, bar) do { unsigned _sp = 0; while (cond) { __builtin_amdgcn_s_sleep(1); \
    if ((++_sp & 255u) == 0u) { if (xb_ld(&(bar)[XB_TMO])) break; if (_sp > XB_SPIN_CAP) { atomicAdd(&(bar)[XB_TMO], 1u); break; } } } } while (0)
struct XcdBarrier { unsigned* bar; unsigned x; volatile LAS unsigned* st; };
DEV XcdBarrier xcd_barrier_post(unsigned* bar, volatile LAS unsigned* st) {
    XcdBarrier b; b.bar = bar; b.x = xb_xcc_id(); b.st = st;
    if (threadIdx.x == 0) (void)xb_add(&bar[XB_XCNT(b.x)], 1u);
    return b;
}
DEV void xcd_barrier_complete(unsigned* bar, unsigned x, unsigned& nloc, unsigned& nx) {
    const unsigned G = gridDim.x * gridDim.y * gridDim.z;
    unsigned sum, cnt, mine, sp = 0u;
    for (;;) {
        sum = 0u; cnt = 0u; mine = 0u;
#pragma unroll
        for (unsigned j = 0; j < 16; ++j) { const unsigned c = xb_ld(&bar[XB_XCNT(j)]); sum += c; cnt += (c > 0u) ? 1u : 0u; mine = (j == x) ? c : mine; }
        if (sum == G) break;
        __builtin_amdgcn_s_sleep(1);
        if ((++sp & 255u) == 0u) { if (xb_ld(&bar[XB_TMO])) break; if (sp > XB_SPIN_CAP) { atomicAdd(&bar[XB_TMO], 1u); break; } }
    }
    nloc = mine > 0u ? mine : 1u; nx = cnt > 0u ? cnt : 1u;
}
DEV void xcd_barrier(const XcdBarrier& b) {
    asm volatile("s_waitcnt vmcnt(0)" ::: "memory");
    __syncthreads();
    if (threadIdx.x == 0) {
        unsigned* bar = b.bar;
        __builtin_amdgcn_s_waitcnt(0);
        unsigned nloc = b.st[0], nx = b.st[1];
        if (nloc == 0u) { xcd_barrier_complete(bar, b.x, nloc, nx); b.st[0] = nloc; b.st[1] = nx; }
        const unsigned old = xb_add(&bar[XB_XSUB(b.x)], 1u);
        const unsigned gen = old / nloc;
        if (old + 1u == (gen + 1u) * nloc) {
            __builtin_amdgcn_fence(__ATOMIC_RELEASE, "agent");
            asm volatile("s_waitcnt vmcnt(0)" ::: "memory");
            const unsigned og = xb_add(&bar[XB_TOP], 1u);
            const unsigned tg = og / nx;
            if (og + 1u == (tg + 1u) * nx) xb_add(&bar[XB_TOPGEN], 1u);
            else XB_SPIN(xb_ld(&bar[XB_TOPGEN]) == tg, bar);
            __builtin_amdgcn_fence(__ATOMIC_ACQUIRE, "agent");
            xb_add(&bar[XB_XGEN(b.x)], 1u);
            asm volatile("s_waitcnt vmcnt(0)" ::: "memory");
        } else {
            XB_SPIN(xb_ld(&bar[XB_XGEN(b.x)]) == gen, bar);
            __builtin_amdgcn_fence(__ATOMIC_ACQUIRE, "agent");
            asm volatile("s_waitcnt vmcnt(0)" ::: "memory");
        }
    }
    __syncthreads();
}

#define STAMP() do { if (TPROBE >= 0) { if (bid == 0 && threadIdx.x == 0) p.ts[nst] = __builtin_amdgcn_s_memrealtime(); ++nst; } } while (0)
#define GSYNC_CG() do { cg::this_grid().sync(); STAMP(); } while (0)
#define GSYNC() do { xcd_barrier(xbar); STAMP(); } while (0)
__global__ void __launch_bounds__(NTHR, 2) fwd_all(P p) {
    extern __shared__ __attribute__((aligned(16))) unsigned char lds_raw[];
    LAS unsigned char* lds = (LAS unsigned char*)lds_raw;
    float* sm = (float*)lds_raw;
    int* off = (int*)(lds_raw + LDS_OFF_TAB);
    const LAS int* offl = (const LAS int*)(lds + LDS_OFF_TAB);
    LAS unsigned* gtab = (LAS unsigned*)(lds + LDS_GTAB);
    const int bid = blockIdx.x, nb = gridDim.x;
    const int tid_ = otid(); const int lane = tid_ & 63, wv = tid_ >> 6;
    LAS float* scr = (LAS float*)(lds + wv * 16384);
    const int gw = bid * NWV + wv, ngw = nb * NWV;
    volatile LAS unsigned* misc = (volatile LAS unsigned*)(lds + LDS_MISC);
    if (threadIdx.x < 2) misc[threadIdx.x] = 0u;
    __syncthreads();
    const XcdBarrier xbar = xcd_barrier_post(p.bar, misc);
    int nst = 0; STAMP();

    ph_mod(p, sm, bid, nb);
    __syncthreads();
    REPEAT(1) ph_prep_small(p, scr, gw, ngw, lane);
#if MF_EXP2
    REPEAT(2) ph_prep_ed(p, scr, gw, ngw, lane);
#endif
    GSYNC();
    REPEAT(3) ph_norm(p.x, p.norm1_g, p.mod, 0, 1024, p.XB, bid, nb);
    GSYNC();
#if MF_INPROJ
    REPEAT(4) { mg::DenseOrder S; S.init(p.XB, p.WT_IN, T, INW, DM, nb, bid);
      mg::gemm_phase<mg::MEpiInProj, mg::DenseOrder, false>(lds, gtab, DM, S, mg::MEpiInProj{p.U, p.QKV, p.G}); }
#else
    ngemm_dense<false>(p.XB, DM, p.w_in, nullptr, INW, T, INW, DM, EpiInProj{p.U, p.QKV, p.G}, sm, bid, nb);
#endif
    GSYNC();
#if !MF_ATTN
    ph_qknorm(p, bid, nb);
#endif
    REPEAT(5) ph_pool(p, bid, nb);
#if !MF_ATTN
    GSYNC();
#endif
#if MF_ATTN
    REPEAT(6) ph_attn_mfma(p, lds, bid, nb);
    GSYNC();
    REPEAT(7) ph_attn_combine(p, bid, nb);
#else
    ph_attn(p, bid, nb);
#endif
#if !MF_MERGE
#pragma unroll 1
    for (int g = 0; g < 4; ++g) ngemm_dense<false>(p.PL + g * 128, 512, p.pool_w_grp + g * 128 * 128, nullptr, 128, T, 128, 128, EpiPoolGrp{p.Y, p.pool_scale, g}, sm, bid, nb);
#endif
    GSYNC();
#if MF_MERGE
    REPEAT(8) { mg::PairOrder S; S.D.init(p.PL, p.WT_EFF, T, DM, 768, nb, bid); S.kt0 = 8; S.kt1 = 4;
      mg::gemm_phase<mg::MEpiMergeF, mg::PairOrder, false>(lds, gtab, 768, S, mg::MEpiMergeF{p.XB, p.G}); }
#else
    ngemm_dense<false>(p.Y, 512, p.w_pool_up, nullptr, DM, T, DM, 512, EpiMergeA{p.XB, p.G}, sm, bid, nb);
    GSYNC();
    ngemm_dense<false>(p.O, 256, p.w_attn_up, nullptr, DM, T, DM, 256, EpiMergeB{p.XB, p.G}, sm, bid, nb);
#endif
    GSYNC();
#if MF_OUT
    REPEAT(9) { mg::DenseOrder S; S.init(p.XB, p.WT_OUT, T, DM, DM, nb, bid);
      mg::gemm_phase<mg::MEpiOutProj, mg::DenseOrder, false>(lds, gtab, DM, S, mg::MEpiOutProj{p.x, p.out, p.mod}); }
#else
    ngemm_dense<false>(p.XB, DM, p.w_out, nullptr, DM, T, DM, DM, EpiOutProj{p.x, p.out, p.mod}, sm, bid, nb);
#endif
    GSYNC();
    REPEAT(10) ph_norm(p.out, p.norm2_g, p.mod, 3072, 4096, p.XB, bid, nb);
#if MF_EXP1
    __syncthreads();
    REPEAT(11) ph_prep_egu(p, scr, gw, ngw, lane);
#endif
    GSYNC();
#if MF_ROUTER
    REPEAT(12) { mg::DenseOrder S; S.init(p.XB, p.WT_RS, T, 768, DM, nb, bid);
      mg::gemm_phase<mg::MEpiRouterShared, mg::DenseOrder, false>(lds, gtab, DM, S, mg::MEpiRouterShared{p.LG, p.HS}); }
#else
    ngemm_dense<false>(p.XB, DM, p.w_router, nullptr, NE, T, NE, DM, EpiLogits{p.LG}, sm, bid, nb);
#endif
    GSYNC();
    ph_route(p, (int*)lds_raw, bid, nb);
    GSYNC();
    ph_scatter(p, off, bid, nb);
    GSYNC();
#if MF_EXP1
    REPEAT(13) { load_offsets(p.cnt, off);
      mg::ExpertOrder S{offl, 2, nb, bid, (const char*)p.XB, (const char*)p.WT_EGU, (size_t)512 * DM * 2, (size_t)256 * DM * 2, 0, true};
      fill_gtab(p, S, gtab);
      mg::gemm_phase<mg::MEpiAct, mg::ExpertOrder, true>(lds, gtab, DM, S, mg::MEpiAct{p.ACT}); }
#else
    ph_expert1(p, sm, off, bid, nb);
#endif
    GSYNC();
#if MF_EXP2
    REPEAT(14) { load_offsets(p.cnt, off);
      mg::ExpertOrder S{offl, 4, nb, bid, (const char*)p.ACT, (const char*)p.WT_ED, (size_t)DM * EFF * 2, (size_t)256 * EFF * 2, (size_t)256 * EFF * 2, false};
      mg::gemm_phase<mg::MEpiSlab, mg::ExpertOrder, false>(lds, gtab, EFF, S, mg::MEpiSlab{(unsigned char*)p.SLAB, p.rowlist, p.roww}); }
#else
    ph_expert2(p, sm, off, bid, nb);
#endif
    GSYNC();
#if !MF_ROUTER
    ngemm_dense<true>(p.XB, DM, p.w_sg, p.w_su, EFF, T, EFF, DM, EpiAct{p.HS}, sm, bid, nb);
    GSYNC();
#endif
#if MF_FINAL
    { mg::DenseOrder S; S.init(p.HS, p.WT_SD, T, DM, EFF, nb, bid);
      mg::gemm_phase<mg::MEpiFinal, mg::DenseOrder, false>(lds, gtab, EFF, S, mg::MEpiFinal{p.out, (const unsigned char*)p.SLAB, p.mod}); }
#else
    ngemm_dense<false>(p.HS, EFF, p.w_sd, nullptr, DM, T, DM, EFF, EpiFinal{p.out, p.SLAB, p.mod}, sm, bid, nb);
#endif
#if TPROBE >= 0
    GSYNC();
    if (bid == 0 && threadIdx.x == 0) { const unsigned long long dt = p.ts[TPROBE + 1] - p.ts[TPROBE]; p.out[0] += (float)dt * 0.01f / TSCALE; }
#endif
}

extern "C" void kernel_launch(void* const* d_in, const int* in_sizes, int n_in, void* d_out, int out_size, void* d_ws, size_t ws_size, hipStream_t stream) {
    static int grid = 0;
    if (grid == 0) {
        int dev = 0, cus = 0;
        (void)hipGetDevice(&dev);
        (void)hipDeviceGetAttribute(&cus, hipDeviceAttributeMultiprocessorCount, dev);
        int per_cu = 0;
        (void)hipFuncSetAttribute((const void*)fwd_all, hipFuncAttributeMaxDynamicSharedMemorySize, LDS_BYTES);
        (void)hipOccupancyMaxActiveBlocksPerMultiprocessor(&per_cu, fwd_all, NTHR, LDS_BYTES);
        if (per_cu < 1) { fprintf(stderr, "kernel_launch: occupancy query says %d blocks/CU\n", per_cu); per_cu = 1; }
        if (per_cu > 1) per_cu = 1;
        grid = cus * per_cu;
        if (ws_size < WS_END) { fprintf(stderr, "kernel_launch: workspace too small (%zu < %zu)\n", ws_size, (size_t)WS_END); grid = -1; }
    }
    if (grid < 0) return;
    P p{};
    const float* const* in = (const float* const*)d_in;
    p.x = in[0]; p.c = in[1]; p.pos = (const int*)d_in[2];
    p.w_ada = in[3]; p.b_ada = in[4]; p.norm1_g = in[5]; p.w_in = in[6]; p.pool_w_grp = in[7]; p.pool_scale = in[8]; p.q_norm_g = in[9]; p.k_norm_g = in[10];
    p.w_pool_up = in[11]; p.w_attn_up = in[12]; p.w_out = in[13]; p.norm2_g = in[14]; p.w_router = in[15]; p.router_bias = in[16];
    p.w_sg = in[17]; p.w_su = in[18]; p.w_sd = in[19]; p.w_eg = in[20]; p.w_eu = in[21]; p.w_ed = in[22];
    p.out = (float*)d_out;
    char* ws = (char*)d_ws;
    p.mod = (float*)(ws + WS_MOD); p.cnt = (int*)(ws + WS_CNT); p.asg_e = (int*)(ws + WS_ASG_E); p.asg_pos = (int*)(ws + WS_ASG_POS);
    p.asg_w = (float*)(ws + WS_ASG_W); p.rowlist = (int*)(ws + WS_ROWLIST);
    p.XB = (bf16_t*)(ws + WS_XB); p.U = (bf16_t*)(ws + WS_U); p.QKV = (bf16_t*)(ws + WS_QKV); p.G = (bf16_t*)(ws + WS_G); p.PL = (bf16_t*)(ws + WS_PL);
    p.Y = (bf16_t*)(ws + WS_Y); p.O = (bf16_t*)(ws + WS_O); p.ACT = (bf16_t*)(ws + WS_ACT); p.SLAB = (bf16_t*)(ws + WS_SLAB); p.HS = (bf16_t*)(ws + WS_HS);
    p.LG = (float*)(ws + WS_ACT);
    p.roww = (float*)(ws + WS_ROWW);
    p.bar = (unsigned*)(ws + WS_BAR); p.ts = (unsigned long long*)(ws + WS_TS);
    p.OG = (bf16_t*)(ws + WS_OG); p.LSUM = (float*)(ws + WS_LSUM);
    p.WT_IN = (bf16_t*)(ws + WS_WT_IN); p.WT_EFF = (bf16_t*)(ws + WS_WT_EFF); p.WT_AU = (bf16_t*)(ws + WS_WT_AU); p.WT_OUT = (bf16_t*)(ws + WS_WT_OUT);
    p.WT_RS = (bf16_t*)(ws + WS_WT_RS); p.WT_SD = (bf16_t*)(ws + WS_WT_SD); p.WT_EGU = (bf16_t*)(ws + WS_WT_EGU); p.WT_ED = (bf16_t*)(ws + WS_WT_ED);
    (void)hipMemsetAsync(ws + WS_BAR, 0, WS_ZERO_BYTES, stream);
    void* args[] = {&p};
    hipError_t e = hipLaunchCooperativeKernel((void*)fwd_all, dim3(grid), dim3(NTHR), args, LDS_BYTES, stream);
    if (e != hipSuccess) fprintf(stderr, "cooperative launch failed: %s (grid %d)\n", hipGetErrorString(e), grid);
}
```

```cpp
#include <hip/hip_runtime.h>
#include <hip/hip_cooperative_groups.h>
#include <stdint.h>
#include <cstdio>
namespace cg = cooperative_groups;

#ifndef ONE_LAUNCH
#define ONE_LAUNCH 0
#endif

typedef unsigned short bf16_t;
#define DEV __device__ __forceinline__
#define LAS __attribute__((address_space(3)))
typedef short bf16x8 __attribute__((ext_vector_type(8)));
typedef float f32x4 __attribute__((ext_vector_type(4)));
typedef unsigned u32x4 __attribute__((ext_vector_type(4)));
typedef unsigned u32x2 __attribute__((ext_vector_type(2)));

#ifndef MF_INPROJ
#define MF_INPROJ 1
#endif
#ifndef MF_MERGE
#define MF_MERGE 1
#endif
#ifndef MF_OUT
#define MF_OUT 1
#endif
#ifndef MF_ROUTER
#define MF_ROUTER 1
#endif
#ifndef MF_EXP1
#define MF_EXP1 1
#endif
#ifndef MF_EXP2
#define MF_EXP2 1
#endif
#ifndef MF_ATTN
#define MF_ATTN 1
#endif
#ifndef DUP
#define DUP 0
#endif
#ifndef TPROBE
#define TPROBE -1
#endif
#ifndef TSCALE
#define TSCALE 10.0f
#endif
#define REPEAT(n) _Pragma("unroll 1") for (int rep_ = 0; rep_ < ((DUP == (n)) ? 2 : 1); ++rep_)
#ifndef MF_FINAL
#define MF_FINAL 1
#endif

constexpr int NB = 16, SEQ = 2048, DM = 1024, T = NB * SEQ;
constexpr int INW = 4864, NMOD = 6144;
constexpr int NE = 256, EFF = 256;
constexpr int NTHR = 512, NWV = 8;
constexpr int NSLOT = T * 8;
constexpr int RMAX = NSLOT + NE * 256;

DEV float bf2f(bf16_t h) { return __uint_as_float(((unsigned)h) << 16); }
DEV bf16_t f2bf(float f) { unsigned u = __float_as_uint(f); u += 0x7fffu + ((u >> 16) & 1u); return (bf16_t)(u >> 16); }
DEV unsigned pk2(float lo, float hi) { return (unsigned)f2bf(lo) | ((unsigned)f2bf(hi) << 16); }
DEV float sigm(float v) { return 1.f / (1.f + __expf(-v)); }
DEV float silu(float v) { return v / (1.f + __expf(-v)); }
DEV int otid() { int t = threadIdx.x; asm volatile("" : "+v"(t)); return t; }
DEV float wave_sum(float v) {
#pragma unroll
    for (int o = 32; o >= 1; o >>= 1) v += __shfl_xor(v, o);
    return v;
}

struct P {
    const float *x, *c; const int* pos;
    const float *w_ada, *b_ada, *norm1_g, *w_in, *pool_w_grp, *pool_scale, *q_norm_g, *k_norm_g, *w_pool_up, *w_attn_up, *w_out, *norm2_g,
        *w_router, *router_bias, *w_sg, *w_su, *w_sd, *w_eg, *w_eu, *w_ed;
    float* out;
    float* mod; int* cnt; int* asg_e; int* asg_pos; float* asg_w; int* rowlist;
    bf16_t *XB, *U, *QKV, *G, *PL, *Y, *O, *ACT, *SLAB, *HS;
    float* LG;
    bf16_t* OG; float* LSUM; unsigned* bar; unsigned long long* ts; float* roww;
    bf16_t *WT_IN, *WT_EFF, *WT_AU, *WT_OUT, *WT_RS, *WT_SD, *WT_EGU, *WT_ED;
};

constexpr size_t MiB = 1u << 20;
constexpr size_t WS_BAR = 640 * 1024, WS_BAR_BYTES = 16384, WS_ZERO_BYTES = 16384 + 65536;
constexpr size_t WS_TS = 800 * 1024;
constexpr size_t WS_MOD = 0, WS_CNT = WS_BAR + WS_BAR_BYTES, WS_ASG_E = 1 * MiB, WS_ASG_POS = 2 * MiB, WS_ASG_W = 3 * MiB, WS_ROWLIST = 4 * MiB, WS_ROWW = 6 * MiB;
constexpr size_t WS_XB = 8 * MiB;
constexpr size_t WS_ACT = 72 * MiB;
constexpr size_t WS_SLAB = 232 * MiB;
constexpr size_t WS_U = 232 * MiB, WS_QKV = 264 * MiB, WS_G = 408 * MiB, WS_PL = 536 * MiB, WS_Y = 568 * MiB, WS_O = 600 * MiB;
constexpr size_t WS_WT_IN = 744 * MiB, WS_WT_EFF = 754 * MiB, WS_WT_AU = 755 * MiB, WS_WT_OUT = 756 * MiB, WS_WT_RS = 758 * MiB, WS_WT_SD = 760 * MiB;
constexpr size_t WS_WT_ED = 762 * MiB;
constexpr size_t WS_WT_EGU = 232 * MiB;
constexpr size_t WS_OG = 616 * MiB, WS_LSUM = 664 * MiB;
constexpr size_t WS_HS = 890 * MiB;
constexpr size_t WS_END = 906 * MiB;

DEV void ph_mod(const P& p, float* sm, int bid, int nb) {
    const int tid_ = otid(); const int lane = tid_ & 63, wv = tid_ >> 6;
    for (int it = bid; it < 96; it += nb) {
        const int k0 = wv * 128, e = it * 64 + lane;
        float acc[16];
#pragma unroll
        for (int b = 0; b < 16; ++b) acc[b] = 0.f;
#pragma unroll 1
        for (int kh = 0; kh < 2; ++kh) {
            float sc[16];
#pragma unroll
            for (int b = 0; b < 16; ++b) sc[b] = silu(p.c[b * DM + k0 + kh * 64 + lane]);
            const float* wp = p.w_ada + (size_t)(k0 + kh * 64) * NMOD + e;
#pragma unroll 8
            for (int kk = 0; kk < 64; ++kk) { const float w = wp[(size_t)kk * NMOD];
#pragma unroll
                for (int b = 0; b < 16; ++b) acc[b] += __uint_as_float(__builtin_amdgcn_readlane(__float_as_uint(sc[b]), kk)) * w; }
        }
        __syncthreads();
#pragma unroll
        for (int b = 0; b < 16; ++b) sm[(wv * 16 + b) * 64 + lane] = acc[b];
        __syncthreads();
#pragma unroll
        for (int j = 0; j < 2; ++j) { const int idx = tid_ + j * NTHR, b = idx >> 6, col = idx & 63; float s = p.b_ada[it * 64 + col];
#pragma unroll
            for (int w = 0; w < 8; ++w) s += sm[(w * 16 + b) * 64 + col];
            p.mod[b * NMOD + it * 64 + col] = s; }
    }
}

DEV void ph_norm(const float* src, const float* g, const float* mod, int shift_off, int scale_off, bf16_t* dst, int bid, int nb) {
    const int tid_ = otid(); const int lane = tid_ & 63, wv = tid_ >> 6;
    for (int row0 = (bid * NWV + wv) * 2; row0 < T; row0 += nb * NWV * 2) {
        float4 v[2][4]; float ss[2] = {0.f, 0.f};
#pragma unroll
        for (int q = 0; q < 2; ++q) { const float4* xr = (const float4*)(src + (size_t)(row0 + q) * DM);
#pragma unroll
            for (int j = 0; j < 4; ++j) v[q][j] = xr[lane + 64 * j]; }
#pragma unroll
        for (int q = 0; q < 2; ++q)
#pragma unroll
            for (int j = 0; j < 4; ++j) ss[q] += v[q][j].x * v[q][j].x + v[q][j].y * v[q][j].y + v[q][j].z * v[q][j].z + v[q][j].w * v[q][j].w;
        const int b = row0 / SEQ;
#pragma unroll
        for (int q = 0; q < 2; ++q) {
            const float r = rsqrtf(wave_sum(ss[q]) * (1.f / DM) + 1e-6f);
#pragma unroll
            for (int j = 0; j < 4; ++j) {
                const int col = (lane + 64 * j) * 4;
                const float4 g4 = *(const float4*)(g + col);
                const float4 sc = *(const float4*)(mod + b * NMOD + scale_off + col);
                const float4 sh = *(const float4*)(mod + b * NMOD + shift_off + col);
                const float o0 = v[q][j].x * r * g4.x * (1.f + sc.x) + sh.x, o1 = v[q][j].y * r * g4.y * (1.f + sc.y) + sh.y;
                const float o2 = v[q][j].z * r * g4.z * (1.f + sc.z) + sh.z, o3 = v[q][j].w * r * g4.w * (1.f + sc.w) + sh.w;
                uint2 w; w.x = pk2(o0, o1); w.y = pk2(o2, o3);
                *(uint2*)(dst + (size_t)(row0 + q) * DM + col) = w;
            }
        }
    }
}

template <bool DUAL, class RowF, class Epi>
DEV void ngemm_tile(const bf16_t* __restrict__ A, int lda, RowF rowf, const float* __restrict__ B, const float* __restrict__ B2, int ldb,
                    int m0, int n0, int K, Epi epi, float* sm) {
    float* As = sm;
    float* Bs = sm + 16 * 132;
    float* Bs2 = Bs + 16 * 64;
    const int tid = otid(), tm = tid >> 4, tn = tid & 15;
    float acc[4][4], acc2[4][4];
#pragma unroll
    for (int i = 0; i < 4; ++i)
#pragma unroll
        for (int j = 0; j < 4; ++j) { acc[i][j] = 0.f; acc2[i][j] = 0.f; }
    const int ar = tid >> 2, ak = (tid & 3) * 4;
    const int arow = rowf(m0 + ar);
    const bf16_t* ap = A + (size_t)(arow < 0 ? 0 : arow) * lda + ak;
    const int bk = tid >> 5, bn = (tid & 31) * 2;
    for (int k0 = 0; k0 < K; k0 += 16) {
        uint2 av = make_uint2(0u, 0u);
        if (arow >= 0) av = *(const uint2*)(ap + k0);
        const float2 bv = *(const float2*)(B + (size_t)(k0 + bk) * ldb + n0 + bn);
        float2 bv2 = make_float2(0.f, 0.f);
        if (DUAL) bv2 = *(const float2*)(B2 + (size_t)(k0 + bk) * ldb + n0 + bn);
        __syncthreads();
        As[(ak + 0) * 132 + ar] = __uint_as_float(av.x << 16);
        As[(ak + 1) * 132 + ar] = __uint_as_float(av.x & 0xffff0000u);
        As[(ak + 2) * 132 + ar] = __uint_as_float(av.y << 16);
        As[(ak + 3) * 132 + ar] = __uint_as_float(av.y & 0xffff0000u);
        Bs[bk * 64 + bn] = bv.x; Bs[bk * 64 + bn + 1] = bv.y;
        if (DUAL) { Bs2[bk * 64 + bn] = bv2.x; Bs2[bk * 64 + bn + 1] = bv2.y; }
        __syncthreads();
#pragma unroll
        for (int kk = 0; kk < 16; ++kk) {
            const float4 a = *(const float4*)&As[kk * 132 + tm * 4];
            const float4 b = *(const float4*)&Bs[kk * 64 + tn * 4];
            const float aa[4] = {a.x, a.y, a.z, a.w}, bb[4] = {b.x, b.y, b.z, b.w};
#pragma unroll
            for (int i = 0; i < 4; ++i)
#pragma unroll
                for (int j = 0; j < 4; ++j) acc[i][j] += aa[i] * bb[j];
            if (DUAL) {
                const float4 b2 = *(const float4*)&Bs2[kk * 64 + tn * 4];
                const float cc[4] = {b2.x, b2.y, b2.z, b2.w};
#pragma unroll
                for (int i = 0; i < 4; ++i)
#pragma unroll
                    for (int j = 0; j < 4; ++j) acc2[i][j] += aa[i] * cc[j];
            }
        }
    }
#pragma unroll
    for (int i = 0; i < 4; ++i)
#pragma unroll
        for (int j = 0; j < 4; ++j) epi(m0 + tm * 4 + i, n0 + tn * 4 + j, acc[i][j], acc2[i][j]);
}

struct RowId { DEV int operator()(int m) const { return m; } };
struct RowTok { const int* rl; DEV int operator()(int m) const { const int s = rl[m]; return s < 0 ? -1 : (s >> 3); } };

template <bool DUAL, class Epi>
DEV void ngemm_dense(const bf16_t* A, int lda, const float* B, const float* B2, int ldb, int M, int N, int K, Epi epi, float* sm, int bid, int nb) {
    const int tn = N / 64, nt = (M / 128) * tn;
    for (int t = bid; t < nt; t += nb) ngemm_tile<DUAL>(A, lda, RowId(), B, B2, ldb, (t / tn) * 128, (t % tn) * 64, K, epi, sm);
}

struct EpiInProj { bf16_t *U, *QKV, *G;
    DEV void operator()(int r, int c, float v, float) const {
        if (c < 512) U[(size_t)r * 512 + c] = f2bf(v);
        else if (c < 2816) QKV[(size_t)r * 2304 + (c - 512)] = f2bf(v);
        else G[(size_t)r * 2048 + (c - 2816)] = f2bf(sigm(v)); } };
struct EpiPoolGrp { bf16_t* Y; const float* ls; int g;
    DEV void operator()(int r, int c, float v, float) const { Y[(size_t)r * 512 + g * 128 + c] = f2bf(v * ls[g * 128 + c]); } };
struct EpiMergeA { bf16_t* MG; const bf16_t* G;
    DEV void operator()(int r, int c, float v, float) const { MG[(size_t)r * DM + c] = f2bf(bf2f(G[(size_t)r * 2048 + c]) * v); } };
struct EpiMergeB { bf16_t* MG; const bf16_t* G;
    DEV void operator()(int r, int c, float v, float) const { const size_t i = (size_t)r * DM + c; MG[i] = f2bf(bf2f(MG[i]) + bf2f(G[(size_t)r * 2048 + 1024 + c]) * v); } };
struct EpiOutProj { const float* x; float* out; const float* mod;
    DEV void operator()(int r, int c, float v, float) const { const size_t i = (size_t)r * DM + c; out[i] = x[i] + mod[(r / SEQ) * NMOD + 2048 + c] * v; } };
struct EpiLogits { float* LG;
    DEV void operator()(int r, int c, float v, float) const { LG[(size_t)r * NE + c] = v; } };
struct EpiAct { bf16_t* ACT;
    DEV void operator()(int r, int c, float v, float v2) const { ACT[(size_t)r * EFF + c] = f2bf(silu(v) * v2); } };
struct EpiSlab { bf16_t* SLAB; const int* rl; const float* w;
    DEV void operator()(int r, int c, float v, float) const { const int s = rl[r]; if (s >= 0) SLAB[(size_t)s * DM + c] = f2bf(v * w[s]); } };
struct EpiFinal { float* out; const bf16_t* SLAB; const float* mod;
    DEV void operator()(int r, int c, float v, float) const {
        float s = v;
#pragma unroll
        for (int k = 0; k < 8; ++k) s += bf2f(SLAB[((size_t)r * 8 + k) * DM + c]);
        const size_t i = (size_t)r * DM + c; out[i] = out[i] + mod[(r / SEQ) * NMOD + 5120 + c] * s; } };

DEV void ph_qknorm(const P& p, int bid, int nb) {
    const int tid_ = otid(); const int lane = tid_ & 63, wv = tid_ >> 6;
    const float gq = p.q_norm_g[lane], gk = p.k_norm_g[lane];
    const float invf = exp2f(-(float)(lane & 7) * (1.f / 8.f) * log2f(500000.f));
    for (int t = bid * NWV + wv; t < T; t += nb * NWV) {
        const float ang = (float)p.pos[t] * invf;
        const float cs = cosf(ang), sn = sinf(ang);
        bf16_t* ptr = p.QKV + (size_t)t * 2304 + lane;
        float v[24];
#pragma unroll
        for (int hh = 0; hh < 24; ++hh) v[hh] = bf2f(ptr[hh * 64]);
#pragma unroll
        for (int hh = 0; hh < 24; ++hh) {
            const float ss = wave_sum(v[hh] * v[hh]);
            float nv = v[hh] * rsqrtf(ss * (1.f / 64.f) + 1e-6f) * (hh < 12 ? gq : gk);
            const float partner = __shfl_xor(nv, 8);
            if (lane < 8) nv = nv * cs - partner * sn;
            else if (lane < 16) nv = nv * cs + partner * sn;
            ptr[hh * 64] = f2bf(nv);
        }
    }
}

template <int R>
DEV void pool_chunk(const unsigned* up, unsigned* op, int s0) {
    constexpr int W = 32 + 2 * R;
    float w0[W], w1[W];
#pragma unroll
    for (int i = 0; i < W; ++i) { const int q = s0 - R + i; const bool ok = (q >= 0) && (q < SEQ); const unsigned w = up[(size_t)min(max(q, 0), SEQ - 1) * 256];
        w0[i] = ok ? __uint_as_float(w << 16) : 0.f; w1[i] = ok ? __uint_as_float(w & 0xffff0000u) : 0.f; }
    float a0 = 0.f, a1 = 0.f;
#pragma unroll
    for (int i = 0; i < 2 * R + 1; ++i) { a0 += w0[i]; a1 += w1[i]; }
#pragma unroll
    for (int j = 0; j < 32; ++j) {
        const int s = s0 + j;
        const int lo = max(s - R, 0), hi = min(s + R, SEQ - 1);
        const float inv = 1.f / (float)(hi - lo + 1);
        op[(size_t)s * 384] = pk2(a0 * inv - w0[j + R], a1 * inv - w1[j + R]);
        if (j < 31) { a0 += w0[j + 2 * R + 1] - w0[j]; a1 += w1[j + 2 * R + 1] - w1[j]; }
    }
}
DEV void ph_pool(const P& p, int bid, int nb) {
    const int tid_ = otid();
    for (int i = bid * NTHR + tid_; i < NB * 64 * 256; i += nb * NTHR) {
        const int cp = i & 255, chunk = (i >> 8) & 63, b = i >> 14;
        const int g = cp >> 6;
        const unsigned* up = (const unsigned*)(p.U + (size_t)b * SEQ * 512) + cp;
        unsigned* op = (unsigned*)(p.PL + (size_t)b * SEQ * 768) + cp;
        const int s0 = chunk * 32;
        if (g == 0) pool_chunk<1>(up, op, s0); else if (g == 1) pool_chunk<2>(up, op, s0); else if (g == 2) pool_chunk<4>(up, op, s0); else pool_chunk<8>(up, op, s0);
    }
}

DEV void ph_attn(const P& p, int bid, int nb) {
    const int tid_ = otid(); const int lane = tid_ & 63, wv = tid_ >> 6;
    for (int it = bid * NWV + wv; it < T * 4; it += nb * NWV) {
        const int t = it >> 2, slot = it & 3;
        const int s = t & (SEQ - 1), base = t - s;
        float M = -1e30f, l = 0.f, acc = 0.f;
#pragma unroll
        for (int g = 0; g < 3; ++g) {
            const int dsh = 2 * g, d = 1 << dsh, L = SEQ >> dsh;
            const int h = 4 * g + slot;
            const int m = s >> dsh, r = s & (d - 1);
            const float q = bf2f(p.QKV[(size_t)t * 2304 + h * 64 + lane]);
            const bf16_t* kb = p.QKV + 768 + h * 64 + lane;
            const bf16_t* vb = p.QKV + 1536 + h * 64 + lane;
#pragma unroll 4
            for (int rel = -64; rel <= 64; ++rel) {
                const int mm = m + rel;
                const bool valid = (mm >= 0) && (mm < L);
                const int mc = valid ? mm : m;
                const size_t tr = (size_t)(base + mc * d + r) * 2304;
                const float kv = bf2f(kb[tr]), vv = bf2f(vb[tr]);
                const float sc = wave_sum(q * kv) * 0.125f;
                if (valid) {
                    const float mn = fmaxf(M, sc);
                    const float f = __expf(M - mn), pe = __expf(sc - mn);
                    l = l * f + pe; acc = acc * f + pe * vv; M = mn;
                }
            }
        }
        p.O[(size_t)t * 256 + slot * 64 + lane] = f2bf(acc / l);
    }
}

DEV void ph_route(const P& p, int* hist, int bid, int nb) {
    const int tid_ = otid(); const int lane = tid_ & 63, wv = tid_ >> 6;
    const int G = lane & 7, tl = lane >> 3;
    float bias[32];
#pragma unroll
    for (int j = 0; j < 8; ++j) { const float4 b4 = *(const float4*)(p.router_bias + G * 32 + 4 * j); bias[4 * j] = b4.x; bias[4 * j + 1] = b4.y; bias[4 * j + 2] = b4.z; bias[4 * j + 3] = b4.w; }
    for (int t0 = (bid * NWV + wv) * 8; t0 < T; t0 += nb * NWV * 8) {
        const int t = t0 + tl;
        float sc[32], v[32];
#pragma unroll
        for (int j = 0; j < 8; ++j) { const float4 lg = *(const float4*)(p.LG + (size_t)t * NE + G * 32 + 4 * j);
            sc[4 * j] = 1.f / (1.f + expf(-lg.x)); sc[4 * j + 1] = 1.f / (1.f + expf(-lg.y)); sc[4 * j + 2] = 1.f / (1.f + expf(-lg.z)); sc[4 * j + 3] = 1.f / (1.f + expf(-lg.w)); }
        float m1 = -INFINITY, m2 = -INFINITY;
#pragma unroll
        for (int j = 0; j < 32; ++j) { v[j] = sc[j] + bias[j]; const float n1 = fmaxf(m1, v[j]), n2 = fmaxf(fminf(m1, v[j]), m2); m1 = n1; m2 = n2; }
        const float gs = m1 + m2;
        int rank = 0;
#pragma unroll
        for (int g2 = 0; g2 < 8; ++g2) { const float o = __shfl(gs, (lane & 56) + g2); rank += ((o > gs) || (o == gs && g2 < G)) ? 1 : 0; }
        const bool gsel = rank < 4;
        int myidx = 0; float myw = 0.f, wsum = 0.f;
#pragma unroll 1
        for (int k = 0; k < 8; ++k) {
            float bv = -INFINITY, bs = 0.f; int bi = 0;
#pragma unroll
            for (int j = 0; j < 32; ++j) { const bool tk = gsel && (v[j] > bv); bv = tk ? v[j] : bv; bs = tk ? sc[j] : bs; bi = tk ? j : bi; }
            int gi = G * 32 + bi;
#pragma unroll
            for (int o = 1; o < 8; o <<= 1) {
                const float ov = __shfl_xor(bv, o), os = __shfl_xor(bs, o); const int oi = __shfl_xor(gi, o);
                if ((ov > bv) || (ov == bv && oi < gi)) { bv = ov; gi = oi; bs = os; }
            }
            const int wj = (gi >> 5) == G ? (gi & 31) : -1;
#pragma unroll
            for (int j = 0; j < 32; ++j) v[j] = (j == wj) ? -INFINITY : v[j];
            if (G == k) { myidx = gi; myw = bs; }
            wsum += bs;
        }
        __syncthreads();
        if (tid_ < NE) hist[tid_] = 0;
        __syncthreads();
        const int lpos = atomicAdd(&hist[myidx], 1);
        __syncthreads();
        if (tid_ < NE) { const int c_ = hist[tid_]; hist[NE + tid_] = c_ ? atomicAdd(&p.cnt[tid_ * 64], c_) : 0; }
        __syncthreads();
        const int slot = t * 8 + G;
        p.asg_e[slot] = myidx; p.asg_pos[slot] = hist[NE + myidx] + lpos; p.asg_w[slot] = myw / wsum * 2.5f;
    }
}

DEV void load_offsets(const int* cnt, int* off) {
    const int tid = otid();
    __syncthreads();
    if (tid < NE) { const int c_ = cnt[tid * 64]; off[300 + tid] = (c_ + 255) & ~255; off[600 + tid] = c_; }
    __syncthreads();
    if (tid == 0) { int a = 0; for (int e = 0; e < NE; ++e) { off[e] = a; a += off[300 + e]; } off[NE] = a;
        const int x = blockIdx.x & 7; int tf = 0, th = 0;
        for (int j = 0; j < 32; ++j) { const int n_ = off[600 + x + 8 * j], nt_ = (n_ + 255) >> 8, hh = (nt_ > 0 && n_ - (nt_ - 1) * 256 <= 128) ? 1 : 0;
            off[860 + j] = tf; off[900 + j] = th; tf += nt_ - hh; th += hh; }
        off[860 + 32] = tf; off[900 + 32] = th; }
    __syncthreads();
}
DEV int find_expert(const int* off, int m0) {
    int lo = 0, hi = NE;
    while (hi - lo > 1) { const int mid = (lo + hi) >> 1; if (off[mid] <= m0) lo = mid; else hi = mid; }
    return lo;
}

DEV void ph_scatter(const P& p, int* off, int bid, int nb) {
    load_offsets(p.cnt, off);
    const int tid_ = otid();
    for (int slot = bid * NTHR + tid_; slot < NSLOT; slot += nb * NTHR) { const int r = off[p.asg_e[slot]] + p.asg_pos[slot]; p.rowlist[r] = slot; p.roww[r] = p.asg_w[slot]; }
    for (int e = bid; e < NE; e += nb) {
        const int n = p.cnt[e * 64], pd = (n + 255) & ~255;
        for (int i = n + tid_; i < pd; i += NTHR) { p.rowlist[off[e] + i] = -1; p.roww[off[e] + i] = 0.f; }
    }
}

DEV void ph_expert1(const P& p, float* sm, int* off, int bid, int nb) {
    load_offsets(p.cnt, off);
    const int nrt = off[NE] / 128, nt = nrt * 4;
    for (int t = bid; t < nt; t += nb) {
        const int m0 = (t >> 2) * 128, n0 = (t & 3) * 64, e = find_expert(off, m0);
        ngemm_tile<true>(p.XB, DM, RowTok{p.rowlist}, p.w_eg + (size_t)e * DM * EFF, p.w_eu + (size_t)e * DM * EFF, EFF, m0, n0, DM, EpiAct{p.ACT}, sm);
    }
}
DEV void ph_expert2(const P& p, float* sm, int* off, int bid, int nb) {
    load_offsets(p.cnt, off);
    const int nrt = off[NE] / 128, nt = nrt * 16;
    for (int t = bid; t < nt; t += nb) {
        const int m0 = (t >> 4) * 128, n0 = (t & 15) * 64, e = find_expert(off, m0);
        ngemm_tile<false>(p.ACT, EFF, RowId(), p.w_ed + (size_t)e * EFF * DM, nullptr, DM, m0, n0, EFF, EpiSlab{p.SLAB, p.rowlist, p.asg_w}, sm);
    }
}

namespace mg {
constexpr int BM = 256, BK = 64, HALF = 128, HTB = HALF * BK * 2, STAGE_BYTES = 8 * HTB, NXCD = 8, WGM = 8;
__host__ __device__ __forceinline__ int lds_byte(int r, int c) { const int st = (r >> 4) * 2 + (c >> 5), rr = r & 15, cc = c & 31, ob = rr * 64 + cc * 2; return st * 1024 + (ob ^ (((ob >> 9) & 1) << 5)); }
__host__ __device__ __forceinline__ void stage_rc(int b, int& R, int& C) { const int st = b / 1024, sb = b % 1024, swz = sb ^ (((sb >> 9) & 1) << 5); R = (st >> 1) * 16 + swz / 64; C = (st & 1) * 32 + (swz % 64) / 2; }
__host__ __device__ __forceinline__ int perm32(int rho) { const int n = rho >> 4, i = rho & 15; return 8 * (i >> 2) + 4 * n + (i & 3); }

struct Unit { int pm, pn, e, pad, half, pad2; const char* A; const char* B; };

struct DenseOrder { static constexpr bool HAS_HALF = false;
    int nM, nN, nwg, G, c; const char* A; const char* B; size_t tstep;
    DEV void init(const bf16_t* A_, const bf16_t* B_, int M, int N, int K, int G_, int c_) { nM = M / BM; nN = N / BM; nwg = nM * nN; G = G_; c = c_; A = (const char*)A_; B = (const char*)B_; tstep = (size_t)BM * K * 2; }
    DEV bool next(int i, Unit& u) const {
        const long L = (long)i * G + c; if (L >= nwg) return false;
        int wgid = (int)L; { const int q = nwg / NXCD, r = nwg % NXCD, xcd = wgid % NXCD, off = wgid / NXCD; wgid = (xcd < r ? xcd * (q + 1) : r * (q + 1) + (xcd - r) * q) + off; }
        const int nig = WGM * nN, gid = wgid / nig, fm = gid * WGM, gsz = (nM - fm) < WGM ? (nM - fm) : WGM;
        u.pm = fm + ((wgid % nig) % gsz); u.pn = (wgid % nig) / gsz; u.e = 0; u.pad = 0; u.half = 0; u.pad2 = 0;
        u.A = A + (size_t)u.pm * tstep; u.B = B + (size_t)u.pn * tstep; return true;
    }
};
struct PairOrder { static constexpr bool HAS_HALF = false; DenseOrder D; int kt0, kt1;
    DEV bool next(int i, Unit& u) const { if (!D.next(i >> 1, u)) return false; const int part = i & 1; u.e = part; u.pad = part ? kt1 : kt0;
        if (part) { u.A += (size_t)kt0 * 128; u.B += (size_t)kt0 * 128; } return true; }
};
struct ExpertOrder { static constexpr bool HAS_HALF = true;
    const LAS int* off; int ncol, G, c; const char* A; const char* W; size_t wstride, tstepB, tstepA; bool gather; const int* rl; int maxu;
    DEV bool tile_of(int i, int& pm, int& pn, int& e) const {
        const int x = c & 7, cl = c >> 3, nbx = G >> 3;
        const int Lx = i * nbx + cl; int tx = Lx / ncol; pn = Lx % ncol;
        const int ftot = __builtin_amdgcn_readfirstlane(off[860 + 32]), htot = __builtin_amdgcn_readfirstlane(off[900 + 32]);
        if (tx >= ftot + htot) return false;
        const bool isf = tx < ftot; const int tb = isf ? 860 : 900; if (!isf) tx -= ftot;
        int lo = 0, hi = 32;
        while (hi - lo > 1) { const int mid = (lo + hi) >> 1; const int ov = __builtin_amdgcn_readfirstlane(off[tb + mid]); if (ov <= tx) lo = mid; else hi = mid; }
        e = x + 8 * lo;
        const int nfull = __builtin_amdgcn_readfirstlane(off[860 + lo + 1]) - __builtin_amdgcn_readfirstlane(off[860 + lo]);
        pm = (__builtin_amdgcn_readfirstlane(off[e]) >> 8) + (isf ? (tx - __builtin_amdgcn_readfirstlane(off[860 + lo])) : nfull);
        return true;
    }
    DEV bool next(int i, Unit& u) const {
        int pm, pn, e; if (!tile_of(i, pm, pn, e)) return false;
        u.pm = pm; u.pn = pn; u.e = e; u.pad = 0; u.pad2 = 0;
        u.half = (__builtin_amdgcn_readfirstlane(off[600 + e]) - (pm * BM - __builtin_amdgcn_readfirstlane(off[e])) <= HALF) ? 1 : 0;
        u.A = gather ? A : A + (size_t)pm * tstepA; u.B = W + (size_t)e * wstride + (size_t)pn * tstepB; return true;
    }
};

template <class Epi, class Sched, bool GATHER>
DEV void gemm_phase(LAS unsigned char* lds, const LAS unsigned* gtab, const int K, const Sched& S, const Epi& E) {
    const int tid = otid(), wid = __builtin_amdgcn_readfirstlane(tid >> 6), lane = tid & 63, wr = wid >> 2, wc = wid & 3, fr = lane & 15, fq = lane >> 4;
    const int nt = K / BK;
    int Rr[2], Cc[2]; unsigned voffB[2];
#pragma unroll
    for (int i = 0; i < 2; ++i) { stage_rc(tid * 16 + i * 8192, Rr[i], Cc[i]); const int Rb = Epi::PERM ? ((Rr[i] & ~31) + perm32(Rr[i] & 31)) : Rr[i]; voffB[i] = (unsigned)(Rb * K + Cc[i]) * 2u; }
    const size_t kstep = (size_t)(BK * 2);
    const size_t hstep = (size_t)HALF * K * 2;
    const unsigned ldsw = (unsigned)wid * 1024u;
    const int aoff = lds_byte(wr * 64 + fr, fq * 8), boff = lds_byte(wc * 32 + fr, fq * 8);
#define MG_SA(b, h) (((b) * 2 + (h)) * HTB)
#define MG_SB(b, h) ((4 + (b) * 2 + (h)) * HTB)
#define MG_STAGE(bufoff, gbase, voff) do { _Pragma("unroll") for (int _i = 0; _i < 2; ++_i) \
        __builtin_amdgcn_global_load_lds((const unsigned*)((const char*)(gbase) + (voff)[_i]), (LAS unsigned*)(lds + (bufoff) + ldsw + _i * 8192), 16, 0, 0); } while (0)
#define MG_LDA(dst, b, h) do { _Pragma("unroll") for (int m = 0; m < 4; ++m) _Pragma("unroll") for (int k = 0; k < 2; ++k) dst[m][k] = *(const LAS bf16x8*)(lds + MG_SA(b, h) + aoff + m * 2048 + k * 1024); } while (0)
#define MG_LDB(dst, b, h) do { _Pragma("unroll") for (int n = 0; n < 2; ++n) _Pragma("unroll") for (int k = 0; k < 2; ++k) dst[n][k] = *(const LAS bf16x8*)(lds + MG_SB(b, h) + boff + n * 2048 + k * 1024); } while (0)
#define MG_MMA(ai, bj, At, Bt) do { __builtin_amdgcn_s_setprio(1); _Pragma("unroll") for (int m = 0; m < 4; ++m) _Pragma("unroll") for (int n = 0; n < 2; ++n) _Pragma("unroll") for (int k = 0; k < 2; ++k) \
        acc[ai][bj][m][n] = __builtin_amdgcn_mfma_f32_16x16x32_bf16(Bt[n][k], At[m][k], acc[ai][bj][m][n], 0, 0, 0); __builtin_amdgcn_s_setprio(0); } while (0)
#define MG_WAIT_V(n) asm volatile("s_waitcnt vmcnt(" #n ")" ::: "memory")
#define MG_WAIT_L(n) asm volatile("s_waitcnt lgkmcnt(" #n ")" ::: "memory")
#define MG_BAR __builtin_amdgcn_s_barrier()
#define MG_SCHED __builtin_amdgcn_sched_barrier(0)
    Unit cur, nxt; int ui = 0;
    if (!S.next(0, cur)) return;
    int ntc = cur.pad > 0 ? cur.pad : nt;
    bool hf = Sched::HAS_HALF && (cur.half != 0);
    f32x4 acc[2][2][4][2];
#pragma unroll
    for (int a = 0; a < 2; ++a)
#pragma unroll
        for (int b = 0; b < 2; ++b)
#pragma unroll
            for (int m = 0; m < 4; ++m)
#pragma unroll
                for (int n = 0; n < 2; ++n) acc[a][b][m][n] = (f32x4){0.f, 0.f, 0.f, 0.f};
    bf16x8 At[4][2], B0[2][2], B1[2][2];
    unsigned va0[2], va1[2], na0[2], na1[2];
#pragma unroll
    for (int i = 0; i < 2; ++i) {
        if (GATHER) { va0[i] = gtab[Rr[i]] + (unsigned)Cc[i] * 2u; va1[i] = gtab[HALF + Rr[i]] + (unsigned)Cc[i] * 2u; }
        else { va0[i] = (unsigned)(Rr[i] * K + Cc[i]) * 2u; va1[i] = va0[i] + (unsigned)hstep; }
        na0[i] = va0[i]; na1[i] = va1[i];
    }
    const char* cA = cur.A; const char* cB = cur.B;
    MG_STAGE(MG_SB(0, 0), cB, voffB); MG_STAGE(MG_SB(0, 1), cB + hstep, voffB); MG_STAGE(MG_SA(0, 0), cA, va0); MG_STAGE(MG_SA(0, 1), cA, va1);
    if (wr == 1) MG_BAR;
    MG_WAIT_V(2); MG_BAR;
    MG_STAGE(MG_SB(1, 0), cB + kstep, voffB); MG_STAGE(MG_SA(1, 0), cA + kstep, va0); MG_STAGE(MG_SB(1, 1), cB + hstep + kstep, voffB);
    MG_WAIT_V(6); MG_BAR;
    for (;;) {
        const bool has_next = S.next(ui + 1, nxt);
        const char* nA = has_next ? nxt.A : cA; const char* nB = has_next ? nxt.B : cB;
        if constexpr (GATHER) {
            if (has_next) {
                if (ui + 1 < S.maxu) {
#pragma unroll
                    for (int i = 0; i < 2; ++i) { na0[i] = gtab[(ui + 1) * BM + Rr[i]] + (unsigned)Cc[i] * 2u; na1[i] = gtab[(ui + 1) * BM + HALF + Rr[i]] + (unsigned)Cc[i] * 2u; }
                } else {
#pragma unroll
                    for (int i = 0; i < 2; ++i) { const int s0_ = S.rl[nxt.pm * BM + Rr[i]], s1_ = S.rl[nxt.pm * BM + HALF + Rr[i]];
                        na0[i] = (unsigned)(s0_ < 0 ? 0 : (s0_ >> 3)) * (unsigned)(K * 2) + (unsigned)Cc[i] * 2u; na1[i] = (unsigned)(s1_ < 0 ? 0 : (s1_ >> 3)) * (unsigned)(K * 2) + (unsigned)Cc[i] * 2u; }
                }
            }
        }
#pragma unroll 1
        for (int t = 0; t < ntc; t += 2) {
            const bool last = (t == ntc - 2);
            const char* a1 = cA + (size_t)(t + 1) * kstep;
            const char* a2 = last ? nA : cA + (size_t)(t + 2) * kstep; const char* b2 = last ? nB : cB + (size_t)(t + 2) * kstep;
            const char* a3 = a2 + kstep; const char* b3 = b2 + kstep;
            unsigned o0[2], o1[2];
#pragma unroll
            for (int i = 0; i < 2; ++i) { o0[i] = (GATHER && last) ? na0[i] : va0[i]; o1[i] = (GATHER && last) ? na1[i] : va1[i]; }
            MG_LDB(B0, 0, 0); MG_LDB(B1, 0, 1); MG_SCHED; MG_LDA(At, 0, 0); MG_STAGE(MG_SA(1, 1), a1, va1);
            MG_WAIT_V(8); MG_WAIT_L(0); MG_BAR; MG_MMA(0, 0, At, B0); MG_MMA(0, 1, At, B1); MG_BAR; MG_SCHED;
            if (!hf) MG_LDA(At, 0, 1); MG_STAGE(MG_SB(0, 0), b2, voffB); MG_STAGE(MG_SB(0, 1), b2 + hstep, voffB); MG_STAGE(MG_SA(0, 0), a2, o0);
            MG_WAIT_V(8); MG_WAIT_L(0); MG_BAR; if (!hf) { MG_MMA(1, 0, At, B0); MG_MMA(1, 1, At, B1); } MG_BAR; MG_SCHED;
            MG_LDB(B0, 1, 0); MG_LDB(B1, 1, 1); MG_SCHED; MG_LDA(At, 1, 0); MG_STAGE(MG_SA(0, 1), a2, o1);
            MG_WAIT_V(8); MG_WAIT_L(0); MG_BAR; MG_MMA(0, 0, At, B0); MG_MMA(0, 1, At, B1); MG_BAR; MG_SCHED;
            if (!hf) MG_LDA(At, 1, 1); MG_STAGE(MG_SB(1, 0), b3, voffB); MG_STAGE(MG_SB(1, 1), b3 + hstep, voffB); MG_STAGE(MG_SA(1, 0), a3, o0);
            MG_WAIT_V(8); MG_WAIT_L(0); MG_BAR; if (!hf) { MG_MMA(1, 0, At, B0); MG_MMA(1, 1, At, B1); } MG_BAR; MG_SCHED;
        }
        if (wr == 0) MG_BAR;
        E(acc, cur, wr, wc, fr, fq);
        if (!has_next) break;
        if (!(Epi::KEEP_ACC && cur.e == 0)) {
#pragma unroll
        for (int a = 0; a < 2; ++a)
#pragma unroll
            for (int b = 0; b < 2; ++b)
#pragma unroll
                for (int m = 0; m < 4; ++m)
#pragma unroll
                    for (int n = 0; n < 2; ++n) acc[a][b][m][n] = (f32x4){0.f, 0.f, 0.f, 0.f};
        }
        cur = nxt; cA = nA; cB = nB; ++ui; ntc = cur.pad > 0 ? cur.pad : nt; hf = Sched::HAS_HALF && (cur.half != 0);
#pragma unroll
        for (int i = 0; i < 2; ++i) { va0[i] = na0[i]; va1[i] = na1[i]; }
        if (wr == 1) MG_BAR;
    }
    MG_WAIT_V(0);
    MG_BAR;
    __syncthreads();
#undef MG_SA
#undef MG_SB
#undef MG_STAGE
#undef MG_LDA
#undef MG_LDB
#undef MG_MMA
#undef MG_WAIT_V
#undef MG_WAIT_L
#undef MG_BAR
#undef MG_SCHED
}

DEV u32x4 pack8(const f32x4 a, const f32x4 b) { u32x4 w; w.x = pk2(a[0], a[1]); w.y = pk2(a[2], a[3]); w.z = pk2(b[0], b[1]); w.w = pk2(b[2], b[3]); return w; }
DEV f32x4 unpack_lo(const u32x4 w) { return (f32x4){__uint_as_float(w.x << 16), __uint_as_float(w.x & 0xffff0000u), __uint_as_float(w.y << 16), __uint_as_float(w.y & 0xffff0000u)}; }
DEV f32x4 unpack_hi(const u32x4 w) { return (f32x4){__uint_as_float(w.z << 16), __uint_as_float(w.z & 0xffff0000u), __uint_as_float(w.w << 16), __uint_as_float(w.w & 0xffff0000u)}; }
DEV f32x4 sig4(const f32x4 v) { return (f32x4){sigm(v[0]), sigm(v[1]), sigm(v[2]), sigm(v[3])}; }
DEV f32x4 silu4(const f32x4 v) { return (f32x4){silu(v[0]), silu(v[1]), silu(v[2]), silu(v[3])}; }
#define ACC_T f32x4 (&acc)[2][2][4][2]

struct MEpiInProj { static constexpr bool PERM = true; static constexpr bool KEEP_ACC = false; bf16_t *U, *QKV, *G;
    DEV void operator()(ACC_T, const Unit& u, int wr, int wc, int fr, int fq) const {
        int colt = u.pn * BM; bf16_t* base; int ld; bool sg = false;
        if (colt < 512) { base = U; ld = 512; } else if (colt < 2816) { base = QKV; ld = 2304; colt -= 512; } else { base = G; ld = 2048; colt -= 2816; sg = true; }
        const int row0 = u.pm * BM + wr * 64 + fr, col0 = colt + wc * 32 + 8 * fq;
#pragma unroll
        for (int ai = 0; ai < 2; ++ai)
#pragma unroll
            for (int m = 0; m < 4; ++m) { bf16_t* rowp = base + (size_t)(row0 + ai * HALF + m * 16) * ld + col0;
#pragma unroll
                for (int bj = 0; bj < 2; ++bj) { f32x4 v0 = acc[ai][bj][m][0], v1 = acc[ai][bj][m][1]; if (sg) { v0 = sig4(v0); v1 = sig4(v1); }
                    *(u32x4*)(rowp + bj * HALF) = pack8(v0, v1); }
                asm volatile("" ::: "memory"); }
    } };
struct MEpiMergeF { static constexpr bool PERM = true; static constexpr bool KEEP_ACC = true; bf16_t* MG; const bf16_t* G;
    DEV void mid(f32x4 (&acc)[2][2][4][2], const Unit& u, int wr, int wc, int fr, int fq) const {
        const int row0 = u.pm * BM + wr * 64 + fr, col0 = u.pn * BM + wc * 32 + 8 * fq;
#pragma unroll
        for (int ai = 0; ai < 2; ++ai)
#pragma unroll
            for (int m = 0; m < 4; ++m) { const bf16_t* gr = G + (size_t)(row0 + ai * HALF + m * 16) * 2048 + col0;
#pragma unroll
                for (int bj = 0; bj < 2; ++bj)
#pragma unroll
                    for (int n = 0; n < 2; ++n) { const u32x2 gp = *(const u32x2*)(gr + bj * HALF + 4 * n), ga = *(const u32x2*)(gr + 1024 + bj * HALF + 4 * n);
                        acc[ai][bj][m][n] *= (f32x4){__uint_as_float(gp.x << 16) * __builtin_amdgcn_rcpf(__uint_as_float(ga.x << 16)), __uint_as_float(gp.x & 0xffff0000u) * __builtin_amdgcn_rcpf(__uint_as_float(ga.x & 0xffff0000u)),
                                                     __uint_as_float(gp.y << 16) * __builtin_amdgcn_rcpf(__uint_as_float(ga.y << 16)), __uint_as_float(gp.y & 0xffff0000u) * __builtin_amdgcn_rcpf(__uint_as_float(ga.y & 0xffff0000u))};
                        asm volatile("" ::: "memory"); } }
    }
    DEV void operator()(f32x4 (&acc)[2][2][4][2], const Unit& u, int wr, int wc, int fr, int fq) const {
        if (u.e == 0) { mid(acc, u, wr, wc, fr, fq); return; }
        const int row0 = u.pm * BM + wr * 64 + fr, col0 = u.pn * BM + wc * 32 + 8 * fq;
#pragma unroll
        for (int ai = 0; ai < 2; ++ai)
#pragma unroll
            for (int m = 0; m < 4; ++m) { const size_t r = (size_t)(row0 + ai * HALF + m * 16);
#pragma unroll
                for (int bj = 0; bj < 2; ++bj) { const int c = col0 + bj * HALF;
                    const u32x4 ga = *(const u32x4*)(G + r * 2048 + 1024 + c);
                    *(u32x4*)(MG + r * DM + c) = pack8(acc[ai][bj][m][0] * unpack_lo(ga), acc[ai][bj][m][1] * unpack_hi(ga)); }
                asm volatile("" ::: "memory"); }
    } };
struct MEpiOutProj { static constexpr bool PERM = false; static constexpr bool KEEP_ACC = false; const float* x; float* out; const float* mod;
    DEV void operator()(ACC_T, const Unit& u, int wr, int wc, int fr, int fq) const {
        const int row0 = u.pm * BM + wr * 64 + fr, col0 = u.pn * BM + wc * 32 + 4 * fq;
        const float* gm = mod + ((u.pm * BM) / SEQ) * NMOD + 2048;
#pragma unroll
        for (int ai = 0; ai < 2; ++ai)
#pragma unroll
            for (int m = 0; m < 4; ++m) { const size_t r = (size_t)(row0 + ai * HALF + m * 16) * DM;
#pragma unroll
                for (int bj = 0; bj < 2; ++bj)
#pragma unroll
                    for (int n = 0; n < 2; ++n) { const int c = col0 + bj * HALF + n * 16;
                        *(f32x4*)(out + r + c) = *(const f32x4*)(x + r + c) + *(const f32x4*)(gm + c) * acc[ai][bj][m][n]; }
                asm volatile("" ::: "memory"); }
    } };
struct MEpiRouterShared { static constexpr bool PERM = true; static constexpr bool KEEP_ACC = false; float* LG; bf16_t* HS;
    DEV void operator()(ACC_T, const Unit& u, int wr, int wc, int fr, int fq) const {
        const int row0 = u.pm * BM + wr * 64 + fr, cw = wc * 32 + 8 * fq;
#pragma unroll
        for (int ai = 0; ai < 2; ++ai)
#pragma unroll
            for (int m = 0; m < 4; ++m) { const size_t r = (size_t)(row0 + ai * HALF + m * 16);
                if (u.pn == 0) {
#pragma unroll
                    for (int bj = 0; bj < 2; ++bj)
#pragma unroll
                        for (int n = 0; n < 2; ++n) *(f32x4*)(LG + r * NE + bj * HALF + cw + 4 * n) = acc[ai][bj][m][n];
                } else {
                    const f32x4 v0 = silu4(acc[ai][0][m][0]) * acc[ai][1][m][0], v1 = silu4(acc[ai][0][m][1]) * acc[ai][1][m][1];
                    *(u32x4*)(HS + r * EFF + (u.pn - 1) * HALF + cw) = pack8(v0, v1);
                }
                asm volatile("" ::: "memory"); }
    } };
struct MEpiAct { static constexpr bool PERM = true; static constexpr bool KEEP_ACC = false; bf16_t* ACT;
    DEV void operator()(ACC_T, const Unit& u, int wr, int wc, int fr, int fq) const {
        const int row0 = u.pm * BM + wr * 64 + fr, cw = u.pn * HALF + wc * 32 + 8 * fq;
#pragma unroll
        for (int ai = 0; ai < 2; ++ai) { if (ai == 1 && u.half) break;
#pragma unroll
            for (int m = 0; m < 4; ++m) { const size_t r = (size_t)(row0 + ai * HALF + m * 16);
                const f32x4 v0 = silu4(acc[ai][0][m][0]) * acc[ai][1][m][0], v1 = silu4(acc[ai][0][m][1]) * acc[ai][1][m][1];
                *(u32x4*)(ACT + r * EFF + cw) = pack8(v0, v1); asm volatile("" ::: "memory"); } }
    } };
constexpr float SLAB_SCALE = 8.f, SLAB_INV = 0.125f;
DEV unsigned pk4_fp8(float a, float b, float c, float d) {
    a = fminf(fmaxf(a, -440.f), 440.f); b = fminf(fmaxf(b, -440.f), 440.f); c = fminf(fmaxf(c, -440.f), 440.f); d = fminf(fmaxf(d, -440.f), 440.f);
    int w = 0; w = __builtin_amdgcn_cvt_pk_fp8_f32(a, b, w, false); w = __builtin_amdgcn_cvt_pk_fp8_f32(c, d, w, true); return (unsigned)w; }
struct MEpiSlab { static constexpr bool PERM = true; static constexpr bool KEEP_ACC = false; unsigned char* SLAB; const int* rl; const float* w;
    DEV void operator()(ACC_T, const Unit& u, int wr, int wc, int fr, int fq) const {
        const int row0 = u.pm * BM + wr * 64 + fr, c16 = u.pn * BM + wc * 64 + 16 * fq;
#pragma unroll
        for (int ai = 0; ai < 2; ++ai) { if (ai == 1 && u.half) break;
#pragma unroll
            for (int m = 0; m < 4; ++m) { const int s = rl[row0 + ai * HALF + m * 16]; const float g = w[row0 + ai * HALF + m * 16] * SLAB_SCALE;
                if (s >= 0) { u32x4 o;
                    { const f32x4 a = acc[ai][0][m][0] * g, b = acc[ai][0][m][1] * g; o.x = pk4_fp8(a[0], a[1], a[2], a[3]); o.y = pk4_fp8(b[0], b[1], b[2], b[3]); }
                    { const f32x4 a = acc[ai][1][m][0] * g, b = acc[ai][1][m][1] * g; o.z = pk4_fp8(a[0], a[1], a[2], a[3]); o.w = pk4_fp8(b[0], b[1], b[2], b[3]); }
                    *(u32x4*)(SLAB + (size_t)s * DM + c16) = o; }
                asm volatile("" ::: "memory"); } }
    } };
DEV void acc4_fp8(f32x4& a, unsigned w) { const auto lo = __builtin_amdgcn_cvt_pk_f32_fp8((int)w, false), hi = __builtin_amdgcn_cvt_pk_f32_fp8((int)w, true); a[0] += lo[0]; a[1] += lo[1]; a[2] += hi[0]; a[3] += hi[1]; }
struct MEpiFinal { static constexpr bool PERM = true; static constexpr bool KEEP_ACC = false; float* out; const unsigned char* SLAB; const float* mod;
    DEV void operator()(ACC_T, const Unit& u, int wr, int wc, int fr, int fq) const {
        const int row0 = u.pm * BM + wr * 64 + fr, c16 = u.pn * BM + wc * 64 + 16 * fq;
        const float* gm = mod + ((u.pm * BM) / SEQ) * NMOD + 5120 + c16;
#pragma unroll
        for (int ai = 0; ai < 2; ++ai)
#pragma unroll
            for (int m = 0; m < 4; ++m) { const size_t row = (size_t)(row0 + ai * HALF + m * 16);
                const unsigned char* sp = SLAB + row * 8 * DM + c16;
                float* op = out + row * DM + c16;
                u32x4 sw[8]; f32x4 x[4];
#pragma unroll
                for (int k = 0; k < 8; ++k) sw[k] = *(const u32x4*)(sp + (size_t)k * DM);
#pragma unroll
                for (int q = 0; q < 4; ++q) x[q] = *(const f32x4*)(op + 4 * q);
                f32x4 s4[4];
#pragma unroll
                for (int q = 0; q < 4; ++q) s4[q] = (f32x4){0.f, 0.f, 0.f, 0.f};
#pragma unroll
                for (int k = 0; k < 8; ++k) { acc4_fp8(s4[0], sw[k].x); acc4_fp8(s4[1], sw[k].y); acc4_fp8(s4[2], sw[k].z); acc4_fp8(s4[3], sw[k].w); }
                s4[0] = s4[0] * SLAB_INV + acc[ai][0][m][0]; s4[1] = s4[1] * SLAB_INV + acc[ai][0][m][1]; s4[2] = s4[2] * SLAB_INV + acc[ai][1][m][0]; s4[3] = s4[3] * SLAB_INV + acc[ai][1][m][1];
#pragma unroll
                for (int q = 0; q < 4; ++q) *(f32x4*)(op + 4 * q) = x[q] + *(const f32x4*)(gm + 4 * q) * s4[q];
                asm volatile("" ::: "memory"); }
    } };
#undef ACC_T
}

typedef float f32x16 __attribute__((ext_vector_type(16)));
typedef short s16x4 __attribute__((ext_vector_type(4)));
DEV int crow(int r, int hi) { return (r & 3) + 8 * (r >> 2) + 4 * hi; }
DEV unsigned cvtpk(float lo, float hi) { unsigned r; asm("v_cvt_pk_bf16_f32 %0, %1, %2" : "=v"(r) : "v"(lo), "v"(hi)); return r; }
DEV s16x4 vtr(const LAS unsigned char* p) { return __builtin_bit_cast(s16x4, __builtin_amdgcn_ds_read_tr16_b64_v4i16((LAS s16x4*)p)); }
DEV float swap32(float v) { return __shfl_xor(v, 32); }

DEV void normrope_frag(bf16x8 (&f)[4], const LAS float* gt, int hi, float posf) {
    float x[32]; float ss = 0.f;
#pragma unroll
    for (int d0 = 0; d0 < 4; ++d0) { const u32x4 w = __builtin_bit_cast(u32x4, f[d0]);
        x[8 * d0 + 0] = __uint_as_float(w.x << 16); x[8 * d0 + 1] = __uint_as_float(w.x & 0xffff0000u); x[8 * d0 + 2] = __uint_as_float(w.y << 16); x[8 * d0 + 3] = __uint_as_float(w.y & 0xffff0000u);
        x[8 * d0 + 4] = __uint_as_float(w.z << 16); x[8 * d0 + 5] = __uint_as_float(w.z & 0xffff0000u); x[8 * d0 + 6] = __uint_as_float(w.w << 16); x[8 * d0 + 7] = __uint_as_float(w.w & 0xffff0000u); }
#pragma unroll
    for (int i = 0; i < 32; ++i) ss += x[i] * x[i];
    ss += __shfl_xor(ss, 32);
    const float rs = rsqrtf(ss * (1.f / 64.f) + 1e-6f);
#pragma unroll
    for (int d0 = 0; d0 < 4; ++d0) { const f32x4 g0 = *(const LAS f32x4*)(gt + 16 * d0 + 8 * hi), g1 = *(const LAS f32x4*)(gt + 16 * d0 + 8 * hi + 4);
#pragma unroll
        for (int j = 0; j < 4; ++j) { x[8 * d0 + j] *= rs * g0[j]; x[8 * d0 + 4 + j] *= rs * g1[j]; } }
    constexpr float INVF[8] = {1.0f, 0.19392274474868576f, 0.03760603093086393f, 0.007292664737217109f, 0.001414213562373095f, 0.0002742481756762073f, 5.318295896944988e-05f, 1.031338537721246e-05f};
#pragma unroll
    for (int i = 0; i < 8; ++i) {
        const float rev = posf * (INVF[i] * 0.15915494309189535f);
        const float fr = rev - floorf(rev);
        const float cs = __builtin_amdgcn_cosf(fr), sn = __builtin_amdgcn_sinf(fr);
        const float partner = __shfl_xor(x[i], 32);
        x[i] = hi ? (x[i] * cs + partner * sn) : (x[i] * cs - partner * sn);
    }
#pragma unroll
    for (int d0 = 0; d0 < 4; ++d0) { u32x4 w; w.x = cvtpk(x[8 * d0], x[8 * d0 + 1]); w.y = cvtpk(x[8 * d0 + 2], x[8 * d0 + 3]); w.z = cvtpk(x[8 * d0 + 4], x[8 * d0 + 5]); w.w = cvtpk(x[8 * d0 + 6], x[8 * d0 + 7]);
        f[d0] = __builtin_bit_cast(bf16x8, w); }
}

DEV void ph_attn_mfma(const P& p, LAS unsigned char* lds, int bid, int nb) {
    const int tid = otid(); const int lane = tid & 63, wid = __builtin_amdgcn_readfirstlane(tid >> 6), r32 = lane & 31, hi = lane >> 5;
    LAS unsigned char* vl = lds + wid * 16384;
    LAS float* wsf = (LAS float*)(lds + wid * 16384 + 4096);
    LAS float* gtab_q = (LAS float*)(lds + wid * 16384 + 4352);
    LAS bf16_t* ost = (LAS bf16_t*)(lds + wid * 16384 + 8192);
    LAS float* gtab_k = gtab_q + 64;
    gtab_q[lane] = p.q_norm_g[lane]; gtab_k[lane] = p.k_norm_g[lane];
    asm volatile("s_waitcnt lgkmcnt(0)" ::: "memory");
    float gq = fabsf(p.q_norm_g[lane]), gk = fabsf(p.k_norm_g[lane]);
#pragma unroll
    for (int o = 32; o >= 1; o >>= 1) { gq = fmaxf(gq, __shfl_xor(gq, o)); gk = fmaxf(gk, __shfl_xor(gk, o)); }
    constexpr float LOG2E = 1.4426950408889634f, C2 = 0.125f * LOG2E;
    const float nmref = -(8.f * gq * gk * LOG2E);
    const int head = wid & 3, par = wid >> 2;
    const int tq = (lane & 15) >> 2, tp = lane & 3, tcb = (lane >> 4) & 1;
    const LAS unsigned char* vrd = vl + (4 * hi + tq) * 128 + (16 * tcb + 4 * tp) * 2;
    for (int it2 = bid; it2 < NB * 48; it2 += nb) {
        const int it = it2 * 2 + par;
        const int cb = it & 31, g = (it >> 5) % 3, b = it / 96;
        const int dsh = 2 * g, d = 1 << dsh, L = SEQ >> dsh, nbk = L >> 6;
        const int r = cb / nbk, blk = cb % nbk;
        const int h = 4 * g + head, base = b * SEQ;
        const int q0 = 64 * blk;
        const int mqa = q0 + r32, mqb = q0 + 32 + r32;
        bf16x8 qa[4], qb[4];
        { const bf16_t* qp = p.QKV + (size_t)(base + mqa * d + r) * 2304 + h * 64 + hi * 8;
#pragma unroll
          for (int d0 = 0; d0 < 4; ++d0) qa[d0] = *(const bf16x8*)(qp + d0 * 16);
          const bf16_t* qp2 = p.QKV + (size_t)(base + mqb * d + r) * 2304 + h * 64 + hi * 8;
#pragma unroll
          for (int d0 = 0; d0 < 4; ++d0) qb[d0] = *(const bf16x8*)(qp2 + d0 * 16); }
        const float pqa = (float)p.pos[base + mqa * d + r], pqb = (float)p.pos[base + mqb * d + r];
        normrope_frag(qa, gtab_q, hi, pqa); normrope_frag(qb, gtab_q, hi, pqb);
        f32x16 oa0, oa1, ob0, ob1;
#pragma unroll
        for (int i = 0; i < 16; ++i) { oa0[i] = 0.f; oa1[i] = 0.f; ob0[i] = 0.f; ob1[i] = 0.f; }
        float lsa = 0.f, lsb = 0.f;
        const int kb0 = q0 - 64;
#pragma unroll 1
        for (int st = 0; st < 6; ++st) {
            const int k0 = kb0 + 32 * st;
            if (k0 + 31 < 0 || k0 >= L) continue;
            const int mkc = min(max(k0 + r32, 0), L - 1);
            const bf16_t* kp = p.QKV + (size_t)(base + mkc * d + r) * 2304 + 768 + h * 64 + hi * 8;
            bf16x8 kf[4];
#pragma unroll
            for (int d0 = 0; d0 < 4; ++d0) kf[d0] = *(const bf16x8*)(kp + d0 * 16);
            const float kposf = (float)p.pos[base + mkc * d + r];
            u32x4 vreg[4];
#pragma unroll
            for (int i = 0; i < 4; ++i) { const int c = lane + 64 * i, row = c >> 3, ch = c & 7; const int mv = min(max(k0 + row, 0), L - 1);
                vreg[i] = *(const u32x4*)(p.QKV + (size_t)(base + mv * d + r) * 2304 + 1536 + h * 64 + ch * 8); }
            normrope_frag(kf, gtab_k, hi, kposf);
            const bool doa = st < 5, dob = st > 0;
            bf16x8 pa0, pa1, pb0, pb1;
#define ATT_SCORES(QR, MQ, LS, PF0, PF1) do { f32x16 s_; _Pragma("unroll") for (int i = 0; i < 16; ++i) s_[i] = 0.f; \
                _Pragma("unroll") for (int d0 = 0; d0 < 4; ++d0) s_ = __builtin_amdgcn_mfma_f32_32x32x16_bf16(kf[d0], QR[d0], s_, 0, 0, 0); \
                _Pragma("unroll") for (int i = 0; i < 16; ++i) { const int key = k0 + crow(i, hi); const int df = key - (MQ); \
                    const bool valid = (key >= 0) && (key < L) && (df <= 64) && (df >= -64); \
                    const float pv = valid ? __builtin_amdgcn_exp2f(__builtin_fmaf(s_[i], C2, nmref)) : 0.f; LS += pv; s_[i] = pv; } \
                u32x4 w0, w1; w0.x = cvtpk(s_[0], s_[1]); w0.y = cvtpk(s_[2], s_[3]); w0.z = cvtpk(s_[4], s_[5]); w0.w = cvtpk(s_[6], s_[7]); \
                w1.x = cvtpk(s_[8], s_[9]); w1.y = cvtpk(s_[10], s_[11]); w1.z = cvtpk(s_[12], s_[13]); w1.w = cvtpk(s_[14], s_[15]); \
                PF0 = __builtin_bit_cast(bf16x8, w0); PF1 = __builtin_bit_cast(bf16x8, w1); } while (0)
            if (doa) ATT_SCORES(qa, mqa, lsa, pa0, pa1);
            if (dob) ATT_SCORES(qb, mqb, lsb, pb0, pb1);
#undef ATT_SCORES
#pragma unroll
            for (int i = 0; i < 4; ++i) { const int c = lane + 64 * i, row = c >> 3, ch = c & 7; *(LAS u32x4*)(vl + row * 128 + ch * 16) = vreg[i]; }
            asm volatile("s_waitcnt lgkmcnt(0)" ::: "memory");
#pragma unroll
            for (int n = 0; n < 2; ++n)
#pragma unroll
                for (int ks = 0; ks < 2; ++ks) {
                    const s16x4 lo = vtr(vrd + (16 * ks) * 128 + 64 * n), hi4 = vtr(vrd + (16 * ks + 8) * 128 + 64 * n);
                    bf16x8 vf; vf[0] = lo[0]; vf[1] = lo[1]; vf[2] = lo[2]; vf[3] = lo[3]; vf[4] = hi4[0]; vf[5] = hi4[1]; vf[6] = hi4[2]; vf[7] = hi4[3];
                    if (doa) { if (n == 0) oa0 = __builtin_amdgcn_mfma_f32_32x32x16_bf16(ks == 0 ? pa0 : pa1, vf, oa0, 0, 0, 0);
                               else oa1 = __builtin_amdgcn_mfma_f32_32x32x16_bf16(ks == 0 ? pa0 : pa1, vf, oa1, 0, 0, 0); }
                    if (dob) { if (n == 0) ob0 = __builtin_amdgcn_mfma_f32_32x32x16_bf16(ks == 0 ? pb0 : pb1, vf, ob0, 0, 0, 0);
                               else ob1 = __builtin_amdgcn_mfma_f32_32x32x16_bf16(ks == 0 ? pb0 : pb1, vf, ob1, 0, 0, 0); }
                }
            asm volatile("s_waitcnt lgkmcnt(0)" ::: "memory");
        }
        const float lta = lsa + swap32(lsa), ltb = lsb + swap32(lsb);
        if (hi == 0) { wsf[r32] = 1.f / lta; wsf[32 + r32] = 1.f / ltb;
            p.LSUM[((size_t)g * T + (base + mqa * d + r)) * 4 + head] = lta; p.LSUM[((size_t)g * T + (base + mqb * d + r)) * 4 + head] = ltb; }
        asm volatile("s_waitcnt lgkmcnt(0)" ::: "memory");
        LAS bf16_t* ob_ = ost + 4 * hi * 64 + r32;
#pragma unroll
        for (int i = 0; i < 16; ++i) { const int qc = (i & 3) + 8 * (i >> 2); const float ia = wsf[4 * hi + qc];
            ob_[qc * 64] = f2bf(oa0[i] * ia); ob_[qc * 64 + 32] = f2bf(oa1[i] * ia); }
        asm volatile("" ::: "memory");
#pragma unroll
        for (int i = 0; i < 16; ++i) { const int qc = (i & 3) + 8 * (i >> 2); const float ib = wsf[32 + 4 * hi + qc];
            ob_[(32 + qc) * 64] = f2bf(ob0[i] * ib); ob_[(32 + qc) * 64 + 32] = f2bf(ob1[i] * ib); }
        asm volatile("s_waitcnt lgkmcnt(0)" ::: "memory");
        bf16_t* og = p.OG + (size_t)g * T * 256 + head * 64;
#pragma unroll
        for (int i = 0; i < 8; ++i) { const int c = lane + 64 * i, qrow = c >> 3, ch = c & 7;
            const u32x4 w = *(const LAS u32x4*)(ost + qrow * 64 + ch * 8);
            *(u32x4*)(og + (size_t)(base + (q0 + qrow) * d + r) * 256 + ch * 8) = w; }
        asm volatile("s_waitcnt lgkmcnt(0)" ::: "memory");
    }
}
DEV void ph_attn_combine(const P& p, int bid, int nb) {
    const int tid_ = otid();
    for (int i = bid * NTHR + tid_; i < T * 32; i += nb * NTHR) {
        const int t = i >> 5, ch = i & 31, slot = ch >> 3;
        const float l0 = p.LSUM[(size_t)t * 4 + slot], l1 = p.LSUM[((size_t)T + t) * 4 + slot], l2 = p.LSUM[((size_t)2 * T + t) * 4 + slot];
        const float inv = 1.f / (l0 + l1 + l2);
        const u32x4 a = *(const u32x4*)(p.OG + (size_t)t * 256 + ch * 8), b = *(const u32x4*)(p.OG + ((size_t)T + t) * 256 + ch * 8), c = *(const u32x4*)(p.OG + ((size_t)2 * T + t) * 256 + ch * 8);
        const f32x4 lo = (mg::unpack_lo(a) * l0 + mg::unpack_lo(b) * l1 + mg::unpack_lo(c) * l2) * inv;
        const f32x4 hi = (mg::unpack_hi(a) * l0 + mg::unpack_hi(b) * l1 + mg::unpack_hi(c) * l2) * inv;
        *(u32x4*)(p.PL + (size_t)t * 768 + 512 + ch * 8) = mg::pack8(lo, hi);
    }
}

template <class Src>
DEV void transpose_blk(const Src& src, int K, bf16_t* WT0, LAS float* scr, int k0, int lane) {
#pragma unroll 8
    for (int i = 0; i < 32; ++i) { const int kk = 2 * i + (lane >> 5); scr[kk * 33 + (lane & 31)] = src(k0 + kk, lane & 31); }
    asm volatile("s_waitcnt lgkmcnt(0)" ::: "memory");
    const int c = lane & 7;
#pragma unroll
    for (int j = 0; j < 4; ++j) { const int n = (lane >> 3) + 8 * j; const LAS float* s = scr + (8 * c) * 33 + n;
        u32x4 o; o.x = pk2(s[0 * 33], s[1 * 33]); o.y = pk2(s[2 * 33], s[3 * 33]); o.z = pk2(s[4 * 33], s[5 * 33]); o.w = pk2(s[6 * 33], s[7 * 33]);
        *(u32x4*)(WT0 + (size_t)n * K + k0 + 8 * c) = o; }
    asm volatile("s_waitcnt lgkmcnt(0)" ::: "memory");
}
struct SrcCol { const float* W; int ld; DEV float operator()(int k, int j) const { return W[(size_t)k * ld + j]; } };
struct SrcEff { const float *wg, *ls, *wu;
    DEV float operator()(int k, int j) const { const int g = k >> 7; const float* a = wg + (size_t)k * 128; const float* l = ls + g * 128; const float* b = wu + (size_t)(g * 128) * DM + j; float s = 0.f;
#pragma unroll 4
        for (int d = 0; d < 128; ++d) s += a[d] * l[d] * b[(size_t)d * DM]; return s; } };
DEV void tr_plain(const float* W, int K, int N, bf16_t* WT, LAS float* scr, int item, int lane) {
    const int nblk = N / 32, k0 = 64 * (item / nblk), n0 = 32 * (item % nblk);
    transpose_blk(SrcCol{W + n0, N}, K, WT + (size_t)n0 * K, scr, k0, lane);
}
DEV void tr_perm16(const float* W, int K, int N, bf16_t* WT, LAS float* scr, int item, int lane) {
    const int nblk = N / 32, k0 = 64 * (item / nblk), rho0 = 32 * (item % nblk);
    const int tile = rho0 >> 8, bj = (rho0 >> 7) & 1, wc = (rho0 >> 5) & 3;
    const int n0 = tile * 256 + 64 * wc + 8 * bj;
    struct SrcP { const float* W; int ld; DEV float operator()(int k, int dr) const { return W[(size_t)k * ld + 16 * (dr >> 3) + (dr & 7)]; } };
    transpose_blk(SrcP{W + n0, N}, K, WT + (size_t)rho0 * K, scr, k0, lane);
}
DEV void tr_gu(const float* g, const float* u, int K, bf16_t* WT, LAS float* scr, int k0, int rho0, int lane) {
    const int ch0 = (rho0 >> 8) * 128 + (rho0 & 127);
    const float* m = (rho0 & 128) ? u : g;
    transpose_blk(SrcCol{m + ch0, EFF}, K, WT + (size_t)rho0 * K, scr, k0, lane);
}

DEV void ph_prep_small(const P& p, LAS float* scr, int gw, int ngw, int lane) {
    constexpr int I_IN = 16 * (INW / 32), I_EFF = 64 * 16, I_AU = 4 * 32, I_OUT = 16 * 32, I_R = 16 * 8, I_S = 16 * 16, I_SD = 4 * 32;
    constexpr int NIT = I_IN + I_EFF + I_AU + I_OUT + I_R + I_S + I_SD;
    for (int it = gw; it < NIT; it += ngw) {
        int r = it;
        if (r < I_IN) { tr_plain(p.w_in, DM, INW, p.WT_IN, scr, r, lane); continue; } r -= I_IN;
        if (r < I_EFF) {
            const int n = 64 * (r & 15) + lane, k0 = 8 * (r >> 4), g = k0 >> 7;
            const float* a = p.pool_w_grp + (size_t)k0 * 128; const float* l = p.pool_scale + g * 128; const float* b = p.w_pool_up + (size_t)(g * 128) * DM + n;
            float acc[8];
#pragma unroll
            for (int j = 0; j < 8; ++j) acc[j] = 0.f;
#pragma unroll 4
            for (int d = 0; d < 128; ++d) { const float bl = b[(size_t)d * DM] * l[d];
#pragma unroll
                for (int j = 0; j < 8; ++j) acc[j] += a[j * 128 + d] * bl; }
            u32x4 o; o.x = pk2(acc[0], acc[1]); o.y = pk2(acc[2], acc[3]); o.z = pk2(acc[4], acc[5]); o.w = pk2(acc[6], acc[7]);
            *(u32x4*)(p.WT_EFF + (size_t)n * 768 + k0) = o; continue; } r -= I_EFF;
        if (r < I_AU) { const int k0 = 64 * (r / 32), n0 = 32 * (r % 32);
            transpose_blk(SrcCol{p.w_attn_up + n0, DM}, 768, p.WT_EFF + (size_t)n0 * 768 + 512, scr, k0, lane); continue; } r -= I_AU;
        if (r < I_OUT) { tr_plain(p.w_out, DM, DM, p.WT_OUT, scr, r, lane); continue; } r -= I_OUT;
        if (r < I_R) { tr_plain(p.w_router, DM, NE, p.WT_RS, scr, r, lane); continue; } r -= I_R;
        if (r < I_S) { tr_gu(p.w_sg, p.w_su, DM, p.WT_RS + (size_t)256 * DM, scr, 64 * (r / 16), 32 * (r % 16), lane); continue; } r -= I_S;
        tr_perm16(p.w_sd, EFF, DM, p.WT_SD, scr, r, lane);
    }
}
DEV void ph_prep_ed2(const P& p, LAS float* scr, int gw, int ngw, int lane) {
    constexpr int IPE = 4 * 32, NIT = NE * IPE;
    for (int it = gw * 2; it < NIT; it += ngw * 2) {
        const float* src[2]; bf16_t* dst[2]; int k0[2];
#pragma unroll
        for (int q = 0; q < 2; ++q) { const int t_ = it + q, e = t_ / IPE, item = t_ % IPE, nblk = DM / 32; k0[q] = 64 * (item / nblk); const int rho0 = 32 * (item % nblk);
            const int tile = rho0 >> 8, bj = (rho0 >> 7) & 1, wc = (rho0 >> 5) & 3, n0 = tile * 256 + 64 * wc + 8 * bj;
            src[q] = p.w_ed + (size_t)e * EFF * DM + n0; dst[q] = p.WT_ED + (size_t)e * DM * EFF + (size_t)rho0 * EFF; }
        const int dr = lane & 31, cofs = 16 * (dr >> 3) + (dr & 7);
        float v[2][32];
#pragma unroll
        for (int q = 0; q < 2; ++q)
#pragma unroll
            for (int i = 0; i < 32; ++i) v[q][i] = src[q][(size_t)(k0[q] + 2 * i + (lane >> 5)) * DM + cofs];
#pragma unroll
        for (int q = 0; q < 2; ++q)
#pragma unroll
            for (int i = 0; i < 32; ++i) scr[q * 2112 + (2 * i + (lane >> 5)) * 33 + dr] = v[q][i];
        asm volatile("s_waitcnt lgkmcnt(0)" ::: "memory");
        const int c = lane & 7;
#pragma unroll
        for (int q = 0; q < 2; ++q)
#pragma unroll
            for (int j = 0; j < 4; ++j) { const int n = (lane >> 3) + 8 * j; const LAS float* sp = scr + q * 2112 + (8 * c) * 33 + n;
                u32x4 o; o.x = pk2(sp[0 * 33], sp[1 * 33]); o.y = pk2(sp[2 * 33], sp[3 * 33]); o.z = pk2(sp[4 * 33], sp[5 * 33]); o.w = pk2(sp[6 * 33], sp[7 * 33]);
                *(u32x4*)(dst[q] + (size_t)n * EFF + k0[q] + 8 * c) = o; }
        asm volatile("s_waitcnt lgkmcnt(0)" ::: "memory");
    }
}
DEV void ph_prep_ed(const P& p, LAS float* scr, int gw, int ngw, int lane) {
    constexpr int IPE = 4 * 32;
    for (int it = gw; it < NE * IPE; it += ngw) { const int e = it / IPE;
        tr_perm16(p.w_ed + (size_t)e * EFF * DM, EFF, DM, p.WT_ED + (size_t)e * DM * EFF, scr, it % IPE, lane); }
}
DEV void ph_prep_egu(const P& p, LAS float* scr, int gw, int ngw, int lane) {
    constexpr int IPE = 16 * 16;
    for (int it = gw; it < NE * IPE; it += ngw) { const int e = it / IPE, r = it % IPE;
        tr_gu(p.w_eg + (size_t)e * DM * EFF, p.w_eu + (size_t)e * DM * EFF, DM, p.WT_EGU + (size_t)e * 512 * DM, scr, 64 * (r / 16), 32 * (r % 16), lane); }
}

constexpr int LDS_BYTES = 155648;
constexpr int LDS_OFF_TAB = 131072;
constexpr int LDS_GTAB = 131072 + 4096;
constexpr int MAXU = 16;
constexpr int LDS_MISC = LDS_GTAB + MAXU * 1024;

DEV void fill_gtab(const P& p, const mg::ExpertOrder& S, LAS unsigned* gtab) {
    const int tid_ = otid();
    for (int i = 0; i < MAXU; ++i) { int pm, pn, e; if (!S.tile_of(i, pm, pn, e)) break;
        if (tid_ < 256) { const int s = p.rowlist[pm * 256 + tid_]; gtab[i * 256 + tid_] = (unsigned)(s < 0 ? 0 : (s >> 3)) * (unsigned)(DM * 2); } }
    __syncthreads();
}

#define GAS __attribute__((address_space(1)))
#define XB_TMO      128
#define XB_XCNT(j)  (256  + 64 * (j))
#define XB_XSUB(j)  (1280 + 64 * (j))
#define XB_XGEN(j)  (2304 + 64 * (j))
#define XB_TOP      3328
#define XB_TOPGEN   3392
#define XCD_BAR_WORDS 3456
#define XB_SPIN_CAP (1u << 18)
DEV unsigned xb_ld(unsigned* p)              { return __hip_atomic_load(p, __ATOMIC_RELAXED, __HIP_MEMORY_SCOPE_AGENT); }
DEV unsigned xb_add(unsigned* p, unsigned v) { return __hip_atomic_fetch_add(p, v, __ATOMIC_RELAXED, __HIP_MEMORY_SCOPE_AGENT); }
DEV unsigned xb_xcc_id() { return (unsigned)__builtin_amdgcn_s_getreg((3 << 11) | 20) & 0xFu; }
#define XB_SPIN(cond, bar) do { unsigned _sp = 0; while (cond) { __builtin_amdgcn_s_sleep(1); \
    if ((++_sp & 255u) == 0u) { if (xb_ld(&(bar)[XB_TMO])) break; if (_sp > XB_SPIN_CAP) { atomicAdd(&(bar)[XB_TMO], 1u); break; } } } } while (0)
struct XcdBarrier { unsigned* bar; unsigned x; volatile LAS unsigned* st; };
DEV XcdBarrier xcd_barrier_post(unsigned* bar, volatile LAS unsigned* st) {
    XcdBarrier b; b.bar = bar; b.x = xb_xcc_id(); b.st = st;
    if (threadIdx.x == 0) (void)xb_add(&bar[XB_XCNT(b.x)], 1u);
    return b;
}
DEV void xcd_barrier_complete(unsigned* bar, unsigned x, unsigned& nloc, unsigned& nx) {
    const unsigned G = gridDim.x * gridDim.y * gridDim.z;
    unsigned sum, cnt, mine, sp = 0u;
    for (;;) {
        sum = 0u; cnt = 0u; mine = 0u;
#pragma unroll
        for (unsigned j = 0; j < 16; ++j) { const unsigned c = xb_ld(&bar[XB_XCNT(j)]); sum += c; cnt += (c > 0u) ? 1u : 0u; mine = (j == x) ? c : mine; }
        if (sum == G) break;
        __builtin_amdgcn_s_sleep(1);
        if ((++sp & 255u) == 0u) { if (xb_ld(&bar[XB_TMO])) break; if (sp > XB_SPIN_CAP) { atomicAdd(&bar[XB_TMO], 1u); break; } }
    }
    nloc = mine > 0u ? mine : 1u; nx = cnt > 0u ? cnt : 1u;
}
DEV void xcd_barrier(const XcdBarrier& b) {
    asm volatile("s_waitcnt vmcnt(0)" ::: "memory");
    __syncthreads();
    if (threadIdx.x == 0) {
        unsigned* bar = b.bar;
        __builtin_amdgcn_s_waitcnt(0);
        unsigned nloc = b.st[0], nx = b.st[1];
        if (nloc == 0u) { xcd_barrier_complete(bar, b.x, nloc, nx); b.st[0] = nloc; b.st[1] = nx; }
        const unsigned old = xb_add(&bar[XB_XSUB(b.x)], 1u);
        const unsigned gen = old / nloc;
        if (old + 1u == (gen + 1u) * nloc) {
            __builtin_amdgcn_fence(__ATOMIC_RELEASE, "agent");
            asm volatile("s_waitcnt vmcnt(0)" ::: "memory");
            const unsigned og = xb_add(&bar[XB_TOP], 1u);
            const unsigned tg = og / nx;
            if (og + 1u == (tg + 1u) * nx) xb_add(&bar[XB_TOPGEN], 1u);
            else XB_SPIN(xb_ld(&bar[XB_TOPGEN]) == tg, bar);
            __builtin_amdgcn_fence(__ATOMIC_ACQUIRE, "agent");
            xb_add(&bar[XB_XGEN(b.x)], 1u);
            asm volatile("s_waitcnt vmcnt(0)" ::: "memory");
        } else {
            XB_SPIN(xb_ld(&bar[XB_XGEN(b.x)]) == gen, bar);
            __builtin_amdgcn_fence(__ATOMIC_ACQUIRE, "agent");
            asm volatile("s_waitcnt vmcnt(0)" ::: "memory");
        }
    }
    __syncthreads();
}

#define STAMP() do { if (TPROBE >= 0) { if (bid == 0 && threadIdx.x == 0) p.ts[nst] = __builtin_amdgcn_s_memrealtime(); ++nst; } } while (0)
#define GSYNC_CG() do { cg::this_grid().sync(); STAMP(); } while (0)
#define GSYNC() do { xcd_barrier(xbar); STAMP(); } while (0)
__global__ void __launch_bounds__(NTHR, 2) fwd_all(P p) {
    extern __shared__ __attribute__((aligned(16))) unsigned char lds_raw[];
    LAS unsigned char* lds = (LAS unsigned char*)lds_raw;
    float* sm = (float*)lds_raw;
    int* off = (int*)(lds_raw + LDS_OFF_TAB);
    const LAS int* offl = (const LAS int*)(lds + LDS_OFF_TAB);
    LAS unsigned* gtab = (LAS unsigned*)(lds + LDS_GTAB);
    const int bid = blockIdx.x, nb = gridDim.x;
    const int tid_ = otid(); const int lane = tid_ & 63, wv = tid_ >> 6;
    LAS float* scr = (LAS float*)(lds + wv * 16384);
    const int gw = bid * NWV + wv, ngw = nb * NWV;
    volatile LAS unsigned* misc = (volatile LAS unsigned*)(lds + LDS_MISC);
    if (threadIdx.x < 2) misc[threadIdx.x] = 0u;
    __syncthreads();
    const XcdBarrier xbar = xcd_barrier_post(p.bar, misc);
    int nst = 0; STAMP();

    ph_mod(p, sm, bid, nb);
    __syncthreads();
    REPEAT(1) ph_prep_small(p, scr, gw, ngw, lane);
#if MF_EXP2
    REPEAT(2) ph_prep_ed(p, scr, gw, ngw, lane);
#endif
    GSYNC();
    REPEAT(3) ph_norm(p.x, p.norm1_g, p.mod, 0, 1024, p.XB, bid, nb);
    GSYNC();
#if MF_INPROJ
    REPEAT(4) { mg::DenseOrder S; S.init(p.XB, p.WT_IN, T, INW, DM, nb, bid);
      mg::gemm_phase<mg::MEpiInProj, mg::DenseOrder, false>(lds, gtab, DM, S, mg::MEpiInProj{p.U, p.QKV, p.G}); }
#else
    ngemm_dense<false>(p.XB, DM, p.w_in, nullptr, INW, T, INW, DM, EpiInProj{p.U, p.QKV, p.G}, sm, bid, nb);
#endif
    GSYNC();
#if !MF_ATTN
    ph_qknorm(p, bid, nb);
#endif
    REPEAT(5) ph_pool(p, bid, nb);
#if !MF_ATTN
    GSYNC();
#endif
#if MF_ATTN
    REPEAT(6) ph_attn_mfma(p, lds, bid, nb);
    GSYNC();
    REPEAT(7) ph_attn_combine(p, bid, nb);
#else
    ph_attn(p, bid, nb);
#endif
#if !MF_MERGE
#pragma unroll 1
    for (int g = 0; g < 4; ++g) ngemm_dense<false>(p.PL + g * 128, 512, p.pool_w_grp + g * 128 * 128, nullptr, 128, T, 128, 128, EpiPoolGrp{p.Y, p.pool_scale, g}, sm, bid, nb);
#endif
    GSYNC();
#if MF_MERGE
    REPEAT(8) { mg::PairOrder S; S.D.init(p.PL, p.WT_EFF, T, DM, 768, nb, bid); S.kt0 = 8; S.kt1 = 4;
      mg::gemm_phase<mg::MEpiMergeF, mg::PairOrder, false>(lds, gtab, 768, S, mg::MEpiMergeF{p.XB, p.G}); }
#else
    ngemm_dense<false>(p.Y, 512, p.w_pool_up, nullptr, DM, T, DM, 512, EpiMergeA{p.XB, p.G}, sm, bid, nb);
    GSYNC();
    ngemm_dense<false>(p.O, 256, p.w_attn_up, nullptr, DM, T, DM, 256, EpiMergeB{p.XB, p.G}, sm, bid, nb);
#endif
    GSYNC();
#if MF_OUT
    REPEAT(9) { mg::DenseOrder S; S.init(p.XB, p.WT_OUT, T, DM, DM, nb, bid);
      mg::gemm_phase<mg::MEpiOutProj, mg::DenseOrder, false>(lds, gtab, DM, S, mg::MEpiOutProj{p.x, p.out, p.mod}); }
#else
    ngemm_dense<false>(p.XB, DM, p.w_out, nullptr, DM, T, DM, DM, EpiOutProj{p.x, p.out, p.mod}, sm, bid, nb);
#endif
    GSYNC();
    REPEAT(10) ph_norm(p.out, p.norm2_g, p.mod, 3072, 4096, p.XB, bid, nb);
#if MF_EXP1
    __syncthreads();
    REPEAT(11) ph_prep_egu(p, scr, gw, ngw, lane);
#endif
    GSYNC();
#if MF_ROUTER
    REPEAT(12) { mg::DenseOrder S; S.init(p.XB, p.WT_RS, T, 768, DM, nb, bid);
      mg::gemm_phase<mg::MEpiRouterShared, mg::DenseOrder, false>(lds, gtab, DM, S, mg::MEpiRouterShared{p.LG, p.HS}); }
#else
    ngemm_dense<false>(p.XB, DM, p.w_router, nullptr, NE, T, NE, DM, EpiLogits{p.LG}, sm, bid, nb);
#endif
    GSYNC();
    ph_route(p, (int*)lds_raw, bid, nb);
    GSYNC();
    ph_scatter(p, off, bid, nb);
    GSYNC();
#if MF_EXP1
    REPEAT(13) { load_offsets(p.cnt, off);
      mg::ExpertOrder S{offl, 2, nb, bid, (const char*)p.XB, (const char*)p.WT_EGU, (size_t)512 * DM * 2, (size_t)256 * DM * 2, 0, true, p.rowlist, MAXU};
      fill_gtab(p, S, gtab);
      mg::gemm_phase<mg::MEpiAct, mg::ExpertOrder, true>(lds, gtab, DM, S, mg::MEpiAct{p.ACT}); }
#else
    ph_expert1(p, sm, off, bid, nb);
#endif
    GSYNC();
#if MF_EXP2
    REPEAT(14) { load_offsets(p.cnt, off);
      mg::ExpertOrder S{offl, 4, nb, bid, (const char*)p.ACT, (const char*)p.WT_ED, (size_t)DM * EFF * 2, (size_t)256 * EFF * 2, (size_t)256 * EFF * 2, false, p.rowlist, MAXU};
      mg::gemm_phase<mg::MEpiSlab, mg::ExpertOrder, false>(lds, gtab, EFF, S, mg::MEpiSlab{(unsigned char*)p.SLAB, p.rowlist, p.roww}); }
#else
    ph_expert2(p, sm, off, bid, nb);
#endif
    GSYNC();
#if !MF_ROUTER
    ngemm_dense<true>(p.XB, DM, p.w_sg, p.w_su, EFF, T, EFF, DM, EpiAct{p.HS}, sm, bid, nb);
    GSYNC();
#endif
#if MF_FINAL
    { mg::DenseOrder S; S.init(p.HS, p.WT_SD, T, DM, EFF, nb, bid);
      mg::gemm_phase<mg::MEpiFinal, mg::DenseOrder, false>(lds, gtab, EFF, S, mg::MEpiFinal{p.out, (const unsigned char*)p.SLAB, p.mod}); }
#else
    ngemm_dense<false>(p.HS, EFF, p.w_sd, nullptr, DM, T, DM, EFF, EpiFinal{p.out, p.SLAB, p.mod}, sm, bid, nb);
#endif
#if TPROBE >= 0
    GSYNC();
    if (bid == 0 && threadIdx.x == 0) { const unsigned long long dt = p.ts[TPROBE + 1] - p.ts[TPROBE]; p.out[0] += (float)dt * 0.01f / TSCALE; }
#endif
}

extern "C" void kernel_launch(void* const* d_in, const int* in_sizes, int n_in, void* d_out, int out_size, void* d_ws, size_t ws_size, hipStream_t stream) {
    static int grid = 0;
    if (grid == 0) {
        int dev = 0, cus = 0;
        (void)hipGetDevice(&dev);
        (void)hipDeviceGetAttribute(&cus, hipDeviceAttributeMultiprocessorCount, dev);
        int per_cu = 0;
        (void)hipFuncSetAttribute((const void*)fwd_all, hipFuncAttributeMaxDynamicSharedMemorySize, LDS_BYTES);
        (void)hipOccupancyMaxActiveBlocksPerMultiprocessor(&per_cu, fwd_all, NTHR, LDS_BYTES);
        if (per_cu < 1) { fprintf(stderr, "kernel_launch: occupancy query says %d blocks/CU\n", per_cu); per_cu = 1; }
        if (per_cu > 1) per_cu = 1;
        grid = cus * per_cu;
        if (ws_size < WS_END) { fprintf(stderr, "kernel_launch: workspace too small (%zu < %zu)\n", ws_size, (size_t)WS_END); grid = -1; }
    }
    if (grid < 0) return;
    P p{};
    const float* const* in = (const float* const*)d_in;
    p.x = in[0]; p.c = in[1]; p.pos = (const int*)d_in[2];
    p.w_ada = in[3]; p.b_ada = in[4]; p.norm1_g = in[5]; p.w_in = in[6]; p.pool_w_grp = in[7]; p.pool_scale = in[8]; p.q_norm_g = in[9]; p.k_norm_g = in[10];
    p.w_pool_up = in[11]; p.w_attn_up = in[12]; p.w_out = in[13]; p.norm2_g = in[14]; p.w_router = in[15]; p.router_bias = in[16];
    p.w_sg = in[17]; p.w_su = in[18]; p.w_sd = in[19]; p.w_eg = in[20]; p.w_eu = in[21]; p.w_ed = in[22];
    p.out = (float*)d_out;
    char* ws = (char*)d_ws;
    p.mod = (float*)(ws + WS_MOD); p.cnt = (int*)(ws + WS_CNT); p.asg_e = (int*)(ws + WS_ASG_E); p.asg_pos = (int*)(ws + WS_ASG_POS);
    p.asg_w = (float*)(ws + WS_ASG_W); p.rowlist = (int*)(ws + WS_ROWLIST);
    p.XB = (bf16_t*)(ws + WS_XB); p.U = (bf16_t*)(ws + WS_U); p.QKV = (bf16_t*)(ws + WS_QKV); p.G = (bf16_t*)(ws + WS_G); p.PL = (bf16_t*)(ws + WS_PL);
    p.Y = (bf16_t*)(ws + WS_Y); p.O = (bf16_t*)(ws + WS_O); p.ACT = (bf16_t*)(ws + WS_ACT); p.SLAB = (bf16_t*)(ws + WS_SLAB); p.HS = (bf16_t*)(ws + WS_HS);
    p.LG = (float*)(ws + WS_ACT);
    p.roww = (float*)(ws + WS_ROWW);
    p.bar = (unsigned*)(ws + WS_BAR); p.ts = (unsigned long long*)(ws + WS_TS);
    p.OG = (bf16_t*)(ws + WS_OG); p.LSUM = (float*)(ws + WS_LSUM);
    p.WT_IN = (bf16_t*)(ws + WS_WT_IN); p.WT_EFF = (bf16_t*)(ws + WS_WT_EFF); p.WT_AU = (bf16_t*)(ws + WS_WT_AU); p.WT_OUT = (bf16_t*)(ws + WS_WT_OUT);
    p.WT_RS = (bf16_t*)(ws + WS_WT_RS); p.WT_SD = (bf16_t*)(ws + WS_WT_SD); p.WT_EGU = (bf16_t*)(ws + WS_WT_EGU); p.WT_ED = (bf16_t*)(ws + WS_WT_ED);
    (void)hipMemsetAsync(ws + WS_BAR, 0, WS_ZERO_BYTES, stream);
    void* args[] = {&p};
    hipError_t e = hipLaunchCooperativeKernel((void*)fwd_all, dim3(grid), dim3(NTHR), args, LDS_BYTES, stream);
    if (e != hipSuccess) fprintf(stderr, "cooperative launch failed: %s (grid %d)\n", hipGetErrorString(e), grid);
}
```

```cpp
#include <hip/hip_runtime.h>
#include <hip/hip_cooperative_groups.h>
#include <stdint.h>
#include <cstdio>
namespace cg = cooperative_groups;

#ifndef ONE_LAUNCH
#define ONE_LAUNCH 0
#endif

typedef unsigned short bf16_t;
#define DEV __device__ __forceinline__
#define LAS __attribute__((address_space(3)))
typedef short bf16x8 __attribute__((ext_vector_type(8)));
typedef float f32x4 __attribute__((ext_vector_type(4)));
typedef unsigned u32x4 __attribute__((ext_vector_type(4)));
typedef unsigned u32x2 __attribute__((ext_vector_type(2)));

#ifndef MF_INPROJ
#define MF_INPROJ 1
#endif
#ifndef MF_MERGE
#define MF_MERGE 1
#endif
#ifndef MF_OUT
#define MF_OUT 1
#endif
#ifndef MF_ROUTER
#define MF_ROUTER 1
#endif
#ifndef MF_EXP1
#define MF_EXP1 1
#endif
#ifndef MF_EXP2
#define MF_EXP2 1
#endif
#ifndef MF_ATTN
#define MF_ATTN 1
#endif
#ifndef DUP
#define DUP 0
#endif
#ifndef TPROBE
#define TPROBE -1
#endif
#ifndef TSCALE
#define TSCALE 10.0f
#endif
#define REPEAT(n) _Pragma("unroll 1") for (int rep_ = 0; rep_ < ((DUP == (n)) ? 2 : 1); ++rep_)
#ifndef MF_FINAL
#define MF_FINAL 1
#endif

constexpr int NB = 16, SEQ = 2048, DM = 1024, T = NB * SEQ;
constexpr int INW = 4864, NMOD = 6144;
constexpr int NE = 256, EFF = 256;
constexpr int NTHR = 512, NWV = 8;
constexpr int NSLOT = T * 8;
constexpr int RMAX = NSLOT + NE * 256;

DEV float bf2f(bf16_t h) { return __uint_as_float(((unsigned)h) << 16); }
DEV bf16_t f2bf(float f) { unsigned u = __float_as_uint(f); u += 0x7fffu + ((u >> 16) & 1u); return (bf16_t)(u >> 16); }
DEV unsigned pk2(float lo, float hi) { return (unsigned)f2bf(lo) | ((unsigned)f2bf(hi) << 16); }
DEV float sigm(float v) { return 1.f / (1.f + __expf(-v)); }
DEV float silu(float v) { return v / (1.f + __expf(-v)); }
DEV int otid() { int t = threadIdx.x; asm volatile("" : "+v"(t)); return t; }
DEV float wave_sum(float v) {
#pragma unroll
    for (int o = 32; o >= 1; o >>= 1) v += __shfl_xor(v, o);
    return v;
}

struct P {
    const float *x, *c; const int* pos;
    const float *w_ada, *b_ada, *norm1_g, *w_in, *pool_w_grp, *pool_scale, *q_norm_g, *k_norm_g, *w_pool_up, *w_attn_up, *w_out, *norm2_g,
        *w_router, *router_bias, *w_sg, *w_su, *w_sd, *w_eg, *w_eu, *w_ed;
    float* out;
    float* mod; int* cnt; int* asg_e; int* asg_pos; float* asg_w; int* rowlist;
    bf16_t *XB, *U, *QKV, *G, *PL, *Y, *O, *ACT, *SLAB, *HS;
    float* LG;
    bf16_t* OG; float* LSUM; unsigned* bar; unsigned long long* ts; float* roww;
    bf16_t *WT_IN, *WT_EFF, *WT_AU, *WT_OUT, *WT_RS, *WT_SD, *WT_EGU, *WT_ED;
};

constexpr size_t MiB = 1u << 20;
constexpr size_t WS_BAR = 640 * 1024, WS_BAR_BYTES = 16384, WS_ZERO_BYTES = 16384 + 65536;
constexpr size_t WS_TS = 800 * 1024;
constexpr size_t WS_MOD = 0, WS_CNT = WS_BAR + WS_BAR_BYTES, WS_ASG_E = 1 * MiB, WS_ASG_POS = 2 * MiB, WS_ASG_W = 3 * MiB, WS_ROWLIST = 4 * MiB, WS_ROWW = 6 * MiB;
constexpr size_t WS_XB = 8 * MiB;
constexpr size_t WS_ACT = 72 * MiB;
constexpr size_t WS_SLAB = 232 * MiB;
constexpr size_t WS_U = 232 * MiB, WS_QKV = 264 * MiB, WS_G = 408 * MiB, WS_PL = 536 * MiB, WS_Y = 568 * MiB, WS_O = 600 * MiB;
constexpr size_t WS_WT_IN = 744 * MiB, WS_WT_EFF = 754 * MiB, WS_WT_AU = 755 * MiB, WS_WT_OUT = 756 * MiB, WS_WT_RS = 758 * MiB, WS_WT_SD = 760 * MiB;
constexpr size_t WS_WT_ED = 762 * MiB;
constexpr size_t WS_WT_EGU = 232 * MiB;
constexpr size_t WS_OG = 616 * MiB, WS_LSUM = 664 * MiB;
constexpr size_t WS_HS = 890 * MiB;
constexpr size_t WS_END = 906 * MiB;

DEV void ph_mod(const P& p, float* sm, int bid, int nb) {
    const int tid_ = otid(); const int lane = tid_ & 63, wv = tid_ >> 6;
    for (int it = bid; it < 96; it += nb) {
        const int k0 = wv * 128, e = it * 64 + lane;
        float acc[16];
#pragma unroll
        for (int b = 0; b < 16; ++b) acc[b] = 0.f;
#pragma unroll 1
        for (int kh = 0; kh < 2; ++kh) {
            float sc[16];
#pragma unroll
            for (int b = 0; b < 16; ++b) sc[b] = silu(p.c[b * DM + k0 + kh * 64 + lane]);
            const float* wp = p.w_ada + (size_t)(k0 + kh * 64) * NMOD + e;
#pragma unroll 8
            for (int kk = 0; kk < 64; ++kk) { const float w = wp[(size_t)kk * NMOD];
#pragma unroll
                for (int b = 0; b < 16; ++b) acc[b] += __uint_as_float(__builtin_amdgcn_readlane(__float_as_uint(sc[b]), kk)) * w; }
        }
        __syncthreads();
#pragma unroll
        for (int b = 0; b < 16; ++b) sm[(wv * 16 + b) * 64 + lane] = acc[b];
        __syncthreads();
#pragma unroll
        for (int j = 0; j < 2; ++j) { const int idx = tid_ + j * NTHR, b = idx >> 6, col = idx & 63; float s = p.b_ada[it * 64 + col];
#pragma unroll
            for (int w = 0; w < 8; ++w) s += sm[(w * 16 + b) * 64 + col];
            p.mod[b * NMOD + it * 64 + col] = s; }
    }
}

DEV void ph_norm(const float* src, const float* g, const float* mod, int shift_off, int scale_off, bf16_t* dst, int bid, int nb) {
    const int tid_ = otid(); const int lane = tid_ & 63, wv = tid_ >> 6;
    for (int row0 = (bid * NWV + wv) * 2; row0 < T; row0 += nb * NWV * 2) {
        float4 v[2][4]; float ss[2] = {0.f, 0.f};
#pragma unroll
        for (int q = 0; q < 2; ++q) { const float4* xr = (const float4*)(src + (size_t)(row0 + q) * DM);
#pragma unroll
            for (int j = 0; j < 4; ++j) v[q][j] = xr[lane + 64 * j]; }
#pragma unroll
        for (int q = 0; q < 2; ++q)
#pragma unroll
            for (int j = 0; j < 4; ++j) ss[q] += v[q][j].x * v[q][j].x + v[q][j].y * v[q][j].y + v[q][j].z * v[q][j].z + v[q][j].w * v[q][j].w;
        const int b = row0 / SEQ;
#pragma unroll
        for (int q = 0; q < 2; ++q) {
            const float r = rsqrtf(wave_sum(ss[q]) * (1.f / DM) + 1e-6f);
#pragma unroll
            for (int j = 0; j < 4; ++j) {
                const int col = (lane + 64 * j) * 4;
                const float4 g4 = *(const float4*)(g + col);
                const float4 sc = *(const float4*)(mod + b * NMOD + scale_off + col);
                const float4 sh = *(const float4*)(mod + b * NMOD + shift_off + col);
                const float o0 = v[q][j].x * r * g4.x * (1.f + sc.x) + sh.x, o1 = v[q][j].y * r * g4.y * (1.f + sc.y) + sh.y;
                const float o2 = v[q][j].z * r * g4.z * (1.f + sc.z) + sh.z, o3 = v[q][j].w * r * g4.w * (1.f + sc.w) + sh.w;
                uint2 w; w.x = pk2(o0, o1); w.y = pk2(o2, o3);
                *(uint2*)(dst + (size_t)(row0 + q) * DM + col) = w;
            }
        }
    }
}

template <bool DUAL, class RowF, class Epi>
DEV void ngemm_tile(const bf16_t* __restrict__ A, int lda, RowF rowf, const float* __restrict__ B, const float* __restrict__ B2, int ldb,
                    int m0, int n0, int K, Epi epi, float* sm) {
    float* As = sm;
    float* Bs = sm + 16 * 132;
    float* Bs2 = Bs + 16 * 64;
    const int tid = otid(), tm = tid >> 4, tn = tid & 15;
    float acc[4][4], acc2[4][4];
#pragma unroll
    for (int i = 0; i < 4; ++i)
#pragma unroll
        for (int j = 0; j < 4; ++j) { acc[i][j] = 0.f; acc2[i][j] = 0.f; }
    const int ar = tid >> 2, ak = (tid & 3) * 4;
    const int arow = rowf(m0 + ar);
    const bf16_t* ap = A + (size_t)(arow < 0 ? 0 : arow) * lda + ak;
    const int bk = tid >> 5, bn = (tid & 31) * 2;
    for (int k0 = 0; k0 < K; k0 += 16) {
        uint2 av = make_uint2(0u, 0u);
        if (arow >= 0) av = *(const uint2*)(ap + k0);
        const float2 bv = *(const float2*)(B + (size_t)(k0 + bk) * ldb + n0 + bn);
        float2 bv2 = make_float2(0.f, 0.f);
        if (DUAL) bv2 = *(const float2*)(B2 + (size_t)(k0 + bk) * ldb + n0 + bn);
        __syncthreads();
        As[(ak + 0) * 132 + ar] = __uint_as_float(av.x << 16);
        As[(ak + 1) * 132 + ar] = __uint_as_float(av.x & 0xffff0000u);
        As[(ak + 2) * 132 + ar] = __uint_as_float(av.y << 16);
        As[(ak + 3) * 132 + ar] = __uint_as_float(av.y & 0xffff0000u);
        Bs[bk * 64 + bn] = bv.x; Bs[bk * 64 + bn + 1] = bv.y;
        if (DUAL) { Bs2[bk * 64 + bn] = bv2.x; Bs2[bk * 64 + bn + 1] = bv2.y; }
        __syncthreads();
#pragma unroll
        for (int kk = 0; kk < 16; ++kk) {
            const float4 a = *(const float4*)&As[kk * 132 + tm * 4];
            const float4 b = *(const float4*)&Bs[kk * 64 + tn * 4];
            const float aa[4] = {a.x, a.y, a.z, a.w}, bb[4] = {b.x, b.y, b.z, b.w};
#pragma unroll
            for (int i = 0; i < 4; ++i)
#pragma unroll
                for (int j = 0; j < 4; ++j) acc[i][j] += aa[i] * bb[j];
            if (DUAL) {
                const float4 b2 = *(const float4*)&Bs2[kk * 64 + tn * 4];
                const float cc[4] = {b2.x, b2.y, b2.z, b2.w};
#pragma unroll
                for (int i = 0; i < 4; ++i)
#pragma unroll
                    for (int j = 0; j < 4; ++j) acc2[i][j] += aa[i] * cc[j];
            }
        }
    }
#pragma unroll
    for (int i = 0; i < 4; ++i)
#pragma unroll
        for (int j = 0; j < 4; ++j) epi(m0 + tm * 4 + i, n0 + tn * 4 + j, acc[i][j], acc2[i][j]);
}

struct RowId { DEV int operator()(int m) const { return m; } };
struct RowTok { const int* rl; DEV int operator()(int m) const { const int s = rl[m]; return s < 0 ? -1 : (s >> 3); } };

template <bool DUAL, class Epi>
DEV void ngemm_dense(const bf16_t* A, int lda, const float* B, const float* B2, int ldb, int M, int N, int K, Epi epi, float* sm, int bid, int nb) {
    const int tn = N / 64, nt = (M / 128) * tn;
    for (int t = bid; t < nt; t += nb) ngemm_tile<DUAL>(A, lda, RowId(), B, B2, ldb, (t / tn) * 128, (t % tn) * 64, K, epi, sm);
}

struct EpiInProj { bf16_t *U, *QKV, *G;
    DEV void operator()(int r, int c, float v, float) const {
        if (c < 512) U[(size_t)r * 512 + c] = f2bf(v);
        else if (c < 2816) QKV[(size_t)r * 2304 + (c - 512)] = f2bf(v);
        else G[(size_t)r * 2048 + (c - 2816)] = f2bf(sigm(v)); } };
struct EpiPoolGrp { bf16_t* Y; const float* ls; int g;
    DEV void operator()(int r, int c, float v, float) const { Y[(size_t)r * 512 + g * 128 + c] = f2bf(v * ls[g * 128 + c]); } };
struct EpiMergeA { bf16_t* MG; const bf16_t* G;
    DEV void operator()(int r, int c, float v, float) const { MG[(size_t)r * DM + c] = f2bf(bf2f(G[(size_t)r * 2048 + c]) * v); } };
struct EpiMergeB { bf16_t* MG; const bf16_t* G;
    DEV void operator()(int r, int c, float v, float) const { const size_t i = (size_t)r * DM + c; MG[i] = f2bf(bf2f(MG[i]) + bf2f(G[(size_t)r * 2048 + 1024 + c]) * v); } };
struct EpiOutProj { const float* x; float* out; const float* mod;
    DEV void operator()(int r, int c, float v, float) const { const size_t i = (size_t)r * DM + c; out[i] = x[i] + mod[(r / SEQ) * NMOD + 2048 + c] * v; } };
struct EpiLogits { float* LG;
    DEV void operator()(int r, int c, float v, float) const { LG[(size_t)r * NE + c] = v; } };
struct EpiAct { bf16_t* ACT;
    DEV void operator()(int r, int c, float v, float v2) const { ACT[(size_t)r * EFF + c] = f2bf(silu(v) * v2); } };
struct EpiSlab { bf16_t* SLAB; const int* rl; const float* w;
    DEV void operator()(int r, int c, float v, float) const { const int s = rl[r]; if (s >= 0) SLAB[(size_t)s * DM + c] = f2bf(v * w[s]); } };
struct EpiFinal { float* out; const bf16_t* SLAB; const float* mod;
    DEV void operator()(int r, int c, float v, float) const {
        float s = v;
#pragma unroll
        for (int k = 0; k < 8; ++k) s += bf2f(SLAB[((size_t)r * 8 + k) * DM + c]);
        const size_t i = (size_t)r * DM + c; out[i] = out[i] + mod[(r / SEQ) * NMOD + 5120 + c] * s; } };

DEV void ph_qknorm(const P& p, int bid, int nb) {
    const int tid_ = otid(); const int lane = tid_ & 63, wv = tid_ >> 6;
    const float gq = p.q_norm_g[lane], gk = p.k_norm_g[lane];
    const float invf = exp2f(-(float)(lane & 7) * (1.f / 8.f) * log2f(500000.f));
    for (int t = bid * NWV + wv; t < T; t += nb * NWV) {
        const float ang = (float)p.pos[t] * invf;
        const float cs = cosf(ang), sn = sinf(ang);
        bf16_t* ptr = p.QKV + (size_t)t * 2304 + lane;
        float v[24];
#pragma unroll
        for (int hh = 0; hh < 24; ++hh) v[hh] = bf2f(ptr[hh * 64]);
#pragma unroll
        for (int hh = 0; hh < 24; ++hh) {
            const float ss = wave_sum(v[hh] * v[hh]);
            float nv = v[hh] * rsqrtf(ss * (1.f / 64.f) + 1e-6f) * (hh < 12 ? gq : gk);
            const float partner = __shfl_xor(nv, 8);
            if (lane < 8) nv = nv * cs - partner * sn;
            else if (lane < 16) nv = nv * cs + partner * sn;
            ptr[hh * 64] = f2bf(nv);
        }
    }
}

template <int R>
DEV void pool_chunk(const unsigned* up, unsigned* op, int s0) {
    constexpr int W = 32 + 2 * R;
    float w0[W], w1[W];
#pragma unroll
    for (int i = 0; i < W; ++i) { const int q = s0 - R + i; const bool ok = (q >= 0) && (q < SEQ); const unsigned w = up[(size_t)min(max(q, 0), SEQ - 1) * 256];
        w0[i] = ok ? __uint_as_float(w << 16) : 0.f; w1[i] = ok ? __uint_as_float(w & 0xffff0000u) : 0.f; }
    float a0 = 0.f, a1 = 0.f;
#pragma unroll
    for (int i = 0; i < 2 * R + 1; ++i) { a0 += w0[i]; a1 += w1[i]; }
#pragma unroll
    for (int j = 0; j < 32; ++j) {
        const int s = s0 + j;
        const int lo = max(s - R, 0), hi = min(s + R, SEQ - 1);
        const float inv = 1.f / (float)(hi - lo + 1);
        op[(size_t)s * 384] = pk2(a0 * inv - w0[j + R], a1 * inv - w1[j + R]);
        if (j < 31) { a0 += w0[j + 2 * R + 1] - w0[j]; a1 += w1[j + 2 * R + 1] - w1[j]; }
    }
}
DEV void ph_pool(const P& p, int bid, int nb) {
    const int tid_ = otid();
    for (int i = bid * NTHR + tid_; i < NB * 64 * 256; i += nb * NTHR) {
        const int cp = i & 255, chunk = (i >> 8) & 63, b = i >> 14;
        const int g = cp >> 6;
        const unsigned* up = (const unsigned*)(p.U + (size_t)b * SEQ * 512) + cp;
        unsigned* op = (unsigned*)(p.PL + (size_t)b * SEQ * 768) + cp;
        const int s0 = chunk * 32;
        if (g == 0) pool_chunk<1>(up, op, s0); else if (g == 1) pool_chunk<2>(up, op, s0); else if (g == 2) pool_chunk<4>(up, op, s0); else pool_chunk<8>(up, op, s0);
    }
}

DEV void ph_attn(const P& p, int bid, int nb) {
    const int tid_ = otid(); const int lane = tid_ & 63, wv = tid_ >> 6;
    for (int it = bid * NWV + wv; it < T * 4; it += nb * NWV) {
        const int t = it >> 2, slot = it & 3;
        const int s = t & (SEQ - 1), base = t - s;
        float M = -1e30f, l = 0.f, acc = 0.f;
#pragma unroll
        for (int g = 0; g < 3; ++g) {
            const int dsh = 2 * g, d = 1 << dsh, L = SEQ >> dsh;
            const int h = 4 * g + slot;
            const int m = s >> dsh, r = s & (d - 1);
            const float q = bf2f(p.QKV[(size_t)t * 2304 + h * 64 + lane]);
            const bf16_t* kb = p.QKV + 768 + h * 64 + lane;
            const bf16_t* vb = p.QKV + 1536 + h * 64 + lane;
#pragma unroll 4
            for (int rel = -64; rel <= 64; ++rel) {
                const int mm = m + rel;
                const bool valid = (mm >= 0) && (mm < L);
                const int mc = valid ? mm : m;
                const size_t tr = (size_t)(base + mc * d + r) * 2304;
                const float kv = bf2f(kb[tr]), vv = bf2f(vb[tr]);
                const float sc = wave_sum(q * kv) * 0.125f;
                if (valid) {
                    const float mn = fmaxf(M, sc);
                    const float f = __expf(M - mn), pe = __expf(sc - mn);
                    l = l * f + pe; acc = acc * f + pe * vv; M = mn;
                }
            }
        }
        p.O[(size_t)t * 256 + slot * 64 + lane] = f2bf(acc / l);
    }
}

DEV void ph_route(const P& p, int* hist, int bid, int nb) {
    const int tid_ = otid(); const int lane = tid_ & 63, wv = tid_ >> 6;
    const int G = lane & 7, tl = lane >> 3;
    float bias[32];
#pragma unroll
    for (int j = 0; j < 8; ++j) { const float4 b4 = *(const float4*)(p.router_bias + G * 32 + 4 * j); bias[4 * j] = b4.x; bias[4 * j + 1] = b4.y; bias[4 * j + 2] = b4.z; bias[4 * j + 3] = b4.w; }
    for (int t0 = (bid * NWV + wv) * 8; t0 < T; t0 += nb * NWV * 8) {
        const int t = t0 + tl;
        float sc[32], v[32];
#pragma unroll
        for (int j = 0; j < 8; ++j) { const float4 lg = *(const float4*)(p.LG + (size_t)t * NE + G * 32 + 4 * j);
            sc[4 * j] = 1.f / (1.f + expf(-lg.x)); sc[4 * j + 1] = 1.f / (1.f + expf(-lg.y)); sc[4 * j + 2] = 1.f / (1.f + expf(-lg.z)); sc[4 * j + 3] = 1.f / (1.f + expf(-lg.w)); }
        float m1 = -INFINITY, m2 = -INFINITY;
#pragma unroll
        for (int j = 0; j < 32; ++j) { v[j] = sc[j] + bias[j]; const float n1 = fmaxf(m1, v[j]), n2 = fmaxf(fminf(m1, v[j]), m2); m1 = n1; m2 = n2; }
        const float gs = m1 + m2;
        int rank = 0;
#pragma unroll
        for (int g2 = 0; g2 < 8; ++g2) { const float o = __shfl(gs, (lane & 56) + g2); rank += ((o > gs) || (o == gs && g2 < G)) ? 1 : 0; }
        const bool gsel = rank < 4;
        int myidx = 0; float myw = 0.f, wsum = 0.f;
#pragma unroll 1
        for (int k = 0; k < 8; ++k) {
            float bv = -INFINITY, bs = 0.f; int bi = 0;
#pragma unroll
            for (int j = 0; j < 32; ++j) { const bool tk = gsel && (v[j] > bv); bv = tk ? v[j] : bv; bs = tk ? sc[j] : bs; bi = tk ? j : bi; }
            int gi = G * 32 + bi;
#pragma unroll
            for (int o = 1; o < 8; o <<= 1) {
                const float ov = __shfl_xor(bv, o), os = __shfl_xor(bs, o); const int oi = __shfl_xor(gi, o);
                if ((ov > bv) || (ov == bv && oi < gi)) { bv = ov; gi = oi; bs = os; }
            }
            const int wj = (gi >> 5) == G ? (gi & 31) : -1;
#pragma unroll
            for (int j = 0; j < 32; ++j) v[j] = (j == wj) ? -INFINITY : v[j];
            if (G == k) { myidx = gi; myw = bs; }
            wsum += bs;
        }
        __syncthreads();
        if (tid_ < NE) hist[tid_] = 0;
        __syncthreads();
        const int lpos = atomicAdd(&hist[myidx], 1);
        __syncthreads();
        if (tid_ < NE) { const int c_ = hist[tid_]; hist[NE + tid_] = c_ ? atomicAdd(&p.cnt[tid_ * 64], c_) : 0; }
        __syncthreads();
        const int slot = t * 8 + G;
        p.asg_e[slot] = myidx; p.asg_pos[slot] = hist[NE + myidx] + lpos; p.asg_w[slot] = myw / wsum * 2.5f;
    }
}

DEV void load_offsets(const int* cnt, int* off) {
    const int tid = otid();
    __syncthreads();
    if (tid < NE) { const int c_ = cnt[tid * 64]; off[300 + tid] = (c_ + 255) & ~255; off[600 + tid] = c_; }
    __syncthreads();
    if (tid == 0) { int a = 0; for (int e = 0; e < NE; ++e) { off[e] = a; a += off[300 + e]; } off[NE] = a;
        const int x = blockIdx.x & 7; int tf = 0, th = 0;
        for (int j = 0; j < 32; ++j) { const int n_ = off[600 + x + 8 * j], nt_ = (n_ + 255) >> 8, hh = (nt_ > 0 && n_ - (nt_ - 1) * 256 <= 128) ? 1 : 0;
            off[860 + j] = tf; off[900 + j] = th; tf += nt_ - hh; th += hh; }
        off[860 + 32] = tf; off[900 + 32] = th; }
    __syncthreads();
}
DEV int find_expert(const int* off, int m0) {
    int lo = 0, hi = NE;
    while (hi - lo > 1) { const int mid = (lo + hi) >> 1; if (off[mid] <= m0) lo = mid; else hi = mid; }
    return lo;
}

DEV void ph_scatter(const P& p, int* off, int bid, int nb) {
    load_offsets(p.cnt, off);
    const int tid_ = otid();
    for (int slot = bid * NTHR + tid_; slot < NSLOT; slot += nb * NTHR) { const int r = off[p.asg_e[slot]] + p.asg_pos[slot]; p.rowlist[r] = slot; p.roww[r] = p.asg_w[slot]; }
    for (int e = bid; e < NE; e += nb) {
        const int n = p.cnt[e * 64], pd = (n + 255) & ~255;
        for (int i = n + tid_; i < pd; i += NTHR) { p.rowlist[off[e] + i] = -1; p.roww[off[e] + i] = 0.f; }
    }
}

DEV void ph_expert1(const P& p, float* sm, int* off, int bid, int nb) {
    load_offsets(p.cnt, off);
    const int nrt = off[NE] / 128, nt = nrt * 4;
    for (int t = bid; t < nt; t += nb) {
        const int m0 = (t >> 2) * 128, n0 = (t & 3) * 64, e = find_expert(off, m0);
        ngemm_tile<true>(p.XB, DM, RowTok{p.rowlist}, p.w_eg + (size_t)e * DM * EFF, p.w_eu + (size_t)e * DM * EFF, EFF, m0, n0, DM, EpiAct{p.ACT}, sm);
    }
}
DEV void ph_expert2(const P& p, float* sm, int* off, int bid, int nb) {
    load_offsets(p.cnt, off);
    const int nrt = off[NE] / 128, nt = nrt * 16;
    for (int t = bid; t < nt; t += nb) {
        const int m0 = (t >> 4) * 128, n0 = (t & 15) * 64, e = find_expert(off, m0);
        ngemm_tile<false>(p.ACT, EFF, RowId(), p.w_ed + (size_t)e * EFF * DM, nullptr, DM, m0, n0, EFF, EpiSlab{p.SLAB, p.rowlist, p.asg_w}, sm);
    }
}

namespace mg {
constexpr int BM = 256, BK = 64, HALF = 128, HTB = HALF * BK * 2, STAGE_BYTES = 8 * HTB, NXCD = 8, WGM = 8;
__host__ __device__ __forceinline__ int lds_byte(int r, int c) { const int st = (r >> 4) * 2 + (c >> 5), rr = r & 15, cc = c & 31, ob = rr * 64 + cc * 2; return st * 1024 + (ob ^ (((ob >> 9) & 1) << 5)); }
__host__ __device__ __forceinline__ void stage_rc(int b, int& R, int& C) { const int st = b / 1024, sb = b % 1024, swz = sb ^ (((sb >> 9) & 1) << 5); R = (st >> 1) * 16 + swz / 64; C = (st & 1) * 32 + (swz % 64) / 2; }
__host__ __device__ __forceinline__ int perm32(int rho) { const int n = rho >> 4, i = rho & 15; return 8 * (i >> 2) + 4 * n + (i & 3); }

struct Unit { int pm, pn, e, pad, half, pad2; const char* A; const char* B; };

struct DenseOrder { static constexpr bool HAS_HALF = false;
    int nM, nN, nwg, G, c; const char* A; const char* B; size_t tstep;
    DEV void init(const bf16_t* A_, const bf16_t* B_, int M, int N, int K, int G_, int c_) { nM = M / BM; nN = N / BM; nwg = nM * nN; G = G_; c = c_; A = (const char*)A_; B = (const char*)B_; tstep = (size_t)BM * K * 2; }
    DEV bool next(int i, Unit& u) const {
        const long L = (long)i * G + c; if (L >= nwg) return false;
        int wgid = (int)L; { const int q = nwg / NXCD, r = nwg % NXCD, xcd = wgid % NXCD, off = wgid / NXCD; wgid = (xcd < r ? xcd * (q + 1) : r * (q + 1) + (xcd - r) * q) + off; }
        const int nig = WGM * nN, gid = wgid / nig, fm = gid * WGM, gsz = (nM - fm) < WGM ? (nM - fm) : WGM;
        u.pm = fm + ((wgid % nig) % gsz); u.pn = (wgid % nig) / gsz; u.e = 0; u.pad = 0; u.half = 0; u.pad2 = 0;
        u.A = A + (size_t)u.pm * tstep; u.B = B + (size_t)u.pn * tstep; return true;
    }
};
struct PairOrder { static constexpr bool HAS_HALF = false; DenseOrder D; int kt0, kt1;
    DEV bool next(int i, Unit& u) const { if (!D.next(i >> 1, u)) return false; const int part = i & 1; u.e = part; u.pad = part ? kt1 : kt0;
        if (part) { u.A += (size_t)kt0 * 128; u.B += (size_t)kt0 * 128; } return true; }
};
struct ExpertOrder { static constexpr bool HAS_HALF = true;
    const LAS int* off; int ncol, G, c; const char* A; const char* W; size_t wstride, tstepB, tstepA; bool gather; const int* rl; int maxu;
    DEV bool tile_of(int i, int& pm, int& pn, int& e) const {
        const int x = c & 7, cl = c >> 3, nbx = G >> 3;
        const int Lx = i * nbx + cl; int tx = Lx / ncol; pn = Lx % ncol;
        const int ftot = __builtin_amdgcn_readfirstlane(off[860 + 32]), htot = __builtin_amdgcn_readfirstlane(off[900 + 32]);
        if (tx >= ftot + htot) return false;
        const bool isf = tx < ftot; const int tb = isf ? 860 : 900; if (!isf) tx -= ftot;
        int lo = 0, hi = 32;
        while (hi - lo > 1) { const int mid = (lo + hi) >> 1; const int ov = __builtin_amdgcn_readfirstlane(off[tb + mid]); if (ov <= tx) lo = mid; else hi = mid; }
        e = x + 8 * lo;
        const int nfull = __builtin_amdgcn_readfirstlane(off[860 + lo + 1]) - __builtin_amdgcn_readfirstlane(off[860 + lo]);
        pm = (__builtin_amdgcn_readfirstlane(off[e]) >> 8) + (isf ? (tx - __builtin_amdgcn_readfirstlane(off[860 + lo])) : nfull);
        return true;
    }
    DEV bool next(int i, Unit& u) const {
        int pm, pn, e; if (!tile_of(i, pm, pn, e)) return false;
        u.pm = pm; u.pn = pn; u.e = e; u.pad = 0; u.pad2 = 0;
        u.half = (__builtin_amdgcn_readfirstlane(off[600 + e]) - (pm * BM - __builtin_amdgcn_readfirstlane(off[e])) <= HALF) ? 1 : 0;
        u.A = gather ? A : A + (size_t)pm * tstepA; u.B = W + (size_t)e * wstride + (size_t)pn * tstepB; return true;
    }
};

template <class Epi, class Sched, bool GATHER>
DEV void gemm_phase(LAS unsigned char* lds, const LAS unsigned* gtab, const int K, const Sched& S, const Epi& E) {
    const int tid = otid(), wid = __builtin_amdgcn_readfirstlane(tid >> 6), lane = tid & 63, wr = wid >> 2, wc = wid & 3, fr = lane & 15, fq = lane >> 4;
    const int nt = K / BK;
    int Rr[2], Cc[2]; unsigned voffB[2];
#pragma unroll
    for (int i = 0; i < 2; ++i) { stage_rc(tid * 16 + i * 8192, Rr[i], Cc[i]); const int Rb = Epi::PERM ? ((Rr[i] & ~31) + perm32(Rr[i] & 31)) : Rr[i]; voffB[i] = (unsigned)(Rb * K + Cc[i]) * 2u; }
    const size_t kstep = (size_t)(BK * 2);
    const size_t hstep = (size_t)HALF * K * 2;
    const unsigned ldsw = (unsigned)wid * 1024u;
    const int aoff = lds_byte(wr * 64 + fr, fq * 8), boff = lds_byte(wc * 32 + fr, fq * 8);
#define MG_SA(b, h) (((b) * 2 + (h)) * HTB)
#define MG_SB(b, h) ((4 + (b) * 2 + (h)) * HTB)
#define MG_STAGE(bufoff, gbase, voff) do { _Pragma("unroll") for (int _i = 0; _i < 2; ++_i) \
        __builtin_amdgcn_global_load_lds((const unsigned*)((const char*)(gbase) + (voff)[_i]), (LAS unsigned*)(lds + (bufoff) + ldsw + _i * 8192), 16, 0, 0); } while (0)
#define MG_LDA(dst, b, h) do { _Pragma("unroll") for (int m = 0; m < 4; ++m) _Pragma("unroll") for (int k = 0; k < 2; ++k) dst[m][k] = *(const LAS bf16x8*)(lds + MG_SA(b, h) + aoff + m * 2048 + k * 1024); } while (0)
#define MG_LDB(dst, b, h) do { _Pragma("unroll") for (int n = 0; n < 2; ++n) _Pragma("unroll") for (int k = 0; k < 2; ++k) dst[n][k] = *(const LAS bf16x8*)(lds + MG_SB(b, h) + boff + n * 2048 + k * 1024); } while (0)
#define MG_MMA(ai, bj, At, Bt) do { __builtin_amdgcn_s_setprio(1); _Pragma("unroll") for (int m = 0; m < 4; ++m) _Pragma("unroll") for (int n = 0; n < 2; ++n) _Pragma("unroll") for (int k = 0; k < 2; ++k) \
        acc[ai][bj][m][n] = __builtin_amdgcn_mfma_f32_16x16x32_bf16(Bt[n][k], At[m][k], acc[ai][bj][m][n], 0, 0, 0); __builtin_amdgcn_s_setprio(0); } while (0)
#define MG_WAIT_V(n) asm volatile("s_waitcnt vmcnt(" #n ")" ::: "memory")
#define MG_WAIT_L(n) asm volatile("s_waitcnt lgkmcnt(" #n ")" ::: "memory")
#define MG_BAR __builtin_amdgcn_s_barrier()
#define MG_SCHED __builtin_amdgcn_sched_barrier(0)
    Unit cur, nxt; int ui = 0;
    if (!S.next(0, cur)) return;
    int ntc = cur.pad > 0 ? cur.pad : nt;
    bool hf = Sched::HAS_HALF && (cur.half != 0);
    f32x4 acc[2][2][4][2];
#pragma unroll
    for (int a = 0; a < 2; ++a)
#pragma unroll
        for (int b = 0; b < 2; ++b)
#pragma unroll
            for (int m = 0; m < 4; ++m)
#pragma unroll
                for (int n = 0; n < 2; ++n) acc[a][b][m][n] = (f32x4){0.f, 0.f, 0.f, 0.f};
    bf16x8 At[4][2], B0[2][2], B1[2][2];
    unsigned va0[2], va1[2], na0[2], na1[2];
#pragma unroll
    for (int i = 0; i < 2; ++i) {
        if (GATHER) { va0[i] = gtab[Rr[i]] + (unsigned)Cc[i] * 2u; va1[i] = gtab[HALF + Rr[i]] + (unsigned)Cc[i] * 2u; }
        else { va0[i] = (unsigned)(Rr[i] * K + Cc[i]) * 2u; va1[i] = va0[i] + (unsigned)hstep; }
        na0[i] = va0[i]; na1[i] = va1[i];
    }
    const char* cA = cur.A; const char* cB = cur.B;
    MG_STAGE(MG_SB(0, 0), cB, voffB); MG_STAGE(MG_SB(0, 1), cB + hstep, voffB); MG_STAGE(MG_SA(0, 0), cA, va0); MG_STAGE(MG_SA(0, 1), cA, va1);
    if (wr == 1) MG_BAR;
    MG_WAIT_V(2); MG_BAR;
    MG_STAGE(MG_SB(1, 0), cB + kstep, voffB); MG_STAGE(MG_SA(1, 0), cA + kstep, va0); MG_STAGE(MG_SB(1, 1), cB + hstep + kstep, voffB);
    MG_WAIT_V(6); MG_BAR;
    for (;;) {
        const bool has_next = S.next(ui + 1, nxt);
        const char* nA = has_next ? nxt.A : cA; const char* nB = has_next ? nxt.B : cB;
        if constexpr (GATHER) {
            if (has_next) {
                if (ui + 1 < S.maxu) {
#pragma unroll
                    for (int i = 0; i < 2; ++i) { na0[i] = gtab[(ui + 1) * BM + Rr[i]] + (unsigned)Cc[i] * 2u; na1[i] = gtab[(ui + 1) * BM + HALF + Rr[i]] + (unsigned)Cc[i] * 2u; }
                } else {
#pragma unroll
                    for (int i = 0; i < 2; ++i) { const int s0_ = S.rl[nxt.pm * BM + Rr[i]], s1_ = S.rl[nxt.pm * BM + HALF + Rr[i]];
                        na0[i] = (unsigned)(s0_ < 0 ? 0 : (s0_ >> 3)) * (unsigned)(K * 2) + (unsigned)Cc[i] * 2u; na1[i] = (unsigned)(s1_ < 0 ? 0 : (s1_ >> 3)) * (unsigned)(K * 2) + (unsigned)Cc[i] * 2u; }
                }
            }
        }
#pragma unroll 1
        for (int t = 0; t < ntc; t += 2) {
            const bool last = (t == ntc - 2);
            const char* a1 = cA + (size_t)(t + 1) * kstep;
            const char* a2 = last ? nA : cA + (size_t)(t + 2) * kstep; const char* b2 = last ? nB : cB + (size_t)(t + 2) * kstep;
            const char* a3 = a2 + kstep; const char* b3 = b2 + kstep;
            unsigned o0[2], o1[2];
#pragma unroll
            for (int i = 0; i < 2; ++i) { o0[i] = (GATHER && last) ? na0[i] : va0[i]; o1[i] = (GATHER && last) ? na1[i] : va1[i]; }
            MG_LDB(B0, 0, 0); MG_LDB(B1, 0, 1); MG_SCHED; MG_LDA(At, 0, 0); MG_STAGE(MG_SA(1, 1), a1, va1);
            MG_WAIT_V(8); MG_WAIT_L(0); MG_BAR; MG_MMA(0, 0, At, B0); MG_MMA(0, 1, At, B1); MG_BAR; MG_SCHED;
            if (!hf) MG_LDA(At, 0, 1); MG_STAGE(MG_SB(0, 0), b2, voffB); MG_STAGE(MG_SB(0, 1), b2 + hstep, voffB); MG_STAGE(MG_SA(0, 0), a2, o0);
            MG_WAIT_V(8); MG_WAIT_L(0); MG_BAR; if (!hf) { MG_MMA(1, 0, At, B0); MG_MMA(1, 1, At, B1); } MG_BAR; MG_SCHED;
            MG_LDB(B0, 1, 0); MG_LDB(B1, 1, 1); MG_SCHED; MG_LDA(At, 1, 0); MG_STAGE(MG_SA(0, 1), a2, o1);
            MG_WAIT_V(8); MG_WAIT_L(0); MG_BAR; MG_MMA(0, 0, At, B0); MG_MMA(0, 1, At, B1); MG_BAR; MG_SCHED;
            if (!hf) MG_LDA(At, 1, 1); MG_STAGE(MG_SB(1, 0), b3, voffB); MG_STAGE(MG_SB(1, 1), b3 + hstep, voffB); MG_STAGE(MG_SA(1, 0), a3, o0);
            MG_WAIT_V(8); MG_WAIT_L(0); MG_BAR; if (!hf) { MG_MMA(1, 0, At, B0); MG_MMA(1, 1, At, B1); } MG_BAR; MG_SCHED;
        }
        if (wr == 0) MG_BAR;
        E(acc, cur, wr, wc, fr, fq);
        if (!has_next) break;
        if (!(Epi::KEEP_ACC && cur.e == 0)) {
#pragma unroll
        for (int a = 0; a < 2; ++a)
#pragma unroll
            for (int b = 0; b < 2; ++b)
#pragma unroll
                for (int m = 0; m < 4; ++m)
#pragma unroll
                    for (int n = 0; n < 2; ++n) acc[a][b][m][n] = (f32x4){0.f, 0.f, 0.f, 0.f};
        }
        cur = nxt; cA = nA; cB = nB; ++ui; ntc = cur.pad > 0 ? cur.pad : nt; hf = Sched::HAS_HALF && (cur.half != 0);
#pragma unroll
        for (int i = 0; i < 2; ++i) { va0[i] = na0[i]; va1[i] = na1[i]; }
        if (wr == 1) MG_BAR;
    }
    MG_WAIT_V(0);
    MG_BAR;
    __syncthreads();
#undef MG_SA
#undef MG_SB
#undef MG_STAGE
#undef MG_LDA
#undef MG_LDB
#undef MG_MMA
#undef MG_WAIT_V
#undef MG_WAIT_L
#undef MG_BAR
#undef MG_SCHED
}

DEV u32x4 pack8(const f32x4 a, const f32x4 b) { u32x4 w; w.x = pk2(a[0], a[1]); w.y = pk2(a[2], a[3]); w.z = pk2(b[0], b[1]); w.w = pk2(b[2], b[3]); return w; }
DEV f32x4 unpack_lo(const u32x4 w) { return (f32x4){__uint_as_float(w.x << 16), __uint_as_float(w.x & 0xffff0000u), __uint_as_float(w.y << 16), __uint_as_float(w.y & 0xffff0000u)}; }
DEV f32x4 unpack_hi(const u32x4 w) { return (f32x4){__uint_as_float(w.z << 16), __uint_as_float(w.z & 0xffff0000u), __uint_as_float(w.w << 16), __uint_as_float(w.w & 0xffff0000u)}; }
DEV f32x4 sig4(const f32x4 v) { return (f32x4){sigm(v[0]), sigm(v[1]), sigm(v[2]), sigm(v[3])}; }
DEV f32x4 silu4(const f32x4 v) { return (f32x4){silu(v[0]), silu(v[1]), silu(v[2]), silu(v[3])}; }
#define ACC_T f32x4 (&acc)[2][2][4][2]

struct MEpiInProj { static constexpr bool PERM = true; static constexpr bool KEEP_ACC = false; bf16_t *U, *QKV, *G;
    DEV void operator()(ACC_T, const Unit& u, int wr, int wc, int fr, int fq) const {
        int colt = u.pn * BM; bf16_t* base; int ld; bool sg = false;
        if (colt < 512) { base = U; ld = 512; } else if (colt < 2816) { base = QKV; ld = 2304; colt -= 512; } else { base = G; ld = 2048; colt -= 2816; sg = true; }
        const int row0 = u.pm * BM + wr * 64 + fr, col0 = colt + wc * 32 + 8 * fq;
#pragma unroll
        for (int ai = 0; ai < 2; ++ai)
#pragma unroll
            for (int m = 0; m < 4; ++m) { bf16_t* rowp = base + (size_t)(row0 + ai * HALF + m * 16) * ld + col0;
#pragma unroll
                for (int bj = 0; bj < 2; ++bj) { f32x4 v0 = acc[ai][bj][m][0], v1 = acc[ai][bj][m][1]; if (sg) { v0 = sig4(v0); v1 = sig4(v1); }
                    *(u32x4*)(rowp + bj * HALF) = pack8(v0, v1); }
                asm volatile("" ::: "memory"); }
    } };
struct MEpiMergeF { static constexpr bool PERM = true; static constexpr bool KEEP_ACC = true; bf16_t* MG; const bf16_t* G;
    DEV void mid(f32x4 (&acc)[2][2][4][2], const Unit& u, int wr, int wc, int fr, int fq) const {
        const int row0 = u.pm * BM + wr * 64 + fr, col0 = u.pn * BM + wc * 32 + 8 * fq;
#pragma unroll
        for (int ai = 0; ai < 2; ++ai)
#pragma unroll
            for (int m = 0; m < 4; ++m) { const bf16_t* gr = G + (size_t)(row0 + ai * HALF + m * 16) * 2048 + col0;
#pragma unroll
                for (int bj = 0; bj < 2; ++bj)
#pragma unroll
                    for (int n = 0; n < 2; ++n) { const u32x2 gp = *(const u32x2*)(gr + bj * HALF + 4 * n), ga = *(const u32x2*)(gr + 1024 + bj * HALF + 4 * n);
                        acc[ai][bj][m][n] *= (f32x4){__uint_as_float(gp.x << 16) * __builtin_amdgcn_rcpf(__uint_as_float(ga.x << 16)), __uint_as_float(gp.x & 0xffff0000u) * __builtin_amdgcn_rcpf(__uint_as_float(ga.x & 0xffff0000u)),
                                                     __uint_as_float(gp.y << 16) * __builtin_amdgcn_rcpf(__uint_as_float(ga.y << 16)), __uint_as_float(gp.y & 0xffff0000u) * __builtin_amdgcn_rcpf(__uint_as_float(ga.y & 0xffff0000u))};
                        asm volatile("" ::: "memory"); } }
    }
    DEV void operator()(f32x4 (&acc)[2][2][4][2], const Unit& u, int wr, int wc, int fr, int fq) const {
        if (u.e == 0) { mid(acc, u, wr, wc, fr, fq); return; }
        const int row0 = u.pm * BM + wr * 64 + fr, col0 = u.pn * BM + wc * 32 + 8 * fq;
#pragma unroll
        for (int ai = 0; ai < 2; ++ai)
#pragma unroll
            for (int m = 0; m < 4; ++m) { const size_t r = (size_t)(row0 + ai * HALF + m * 16);
#pragma unroll
                for (int bj = 0; bj < 2; ++bj) { const int c = col0 + bj * HALF;
                    const u32x4 ga = *(const u32x4*)(G + r * 2048 + 1024 + c);
                    *(u32x4*)(MG + r * DM + c) = pack8(acc[ai][bj][m][0] * unpack_lo(ga), acc[ai][bj][m][1] * unpack_hi(ga)); }
                asm volatile("" ::: "memory"); }
    } };
struct MEpiOutProj { static constexpr bool PERM = false; static constexpr bool KEEP_ACC = false; const float* x; float* out; const float* mod;
    DEV void operator()(ACC_T, const Unit& u, int wr, int wc, int fr, int fq) const {
        const int row0 = u.pm * BM + wr * 64 + fr, col0 = u.pn * BM + wc * 32 + 4 * fq;
        const float* gm = mod + ((u.pm * BM) / SEQ) * NMOD + 2048;
#pragma unroll
        for (int ai = 0; ai < 2; ++ai)
#pragma unroll
            for (int m = 0; m < 4; ++m) { const size_t r = (size_t)(row0 + ai * HALF + m * 16) * DM;
#pragma unroll
                for (int bj = 0; bj < 2; ++bj)
#pragma unroll
                    for (int n = 0; n < 2; ++n) { const int c = col0 + bj * HALF + n * 16;
                        *(f32x4*)(out + r + c) = *(const f32x4*)(x + r + c) + *(const f32x4*)(gm + c) * acc[ai][bj][m][n]; }
                asm volatile("" ::: "memory"); }
    } };
struct MEpiRouterShared { static constexpr bool PERM = true; static constexpr bool KEEP_ACC = false; float* LG; bf16_t* HS;
    DEV void operator()(ACC_T, const Unit& u, int wr, int wc, int fr, int fq) const {
        const int row0 = u.pm * BM + wr * 64 + fr, cw = wc * 32 + 8 * fq;
#pragma unroll
        for (int ai = 0; ai < 2; ++ai)
#pragma unroll
            for (int m = 0; m < 4; ++m) { const size_t r = (size_t)(row0 + ai * HALF + m * 16);
                if (u.pn == 0) {
#pragma unroll
                    for (int bj = 0; bj < 2; ++bj)
#pragma unroll
                        for (int n = 0; n < 2; ++n) *(f32x4*)(LG + r * NE + bj * HALF + cw + 4 * n) = acc[ai][bj][m][n];
                } else {
                    const f32x4 v0 = silu4(acc[ai][0][m][0]) * acc[ai][1][m][0], v1 = silu4(acc[ai][0][m][1]) * acc[ai][1][m][1];
                    *(u32x4*)(HS + r * EFF + (u.pn - 1) * HALF + cw) = pack8(v0, v1);
                }
                asm volatile("" ::: "memory"); }
    } };
struct MEpiAct { static constexpr bool PERM = true; static constexpr bool KEEP_ACC = false; bf16_t* ACT;
    DEV void operator()(ACC_T, const Unit& u, int wr, int wc, int fr, int fq) const {
        const int row0 = u.pm * BM + wr * 64 + fr, cw = u.pn * HALF + wc * 32 + 8 * fq;
#pragma unroll
        for (int ai = 0; ai < 2; ++ai) { if (ai == 1 && u.half) break;
#pragma unroll
            for (int m = 0; m < 4; ++m) { const size_t r = (size_t)(row0 + ai * HALF + m * 16);
                const f32x4 v0 = silu4(acc[ai][0][m][0]) * acc[ai][1][m][0], v1 = silu4(acc[ai][0][m][1]) * acc[ai][1][m][1];
                *(u32x4*)(ACT + r * EFF + cw) = pack8(v0, v1); asm volatile("" ::: "memory"); } }
    } };
constexpr float SLAB_SCALE = 4.f, SLAB_INV = 0.25f;
DEV unsigned pk4_fp8(float a, float b, float c, float d) {
    a = fminf(fmaxf(a, -440.f), 440.f); b = fminf(fmaxf(b, -440.f), 440.f); c = fminf(fmaxf(c, -440.f), 440.f); d = fminf(fmaxf(d, -440.f), 440.f);
    int w = 0; w = __builtin_amdgcn_cvt_pk_fp8_f32(a, b, w, false); w = __builtin_amdgcn_cvt_pk_fp8_f32(c, d, w, true); return (unsigned)w; }
struct MEpiSlab { static constexpr bool PERM = true; static constexpr bool KEEP_ACC = false; unsigned char* SLAB; const int* rl; const float* w;
    DEV void operator()(ACC_T, const Unit& u, int wr, int wc, int fr, int fq) const {
        const int row0 = u.pm * BM + wr * 64 + fr, c16 = u.pn * BM + wc * 64 + 16 * fq;
#pragma unroll
        for (int ai = 0; ai < 2; ++ai) { if (ai == 1 && u.half) break;
#pragma unroll
            for (int m = 0; m < 4; ++m) { const int s = rl[row0 + ai * HALF + m * 16]; const float g = w[row0 + ai * HALF + m * 16] * SLAB_SCALE;
                if (s >= 0) { u32x4 o;
                    { const f32x4 a = acc[ai][0][m][0] * g, b = acc[ai][0][m][1] * g; o.x = pk4_fp8(a[0], a[1], a[2], a[3]); o.y = pk4_fp8(b[0], b[1], b[2], b[3]); }
                    { const f32x4 a = acc[ai][1][m][0] * g, b = acc[ai][1][m][1] * g; o.z = pk4_fp8(a[0], a[1], a[2], a[3]); o.w = pk4_fp8(b[0], b[1], b[2], b[3]); }
                    *(u32x4*)(SLAB + (size_t)s * DM + c16) = o; }
                asm volatile("" ::: "memory"); } }
    } };
DEV void acc4_fp8(f32x4& a, unsigned w) { const auto lo = __builtin_amdgcn_cvt_pk_f32_fp8((int)w, false), hi = __builtin_amdgcn_cvt_pk_f32_fp8((int)w, true); a[0] += lo[0]; a[1] += lo[1]; a[2] += hi[0]; a[3] += hi[1]; }
struct MEpiFinal { static constexpr bool PERM = true; static constexpr bool KEEP_ACC = false; float* out; const unsigned char* SLAB; const float* mod;
    DEV void operator()(ACC_T, const Unit& u, int wr, int wc, int fr, int fq) const {
        const int row0 = u.pm * BM + wr * 64 + fr, c16 = u.pn * BM + wc * 64 + 16 * fq;
        const float* gm = mod + ((u.pm * BM) / SEQ) * NMOD + 5120 + c16;
#pragma unroll
        for (int ai = 0; ai < 2; ++ai)
#pragma unroll
            for (int m = 0; m < 4; ++m) { const size_t row = (size_t)(row0 + ai * HALF + m * 16);
                const unsigned char* sp = SLAB + row * 8 * DM + c16;
                float* op = out + row * DM + c16;
                u32x4 sw[8]; f32x4 x[4];
#pragma unroll
                for (int k = 0; k < 8; ++k) sw[k] = *(const u32x4*)(sp + (size_t)k * DM);
#pragma unroll
                for (int q = 0; q < 4; ++q) x[q] = *(const f32x4*)(op + 4 * q);
                f32x4 s4[4];
#pragma unroll
                for (int q = 0; q < 4; ++q) s4[q] = (f32x4){0.f, 0.f, 0.f, 0.f};
#pragma unroll
                for (int k = 0; k < 8; ++k) { acc4_fp8(s4[0], sw[k].x); acc4_fp8(s4[1], sw[k].y); acc4_fp8(s4[2], sw[k].z); acc4_fp8(s4[3], sw[k].w); }
                s4[0] = s4[0] * SLAB_INV + acc[ai][0][m][0]; s4[1] = s4[1] * SLAB_INV + acc[ai][0][m][1]; s4[2] = s4[2] * SLAB_INV + acc[ai][1][m][0]; s4[3] = s4[3] * SLAB_INV + acc[ai][1][m][1];
#pragma unroll
                for (int q = 0; q < 4; ++q) *(f32x4*)(op + 4 * q) = x[q] + *(const f32x4*)(gm + 4 * q) * s4[q];
                asm volatile("" ::: "memory"); }
    } };
#undef ACC_T
}

typedef float f32x16 __attribute__((ext_vector_type(16)));
typedef short s16x4 __attribute__((ext_vector_type(4)));
DEV int crow(int r, int hi) { return (r & 3) + 8 * (r >> 2) + 4 * hi; }
DEV unsigned cvtpk(float lo, float hi) { unsigned r; asm("v_cvt_pk_bf16_f32 %0, %1, %2" : "=v"(r) : "v"(lo), "v"(hi)); return r; }
DEV s16x4 vtr(const LAS unsigned char* p) { return __builtin_bit_cast(s16x4, __builtin_amdgcn_ds_read_tr16_b64_v4i16((LAS s16x4*)p)); }
DEV float swap32(float v) { return __shfl_xor(v, 32); }

DEV void normrope_frag(bf16x8 (&f)[4], const LAS float* gt, int hi, float posf) {
    float x[32]; float ss = 0.f;
#pragma unroll
    for (int d0 = 0; d0 < 4; ++d0) { const u32x4 w = __builtin_bit_cast(u32x4, f[d0]);
        x[8 * d0 + 0] = __uint_as_float(w.x << 16); x[8 * d0 + 1] = __uint_as_float(w.x & 0xffff0000u); x[8 * d0 + 2] = __uint_as_float(w.y << 16); x[8 * d0 + 3] = __uint_as_float(w.y & 0xffff0000u);
        x[8 * d0 + 4] = __uint_as_float(w.z << 16); x[8 * d0 + 5] = __uint_as_float(w.z & 0xffff0000u); x[8 * d0 + 6] = __uint_as_float(w.w << 16); x[8 * d0 + 7] = __uint_as_float(w.w & 0xffff0000u); }
#pragma unroll
    for (int i = 0; i < 32; ++i) ss += x[i] * x[i];
    ss += __shfl_xor(ss, 32);
    const float rs = rsqrtf(ss * (1.f / 64.f) + 1e-6f);
#pragma unroll
    for (int d0 = 0; d0 < 4; ++d0) { const f32x4 g0 = *(const LAS f32x4*)(gt + 16 * d0 + 8 * hi), g1 = *(const LAS f32x4*)(gt + 16 * d0 + 8 * hi + 4);
#pragma unroll
        for (int j = 0; j < 4; ++j) { x[8 * d0 + j] *= rs * g0[j]; x[8 * d0 + 4 + j] *= rs * g1[j]; } }
    constexpr float INVF[8] = {1.0f, 0.19392274474868576f, 0.03760603093086393f, 0.007292664737217109f, 0.001414213562373095f, 0.0002742481756762073f, 5.318295896944988e-05f, 1.031338537721246e-05f};
#pragma unroll
    for (int i = 0; i < 8; ++i) {
        const float rev = posf * (INVF[i] * 0.15915494309189535f);
        const float fr = rev - floorf(rev);
        const float cs = __builtin_amdgcn_cosf(fr), sn = __builtin_amdgcn_sinf(fr);
        const float partner = __shfl_xor(x[i], 32);
        x[i] = hi ? (x[i] * cs + partner * sn) : (x[i] * cs - partner * sn);
    }
#pragma unroll
    for (int d0 = 0; d0 < 4; ++d0) { u32x4 w; w.x = cvtpk(x[8 * d0], x[8 * d0 + 1]); w.y = cvtpk(x[8 * d0 + 2], x[8 * d0 + 3]); w.z = cvtpk(x[8 * d0 + 4], x[8 * d0 + 5]); w.w = cvtpk(x[8 * d0 + 6], x[8 * d0 + 7]);
        f[d0] = __builtin_bit_cast(bf16x8, w); }
}

DEV void ph_attn_mfma(const P& p, LAS unsigned char* lds, int bid, int nb) {
    const int tid = otid(); const int lane = tid & 63, wid = __builtin_amdgcn_readfirstlane(tid >> 6), r32 = lane & 31, hi = lane >> 5;
    LAS unsigned char* vl = lds + wid * 16384;
    LAS float* wsf = (LAS float*)(lds + wid * 16384 + 4096);
    LAS float* gtab_q = (LAS float*)(lds + wid * 16384 + 4352);
    LAS bf16_t* ost = (LAS bf16_t*)(lds + wid * 16384 + 8192);
    LAS float* gtab_k = gtab_q + 64;
    gtab_q[lane] = p.q_norm_g[lane]; gtab_k[lane] = p.k_norm_g[lane];
    asm volatile("s_waitcnt lgkmcnt(0)" ::: "memory");
    float gq = fabsf(p.q_norm_g[lane]), gk = fabsf(p.k_norm_g[lane]);
#pragma unroll
    for (int o = 32; o >= 1; o >>= 1) { gq = fmaxf(gq, __shfl_xor(gq, o)); gk = fmaxf(gk, __shfl_xor(gk, o)); }
    constexpr float LOG2E = 1.4426950408889634f, C2 = 0.125f * LOG2E;
    const float nmref = -(8.f * gq * gk * LOG2E);
    const int head = wid & 3, par = wid >> 2;
    const int tq = (lane & 15) >> 2, tp = lane & 3, tcb = (lane >> 4) & 1;
    const LAS unsigned char* vrd = vl + (4 * hi + tq) * 128 + (16 * tcb + 4 * tp) * 2;
    for (int it2 = bid; it2 < NB * 48; it2 += nb) {
        const int it = it2 * 2 + par;
        const int cb = it & 31, g = (it >> 5) % 3, b = it / 96;
        const int dsh = 2 * g, d = 1 << dsh, L = SEQ >> dsh, nbk = L >> 6;
        const int r = cb / nbk, blk = cb % nbk;
        const int h = 4 * g + head, base = b * SEQ;
        const int q0 = 64 * blk;
        const int mqa = q0 + r32, mqb = q0 + 32 + r32;
        bf16x8 qa[4], qb[4];
        { const bf16_t* qp = p.QKV + (size_t)(base + mqa * d + r) * 2304 + h * 64 + hi * 8;
#pragma unroll
          for (int d0 = 0; d0 < 4; ++d0) qa[d0] = *(const bf16x8*)(qp + d0 * 16);
          const bf16_t* qp2 = p.QKV + (size_t)(base + mqb * d + r) * 2304 + h * 64 + hi * 8;
#pragma unroll
          for (int d0 = 0; d0 < 4; ++d0) qb[d0] = *(const bf16x8*)(qp2 + d0 * 16); }
        const float pqa = (float)p.pos[base + mqa * d + r], pqb = (float)p.pos[base + mqb * d + r];
        normrope_frag(qa, gtab_q, hi, pqa); normrope_frag(qb, gtab_q, hi, pqb);
        f32x16 oa0, oa1, ob0, ob1;
#pragma unroll
        for (int i = 0; i < 16; ++i) { oa0[i] = 0.f; oa1[i] = 0.f; ob0[i] = 0.f; ob1[i] = 0.f; }
        float lsa = 0.f, lsb = 0.f;
        const int kb0 = q0 - 64;
#pragma unroll 1
        for (int st = 0; st < 6; ++st) {
            const int k0 = kb0 + 32 * st;
            if (k0 + 31 < 0 || k0 >= L) continue;
            const int mkc = min(max(k0 + r32, 0), L - 1);
            const bf16_t* kp = p.QKV + (size_t)(base + mkc * d + r) * 2304 + 768 + h * 64 + hi * 8;
            bf16x8 kf[4];
#pragma unroll
            for (int d0 = 0; d0 < 4; ++d0) kf[d0] = *(const bf16x8*)(kp + d0 * 16);
            const float kposf = (float)p.pos[base + mkc * d + r];
            u32x4 vreg[4];
#pragma unroll
            for (int i = 0; i < 4; ++i) { const int c = lane + 64 * i, row = c >> 3, ch = c & 7; const int mv = min(max(k0 + row, 0), L - 1);
                vreg[i] = *(const u32x4*)(p.QKV + (size_t)(base + mv * d + r) * 2304 + 1536 + h * 64 + ch * 8); }
            normrope_frag(kf, gtab_k, hi, kposf);
            const bool doa = st < 5, dob = st > 0;
            bf16x8 pa0, pa1, pb0, pb1;
#define ATT_SCORES(QR, MQ, LS, PF0, PF1) do { f32x16 s_; _Pragma("unroll") for (int i = 0; i < 16; ++i) s_[i] = 0.f; \
                _Pragma("unroll") for (int d0 = 0; d0 < 4; ++d0) s_ = __builtin_amdgcn_mfma_f32_32x32x16_bf16(kf[d0], QR[d0], s_, 0, 0, 0); \
                _Pragma("unroll") for (int i = 0; i < 16; ++i) { const int key = k0 + crow(i, hi); const int df = key - (MQ); \
                    const bool valid = (key >= 0) && (key < L) && (df <= 64) && (df >= -64); \
                    const float pv = valid ? __builtin_amdgcn_exp2f(__builtin_fmaf(s_[i], C2, nmref)) : 0.f; LS += pv; s_[i] = pv; } \
                u32x4 w0, w1; w0.x = cvtpk(s_[0], s_[1]); w0.y = cvtpk(s_[2], s_[3]); w0.z = cvtpk(s_[4], s_[5]); w0.w = cvtpk(s_[6], s_[7]); \
                w1.x = cvtpk(s_[8], s_[9]); w1.y = cvtpk(s_[10], s_[11]); w1.z = cvtpk(s_[12], s_[13]); w1.w = cvtpk(s_[14], s_[15]); \
                PF0 = __builtin_bit_cast(bf16x8, w0); PF1 = __builtin_bit_cast(bf16x8, w1); } while (0)
            if (doa) ATT_SCORES(qa, mqa, lsa, pa0, pa1);
            if (dob) ATT_SCORES(qb, mqb, lsb, pb0, pb1);
#undef ATT_SCORES
#pragma unroll
            for (int i = 0; i < 4; ++i) { const int c = lane + 64 * i, row = c >> 3, ch = c & 7; *(LAS u32x4*)(vl + row * 128 + ch * 16) = vreg[i]; }
            asm volatile("s_waitcnt lgkmcnt(0)" ::: "memory");
#pragma unroll
            for (int n = 0; n < 2; ++n)
#pragma unroll
                for (int ks = 0; ks < 2; ++ks) {
                    const s16x4 lo = vtr(vrd + (16 * ks) * 128 + 64 * n), hi4 = vtr(vrd + (16 * ks + 8) * 128 + 64 * n);
                    bf16x8 vf; vf[0] = lo[0]; vf[1] = lo[1]; vf[2] = lo[2]; vf[3] = lo[3]; vf[4] = hi4[0]; vf[5] = hi4[1]; vf[6] = hi4[2]; vf[7] = hi4[3];
                    if (doa) { if (n == 0) oa0 = __builtin_amdgcn_mfma_f32_32x32x16_bf16(ks == 0 ? pa0 : pa1, vf, oa0, 0, 0, 0);
                               else oa1 = __builtin_amdgcn_mfma_f32_32x32x16_bf16(ks == 0 ? pa0 : pa1, vf, oa1, 0, 0, 0); }
                    if (dob) { if (n == 0) ob0 = __builtin_amdgcn_mfma_f32_32x32x16_bf16(ks == 0 ? pb0 : pb1, vf, ob0, 0, 0, 0);
                               else ob1 = __builtin_amdgcn_mfma_f32_32x32x16_bf16(ks == 0 ? pb0 : pb1, vf, ob1, 0, 0, 0); }
                }
            asm volatile("s_waitcnt lgkmcnt(0)" ::: "memory");
        }
        const float lta = lsa + swap32(lsa), ltb = lsb + swap32(lsb);
        if (hi == 0) { wsf[r32] = 1.f / lta; wsf[32 + r32] = 1.f / ltb;
            p.LSUM[((size_t)g * T + (base + mqa * d + r)) * 4 + head] = lta; p.LSUM[((size_t)g * T + (base + mqb * d + r)) * 4 + head] = ltb; }
        asm volatile("s_waitcnt lgkmcnt(0)" ::: "memory");
        LAS bf16_t* ob_ = ost + 4 * hi * 64 + r32;
#pragma unroll
        for (int i = 0; i < 16; ++i) { const int qc = (i & 3) + 8 * (i >> 2); const float ia = wsf[4 * hi + qc];
            ob_[qc * 64] = f2bf(oa0[i] * ia); ob_[qc * 64 + 32] = f2bf(oa1[i] * ia); }
        asm volatile("" ::: "memory");
#pragma unroll
        for (int i = 0; i < 16; ++i) { const int qc = (i & 3) + 8 * (i >> 2); const float ib = wsf[32 + 4 * hi + qc];
            ob_[(32 + qc) * 64] = f2bf(ob0[i] * ib); ob_[(32 + qc) * 64 + 32] = f2bf(ob1[i] * ib); }
        asm volatile("s_waitcnt lgkmcnt(0)" ::: "memory");
        bf16_t* og = p.OG + (size_t)g * T * 256 + head * 64;
#pragma unroll
        for (int i = 0; i < 8; ++i) { const int c = lane + 64 * i, qrow = c >> 3, ch = c & 7;
            const u32x4 w = *(const LAS u32x4*)(ost + qrow * 64 + ch * 8);
            *(u32x4*)(og + (size_t)(base + (q0 + qrow) * d + r) * 256 + ch * 8) = w; }
        asm volatile("s_waitcnt lgkmcnt(0)" ::: "memory");
    }
}
DEV void ph_attn_combine(const P& p, int bid, int nb) {
    const int tid_ = otid();
    for (int i = bid * NTHR + tid_; i < T * 32; i += nb * NTHR) {
        const int t = i >> 5, ch = i & 31, slot = ch >> 3;
        const float l0 = p.LSUM[(size_t)t * 4 + slot], l1 = p.LSUM[((size_t)T + t) * 4 + slot], l2 = p.LSUM[((size_t)2 * T + t) * 4 + slot];
        const float inv = 1.f / (l0 + l1 + l2);
        const u32x4 a = *(const u32x4*)(p.OG + (size_t)t * 256 + ch * 8), b = *(const u32x4*)(p.OG + ((size_t)T + t) * 256 + ch * 8), c = *(const u32x4*)(p.OG + ((size_t)2 * T + t) * 256 + ch * 8);
        const f32x4 lo = (mg::unpack_lo(a) * l0 + mg::unpack_lo(b) * l1 + mg::unpack_lo(c) * l2) * inv;
        const f32x4 hi = (mg::unpack_hi(a) * l0 + mg::unpack_hi(b) * l1 + mg::unpack_hi(c) * l2) * inv;
        *(u32x4*)(p.PL + (size_t)t * 768 + 512 + ch * 8) = mg::pack8(lo, hi);
    }
}

template <class Src>
DEV void transpose_blk(const Src& src, int K, bf16_t* WT0, LAS float* scr, int k0, int lane) {
#pragma unroll 8
    for (int i = 0; i < 32; ++i) { const int kk = 2 * i + (lane >> 5); scr[kk * 33 + (lane & 31)] = src(k0 + kk, lane & 31); }
    asm volatile("s_waitcnt lgkmcnt(0)" ::: "memory");
    const int c = lane & 7;
#pragma unroll
    for (int j = 0; j < 4; ++j) { const int n = (lane >> 3) + 8 * j; const LAS float* s = scr + (8 * c) * 33 + n;
        u32x4 o; o.x = pk2(s[0 * 33], s[1 * 33]); o.y = pk2(s[2 * 33], s[3 * 33]); o.z = pk2(s[4 * 33], s[5 * 33]); o.w = pk2(s[6 * 33], s[7 * 33]);
        *(u32x4*)(WT0 + (size_t)n * K + k0 + 8 * c) = o; }
    asm volatile("s_waitcnt lgkmcnt(0)" ::: "memory");
}
struct SrcCol { const float* W; int ld; DEV float operator()(int k, int j) const { return W[(size_t)k * ld + j]; } };
struct SrcEff { const float *wg, *ls, *wu;
    DEV float operator()(int k, int j) const { const int g = k >> 7; const float* a = wg + (size_t)k * 128; const float* l = ls + g * 128; const float* b = wu + (size_t)(g * 128) * DM + j; float s = 0.f;
#pragma unroll 4
        for (int d = 0; d < 128; ++d) s += a[d] * l[d] * b[(size_t)d * DM]; return s; } };
DEV void tr_plain(const float* W, int K, int N, bf16_t* WT, LAS float* scr, int item, int lane) {
    const int nblk = N / 32, k0 = 64 * (item / nblk), n0 = 32 * (item % nblk);
    transpose_blk(SrcCol{W + n0, N}, K, WT + (size_t)n0 * K, scr, k0, lane);
}
DEV void tr_perm16(const float* W, int K, int N, bf16_t* WT, LAS float* scr, int item, int lane) {
    const int nblk = N / 32, k0 = 64 * (item / nblk), rho0 = 32 * (item % nblk);
    const int tile = rho0 >> 8, bj = (rho0 >> 7) & 1, wc = (rho0 >> 5) & 3;
    const int n0 = tile * 256 + 64 * wc + 8 * bj;
    struct SrcP { const float* W; int ld; DEV float operator()(int k, int dr) const { return W[(size_t)k * ld + 16 * (dr >> 3) + (dr & 7)]; } };
    transpose_blk(SrcP{W + n0, N}, K, WT + (size_t)rho0 * K, scr, k0, lane);
}
DEV void tr_gu(const float* g, const float* u, int K, bf16_t* WT, LAS float* scr, int k0, int rho0, int lane) {
    const int ch0 = (rho0 >> 8) * 128 + (rho0 & 127);
    const float* m = (rho0 & 128) ? u : g;
    transpose_blk(SrcCol{m + ch0, EFF}, K, WT + (size_t)rho0 * K, scr, k0, lane);
}

DEV void ph_prep_small(const P& p, LAS float* scr, int gw, int ngw, int lane) {
    constexpr int I_IN = 16 * (INW / 32), I_EFF = 64 * 16, I_AU = 4 * 32, I_OUT = 16 * 32, I_R = 16 * 8, I_S = 16 * 16, I_SD = 4 * 32;
    constexpr int NIT = I_IN + I_EFF + I_AU + I_OUT + I_R + I_S + I_SD;
    for (int it = gw; it < NIT; it += ngw) {
        int r = it;
        if (r < I_IN) { tr_plain(p.w_in, DM, INW, p.WT_IN, scr, r, lane); continue; } r -= I_IN;
        if (r < I_EFF) {
            const int n = 64 * (r & 15) + lane, k0 = 8 * (r >> 4), g = k0 >> 7;
            const float* a = p.pool_w_grp + (size_t)k0 * 128; const float* l = p.pool_scale + g * 128; const float* b = p.w_pool_up + (size_t)(g * 128) * DM + n;
            float acc[8];
#pragma unroll
            for (int j = 0; j < 8; ++j) acc[j] = 0.f;
#pragma unroll 4
            for (int d = 0; d < 128; ++d) { const float bl = b[(size_t)d * DM] * l[d];
#pragma unroll
                for (int j = 0; j < 8; ++j) acc[j] += a[j * 128 + d] * bl; }
            u32x4 o; o.x = pk2(acc[0], acc[1]); o.y = pk2(acc[2], acc[3]); o.z = pk2(acc[4], acc[5]); o.w = pk2(acc[6], acc[7]);
            *(u32x4*)(p.WT_EFF + (size_t)n * 768 + k0) = o; continue; } r -= I_EFF;
        if (r < I_AU) { const int k0 = 64 * (r / 32), n0 = 32 * (r % 32);
            transpose_blk(SrcCol{p.w_attn_up + n0, DM}, 768, p.WT_EFF + (size_t)n0 * 768 + 512, scr, k0, lane); continue; } r -= I_AU;
        if (r < I_OUT) { tr_plain(p.w_out, DM, DM, p.WT_OUT, scr, r, lane); continue; } r -= I_OUT;
        if (r < I_R) { tr_plain(p.w_router, DM, NE, p.WT_RS, scr, r, lane); continue; } r -= I_R;
        if (r < I_S) { tr_gu(p.w_sg, p.w_su, DM, p.WT_RS + (size_t)256 * DM, scr, 64 * (r / 16), 32 * (r % 16), lane); continue; } r -= I_S;
        tr_perm16(p.w_sd, EFF, DM, p.WT_SD, scr, r, lane);
    }
}
DEV void ph_prep_ed2(const P& p, LAS float* scr, int gw, int ngw, int lane) {
    constexpr int IPE = 4 * 32, NIT = NE * IPE;
    for (int it = gw * 2; it < NIT; it += ngw * 2) {
        const float* src[2]; bf16_t* dst[2]; int k0[2];
#pragma unroll
        for (int q = 0; q < 2; ++q) { const int t_ = it + q, e = t_ / IPE, item = t_ % IPE, nblk = DM / 32; k0[q] = 64 * (item / nblk); const int rho0 = 32 * (item % nblk);
            const int tile = rho0 >> 8, bj = (rho0 >> 7) & 1, wc = (rho0 >> 5) & 3, n0 = tile * 256 + 64 * wc + 8 * bj;
            src[q] = p.w_ed + (size_t)e * EFF * DM + n0; dst[q] = p.WT_ED + (size_t)e * DM * EFF + (size_t)rho0 * EFF; }
        const int dr = lane & 31, cofs = 16 * (dr >> 3) + (dr & 7);
        float v[2][32];
#pragma unroll
        for (int q = 0; q < 2; ++q)
#pragma unroll
            for (int i = 0; i < 32; ++i) v[q][i] = src[q][(size_t)(k0[q] + 2 * i + (lane >> 5)) * DM + cofs];
#pragma unroll
        for (int q = 0; q < 2; ++q)
#pragma unroll
            for (int i = 0; i < 32; ++i) scr[q * 2112 + (2 * i + (lane >> 5)) * 33 + dr] = v[q][i];
        asm volatile("s_waitcnt lgkmcnt(0)" ::: "memory");
        const int c = lane & 7;
#pragma unroll
        for (int q = 0; q < 2; ++q)
#pragma unroll
            for (int j = 0; j < 4; ++j) { const int n = (lane >> 3) + 8 * j; const LAS float* sp = scr + q * 2112 + (8 * c) * 33 + n;
                u32x4 o; o.x = pk2(sp[0 * 33], sp[1 * 33]); o.y = pk2(sp[2 * 33], sp[3 * 33]); o.z = pk2(sp[4 * 33], sp[5 * 33]); o.w = pk2(sp[6 * 33], sp[7 * 33]);
                *(u32x4*)(dst[q] + (size_t)n * EFF + k0[q] + 8 * c) = o; }
        asm volatile("s_waitcnt lgkmcnt(0)" ::: "memory");
    }
}
DEV void ph_prep_ed(const P& p, LAS float* scr, int gw, int ngw, int lane) {
    constexpr int IPE = 4 * 32;
    for (int it = gw; it < NE * IPE; it += ngw) { const int e = it / IPE;
        tr_perm16(p.w_ed + (size_t)e * EFF * DM, EFF, DM, p.WT_ED + (size_t)e * DM * EFF, scr, it % IPE, lane); }
}
DEV void ph_prep_egu(const P& p, LAS float* scr, int gw, int ngw, int lane) {
    constexpr int IPE = 16 * 16;
    for (int it = gw; it < NE * IPE; it += ngw) { const int e = it / IPE, r = it % IPE;
        tr_gu(p.w_eg + (size_t)e * DM * EFF, p.w_eu + (size_t)e * DM * EFF, DM, p.WT_EGU + (size_t)e * 512 * DM, scr, 64 * (r / 16), 32 * (r % 16), lane); }
}

constexpr int LDS_BYTES = 155648;
constexpr int LDS_OFF_TAB = 131072;
constexpr int LDS_GTAB = 131072 + 4096;
constexpr int MAXU = 16;
constexpr int LDS_MISC = LDS_GTAB + MAXU * 1024;

DEV void fill_gtab(const P& p, const mg::ExpertOrder& S, LAS unsigned* gtab) {
    const int tid_ = otid();
    for (int i = 0; i < MAXU; ++i) { int pm, pn, e; if (!S.tile_of(i, pm, pn, e)) break;
        if (tid_ < 256) { const int s = p.rowlist[pm * 256 + tid_]; gtab[i * 256 + tid_] = (unsigned)(s < 0 ? 0 : (s >> 3)) * (unsigned)(DM * 2); } }
    __syncthreads();
}

#define GAS __attribute__((address_space(1)))
#define XB_TMO      128
#define XB_XCNT(j)  (256  + 64 * (j))
#define XB_XSUB(j)  (1280 + 64 * (j))
#define XB_XGEN(j)  (2304 + 64 * (j))
#define XB_TOP      3328
#define XB_TOPGEN   3392
#define XCD_BAR_WORDS 3456
#define XB_SPIN_CAP (1u << 18)
DEV unsigned xb_ld(unsigned* p)              { return __hip_atomic_load(p, __ATOMIC_RELAXED, __HIP_MEMORY_SCOPE_AGENT); }
DEV unsigned xb_add(unsigned* p, unsigned v) { return __hip_atomic_fetch_add(p, v, __ATOMIC_RELAXED, __HIP_MEMORY_SCOPE_AGENT); }
DEV unsigned xb_xcc_id() { return (unsigned)__builtin_amdgcn_s_getreg((3 << 11) | 20) & 0xFu; }
#define XB_SPIN(cond, bar) do { unsigned _sp = 0; while (cond) { __builtin_amdgcn_s_sleep(1); \
    if ((++_sp & 255u) == 0u) { if (xb_ld(&(bar)[XB_TMO])) break; if (_sp > XB_SPIN_CAP) { atomicAdd(&(bar)[XB_TMO], 1u); break; } } } } while (0)
struct XcdBarrier { unsigned* bar; unsigned x; volatile LAS unsigned* st; };
DEV XcdBarrier xcd_barrier_post(unsigned* bar, volatile LAS unsigned* st) {
    XcdBarrier b; b.bar = bar; b.x = xb_xcc_id(); b.st = st;
    if (threadIdx.x == 0) (void)xb_add(&bar[XB_XCNT(b.x)], 1u);
    return b;
}
DEV void xcd_barrier_complete(unsigned* bar, unsigned x, unsigned& nloc, unsigned& nx) {
    const unsigned G = gridDim.x * gridDim.y * gridDim.z;
    unsigned sum, cnt, mine, sp = 0u;
    for (;;) {
        sum = 0u; cnt = 0u; mine = 0u;
#pragma unroll
        for (unsigned j = 0; j < 16; ++j) { const unsigned c = xb_ld(&bar[XB_XCNT(j)]); sum += c; cnt += (c > 0u) ? 1u : 0u; mine = (j == x) ? c : mine; }
        if (sum == G) break;
        __builtin_amdgcn_s_sleep(1);
        if ((++sp & 255u) == 0u) { if (xb_ld(&bar[XB_TMO])) break; if (sp > XB_SPIN_CAP) { atomicAdd(&bar[XB_TMO], 1u); break; } }
    }
    nloc = mine > 0u ? mine : 1u; nx = cnt > 0u ? cnt : 1u;
}
DEV void xcd_barrier(const XcdBarrier& b) {
    asm volatile("s_waitcnt vmcnt(0)" ::: "memory");
    __syncthreads();
    if (threadIdx.x == 0) {
        unsigned* bar = b.bar;
        __builtin_amdgcn_s_waitcnt(0);
        unsigned nloc = b.st[0], nx = b.st[1];
        if (nloc == 0u) { xcd_barrier_complete(bar, b.x, nloc, nx); b.st[0] = nloc; b.st[1] = nx; }
        const unsigned old = xb_add(&bar[XB_XSUB(b.x)], 1u);
        const unsigned gen = old / nloc;
        if (old + 1u == (gen + 1u) * nloc) {
            __builtin_amdgcn_fence(__ATOMIC_RELEASE, "agent");
            asm volatile("s_waitcnt vmcnt(0)" ::: "memory");
            const unsigned og = xb_add(&bar[XB_TOP], 1u);
            const unsigned tg = og / nx;
            if (og + 1u == (tg + 1u) * nx) xb_add(&bar[XB_TOPGEN], 1u);
            else XB_SPIN(xb_ld(&bar[XB_TOPGEN]) == tg, bar);
            __builtin_amdgcn_fence(__ATOMIC_ACQUIRE, "agent");
            xb_add(&bar[XB_XGEN(b.x)], 1u);
            asm volatile("s_waitcnt vmcnt(0)" ::: "memory");
        } else {
            XB_SPIN(xb_ld(&bar[XB_XGEN(b.x)]) == gen, bar);
            __builtin_amdgcn_fence(__ATOMIC_ACQUIRE, "agent");
            asm volatile("s_waitcnt vmcnt(0)" ::: "memory");
        }
    }
    __syncthreads();
}

#define STAMP() do { if (TPROBE >= 0) { if (bid == 0 && threadIdx.x == 0) p.ts[nst] = __builtin_amdgcn_s_memrealtime(); ++nst; } } while (0)
#define GSYNC_CG() do { cg::this_grid().sync(); STAMP(); } while (0)
#define GSYNC() do { xcd_barrier(xbar); STAMP(); } while (0)
__global__ void __launch_bounds__(NTHR, 2) fwd_all(P p) {
    extern __shared__ __attribute__((aligned(16))) unsigned char lds_raw[];
    LAS unsigned char* lds = (LAS unsigned char*)lds_raw;
    float* sm = (float*)lds_raw;
    int* off = (int*)(lds_raw + LDS_OFF_TAB);
    const LAS int* offl = (const LAS int*)(lds + LDS_OFF_TAB);
    LAS unsigned* gtab = (LAS unsigned*)(lds + LDS_GTAB);
    const int bid = blockIdx.x, nb = gridDim.x;
    const int tid_ = otid(); const int lane = tid_ & 63, wv = tid_ >> 6;
    LAS float* scr = (LAS float*)(lds + wv * 16384);
    const int gw = bid * NWV + wv, ngw = nb * NWV;
    volatile LAS unsigned* misc = (volatile LAS unsigned*)(lds + LDS_MISC);
    if (threadIdx.x < 2) misc[threadIdx.x] = 0u;
    __syncthreads();
    const XcdBarrier xbar = xcd_barrier_post(p.bar, misc);
    int nst = 0; STAMP();

    ph_mod(p, sm, bid, nb);
    __syncthreads();
    REPEAT(1) ph_prep_small(p, scr, gw, ngw, lane);
#if MF_EXP2
    REPEAT(2) ph_prep_ed(p, scr, gw, ngw, lane);
#endif
    GSYNC();
    REPEAT(3) ph_norm(p.x, p.norm1_g, p.mod, 0, 1024, p.XB, bid, nb);
    GSYNC();
#if MF_INPROJ
    REPEAT(4) { mg::DenseOrder S; S.init(p.XB, p.WT_IN, T, INW, DM, nb, bid);
      mg::gemm_phase<mg::MEpiInProj, mg::DenseOrder, false>(lds, gtab, DM, S, mg::MEpiInProj{p.U, p.QKV, p.G}); }
#else
    ngemm_dense<false>(p.XB, DM, p.w_in, nullptr, INW, T, INW, DM, EpiInProj{p.U, p.QKV, p.G}, sm, bid, nb);
#endif
    GSYNC();
#if !MF_ATTN
    ph_qknorm(p, bid, nb);
#endif
    REPEAT(5) ph_pool(p, bid, nb);
#if !MF_ATTN
    GSYNC();
#endif
#if MF_ATTN
    REPEAT(6) ph_attn_mfma(p, lds, bid, nb);
    GSYNC();
    REPEAT(7) ph_attn_combine(p, bid, nb);
#else
    ph_attn(p, bid, nb);
#endif
#if !MF_MERGE
#pragma unroll 1
    for (int g = 0; g < 4; ++g) ngemm_dense<false>(p.PL + g * 128, 512, p.pool_w_grp + g * 128 * 128, nullptr, 128, T, 128, 128, EpiPoolGrp{p.Y, p.pool_scale, g}, sm, bid, nb);
#endif
    GSYNC();
#if MF_MERGE
    REPEAT(8) { mg::PairOrder S; S.D.init(p.PL, p.WT_EFF, T, DM, 768, nb, bid); S.kt0 = 8; S.kt1 = 4;
      mg::gemm_phase<mg::MEpiMergeF, mg::PairOrder, false>(lds, gtab, 768, S, mg::MEpiMergeF{p.XB, p.G}); }
#else
    ngemm_dense<false>(p.Y, 512, p.w_pool_up, nullptr, DM, T, DM, 512, EpiMergeA{p.XB, p.G}, sm, bid, nb);
    GSYNC();
    ngemm_dense<false>(p.O, 256, p.w_attn_up, nullptr, DM, T, DM, 256, EpiMergeB{p.XB, p.G}, sm, bid, nb);
#endif
    GSYNC();
#if MF_OUT
    REPEAT(9) { mg::DenseOrder S; S.init(p.XB, p.WT_OUT, T, DM, DM, nb, bid);
      mg::gemm_phase<mg::MEpiOutProj, mg::DenseOrder, false>(lds, gtab, DM, S, mg::MEpiOutProj{p.x, p.out, p.mod}); }
#else
    ngemm_dense<false>(p.XB, DM, p.w_out, nullptr, DM, T, DM, DM, EpiOutProj{p.x, p.out, p.mod}, sm, bid, nb);
#endif
    GSYNC();
    REPEAT(10) ph_norm(p.out, p.norm2_g, p.mod, 3072, 4096, p.XB, bid, nb);
#if MF_EXP1
    __syncthreads();
    REPEAT(11) ph_prep_egu(p, scr, gw, ngw, lane);
#endif
    GSYNC();
#if MF_ROUTER
    REPEAT(12) { mg::DenseOrder S; S.init(p.XB, p.WT_RS, T, 768, DM, nb, bid);
      mg::gemm_phase<mg::MEpiRouterShared, mg::DenseOrder, false>(lds, gtab, DM, S, mg::MEpiRouterShared{p.LG, p.HS}); }
#else
    ngemm_dense<false>(p.XB, DM, p.w_router, nullptr, NE, T, NE, DM, EpiLogits{p.LG}, sm, bid, nb);
#endif
    GSYNC();
    ph_route(p, (int*)lds_raw, bid, nb);
    GSYNC();
    ph_scatter(p, off, bid, nb);
    GSYNC();
#if MF_EXP1
    REPEAT(13) { load_offsets(p.cnt, off);
      mg::ExpertOrder S{offl, 2, nb, bid, (const char*)p.XB, (const char*)p.WT_EGU, (size_t)512 * DM * 2, (size_t)256 * DM * 2, 0, true, p.rowlist, MAXU};
      fill_gtab(p, S, gtab);
      mg::gemm_phase<mg::MEpiAct, mg::ExpertOrder, true>(lds, gtab, DM, S, mg::MEpiAct{p.ACT}); }
#else
    ph_expert1(p, sm, off, bid, nb);
#endif
    GSYNC();
#if MF_EXP2
    REPEAT(14) { load_offsets(p.cnt, off);
      mg::ExpertOrder S{offl, 4, nb, bid, (const char*)p.ACT, (const char*)p.WT_ED, (size_t)DM * EFF * 2, (size_t)256 * EFF * 2, (size_t)256 * EFF * 2, false, p.rowlist, MAXU};
      mg::gemm_phase<mg::MEpiSlab, mg::ExpertOrder, false>(lds, gtab, EFF, S, mg::MEpiSlab{(unsigned char*)p.SLAB, p.rowlist, p.roww}); }
#else
    ph_expert2(p, sm, off, bid, nb);
#endif
    GSYNC();
#if !MF_ROUTER
    ngemm_dense<true>(p.XB, DM, p.w_sg, p.w_su, EFF, T, EFF, DM, EpiAct{p.HS}, sm, bid, nb);
    GSYNC();
#endif
#if MF_FINAL
    { mg::DenseOrder S; S.init(p.HS, p.WT_SD, T, DM, EFF, nb, bid);
      mg::gemm_phase<mg::MEpiFinal, mg::DenseOrder, false>(lds, gtab, EFF, S, mg::MEpiFinal{p.out, (const unsigned char*)p.SLAB, p.mod}); }
#else
    ngemm_dense<false>(p.HS, EFF, p.w_sd, nullptr, DM, T, DM, EFF, EpiFinal{p.out, p.SLAB, p.mod}, sm, bid, nb);
#endif
#if TPROBE >= 0
    GSYNC();
    if (bid == 0 && threadIdx.x == 0) { const unsigned long long dt = p.ts[TPROBE + 1] - p.ts[TPROBE]; p.out[0] += (float)dt * 0.01f / TSCALE; }
#endif
}

extern "C" void kernel_launch(void* const* d_in, const int* in_sizes, int n_in, void* d_out, int out_size, void* d_ws, size_t ws_size, hipStream_t stream) {
    static int grid = 0;
    if (grid == 0) {
        int dev = 0, cus = 0;
        (void)hipGetDevice(&dev);
        (void)hipDeviceGetAttribute(&cus, hipDeviceAttributeMultiprocessorCount, dev);
        int per_cu = 0;
        (void)hipFuncSetAttribute((const void*)fwd_all, hipFuncAttributeMaxDynamicSharedMemorySize, LDS_BYTES);
        (void)hipOccupancyMaxActiveBlocksPerMultiprocessor(&per_cu, fwd_all, NTHR, LDS_BYTES);
        if (per_cu < 1) { fprintf(stderr, "kernel_launch: occupancy query says %d blocks/CU\n", per_cu); per_cu = 1; }
        if (per_cu > 1) per_cu = 1;
        grid = cus * per_cu;
        if (ws_size < WS_END) { fprintf(stderr, "kernel_launch: workspace too small (%zu < %zu)\n", ws_size, (size_t)WS_END); grid = -1; }
    }
    if (grid < 0) return;
    P p{};
    const float* const* in = (const float* const*)d_in;
    p.x = in[0]; p.c = in[1]; p.pos = (const int*)d_in[2];
    p.w_ada = in[3]; p.b_ada = in[4]; p.norm1_g = in[5]; p.w_in = in[6]; p.pool_w_grp = in[7]; p.pool_scale = in[8]; p.q_norm_g = in[9]; p.k_norm_g = in[10];
    p.w_pool_up = in[11]; p.w_attn_up = in[12]; p.w_out = in[13]; p.norm2_g = in[14]; p.w_router = in[15]; p.router_bias = in[16];
    p.w_sg = in[17]; p.w_su = in[18]; p.w_sd = in[19]; p.w_eg = in[20]; p.w_eu = in[21]; p.w_ed = in[22];
    p.out = (float*)d_out;
    char* ws = (char*)d_ws;
    p.mod = (float*)(ws + WS_MOD); p.cnt = (int*)(ws + WS_CNT); p.asg_e = (int*)(ws + WS_ASG_E); p.asg_pos = (int*)(ws + WS_ASG_POS);
    p.asg_w = (float*)(ws + WS_ASG_W); p.rowlist = (int*)(ws + WS_ROWLIST);
    p.XB = (bf16_t*)(ws + WS_XB); p.U = (bf16_t*)(ws + WS_U); p.QKV = (bf16_t*)(ws + WS_QKV); p.G = (bf16_t*)(ws + WS_G); p.PL = (bf16_t*)(ws + WS_PL);
    p.Y = (bf16_t*)(ws + WS_Y); p.O = (bf16_t*)(ws + WS_O); p.ACT = (bf16_t*)(ws + WS_ACT); p.SLAB = (bf16_t*)(ws + WS_SLAB); p.HS = (bf16_t*)(ws + WS_HS);
    p.LG = (float*)(ws + WS_ACT);
    p.roww = (float*)(ws + WS_ROWW);
    p.bar = (unsigned*)(ws + WS_BAR); p.ts = (unsigned long long*)(ws + WS_TS);
    p.OG = (bf16_t*)(ws + WS_OG); p.LSUM = (float*)(ws + WS_LSUM);
    p.WT_IN = (bf16_t*)(ws + WS_WT_IN); p.WT_EFF = (bf16_t*)(ws + WS_WT_EFF); p.WT_AU = (bf16_t*)(ws + WS_WT_AU); p.WT_OUT = (bf16_t*)(ws + WS_WT_OUT);
    p.WT_RS = (bf16_t*)(ws + WS_WT_RS); p.WT_SD = (bf16_t*)(ws + WS_WT_SD); p.WT_EGU = (bf16_t*)(ws + WS_WT_EGU); p.WT_ED = (bf16_t*)(ws + WS_WT_ED);
    (void)hipMemsetAsync(ws + WS_BAR, 0, WS_ZERO_BYTES, stream);
    void* args[] = {&p};
    hipError_t e = hipLaunchCooperativeKernel((void*)fwd_all, dim3(grid), dim3(NTHR), args, LDS_BYTES, stream);
    if (e != hipSuccess) fprintf(stderr, "cooperative launch failed: %s (grid %d)\n", hipGetErrorString(e), grid);
}
```

```cpp
#include <hip/hip_runtime.h>
#include <hip/hip_cooperative_groups.h>
#include <stdint.h>
#include <cstdio>
namespace cg = cooperative_groups;

#ifndef ONE_LAUNCH
#define ONE_LAUNCH 0
#endif

typedef unsigned short bf16_t;
#define DEV __device__ __forceinline__
#define LAS __attribute__((address_space(3)))
typedef short bf16x8 __attribute__((ext_vector_type(8)));
typedef float f32x4 __attribute__((ext_vector_type(4)));
typedef unsigned u32x4 __attribute__((ext_vector_type(4)));
typedef unsigned u32x2 __attribute__((ext_vector_type(2)));

#ifndef MF_INPROJ
#define MF_INPROJ 1
#endif
#ifndef MF_MERGE
#define MF_MERGE 1
#endif
#ifndef MF_OUT
#define MF_OUT 1
#endif
#ifndef MF_ROUTER
#define MF_ROUTER 1
#endif
#ifndef MF_EXP1
#define MF_EXP1 1
#endif
#ifndef MF_EXP2
#define MF_EXP2 1
#endif
#ifndef MF_ATTN
#define MF_ATTN 1
#endif
#ifndef DUP
#define DUP 0
#endif
#ifndef TPROBE
#define TPROBE -1
#endif
#ifndef TSCALE
#define TSCALE 10.0f
#endif
#define REPEAT(n) _Pragma("unroll 1") for (int rep_ = 0; rep_ < ((DUP == (n)) ? 2 : 1); ++rep_)
#ifndef MF_FINAL
#define MF_FINAL 1
#endif

constexpr int NB = 16, SEQ = 2048, DM = 1024, T = NB * SEQ;
constexpr int INW = 4864, NMOD = 6144;
constexpr int NE = 256, EFF = 256;
constexpr int NTHR = 512, NWV = 8;
constexpr int NSLOT = T * 8;
constexpr int RMAX = NSLOT + NE * 256;

DEV float bf2f(bf16_t h) { return __uint_as_float(((unsigned)h) << 16); }
DEV bf16_t f2bf(float f) { unsigned u = __float_as_uint(f); u += 0x7fffu + ((u >> 16) & 1u); return (bf16_t)(u >> 16); }
DEV unsigned pk2(float lo, float hi) { return (unsigned)f2bf(lo) | ((unsigned)f2bf(hi) << 16); }
DEV float sigm(float v) { return 1.f / (1.f + __expf(-v)); }
DEV float silu(float v) { return v / (1.f + __expf(-v)); }
DEV int otid() { int t = threadIdx.x; asm volatile("" : "+v"(t)); return t; }
DEV float wave_sum(float v) {
#pragma unroll
    for (int o = 32; o >= 1; o >>= 1) v += __shfl_xor(v, o);
    return v;
}

struct P {
    const float *x, *c; const int* pos;
    const float *w_ada, *b_ada, *norm1_g, *w_in, *pool_w_grp, *pool_scale, *q_norm_g, *k_norm_g, *w_pool_up, *w_attn_up, *w_out, *norm2_g,
        *w_router, *router_bias, *w_sg, *w_su, *w_sd, *w_eg, *w_eu, *w_ed;
    float* out;
    float* mod; int* cnt; int* asg_e; int* asg_pos; float* asg_w; int* rowlist;
    bf16_t *XB, *U, *QKV, *G, *PL, *Y, *O, *ACT, *SLAB, *HS;
    float* LG;
    bf16_t* OG; float* LSUM; unsigned* bar; unsigned long long* ts; float* roww;
    bf16_t *WT_IN, *WT_EFF, *WT_AU, *WT_OUT, *WT_RS, *WT_SD, *WT_EGU, *WT_ED;
};

constexpr size_t MiB = 1u << 20;
constexpr size_t WS_BAR = 640 * 1024, WS_BAR_BYTES = 16384, WS_ZERO_BYTES = 16384 + 65536;
constexpr size_t WS_TS = 800 * 1024;
constexpr size_t WS_MOD = 0, WS_CNT = WS_BAR + WS_BAR_BYTES, WS_ASG_E = 1 * MiB, WS_ASG_POS = 2 * MiB, WS_ASG_W = 3 * MiB, WS_ROWLIST = 4 * MiB, WS_ROWW = 6 * MiB;
constexpr size_t WS_XB = 8 * MiB;
constexpr size_t WS_ACT = 72 * MiB;
constexpr size_t WS_SLAB = 232 * MiB;
constexpr size_t WS_U = 232 * MiB, WS_QKV = 264 * MiB, WS_G = 408 * MiB, WS_PL = 536 * MiB, WS_Y = 568 * MiB, WS_O = 600 * MiB;
constexpr size_t WS_WT_IN = 744 * MiB, WS_WT_EFF = 754 * MiB, WS_WT_AU = 755 * MiB, WS_WT_OUT = 756 * MiB, WS_WT_RS = 758 * MiB, WS_WT_SD = 760 * MiB;
constexpr size_t WS_WT_ED = 762 * MiB;
constexpr size_t WS_WT_EGU = 232 * MiB;
constexpr size_t WS_OG = 616 * MiB, WS_LSUM = 664 * MiB;
constexpr size_t WS_HS = 890 * MiB;
constexpr size_t WS_END = 906 * MiB;

DEV void ph_mod(const P& p, float* sm, int bid, int nb) {
    const int tid_ = otid(); const int lane = tid_ & 63, wv = tid_ >> 6;
    for (int it = bid; it < 96; it += nb) {
        const int k0 = wv * 128, e = it * 64 + lane;
        float acc[16];
#pragma unroll
        for (int b = 0; b < 16; ++b) acc[b] = 0.f;
#pragma unroll 1
        for (int kh = 0; kh < 2; ++kh) {
            float sc[16];
#pragma unroll
            for (int b = 0; b < 16; ++b) sc[b] = silu(p.c[b * DM + k0 + kh * 64 + lane]);
            const float* wp = p.w_ada + (size_t)(k0 + kh * 64) * NMOD + e;
#pragma unroll 8
            for (int kk = 0; kk < 64; ++kk) { const float w = wp[(size_t)kk * NMOD];
#pragma unroll
                for (int b = 0; b < 16; ++b) acc[b] += __uint_as_float(__builtin_amdgcn_readlane(__float_as_uint(sc[b]), kk)) * w; }
        }
        __syncthreads();
#pragma unroll
        for (int b = 0; b < 16; ++b) sm[(wv * 16 + b) * 64 + lane] = acc[b];
        __syncthreads();
#pragma unroll
        for (int j = 0; j < 2; ++j) { const int idx = tid_ + j * NTHR, b = idx >> 6, col = idx & 63; float s = p.b_ada[it * 64 + col];
#pragma unroll
            for (int w = 0; w < 8; ++w) s += sm[(w * 16 + b) * 64 + col];
            p.mod[b * NMOD + it * 64 + col] = s; }
    }
}

DEV void ph_norm(const float* src, const float* g, const float* mod, int shift_off, int scale_off, bf16_t* dst, int bid, int nb) {
    const int tid_ = otid(); const int lane = tid_ & 63, wv = tid_ >> 6;
    for (int row0 = (bid * NWV + wv) * 2; row0 < T; row0 += nb * NWV * 2) {
        float4 v[2][4]; float ss[2] = {0.f, 0.f};
#pragma unroll
        for (int q = 0; q < 2; ++q) { const float4* xr = (const float4*)(src + (size_t)(row0 + q) * DM);
#pragma unroll
            for (int j = 0; j < 4; ++j) v[q][j] = xr[lane + 64 * j]; }
#pragma unroll
        for (int q = 0; q < 2; ++q)
#pragma unroll
            for (int j = 0; j < 4; ++j) ss[q] += v[q][j].x * v[q][j].x + v[q][j].y * v[q][j].y + v[q][j].z * v[q][j].z + v[q][j].w * v[q][j].w;
        const int b = row0 / SEQ;
#pragma unroll
        for (int q = 0; q < 2; ++q) {
            const float r = rsqrtf(wave_sum(ss[q]) * (1.f / DM) + 1e-6f);
#pragma unroll
            for (int j = 0; j < 4; ++j) {
                const int col = (lane + 64 * j) * 4;
                const float4 g4 = *(const float4*)(g + col);
                const float4 sc = *(const float4*)(mod + b * NMOD + scale_off + col);
                const float4 sh = *(const float4*)(mod + b * NMOD + shift_off + col);
                const float o0 = v[q][j].x * r * g4.x * (1.f + sc.x) + sh.x, o1 = v[q][j].y * r * g4.y * (1.f + sc.y) + sh.y;
                const float o2 = v[q][j].z * r * g4.z * (1.f + sc.z) + sh.z, o3 = v[q][j].w * r * g4.w * (1.f + sc.w) + sh.w;
                uint2 w; w.x = pk2(o0, o1); w.y = pk2(o2, o3);
                *(uint2*)(dst + (size_t)(row0 + q) * DM + col) = w;
            }
        }
    }
}

template <bool DUAL, class RowF, class Epi>
DEV void ngemm_tile(const bf16_t* __restrict__ A, int lda, RowF rowf, const float* __restrict__ B, const float* __restrict__ B2, int ldb,
                    int m0, int n0, int K, Epi epi, float* sm) {
    float* As = sm;
    float* Bs = sm + 16 * 132;
    float* Bs2 = Bs + 16 * 64;
    const int tid = otid(), tm = tid >> 4, tn = tid & 15;
    float acc[4][4], acc2[4][4];
#pragma unroll
    for (int i = 0; i < 4; ++i)
#pragma unroll
        for (int j = 0; j < 4; ++j) { acc[i][j] = 0.f; acc2[i][j] = 0.f; }
    const int ar = tid >> 2, ak = (tid & 3) * 4;
    const int arow = rowf(m0 + ar);
    const bf16_t* ap = A + (size_t)(arow < 0 ? 0 : arow) * lda + ak;
    const int bk = tid >> 5, bn = (tid & 31) * 2;
    for (int k0 = 0; k0 < K; k0 += 16) {
        uint2 av = make_uint2(0u, 0u);
        if (arow >= 0) av = *(const uint2*)(ap + k0);
        const float2 bv = *(const float2*)(B + (size_t)(k0 + bk) * ldb + n0 + bn);
        float2 bv2 = make_float2(0.f, 0.f);
        if (DUAL) bv2 = *(const float2*)(B2 + (size_t)(k0 + bk) * ldb + n0 + bn);
        __syncthreads();
        As[(ak + 0) * 132 + ar] = __uint_as_float(av.x << 16);
        As[(ak + 1) * 132 + ar] = __uint_as_float(av.x & 0xffff0000u);
        As[(ak + 2) * 132 + ar] = __uint_as_float(av.y << 16);
        As[(ak + 3) * 132 + ar] = __uint_as_float(av.y & 0xffff0000u);
        Bs[bk * 64 + bn] = bv.x; Bs[bk * 64 + bn + 1] = bv.y;
        if (DUAL) { Bs2[bk * 64 + bn] = bv2.x; Bs2[bk * 64 + bn + 1] = bv2.y; }
        __syncthreads();
#pragma unroll
        for (int kk = 0; kk < 16; ++kk) {
            const float4 a = *(const float4*)&As[kk * 132 + tm * 4];
            const float4 b = *(const float4*)&Bs[kk * 64 + tn * 4];
            const float aa[4] = {a.x, a.y, a.z, a.w}, bb[4] = {b.x, b.y, b.z, b.w};
#pragma unroll
            for (int i = 0; i < 4; ++i)
#pragma unroll
                for (int j = 0; j < 4; ++j) acc[i][j] += aa[i] * bb[j];
            if (DUAL) {
                const float4 b2 = *(const float4*)&Bs2[kk * 64 + tn * 4];
                const float cc[4] = {b2.x, b2.y, b2.z, b2.w};
#pragma unroll
                for (int i = 0; i < 4; ++i)
#pragma unroll
                    for (int j = 0; j < 4; ++j) acc2[i][j] += aa[i] * cc[j];
            }
        }
    }
#pragma unroll
    for (int i = 0; i < 4; ++i)
#pragma unroll
        for (int j = 0; j < 4; ++j) epi(m0 + tm * 4 + i, n0 + tn * 4 + j, acc[i][j], acc2[i][j]);
}

struct RowId { DEV int operator()(int m) const { return m; } };
struct RowTok { const int* rl; DEV int operator()(int m) const { const int s = rl[m]; return s < 0 ? -1 : (s >> 3); } };

template <bool DUAL, class Epi>
DEV void ngemm_dense(const bf16_t* A, int lda, const float* B, const float* B2, int ldb, int M, int N, int K, Epi epi, float* sm, int bid, int nb) {
    const int tn = N / 64, nt = (M / 128) * tn;
    for (int t = bid; t < nt; t += nb) ngemm_tile<DUAL>(A, lda, RowId(), B, B2, ldb, (t / tn) * 128, (t % tn) * 64, K, epi, sm);
}

struct EpiInProj { bf16_t *U, *QKV, *G;
    DEV void operator()(int r, int c, float v, float) const {
        if (c < 512) U[(size_t)r * 512 + c] = f2bf(v);
        else if (c < 2816) QKV[(size_t)r * 2304 + (c - 512)] = f2bf(v);
        else G[(size_t)r * 2048 + (c - 2816)] = f2bf(sigm(v)); } };
struct EpiPoolGrp { bf16_t* Y; const float* ls; int g;
    DEV void operator()(int r, int c, float v, float) const { Y[(size_t)r * 512 + g * 128 + c] = f2bf(v * ls[g * 128 + c]); } };
struct EpiMergeA { bf16_t* MG; const bf16_t* G;
    DEV void operator()(int r, int c, float v, float) const { MG[(size_t)r * DM + c] = f2bf(bf2f(G[(size_t)r * 2048 + c]) * v); } };
struct EpiMergeB { bf16_t* MG; const bf16_t* G;
    DEV void operator()(int r, int c, float v, float) const { const size_t i = (size_t)r * DM + c; MG[i] = f2bf(bf2f(MG[i]) + bf2f(G[(size_t)r * 2048 + 1024 + c]) * v); } };
struct EpiOutProj { const float* x; float* out; const float* mod;
    DEV void operator()(int r, int c, float v, float) const { const size_t i = (size_t)r * DM + c; out[i] = x[i] + mod[(r / SEQ) * NMOD + 2048 + c] * v; } };
struct EpiLogits { float* LG;
    DEV void operator()(int r, int c, float v, float) const { LG[(size_t)r * NE + c] = v; } };
struct EpiAct { bf16_t* ACT;
    DEV void operator()(int r, int c, float v, float v2) const { ACT[(size_t)r * EFF + c] = f2bf(silu(v) * v2); } };
struct EpiSlab { bf16_t* SLAB; const int* rl; const float* w;
    DEV void operator()(int r, int c, float v, float) const { const int s = rl[r]; if (s >= 0) SLAB[(size_t)s * DM + c] = f2bf(v * w[s]); } };
struct EpiFinal { float* out; const bf16_t* SLAB; const float* mod;
    DEV void operator()(int r, int c, float v, float) const {
        float s = v;
#pragma unroll
        for (int k = 0; k < 8; ++k) s += bf2f(SLAB[((size_t)r * 8 + k) * DM + c]);
        const size_t i = (size_t)r * DM + c; out[i] = out[i] + mod[(r / SEQ) * NMOD + 5120 + c] * s; } };

DEV void ph_qknorm(const P& p, int bid, int nb) {
    const int tid_ = otid(); const int lane = tid_ & 63, wv = tid_ >> 6;
    const float gq = p.q_norm_g[lane], gk = p.k_norm_g[lane];
    const float invf = exp2f(-(float)(lane & 7) * (1.f / 8.f) * log2f(500000.f));
    for (int t = bid * NWV + wv; t < T; t += nb * NWV) {
        const float ang = (float)p.pos[t] * invf;
        const float cs = cosf(ang), sn = sinf(ang);
        bf16_t* ptr = p.QKV + (size_t)t * 2304 + lane;
        float v[24];
#pragma unroll
        for (int hh = 0; hh < 24; ++hh) v[hh] = bf2f(ptr[hh * 64]);
#pragma unroll
        for (int hh = 0; hh < 24; ++hh) {
            const float ss = wave_sum(v[hh] * v[hh]);
            float nv = v[hh] * rsqrtf(ss * (1.f / 64.f) + 1e-6f) * (hh < 12 ? gq : gk);
            const float partner = __shfl_xor(nv, 8);
            if (lane < 8) nv = nv * cs - partner * sn;
            else if (lane < 16) nv = nv * cs + partner * sn;
            ptr[hh * 64] = f2bf(nv);
        }
    }
}

template <int R>
DEV void pool_chunk(const unsigned* up, unsigned* op, int s0) {
    constexpr int W = 32 + 2 * R;
    float w0[W], w1[W];
#pragma unroll
    for (int i = 0; i < W; ++i) { const int q = s0 - R + i; const bool ok = (q >= 0) && (q < SEQ); const unsigned w = up[(size_t)min(max(q, 0), SEQ - 1) * 256];
        w0[i] = ok ? __uint_as_float(w << 16) : 0.f; w1[i] = ok ? __uint_as_float(w & 0xffff0000u) : 0.f; }
    float a0 = 0.f, a1 = 0.f;
#pragma unroll
    for (int i = 0; i < 2 * R + 1; ++i) { a0 += w0[i]; a1 += w1[i]; }
#pragma unroll
    for (int j = 0; j < 32; ++j) {
        const int s = s0 + j;
        const int lo = max(s - R, 0), hi = min(s + R, SEQ - 1);
        const float inv = 1.f / (float)(hi - lo + 1);
        op[(size_t)s * 384] = pk2(a0 * inv - w0[j + R], a1 * inv - w1[j + R]);
        if (j < 31) { a0 += w0[j + 2 * R + 1] - w0[j]; a1 += w1[j + 2 * R + 1] - w1[j]; }
    }
}
DEV void ph_pool(const P& p, int bid, int nb) {
    const int tid_ = otid();
    for (int i = bid * NTHR + tid_; i < NB * 64 * 256; i += nb * NTHR) {
        const int cp = i & 255, chunk = (i >> 8) & 63, b = i >> 14;
        const int g = cp >> 6;
        const unsigned* up = (const unsigned*)(p.U + (size_t)b * SEQ * 512) + cp;
        unsigned* op = (unsigned*)(p.PL + (size_t)b * SEQ * 768) + cp;
        const int s0 = chunk * 32;
        if (g == 0) pool_chunk<1>(up, op, s0); else if (g == 1) pool_chunk<2>(up, op, s0); else if (g == 2) pool_chunk<4>(up, op, s0); else pool_chunk<8>(up, op, s0);
    }
}

DEV void ph_attn(const P& p, int bid, int nb) {
    const int tid_ = otid(); const int lane = tid_ & 63, wv = tid_ >> 6;
    for (int it = bid * NWV + wv; it < T * 4; it += nb * NWV) {
        const int t = it >> 2, slot = it & 3;
        const int s = t & (SEQ - 1), base = t - s;
        float M = -1e30f, l = 0.f, acc = 0.f;
#pragma unroll
        for (int g = 0; g < 3; ++g) {
            const int dsh = 2 * g, d = 1 << dsh, L = SEQ >> dsh;
            const int h = 4 * g + slot;
            const int m = s >> dsh, r = s & (d - 1);
            const float q = bf2f(p.QKV[(size_t)t * 2304 + h * 64 + lane]);
            const bf16_t* kb = p.QKV + 768 + h * 64 + lane;
            const bf16_t* vb = p.QKV + 1536 + h * 64 + lane;
#pragma unroll 4
            for (int rel = -64; rel <= 64; ++rel) {
                const int mm = m + rel;
                const bool valid = (mm >= 0) && (mm < L);
                const int mc = valid ? mm : m;
                const size_t tr = (size_t)(base + mc * d + r) * 2304;
                const float kv = bf2f(kb[tr]), vv = bf2f(vb[tr]);
                const float sc = wave_sum(q * kv) * 0.125f;
                if (valid) {
                    const float mn = fmaxf(M, sc);
                    const float f = __expf(M - mn), pe = __expf(sc - mn);
                    l = l * f + pe; acc = acc * f + pe * vv; M = mn;
                }
            }
        }
        p.O[(size_t)t * 256 + slot * 64 + lane] = f2bf(acc / l);
    }
}

DEV void ph_route(const P& p, int* hist, int bid, int nb) {
    const int tid_ = otid(); const int lane = tid_ & 63, wv = tid_ >> 6;
    const int G = lane & 7, tl = lane >> 3;
    float bias[32];
#pragma unroll
    for (int j = 0; j < 8; ++j) { const float4 b4 = *(const float4*)(p.router_bias + G * 32 + 4 * j); bias[4 * j] = b4.x; bias[4 * j + 1] = b4.y; bias[4 * j + 2] = b4.z; bias[4 * j + 3] = b4.w; }
    for (int t0 = (bid * NWV + wv) * 8; t0 < T; t0 += nb * NWV * 8) {
        const int t = t0 + tl;
        float sc[32], v[32];
#pragma unroll
        for (int j = 0; j < 8; ++j) { const float4 lg = *(const float4*)(p.LG + (size_t)t * NE + G * 32 + 4 * j);
            sc[4 * j] = 1.f / (1.f + expf(-lg.x)); sc[4 * j + 1] = 1.f / (1.f + expf(-lg.y)); sc[4 * j + 2] = 1.f / (1.f + expf(-lg.z)); sc[4 * j + 3] = 1.f / (1.f + expf(-lg.w)); }
        float m1 = -INFINITY, m2 = -INFINITY;
#pragma unroll
        for (int j = 0; j < 32; ++j) { v[j] = sc[j] + bias[j]; const float n1 = fmaxf(m1, v[j]), n2 = fmaxf(fminf(m1, v[j]), m2); m1 = n1; m2 = n2; }
        const float gs = m1 + m2;
        int rank = 0;
#pragma unroll
        for (int g2 = 0; g2 < 8; ++g2) { const float o = __shfl(gs, (lane & 56) + g2); rank += ((o > gs) || (o == gs && g2 < G)) ? 1 : 0; }
        const bool gsel = rank < 4;
        int myidx = 0; float myw = 0.f, wsum = 0.f;
#pragma unroll 1
        for (int k = 0; k < 8; ++k) {
            float bv = -INFINITY, bs = 0.f; int bi = 0;
#pragma unroll
            for (int j = 0; j < 32; ++j) { const bool tk = gsel && (v[j] > bv); bv = tk ? v[j] : bv; bs = tk ? sc[j] : bs; bi = tk ? j : bi; }
            int gi = G * 32 + bi;
#pragma unroll
            for (int o = 1; o < 8; o <<= 1) {
                const float ov = __shfl_xor(bv, o), os = __shfl_xor(bs, o); const int oi = __shfl_xor(gi, o);
                if ((ov > bv) || (ov == bv && oi < gi)) { bv = ov; gi = oi; bs = os; }
            }
            const int wj = (gi >> 5) == G ? (gi & 31) : -1;
#pragma unroll
            for (int j = 0; j < 32; ++j) v[j] = (j == wj) ? -INFINITY : v[j];
            if (G == k) { myidx = gi; myw = bs; }
            wsum += bs;
        }
        __syncthreads();
        if (tid_ < NE) hist[tid_] = 0;
        __syncthreads();
        const int lpos = atomicAdd(&hist[myidx], 1);
        __syncthreads();
        if (tid_ < NE) { const int c_ = hist[tid_]; hist[NE + tid_] = c_ ? atomicAdd(&p.cnt[tid_ * 64], c_) : 0; }
        __syncthreads();
        const int slot = t * 8 + G;
        p.asg_e[slot] = myidx; p.asg_pos[slot] = hist[NE + myidx] + lpos; p.asg_w[slot] = myw / wsum * 2.5f;
    }
}

DEV void load_offsets(const int* cnt, int* off) {
    const int tid = otid();
    __syncthreads();
    if (tid < NE) { const int c_ = cnt[tid * 64]; off[300 + tid] = (c_ + 255) & ~255; off[600 + tid] = c_; }
    __syncthreads();
    if (tid == 0) { int a = 0; for (int e = 0; e < NE; ++e) { off[e] = a; a += off[300 + e]; } off[NE] = a;
        const int x = blockIdx.x & 7; int tf = 0, th = 0;
        for (int j = 0; j < 32; ++j) { const int n_ = off[600 + x + 8 * j], nt_ = (n_ + 255) >> 8, hh = (nt_ > 0 && n_ - (nt_ - 1) * 256 <= 128) ? 1 : 0;
            off[860 + j] = tf; off[900 + j] = th; tf += nt_ - hh; th += hh; }
        off[860 + 32] = tf; off[900 + 32] = th; }
    __syncthreads();
}
DEV int find_expert(const int* off, int m0) {
    int lo = 0, hi = NE;
    while (hi - lo > 1) { const int mid = (lo + hi) >> 1; if (off[mid] <= m0) lo = mid; else hi = mid; }
    return lo;
}

DEV void ph_scatter(const P& p, int* off, int bid, int nb) {
    load_offsets(p.cnt, off);
    const int tid_ = otid();
    for (int slot = bid * NTHR + tid_; slot < NSLOT; slot += nb * NTHR) { const int r = off[p.asg_e[slot]] + p.asg_pos[slot]; p.rowlist[r] = slot; p.roww[r] = p.asg_w[slot]; }
    for (int e = bid; e < NE; e += nb) {
        const int n = p.cnt[e * 64], pd = (n + 255) & ~255;
        for (int i = n + tid_; i < pd; i += NTHR) { p.rowlist[off[e] + i] = -1; p.roww[off[e] + i] = 0.f; }
    }
}

DEV void ph_expert1(const P& p, float* sm, int* off, int bid, int nb) {
    load_offsets(p.cnt, off);
    const int nrt = off[NE] / 128, nt = nrt * 4;
    for (int t = bid; t < nt; t += nb) {
        const int m0 = (t >> 2) * 128, n0 = (t & 3) * 64, e = find_expert(off, m0);
        ngemm_tile<true>(p.XB, DM, RowTok{p.rowlist}, p.w_eg + (size_t)e * DM * EFF, p.w_eu + (size_t)e * DM * EFF, EFF, m0, n0, DM, EpiAct{p.ACT}, sm);
    }
}
DEV void ph_expert2(const P& p, float* sm, int* off, int bid, int nb) {
    load_offsets(p.cnt, off);
    const int nrt = off[NE] / 128, nt = nrt * 16;
    for (int t = bid; t < nt; t += nb) {
        const int m0 = (t >> 4) * 128, n0 = (t & 15) * 64, e = find_expert(off, m0);
        ngemm_tile<false>(p.ACT, EFF, RowId(), p.w_ed + (size_t)e * EFF * DM, nullptr, DM, m0, n0, EFF, EpiSlab{p.SLAB, p.rowlist, p.asg_w}, sm);
    }
}

namespace mg {
constexpr int BM = 256, BK = 64, HALF = 128, HTB = HALF * BK * 2, STAGE_BYTES = 8 * HTB, NXCD = 8, WGM = 8;
__host__ __device__ __forceinline__ int lds_byte(int r, int c) { const int st = (r >> 4) * 2 + (c >> 5), rr = r & 15, cc = c & 31, ob = rr * 64 + cc * 2; return st * 1024 + (ob ^ (((ob >> 9) & 1) << 5)); }
__host__ __device__ __forceinline__ void stage_rc(int b, int& R, int& C) { const int st = b / 1024, sb = b % 1024, swz = sb ^ (((sb >> 9) & 1) << 5); R = (st >> 1) * 16 + swz / 64; C = (st & 1) * 32 + (swz % 64) / 2; }
__host__ __device__ __forceinline__ int perm32(int rho) { const int n = rho >> 4, i = rho & 15; return 8 * (i >> 2) + 4 * n + (i & 3); }

struct Unit { int pm, pn, e, pad, half, pad2; const char* A; const char* B; };

struct DenseOrder { static constexpr bool HAS_HALF = false;
    int nM, nN, nwg, G, c; const char* A; const char* B; size_t tstep;
    DEV void init(const bf16_t* A_, const bf16_t* B_, int M, int N, int K, int G_, int c_) { nM = M / BM; nN = N / BM; nwg = nM * nN; G = G_; c = c_; A = (const char*)A_; B = (const char*)B_; tstep = (size_t)BM * K * 2; }
    DEV bool next(int i, Unit& u) const {
        const long L = (long)i * G + c; if (L >= nwg) return false;
        int wgid = (int)L; { const int q = nwg / NXCD, r = nwg % NXCD, xcd = wgid % NXCD, off = wgid / NXCD; wgid = (xcd < r ? xcd * (q + 1) : r * (q + 1) + (xcd - r) * q) + off; }
        const int nig = WGM * nN, gid = wgid / nig, fm = gid * WGM, gsz = (nM - fm) < WGM ? (nM - fm) : WGM;
        u.pm = fm + ((wgid % nig) % gsz); u.pn = (wgid % nig) / gsz; u.e = 0; u.pad = 0; u.half = 0; u.pad2 = 0;
        u.A = A + (size_t)u.pm * tstep; u.B = B + (size_t)u.pn * tstep; return true;
    }
};
struct PairOrder { static constexpr bool HAS_HALF = false; DenseOrder D; int kt0, kt1;
    DEV bool next(int i, Unit& u) const { if (!D.next(i >> 1, u)) return false; const int part = i & 1; u.e = part; u.pad = part ? kt1 : kt0;
        if (part) { u.A += (size_t)kt0 * 128; u.B += (size_t)kt0 * 128; } return true; }
};
struct ExpertOrder { static constexpr bool HAS_HALF = true;
    const LAS int* off; int ncol, G, c; const char* A; const char* W; size_t wstride, tstepB, tstepA; bool gather; const int* rl; int maxu;
    DEV bool tile_of(int i, int& pm, int& pn, int& e) const {
        const int x = c & 7, cl = c >> 3, nbx = G >> 3;
        const int Lx = i * nbx + cl; int tx = Lx / ncol; pn = Lx % ncol;
        const int ftot = __builtin_amdgcn_readfirstlane(off[860 + 32]), htot = __builtin_amdgcn_readfirstlane(off[900 + 32]);
        if (tx >= ftot + htot) return false;
        const bool isf = tx < ftot; const int tb = isf ? 860 : 900; if (!isf) tx -= ftot;
        int lo = 0, hi = 32;
        while (hi - lo > 1) { const int mid = (lo + hi) >> 1; const int ov = __builtin_amdgcn_readfirstlane(off[tb + mid]); if (ov <= tx) lo = mid; else hi = mid; }
        e = x + 8 * lo;
        const int nfull = __builtin_amdgcn_readfirstlane(off[860 + lo + 1]) - __builtin_amdgcn_readfirstlane(off[860 + lo]);
        pm = (__builtin_amdgcn_readfirstlane(off[e]) >> 8) + (isf ? (tx - __builtin_amdgcn_readfirstlane(off[860 + lo])) : nfull);
        return true;
    }
    DEV bool next(int i, Unit& u) const {
        int pm, pn, e; if (!tile_of(i, pm, pn, e)) return false;
        u.pm = pm; u.pn = pn; u.e = e; u.pad = 0; u.pad2 = 0;
        u.half = (__builtin_amdgcn_readfirstlane(off[600 + e]) - (pm * BM - __builtin_amdgcn_readfirstlane(off[e])) <= HALF) ? 1 : 0;
        u.A = gather ? A : A + (size_t)pm * tstepA; u.B = W + (size_t)e * wstride + (size_t)pn * tstepB; return true;
    }
};

template <class Epi, class Sched, bool GATHER>
DEV void gemm_phase(LAS unsigned char* lds, const LAS unsigned* gtab, const int K, const Sched& S, const Epi& E) {
    const int tid = otid(), wid = __builtin_amdgcn_readfirstlane(tid >> 6), lane = tid & 63, wr = wid >> 2, wc = wid & 3, fr = lane & 15, fq = lane >> 4;
    const int nt = K / BK;
    int Rr[2], Cc[2]; unsigned voffB[2];
#pragma unroll
    for (int i = 0; i < 2; ++i) { stage_rc(tid * 16 + i * 8192, Rr[i], Cc[i]); const int Rb = Epi::PERM ? ((Rr[i] & ~31) + perm32(Rr[i] & 31)) : Rr[i]; voffB[i] = (unsigned)(Rb * K + Cc[i]) * 2u; }
    const size_t kstep = (size_t)(BK * 2);
    const size_t hstep = (size_t)HALF * K * 2;
    const unsigned ldsw = (unsigned)wid * 1024u;
    const int aoff = lds_byte(wr * 64 + fr, fq * 8), boff = lds_byte(wc * 32 + fr, fq * 8);
#define MG_SA(b, h) (((b) * 2 + (h)) * HTB)
#define MG_SB(b, h) ((4 + (b) * 2 + (h)) * HTB)
#define MG_STAGE(bufoff, gbase, voff) do { _Pragma("unroll") for (int _i = 0; _i < 2; ++_i) \
        __builtin_amdgcn_global_load_lds((const unsigned*)((const char*)(gbase) + (voff)[_i]), (LAS unsigned*)(lds + (bufoff) + ldsw + _i * 8192), 16, 0, 0); } while (0)
#define MG_LDA(dst, b, h) do { _Pragma("unroll") for (int m = 0; m < 4; ++m) _Pragma("unroll") for (int k = 0; k < 2; ++k) dst[m][k] = *(const LAS bf16x8*)(lds + MG_SA(b, h) + aoff + m * 2048 + k * 1024); } while (0)
#define MG_LDB(dst, b, h) do { _Pragma("unroll") for (int n = 0; n < 2; ++n) _Pragma("unroll") for (int k = 0; k < 2; ++k) dst[n][k] = *(const LAS bf16x8*)(lds + MG_SB(b, h) + boff + n * 2048 + k * 1024); } while (0)
#define MG_MMA(ai, bj, At, Bt) do { __builtin_amdgcn_s_setprio(1); _Pragma("unroll") for (int m = 0; m < 4; ++m) _Pragma("unroll") for (int n = 0; n < 2; ++n) _Pragma("unroll") for (int k = 0; k < 2; ++k) \
        acc[ai][bj][m][n] = __builtin_amdgcn_mfma_f32_16x16x32_bf16(Bt[n][k], At[m][k], acc[ai][bj][m][n], 0, 0, 0); __builtin_amdgcn_s_setprio(0); } while (0)
#define MG_WAIT_V(n) asm volatile("s_waitcnt vmcnt(" #n ")" ::: "memory")
#define MG_WAIT_L(n) asm volatile("s_waitcnt lgkmcnt(" #n ")" ::: "memory")
#define MG_BAR __builtin_amdgcn_s_barrier()
#define MG_SCHED __builtin_amdgcn_sched_barrier(0)
    Unit cur, nxt; int ui = 0;
    if (!S.next(0, cur)) return;
    int ntc = cur.pad > 0 ? cur.pad : nt;
    bool hf = Sched::HAS_HALF && (cur.half != 0);
    f32x4 acc[2][2][4][2];
#pragma unroll
    for (int a = 0; a < 2; ++a)
#pragma unroll
        for (int b = 0; b < 2; ++b)
#pragma unroll
            for (int m = 0; m < 4; ++m)
#pragma unroll
                for (int n = 0; n < 2; ++n) acc[a][b][m][n] = (f32x4){0.f, 0.f, 0.f, 0.f};
    bf16x8 At[4][2], B0[2][2], B1[2][2];
    unsigned va0[2], va1[2], na0[2], na1[2];
#pragma unroll
    for (int i = 0; i < 2; ++i) {
        if (GATHER) { va0[i] = gtab[Rr[i]] + (unsigned)Cc[i] * 2u; va1[i] = gtab[HALF + Rr[i]] + (unsigned)Cc[i] * 2u; }
        else { va0[i] = (unsigned)(Rr[i] * K + Cc[i]) * 2u; va1[i] = va0[i] + (unsigned)hstep; }
        na0[i] = va0[i]; na1[i] = va1[i];
    }
    const char* cA = cur.A; const char* cB = cur.B;
    MG_STAGE(MG_SB(0, 0), cB, voffB); MG_STAGE(MG_SB(0, 1), cB + hstep, voffB); MG_STAGE(MG_SA(0, 0), cA, va0); MG_STAGE(MG_SA(0, 1), cA, va1);
    if (wr == 1) MG_BAR;
    MG_WAIT_V(2); MG_BAR;
    MG_STAGE(MG_SB(1, 0), cB + kstep, voffB); MG_STAGE(MG_SA(1, 0), cA + kstep, va0); MG_STAGE(MG_SB(1, 1), cB + hstep + kstep, voffB);
    MG_WAIT_V(6); MG_BAR;
    for (;;) {
        if constexpr (Epi::ROWTAB) E.prefetch(cur, (LAS unsigned char*)gtab + (ui & 1) * 2048, wid, lane);
        const bool has_next = S.next(ui + 1, nxt);
        const char* nA = has_next ? nxt.A : cA; const char* nB = has_next ? nxt.B : cB;
        if constexpr (GATHER) {
            if (has_next) {
                if (ui + 1 < S.maxu) {
#pragma unroll
                    for (int i = 0; i < 2; ++i) { na0[i] = gtab[(ui + 1) * BM + Rr[i]] + (unsigned)Cc[i] * 2u; na1[i] = gtab[(ui + 1) * BM + HALF + Rr[i]] + (unsigned)Cc[i] * 2u; }
                } else {
#pragma unroll
                    for (int i = 0; i < 2; ++i) { const int s0_ = S.rl[nxt.pm * BM + Rr[i]], s1_ = S.rl[nxt.pm * BM + HALF + Rr[i]];
                        na0[i] = (unsigned)(s0_ < 0 ? 0 : (s0_ >> 3)) * (unsigned)(K * 2) + (unsigned)Cc[i] * 2u; na1[i] = (unsigned)(s1_ < 0 ? 0 : (s1_ >> 3)) * (unsigned)(K * 2) + (unsigned)Cc[i] * 2u; }
                }
            }
        }
#pragma unroll 1
        for (int t = 0; t < ntc; t += 2) {
            const bool last = (t == ntc - 2);
            const char* a1 = cA + (size_t)(t + 1) * kstep;
            const char* a2 = last ? nA : cA + (size_t)(t + 2) * kstep; const char* b2 = last ? nB : cB + (size_t)(t + 2) * kstep;
            const char* a3 = a2 + kstep; const char* b3 = b2 + kstep;
            unsigned o0[2], o1[2];
#pragma unroll
            for (int i = 0; i < 2; ++i) { o0[i] = (GATHER && last) ? na0[i] : va0[i]; o1[i] = (GATHER && last) ? na1[i] : va1[i]; }
            MG_LDB(B0, 0, 0); MG_LDB(B1, 0, 1); MG_SCHED; MG_LDA(At, 0, 0); MG_STAGE(MG_SA(1, 1), a1, va1);
            MG_WAIT_V(8); MG_WAIT_L(0); MG_BAR; MG_MMA(0, 0, At, B0); MG_MMA(0, 1, At, B1); MG_BAR; MG_SCHED;
            if (!hf) MG_LDA(At, 0, 1); MG_STAGE(MG_SB(0, 0), b2, voffB); MG_STAGE(MG_SB(0, 1), b2 + hstep, voffB); MG_STAGE(MG_SA(0, 0), a2, o0);
            MG_WAIT_V(8); MG_WAIT_L(0); MG_BAR; if (!hf) { MG_MMA(1, 0, At, B0); MG_MMA(1, 1, At, B1); } MG_BAR; MG_SCHED;
            MG_LDB(B0, 1, 0); MG_LDB(B1, 1, 1); MG_SCHED; MG_LDA(At, 1, 0); MG_STAGE(MG_SA(0, 1), a2, o1);
            MG_WAIT_V(8); MG_WAIT_L(0); MG_BAR; MG_MMA(0, 0, At, B0); MG_MMA(0, 1, At, B1); MG_BAR; MG_SCHED;
            if (!hf) MG_LDA(At, 1, 1); MG_STAGE(MG_SB(1, 0), b3, voffB); MG_STAGE(MG_SB(1, 1), b3 + hstep, voffB); MG_STAGE(MG_SA(1, 0), a3, o0);
            MG_WAIT_V(8); MG_WAIT_L(0); MG_BAR; if (!hf) { MG_MMA(1, 0, At, B0); MG_MMA(1, 1, At, B1); } MG_BAR; MG_SCHED;
        }
        if (wr == 0) MG_BAR;
        if constexpr (Epi::ROWTAB) E.epi_tab(acc, cur, wr, wc, fr, fq, (const LAS unsigned char*)gtab + (ui & 1) * 2048);
        else E(acc, cur, wr, wc, fr, fq);
        if (!has_next) break;
        if (!(Epi::KEEP_ACC && cur.e == 0)) {
#pragma unroll
        for (int a = 0; a < 2; ++a)
#pragma unroll
            for (int b = 0; b < 2; ++b)
#pragma unroll
                for (int m = 0; m < 4; ++m)
#pragma unroll
                    for (int n = 0; n < 2; ++n) acc[a][b][m][n] = (f32x4){0.f, 0.f, 0.f, 0.f};
        }
        cur = nxt; cA = nA; cB = nB; ++ui; ntc = cur.pad > 0 ? cur.pad : nt; hf = Sched::HAS_HALF && (cur.half != 0);
#pragma unroll
        for (int i = 0; i < 2; ++i) { va0[i] = na0[i]; va1[i] = na1[i]; }
        if (wr == 1) MG_BAR;
    }
    MG_WAIT_V(0);
    MG_BAR;
    __syncthreads();
#undef MG_SA
#undef MG_SB
#undef MG_STAGE
#undef MG_LDA
#undef MG_LDB
#undef MG_MMA
#undef MG_WAIT_V
#undef MG_WAIT_L
#undef MG_BAR
#undef MG_SCHED
}

DEV u32x4 pack8(const f32x4 a, const f32x4 b) { u32x4 w; w.x = pk2(a[0], a[1]); w.y = pk2(a[2], a[3]); w.z = pk2(b[0], b[1]); w.w = pk2(b[2], b[3]); return w; }
DEV f32x4 unpack_lo(const u32x4 w) { return (f32x4){__uint_as_float(w.x << 16), __uint_as_float(w.x & 0xffff0000u), __uint_as_float(w.y << 16), __uint_as_float(w.y & 0xffff0000u)}; }
DEV f32x4 unpack_hi(const u32x4 w) { return (f32x4){__uint_as_float(w.z << 16), __uint_as_float(w.z & 0xffff0000u), __uint_as_float(w.w << 16), __uint_as_float(w.w & 0xffff0000u)}; }
DEV f32x4 sig4(const f32x4 v) { return (f32x4){sigm(v[0]), sigm(v[1]), sigm(v[2]), sigm(v[3])}; }
DEV f32x4 silu4(const f32x4 v) { return (f32x4){silu(v[0]), silu(v[1]), silu(v[2]), silu(v[3])}; }
#define ACC_T f32x4 (&acc)[2][2][4][2]

struct MEpiInProj { static constexpr bool PERM = true; static constexpr bool KEEP_ACC = false; static constexpr bool ROWTAB = false; bf16_t *U, *QKV, *G;
    DEV void operator()(ACC_T, const Unit& u, int wr, int wc, int fr, int fq) const {
        int colt = u.pn * BM; bf16_t* base; int ld; bool sg = false;
        if (colt < 512) { base = U; ld = 512; } else if (colt < 2816) { base = QKV; ld = 2304; colt -= 512; } else { base = G; ld = 2048; colt -= 2816; sg = true; }
        const int row0 = u.pm * BM + wr * 64 + fr, col0 = colt + wc * 32 + 8 * fq;
#pragma unroll
        for (int ai = 0; ai < 2; ++ai)
#pragma unroll
            for (int m = 0; m < 4; ++m) { bf16_t* rowp = base + (size_t)(row0 + ai * HALF + m * 16) * ld + col0;
#pragma unroll
                for (int bj = 0; bj < 2; ++bj) { f32x4 v0 = acc[ai][bj][m][0], v1 = acc[ai][bj][m][1]; if (sg) { v0 = sig4(v0); v1 = sig4(v1); }
                    *(u32x4*)(rowp + bj * HALF) = pack8(v0, v1); }
                asm volatile("" ::: "memory"); }
    } };
struct MEpiMergeF { static constexpr bool PERM = true; static constexpr bool KEEP_ACC = true; static constexpr bool ROWTAB = false; bf16_t* MG; const bf16_t* G;
    DEV void mid(f32x4 (&acc)[2][2][4][2], const Unit& u, int wr, int wc, int fr, int fq) const {
        const int row0 = u.pm * BM + wr * 64 + fr, col0 = u.pn * BM + wc * 32 + 8 * fq;
        u32x4 ga[4], gb[4];
        { const bf16_t* gr = G + (size_t)row0 * 2048 + col0;
          ga[0] = *(const u32x4*)gr; ga[1] = *(const u32x4*)(gr + HALF); ga[2] = *(const u32x4*)(gr + 1024); ga[3] = *(const u32x4*)(gr + 1024 + HALF); }
#pragma unroll
        for (int gi = 0; gi < 8; ++gi) { const int ai = gi >> 2, m = gi & 3;
            if (gi < 7) { const bf16_t* gr = G + (size_t)(row0 + ((gi + 1) >> 2) * HALF + ((gi + 1) & 3) * 16) * 2048 + col0;
                if (gi & 1) { ga[0] = *(const u32x4*)gr; ga[1] = *(const u32x4*)(gr + HALF); ga[2] = *(const u32x4*)(gr + 1024); ga[3] = *(const u32x4*)(gr + 1024 + HALF); }
                else { gb[0] = *(const u32x4*)gr; gb[1] = *(const u32x4*)(gr + HALF); gb[2] = *(const u32x4*)(gr + 1024); gb[3] = *(const u32x4*)(gr + 1024 + HALF); } }
#pragma unroll
            for (int bj = 0; bj < 2; ++bj) { const u32x4 gp_ = (gi & 1) ? gb[bj] : ga[bj], gq_ = (gi & 1) ? gb[2 + bj] : ga[2 + bj];
                const f32x4 pl = unpack_lo(gp_), ph = unpack_hi(gp_), al = unpack_lo(gq_), ah = unpack_hi(gq_);
                acc[ai][bj][m][0] *= (f32x4){pl[0] * __builtin_amdgcn_rcpf(al[0]), pl[1] * __builtin_amdgcn_rcpf(al[1]), pl[2] * __builtin_amdgcn_rcpf(al[2]), pl[3] * __builtin_amdgcn_rcpf(al[3])};
                acc[ai][bj][m][1] *= (f32x4){ph[0] * __builtin_amdgcn_rcpf(ah[0]), ph[1] * __builtin_amdgcn_rcpf(ah[1]), ph[2] * __builtin_amdgcn_rcpf(ah[2]), ph[3] * __builtin_amdgcn_rcpf(ah[3])}; }
            asm volatile("" ::: "memory"); }
    }
    DEV void operator()(f32x4 (&acc)[2][2][4][2], const Unit& u, int wr, int wc, int fr, int fq) const {
        if (u.e == 0) { mid(acc, u, wr, wc, fr, fq); return; }
        const int row0 = u.pm * BM + wr * 64 + fr, col0 = u.pn * BM + wc * 32 + 8 * fq;
        u32x4 ga[2], gb[2];
        { const bf16_t* gr = G + (size_t)row0 * 2048 + 1024 + col0; ga[0] = *(const u32x4*)gr; ga[1] = *(const u32x4*)(gr + HALF); }
#pragma unroll
        for (int gi = 0; gi < 8; ++gi) { const int ai = gi >> 2, m = gi & 3; const size_t r = (size_t)(row0 + ai * HALF + m * 16);
            if (gi < 7) { const bf16_t* gr = G + (size_t)(row0 + ((gi + 1) >> 2) * HALF + ((gi + 1) & 3) * 16) * 2048 + 1024 + col0;
                if (gi & 1) { ga[0] = *(const u32x4*)gr; ga[1] = *(const u32x4*)(gr + HALF); } else { gb[0] = *(const u32x4*)gr; gb[1] = *(const u32x4*)(gr + HALF); } }
#pragma unroll
            for (int bj = 0; bj < 2; ++bj) { const u32x4 gq_ = (gi & 1) ? gb[bj] : ga[bj];
                *(u32x4*)(MG + r * DM + col0 + bj * HALF) = pack8(acc[ai][bj][m][0] * unpack_lo(gq_), acc[ai][bj][m][1] * unpack_hi(gq_)); }
            asm volatile("" ::: "memory"); }
    } };
struct MEpiOutProj { static constexpr bool PERM = false; static constexpr bool KEEP_ACC = false; static constexpr bool ROWTAB = false; const float* x; float* out; const float* mod;
    DEV void operator()(ACC_T, const Unit& u, int wr, int wc, int fr, int fq) const {
        const int row0 = u.pm * BM + wr * 64 + fr, col0 = u.pn * BM + wc * 32 + 4 * fq;
        const float* gm = mod + ((u.pm * BM) / SEQ) * NMOD + 2048 + col0;
        f32x4 gv[4];
#pragma unroll
        for (int q = 0; q < 4; ++q) gv[q] = *(const f32x4*)(gm + (q >> 1) * HALF + (q & 1) * 16);
        f32x4 xa[4], xb[4];
        { const float* xp = x + (size_t)row0 * DM + col0;
#pragma unroll
          for (int q = 0; q < 4; ++q) xa[q] = *(const f32x4*)(xp + (q >> 1) * HALF + (q & 1) * 16); }
#pragma unroll
        for (int gi = 0; gi < 8; ++gi) { const int ai = gi >> 2, m = gi & 3; const size_t r = (size_t)(row0 + ai * HALF + m * 16) * DM + col0;
            if (gi < 7) { const int ai2 = (gi + 1) >> 2, m2 = (gi + 1) & 3; const float* xp = x + (size_t)(row0 + ai2 * HALF + m2 * 16) * DM + col0;
#pragma unroll
                for (int q = 0; q < 4; ++q) { if (gi & 1) xa[q] = *(const f32x4*)(xp + (q >> 1) * HALF + (q & 1) * 16); else xb[q] = *(const f32x4*)(xp + (q >> 1) * HALF + (q & 1) * 16); } }
#pragma unroll
            for (int q = 0; q < 4; ++q) { const f32x4 xv = (gi & 1) ? xb[q] : xa[q];
                *(f32x4*)(out + r + (q >> 1) * HALF + (q & 1) * 16) = xv + gv[q] * acc[ai][q >> 1][m][q & 1]; }
            asm volatile("" ::: "memory"); }
    } };
struct MEpiRouterShared { static constexpr bool PERM = true; static constexpr bool KEEP_ACC = false; static constexpr bool ROWTAB = false; float* LG; bf16_t* HS;
    DEV void operator()(ACC_T, const Unit& u, int wr, int wc, int fr, int fq) const {
        const int row0 = u.pm * BM + wr * 64 + fr, cw = wc * 32 + 8 * fq;
#pragma unroll
        for (int ai = 0; ai < 2; ++ai)
#pragma unroll
            for (int m = 0; m < 4; ++m) { const size_t r = (size_t)(row0 + ai * HALF + m * 16);
                if (u.pn == 0) {
#pragma unroll
                    for (int bj = 0; bj < 2; ++bj)
#pragma unroll
                        for (int n = 0; n < 2; ++n) *(f32x4*)(LG + r * NE + bj * HALF + cw + 4 * n) = acc[ai][bj][m][n];
                } else {
                    const f32x4 v0 = silu4(acc[ai][0][m][0]) * acc[ai][1][m][0], v1 = silu4(acc[ai][0][m][1]) * acc[ai][1][m][1];
                    *(u32x4*)(HS + r * EFF + (u.pn - 1) * HALF + cw) = pack8(v0, v1);
                }
                asm volatile("" ::: "memory"); }
    } };
struct MEpiAct { static constexpr bool PERM = true; static constexpr bool KEEP_ACC = false; static constexpr bool ROWTAB = false; bf16_t* ACT;
    DEV void operator()(ACC_T, const Unit& u, int wr, int wc, int fr, int fq) const {
        const int row0 = u.pm * BM + wr * 64 + fr, cw = u.pn * HALF + wc * 32 + 8 * fq;
#pragma unroll
        for (int ai = 0; ai < 2; ++ai) { if (ai == 1 && u.half) break;
#pragma unroll
            for (int m = 0; m < 4; ++m) { const size_t r = (size_t)(row0 + ai * HALF + m * 16);
                const f32x4 v0 = silu4(acc[ai][0][m][0]) * acc[ai][1][m][0], v1 = silu4(acc[ai][0][m][1]) * acc[ai][1][m][1];
                *(u32x4*)(ACT + r * EFF + cw) = pack8(v0, v1); asm volatile("" ::: "memory"); } }
    } };
constexpr float SLAB_SCALE = 4.f, SLAB_INV = 0.25f;
DEV unsigned pk4_fp8(float a, float b, float c, float d) {
    a = __builtin_amdgcn_fmed3f(a, -440.f, 440.f); b = __builtin_amdgcn_fmed3f(b, -440.f, 440.f); c = __builtin_amdgcn_fmed3f(c, -440.f, 440.f); d = __builtin_amdgcn_fmed3f(d, -440.f, 440.f);
    int w = 0; w = __builtin_amdgcn_cvt_pk_fp8_f32(a, b, w, false); w = __builtin_amdgcn_cvt_pk_fp8_f32(c, d, w, true); return (unsigned)w; }
struct MEpiSlab { static constexpr bool PERM = true; static constexpr bool KEEP_ACC = false; static constexpr bool ROWTAB = true; unsigned char* SLAB; const int* rl; const float* w;
    DEV void prefetch(const Unit& u, LAS unsigned char* tab, int wid, int lane) const {
        const int rr = (wid & 3) * 64 + lane;
        const unsigned* src = (wid < 4) ? (const unsigned*)(rl + u.pm * BM + rr) : (const unsigned*)(w + u.pm * BM + rr);
        __builtin_amdgcn_global_load_lds(src, (LAS unsigned*)(tab + wid * 256), 4, 0, 0);
    }
    DEV void epi_tab(ACC_T, const Unit& u, int wr, int wc, int fr, int fq, const LAS unsigned char* tab) const {
        const int rloc = wr * 64 + fr, c16 = u.pn * BM + wc * 64 + 16 * fq;
#pragma unroll
        for (int ai = 0; ai < 2; ++ai) { if (ai == 1 && u.half) break;
#pragma unroll
            for (int m = 0; m < 4; ++m) { const int rr = rloc + ai * HALF + m * 16;
                const int s = *(const LAS int*)(tab + rr * 4); const float g = *(const LAS float*)(tab + 1024 + rr * 4) * SLAB_SCALE;
                if (s >= 0) { u32x4 o;
                    { const f32x4 a = acc[ai][0][m][0] * g, b = acc[ai][0][m][1] * g; o.x = pk4_fp8(a[0], a[1], a[2], a[3]); o.y = pk4_fp8(b[0], b[1], b[2], b[3]); }
                    { const f32x4 a = acc[ai][1][m][0] * g, b = acc[ai][1][m][1] * g; o.z = pk4_fp8(a[0], a[1], a[2], a[3]); o.w = pk4_fp8(b[0], b[1], b[2], b[3]); }
                    *(u32x4*)(SLAB + (size_t)s * DM + c16) = o; }
                asm volatile("" ::: "memory"); } }
    }
    DEV void operator()(ACC_T, const Unit& u, int wr, int wc, int fr, int fq) const {}
};
DEV void acc4_fp8(f32x4& a, unsigned w) { const auto lo = __builtin_amdgcn_cvt_pk_f32_fp8((int)w, false), hi = __builtin_amdgcn_cvt_pk_f32_fp8((int)w, true); a[0] += lo[0]; a[1] += lo[1]; a[2] += hi[0]; a[3] += hi[1]; }
struct MEpiFinal { static constexpr bool PERM = true; static constexpr bool KEEP_ACC = false; static constexpr bool ROWTAB = false; float* out; const unsigned char* SLAB; const float* mod;
    DEV void operator()(ACC_T, const Unit& u, int wr, int wc, int fr, int fq) const {
        const int row0 = u.pm * BM + wr * 64 + fr, c16 = u.pn * BM + wc * 64 + 16 * fq;
        const float* gm = mod + ((u.pm * BM) / SEQ) * NMOD + 5120 + c16;
        u32x4 swn[4];
        { const unsigned char* sp_ = SLAB + (size_t)row0 * 8 * DM + c16;
#pragma unroll
          for (int k = 0; k < 4; ++k) swn[k] = *(const u32x4*)(sp_ + (size_t)k * DM); }
#pragma unroll
        for (int gi = 0; gi < 8; ++gi) { const int ai = gi >> 2, m = gi & 3; const size_t row = (size_t)(row0 + ai * HALF + m * 16);
            const unsigned char* sp = SLAB + row * 8 * DM + c16;
            float* op = out + row * DM + c16;
            u32x4 swl[4], swh[4]; f32x4 x[4];
#pragma unroll
            for (int k = 0; k < 4; ++k) { swl[k] = swn[k]; swh[k] = *(const u32x4*)(sp + (size_t)(4 + k) * DM); }
#pragma unroll
            for (int q = 0; q < 4; ++q) x[q] = *(const f32x4*)(op + 4 * q);
            if (gi < 7) { const unsigned char* sp_ = SLAB + (size_t)(row0 + ((gi + 1) >> 2) * HALF + ((gi + 1) & 3) * 16) * 8 * DM + c16;
#pragma unroll
                for (int k = 0; k < 4; ++k) swn[k] = *(const u32x4*)(sp_ + (size_t)k * DM); }
            f32x4 s4[4];
#pragma unroll
            for (int q = 0; q < 4; ++q) s4[q] = (f32x4){0.f, 0.f, 0.f, 0.f};
#pragma unroll
            for (int k = 0; k < 4; ++k) { acc4_fp8(s4[0], swl[k].x); acc4_fp8(s4[1], swl[k].y); acc4_fp8(s4[2], swl[k].z); acc4_fp8(s4[3], swl[k].w); }
#pragma unroll
            for (int k = 0; k < 4; ++k) { acc4_fp8(s4[0], swh[k].x); acc4_fp8(s4[1], swh[k].y); acc4_fp8(s4[2], swh[k].z); acc4_fp8(s4[3], swh[k].w); }
            s4[0] = s4[0] * SLAB_INV + acc[ai][0][m][0]; s4[1] = s4[1] * SLAB_INV + acc[ai][0][m][1]; s4[2] = s4[2] * SLAB_INV + acc[ai][1][m][0]; s4[3] = s4[3] * SLAB_INV + acc[ai][1][m][1];
#pragma unroll
            for (int q = 0; q < 4; ++q) *(f32x4*)(op + 4 * q) = x[q] + *(const f32x4*)(gm + 4 * q) * s4[q];
            asm volatile("" ::: "memory"); }
    } };
#undef ACC_T
}

typedef float f32x16 __attribute__((ext_vector_type(16)));
typedef short s16x4 __attribute__((ext_vector_type(4)));
DEV int crow(int r, int hi) { return (r & 3) + 8 * (r >> 2) + 4 * hi; }
DEV unsigned cvtpk(float lo, float hi) { unsigned r; asm("v_cvt_pk_bf16_f32 %0, %1, %2" : "=v"(r) : "v"(lo), "v"(hi)); return r; }
DEV s16x4 vtr(const LAS unsigned char* p) { return __builtin_bit_cast(s16x4, __builtin_amdgcn_ds_read_tr16_b64_v4i16((LAS s16x4*)p)); }
DEV float swap32(float v) { return __shfl_xor(v, 32); }

DEV void normrope_frag(bf16x8 (&f)[4], const LAS float* gt, int hi, float posf) {
    float x[32]; float ss = 0.f;
#pragma unroll
    for (int d0 = 0; d0 < 4; ++d0) { const u32x4 w = __builtin_bit_cast(u32x4, f[d0]);
        x[8 * d0 + 0] = __uint_as_float(w.x << 16); x[8 * d0 + 1] = __uint_as_float(w.x & 0xffff0000u); x[8 * d0 + 2] = __uint_as_float(w.y << 16); x[8 * d0 + 3] = __uint_as_float(w.y & 0xffff0000u);
        x[8 * d0 + 4] = __uint_as_float(w.z << 16); x[8 * d0 + 5] = __uint_as_float(w.z & 0xffff0000u); x[8 * d0 + 6] = __uint_as_float(w.w << 16); x[8 * d0 + 7] = __uint_as_float(w.w & 0xffff0000u); }
#pragma unroll
    for (int i = 0; i < 32; ++i) ss += x[i] * x[i];
    ss += __shfl_xor(ss, 32);
    const float rs = rsqrtf(ss * (1.f / 64.f) + 1e-6f);
#pragma unroll
    for (int d0 = 0; d0 < 4; ++d0) { const f32x4 g0 = *(const LAS f32x4*)(gt + 16 * d0 + 8 * hi), g1 = *(const LAS f32x4*)(gt + 16 * d0 + 8 * hi + 4);
#pragma unroll
        for (int j = 0; j < 4; ++j) { x[8 * d0 + j] *= rs * g0[j]; x[8 * d0 + 4 + j] *= rs * g1[j]; } }
    constexpr float INVF[8] = {1.0f, 0.19392274474868576f, 0.03760603093086393f, 0.007292664737217109f, 0.001414213562373095f, 0.0002742481756762073f, 5.318295896944988e-05f, 1.031338537721246e-05f};
#pragma unroll
    for (int i = 0; i < 8; ++i) {
        const float rev = posf * (INVF[i] * 0.15915494309189535f);
        const float fr = rev - floorf(rev);
        const float cs = __builtin_amdgcn_cosf(fr), sn = __builtin_amdgcn_sinf(fr);
        const float partner = __shfl_xor(x[i], 32);
        x[i] = hi ? (x[i] * cs + partner * sn) : (x[i] * cs - partner * sn);
    }
#pragma unroll
    for (int d0 = 0; d0 < 4; ++d0) { u32x4 w; w.x = cvtpk(x[8 * d0], x[8 * d0 + 1]); w.y = cvtpk(x[8 * d0 + 2], x[8 * d0 + 3]); w.z = cvtpk(x[8 * d0 + 4], x[8 * d0 + 5]); w.w = cvtpk(x[8 * d0 + 6], x[8 * d0 + 7]);
        f[d0] = __builtin_bit_cast(bf16x8, w); }
}

DEV void ph_attn_mfma(const P& p, LAS unsigned char* lds, int bid, int nb) {
    const int tid = otid(); const int lane = tid & 63, wid = __builtin_amdgcn_readfirstlane(tid >> 6), r32 = lane & 31, hi = lane >> 5;
    LAS unsigned char* vl = lds + wid * 16384;
    LAS float* wsf = (LAS float*)(lds + wid * 16384 + 4096);
    LAS float* gtab_q = (LAS float*)(lds + wid * 16384 + 4352);
    LAS bf16_t* ost = (LAS bf16_t*)(lds + wid * 16384 + 8192);
    LAS float* gtab_k = gtab_q + 64;
    gtab_q[lane] = p.q_norm_g[lane]; gtab_k[lane] = p.k_norm_g[lane];
    asm volatile("s_waitcnt lgkmcnt(0)" ::: "memory");
    float gq = fabsf(p.q_norm_g[lane]), gk = fabsf(p.k_norm_g[lane]);
#pragma unroll
    for (int o = 32; o >= 1; o >>= 1) { gq = fmaxf(gq, __shfl_xor(gq, o)); gk = fmaxf(gk, __shfl_xor(gk, o)); }
    constexpr float LOG2E = 1.4426950408889634f, C2 = 0.125f * LOG2E;
    const float nmref = -(8.f * gq * gk * LOG2E);
    const int head = wid & 3, par = wid >> 2;
    const int tq = (lane & 15) >> 2, tp = lane & 3, tcb = (lane >> 4) & 1;
    const LAS unsigned char* vrd = vl + (4 * hi + tq) * 128 + (16 * tcb + 4 * tp) * 2;
    for (int it2 = bid; it2 < NB * 48; it2 += nb) {
        const int it = it2 * 2 + par;
        const int cb = it & 31, g = (it >> 5) % 3, b = it / 96;
        const int dsh = 2 * g, d = 1 << dsh, L = SEQ >> dsh, nbk = L >> 6;
        const int r = cb / nbk, blk = cb % nbk;
        const int h = 4 * g + head, base = b * SEQ;
        const int q0 = 64 * blk;
        const int mqa = q0 + r32, mqb = q0 + 32 + r32;
        bf16x8 qa[4], qb[4];
        { const bf16_t* qp = p.QKV + (size_t)(base + mqa * d + r) * 2304 + h * 64 + hi * 8;
#pragma unroll
          for (int d0 = 0; d0 < 4; ++d0) qa[d0] = *(const bf16x8*)(qp + d0 * 16);
          const bf16_t* qp2 = p.QKV + (size_t)(base + mqb * d + r) * 2304 + h * 64 + hi * 8;
#pragma unroll
          for (int d0 = 0; d0 < 4; ++d0) qb[d0] = *(const bf16x8*)(qp2 + d0 * 16); }
        const float pqa = (float)p.pos[base + mqa * d + r], pqb = (float)p.pos[base + mqb * d + r];
        normrope_frag(qa, gtab_q, hi, pqa); normrope_frag(qb, gtab_q, hi, pqb);
        f32x16 oa0, oa1, ob0, ob1;
#pragma unroll
        for (int i = 0; i < 16; ++i) { oa0[i] = 0.f; oa1[i] = 0.f; ob0[i] = 0.f; ob1[i] = 0.f; }
        float lsa = 0.f, lsb = 0.f;
        const int kb0 = q0 - 64;
#pragma unroll 1
        for (int st = 0; st < 6; ++st) {
            const int k0 = kb0 + 32 * st;
            if (k0 + 31 < 0 || k0 >= L) continue;
            const int mkc = min(max(k0 + r32, 0), L - 1);
            const bf16_t* kp = p.QKV + (size_t)(base + mkc * d + r) * 2304 + 768 + h * 64 + hi * 8;
            bf16x8 kf[4];
#pragma unroll
            for (int d0 = 0; d0 < 4; ++d0) kf[d0] = *(const bf16x8*)(kp + d0 * 16);
            const float kposf = (float)p.pos[base + mkc * d + r];
            u32x4 vreg[4];
#pragma unroll
            for (int i = 0; i < 4; ++i) { const int c = lane + 64 * i, row = c >> 3, ch = c & 7; const int mv = min(max(k0 + row, 0), L - 1);
                vreg[i] = *(const u32x4*)(p.QKV + (size_t)(base + mv * d + r) * 2304 + 1536 + h * 64 + ch * 8); }
            normrope_frag(kf, gtab_k, hi, kposf);
            const bool doa = st < 5, dob = st > 0;
            bf16x8 pa0, pa1, pb0, pb1;
#define ATT_SCORES(QR, MQ, LS, PF0, PF1) do { f32x16 s_; _Pragma("unroll") for (int i = 0; i < 16; ++i) s_[i] = 0.f; \
                _Pragma("unroll") for (int d0 = 0; d0 < 4; ++d0) s_ = __builtin_amdgcn_mfma_f32_32x32x16_bf16(kf[d0], QR[d0], s_, 0, 0, 0); \
                _Pragma("unroll") for (int i = 0; i < 16; ++i) { const int key = k0 + crow(i, hi); const int df = key - (MQ); \
                    const bool valid = (key >= 0) && (key < L) && (df <= 64) && (df >= -64); \
                    const float pv = valid ? __builtin_amdgcn_exp2f(__builtin_fmaf(s_[i], C2, nmref)) : 0.f; LS += pv; s_[i] = pv; } \
                u32x4 w0, w1; w0.x = cvtpk(s_[0], s_[1]); w0.y = cvtpk(s_[2], s_[3]); w0.z = cvtpk(s_[4], s_[5]); w0.w = cvtpk(s_[6], s_[7]); \
                w1.x = cvtpk(s_[8], s_[9]); w1.y = cvtpk(s_[10], s_[11]); w1.z = cvtpk(s_[12], s_[13]); w1.w = cvtpk(s_[14], s_[15]); \
                PF0 = __builtin_bit_cast(bf16x8, w0); PF1 = __builtin_bit_cast(bf16x8, w1); } while (0)
            if (doa) ATT_SCORES(qa, mqa, lsa, pa0, pa1);
            if (dob) ATT_SCORES(qb, mqb, lsb, pb0, pb1);
#undef ATT_SCORES
#pragma unroll
            for (int i = 0; i < 4; ++i) { const int c = lane + 64 * i, row = c >> 3, ch = c & 7; *(LAS u32x4*)(vl + row * 128 + ch * 16) = vreg[i]; }
            asm volatile("s_waitcnt lgkmcnt(0)" ::: "memory");
#pragma unroll
            for (int n = 0; n < 2; ++n)
#pragma unroll
                for (int ks = 0; ks < 2; ++ks) {
                    const s16x4 lo = vtr(vrd + (16 * ks) * 128 + 64 * n), hi4 = vtr(vrd + (16 * ks + 8) * 128 + 64 * n);
                    bf16x8 vf; vf[0] = lo[0]; vf[1] = lo[1]; vf[2] = lo[2]; vf[3] = lo[3]; vf[4] = hi4[0]; vf[5] = hi4[1]; vf[6] = hi4[2]; vf[7] = hi4[3];
                    if (doa) { if (n == 0) oa0 = __builtin_amdgcn_mfma_f32_32x32x16_bf16(ks == 0 ? pa0 : pa1, vf, oa0, 0, 0, 0);
                               else oa1 = __builtin_amdgcn_mfma_f32_32x32x16_bf16(ks == 0 ? pa0 : pa1, vf, oa1, 0, 0, 0); }
                    if (dob) { if (n == 0) ob0 = __builtin_amdgcn_mfma_f32_32x32x16_bf16(ks == 0 ? pb0 : pb1, vf, ob0, 0, 0, 0);
                               else ob1 = __builtin_amdgcn_mfma_f32_32x32x16_bf16(ks == 0 ? pb0 : pb1, vf, ob1, 0, 0, 0); }
                }
            asm volatile("s_waitcnt lgkmcnt(0)" ::: "memory");
        }
        const float lta = lsa + swap32(lsa), ltb = lsb + swap32(lsb);
        if (hi == 0) { wsf[r32] = 1.f / lta; wsf[32 + r32] = 1.f / ltb;
            p.LSUM[((size_t)g * T + (base + mqa * d + r)) * 4 + head] = lta; p.LSUM[((size_t)g * T + (base + mqb * d + r)) * 4 + head] = ltb; }
        asm volatile("s_waitcnt lgkmcnt(0)" ::: "memory");
        LAS bf16_t* ob_ = ost + 4 * hi * 64 + r32;
#pragma unroll
        for (int i = 0; i < 16; ++i) { const int qc = (i & 3) + 8 * (i >> 2); const float ia = wsf[4 * hi + qc];
            ob_[qc * 64] = f2bf(oa0[i] * ia); ob_[qc * 64 + 32] = f2bf(oa1[i] * ia); }
        asm volatile("" ::: "memory");
#pragma unroll
        for (int i = 0; i < 16; ++i) { const int qc = (i & 3) + 8 * (i >> 2); const float ib = wsf[32 + 4 * hi + qc];
            ob_[(32 + qc) * 64] = f2bf(ob0[i] * ib); ob_[(32 + qc) * 64 + 32] = f2bf(ob1[i] * ib); }
        asm volatile("s_waitcnt lgkmcnt(0)" ::: "memory");
        bf16_t* og = p.OG + (size_t)g * T * 256 + head * 64;
#pragma unroll
        for (int i = 0; i < 8; ++i) { const int c = lane + 64 * i, qrow = c >> 3, ch = c & 7;
            const u32x4 w = *(const LAS u32x4*)(ost + qrow * 64 + ch * 8);
            *(u32x4*)(og + (size_t)(base + (q0 + qrow) * d + r) * 256 + ch * 8) = w; }
        asm volatile("s_waitcnt lgkmcnt(0)" ::: "memory");
    }
}
DEV void ph_attn_combine(const P& p, int bid, int nb) {
    const int tid_ = otid();
    for (int i = bid * NTHR + tid_; i < T * 32; i += nb * NTHR) {
        const int t = i >> 5, ch = i & 31, slot = ch >> 3;
        const float l0 = p.LSUM[(size_t)t * 4 + slot], l1 = p.LSUM[((size_t)T + t) * 4 + slot], l2 = p.LSUM[((size_t)2 * T + t) * 4 + slot];
        const float inv = 1.f / (l0 + l1 + l2);
        const u32x4 a = *(const u32x4*)(p.OG + (size_t)t * 256 + ch * 8), b = *(const u32x4*)(p.OG + ((size_t)T + t) * 256 + ch * 8), c = *(const u32x4*)(p.OG + ((size_t)2 * T + t) * 256 + ch * 8);
        const f32x4 lo = (mg::unpack_lo(a) * l0 + mg::unpack_lo(b) * l1 + mg::unpack_lo(c) * l2) * inv;
        const f32x4 hi = (mg::unpack_hi(a) * l0 + mg::unpack_hi(b) * l1 + mg::unpack_hi(c) * l2) * inv;
        *(u32x4*)(p.PL + (size_t)t * 768 + 512 + ch * 8) = mg::pack8(lo, hi);
    }
}

template <class Src>
DEV void transpose_blk(const Src& src, int K, bf16_t* WT0, LAS float* scr, int k0, int lane) {
#pragma unroll 8
    for (int i = 0; i < 32; ++i) { const int kk = 2 * i + (lane >> 5); scr[kk * 33 + (lane & 31)] = src(k0 + kk, lane & 31); }
    asm volatile("s_waitcnt lgkmcnt(0)" ::: "memory");
    const int c = lane & 7;
#pragma unroll
    for (int j = 0; j < 4; ++j) { const int n = (lane >> 3) + 8 * j; const LAS float* s = scr + (8 * c) * 33 + n;
        u32x4 o; o.x = pk2(s[0 * 33], s[1 * 33]); o.y = pk2(s[2 * 33], s[3 * 33]); o.z = pk2(s[4 * 33], s[5 * 33]); o.w = pk2(s[6 * 33], s[7 * 33]);
        *(u32x4*)(WT0 + (size_t)n * K + k0 + 8 * c) = o; }
    asm volatile("s_waitcnt lgkmcnt(0)" ::: "memory");
}
struct SrcCol { const float* W; int ld; DEV float operator()(int k, int j) const { return W[(size_t)k * ld + j]; } };
struct SrcEff { const float *wg, *ls, *wu;
    DEV float operator()(int k, int j) const { const int g = k >> 7; const float* a = wg + (size_t)k * 128; const float* l = ls + g * 128; const float* b = wu + (size_t)(g * 128) * DM + j; float s = 0.f;
#pragma unroll 4
        for (int d = 0; d < 128; ++d) s += a[d] * l[d] * b[(size_t)d * DM]; return s; } };
DEV void tr_plain(const float* W, int K, int N, bf16_t* WT, LAS float* scr, int item, int lane) {
    const int nblk = N / 32, k0 = 64 * (item / nblk), n0 = 32 * (item % nblk);
    transpose_blk(SrcCol{W + n0, N}, K, WT + (size_t)n0 * K, scr, k0, lane);
}
DEV void tr_perm16(const float* W, int K, int N, bf16_t* WT, LAS float* scr, int item, int lane) {
    const int nblk = N / 32, k0 = 64 * (item / nblk), rho0 = 32 * (item % nblk);
    const int tile = rho0 >> 8, bj = (rho0 >> 7) & 1, wc = (rho0 >> 5) & 3;
    const int n0 = tile * 256 + 64 * wc + 8 * bj;
    struct SrcP { const float* W; int ld; DEV float operator()(int k, int dr) const { return W[(size_t)k * ld + 16 * (dr >> 3) + (dr & 7)]; } };
    transpose_blk(SrcP{W + n0, N}, K, WT + (size_t)rho0 * K, scr, k0, lane);
}
DEV void tr_gu(const float* g, const float* u, int K, bf16_t* WT, LAS float* scr, int k0, int rho0, int lane) {
    const int ch0 = (rho0 >> 8) * 128 + (rho0 & 127);
    const float* m = (rho0 & 128) ? u : g;
    transpose_blk(SrcCol{m + ch0, EFF}, K, WT + (size_t)rho0 * K, scr, k0, lane);
}

DEV void ph_prep_small(const P& p, LAS float* scr, int gw, int ngw, int lane) {
    constexpr int I_IN = 16 * (INW / 32), I_EFF = 64 * 16, I_AU = 4 * 32, I_OUT = 16 * 32, I_R = 16 * 8, I_S = 16 * 16, I_SD = 4 * 32;
    constexpr int NIT = I_IN + I_EFF + I_AU + I_OUT + I_R + I_S + I_SD;
    for (int it = gw; it < NIT; it += ngw) {
        int r = it;
        if (r < I_IN) { tr_plain(p.w_in, DM, INW, p.WT_IN, scr, r, lane); continue; } r -= I_IN;
        if (r < I_EFF) {
            const int n = 64 * (r & 15) + lane, k0 = 8 * (r >> 4), g = k0 >> 7;
            const float* a = p.pool_w_grp + (size_t)k0 * 128; const float* l = p.pool_scale + g * 128; const float* b = p.w_pool_up + (size_t)(g * 128) * DM + n;
            float acc[8];
#pragma unroll
            for (int j = 0; j < 8; ++j) acc[j] = 0.f;
#pragma unroll 4
            for (int d = 0; d < 128; ++d) { const float bl = b[(size_t)d * DM] * l[d];
#pragma unroll
                for (int j = 0; j < 8; ++j) acc[j] += a[j * 128 + d] * bl; }
            u32x4 o; o.x = pk2(acc[0], acc[1]); o.y = pk2(acc[2], acc[3]); o.z = pk2(acc[4], acc[5]); o.w = pk2(acc[6], acc[7]);
            *(u32x4*)(p.WT_EFF + (size_t)n * 768 + k0) = o; continue; } r -= I_EFF;
        if (r < I_AU) { const int k0 = 64 * (r / 32), n0 = 32 * (r % 32);
            transpose_blk(SrcCol{p.w_attn_up + n0, DM}, 768, p.WT_EFF + (size_t)n0 * 768 + 512, scr, k0, lane); continue; } r -= I_AU;
        if (r < I_OUT) { tr_plain(p.w_out, DM, DM, p.WT_OUT, scr, r, lane); continue; } r -= I_OUT;
        if (r < I_R) { tr_plain(p.w_router, DM, NE, p.WT_RS, scr, r, lane); continue; } r -= I_R;
        if (r < I_S) { tr_gu(p.w_sg, p.w_su, DM, p.WT_RS + (size_t)256 * DM, scr, 64 * (r / 16), 32 * (r % 16), lane); continue; } r -= I_S;
        tr_perm16(p.w_sd, EFF, DM, p.WT_SD, scr, r, lane);
    }
}
DEV void ph_prep_ed2(const P& p, LAS float* scr, int gw, int ngw, int lane) {
    constexpr int IPE = 4 * 32, NIT = NE * IPE;
    for (int it = gw * 2; it < NIT; it += ngw * 2) {
        const float* src[2]; bf16_t* dst[2]; int k0[2];
#pragma unroll
        for (int q = 0; q < 2; ++q) { const int t_ = it + q, e = t_ / IPE, item = t_ % IPE, nblk = DM / 32; k0[q] = 64 * (item / nblk); const int rho0 = 32 * (item % nblk);
            const int tile = rho0 >> 8, bj = (rho0 >> 7) & 1, wc = (rho0 >> 5) & 3, n0 = tile * 256 + 64 * wc + 8 * bj;
            src[q] = p.w_ed + (size_t)e * EFF * DM + n0; dst[q] = p.WT_ED + (size_t)e * DM * EFF + (size_t)rho0 * EFF; }
        const int dr = lane & 31, cofs = 16 * (dr >> 3) + (dr & 7);
        float v[2][32];
#pragma unroll
        for (int q = 0; q < 2; ++q)
#pragma unroll
            for (int i = 0; i < 32; ++i) v[q][i] = src[q][(size_t)(k0[q] + 2 * i + (lane >> 5)) * DM + cofs];
#pragma unroll
        for (int q = 0; q < 2; ++q)
#pragma unroll
            for (int i = 0; i < 32; ++i) scr[q * 2112 + (2 * i + (lane >> 5)) * 33 + dr] = v[q][i];
        asm volatile("s_waitcnt lgkmcnt(0)" ::: "memory");
        const int c = lane & 7;
#pragma unroll
        for (int q = 0; q < 2; ++q)
#pragma unroll
            for (int j = 0; j < 4; ++j) { const int n = (lane >> 3) + 8 * j; const LAS float* sp = scr + q * 2112 + (8 * c) * 33 + n;
                u32x4 o; o.x = pk2(sp[0 * 33], sp[1 * 33]); o.y = pk2(sp[2 * 33], sp[3 * 33]); o.z = pk2(sp[4 * 33], sp[5 * 33]); o.w = pk2(sp[6 * 33], sp[7 * 33]);
                *(u32x4*)(dst[q] + (size_t)n * EFF + k0[q] + 8 * c) = o; }
        asm volatile("s_waitcnt lgkmcnt(0)" ::: "memory");
    }
}
DEV void ph_prep_ed(const P& p, LAS float* scr, int gw, int ngw, int lane) {
    constexpr int IPE = 4 * 32;
    for (int it = gw; it < NE * IPE; it += ngw) { const int e = it / IPE;
        tr_perm16(p.w_ed + (size_t)e * EFF * DM, EFF, DM, p.WT_ED + (size_t)e * DM * EFF, scr, it % IPE, lane); }
}
DEV void ph_prep_egu(const P& p, LAS float* scr, int gw, int ngw, int lane) {
    constexpr int IPE = 16 * 16;
    for (int it = gw; it < NE * IPE; it += ngw) { const int e = it / IPE, r = it % IPE;
        tr_gu(p.w_eg + (size_t)e * DM * EFF, p.w_eu + (size_t)e * DM * EFF, DM, p.WT_EGU + (size_t)e * 512 * DM, scr, 64 * (r / 16), 32 * (r % 16), lane); }
}

constexpr int LDS_BYTES = 155648;
constexpr int LDS_OFF_TAB = 131072;
constexpr int LDS_GTAB = 131072 + 4096;
constexpr int MAXU = 16;
constexpr int LDS_MISC = LDS_GTAB + MAXU * 1024;

DEV void fill_gtab(const P& p, const mg::ExpertOrder& S, LAS unsigned* gtab) {
    const int tid_ = otid();
    for (int i = 0; i < MAXU; ++i) { int pm, pn, e; if (!S.tile_of(i, pm, pn, e)) break;
        if (tid_ < 256) { const int s = p.rowlist[pm * 256 + tid_]; gtab[i * 256 + tid_] = (unsigned)(s < 0 ? 0 : (s >> 3)) * (unsigned)(DM * 2); } }
    __syncthreads();
}

#define GAS __attribute__((address_space(1)))
#define XB_TMO      128
#define XB_XCNT(j)  (256  + 64 * (j))
#define XB_XSUB(j)  (1280 + 64 * (j))
#define XB_XGEN(j)  (2304 + 64 * (j))
#define XB_TOP      3328
#define XB_TOPGEN   3392
#define XCD_BAR_WORDS 3456
#define XB_SPIN_CAP (1u << 18)
DEV unsigned xb_ld(unsigned* p)              { return __hip_atomic_load(p, __ATOMIC_RELAXED, __HIP_MEMORY_SCOPE_AGENT); }
DEV unsigned xb_add(unsigned* p, unsigned v) { return __hip_atomic_fetch_add(p, v, __ATOMIC_RELAXED, __HIP_MEMORY_SCOPE_AGENT); }
DEV unsigned xb_xcc_id() { return (unsigned)__builtin_amdgcn_s_getreg((3 << 11) | 20) & 0xFu; }
#define XB_SPIN(cond, bar) do { unsigned _sp = 0; while (cond) { __builtin_amdgcn_s_sleep(1); \
    if ((++_sp & 255u) == 0u) { if (xb_ld(&(bar)[XB_TMO])) break; if (_sp > XB_SPIN_CAP) { atomicAdd(&(bar)[XB_TMO], 1u); break; } } } } while (0)
struct XcdBarrier { unsigned* bar; unsigned x; volatile LAS unsigned* st; };
DEV XcdBarrier xcd_barrier_post(unsigned* bar, volatile LAS unsigned* st) {
    XcdBarrier b; b.bar = bar; b.x = xb_xcc_id(); b.st = st;
    if (threadIdx.x == 0) (void)xb_add(&bar[XB_XCNT(b.x)], 1u);
    return b;
}
DEV void xcd_barrier_complete(unsigned* bar, unsigned x, unsigned& nloc, unsigned& nx) {
    const unsigned G = gridDim.x * gridDim.y * gridDim.z;
    unsigned sum, cnt, mine, sp = 0u;
    for (;;) {
        sum = 0u; cnt = 0u; mine = 0u;
#pragma unroll
        for (unsigned j = 0; j < 16; ++j) { const unsigned c = xb_ld(&bar[XB_XCNT(j)]); sum += c; cnt += (c > 0u) ? 1u : 0u; mine = (j == x) ? c : mine; }
        if (sum == G) break;
        __builtin_amdgcn_s_sleep(1);
        if ((++sp & 255u) == 0u) { if (xb_ld(&bar[XB_TMO])) break; if (sp > XB_SPIN_CAP) { atomicAdd(&bar[XB_TMO], 1u); break; } }
    }
    nloc = mine > 0u ? mine : 1u; nx = cnt > 0u ? cnt : 1u;
}
DEV void xcd_barrier(const XcdBarrier& b) {
    asm volatile("s_waitcnt vmcnt(0)" ::: "memory");
    __syncthreads();
    if (threadIdx.x == 0) {
        unsigned* bar = b.bar;
        __builtin_amdgcn_s_waitcnt(0);
        unsigned nloc = b.st[0], nx = b.st[1];
        if (nloc == 0u) { xcd_barrier_complete(bar, b.x, nloc, nx); b.st[0] = nloc; b.st[1] = nx; }
        const unsigned old = xb_add(&bar[XB_XSUB(b.x)], 1u);
        const unsigned gen = old / nloc;
        if (old + 1u == (gen + 1u) * nloc) {
            __builtin_amdgcn_fence(__ATOMIC_RELEASE, "agent");
            asm volatile("s_waitcnt vmcnt(0)" ::: "memory");
            const unsigned og = xb_add(&bar[XB_TOP], 1u);
            const unsigned tg = og / nx;
            if (og + 1u == (tg + 1u) * nx) xb_add(&bar[XB_TOPGEN], 1u);
            else XB_SPIN(xb_ld(&bar[XB_TOPGEN]) == tg, bar);
            __builtin_amdgcn_fence(__ATOMIC_ACQUIRE, "agent");
            xb_add(&bar[XB_XGEN(b.x)], 1u);
            asm volatile("s_waitcnt vmcnt(0)" ::: "memory");
        } else {
            XB_SPIN(xb_ld(&bar[XB_XGEN(b.x)]) == gen, bar);
            __builtin_amdgcn_fence(__ATOMIC_ACQUIRE, "agent");
            asm volatile("s_waitcnt vmcnt(0)" ::: "memory");
        }
    }
    __syncthreads();
}

#define STAMP() do { if (TPROBE >= 0) { if (bid == 0 && threadIdx.x == 0) p.ts[nst] = __builtin_amdgcn_s_memrealtime(); ++nst; } } while (0)
#define GSYNC_CG() do { cg::this_grid().sync(); STAMP(); } while (0)
#define GSYNC() do { xcd_barrier(xbar); STAMP(); } while (0)
__global__ void __launch_bounds__(NTHR, 2) fwd_all(P p) {
    extern __shared__ __attribute__((aligned(16))) unsigned char lds_raw[];
    LAS unsigned char* lds = (LAS unsigned char*)lds_raw;
    float* sm = (float*)lds_raw;
    int* off = (int*)(lds_raw + LDS_OFF_TAB);
    const LAS int* offl = (const LAS int*)(lds + LDS_OFF_TAB);
    LAS unsigned* gtab = (LAS unsigned*)(lds + LDS_GTAB);
    const int bid = blockIdx.x, nb = gridDim.x;
    const int tid_ = otid(); const int lane = tid_ & 63, wv = tid_ >> 6;
    LAS float* scr = (LAS float*)(lds + wv * 16384);
    const int gw = bid * NWV + wv, ngw = nb * NWV;
    volatile LAS unsigned* misc = (volatile LAS unsigned*)(lds + LDS_MISC);
    if (threadIdx.x < 2) misc[threadIdx.x] = 0u;
    __syncthreads();
    const XcdBarrier xbar = xcd_barrier_post(p.bar, misc);
    int nst = 0; STAMP();

    ph_mod(p, sm, bid, nb);
    __syncthreads();
    REPEAT(1) ph_prep_small(p, scr, gw, ngw, lane);
#if MF_EXP2
    REPEAT(2) ph_prep_ed(p, scr, gw, ngw, lane);
#endif
    GSYNC();
    REPEAT(3) ph_norm(p.x, p.norm1_g, p.mod, 0, 1024, p.XB, bid, nb);
    GSYNC();
#if MF_INPROJ
    REPEAT(4) { mg::DenseOrder S; S.init(p.XB, p.WT_IN, T, INW, DM, nb, bid);
      mg::gemm_phase<mg::MEpiInProj, mg::DenseOrder, false>(lds, gtab, DM, S, mg::MEpiInProj{p.U, p.QKV, p.G}); }
#else
    ngemm_dense<false>(p.XB, DM, p.w_in, nullptr, INW, T, INW, DM, EpiInProj{p.U, p.QKV, p.G}, sm, bid, nb);
#endif
    GSYNC();
#if !MF_ATTN
    ph_qknorm(p, bid, nb);
#endif
    REPEAT(5) ph_pool(p, bid, nb);
#if !MF_ATTN
    GSYNC();
#endif
#if MF_ATTN
    REPEAT(6) ph_attn_mfma(p, lds, bid, nb);
    GSYNC();
    REPEAT(7) ph_attn_combine(p, bid, nb);
#else
    ph_attn(p, bid, nb);
#endif
#if !MF_MERGE
#pragma unroll 1
    for (int g = 0; g < 4; ++g) ngemm_dense<false>(p.PL + g * 128, 512, p.pool_w_grp + g * 128 * 128, nullptr, 128, T, 128, 128, EpiPoolGrp{p.Y, p.pool_scale, g}, sm, bid, nb);
#endif
    GSYNC();
#if MF_MERGE
    REPEAT(8) { mg::PairOrder S; S.D.init(p.PL, p.WT_EFF, T, DM, 768, nb, bid); S.kt0 = 8; S.kt1 = 4;
      mg::gemm_phase<mg::MEpiMergeF, mg::PairOrder, false>(lds, gtab, 768, S, mg::MEpiMergeF{p.XB, p.G}); }
#else
    ngemm_dense<false>(p.Y, 512, p.w_pool_up, nullptr, DM, T, DM, 512, EpiMergeA{p.XB, p.G}, sm, bid, nb);
    GSYNC();
    ngemm_dense<false>(p.O, 256, p.w_attn_up, nullptr, DM, T, DM, 256, EpiMergeB{p.XB, p.G}, sm, bid, nb);
#endif
    GSYNC();
#if MF_OUT
    REPEAT(9) { mg::DenseOrder S; S.init(p.XB, p.WT_OUT, T, DM, DM, nb, bid);
      mg::gemm_phase<mg::MEpiOutProj, mg::DenseOrder, false>(lds, gtab, DM, S, mg::MEpiOutProj{p.x, p.out, p.mod}); }
#else
    ngemm_dense<false>(p.XB, DM, p.w_out, nullptr, DM, T, DM, DM, EpiOutProj{p.x, p.out, p.mod}, sm, bid, nb);
#endif
    GSYNC();
    REPEAT(10) ph_norm(p.out, p.norm2_g, p.mod, 3072, 4096, p.XB, bid, nb);
#if MF_EXP1
    __syncthreads();
    REPEAT(11) ph_prep_egu(p, scr, gw, ngw, lane);
#endif
    GSYNC();
#if MF_ROUTER
    REPEAT(12) { mg::DenseOrder S; S.init(p.XB, p.WT_RS, T, 768, DM, nb, bid);
      mg::gemm_phase<mg::MEpiRouterShared, mg::DenseOrder, false>(lds, gtab, DM, S, mg::MEpiRouterShared{p.LG, p.HS}); }
#else
    ngemm_dense<false>(p.XB, DM, p.w_router, nullptr, NE, T, NE, DM, EpiLogits{p.LG}, sm, bid, nb);
#endif
    GSYNC();
    ph_route(p, (int*)lds_raw, bid, nb);
    GSYNC();
    ph_scatter(p, off, bid, nb);
    GSYNC();
#if MF_EXP1
    REPEAT(13) { load_offsets(p.cnt, off);
      mg::ExpertOrder S{offl, 2, nb, bid, (const char*)p.XB, (const char*)p.WT_EGU, (size_t)512 * DM * 2, (size_t)256 * DM * 2, 0, true, p.rowlist, MAXU};
      fill_gtab(p, S, gtab);
      mg::gemm_phase<mg::MEpiAct, mg::ExpertOrder, true>(lds, gtab, DM, S, mg::MEpiAct{p.ACT}); }
#else
    ph_expert1(p, sm, off, bid, nb);
#endif
    GSYNC();
#if MF_EXP2
    REPEAT(14) { load_offsets(p.cnt, off);
      mg::ExpertOrder S{offl, 4, nb, bid, (const char*)p.ACT, (const char*)p.WT_ED, (size_t)DM * EFF * 2, (size_t)256 * EFF * 2, (size_t)256 * EFF * 2, false, p.rowlist, MAXU};
      mg::gemm_phase<mg::MEpiSlab, mg::ExpertOrder, false>(lds, gtab, EFF, S, mg::MEpiSlab{(unsigned char*)p.SLAB, p.rowlist, p.roww}); }
#else
    ph_expert2(p, sm, off, bid, nb);
#endif
    GSYNC();
#if !MF_ROUTER
    ngemm_dense<true>(p.XB, DM, p.w_sg, p.w_su, EFF, T, EFF, DM, EpiAct{p.HS}, sm, bid, nb);
    GSYNC();
#endif
#if MF_FINAL
    { mg::DenseOrder S; S.init(p.HS, p.WT_SD, T, DM, EFF, nb, bid);
      mg::gemm_phase<mg::MEpiFinal, mg::DenseOrder, false>(lds, gtab, EFF, S, mg::MEpiFinal{p.out, (const unsigned char*)p.SLAB, p.mod}); }
#else
    ngemm_dense<false>(p.HS, EFF, p.w_sd, nullptr, DM, T, DM, EFF, EpiFinal{p.out, p.SLAB, p.mod}, sm, bid, nb);
#endif
#if TPROBE >= 0
    GSYNC();
    if (bid == 0 && threadIdx.x == 0) { const unsigned long long dt = p.ts[TPROBE + 1] - p.ts[TPROBE]; p.out[0] += (float)dt * 0.01f / TSCALE; }
#endif
}

extern "C" void kernel_launch(void* const* d_in, const int* in_sizes, int n_in, void* d_out, int out_size, void* d_ws, size_t ws_size, hipStream_t stream) {
    static int grid = 0;
    if (grid == 0) {
        int dev = 0, cus = 0;
        (void)hipGetDevice(&dev);
        (void)hipDeviceGetAttribute(&cus, hipDeviceAttributeMultiprocessorCount, dev);
        int per_cu = 0;
        (void)hipFuncSetAttribute((const void*)fwd_all, hipFuncAttributeMaxDynamicSharedMemorySize, LDS_BYTES);
        (void)hipOccupancyMaxActiveBlocksPerMultiprocessor(&per_cu, fwd_all, NTHR, LDS_BYTES);
        if (per_cu < 1) { fprintf(stderr, "kernel_launch: occupancy query says %d blocks/CU\n", per_cu); per_cu = 1; }
        if (per_cu > 1) per_cu = 1;
        grid = cus * per_cu;
        if (ws_size < WS_END) { fprintf(stderr, "kernel_launch: workspace too small (%zu < %zu)\n", ws_size, (size_t)WS_END); grid = -1; }
    }
    if (grid < 0) return;
    P p{};
    const float* const* in = (const float* const*)d_in;
    p.x = in[0]; p.c = in[1]; p.pos = (const int*)d_in[2];
    p.w_ada = in[3]; p.b_ada = in[4]; p.norm1_g = in[5]; p.w_in = in[6]; p.pool_w_grp = in[7]; p.pool_scale = in[8]; p.q_norm_g = in[9]; p.k_norm_g = in[10];
    p.w_pool_up = in[11]; p.w_attn_up = in[12]; p.w_out = in[13]; p.norm2_g = in[14]; p.w_router = in[15]; p.router_bias = in[16];
    p.w_sg = in[17]; p.w_su = in[18]; p.w_sd = in[19]; p.w_eg = in[20]; p.w_eu = in[21]; p.w_ed = in[22];
    p.out = (float*)d_out;
    char* ws = (char*)d_ws;
    p.mod = (float*)(ws + WS_MOD); p.cnt = (int*)(ws + WS_CNT); p.asg_e = (int*)(ws + WS_ASG_E); p.asg_pos = (int*)(ws + WS_ASG_POS);
    p.asg_w = (float*)(ws + WS_ASG_W); p.rowlist = (int*)(ws + WS_ROWLIST);
    p.XB = (bf16_t*)(ws + WS_XB); p.U = (bf16_t*)(ws + WS_U); p.QKV = (bf16_t*)(ws + WS_QKV); p.G = (bf16_t*)(ws + WS_G); p.PL = (bf16_t*)(ws + WS_PL);
    p.Y = (bf16_t*)(ws + WS_Y); p.O = (bf16_t*)(ws + WS_O); p.ACT = (bf16_t*)(ws + WS_ACT); p.SLAB = (bf16_t*)(ws + WS_SLAB); p.HS = (bf16_t*)(ws + WS_HS);
    p.LG = (float*)(ws + WS_ACT);
    p.roww = (float*)(ws + WS_ROWW);
    p.bar = (unsigned*)(ws + WS_BAR); p.ts = (unsigned long long*)(ws + WS_TS);
    p.OG = (bf16_t*)(ws + WS_OG); p.LSUM = (float*)(ws + WS_LSUM);
    p.WT_IN = (bf16_t*)(ws + WS_WT_IN); p.WT_EFF = (bf16_t*)(ws + WS_WT_EFF); p.WT_AU = (bf16_t*)(ws + WS_WT_AU); p.WT_OUT = (bf16_t*)(ws + WS_WT_OUT);
    p.WT_RS = (bf16_t*)(ws + WS_WT_RS); p.WT_SD = (bf16_t*)(ws + WS_WT_SD); p.WT_EGU = (bf16_t*)(ws + WS_WT_EGU); p.WT_ED = (bf16_t*)(ws + WS_WT_ED);
    (void)hipMemsetAsync(ws + WS_BAR, 0, WS_ZERO_BYTES, stream);
    void* args[] = {&p};
    hipError_t e = hipLaunchCooperativeKernel((void*)fwd_all, dim3(grid), dim3(NTHR), args, LDS_BYTES, stream);
    if (e != hipSuccess) fprintf(stderr, "cooperative launch failed: %s (grid %d)\n", hipGetErrorString(e), grid);
}
```

```cpp
#include <hip/hip_runtime.h>
#include <hip/hip_cooperative_groups.h>
#include <stdint.h>
#include <cstdio>
namespace cg = cooperative_groups;

#ifndef ONE_LAUNCH
#define ONE_LAUNCH 0
#endif

typedef unsigned short bf16_t;
#define DEV __device__ __forceinline__
#define LAS __attribute__((address_space(3)))
typedef short bf16x8 __attribute__((ext_vector_type(8)));
typedef float f32x4 __attribute__((ext_vector_type(4)));
typedef unsigned u32x4 __attribute__((ext_vector_type(4)));
typedef unsigned u32x2 __attribute__((ext_vector_type(2)));

#ifndef MF_INPROJ
#define MF_INPROJ 1
#endif
#ifndef MF_MERGE
#define MF_MERGE 1
#endif
#ifndef MF_OUT
#define MF_OUT 1
#endif
#ifndef MF_ROUTER
#define MF_ROUTER 1
#endif
#ifndef MF_EXP1
#define MF_EXP1 1
#endif
#ifndef MF_EXP2
#define MF_EXP2 1
#endif
#ifndef MF_ATTN
#define MF_ATTN 1
#endif
#ifndef DUP
#define DUP 0
#endif
#ifndef TPROBE
#define TPROBE -1
#endif
#ifndef TSCALE
#define TSCALE 10.0f
#endif
#define REPEAT(n) _Pragma("unroll 1") for (int rep_ = 0; rep_ < ((DUP == (n)) ? 2 : 1); ++rep_)
#ifndef MF_FINAL
#define MF_FINAL 1
#endif

constexpr int NB = 16, SEQ = 2048, DM = 1024, T = NB * SEQ;
constexpr int INW = 4864, NMOD = 6144;
constexpr int NE = 256, EFF = 256;
constexpr int NTHR = 512, NWV = 8;
constexpr int NSLOT = T * 8;
constexpr int RMAX = NSLOT + NE * 256;

DEV float bf2f(bf16_t h) { return __uint_as_float(((unsigned)h) << 16); }
DEV bf16_t f2bf(float f) { unsigned u = __float_as_uint(f); u += 0x7fffu + ((u >> 16) & 1u); return (bf16_t)(u >> 16); }
DEV unsigned pk2(float lo, float hi) { return (unsigned)f2bf(lo) | ((unsigned)f2bf(hi) << 16); }
DEV float sigm(float v) { return 1.f / (1.f + __expf(-v)); }
DEV float silu(float v) { return v / (1.f + __expf(-v)); }
DEV int otid() { int t = threadIdx.x; asm volatile("" : "+v"(t)); return t; }
DEV float wave_sum(float v) {
#pragma unroll
    for (int o = 32; o >= 1; o >>= 1) v += __shfl_xor(v, o);
    return v;
}

struct P {
    const float *x, *c; const int* pos;
    const float *w_ada, *b_ada, *norm1_g, *w_in, *pool_w_grp, *pool_scale, *q_norm_g, *k_norm_g, *w_pool_up, *w_attn_up, *w_out, *norm2_g,
        *w_router, *router_bias, *w_sg, *w_su, *w_sd, *w_eg, *w_eu, *w_ed;
    float* out;
    float* mod; int* cnt; int* asg_e; int* asg_pos; float* asg_w; int* rowlist;
    bf16_t *XB, *U, *QKV, *G, *PL, *Y, *O, *ACT, *SLAB, *HS;
    float* LG;
    bf16_t* OG; float* LSUM; unsigned* bar; unsigned long long* ts; float* roww;
    bf16_t *WT_IN, *WT_EFF, *WT_AU, *WT_OUT, *WT_RS, *WT_SD, *WT_EGU, *WT_ED;
};

constexpr size_t MiB = 1u << 20;
constexpr size_t WS_BAR = 640 * 1024, WS_BAR_BYTES = 16384, WS_ZERO_BYTES = 16384 + 65536;
constexpr size_t WS_TS = 800 * 1024;
constexpr size_t WS_MOD = 0, WS_CNT = WS_BAR + WS_BAR_BYTES, WS_ASG_E = 1 * MiB, WS_ASG_POS = 2 * MiB, WS_ASG_W = 3 * MiB, WS_ROWLIST = 4 * MiB, WS_ROWW = 6 * MiB;
constexpr size_t WS_XB = 8 * MiB;
constexpr size_t WS_ACT = 72 * MiB;
constexpr size_t WS_SLAB = 232 * MiB;
constexpr size_t WS_U = 232 * MiB, WS_QKV = 264 * MiB, WS_G = 408 * MiB, WS_PL = 536 * MiB, WS_Y = 568 * MiB, WS_O = 600 * MiB;
constexpr size_t WS_WT_IN = 744 * MiB, WS_WT_EFF = 754 * MiB, WS_WT_AU = 755 * MiB, WS_WT_OUT = 756 * MiB, WS_WT_RS = 758 * MiB, WS_WT_SD = 760 * MiB;
constexpr size_t WS_WT_ED = 762 * MiB;
constexpr size_t WS_WT_EGU = 232 * MiB;
constexpr size_t WS_OG = 616 * MiB, WS_LSUM = 664 * MiB;
constexpr size_t WS_HS = 890 * MiB;
constexpr size_t WS_END = 906 * MiB;

DEV void ph_mod(const P& p, float* sm, int bid, int nb) {
    const int tid_ = otid(); const int lane = tid_ & 63, wv = tid_ >> 6;
    for (int it = bid; it < 96; it += nb) {
        const int k0 = wv * 128, e = it * 64 + lane;
        float acc[16];
#pragma unroll
        for (int b = 0; b < 16; ++b) acc[b] = 0.f;
#pragma unroll 1
        for (int kh = 0; kh < 2; ++kh) {
            float sc[16];
#pragma unroll
            for (int b = 0; b < 16; ++b) sc[b] = silu(p.c[b * DM + k0 + kh * 64 + lane]);
            const float* wp = p.w_ada + (size_t)(k0 + kh * 64) * NMOD + e;
#pragma unroll 8
            for (int kk = 0; kk < 64; ++kk) { const float w = wp[(size_t)kk * NMOD];
#pragma unroll
                for (int b = 0; b < 16; ++b) acc[b] += __uint_as_float(__builtin_amdgcn_readlane(__float_as_uint(sc[b]), kk)) * w; }
        }
        __syncthreads();
#pragma unroll
        for (int b = 0; b < 16; ++b) sm[(wv * 16 + b) * 64 + lane] = acc[b];
        __syncthreads();
#pragma unroll
        for (int j = 0; j < 2; ++j) { const int idx = tid_ + j * NTHR, b = idx >> 6, col = idx & 63; float s = p.b_ada[it * 64 + col];
#pragma unroll
            for (int w = 0; w < 8; ++w) s += sm[(w * 16 + b) * 64 + col];
            p.mod[b * NMOD + it * 64 + col] = s; }
    }
}

DEV void ph_norm(const float* src, const float* g, const float* mod, int shift_off, int scale_off, bf16_t* dst, int bid, int nb) {
    const int tid_ = otid(); const int lane = tid_ & 63, wv = tid_ >> 6;
    for (int row0 = (bid * NWV + wv) * 2; row0 < T; row0 += nb * NWV * 2) {
        float4 v[2][4]; float ss[2] = {0.f, 0.f};
#pragma unroll
        for (int q = 0; q < 2; ++q) { const float4* xr = (const float4*)(src + (size_t)(row0 + q) * DM);
#pragma unroll
            for (int j = 0; j < 4; ++j) v[q][j] = xr[lane + 64 * j]; }
#pragma unroll
        for (int q = 0; q < 2; ++q)
#pragma unroll
            for (int j = 0; j < 4; ++j) ss[q] += v[q][j].x * v[q][j].x + v[q][j].y * v[q][j].y + v[q][j].z * v[q][j].z + v[q][j].w * v[q][j].w;
        const int b = row0 / SEQ;
#pragma unroll
        for (int q = 0; q < 2; ++q) {
            const float r = rsqrtf(wave_sum(ss[q]) * (1.f / DM) + 1e-6f);
#pragma unroll
            for (int j = 0; j < 4; ++j) {
                const int col = (lane + 64 * j) * 4;
                const float4 g4 = *(const float4*)(g + col);
                const float4 sc = *(const float4*)(mod + b * NMOD + scale_off + col);
                const float4 sh = *(const float4*)(mod + b * NMOD + shift_off + col);
                const float o0 = v[q][j].x * r * g4.x * (1.f + sc.x) + sh.x, o1 = v[q][j].y * r * g4.y * (1.f + sc.y) + sh.y;
                const float o2 = v[q][j].z * r * g4.z * (1.f + sc.z) + sh.z, o3 = v[q][j].w * r * g4.w * (1.f + sc.w) + sh.w;
                uint2 w; w.x = pk2(o0, o1); w.y = pk2(o2, o3);
                *(uint2*)(dst + (size_t)(row0 + q) * DM + col) = w;
            }
        }
    }
}

template <bool DUAL, class RowF, class Epi>
DEV void ngemm_tile(const bf16_t* __restrict__ A, int lda, RowF rowf, const float* __restrict__ B, const float* __restrict__ B2, int ldb,
                    int m0, int n0, int K, Epi epi, float* sm) {
    float* As = sm;
    float* Bs = sm + 16 * 132;
    float* Bs2 = Bs + 16 * 64;
    const int tid = otid(), tm = tid >> 4, tn = tid & 15;
    float acc[4][4], acc2[4][4];
#pragma unroll
    for (int i = 0; i < 4; ++i)
#pragma unroll
        for (int j = 0; j < 4; ++j) { acc[i][j] = 0.f; acc2[i][j] = 0.f; }
    const int ar = tid >> 2, ak = (tid & 3) * 4;
    const int arow = rowf(m0 + ar);
    const bf16_t* ap = A + (size_t)(arow < 0 ? 0 : arow) * lda + ak;
    const int bk = tid >> 5, bn = (tid & 31) * 2;
    for (int k0 = 0; k0 < K; k0 += 16) {
        uint2 av = make_uint2(0u, 0u);
        if (arow >= 0) av = *(const uint2*)(ap + k0);
        const float2 bv = *(const float2*)(B + (size_t)(k0 + bk) * ldb + n0 + bn);
        float2 bv2 = make_float2(0.f, 0.f);
        if (DUAL) bv2 = *(const float2*)(B2 + (size_t)(k0 + bk) * ldb + n0 + bn);
        __syncthreads();
        As[(ak + 0) * 132 + ar] = __uint_as_float(av.x << 16);
        As[(ak + 1) * 132 + ar] = __uint_as_float(av.x & 0xffff0000u);
        As[(ak + 2) * 132 + ar] = __uint_as_float(av.y << 16);
        As[(ak + 3) * 132 + ar] = __uint_as_float(av.y & 0xffff0000u);
        Bs[bk * 64 + bn] = bv.x; Bs[bk * 64 + bn + 1] = bv.y;
        if (DUAL) { Bs2[bk * 64 + bn] = bv2.x; Bs2[bk * 64 + bn + 1] = bv2.y; }
        __syncthreads();
#pragma unroll
        for (int kk = 0; kk < 16; ++kk) {
            const float4 a = *(const float4*)&As[kk * 132 + tm * 4];
            const float4 b = *(const float4*)&Bs[kk * 64 + tn * 4];
            const float aa[4] = {a.x, a.y, a.z, a.w}, bb[4] = {b.x, b.y, b.z, b.w};
#pragma unroll
            for (int i = 0; i < 4; ++i)
#pragma unroll
                for (int j = 0; j < 4; ++j) acc[i][j] += aa[i] * bb[j];
            if (DUAL) {
                const float4 b2 = *(const float4*)&Bs2[kk * 64 + tn * 4];
                const float cc[4] = {b2.x, b2.y, b2.z, b2.w};
#pragma unroll
                for (int i = 0; i < 4; ++i)
#pragma unroll
                    for (int j = 0; j < 4; ++j) acc2[i][j] += aa[i] * cc[j];
            }
        }
    }
#pragma unroll
    for (int i = 0; i < 4; ++i)
#pragma unroll
        for (int j = 0; j < 4; ++j) epi(m0 + tm * 4 + i, n0 + tn * 4 + j, acc[i][j], acc2[i][j]);
}

struct RowId { DEV int operator()(int m) const { return m; } };
struct RowTok { const int* rl; DEV int operator()(int m) const { const int s = rl[m]; return s < 0 ? -1 : (s >> 3); } };

template <bool DUAL, class Epi>
DEV void ngemm_dense(const bf16_t* A, int lda, const float* B, const float* B2, int ldb, int M, int N, int K, Epi epi, float* sm, int bid, int nb) {
    const int tn = N / 64, nt = (M / 128) * tn;
    for (int t = bid; t < nt; t += nb) ngemm_tile<DUAL>(A, lda, RowId(), B, B2, ldb, (t / tn) * 128, (t % tn) * 64, K, epi, sm);
}

struct EpiInProj { bf16_t *U, *QKV, *G;
    DEV void operator()(int r, int c, float v, float) const {
        if (c < 512) U[(size_t)r * 512 + c] = f2bf(v);
        else if (c < 2816) QKV[(size_t)r * 2304 + (c - 512)] = f2bf(v);
        else G[(size_t)r * 2048 + (c - 2816)] = f2bf(sigm(v)); } };
struct EpiPoolGrp { bf16_t* Y; const float* ls; int g;
    DEV void operator()(int r, int c, float v, float) const { Y[(size_t)r * 512 + g * 128 + c] = f2bf(v * ls[g * 128 + c]); } };
struct EpiMergeA { bf16_t* MG; const bf16_t* G;
    DEV void operator()(int r, int c, float v, float) const { MG[(size_t)r * DM + c] = f2bf(bf2f(G[(size_t)r * 2048 + c]) * v); } };
struct EpiMergeB { bf16_t* MG; const bf16_t* G;
    DEV void operator()(int r, int c, float v, float) const { const size_t i = (size_t)r * DM + c; MG[i] = f2bf(bf2f(MG[i]) + bf2f(G[(size_t)r * 2048 + 1024 + c]) * v); } };
struct EpiOutProj { const float* x; float* out; const float* mod;
    DEV void operator()(int r, int c, float v, float) const { const size_t i = (size_t)r * DM + c; out[i] = x[i] + mod[(r / SEQ) * NMOD + 2048 + c] * v; } };
struct EpiLogits { float* LG;
    DEV void operator()(int r, int c, float v, float) const { LG[(size_t)r * NE + c] = v; } };
struct EpiAct { bf16_t* ACT;
    DEV void operator()(int r, int c, float v, float v2) const { ACT[(size_t)r * EFF + c] = f2bf(silu(v) * v2); } };
struct EpiSlab { bf16_t* SLAB; const int* rl; const float* w;
    DEV void operator()(int r, int c, float v, float) const { const int s = rl[r]; if (s >= 0) SLAB[(size_t)s * DM + c] = f2bf(v * w[s]); } };
struct EpiFinal { float* out; const bf16_t* SLAB; const float* mod;
    DEV void operator()(int r, int c, float v, float) const {
        float s = v;
#pragma unroll
        for (int k = 0; k < 8; ++k) s += bf2f(SLAB[((size_t)r * 8 + k) * DM + c]);
        const size_t i = (size_t)r * DM + c; out[i] = out[i] + mod[(r / SEQ) * NMOD + 5120 + c] * s; } };

DEV void ph_qknorm(const P& p, int bid, int nb) {
    const int tid_ = otid(); const int lane = tid_ & 63, wv = tid_ >> 6;
    const float gq = p.q_norm_g[lane], gk = p.k_norm_g[lane];
    const float invf = exp2f(-(float)(lane & 7) * (1.f / 8.f) * log2f(500000.f));
    for (int t = bid * NWV + wv; t < T; t += nb * NWV) {
        const float ang = (float)p.pos[t] * invf;
        const float cs = cosf(ang), sn = sinf(ang);
        bf16_t* ptr = p.QKV + (size_t)t * 2304 + lane;
        float v[24];
#pragma unroll
        for (int hh = 0; hh < 24; ++hh) v[hh] = bf2f(ptr[hh * 64]);
#pragma unroll
        for (int hh = 0; hh < 24; ++hh) {
            const float ss = wave_sum(v[hh] * v[hh]);
            float nv = v[hh] * rsqrtf(ss * (1.f / 64.f) + 1e-6f) * (hh < 12 ? gq : gk);
            const float partner = __shfl_xor(nv, 8);
            if (lane < 8) nv = nv * cs - partner * sn;
            else if (lane < 16) nv = nv * cs + partner * sn;
            ptr[hh * 64] = f2bf(nv);
        }
    }
}

template <int R>
DEV void pool_chunk(const unsigned* up, unsigned* op, int s0) {
    constexpr int W = 32 + 2 * R;
    float w0[W], w1[W];
#pragma unroll
    for (int i = 0; i < W; ++i) { const int q = s0 - R + i; const bool ok = (q >= 0) && (q < SEQ); const unsigned w = up[(size_t)min(max(q, 0), SEQ - 1) * 256];
        w0[i] = ok ? __uint_as_float(w << 16) : 0.f; w1[i] = ok ? __uint_as_float(w & 0xffff0000u) : 0.f; }
    float a0 = 0.f, a1 = 0.f;
#pragma unroll
    for (int i = 0; i < 2 * R + 1; ++i) { a0 += w0[i]; a1 += w1[i]; }
#pragma unroll
    for (int j = 0; j < 32; ++j) {
        const int s = s0 + j;
        const int lo = max(s - R, 0), hi = min(s + R, SEQ - 1);
        const float inv = 1.f / (float)(hi - lo + 1);
        op[(size_t)s * 384] = pk2(a0 * inv - w0[j + R], a1 * inv - w1[j + R]);
        if (j < 31) { a0 += w0[j + 2 * R + 1] - w0[j]; a1 += w1[j + 2 * R + 1] - w1[j]; }
    }
}
DEV void ph_pool(const P& p, int bid, int nb) {
    const int tid_ = otid();
    for (int i = bid * NTHR + tid_; i < NB * 64 * 256; i += nb * NTHR) {
        const int cp = i & 255, chunk = (i >> 8) & 63, b = i >> 14;
        const int g = cp >> 6;
        const unsigned* up = (const unsigned*)(p.U + (size_t)b * SEQ * 512) + cp;
        unsigned* op = (unsigned*)(p.PL + (size_t)b * SEQ * 768) + cp;
        const int s0 = chunk * 32;
        if (g == 0) pool_chunk<1>(up, op, s0); else if (g == 1) pool_chunk<2>(up, op, s0); else if (g == 2) pool_chunk<4>(up, op, s0); else pool_chunk<8>(up, op, s0);
    }
}

DEV void ph_attn(const P& p, int bid, int nb) {
    const int tid_ = otid(); const int lane = tid_ & 63, wv = tid_ >> 6;
    for (int it = bid * NWV + wv; it < T * 4; it += nb * NWV) {
        const int t = it >> 2, slot = it & 3;
        const int s = t & (SEQ - 1), base = t - s;
        float M = -1e30f, l = 0.f, acc = 0.f;
#pragma unroll
        for (int g = 0; g < 3; ++g) {
            const int dsh = 2 * g, d = 1 << dsh, L = SEQ >> dsh;
            const int h = 4 * g + slot;
            const int m = s >> dsh, r = s & (d - 1);
            const float q = bf2f(p.QKV[(size_t)t * 2304 + h * 64 + lane]);
            const bf16_t* kb = p.QKV + 768 + h * 64 + lane;
            const bf16_t* vb = p.QKV + 1536 + h * 64 + lane;
#pragma unroll 4
            for (int rel = -64; rel <= 64; ++rel) {
                const int mm = m + rel;
                const bool valid = (mm >= 0) && (mm < L);
                const int mc = valid ? mm : m;
                const size_t tr = (size_t)(base + mc * d + r) * 2304;
                const float kv = bf2f(kb[tr]), vv = bf2f(vb[tr]);
                const float sc = wave_sum(q * kv) * 0.125f;
                if (valid) {
                    const float mn = fmaxf(M, sc);
                    const float f = __expf(M - mn), pe = __expf(sc - mn);
                    l = l * f + pe; acc = acc * f + pe * vv; M = mn;
                }
            }
        }
        p.O[(size_t)t * 256 + slot * 64 + lane] = f2bf(acc / l);
    }
}

DEV void ph_route(const P& p, int* hist, int bid, int nb) {
    const int tid_ = otid(); const int lane = tid_ & 63, wv = tid_ >> 6;
    const int G = lane & 7, tl = lane >> 3;
    float bias[32];
#pragma unroll
    for (int j = 0; j < 8; ++j) { const float4 b4 = *(const float4*)(p.router_bias + G * 32 + 4 * j); bias[4 * j] = b4.x; bias[4 * j + 1] = b4.y; bias[4 * j + 2] = b4.z; bias[4 * j + 3] = b4.w; }
    for (int t0 = (bid * NWV + wv) * 8; t0 < T; t0 += nb * NWV * 8) {
        const int t = t0 + tl;
        float sc[32], v[32];
#pragma unroll
        for (int j = 0; j < 8; ++j) { const float4 lg = *(const float4*)(p.LG + (size_t)t * NE + G * 32 + 4 * j);
            sc[4 * j] = 1.f / (1.f + expf(-lg.x)); sc[4 * j + 1] = 1.f / (1.f + expf(-lg.y)); sc[4 * j + 2] = 1.f / (1.f + expf(-lg.z)); sc[4 * j + 3] = 1.f / (1.f + expf(-lg.w)); }
        float m1 = -INFINITY, m2 = -INFINITY;
#pragma unroll
        for (int j = 0; j < 32; ++j) { v[j] = sc[j] + bias[j]; const float n1 = fmaxf(m1, v[j]), n2 = fmaxf(fminf(m1, v[j]), m2); m1 = n1; m2 = n2; }
        const float gs = m1 + m2;
        int rank = 0;
#pragma unroll
        for (int g2 = 0; g2 < 8; ++g2) { const float o = __shfl(gs, (lane & 56) + g2); rank += ((o > gs) || (o == gs && g2 < G)) ? 1 : 0; }
        const bool gsel = rank < 4;
        int myidx = 0; float myw = 0.f, wsum = 0.f;
#pragma unroll 1
        for (int k = 0; k < 8; ++k) {
            float bv = -INFINITY, bs = 0.f; int bi = 0;
#pragma unroll
            for (int j = 0; j < 32; ++j) { const bool tk = gsel && (v[j] > bv); bv = tk ? v[j] : bv; bs = tk ? sc[j] : bs; bi = tk ? j : bi; }
            int gi = G * 32 + bi;
#pragma unroll
            for (int o = 1; o < 8; o <<= 1) {
                const float ov = __shfl_xor(bv, o), os = __shfl_xor(bs, o); const int oi = __shfl_xor(gi, o);
                if ((ov > bv) || (ov == bv && oi < gi)) { bv = ov; gi = oi; bs = os; }
            }
            const int wj = (gi >> 5) == G ? (gi & 31) : -1;
#pragma unroll
            for (int j = 0; j < 32; ++j) v[j] = (j == wj) ? -INFINITY : v[j];
            if (G == k) { myidx = gi; myw = bs; }
            wsum += bs;
        }
        __syncthreads();
        if (tid_ < NE) hist[tid_] = 0;
        __syncthreads();
        const int lpos = atomicAdd(&hist[myidx], 1);
        __syncthreads();
        if (tid_ < NE) { const int c_ = hist[tid_]; hist[NE + tid_] = c_ ? atomicAdd(&p.cnt[tid_ * 64], c_) : 0; }
        __syncthreads();
        const int slot = t * 8 + G;
        p.asg_e[slot] = myidx; p.asg_pos[slot] = hist[NE + myidx] + lpos; p.asg_w[slot] = myw / wsum * 2.5f;
    }
}

DEV void load_offsets(const int* cnt, int* off) {
    const int tid = otid();
    __syncthreads();
    if (tid < NE) { const int c_ = cnt[tid * 64]; off[300 + tid] = (c_ + 255) & ~255; off[600 + tid] = c_; }
    __syncthreads();
    if (tid == 0) { int a = 0; for (int e = 0; e < NE; ++e) { off[e] = a; a += off[300 + e]; } off[NE] = a;
        const int x = blockIdx.x & 7; int tf = 0, th = 0;
        for (int j = 0; j < 32; ++j) { const int n_ = off[600 + x + 8 * j], nt_ = (n_ + 255) >> 8, hh = (nt_ > 0 && n_ - (nt_ - 1) * 256 <= 128) ? 1 : 0;
            off[860 + j] = tf; off[900 + j] = th; tf += nt_ - hh; th += hh; }
        off[860 + 32] = tf; off[900 + 32] = th; }
    __syncthreads();
}
DEV int find_expert(const int* off, int m0) {
    int lo = 0, hi = NE;
    while (hi - lo > 1) { const int mid = (lo + hi) >> 1; if (off[mid] <= m0) lo = mid; else hi = mid; }
    return lo;
}

DEV void ph_scatter(const P& p, int* off, int bid, int nb) {
    load_offsets(p.cnt, off);
    const int tid_ = otid();
    for (int slot = bid * NTHR + tid_; slot < NSLOT; slot += nb * NTHR) { const int r = off[p.asg_e[slot]] + p.asg_pos[slot]; p.rowlist[r] = slot; p.roww[r] = p.asg_w[slot]; }
    for (int e = bid; e < NE; e += nb) {
        const int n = p.cnt[e * 64], pd = (n + 255) & ~255;
        for (int i = n + tid_; i < pd; i += NTHR) { p.rowlist[off[e] + i] = -1; p.roww[off[e] + i] = 0.f; }
    }
}

DEV void ph_expert1(const P& p, float* sm, int* off, int bid, int nb) {
    load_offsets(p.cnt, off);
    const int nrt = off[NE] / 128, nt = nrt * 4;
    for (int t = bid; t < nt; t += nb) {
        const int m0 = (t >> 2) * 128, n0 = (t & 3) * 64, e = find_expert(off, m0);
        ngemm_tile<true>(p.XB, DM, RowTok{p.rowlist}, p.w_eg + (size_t)e * DM * EFF, p.w_eu + (size_t)e * DM * EFF, EFF, m0, n0, DM, EpiAct{p.ACT}, sm);
    }
}
DEV void ph_expert2(const P& p, float* sm, int* off, int bid, int nb) {
    load_offsets(p.cnt, off);
    const int nrt = off[NE] / 128, nt = nrt * 16;
    for (int t = bid; t < nt; t += nb) {
        const int m0 = (t >> 4) * 128, n0 = (t & 15) * 64, e = find_expert(off, m0);
        ngemm_tile<false>(p.ACT, EFF, RowId(), p.w_ed + (size_t)e * EFF * DM, nullptr, DM, m0, n0, EFF, EpiSlab{p.SLAB, p.rowlist, p.asg_w}, sm);
    }
}

namespace mg {
constexpr int BM = 256, BK = 64, HALF = 128, HTB = HALF * BK * 2, STAGE_BYTES = 8 * HTB, NXCD = 8, WGM = 8;
__host__ __device__ __forceinline__ int lds_byte(int r, int c) { const int st = (r >> 4) * 2 + (c >> 5), rr = r & 15, cc = c & 31, ob = rr * 64 + cc * 2; return st * 1024 + (ob ^ (((ob >> 9) & 1) << 5)); }
__host__ __device__ __forceinline__ void stage_rc(int b, int& R, int& C) { const int st = b / 1024, sb = b % 1024, swz = sb ^ (((sb >> 9) & 1) << 5); R = (st >> 1) * 16 + swz / 64; C = (st & 1) * 32 + (swz % 64) / 2; }
__host__ __device__ __forceinline__ int perm32(int rho) { const int n = rho >> 4, i = rho & 15; return 8 * (i >> 2) + 4 * n + (i & 3); }

struct Unit { int pm, pn, e, pad, half, pad2; const char* A; const char* B; };

struct DenseOrder { static constexpr bool HAS_HALF = false;
    int nM, nN, nwg, G, c; const char* A; const char* B; size_t tstep;
    DEV void init(const bf16_t* A_, const bf16_t* B_, int M, int N, int K, int G_, int c_) { nM = M / BM; nN = N / BM; nwg = nM * nN; G = G_; c = c_; A = (const char*)A_; B = (const char*)B_; tstep = (size_t)BM * K * 2; }
    DEV bool next(int i, Unit& u) const {
        const long L = (long)i * G + c; if (L >= nwg) return false;
        int wgid = (int)L; { const int q = nwg / NXCD, r = nwg % NXCD, xcd = wgid % NXCD, off = wgid / NXCD; wgid = (xcd < r ? xcd * (q + 1) : r * (q + 1) + (xcd - r) * q) + off; }
        const int nig = WGM * nN, gid = wgid / nig, fm = gid * WGM, gsz = (nM - fm) < WGM ? (nM - fm) : WGM;
        u.pm = fm + ((wgid % nig) % gsz); u.pn = (wgid % nig) / gsz; u.e = 0; u.pad = 0; u.half = 0; u.pad2 = 0;
        u.A = A + (size_t)u.pm * tstep; u.B = B + (size_t)u.pn * tstep; return true;
    }
};
struct PairOrder { static constexpr bool HAS_HALF = false; DenseOrder D; int kt0, kt1;
    DEV bool next(int i, Unit& u) const { if (!D.next(i >> 1, u)) return false; const int part = i & 1; u.e = part; u.pad = part ? kt1 : kt0;
        if (part) { u.A += (size_t)kt0 * 128; u.B += (size_t)kt0 * 128; } return true; }
};
struct ExpertOrder { static constexpr bool HAS_HALF = true;
    const LAS int* off; int ncol, G, c; const char* A; const char* W; size_t wstride, tstepB, tstepA; bool gather; const int* rl; int maxu;
    DEV bool tile_of(int i, int& pm, int& pn, int& e) const {
        const int x = c & 7, cl = c >> 3, nbx = G >> 3;
        const int Lx = i * nbx + cl; int tx = Lx / ncol; pn = Lx % ncol;
        const int ftot = off[860 + 32], htot = off[900 + 32];
        if (tx >= ftot + htot) return false;
        const bool isf = tx < ftot; const int tb = isf ? 860 : 900; if (!isf) tx -= ftot;
        int lo = 0, hi = 32;
        while (hi - lo > 1) { const int mid = (lo + hi) >> 1; if (off[tb + mid] <= tx) lo = mid; else hi = mid; }
        e = x + 8 * lo;
        const int nfull = off[860 + lo + 1] - off[860 + lo];
        pm = (off[e] >> 8) + (isf ? (tx - off[860 + lo]) : nfull);
        return true;
    }
    static constexpr int UT0 = 1024, UTN = 64;
    DEV void build_table(LAS int* offw, int tid) const {
        if (tid < UTN) { int pm = 0, pn = 0, e = 0; const bool ok = tile_of(tid, pm, pn, e);
            const int hf = ok ? ((off[600 + e] - (pm * BM - off[e]) <= HALF) ? 1 : 0) : 0;
            offw[UT0 + 4 * tid] = pm; offw[UT0 + 4 * tid + 1] = pn; offw[UT0 + 4 * tid + 2] = e | (hf << 16); offw[UT0 + 4 * tid + 3] = ok ? 1 : 0; }
    }
    DEV bool next(int i, Unit& u) const {
        int pm, pn, e, hf;
        if (i < UTN) { if (__builtin_amdgcn_readfirstlane(off[UT0 + 4 * i + 3]) == 0) return false;
            pm = __builtin_amdgcn_readfirstlane(off[UT0 + 4 * i]); pn = __builtin_amdgcn_readfirstlane(off[UT0 + 4 * i + 1]);
            const int eh = __builtin_amdgcn_readfirstlane(off[UT0 + 4 * i + 2]); e = eh & 0xffff; hf = eh >> 16; }
        else { if (!tile_of(i, pm, pn, e)) return false; pm = __builtin_amdgcn_readfirstlane(pm); pn = __builtin_amdgcn_readfirstlane(pn); e = __builtin_amdgcn_readfirstlane(e);
            hf = (__builtin_amdgcn_readfirstlane(off[600 + e]) - (pm * BM - __builtin_amdgcn_readfirstlane(off[e])) <= HALF) ? 1 : 0; }
        u.pm = pm; u.pn = pn; u.e = e; u.pad = 0; u.pad2 = 0; u.half = hf;
        u.A = gather ? A : A + (size_t)pm * tstepA; u.B = W + (size_t)e * wstride + (size_t)pn * tstepB; return true;
    }
};

template <class Epi, class Sched, bool GATHER>
DEV void gemm_phase(LAS unsigned char* lds, const LAS unsigned* gtab, const int K, const Sched& S, const Epi& E) {
    const int tid = otid(), wid = __builtin_amdgcn_readfirstlane(tid >> 6), lane = tid & 63, wr = wid >> 2, wc = wid & 3, fr = lane & 15, fq = lane >> 4;
    const int nt = K / BK;
    int Rr[2], Cc[2]; unsigned voffB[2];
#pragma unroll
    for (int i = 0; i < 2; ++i) { stage_rc(tid * 16 + i * 8192, Rr[i], Cc[i]); const int Rb = Epi::PERM ? ((Rr[i] & ~31) + perm32(Rr[i] & 31)) : Rr[i]; voffB[i] = (unsigned)(Rb * K + Cc[i]) * 2u; }
    const size_t kstep = (size_t)(BK * 2);
    const size_t hstep = (size_t)HALF * K * 2;
    const unsigned ldsw = (unsigned)wid * 1024u;
    const int aoff = lds_byte(wr * 64 + fr, fq * 8), boff = lds_byte(wc * 32 + fr, fq * 8);
#define MG_SA(b, h) (((b) * 2 + (h)) * HTB)
#define MG_SB(b, h) ((4 + (b) * 2 + (h)) * HTB)
#define MG_STAGE(bufoff, gbase, voff) do { _Pragma("unroll") for (int _i = 0; _i < 2; ++_i) \
        __builtin_amdgcn_global_load_lds((const unsigned*)((const char*)(gbase) + (voff)[_i]), (LAS unsigned*)(lds + (bufoff) + ldsw + _i * 8192), 16, 0, 0); } while (0)
#define MG_LDA(dst, b, h) do { _Pragma("unroll") for (int m = 0; m < 4; ++m) _Pragma("unroll") for (int k = 0; k < 2; ++k) dst[m][k] = *(const LAS bf16x8*)(lds + MG_SA(b, h) + aoff + m * 2048 + k * 1024); } while (0)
#define MG_LDB(dst, b, h) do { _Pragma("unroll") for (int n = 0; n < 2; ++n) _Pragma("unroll") for (int k = 0; k < 2; ++k) dst[n][k] = *(const LAS bf16x8*)(lds + MG_SB(b, h) + boff + n * 2048 + k * 1024); } while (0)
#define MG_MMA(ai, bj, At, Bt) do { __builtin_amdgcn_s_setprio(1); _Pragma("unroll") for (int m = 0; m < 4; ++m) _Pragma("unroll") for (int n = 0; n < 2; ++n) _Pragma("unroll") for (int k = 0; k < 2; ++k) \
        acc[ai][bj][m][n] = __builtin_amdgcn_mfma_f32_16x16x32_bf16(Bt[n][k], At[m][k], acc[ai][bj][m][n], 0, 0, 0); __builtin_amdgcn_s_setprio(0); } while (0)
#define MG_WAIT_V(n) asm volatile("s_waitcnt vmcnt(" #n ")" ::: "memory")
#define MG_WAIT_L(n) asm volatile("s_waitcnt lgkmcnt(" #n ")" ::: "memory")
#define MG_BAR __builtin_amdgcn_s_barrier()
#define MG_SCHED __builtin_amdgcn_sched_barrier(0)
    Unit cur, nxt; int ui = 0;
    if (!S.next(0, cur)) return;
    int ntc = cur.pad > 0 ? cur.pad : nt;
    bool hf = Sched::HAS_HALF && (cur.half != 0);
    f32x4 acc[2][2][4][2];
#pragma unroll
    for (int a = 0; a < 2; ++a)
#pragma unroll
        for (int b = 0; b < 2; ++b)
#pragma unroll
            for (int m = 0; m < 4; ++m)
#pragma unroll
                for (int n = 0; n < 2; ++n) acc[a][b][m][n] = (f32x4){0.f, 0.f, 0.f, 0.f};
    bf16x8 At[4][2], B0[2][2], B1[2][2];
    unsigned va0[2], va1[2], na0[2], na1[2];
#pragma unroll
    for (int i = 0; i < 2; ++i) {
        if (GATHER) { va0[i] = gtab[Rr[i]] + (unsigned)Cc[i] * 2u; va1[i] = gtab[HALF + Rr[i]] + (unsigned)Cc[i] * 2u; }
        else { va0[i] = (unsigned)(Rr[i] * K + Cc[i]) * 2u; va1[i] = va0[i] + (unsigned)hstep; }
        na0[i] = va0[i]; na1[i] = va1[i];
    }
    const char* cA = cur.A; const char* cB = cur.B;
    MG_STAGE(MG_SB(0, 0), cB, voffB); MG_STAGE(MG_SB(0, 1), cB + hstep, voffB); MG_STAGE(MG_SA(0, 0), cA, va0); MG_STAGE(MG_SA(0, 1), cA, va1);
    if (wr == 1) MG_BAR;
    MG_WAIT_V(2); MG_BAR;
    MG_STAGE(MG_SB(1, 0), cB + kstep, voffB); MG_STAGE(MG_SA(1, 0), cA + kstep, va0); MG_STAGE(MG_SB(1, 1), cB + hstep + kstep, voffB);
    MG_WAIT_V(6); MG_BAR;
    for (;;) {
        if constexpr (Epi::ROWTAB) E.prefetch(cur, (LAS unsigned char*)gtab + (ui & 1) * 2048, wid, lane);
        const bool has_next = S.next(ui + 1, nxt);
        const char* nA = has_next ? nxt.A : cA; const char* nB = has_next ? nxt.B : cB;
        if constexpr (GATHER) {
            if (has_next) {
                if (ui + 1 < S.maxu) {
#pragma unroll
                    for (int i = 0; i < 2; ++i) { na0[i] = gtab[(ui + 1) * BM + Rr[i]] + (unsigned)Cc[i] * 2u; na1[i] = gtab[(ui + 1) * BM + HALF + Rr[i]] + (unsigned)Cc[i] * 2u; }
                } else {
#pragma unroll
                    for (int i = 0; i < 2; ++i) { const int s0_ = S.rl[nxt.pm * BM + Rr[i]], s1_ = S.rl[nxt.pm * BM + HALF + Rr[i]];
                        na0[i] = (unsigned)(s0_ < 0 ? 0 : (s0_ >> 3)) * (unsigned)(K * 2) + (unsigned)Cc[i] * 2u; na1[i] = (unsigned)(s1_ < 0 ? 0 : (s1_ >> 3)) * (unsigned)(K * 2) + (unsigned)Cc[i] * 2u; }
                }
            }
        }
#pragma unroll 1
        for (int t = 0; t < ntc; t += 2) {
            const bool last = (t == ntc - 2);
            const char* a1 = cA + (size_t)(t + 1) * kstep;
            const char* a2 = last ? nA : cA + (size_t)(t + 2) * kstep; const char* b2 = last ? nB : cB + (size_t)(t + 2) * kstep;
            const char* a3 = a2 + kstep; const char* b3 = b2 + kstep;
            unsigned o0[2], o1[2];
#pragma unroll
            for (int i = 0; i < 2; ++i) { o0[i] = (GATHER && last) ? na0[i] : va0[i]; o1[i] = (GATHER && last) ? na1[i] : va1[i]; }
            MG_LDB(B0, 0, 0); MG_LDB(B1, 0, 1); MG_SCHED; MG_LDA(At, 0, 0); MG_STAGE(MG_SA(1, 1), a1, va1);
            MG_WAIT_V(8); MG_WAIT_L(0); MG_BAR; MG_MMA(0, 0, At, B0); MG_MMA(0, 1, At, B1); MG_BAR; MG_SCHED;
            if (!hf) MG_LDA(At, 0, 1); MG_STAGE(MG_SB(0, 0), b2, voffB); MG_STAGE(MG_SB(0, 1), b2 + hstep, voffB); MG_STAGE(MG_SA(0, 0), a2, o0);
            MG_WAIT_V(8); MG_WAIT_L(0); MG_BAR; if (!hf) { MG_MMA(1, 0, At, B0); MG_MMA(1, 1, At, B1); } MG_BAR; MG_SCHED;
            MG_LDB(B0, 1, 0); MG_LDB(B1, 1, 1); MG_SCHED; MG_LDA(At, 1, 0); MG_STAGE(MG_SA(0, 1), a2, o1);
            MG_WAIT_V(8); MG_WAIT_L(0); MG_BAR; MG_MMA(0, 0, At, B0); MG_MMA(0, 1, At, B1); MG_BAR; MG_SCHED;
            if (!hf) MG_LDA(At, 1, 1); MG_STAGE(MG_SB(1, 0), b3, voffB); MG_STAGE(MG_SB(1, 1), b3 + hstep, voffB); MG_STAGE(MG_SA(1, 0), a3, o0);
            MG_WAIT_V(8); MG_WAIT_L(0); MG_BAR; if (!hf) { MG_MMA(1, 0, At, B0); MG_MMA(1, 1, At, B1); } MG_BAR; MG_SCHED;
        }
        if (wr == 0) MG_BAR;
        if constexpr (Epi::ROWTAB) E.epi_tab(acc, cur, wr, wc, fr, fq, (const LAS unsigned char*)gtab + (ui & 1) * 2048);
        else E(acc, cur, wr, wc, fr, fq);
        if (!has_next) break;
        if (!(Epi::KEEP_ACC && cur.e == 0)) {
#pragma unroll
        for (int a = 0; a < 2; ++a)
#pragma unroll
            for (int b = 0; b < 2; ++b)
#pragma unroll
                for (int m = 0; m < 4; ++m)
#pragma unroll
                    for (int n = 0; n < 2; ++n) acc[a][b][m][n] = (f32x4){0.f, 0.f, 0.f, 0.f};
        }
        cur = nxt; cA = nA; cB = nB; ++ui; ntc = cur.pad > 0 ? cur.pad : nt; hf = Sched::HAS_HALF && (cur.half != 0);
#pragma unroll
        for (int i = 0; i < 2; ++i) { va0[i] = na0[i]; va1[i] = na1[i]; }
        if (wr == 1) MG_BAR;
    }
    MG_WAIT_V(0);
    MG_BAR;
    __syncthreads();
#undef MG_SA
#undef MG_SB
#undef MG_STAGE
#undef MG_LDA
#undef MG_LDB
#undef MG_MMA
#undef MG_WAIT_V
#undef MG_WAIT_L
#undef MG_BAR
#undef MG_SCHED
}

DEV u32x4 pack8(const f32x4 a, const f32x4 b) { u32x4 w; w.x = pk2(a[0], a[1]); w.y = pk2(a[2], a[3]); w.z = pk2(b[0], b[1]); w.w = pk2(b[2], b[3]); return w; }
DEV f32x4 unpack_lo(const u32x4 w) { return (f32x4){__uint_as_float(w.x << 16), __uint_as_float(w.x & 0xffff0000u), __uint_as_float(w.y << 16), __uint_as_float(w.y & 0xffff0000u)}; }
DEV f32x4 unpack_hi(const u32x4 w) { return (f32x4){__uint_as_float(w.z << 16), __uint_as_float(w.z & 0xffff0000u), __uint_as_float(w.w << 16), __uint_as_float(w.w & 0xffff0000u)}; }
DEV f32x4 sig4(const f32x4 v) { return (f32x4){sigm(v[0]), sigm(v[1]), sigm(v[2]), sigm(v[3])}; }
DEV f32x4 silu4(const f32x4 v) { return (f32x4){silu(v[0]), silu(v[1]), silu(v[2]), silu(v[3])}; }
#define ACC_T f32x4 (&acc)[2][2][4][2]

struct MEpiInProj { static constexpr bool PERM = true; static constexpr bool KEEP_ACC = false; static constexpr bool ROWTAB = false; bf16_t *U, *QKV, *G;
    DEV void operator()(ACC_T, const Unit& u, int wr, int wc, int fr, int fq) const {
        int colt = u.pn * BM; bf16_t* base; int ld; bool sg = false;
        if (colt < 512) { base = U; ld = 512; } else if (colt < 2816) { base = QKV; ld = 2304; colt -= 512; } else { base = G; ld = 2048; colt -= 2816; sg = true; }
        const int row0 = u.pm * BM + wr * 64 + fr, col0 = colt + wc * 32 + 8 * fq;
#pragma unroll
        for (int ai = 0; ai < 2; ++ai)
#pragma unroll
            for (int m = 0; m < 4; ++m) { bf16_t* rowp = base + (size_t)(row0 + ai * HALF + m * 16) * ld + col0;
#pragma unroll
                for (int bj = 0; bj < 2; ++bj) { f32x4 v0 = acc[ai][bj][m][0], v1 = acc[ai][bj][m][1]; if (sg) { v0 = sig4(v0); v1 = sig4(v1); }
                    *(u32x4*)(rowp + bj * HALF) = pack8(v0, v1); }
                asm volatile("" ::: "memory"); }
    } };
struct MEpiMergeF { static constexpr bool PERM = true; static constexpr bool KEEP_ACC = true; static constexpr bool ROWTAB = false; bf16_t* MG; const bf16_t* G;
    DEV void mid(f32x4 (&acc)[2][2][4][2], const Unit& u, int wr, int wc, int fr, int fq) const {
        const int row0 = u.pm * BM + wr * 64 + fr, col0 = u.pn * BM + wc * 32 + 8 * fq;
        u32x4 ga[4], gb[4];
        { const bf16_t* gr = G + (size_t)row0 * 2048 + col0;
          ga[0] = *(const u32x4*)gr; ga[1] = *(const u32x4*)(gr + HALF); ga[2] = *(const u32x4*)(gr + 1024); ga[3] = *(const u32x4*)(gr + 1024 + HALF); }
#pragma unroll
        for (int gi = 0; gi < 8; ++gi) { const int ai = gi >> 2, m = gi & 3;
            if (gi < 7) { const bf16_t* gr = G + (size_t)(row0 + ((gi + 1) >> 2) * HALF + ((gi + 1) & 3) * 16) * 2048 + col0;
                if (gi & 1) { ga[0] = *(const u32x4*)gr; ga[1] = *(const u32x4*)(gr + HALF); ga[2] = *(const u32x4*)(gr + 1024); ga[3] = *(const u32x4*)(gr + 1024 + HALF); }
                else { gb[0] = *(const u32x4*)gr; gb[1] = *(const u32x4*)(gr + HALF); gb[2] = *(const u32x4*)(gr + 1024); gb[3] = *(const u32x4*)(gr + 1024 + HALF); } }
#pragma unroll
            for (int bj = 0; bj < 2; ++bj) { const u32x4 gp_ = (gi & 1) ? gb[bj] : ga[bj], gq_ = (gi & 1) ? gb[2 + bj] : ga[2 + bj];
                const f32x4 pl = unpack_lo(gp_), ph = unpack_hi(gp_), al = unpack_lo(gq_), ah = unpack_hi(gq_);
                acc[ai][bj][m][0] *= (f32x4){pl[0] * __builtin_amdgcn_rcpf(al[0]), pl[1] * __builtin_amdgcn_rcpf(al[1]), pl[2] * __builtin_amdgcn_rcpf(al[2]), pl[3] * __builtin_amdgcn_rcpf(al[3])};
                acc[ai][bj][m][1] *= (f32x4){ph[0] * __builtin_amdgcn_rcpf(ah[0]), ph[1] * __builtin_amdgcn_rcpf(ah[1]), ph[2] * __builtin_amdgcn_rcpf(ah[2]), ph[3] * __builtin_amdgcn_rcpf(ah[3])}; }
            asm volatile("" ::: "memory"); }
    }
    DEV void operator()(f32x4 (&acc)[2][2][4][2], const Unit& u, int wr, int wc, int fr, int fq) const {
        if (u.e == 0) { mid(acc, u, wr, wc, fr, fq); return; }
        const int row0 = u.pm * BM + wr * 64 + fr, col0 = u.pn * BM + wc * 32 + 8 * fq;
        u32x4 ga[2], gb[2];
        { const bf16_t* gr = G + (size_t)row0 * 2048 + 1024 + col0; ga[0] = *(const u32x4*)gr; ga[1] = *(const u32x4*)(gr + HALF); }
#pragma unroll
        for (int gi = 0; gi < 8; ++gi) { const int ai = gi >> 2, m = gi & 3; const size_t r = (size_t)(row0 + ai * HALF + m * 16);
            if (gi < 7) { const bf16_t* gr = G + (size_t)(row0 + ((gi + 1) >> 2) * HALF + ((gi + 1) & 3) * 16) * 2048 + 1024 + col0;
                if (gi & 1) { ga[0] = *(const u32x4*)gr; ga[1] = *(const u32x4*)(gr + HALF); } else { gb[0] = *(const u32x4*)gr; gb[1] = *(const u32x4*)(gr + HALF); } }
#pragma unroll
            for (int bj = 0; bj < 2; ++bj) { const u32x4 gq_ = (gi & 1) ? gb[bj] : ga[bj];
                *(u32x4*)(MG + r * DM + col0 + bj * HALF) = pack8(acc[ai][bj][m][0] * unpack_lo(gq_), acc[ai][bj][m][1] * unpack_hi(gq_)); }
            asm volatile("" ::: "memory"); }
    } };
struct MEpiOutProj { static constexpr bool PERM = false; static constexpr bool KEEP_ACC = false; static constexpr bool ROWTAB = false; const float* x; float* out; const float* mod;
    DEV void operator()(ACC_T, const Unit& u, int wr, int wc, int fr, int fq) const {
        const int row0 = u.pm * BM + wr * 64 + fr, col0 = u.pn * BM + wc * 32 + 4 * fq;
        const float* gm = mod + ((u.pm * BM) / SEQ) * NMOD + 2048 + col0;
        f32x4 gv[4];
#pragma unroll
        for (int q = 0; q < 4; ++q) gv[q] = *(const f32x4*)(gm + (q >> 1) * HALF + (q & 1) * 16);
        f32x4 xa[4], xb[4];
        { const float* xp = x + (size_t)row0 * DM + col0;
#pragma unroll
          for (int q = 0; q < 4; ++q) xa[q] = *(const f32x4*)(xp + (q >> 1) * HALF + (q & 1) * 16); }
#pragma unroll
        for (int gi = 0; gi < 8; ++gi) { const int ai = gi >> 2, m = gi & 3; const size_t r = (size_t)(row0 + ai * HALF + m * 16) * DM + col0;
            if (gi < 7) { const int ai2 = (gi + 1) >> 2, m2 = (gi + 1) & 3; const float* xp = x + (size_t)(row0 + ai2 * HALF + m2 * 16) * DM + col0;
#pragma unroll
                for (int q = 0; q < 4; ++q) { if (gi & 1) xa[q] = *(const f32x4*)(xp + (q >> 1) * HALF + (q & 1) * 16); else xb[q] = *(const f32x4*)(xp + (q >> 1) * HALF + (q & 1) * 16); } }
#pragma unroll
            for (int q = 0; q < 4; ++q) { const f32x4 xv = (gi & 1) ? xb[q] : xa[q];
                *(f32x4*)(out + r + (q >> 1) * HALF + (q & 1) * 16) = xv + gv[q] * acc[ai][q >> 1][m][q & 1]; }
            asm volatile("" ::: "memory"); }
    } };
struct MEpiRouterShared { static constexpr bool PERM = true; static constexpr bool KEEP_ACC = false; static constexpr bool ROWTAB = false; float* LG; bf16_t* HS;
    DEV void operator()(ACC_T, const Unit& u, int wr, int wc, int fr, int fq) const {
        const int row0 = u.pm * BM + wr * 64 + fr, cw = wc * 32 + 8 * fq;
#pragma unroll
        for (int ai = 0; ai < 2; ++ai)
#pragma unroll
            for (int m = 0; m < 4; ++m) { const size_t r = (size_t)(row0 + ai * HALF + m * 16);
                if (u.pn == 0) {
#pragma unroll
                    for (int bj = 0; bj < 2; ++bj)
#pragma unroll
                        for (int n = 0; n < 2; ++n) *(f32x4*)(LG + r * NE + bj * HALF + cw + 4 * n) = acc[ai][bj][m][n];
                } else {
                    const f32x4 v0 = silu4(acc[ai][0][m][0]) * acc[ai][1][m][0], v1 = silu4(acc[ai][0][m][1]) * acc[ai][1][m][1];
                    *(u32x4*)(HS + r * EFF + (u.pn - 1) * HALF + cw) = pack8(v0, v1);
                }
                asm volatile("" ::: "memory"); }
    } };
struct MEpiAct { static constexpr bool PERM = true; static constexpr bool KEEP_ACC = false; static constexpr bool ROWTAB = false; bf16_t* ACT;
    DEV void operator()(ACC_T, const Unit& u, int wr, int wc, int fr, int fq) const {
        const int row0 = u.pm * BM + wr * 64 + fr, cw = u.pn * HALF + wc * 32 + 8 * fq;
#pragma unroll
        for (int ai = 0; ai < 2; ++ai) { if (ai == 1 && u.half) break;
#pragma unroll
            for (int m = 0; m < 4; ++m) { const size_t r = (size_t)(row0 + ai * HALF + m * 16);
                const f32x4 v0 = silu4(acc[ai][0][m][0]) * acc[ai][1][m][0], v1 = silu4(acc[ai][0][m][1]) * acc[ai][1][m][1];
                *(u32x4*)(ACT + r * EFF + cw) = pack8(v0, v1); asm volatile("" ::: "memory"); } }
    } };
constexpr float SLAB_SCALE = 4.f, SLAB_INV = 0.25f;
DEV unsigned pk4_fp8(float a, float b, float c, float d) {
    a = __builtin_amdgcn_fmed3f(a, -440.f, 440.f); b = __builtin_amdgcn_fmed3f(b, -440.f, 440.f); c = __builtin_amdgcn_fmed3f(c, -440.f, 440.f); d = __builtin_amdgcn_fmed3f(d, -440.f, 440.f);
    int w = 0; w = __builtin_amdgcn_cvt_pk_fp8_f32(a, b, w, false); w = __builtin_amdgcn_cvt_pk_fp8_f32(c, d, w, true); return (unsigned)w; }
struct MEpiSlab { static constexpr bool PERM = true; static constexpr bool KEEP_ACC = false; static constexpr bool ROWTAB = true; unsigned char* SLAB; const int* rl; const float* w;
    DEV void prefetch(const Unit& u, LAS unsigned char* tab, int wid, int lane) const {
        const int rr = (wid & 3) * 64 + lane;
        const unsigned* src = (wid < 4) ? (const unsigned*)(rl + u.pm * BM + rr) : (const unsigned*)(w + u.pm * BM + rr);
        __builtin_amdgcn_global_load_lds(src, (LAS unsigned*)(tab + wid * 256), 4, 0, 0);
    }
    DEV void epi_tab(ACC_T, const Unit& u, int wr, int wc, int fr, int fq, const LAS unsigned char* tab) const {
        const int rloc = wr * 64 + fr, c16 = u.pn * BM + wc * 64 + 16 * fq;
#pragma unroll
        for (int ai = 0; ai < 2; ++ai) { if (ai == 1 && u.half) break;
#pragma unroll
            for (int m = 0; m < 4; ++m) { const int rr = rloc + ai * HALF + m * 16;
                const int s = *(const LAS int*)(tab + rr * 4); const float g = *(const LAS float*)(tab + 1024 + rr * 4) * SLAB_SCALE;
                if (s >= 0) { u32x4 o;
                    { const f32x4 a = acc[ai][0][m][0] * g, b = acc[ai][0][m][1] * g; o.x = pk4_fp8(a[0], a[1], a[2], a[3]); o.y = pk4_fp8(b[0], b[1], b[2], b[3]); }
                    { const f32x4 a = acc[ai][1][m][0] * g, b = acc[ai][1][m][1] * g; o.z = pk4_fp8(a[0], a[1], a[2], a[3]); o.w = pk4_fp8(b[0], b[1], b[2], b[3]); }
                    *(u32x4*)(SLAB + (size_t)s * DM + c16) = o; }
                asm volatile("" ::: "memory"); } }
    }
    DEV void operator()(ACC_T, const Unit& u, int wr, int wc, int fr, int fq) const {}
};
DEV void acc4_fp8(f32x4& a, unsigned w) { const auto lo = __builtin_amdgcn_cvt_pk_f32_fp8((int)w, false), hi = __builtin_amdgcn_cvt_pk_f32_fp8((int)w, true); a[0] += lo[0]; a[1] += lo[1]; a[2] += hi[0]; a[3] += hi[1]; }
struct MEpiFinal { static constexpr bool PERM = true; static constexpr bool KEEP_ACC = false; static constexpr bool ROWTAB = false; float* out; const unsigned char* SLAB; const float* mod;
    DEV void operator()(ACC_T, const Unit& u, int wr, int wc, int fr, int fq) const {
        const int row0 = u.pm * BM + wr * 64 + fr, c16 = u.pn * BM + wc * 64 + 16 * fq;
        const float* gm = mod + ((u.pm * BM) / SEQ) * NMOD + 5120 + c16;
#pragma unroll
        for (int ai = 0; ai < 2; ++ai)
#pragma unroll
            for (int m = 0; m < 4; ++m) { const size_t row = (size_t)(row0 + ai * HALF + m * 16);
                const unsigned char* sp = SLAB + row * 8 * DM + c16;
                float* op = out + row * DM + c16;
                u32x4 sw[8]; f32x4 x[4];
#pragma unroll
                for (int k = 0; k < 8; ++k) sw[k] = *(const u32x4*)(sp + (size_t)k * DM);
#pragma unroll
                for (int q = 0; q < 4; ++q) x[q] = *(const f32x4*)(op + 4 * q);
                f32x4 s4[4];
#pragma unroll
                for (int q = 0; q < 4; ++q) s4[q] = (f32x4){0.f, 0.f, 0.f, 0.f};
#pragma unroll
                for (int k = 0; k < 8; ++k) { acc4_fp8(s4[0], sw[k].x); acc4_fp8(s4[1], sw[k].y); acc4_fp8(s4[2], sw[k].z); acc4_fp8(s4[3], sw[k].w); }
                s4[0] = s4[0] * SLAB_INV + acc[ai][0][m][0]; s4[1] = s4[1] * SLAB_INV + acc[ai][0][m][1]; s4[2] = s4[2] * SLAB_INV + acc[ai][1][m][0]; s4[3] = s4[3] * SLAB_INV + acc[ai][1][m][1];
#pragma unroll
                for (int q = 0; q < 4; ++q) *(f32x4*)(op + 4 * q) = x[q] + *(const f32x4*)(gm + 4 * q) * s4[q];
                asm volatile("" ::: "memory"); }
    } };
#undef ACC_T
}

typedef float f32x16 __attribute__((ext_vector_type(16)));
typedef short s16x4 __attribute__((ext_vector_type(4)));
DEV int crow(int r, int hi) { return (r & 3) + 8 * (r >> 2) + 4 * hi; }
DEV unsigned cvtpk(float lo, float hi) { unsigned r; asm("v_cvt_pk_bf16_f32 %0, %1, %2" : "=v"(r) : "v"(lo), "v"(hi)); return r; }
DEV s16x4 vtr(const LAS unsigned char* p) { return __builtin_bit_cast(s16x4, __builtin_amdgcn_ds_read_tr16_b64_v4i16((LAS s16x4*)p)); }
DEV float swap32(float v) { return __shfl_xor(v, 32); }

DEV void normrope_frag(bf16x8 (&f)[4], const LAS float* gt, int hi, float posf) {
    float x[32]; float ss = 0.f;
#pragma unroll
    for (int d0 = 0; d0 < 4; ++d0) { const u32x4 w = __builtin_bit_cast(u32x4, f[d0]);
        x[8 * d0 + 0] = __uint_as_float(w.x << 16); x[8 * d0 + 1] = __uint_as_float(w.x & 0xffff0000u); x[8 * d0 + 2] = __uint_as_float(w.y << 16); x[8 * d0 + 3] = __uint_as_float(w.y & 0xffff0000u);
        x[8 * d0 + 4] = __uint_as_float(w.z << 16); x[8 * d0 + 5] = __uint_as_float(w.z & 0xffff0000u); x[8 * d0 + 6] = __uint_as_float(w.w << 16); x[8 * d0 + 7] = __uint_as_float(w.w & 0xffff0000u); }
#pragma unroll
    for (int i = 0; i < 32; ++i) ss += x[i] * x[i];
    ss += __shfl_xor(ss, 32);
    const float rs = rsqrtf(ss * (1.f / 64.f) + 1e-6f);
#pragma unroll
    for (int d0 = 0; d0 < 4; ++d0) { const f32x4 g0 = *(const LAS f32x4*)(gt + 16 * d0 + 8 * hi), g1 = *(const LAS f32x4*)(gt + 16 * d0 + 8 * hi + 4);
#pragma unroll
        for (int j = 0; j < 4; ++j) { x[8 * d0 + j] *= rs * g0[j]; x[8 * d0 + 4 + j] *= rs * g1[j]; } }
    constexpr float INVF[8] = {1.0f, 0.19392274474868576f, 0.03760603093086393f, 0.007292664737217109f, 0.001414213562373095f, 0.0002742481756762073f, 5.318295896944988e-05f, 1.031338537721246e-05f};
#pragma unroll
    for (int i = 0; i < 8; ++i) {
        const float rev = posf * (INVF[i] * 0.15915494309189535f);
        const float fr = rev - floorf(rev);
        const float cs = __builtin_amdgcn_cosf(fr), sn = __builtin_amdgcn_sinf(fr);
        const float partner = __shfl_xor(x[i], 32);
        x[i] = hi ? (x[i] * cs + partner * sn) : (x[i] * cs - partner * sn);
    }
#pragma unroll
    for (int d0 = 0; d0 < 4; ++d0) { u32x4 w; w.x = cvtpk(x[8 * d0], x[8 * d0 + 1]); w.y = cvtpk(x[8 * d0 + 2], x[8 * d0 + 3]); w.z = cvtpk(x[8 * d0 + 4], x[8 * d0 + 5]); w.w = cvtpk(x[8 * d0 + 6], x[8 * d0 + 7]);
        f[d0] = __builtin_bit_cast(bf16x8, w); }
}

DEV void ph_attn_mfma(const P& p, LAS unsigned char* lds, int bid, int nb) {
    const int tid = otid(); const int lane = tid & 63, wid = __builtin_amdgcn_readfirstlane(tid >> 6), r32 = lane & 31, hi = lane >> 5;
    LAS unsigned char* vl = lds + wid * 16384;
    LAS float* wsf = (LAS float*)(lds + wid * 16384 + 4096);
    LAS float* gtab_q = (LAS float*)(lds + wid * 16384 + 4352);
    LAS bf16_t* ost = (LAS bf16_t*)(lds + wid * 16384 + 8192);
    LAS float* gtab_k = gtab_q + 64;
    gtab_q[lane] = p.q_norm_g[lane]; gtab_k[lane] = p.k_norm_g[lane];
    asm volatile("s_waitcnt lgkmcnt(0)" ::: "memory");
    float gq = fabsf(p.q_norm_g[lane]), gk = fabsf(p.k_norm_g[lane]);
#pragma unroll
    for (int o = 32; o >= 1; o >>= 1) { gq = fmaxf(gq, __shfl_xor(gq, o)); gk = fmaxf(gk, __shfl_xor(gk, o)); }
    constexpr float LOG2E = 1.4426950408889634f, C2 = 0.125f * LOG2E;
    const float nmref = -(8.f * gq * gk * LOG2E);
    const int head = wid & 3, par = wid >> 2;
    const int tq = (lane & 15) >> 2, tp = lane & 3, tcb = (lane >> 4) & 1;
    const LAS unsigned char* vrd = vl + (4 * hi + tq) * 128 + (16 * tcb + 4 * tp) * 2;
    for (int it2 = bid; it2 < NB * 48; it2 += nb) {
        const int it = it2 * 2 + par;
        const int cb = it & 31, g = (it >> 5) % 3, b = it / 96;
        const int dsh = 2 * g, d = 1 << dsh, L = SEQ >> dsh, nbk = L >> 6;
        const int r = cb / nbk, blk = cb % nbk;
        const int h = 4 * g + head, base = b * SEQ;
        const int q0 = 64 * blk;
        const int mqa = q0 + r32, mqb = q0 + 32 + r32;
        bf16x8 qa[4], qb[4];
        { const bf16_t* qp = p.QKV + (size_t)(base + mqa * d + r) * 2304 + h * 64 + hi * 8;
#pragma unroll
          for (int d0 = 0; d0 < 4; ++d0) qa[d0] = *(const bf16x8*)(qp + d0 * 16);
          const bf16_t* qp2 = p.QKV + (size_t)(base + mqb * d + r) * 2304 + h * 64 + hi * 8;
#pragma unroll
          for (int d0 = 0; d0 < 4; ++d0) qb[d0] = *(const bf16x8*)(qp2 + d0 * 16); }
        const float pqa = (float)p.pos[base + mqa * d + r], pqb = (float)p.pos[base + mqb * d + r];
        normrope_frag(qa, gtab_q, hi, pqa); normrope_frag(qb, gtab_q, hi, pqb);
        f32x16 oa0, oa1, ob0, ob1;
#pragma unroll
        for (int i = 0; i < 16; ++i) { oa0[i] = 0.f; oa1[i] = 0.f; ob0[i] = 0.f; ob1[i] = 0.f; }
        float lsa = 0.f, lsb = 0.f;
        const int kb0 = q0 - 64;
#pragma unroll 1
        for (int st = 0; st < 6; ++st) {
            const int k0 = kb0 + 32 * st;
            if (k0 + 31 < 0 || k0 >= L) continue;
            const int mkc = min(max(k0 + r32, 0), L - 1);
            const bf16_t* kp = p.QKV + (size_t)(base + mkc * d + r) * 2304 + 768 + h * 64 + hi * 8;
            bf16x8 kf[4];
#pragma unroll
            for (int d0 = 0; d0 < 4; ++d0) kf[d0] = *(const bf16x8*)(kp + d0 * 16);
            const float kposf = (float)p.pos[base + mkc * d + r];
            u32x4 vreg[4];
#pragma unroll
            for (int i = 0; i < 4; ++i) { const int c = lane + 64 * i, row = c >> 3, ch = c & 7; const int mv = min(max(k0 + row, 0), L - 1);
                vreg[i] = *(const u32x4*)(p.QKV + (size_t)(base + mv * d + r) * 2304 + 1536 + h * 64 + ch * 8); }
            normrope_frag(kf, gtab_k, hi, kposf);
            const bool doa = st < 5, dob = st > 0;
            bf16x8 pa0, pa1, pb0, pb1;
#define ATT_SCORES(QR, MQ, LS, PF0, PF1) do { f32x16 s_; _Pragma("unroll") for (int i = 0; i < 16; ++i) s_[i] = 0.f; \
                _Pragma("unroll") for (int d0 = 0; d0 < 4; ++d0) s_ = __builtin_amdgcn_mfma_f32_32x32x16_bf16(kf[d0], QR[d0], s_, 0, 0, 0); \
                _Pragma("unroll") for (int i = 0; i < 16; ++i) { const int key = k0 + crow(i, hi); const int df = key - (MQ); \
                    const bool valid = (key >= 0) && (key < L) && (df <= 64) && (df >= -64); \
                    const float pv = valid ? __builtin_amdgcn_exp2f(__builtin_fmaf(s_[i], C2, nmref)) : 0.f; LS += pv; s_[i] = pv; } \
                u32x4 w0, w1; w0.x = cvtpk(s_[0], s_[1]); w0.y = cvtpk(s_[2], s_[3]); w0.z = cvtpk(s_[4], s_[5]); w0.w = cvtpk(s_[6], s_[7]); \
                w1.x = cvtpk(s_[8], s_[9]); w1.y = cvtpk(s_[10], s_[11]); w1.z = cvtpk(s_[12], s_[13]); w1.w = cvtpk(s_[14], s_[15]); \
                PF0 = __builtin_bit_cast(bf16x8, w0); PF1 = __builtin_bit_cast(bf16x8, w1); } while (0)
            if (doa) ATT_SCORES(qa, mqa, lsa, pa0, pa1);
            if (dob) ATT_SCORES(qb, mqb, lsb, pb0, pb1);
#undef ATT_SCORES
#pragma unroll
            for (int i = 0; i < 4; ++i) { const int c = lane + 64 * i, row = c >> 3, ch = c & 7; *(LAS u32x4*)(vl + row * 128 + ch * 16) = vreg[i]; }
            asm volatile("s_waitcnt lgkmcnt(0)" ::: "memory");
#pragma unroll
            for (int n = 0; n < 2; ++n)
#pragma unroll
                for (int ks = 0; ks < 2; ++ks) {
                    const s16x4 lo = vtr(vrd + (16 * ks) * 128 + 64 * n), hi4 = vtr(vrd + (16 * ks + 8) * 128 + 64 * n);
                    bf16x8 vf; vf[0] = lo[0]; vf[1] = lo[1]; vf[2] = lo[2]; vf[3] = lo[3]; vf[4] = hi4[0]; vf[5] = hi4[1]; vf[6] = hi4[2]; vf[7] = hi4[3];
                    if (doa) { if (n == 0) oa0 = __builtin_amdgcn_mfma_f32_32x32x16_bf16(ks == 0 ? pa0 : pa1, vf, oa0, 0, 0, 0);
                               else oa1 = __builtin_amdgcn_mfma_f32_32x32x16_bf16(ks == 0 ? pa0 : pa1, vf, oa1, 0, 0, 0); }
                    if (dob) { if (n == 0) ob0 = __builtin_amdgcn_mfma_f32_32x32x16_bf16(ks == 0 ? pb0 : pb1, vf, ob0, 0, 0, 0);
                               else ob1 = __builtin_amdgcn_mfma_f32_32x32x16_bf16(ks == 0 ? pb0 : pb1, vf, ob1, 0, 0, 0); }
                }
            asm volatile("s_waitcnt lgkmcnt(0)" ::: "memory");
        }
        const float lta = lsa + swap32(lsa), ltb = lsb + swap32(lsb);
        if (hi == 0) { wsf[r32] = 1.f / lta; wsf[32 + r32] = 1.f / ltb;
            p.LSUM[((size_t)g * T + (base + mqa * d + r)) * 4 + head] = lta; p.LSUM[((size_t)g * T + (base + mqb * d + r)) * 4 + head] = ltb; }
        asm volatile("s_waitcnt lgkmcnt(0)" ::: "memory");
        LAS bf16_t* ob_ = ost + 4 * hi * 64 + r32;
#pragma unroll
        for (int i = 0; i < 16; ++i) { const int qc = (i & 3) + 8 * (i >> 2); const float ia = wsf[4 * hi + qc];
            ob_[qc * 64] = f2bf(oa0[i] * ia); ob_[qc * 64 + 32] = f2bf(oa1[i] * ia); }
        asm volatile("" ::: "memory");
#pragma unroll
        for (int i = 0; i < 16; ++i) { const int qc = (i & 3) + 8 * (i >> 2); const float ib = wsf[32 + 4 * hi + qc];
            ob_[(32 + qc) * 64] = f2bf(ob0[i] * ib); ob_[(32 + qc) * 64 + 32] = f2bf(ob1[i] * ib); }
        asm volatile("s_waitcnt lgkmcnt(0)" ::: "memory");
        bf16_t* og = p.OG + (size_t)g * T * 256 + head * 64;
#pragma unroll
        for (int i = 0; i < 8; ++i) { const int c = lane + 64 * i, qrow = c >> 3, ch = c & 7;
            const u32x4 w = *(const LAS u32x4*)(ost + qrow * 64 + ch * 8);
            *(u32x4*)(og + (size_t)(base + (q0 + qrow) * d + r) * 256 + ch * 8) = w; }
        asm volatile("s_waitcnt lgkmcnt(0)" ::: "memory");
    }
}
DEV void ph_attn_combine(const P& p, int bid, int nb) {
    const int tid_ = otid();
    for (int i = bid * NTHR + tid_; i < T * 32; i += nb * NTHR) {
        const int t = i >> 5, ch = i & 31, slot = ch >> 3;
        const float l0 = p.LSUM[(size_t)t * 4 + slot], l1 = p.LSUM[((size_t)T + t) * 4 + slot], l2 = p.LSUM[((size_t)2 * T + t) * 4 + slot];
        const float inv = 1.f / (l0 + l1 + l2);
        const u32x4 a = *(const u32x4*)(p.OG + (size_t)t * 256 + ch * 8), b = *(const u32x4*)(p.OG + ((size_t)T + t) * 256 + ch * 8), c = *(const u32x4*)(p.OG + ((size_t)2 * T + t) * 256 + ch * 8);
        const f32x4 lo = (mg::unpack_lo(a) * l0 + mg::unpack_lo(b) * l1 + mg::unpack_lo(c) * l2) * inv;
        const f32x4 hi = (mg::unpack_hi(a) * l0 + mg::unpack_hi(b) * l1 + mg::unpack_hi(c) * l2) * inv;
        *(u32x4*)(p.PL + (size_t)t * 768 + 512 + ch * 8) = mg::pack8(lo, hi);
    }
}

template <class Src>
DEV void transpose_blk(const Src& src, int K, bf16_t* WT0, LAS float* scr, int k0, int lane) {
#pragma unroll 8
    for (int i = 0; i < 32; ++i) { const int kk = 2 * i + (lane >> 5); scr[kk * 33 + (lane & 31)] = src(k0 + kk, lane & 31); }
    asm volatile("s_waitcnt lgkmcnt(0)" ::: "memory");
    const int c = lane & 7;
#pragma unroll
    for (int j = 0; j < 4; ++j) { const int n = (lane >> 3) + 8 * j; const LAS float* s = scr + (8 * c) * 33 + n;
        u32x4 o; o.x = pk2(s[0 * 33], s[1 * 33]); o.y = pk2(s[2 * 33], s[3 * 33]); o.z = pk2(s[4 * 33], s[5 * 33]); o.w = pk2(s[6 * 33], s[7 * 33]);
        *(u32x4*)(WT0 + (size_t)n * K + k0 + 8 * c) = o; }
    asm volatile("s_waitcnt lgkmcnt(0)" ::: "memory");
}
struct SrcCol { const float* W; int ld; DEV float operator()(int k, int j) const { return W[(size_t)k * ld + j]; } };
struct SrcEff { const float *wg, *ls, *wu;
    DEV float operator()(int k, int j) const { const int g = k >> 7; const float* a = wg + (size_t)k * 128; const float* l = ls + g * 128; const float* b = wu + (size_t)(g * 128) * DM + j; float s = 0.f;
#pragma unroll 4
        for (int d = 0; d < 128; ++d) s += a[d] * l[d] * b[(size_t)d * DM]; return s; } };
DEV void tr_plain(const float* W, int K, int N, bf16_t* WT, LAS float* scr, int item, int lane) {
    const int nblk = N / 32, k0 = 64 * (item / nblk), n0 = 32 * (item % nblk);
    transpose_blk(SrcCol{W + n0, N}, K, WT + (size_t)n0 * K, scr, k0, lane);
}
DEV void tr_perm16(const float* W, int K, int N, bf16_t* WT, LAS float* scr, int item, int lane) {
    const int nblk = N / 32, k0 = 64 * (item / nblk), rho0 = 32 * (item % nblk);
    const int tile = rho0 >> 8, bj = (rho0 >> 7) & 1, wc = (rho0 >> 5) & 3;
    const int n0 = tile * 256 + 64 * wc + 8 * bj;
    struct SrcP { const float* W; int ld; DEV float operator()(int k, int dr) const { return W[(size_t)k * ld + 16 * (dr >> 3) + (dr & 7)]; } };
    transpose_blk(SrcP{W + n0, N}, K, WT + (size_t)rho0 * K, scr, k0, lane);
}
DEV void tr_gu(const float* g, const float* u, int K, bf16_t* WT, LAS float* scr, int k0, int rho0, int lane) {
    const int ch0 = (rho0 >> 8) * 128 + (rho0 & 127);
    const float* m = (rho0 & 128) ? u : g;
    transpose_blk(SrcCol{m + ch0, EFF}, K, WT + (size_t)rho0 * K, scr, k0, lane);
}

DEV void ph_prep_small(const P& p, LAS float* scr, int gw, int ngw, int lane) {
    constexpr int I_IN = 16 * (INW / 32), I_EFF = 64 * 16, I_AU = 4 * 32, I_OUT = 16 * 32, I_R = 16 * 8, I_S = 16 * 16, I_SD = 4 * 32;
    constexpr int NIT = I_IN + I_EFF + I_AU + I_OUT + I_R + I_S + I_SD;
    for (int it = gw; it < NIT; it += ngw) {
        int r = it;
        if (r < I_IN) { tr_plain(p.w_in, DM, INW, p.WT_IN, scr, r, lane); continue; } r -= I_IN;
        if (r < I_EFF) {
            const int n = 64 * (r & 15) + lane, k0 = 8 * (r >> 4), g = k0 >> 7;
            const float* a = p.pool_w_grp + (size_t)k0 * 128; const float* l = p.pool_scale + g * 128; const float* b = p.w_pool_up + (size_t)(g * 128) * DM + n;
            float acc[8];
#pragma unroll
            for (int j = 0; j < 8; ++j) acc[j] = 0.f;
#pragma unroll 4
            for (int d = 0; d < 128; ++d) { const float bl = b[(size_t)d * DM] * l[d];
#pragma unroll
                for (int j = 0; j < 8; ++j) acc[j] += a[j * 128 + d] * bl; }
            u32x4 o; o.x = pk2(acc[0], acc[1]); o.y = pk2(acc[2], acc[3]); o.z = pk2(acc[4], acc[5]); o.w = pk2(acc[6], acc[7]);
            *(u32x4*)(p.WT_EFF + (size_t)n * 768 + k0) = o; continue; } r -= I_EFF;
        if (r < I_AU) { const int k0 = 64 * (r / 32), n0 = 32 * (r % 32);
            transpose_blk(SrcCol{p.w_attn_up + n0, DM}, 768, p.WT_EFF + (size_t)n0 * 768 + 512, scr, k0, lane); continue; } r -= I_AU;
        if (r < I_OUT) { tr_plain(p.w_out, DM, DM, p.WT_OUT, scr, r, lane); continue; } r -= I_OUT;
        if (r < I_R) { tr_plain(p.w_router, DM, NE, p.WT_RS, scr, r, lane); continue; } r -= I_R;
        if (r < I_S) { tr_gu(p.w_sg, p.w_su, DM, p.WT_RS + (size_t)256 * DM, scr, 64 * (r / 16), 32 * (r % 16), lane); continue; } r -= I_S;
        tr_perm16(p.w_sd, EFF, DM, p.WT_SD, scr, r, lane);
    }
}
DEV void ph_prep_ed2(const P& p, LAS float* scr, int gw, int ngw, int lane) {
    constexpr int IPE = 4 * 32, NIT = NE * IPE;
    for (int it = gw * 2; it < NIT; it += ngw * 2) {
        const float* src[2]; bf16_t* dst[2]; int k0[2];
#pragma unroll
        for (int q = 0; q < 2; ++q) { const int t_ = it + q, e = t_ / IPE, item = t_ % IPE, nblk = DM / 32; k0[q] = 64 * (item / nblk); const int rho0 = 32 * (item % nblk);
            const int tile = rho0 >> 8, bj = (rho0 >> 7) & 1, wc = (rho0 >> 5) & 3, n0 = tile * 256 + 64 * wc + 8 * bj;
            src[q] = p.w_ed + (size_t)e * EFF * DM + n0; dst[q] = p.WT_ED + (size_t)e * DM * EFF + (size_t)rho0 * EFF; }
        const int dr = lane & 31, cofs = 16 * (dr >> 3) + (dr & 7);
        float v[2][32];
#pragma unroll
        for (int q = 0; q < 2; ++q)
#pragma unroll
            for (int i = 0; i < 32; ++i) v[q][i] = src[q][(size_t)(k0[q] + 2 * i + (lane >> 5)) * DM + cofs];
#pragma unroll
        for (int q = 0; q < 2; ++q)
#pragma unroll
            for (int i = 0; i < 32; ++i) scr[q * 2112 + (2 * i + (lane >> 5)) * 33 + dr] = v[q][i];
        asm volatile("s_waitcnt lgkmcnt(0)" ::: "memory");
        const int c = lane & 7;
#pragma unroll
        for (int q = 0; q < 2; ++q)
#pragma unroll
            for (int j = 0; j < 4; ++j) { const int n = (lane >> 3) + 8 * j; const LAS float* sp = scr + q * 2112 + (8 * c) * 33 + n;
                u32x4 o; o.x = pk2(sp[0 * 33], sp[1 * 33]); o.y = pk2(sp[2 * 33], sp[3 * 33]); o.z = pk2(sp[4 * 33], sp[5 * 33]); o.w = pk2(sp[6 * 33], sp[7 * 33]);
                *(u32x4*)(dst[q] + (size_t)n * EFF + k0[q] + 8 * c) = o; }
        asm volatile("s_waitcnt lgkmcnt(0)" ::: "memory");
    }
}
DEV void ph_prep_ed(const P& p, LAS float* scr, int gw, int ngw, int lane) {
    constexpr int IPE = 4 * 32;
    for (int it = gw; it < NE * IPE; it += ngw) { const int e = it / IPE;
        tr_perm16(p.w_ed + (size_t)e * EFF * DM, EFF, DM, p.WT_ED + (size_t)e * DM * EFF, scr, it % IPE, lane); }
}
DEV void ph_prep_egu(const P& p, LAS float* scr, int gw, int ngw, int lane) {
    constexpr int IPE = 16 * 16;
    for (int it = gw; it < NE * IPE; it += ngw) { const int e = it / IPE, r = it % IPE;
        tr_gu(p.w_eg + (size_t)e * DM * EFF, p.w_eu + (size_t)e * DM * EFF, DM, p.WT_EGU + (size_t)e * 512 * DM, scr, 64 * (r / 16), 32 * (r % 16), lane); }
}

constexpr int LDS_BYTES = 156672;
constexpr int LDS_OFF_TAB = 131072;
constexpr int LDS_GTAB = 131072 + 8192;
constexpr int MAXU = 16;
constexpr int LDS_MISC = LDS_GTAB + MAXU * 1024;

DEV void fill_gtab(const P& p, const mg::ExpertOrder& S, LAS unsigned* gtab) {
    const int tid_ = otid();
    for (int i = 0; i < MAXU; ++i) { int pm, pn, e; if (!S.tile_of(i, pm, pn, e)) break;
        if (tid_ < 256) { const int s = p.rowlist[pm * 256 + tid_]; gtab[i * 256 + tid_] = (unsigned)(s < 0 ? 0 : (s >> 3)) * (unsigned)(DM * 2); } }
    __syncthreads();
}

#define GAS __attribute__((address_space(1)))
#define XB_TMO      128
#define XB_XCNT(j)  (256  + 64 * (j))
#define XB_XSUB(j)  (1280 + 64 * (j))
#define XB_XGEN(j)  (2304 + 64 * (j))
#define XB_TOP      3328
#define XB_TOPGEN   3392
#define XCD_BAR_WORDS 3456
#define XB_SPIN_CAP (1u << 18)
DEV unsigned xb_ld(unsigned* p)              { return __hip_atomic_load(p, __ATOMIC_RELAXED, __HIP_MEMORY_SCOPE_AGENT); }
DEV unsigned xb_add(unsigned* p, unsigned v) { return __hip_atomic_fetch_add(p, v, __ATOMIC_RELAXED, __HIP_MEMORY_SCOPE_AGENT); }
DEV unsigned xb_xcc_id() { return (unsigned)__builtin_amdgcn_s_getreg((3 << 11) | 20) & 0xFu; }
#define XB_SPIN(cond, bar) do { unsigned _sp = 0; while (cond) { __builtin_amdgcn_s_sleep(1); \
    if ((++_sp & 255u) == 0u) { if (xb_ld(&(bar)[XB_TMO])) break; if (_sp > XB_SPIN_CAP) { atomicAdd(&(bar)[XB_TMO], 1u); break; } } } } while (0)
struct XcdBarrier { unsigned* bar; unsigned x; volatile LAS unsigned* st; };
DEV XcdBarrier xcd_barrier_post(unsigned* bar, volatile LAS unsigned* st) {
    XcdBarrier b; b.bar = bar; b.x = xb_xcc_id(); b.st = st;
    if (threadIdx.x == 0) (void)xb_add(&bar[XB_XCNT(b.x)], 1u);
    return b;
}
DEV void xcd_barrier_complete(unsigned* bar, unsigned x, unsigned& nloc, unsigned& nx) {
    const unsigned G = gridDim.x * gridDim.y * gridDim.z;
    unsigned sum, cnt, mine, sp = 0u;
    for (;;) {
        sum = 0u; cnt = 0u; mine = 0u;
#pragma unroll
        for (unsigned j = 0; j < 16; ++j) { const unsigned c = xb_ld(&bar[XB_XCNT(j)]); sum += c; cnt += (c > 0u) ? 1u : 0u; mine = (j == x) ? c : mine; }
        if (sum == G) break;
        __builtin_amdgcn_s_sleep(1);
        if ((++sp & 255u) == 0u) { if (xb_ld(&bar[XB_TMO])) break; if (sp > XB_SPIN_CAP) { atomicAdd(&bar[XB_TMO], 1u); break; } }
    }
    nloc = mine > 0u ? mine : 1u; nx = cnt > 0u ? cnt : 1u;
}
DEV void xcd_barrier(const XcdBarrier& b) {
    asm volatile("s_waitcnt vmcnt(0)" ::: "memory");
    __syncthreads();
    if (threadIdx.x == 0) {
        unsigned* bar = b.bar;
        __builtin_amdgcn_s_waitcnt(0);
        unsigned nloc = b.st[0], nx = b.st[1];
        if (nloc == 0u) { xcd_barrier_complete(bar, b.x, nloc, nx); b.st[0] = nloc; b.st[1] = nx; }
        const unsigned old = xb_add(&bar[XB_XSUB(b.x)], 1u);
        const unsigned gen = old / nloc;
        if (old + 1u == (gen + 1u) * nloc) {
            __builtin_amdgcn_fence(__ATOMIC_RELEASE, "agent");
            asm volatile("s_waitcnt vmcnt(0)" ::: "memory");
            const unsigned og = xb_add(&bar[XB_TOP], 1u);
            const unsigned tg = og / nx;
            if (og + 1u == (tg + 1u) * nx) xb_add(&bar[XB_TOPGEN], 1u);
            else XB_SPIN(xb_ld(&bar[XB_TOPGEN]) == tg, bar);
            __builtin_amdgcn_fence(__ATOMIC_ACQUIRE, "agent");
            xb_add(&bar[XB_XGEN(b.x)], 1u);
            asm volatile("s_waitcnt vmcnt(0)" ::: "memory");
        } else {
            XB_SPIN(xb_ld(&bar[XB_XGEN(b.x)]) == gen, bar);
            __builtin_amdgcn_fence(__ATOMIC_ACQUIRE, "agent");
            asm volatile("s_waitcnt vmcnt(0)" ::: "memory");
        }
    }
    __syncthreads();
}

#define STAMP() do { if (TPROBE >= 0) { if (bid == 0 && threadIdx.x == 0) p.ts[nst] = __builtin_amdgcn_s_memrealtime(); ++nst; } } while (0)
#define GSYNC_CG() do { cg::this_grid().sync(); STAMP(); } while (0)
#define GSYNC() do { xcd_barrier(xbar); STAMP(); } while (0)
__global__ void __launch_bounds__(NTHR, 2) fwd_all(P p) {
    extern __shared__ __attribute__((aligned(16))) unsigned char lds_raw[];
    LAS unsigned char* lds = (LAS unsigned char*)lds_raw;
    float* sm = (float*)lds_raw;
    int* off = (int*)(lds_raw + LDS_OFF_TAB);
    const LAS int* offl = (const LAS int*)(lds + LDS_OFF_TAB);
    LAS unsigned* gtab = (LAS unsigned*)(lds + LDS_GTAB);
    const int bid = blockIdx.x, nb = gridDim.x;
    const int tid_ = otid(); const int lane = tid_ & 63, wv = tid_ >> 6;
    LAS float* scr = (LAS float*)(lds + wv * 16384);
    const int gw = bid * NWV + wv, ngw = nb * NWV;
    volatile LAS unsigned* misc = (volatile LAS unsigned*)(lds + LDS_MISC);
    if (threadIdx.x < 2) misc[threadIdx.x] = 0u;
    __syncthreads();
    const XcdBarrier xbar = xcd_barrier_post(p.bar, misc);
    int nst = 0; STAMP();

    ph_mod(p, sm, bid, nb);
    __syncthreads();
    REPEAT(1) ph_prep_small(p, scr, gw, ngw, lane);
#if MF_EXP2
    REPEAT(2) ph_prep_ed(p, scr, gw, ngw, lane);
#endif
    GSYNC();
    REPEAT(3) ph_norm(p.x, p.norm1_g, p.mod, 0, 1024, p.XB, bid, nb);
    GSYNC();
#if MF_INPROJ
    REPEAT(4) { mg::DenseOrder S; S.init(p.XB, p.WT_IN, T, INW, DM, nb, bid);
      mg::gemm_phase<mg::MEpiInProj, mg::DenseOrder, false>(lds, gtab, DM, S, mg::MEpiInProj{p.U, p.QKV, p.G}); }
#else
    ngemm_dense<false>(p.XB, DM, p.w_in, nullptr, INW, T, INW, DM, EpiInProj{p.U, p.QKV, p.G}, sm, bid, nb);
#endif
    GSYNC();
#if !MF_ATTN
    ph_qknorm(p, bid, nb);
#endif
    REPEAT(5) ph_pool(p, bid, nb);
#if !MF_ATTN
    GSYNC();
#endif
#if MF_ATTN
    REPEAT(6) ph_attn_mfma(p, lds, bid, nb);
    GSYNC();
    REPEAT(7) ph_attn_combine(p, bid, nb);
#else
    ph_attn(p, bid, nb);
#endif
#if !MF_MERGE
#pragma unroll 1
    for (int g = 0; g < 4; ++g) ngemm_dense<false>(p.PL + g * 128, 512, p.pool_w_grp + g * 128 * 128, nullptr, 128, T, 128, 128, EpiPoolGrp{p.Y, p.pool_scale, g}, sm, bid, nb);
#endif
    GSYNC();
#if MF_MERGE
    REPEAT(8) { mg::PairOrder S; S.D.init(p.PL, p.WT_EFF, T, DM, 768, nb, bid); S.kt0 = 8; S.kt1 = 4;
      mg::gemm_phase<mg::MEpiMergeF, mg::PairOrder, false>(lds, gtab, 768, S, mg::MEpiMergeF{p.XB, p.G}); }
#else
    ngemm_dense<false>(p.Y, 512, p.w_pool_up, nullptr, DM, T, DM, 512, EpiMergeA{p.XB, p.G}, sm, bid, nb);
    GSYNC();
    ngemm_dense<false>(p.O, 256, p.w_attn_up, nullptr, DM, T, DM, 256, EpiMergeB{p.XB, p.G}, sm, bid, nb);
#endif
    GSYNC();
#if MF_OUT
    REPEAT(9) { mg::DenseOrder S; S.init(p.XB, p.WT_OUT, T, DM, DM, nb, bid);
      mg::gemm_phase<mg::MEpiOutProj, mg::DenseOrder, false>(lds, gtab, DM, S, mg::MEpiOutProj{p.x, p.out, p.mod}); }
#else
    ngemm_dense<false>(p.XB, DM, p.w_out, nullptr, DM, T, DM, DM, EpiOutProj{p.x, p.out, p.mod}, sm, bid, nb);
#endif
    GSYNC();
    REPEAT(10) ph_norm(p.out, p.norm2_g, p.mod, 3072, 4096, p.XB, bid, nb);
#if MF_EXP1
    __syncthreads();
    REPEAT(11) ph_prep_egu(p, scr, gw, ngw, lane);
#endif
    GSYNC();
#if MF_ROUTER
    REPEAT(12) { mg::DenseOrder S; S.init(p.XB, p.WT_RS, T, 768, DM, nb, bid);
      mg::gemm_phase<mg::MEpiRouterShared, mg::DenseOrder, false>(lds, gtab, DM, S, mg::MEpiRouterShared{p.LG, p.HS}); }
#else
    ngemm_dense<false>(p.XB, DM, p.w_router, nullptr, NE, T, NE, DM, EpiLogits{p.LG}, sm, bid, nb);
#endif
    GSYNC();
    ph_route(p, (int*)lds_raw, bid, nb);
    GSYNC();
    ph_scatter(p, off, bid, nb);
    GSYNC();
#if MF_EXP1
    REPEAT(13) { load_offsets(p.cnt, off);
      mg::ExpertOrder S{offl, 2, nb, bid, (const char*)p.XB, (const char*)p.WT_EGU, (size_t)512 * DM * 2, (size_t)256 * DM * 2, 0, true, p.rowlist, MAXU};
      S.build_table((LAS int*)(lds + LDS_OFF_TAB), otid()); __syncthreads();
      fill_gtab(p, S, gtab);
      mg::gemm_phase<mg::MEpiAct, mg::ExpertOrder, true>(lds, gtab, DM, S, mg::MEpiAct{p.ACT}); }
#else
    ph_expert1(p, sm, off, bid, nb);
#endif
    GSYNC();
#if MF_EXP2
    REPEAT(14) { load_offsets(p.cnt, off);
      mg::ExpertOrder S{offl, 4, nb, bid, (const char*)p.ACT, (const char*)p.WT_ED, (size_t)DM * EFF * 2, (size_t)256 * EFF * 2, (size_t)256 * EFF * 2, false, p.rowlist, MAXU};
      S.build_table((LAS int*)(lds + LDS_OFF_TAB), otid()); __syncthreads();
      mg::gemm_phase<mg::MEpiSlab, mg::ExpertOrder, false>(lds, gtab, EFF, S, mg::MEpiSlab{(unsigned char*)p.SLAB, p.rowlist, p.roww}); }
#else
    ph_expert2(p, sm, off, bid, nb);
#endif
    GSYNC();
#if !MF_ROUTER
    ngemm_dense<true>(p.XB, DM, p.w_sg, p.w_su, EFF, T, EFF, DM, EpiAct{p.HS}, sm, bid, nb);
    GSYNC();
#endif
#if MF_FINAL
    { mg::DenseOrder S; S.init(p.HS, p.WT_SD, T, DM, EFF, nb, bid);
      mg::gemm_phase<mg::MEpiFinal, mg::DenseOrder, false>(lds, gtab, EFF, S, mg::MEpiFinal{p.out, (const unsigned char*)p.SLAB, p.mod}); }
#else
    ngemm_dense<false>(p.HS, EFF, p.w_sd, nullptr, DM, T, DM, EFF, EpiFinal{p.out, p.SLAB, p.mod}, sm, bid, nb);
#endif
#if TPROBE >= 0
    GSYNC();
    if (bid == 0 && threadIdx.x == 0) { const unsigned long long dt = p.ts[TPROBE + 1] - p.ts[TPROBE]; p.out[0] += (float)dt * 0.01f / TSCALE; }
#endif
}

extern "C" void kernel_launch(void* const* d_in, const int* in_sizes, int n_in, void* d_out, int out_size, void* d_ws, size_t ws_size, hipStream_t stream) {
    static int grid = 0;
    if (grid == 0) {
        int dev = 0, cus = 0;
        (void)hipGetDevice(&dev);
        (void)hipDeviceGetAttribute(&cus, hipDeviceAttributeMultiprocessorCount, dev);
        int per_cu = 0;
        (void)hipFuncSetAttribute((const void*)fwd_all, hipFuncAttributeMaxDynamicSharedMemorySize, LDS_BYTES);
        (void)hipOccupancyMaxActiveBlocksPerMultiprocessor(&per_cu, fwd_all, NTHR, LDS_BYTES);
        if (per_cu < 1) { fprintf(stderr, "kernel_launch: occupancy query says %d blocks/CU\n", per_cu); per_cu = 1; }
        if (per_cu > 1) per_cu = 1;
        grid = cus * per_cu;
        if (ws_size < WS_END) { fprintf(stderr, "kernel_launch: workspace too small (%zu < %zu)\n", ws_size, (size_t)WS_END); grid = -1; }
    }
    if (grid < 0) return;
    P p{};
    const float* const* in = (const float* const*)d_in;
    p.x = in[0]; p.c = in[1]; p.pos = (const int*)d_in[2];
    p.w_ada = in[3]; p.b_ada = in[4]; p.norm1_g = in[5]; p.w_in = in[6]; p.pool_w_grp = in[7]; p.pool_scale = in[8]; p.q_norm_g = in[9]; p.k_norm_g = in[10];
    p.w_pool_up = in[11]; p.w_attn_up = in[12]; p.w_out = in[13]; p.norm2_g = in[14]; p.w_router = in[15]; p.router_bias = in[16];
    p.w_sg = in[17]; p.w_su = in[18]; p.w_sd = in[19]; p.w_eg = in[20]; p.w_eu = in[21]; p.w_ed = in[22];
    p.out = (float*)d_out;
    char* ws = (char*)d_ws;
    p.mod = (float*)(ws + WS_MOD); p.cnt = (int*)(ws + WS_CNT); p.asg_e = (int*)(ws + WS_ASG_E); p.asg_pos = (int*)(ws + WS_ASG_POS);
    p.asg_w = (float*)(ws + WS_ASG_W); p.rowlist = (int*)(ws + WS_ROWLIST);
    p.XB = (bf16_t*)(ws + WS_XB); p.U = (bf16_t*)(ws + WS_U); p.QKV = (bf16_t*)(ws + WS_QKV); p.G = (bf16_t*)(ws + WS_G); p.PL = (bf16_t*)(ws + WS_PL);
    p.Y = (bf16_t*)(ws + WS_Y); p.O = (bf16_t*)(ws + WS_O); p.ACT = (bf16_t*)(ws + WS_ACT); p.SLAB = (bf16_t*)(ws + WS_SLAB); p.HS = (bf16_t*)(ws + WS_HS);
    p.LG = (float*)(ws + WS_ACT);
    p.roww = (float*)(ws + WS_ROWW);
    p.bar = (unsigned*)(ws + WS_BAR); p.ts = (unsigned long long*)(ws + WS_TS);
    p.OG = (bf16_t*)(ws + WS_OG); p.LSUM = (float*)(ws + WS_LSUM);
    p.WT_IN = (bf16_t*)(ws + WS_WT_IN); p.WT_EFF = (bf16_t*)(ws + WS_WT_EFF); p.WT_AU = (bf16_t*)(ws + WS_WT_AU); p.WT_OUT = (bf16_t*)(ws + WS_WT_OUT);
    p.WT_RS = (bf16_t*)(ws + WS_WT_RS); p.WT_SD = (bf16_t*)(ws + WS_WT_SD); p.WT_EGU = (bf16_t*)(ws + WS_WT_EGU); p.WT_ED = (bf16_t*)(ws + WS_WT_ED);
    (void)hipMemsetAsync(ws + WS_BAR, 0, WS_ZERO_BYTES, stream);
    void* args[] = {&p};
    hipError_t e = hipLaunchCooperativeKernel((void*)fwd_all, dim3(grid), dim3(NTHR), args, LDS_BYTES, stream);
    if (e != hipSuccess) fprintf(stderr, "cooperative launch failed: %s (grid %d)\n", hipGetErrorString(e), grid);
}
```

```cpp
#include <hip/hip_runtime.h>
#include <hip/hip_cooperative_groups.h>
#include <stdint.h>
#include <cstdio>
namespace cg = cooperative_groups;

#ifndef ONE_LAUNCH
#define ONE_LAUNCH 0
#endif

typedef unsigned short bf16_t;
#define DEV __device__ __forceinline__
#define LAS __attribute__((address_space(3)))
typedef short bf16x8 __attribute__((ext_vector_type(8)));
typedef float f32x4 __attribute__((ext_vector_type(4)));
typedef unsigned u32x4 __attribute__((ext_vector_type(4)));
typedef unsigned u32x2 __attribute__((ext_vector_type(2)));

#ifndef MF_INPROJ
#define MF_INPROJ 1
#endif
#ifndef MF_MERGE
#define MF_MERGE 1
#endif
#ifndef MF_OUT
#define MF_OUT 1
#endif
#ifndef MF_ROUTER
#define MF_ROUTER 1
#endif
#ifndef MF_EXP1
#define MF_EXP1 1
#endif
#ifndef MF_EXP2
#define MF_EXP2 1
#endif
#ifndef MF_ATTN
#define MF_ATTN 1
#endif
#ifndef DUP
#define DUP 0
#endif
#ifndef TPROBE
#define TPROBE -1
#endif
#ifndef TSCALE
#define TSCALE 10.0f
#endif
#define REPEAT(n) _Pragma("unroll 1") for (int rep_ = 0; rep_ < ((DUP == (n)) ? 2 : 1); ++rep_)
#ifndef MF_FINAL
#define MF_FINAL 1
#endif

constexpr int NB = 16, SEQ = 2048, DM = 1024, T = NB * SEQ;
constexpr int INW = 4864, NMOD = 6144;
constexpr int NE = 256, EFF = 256;
constexpr int NTHR = 512, NWV = 8;
constexpr int NSLOT = T * 8;
constexpr int RMAX = NSLOT + NE * 256;

DEV float bf2f(bf16_t h) { return __uint_as_float(((unsigned)h) << 16); }
DEV bf16_t f2bf(float f) { unsigned u = __float_as_uint(f); u += 0x7fffu + ((u >> 16) & 1u); return (bf16_t)(u >> 16); }
DEV unsigned pk2(float lo, float hi) { return (unsigned)f2bf(lo) | ((unsigned)f2bf(hi) << 16); }
DEV float sigm(float v) { return 1.f / (1.f + __expf(-v)); }
DEV float silu(float v) { return v / (1.f + __expf(-v)); }
DEV int otid() { int t = threadIdx.x; asm volatile("" : "+v"(t)); return t; }
DEV float wave_sum(float v) {
#pragma unroll
    for (int o = 32; o >= 1; o >>= 1) v += __shfl_xor(v, o);
    return v;
}

struct P {
    const float *x, *c; const int* pos;
    const float *w_ada, *b_ada, *norm1_g, *w_in, *pool_w_grp, *pool_scale, *q_norm_g, *k_norm_g, *w_pool_up, *w_attn_up, *w_out, *norm2_g,
        *w_router, *router_bias, *w_sg, *w_su, *w_sd, *w_eg, *w_eu, *w_ed;
    float* out;
    float* mod; int* cnt; int* asg_e; int* asg_pos; float* asg_w; int* rowlist;
    bf16_t *XB, *U, *QKV, *G, *PL, *Y, *O, *ACT, *SLAB, *HS;
    float* LG;
    bf16_t* OG; float* LSUM; unsigned* bar; unsigned long long* ts; float* roww;
    bf16_t *WT_IN, *WT_EFF, *WT_AU, *WT_OUT, *WT_RS, *WT_SD, *WT_EGU, *WT_ED;
};

constexpr size_t MiB = 1u << 20;
constexpr size_t WS_BAR = 640 * 1024, WS_BAR_BYTES = 16384, WS_ZERO_BYTES = 16384 + 65536;
constexpr size_t WS_TS = 800 * 1024;
constexpr size_t WS_MOD = 0, WS_CNT = WS_BAR + WS_BAR_BYTES, WS_ASG_E = 1 * MiB, WS_ASG_POS = 2 * MiB, WS_ASG_W = 3 * MiB, WS_ROWLIST = 4 * MiB, WS_ROWW = 6 * MiB;
constexpr size_t WS_XB = 8 * MiB;
constexpr size_t WS_ACT = 72 * MiB;
constexpr size_t WS_SLAB = 232 * MiB;
constexpr size_t WS_U = 232 * MiB, WS_QKV = 264 * MiB, WS_G = 408 * MiB, WS_PL = 536 * MiB, WS_Y = 568 * MiB, WS_O = 600 * MiB;
constexpr size_t WS_WT_IN = 744 * MiB, WS_WT_EFF = 754 * MiB, WS_WT_AU = 755 * MiB, WS_WT_OUT = 756 * MiB, WS_WT_RS = 758 * MiB, WS_WT_SD = 760 * MiB;
constexpr size_t WS_WT_ED = 762 * MiB;
constexpr size_t WS_WT_EGU = 232 * MiB;
constexpr size_t WS_OG = 616 * MiB, WS_LSUM = 664 * MiB;
constexpr size_t WS_HS = 890 * MiB;
constexpr size_t WS_END = 906 * MiB;

DEV void ph_mod(const P& p, float* sm, int bid, int nb) {
    const int tid_ = otid(); const int lane = tid_ & 63, wv = tid_ >> 6;
    for (int it = bid; it < 96; it += nb) {
        const int k0 = wv * 128, e = it * 64 + lane;
        float acc[16];
#pragma unroll
        for (int b = 0; b < 16; ++b) acc[b] = 0.f;
#pragma unroll 1
        for (int kh = 0; kh < 2; ++kh) {
            float sc[16];
#pragma unroll
            for (int b = 0; b < 16; ++b) sc[b] = silu(p.c[b * DM + k0 + kh * 64 + lane]);
            const float* wp = p.w_ada + (size_t)(k0 + kh * 64) * NMOD + e;
#pragma unroll 8
            for (int kk = 0; kk < 64; ++kk) { const float w = wp[(size_t)kk * NMOD];
#pragma unroll
                for (int b = 0; b < 16; ++b) acc[b] += __uint_as_float(__builtin_amdgcn_readlane(__float_as_uint(sc[b]), kk)) * w; }
        }
        __syncthreads();
#pragma unroll
        for (int b = 0; b < 16; ++b) sm[(wv * 16 + b) * 64 + lane] = acc[b];
        __syncthreads();
#pragma unroll
        for (int j = 0; j < 2; ++j) { const int idx = tid_ + j * NTHR, b = idx >> 6, col = idx & 63; float s = p.b_ada[it * 64 + col];
#pragma unroll
            for (int w = 0; w < 8; ++w) s += sm[(w * 16 + b) * 64 + col];
            p.mod[b * NMOD + it * 64 + col] = s; }
    }
}

DEV void ph_norm(const float* src, const float* g, const float* mod, int shift_off, int scale_off, bf16_t* dst, int bid, int nb) {
    const int tid_ = otid(); const int lane = tid_ & 63, wv = tid_ >> 6;
    for (int row0 = (bid * NWV + wv) * 2; row0 < T; row0 += nb * NWV * 2) {
        float4 v[2][4]; float ss[2] = {0.f, 0.f};
#pragma unroll
        for (int q = 0; q < 2; ++q) { const float4* xr = (const float4*)(src + (size_t)(row0 + q) * DM);
#pragma unroll
            for (int j = 0; j < 4; ++j) v[q][j] = xr[lane + 64 * j]; }
#pragma unroll
        for (int q = 0; q < 2; ++q)
#pragma unroll
            for (int j = 0; j < 4; ++j) ss[q] += v[q][j].x * v[q][j].x + v[q][j].y * v[q][j].y + v[q][j].z * v[q][j].z + v[q][j].w * v[q][j].w;
        const int b = row0 / SEQ;
#pragma unroll
        for (int q = 0; q < 2; ++q) {
            const float r = rsqrtf(wave_sum(ss[q]) * (1.f / DM) + 1e-6f);
#pragma unroll
            for (int j = 0; j < 4; ++j) {
                const int col = (lane + 64 * j) * 4;
                const float4 g4 = *(const float4*)(g + col);
                const float4 sc = *(const float4*)(mod + b * NMOD + scale_off + col);
                const float4 sh = *(const float4*)(mod + b * NMOD + shift_off + col);
                const float o0 = v[q][j].x * r * g4.x * (1.f + sc.x) + sh.x, o1 = v[q][j].y * r * g4.y * (1.f + sc.y) + sh.y;
                const float o2 = v[q][j].z * r * g4.z * (1.f + sc.z) + sh.z, o3 = v[q][j].w * r * g4.w * (1.f + sc.w) + sh.w;
                uint2 w; w.x = pk2(o0, o1); w.y = pk2(o2, o3);
                *(uint2*)(dst + (size_t)(row0 + q) * DM + col) = w;
            }
        }
    }
}

template <bool DUAL, class RowF, class Epi>
DEV void ngemm_tile(const bf16_t* __restrict__ A, int lda, RowF rowf, const float* __restrict__ B, const float* __restrict__ B2, int ldb,
                    int m0, int n0, int K, Epi epi, float* sm) {
    float* As = sm;
    float* Bs = sm + 16 * 132;
    float* Bs2 = Bs + 16 * 64;
    const int tid = otid(), tm = tid >> 4, tn = tid & 15;
    float acc[4][4], acc2[4][4];
#pragma unroll
    for (int i = 0; i < 4; ++i)
#pragma unroll
        for (int j = 0; j < 4; ++j) { acc[i][j] = 0.f; acc2[i][j] = 0.f; }
    const int ar = tid >> 2, ak = (tid & 3) * 4;
    const int arow = rowf(m0 + ar);
    const bf16_t* ap = A + (size_t)(arow < 0 ? 0 : arow) * lda + ak;
    const int bk = tid >> 5, bn = (tid & 31) * 2;
    for (int k0 = 0; k0 < K; k0 += 16) {
        uint2 av = make_uint2(0u, 0u);
        if (arow >= 0) av = *(const uint2*)(ap + k0);
        const float2 bv = *(const float2*)(B + (size_t)(k0 + bk) * ldb + n0 + bn);
        float2 bv2 = make_float2(0.f, 0.f);
        if (DUAL) bv2 = *(const float2*)(B2 + (size_t)(k0 + bk) * ldb + n0 + bn);
        __syncthreads();
        As[(ak + 0) * 132 + ar] = __uint_as_float(av.x << 16);
        As[(ak + 1) * 132 + ar] = __uint_as_float(av.x & 0xffff0000u);
        As[(ak + 2) * 132 + ar] = __uint_as_float(av.y << 16);
        As[(ak + 3) * 132 + ar] = __uint_as_float(av.y & 0xffff0000u);
        Bs[bk * 64 + bn] = bv.x; Bs[bk * 64 + bn + 1] = bv.y;
        if (DUAL) { Bs2[bk * 64 + bn] = bv2.x; Bs2[bk * 64 + bn + 1] = bv2.y; }
        __syncthreads();
#pragma unroll
        for (int kk = 0; kk < 16; ++kk) {
            const float4 a = *(const float4*)&As[kk * 132 + tm * 4];
            const float4 b = *(const float4*)&Bs[kk * 64 + tn * 4];
            const float aa[4] = {a.x, a.y, a.z, a.w}, bb[4] = {b.x, b.y, b.z, b.w};
#pragma unroll
            for (int i = 0; i < 4; ++i)
#pragma unroll
                for (int j = 0; j < 4; ++j) acc[i][j] += aa[i] * bb[j];
            if (DUAL) {
                const float4 b2 = *(const float4*)&Bs2[kk * 64 + tn * 4];
                const float cc[4] = {b2.x, b2.y, b2.z, b2.w};
#pragma unroll
                for (int i = 0; i < 4; ++i)
#pragma unroll
                    for (int j = 0; j < 4; ++j) acc2[i][j] += aa[i] * cc[j];
            }
        }
    }
#pragma unroll
    for (int i = 0; i < 4; ++i)
#pragma unroll
        for (int j = 0; j < 4; ++j) epi(m0 + tm * 4 + i, n0 + tn * 4 + j, acc[i][j], acc2[i][j]);
}

struct RowId { DEV int operator()(int m) const { return m; } };
struct RowTok { const int* rl; DEV int operator()(int m) const { const int s = rl[m]; return s < 0 ? -1 : (s >> 3); } };

template <bool DUAL, class Epi>
DEV void ngemm_dense(const bf16_t* A, int lda, const float* B, const float* B2, int ldb, int M, int N, int K, Epi epi, float* sm, int bid, int nb) {
    const int tn = N / 64, nt = (M / 128) * tn;
    for (int t = bid; t < nt; t += nb) ngemm_tile<DUAL>(A, lda, RowId(), B, B2, ldb, (t / tn) * 128, (t % tn) * 64, K, epi, sm);
}

struct EpiInProj { bf16_t *U, *QKV, *G;
    DEV void operator()(int r, int c, float v, float) const {
        if (c < 512) U[(size_t)r * 512 + c] = f2bf(v);
        else if (c < 2816) QKV[(size_t)r * 2304 + (c - 512)] = f2bf(v);
        else G[(size_t)r * 2048 + (c - 2816)] = f2bf(sigm(v)); } };
struct EpiPoolGrp { bf16_t* Y; const float* ls; int g;
    DEV void operator()(int r, int c, float v, float) const { Y[(size_t)r * 512 + g * 128 + c] = f2bf(v * ls[g * 128 + c]); } };
struct EpiMergeA { bf16_t* MG; const bf16_t* G;
    DEV void operator()(int r, int c, float v, float) const { MG[(size_t)r * DM + c] = f2bf(bf2f(G[(size_t)r * 2048 + c]) * v); } };
struct EpiMergeB { bf16_t* MG; const bf16_t* G;
    DEV void operator()(int r, int c, float v, float) const { const size_t i = (size_t)r * DM + c; MG[i] = f2bf(bf2f(MG[i]) + bf2f(G[(size_t)r * 2048 + 1024 + c]) * v); } };
struct EpiOutProj { const float* x; float* out; const float* mod;
    DEV void operator()(int r, int c, float v, float) const { const size_t i = (size_t)r * DM + c; out[i] = x[i] + mod[(r / SEQ) * NMOD + 2048 + c] * v; } };
struct EpiLogits { float* LG;
    DEV void operator()(int r, int c, float v, float) const { LG[(size_t)r * NE + c] = v; } };
struct EpiAct { bf16_t* ACT;
    DEV void operator()(int r, int c, float v, float v2) const { ACT[(size_t)r * EFF + c] = f2bf(silu(v) * v2); } };
struct EpiSlab { bf16_t* SLAB; const int* rl; const float* w;
    DEV void operator()(int r, int c, float v, float) const { const int s = rl[r]; if (s >= 0) SLAB[(size_t)s * DM + c] = f2bf(v * w[s]); } };
struct EpiFinal { float* out; const bf16_t* SLAB; const float* mod;
    DEV void operator()(int r, int c, float v, float) const {
        float s = v;
#pragma unroll
        for (int k = 0; k < 8; ++k) s += bf2f(SLAB[((size_t)r * 8 + k) * DM + c]);
        const size_t i = (size_t)r * DM + c; out[i] = out[i] + mod[(r / SEQ) * NMOD + 5120 + c] * s; } };

DEV void ph_qknorm(const P& p, int bid, int nb) {
    const int tid_ = otid(); const int lane = tid_ & 63, wv = tid_ >> 6;
    const float gq = p.q_norm_g[lane], gk = p.k_norm_g[lane];
    const float invf = exp2f(-(float)(lane & 7) * (1.f / 8.f) * log2f(500000.f));
    for (int t = bid * NWV + wv; t < T; t += nb * NWV) {
        const float ang = (float)p.pos[t] * invf;
        const float cs = cosf(ang), sn = sinf(ang);
        bf16_t* ptr = p.QKV + (size_t)t * 2304 + lane;
        float v[24];
#pragma unroll
        for (int hh = 0; hh < 24; ++hh) v[hh] = bf2f(ptr[hh * 64]);
#pragma unroll
        for (int hh = 0; hh < 24; ++hh) {
            const float ss = wave_sum(v[hh] * v[hh]);
            float nv = v[hh] * rsqrtf(ss * (1.f / 64.f) + 1e-6f) * (hh < 12 ? gq : gk);
            const float partner = __shfl_xor(nv, 8);
            if (lane < 8) nv = nv * cs - partner * sn;
            else if (lane < 16) nv = nv * cs + partner * sn;
            ptr[hh * 64] = f2bf(nv);
        }
    }
}

template <int R>
DEV void pool_chunk(const unsigned* up, unsigned* op, int s0) {
    constexpr int W = 32 + 2 * R;
    float w0[W], w1[W];
#pragma unroll
    for (int i = 0; i < W; ++i) { const int q = s0 - R + i; const bool ok = (q >= 0) && (q < SEQ); const unsigned w = up[(size_t)min(max(q, 0), SEQ - 1) * 256];
        w0[i] = ok ? __uint_as_float(w << 16) : 0.f; w1[i] = ok ? __uint_as_float(w & 0xffff0000u) : 0.f; }
    float a0 = 0.f, a1 = 0.f;
#pragma unroll
    for (int i = 0; i < 2 * R + 1; ++i) { a0 += w0[i]; a1 += w1[i]; }
#pragma unroll
    for (int j = 0; j < 32; ++j) {
        const int s = s0 + j;
        const int lo = max(s - R, 0), hi = min(s + R, SEQ - 1);
        const float inv = 1.f / (float)(hi - lo + 1);
        op[(size_t)s * 384] = pk2(a0 * inv - w0[j + R], a1 * inv - w1[j + R]);
        if (j < 31) { a0 += w0[j + 2 * R + 1] - w0[j]; a1 += w1[j + 2 * R + 1] - w1[j]; }
    }
}
DEV void ph_pool(const P& p, int bid, int nb) {
    const int tid_ = otid();
    for (int i = bid * NTHR + tid_; i < NB * 64 * 256; i += nb * NTHR) {
        const int cp = i & 255, chunk = (i >> 8) & 63, b = i >> 14;
        const int g = cp >> 6;
        const unsigned* up = (const unsigned*)(p.U + (size_t)b * SEQ * 512) + cp;
        unsigned* op = (unsigned*)(p.PL + (size_t)b * SEQ * 768) + cp;
        const int s0 = chunk * 32;
        if (g == 0) pool_chunk<1>(up, op, s0); else if (g == 1) pool_chunk<2>(up, op, s0); else if (g == 2) pool_chunk<4>(up, op, s0); else pool_chunk<8>(up, op, s0);
    }
}

DEV void ph_attn(const P& p, int bid, int nb) {
    const int tid_ = otid(); const int lane = tid_ & 63, wv = tid_ >> 6;
    for (int it = bid * NWV + wv; it < T * 4; it += nb * NWV) {
        const int t = it >> 2, slot = it & 3;
        const int s = t & (SEQ - 1), base = t - s;
        float M = -1e30f, l = 0.f, acc = 0.f;
#pragma unroll
        for (int g = 0; g < 3; ++g) {
            const int dsh = 2 * g, d = 1 << dsh, L = SEQ >> dsh;
            const int h = 4 * g + slot;
            const int m = s >> dsh, r = s & (d - 1);
            const float q = bf2f(p.QKV[(size_t)t * 2304 + h * 64 + lane]);
            const bf16_t* kb = p.QKV + 768 + h * 64 + lane;
            const bf16_t* vb = p.QKV + 1536 + h * 64 + lane;
#pragma unroll 4
            for (int rel = -64; rel <= 64; ++rel) {
                const int mm = m + rel;
                const bool valid = (mm >= 0) && (mm < L);
                const int mc = valid ? mm : m;
                const size_t tr = (size_t)(base + mc * d + r) * 2304;
                const float kv = bf2f(kb[tr]), vv = bf2f(vb[tr]);
                const float sc = wave_sum(q * kv) * 0.125f;
                if (valid) {
                    const float mn = fmaxf(M, sc);
                    const float f = __expf(M - mn), pe = __expf(sc - mn);
                    l = l * f + pe; acc = acc * f + pe * vv; M = mn;
                }
            }
        }
        p.O[(size_t)t * 256 + slot * 64 + lane] = f2bf(acc / l);
    }
}

DEV void ph_route(const P& p, int* hist, int bid, int nb) {
    const int tid_ = otid(); const int lane = tid_ & 63, wv = tid_ >> 6;
    const int G = lane & 7, tl = lane >> 3;
    float bias[32];
#pragma unroll
    for (int j = 0; j < 8; ++j) { const float4 b4 = *(const float4*)(p.router_bias + G * 32 + 4 * j); bias[4 * j] = b4.x; bias[4 * j + 1] = b4.y; bias[4 * j + 2] = b4.z; bias[4 * j + 3] = b4.w; }
    for (int t0 = (bid * NWV + wv) * 8; t0 < T; t0 += nb * NWV * 8) {
        const int t = t0 + tl;
        float sc[32], v[32];
#pragma unroll
        for (int j = 0; j < 8; ++j) { const float4 lg = *(const float4*)(p.LG + (size_t)t * NE + G * 32 + 4 * j);
            sc[4 * j] = 1.f / (1.f + expf(-lg.x)); sc[4 * j + 1] = 1.f / (1.f + expf(-lg.y)); sc[4 * j + 2] = 1.f / (1.f + expf(-lg.z)); sc[4 * j + 3] = 1.f / (1.f + expf(-lg.w)); }
        float m1 = -INFINITY, m2 = -INFINITY;
#pragma unroll
        for (int j = 0; j < 32; ++j) { v[j] = sc[j] + bias[j]; const float n1 = fmaxf(m1, v[j]), n2 = fmaxf(fminf(m1, v[j]), m2); m1 = n1; m2 = n2; }
        const float gs = m1 + m2;
        int rank = 0;
#pragma unroll
        for (int g2 = 0; g2 < 8; ++g2) { const float o = __shfl(gs, (lane & 56) + g2); rank += ((o > gs) || (o == gs && g2 < G)) ? 1 : 0; }
        const bool gsel = rank < 4;
        int myidx = 0; float myw = 0.f, wsum = 0.f;
#pragma unroll 1
        for (int k = 0; k < 8; ++k) {
            float bv = -INFINITY, bs = 0.f; int bi = 0;
#pragma unroll
            for (int j = 0; j < 32; ++j) { const bool tk = gsel && (v[j] > bv); bv = tk ? v[j] : bv; bs = tk ? sc[j] : bs; bi = tk ? j : bi; }
            int gi = G * 32 + bi;
#pragma unroll
            for (int o = 1; o < 8; o <<= 1) {
                const float ov = __shfl_xor(bv, o), os = __shfl_xor(bs, o); const int oi = __shfl_xor(gi, o);
                if ((ov > bv) || (ov == bv && oi < gi)) { bv = ov; gi = oi; bs = os; }
            }
            const int wj = (gi >> 5) == G ? (gi & 31) : -1;
#pragma unroll
            for (int j = 0; j < 32; ++j) v[j] = (j == wj) ? -INFINITY : v[j];
            if (G == k) { myidx = gi; myw = bs; }
            wsum += bs;
        }
        __syncthreads();
        if (tid_ < NE) hist[tid_] = 0;
        __syncthreads();
        const int lpos = atomicAdd(&hist[myidx], 1);
        __syncthreads();
        if (tid_ < NE) { const int c_ = hist[tid_]; hist[NE + tid_] = c_ ? atomicAdd(&p.cnt[tid_ * 64], c_) : 0; }
        __syncthreads();
        const int slot = t * 8 + G;
        p.asg_e[slot] = myidx; p.asg_pos[slot] = hist[NE + myidx] + lpos; p.asg_w[slot] = myw / wsum * 2.5f;
    }
}

DEV void load_offsets(const int* cnt, int* off) {
    const int tid = otid();
    __syncthreads();
    if (tid < NE) { const int c_ = cnt[tid * 64]; off[300 + tid] = (c_ + 255) & ~255; off[600 + tid] = c_; }
    __syncthreads();
    if (tid == 0) { int a = 0; for (int e = 0; e < NE; ++e) { off[e] = a; a += off[300 + e]; } off[NE] = a;
        const int x = blockIdx.x & 7; int tf = 0, th = 0;
        for (int j = 0; j < 32; ++j) { const int n_ = off[600 + x + 8 * j], nt_ = (n_ + 255) >> 8, hh = (nt_ > 0 && n_ - (nt_ - 1) * 256 <= 128) ? 1 : 0;
            off[860 + j] = tf; off[900 + j] = th; tf += nt_ - hh; th += hh; }
        off[860 + 32] = tf; off[900 + 32] = th; }
    __syncthreads();
}
DEV int find_expert(const int* off, int m0) {
    int lo = 0, hi = NE;
    while (hi - lo > 1) { const int mid = (lo + hi) >> 1; if (off[mid] <= m0) lo = mid; else hi = mid; }
    return lo;
}

DEV void ph_scatter(const P& p, int* off, int bid, int nb) {
    load_offsets(p.cnt, off);
    const int tid_ = otid();
    for (int slot = bid * NTHR + tid_; slot < NSLOT; slot += nb * NTHR) { const int r = off[p.asg_e[slot]] + p.asg_pos[slot]; p.rowlist[r] = slot; p.roww[r] = p.asg_w[slot]; }
    for (int e = bid; e < NE; e += nb) {
        const int n = p.cnt[e * 64], pd = (n + 255) & ~255;
        for (int i = n + tid_; i < pd; i += NTHR) { p.rowlist[off[e] + i] = -1; p.roww[off[e] + i] = 0.f; }
    }
}

DEV void ph_expert1(const P& p, float* sm, int* off, int bid, int nb) {
    load_offsets(p.cnt, off);
    const int nrt = off[NE] / 128, nt = nrt * 4;
    for (int t = bid; t < nt; t += nb) {
        const int m0 = (t >> 2) * 128, n0 = (t & 3) * 64, e = find_expert(off, m0);
        ngemm_tile<true>(p.XB, DM, RowTok{p.rowlist}, p.w_eg + (size_t)e * DM * EFF, p.w_eu + (size_t)e * DM * EFF, EFF, m0, n0, DM, EpiAct{p.ACT}, sm);
    }
}
DEV void ph_expert2(const P& p, float* sm, int* off, int bid, int nb) {
    load_offsets(p.cnt, off);
    const int nrt = off[NE] / 128, nt = nrt * 16;
    for (int t = bid; t < nt; t += nb) {
        const int m0 = (t >> 4) * 128, n0 = (t & 15) * 64, e = find_expert(off, m0);
        ngemm_tile<false>(p.ACT, EFF, RowId(), p.w_ed + (size_t)e * EFF * DM, nullptr, DM, m0, n0, EFF, EpiSlab{p.SLAB, p.rowlist, p.asg_w}, sm);
    }
}

namespace mg {
constexpr int BM = 256, BK = 64, HALF = 128, HTB = HALF * BK * 2, STAGE_BYTES = 8 * HTB, NXCD = 8, WGM = 8;
__host__ __device__ __forceinline__ int lds_byte(int r, int c) { const int st = (r >> 4) * 2 + (c >> 5), rr = r & 15, cc = c & 31, ob = rr * 64 + cc * 2; return st * 1024 + (ob ^ (((ob >> 9) & 1) << 5)); }
__host__ __device__ __forceinline__ void stage_rc(int b, int& R, int& C) { const int st = b / 1024, sb = b % 1024, swz = sb ^ (((sb >> 9) & 1) << 5); R = (st >> 1) * 16 + swz / 64; C = (st & 1) * 32 + (swz % 64) / 2; }
__host__ __device__ __forceinline__ int perm32(int rho) { const int n = rho >> 4, i = rho & 15; return 8 * (i >> 2) + 4 * n + (i & 3); }

struct Unit { int pm, pn, e, pad, half, pad2; const char* A; const char* B; };

struct DenseOrder { static constexpr bool HAS_HALF = false;
    int nM, nN, nwg, G, c; const char* A; const char* B; size_t tstep;
    DEV void init(const bf16_t* A_, const bf16_t* B_, int M, int N, int K, int G_, int c_) { nM = M / BM; nN = N / BM; nwg = nM * nN; G = G_; c = c_; A = (const char*)A_; B = (const char*)B_; tstep = (size_t)BM * K * 2; }
    DEV bool next(int i, Unit& u) const {
        const long L = (long)i * G + c; if (L >= nwg) return false;
        int wgid = (int)L; { const int q = nwg / NXCD, r = nwg % NXCD, xcd = wgid % NXCD, off = wgid / NXCD; wgid = (xcd < r ? xcd * (q + 1) : r * (q + 1) + (xcd - r) * q) + off; }
        const int nig = WGM * nN, gid = wgid / nig, fm = gid * WGM, gsz = (nM - fm) < WGM ? (nM - fm) : WGM;
        u.pm = fm + ((wgid % nig) % gsz); u.pn = (wgid % nig) / gsz; u.e = 0; u.pad = 0; u.half = 0; u.pad2 = 0;
        u.A = A + (size_t)u.pm * tstep; u.B = B + (size_t)u.pn * tstep; return true;
    }
};
struct PairOrder { static constexpr bool HAS_HALF = false; DenseOrder D; int kt0, kt1;
    DEV bool next(int i, Unit& u) const { if (!D.next(i >> 1, u)) return false; const int part = i & 1; u.e = part; u.pad = part ? kt1 : kt0;
        if (part) { u.A += (size_t)kt0 * 128; u.B += (size_t)kt0 * 128; } return true; }
};
struct ExpertOrder { static constexpr bool HAS_HALF = true;
    const LAS int* off; int ncol, G, c; const char* A; const char* W; size_t wstride, tstepB, tstepA; bool gather; const int* rl; int maxu;
    DEV bool tile_of(int i, int& pm, int& pn, int& e) const {
        const int x = c & 7, cl = c >> 3, nbx = G >> 3;
        const int Lx = i * nbx + cl; int tx = Lx / ncol; pn = Lx % ncol;
        const int ftot = off[860 + 32], htot = off[900 + 32];
        if (tx >= ftot + htot) return false;
        const bool isf = tx < ftot; const int tb = isf ? 860 : 900; if (!isf) tx -= ftot;
        int lo = 0, hi = 32;
        while (hi - lo > 1) { const int mid = (lo + hi) >> 1; if (off[tb + mid] <= tx) lo = mid; else hi = mid; }
        e = x + 8 * lo;
        const int nfull = off[860 + lo + 1] - off[860 + lo];
        pm = (off[e] >> 8) + (isf ? (tx - off[860 + lo]) : nfull);
        return true;
    }
    static constexpr int UT0 = 1024, UTN = 64;
    DEV void build_table(LAS int* offw, int tid) const {
        if (tid < UTN) { int pm = 0, pn = 0, e = 0; const bool ok = tile_of(tid, pm, pn, e);
            const int hf = ok ? ((off[600 + e] - (pm * BM - off[e]) <= HALF) ? 1 : 0) : 0;
            offw[UT0 + 4 * tid] = pm; offw[UT0 + 4 * tid + 1] = pn; offw[UT0 + 4 * tid + 2] = e | (hf << 16); offw[UT0 + 4 * tid + 3] = ok ? 1 : 0; }
    }
    DEV bool next(int i, Unit& u) const {
        int pm, pn, e, hf;
        if (i < UTN) { if (__builtin_amdgcn_readfirstlane(off[UT0 + 4 * i + 3]) == 0) return false;
            pm = __builtin_amdgcn_readfirstlane(off[UT0 + 4 * i]); pn = __builtin_amdgcn_readfirstlane(off[UT0 + 4 * i + 1]);
            const int eh = __builtin_amdgcn_readfirstlane(off[UT0 + 4 * i + 2]); e = eh & 0xffff; hf = eh >> 16; }
        else { if (!tile_of(i, pm, pn, e)) return false; pm = __builtin_amdgcn_readfirstlane(pm); pn = __builtin_amdgcn_readfirstlane(pn); e = __builtin_amdgcn_readfirstlane(e);
            hf = (__builtin_amdgcn_readfirstlane(off[600 + e]) - (pm * BM - __builtin_amdgcn_readfirstlane(off[e])) <= HALF) ? 1 : 0; }
        u.pm = pm; u.pn = pn; u.e = e; u.pad = 0; u.pad2 = 0; u.half = hf;
        u.A = gather ? A : A + (size_t)pm * tstepA; u.B = W + (size_t)e * wstride + (size_t)pn * tstepB; return true;
    }
};

template <class Epi, class Sched, bool GATHER>
DEV void gemm_phase(LAS unsigned char* lds, const LAS unsigned* gtab, const int K, const Sched& S, const Epi& E) {
    const int tid = otid(), wid = __builtin_amdgcn_readfirstlane(tid >> 6), lane = tid & 63, wr = wid >> 2, wc = wid & 3, fr = lane & 15, fq = lane >> 4;
    const int nt = K / BK;
    int Rr[2], Cc[2]; unsigned voffB[2];
#pragma unroll
    for (int i = 0; i < 2; ++i) { stage_rc(tid * 16 + i * 8192, Rr[i], Cc[i]); const int Rb = Epi::PERM ? ((Rr[i] & ~31) + perm32(Rr[i] & 31)) : Rr[i]; voffB[i] = (unsigned)(Rb * K + Cc[i]) * 2u; }
    const size_t kstep = (size_t)(BK * 2);
    const size_t hstep = (size_t)HALF * K * 2;
    const unsigned ldsw = (unsigned)wid * 1024u;
    const int aoff = lds_byte(wr * 64 + fr, fq * 8), boff = lds_byte(wc * 32 + fr, fq * 8);
#define MG_SA(b, h) (((b) * 2 + (h)) * HTB)
#define MG_SB(b, h) ((4 + (b) * 2 + (h)) * HTB)
#define MG_STAGE(bufoff, gbase, voff) do { _Pragma("unroll") for (int _i = 0; _i < 2; ++_i) \
        __builtin_amdgcn_global_load_lds((const unsigned*)((const char*)(gbase) + (voff)[_i]), (LAS unsigned*)(lds + (bufoff) + ldsw + _i * 8192), 16, 0, 0); } while (0)
#define MG_LDA(dst, b, h) do { _Pragma("unroll") for (int m = 0; m < 4; ++m) _Pragma("unroll") for (int k = 0; k < 2; ++k) dst[m][k] = *(const LAS bf16x8*)(lds + MG_SA(b, h) + aoff + m * 2048 + k * 1024); } while (0)
#define MG_LDB(dst, b, h) do { _Pragma("unroll") for (int n = 0; n < 2; ++n) _Pragma("unroll") for (int k = 0; k < 2; ++k) dst[n][k] = *(const LAS bf16x8*)(lds + MG_SB(b, h) + boff + n * 2048 + k * 1024); } while (0)
#define MG_MMA(ai, bj, At, Bt) do { __builtin_amdgcn_s_setprio(1); _Pragma("unroll") for (int m = 0; m < 4; ++m) _Pragma("unroll") for (int n = 0; n < 2; ++n) _Pragma("unroll") for (int k = 0; k < 2; ++k) \
        acc[ai][bj][m][n] = __builtin_amdgcn_mfma_f32_16x16x32_bf16(Bt[n][k], At[m][k], acc[ai][bj][m][n], 0, 0, 0); __builtin_amdgcn_s_setprio(0); } while (0)
#define MG_WAIT_V(n) asm volatile("s_waitcnt vmcnt(" #n ")" ::: "memory")
#define MG_WAIT_L(n) asm volatile("s_waitcnt lgkmcnt(" #n ")" ::: "memory")
#define MG_BAR __builtin_amdgcn_s_barrier()
#define MG_SCHED __builtin_amdgcn_sched_barrier(0)
    Unit cur, nxt; int ui = 0;
    if (!S.next(0, cur)) return;
    int ntc = cur.pad > 0 ? cur.pad : nt;
    bool hf = Sched::HAS_HALF && (cur.half != 0);
    f32x4 acc[2][2][4][2];
#pragma unroll
    for (int a = 0; a < 2; ++a)
#pragma unroll
        for (int b = 0; b < 2; ++b)
#pragma unroll
            for (int m = 0; m < 4; ++m)
#pragma unroll
                for (int n = 0; n < 2; ++n) acc[a][b][m][n] = (f32x4){0.f, 0.f, 0.f, 0.f};
    bf16x8 At[4][2], B0[2][2], B1[2][2];
    unsigned va0[2], va1[2], na0[2], na1[2];
#pragma unroll
    for (int i = 0; i < 2; ++i) {
        if (GATHER) { va0[i] = gtab[Rr[i]] + (unsigned)Cc[i] * 2u; va1[i] = gtab[HALF + Rr[i]] + (unsigned)Cc[i] * 2u; }
        else { va0[i] = (unsigned)(Rr[i] * K + Cc[i]) * 2u; va1[i] = va0[i] + (unsigned)hstep; }
        na0[i] = va0[i]; na1[i] = va1[i];
    }
    const char* cA = cur.A; const char* cB = cur.B;
    MG_STAGE(MG_SB(0, 0), cB, voffB); MG_STAGE(MG_SB(0, 1), cB + hstep, voffB); MG_STAGE(MG_SA(0, 0), cA, va0); MG_STAGE(MG_SA(0, 1), cA, va1);
    if (wr == 1) MG_BAR;
    MG_WAIT_V(2); MG_BAR;
    MG_STAGE(MG_SB(1, 0), cB + kstep, voffB); MG_STAGE(MG_SA(1, 0), cA + kstep, va0); MG_STAGE(MG_SB(1, 1), cB + hstep + kstep, voffB);
    MG_WAIT_V(6); MG_BAR;
    for (;;) {
        if constexpr (Epi::ROWTAB) E.prefetch(cur, (LAS unsigned char*)gtab + (ui & 1) * 2048, wid, lane);
        const bool has_next = S.next(ui + 1, nxt);
        const char* nA = has_next ? nxt.A : cA; const char* nB = has_next ? nxt.B : cB;
        if constexpr (GATHER) {
            if (has_next) {
                if (ui + 1 < S.maxu) {
#pragma unroll
                    for (int i = 0; i < 2; ++i) { na0[i] = gtab[(ui + 1) * BM + Rr[i]] + (unsigned)Cc[i] * 2u; na1[i] = gtab[(ui + 1) * BM + HALF + Rr[i]] + (unsigned)Cc[i] * 2u; }
                } else {
#pragma unroll
                    for (int i = 0; i < 2; ++i) { const int s0_ = S.rl[nxt.pm * BM + Rr[i]], s1_ = S.rl[nxt.pm * BM + HALF + Rr[i]];
                        na0[i] = (unsigned)(s0_ < 0 ? 0 : (s0_ >> 3)) * (unsigned)(K * 2) + (unsigned)Cc[i] * 2u; na1[i] = (unsigned)(s1_ < 0 ? 0 : (s1_ >> 3)) * (unsigned)(K * 2) + (unsigned)Cc[i] * 2u; }
                }
            }
        }
#pragma unroll 1
        for (int t = 0; t < ntc; t += 2) {
            const bool last = (t == ntc - 2);
            const char* a1 = cA + (size_t)(t + 1) * kstep;
            const char* a2 = last ? nA : cA + (size_t)(t + 2) * kstep; const char* b2 = last ? nB : cB + (size_t)(t + 2) * kstep;
            const char* a3 = a2 + kstep; const char* b3 = b2 + kstep;
            unsigned o0[2], o1[2];
#pragma unroll
            for (int i = 0; i < 2; ++i) { o0[i] = (GATHER && last) ? na0[i] : va0[i]; o1[i] = (GATHER && last) ? na1[i] : va1[i]; }
            MG_LDB(B0, 0, 0); MG_LDB(B1, 0, 1); MG_SCHED; MG_LDA(At, 0, 0); MG_STAGE(MG_SA(1, 1), a1, va1);
            MG_WAIT_V(8); MG_WAIT_L(0); MG_BAR; MG_MMA(0, 0, At, B0); MG_MMA(0, 1, At, B1); MG_BAR; MG_SCHED;
            if (!hf) MG_LDA(At, 0, 1); MG_STAGE(MG_SB(0, 0), b2, voffB); MG_STAGE(MG_SB(0, 1), b2 + hstep, voffB); MG_STAGE(MG_SA(0, 0), a2, o0);
            MG_WAIT_V(8); MG_WAIT_L(0); MG_BAR; if (!hf) { MG_MMA(1, 0, At, B0); MG_MMA(1, 1, At, B1); } MG_BAR; MG_SCHED;
            MG_LDB(B0, 1, 0); MG_LDB(B1, 1, 1); MG_SCHED; MG_LDA(At, 1, 0); MG_STAGE(MG_SA(0, 1), a2, o1);
            MG_WAIT_V(8); MG_WAIT_L(0); MG_BAR; MG_MMA(0, 0, At, B0); MG_MMA(0, 1, At, B1); MG_BAR; MG_SCHED;
            if (!hf) MG_LDA(At, 1, 1); MG_STAGE(MG_SB(1, 0), b3, voffB); MG_STAGE(MG_SB(1, 1), b3 + hstep, voffB); MG_STAGE(MG_SA(1, 0), a3, o0);
            MG_WAIT_V(8); MG_WAIT_L(0); MG_BAR; if (!hf) { MG_MMA(1, 0, At, B0); MG_MMA(1, 1, At, B1); } MG_BAR; MG_SCHED;
        }
        if (wr == 0) MG_BAR;
        if constexpr (Epi::ROWTAB) E.epi_tab(acc, cur, wr, wc, fr, fq, (const LAS unsigned char*)gtab + (ui & 1) * 2048);
        else E(acc, cur, wr, wc, fr, fq);
        if (!has_next) break;
        if (!(Epi::KEEP_ACC && cur.e == 0)) {
#pragma unroll
        for (int a = 0; a < 2; ++a)
#pragma unroll
            for (int b = 0; b < 2; ++b)
#pragma unroll
                for (int m = 0; m < 4; ++m)
#pragma unroll
                    for (int n = 0; n < 2; ++n) acc[a][b][m][n] = (f32x4){0.f, 0.f, 0.f, 0.f};
        }
        cur = nxt; cA = nA; cB = nB; ++ui; ntc = cur.pad > 0 ? cur.pad : nt; hf = Sched::HAS_HALF && (cur.half != 0);
#pragma unroll
        for (int i = 0; i < 2; ++i) { va0[i] = na0[i]; va1[i] = na1[i]; }
        if (wr == 1) MG_BAR;
    }
    MG_WAIT_V(0);
    MG_BAR;
    __syncthreads();
#undef MG_SA
#undef MG_SB
#undef MG_STAGE
#undef MG_LDA
#undef MG_LDB
#undef MG_MMA
#undef MG_WAIT_V
#undef MG_WAIT_L
#undef MG_BAR
#undef MG_SCHED
}

DEV u32x4 pack8(const f32x4 a, const f32x4 b) { u32x4 w; w.x = pk2(a[0], a[1]); w.y = pk2(a[2], a[3]); w.z = pk2(b[0], b[1]); w.w = pk2(b[2], b[3]); return w; }
DEV f32x4 unpack_lo(const u32x4 w) { return (f32x4){__uint_as_float(w.x << 16), __uint_as_float(w.x & 0xffff0000u), __uint_as_float(w.y << 16), __uint_as_float(w.y & 0xffff0000u)}; }
DEV f32x4 unpack_hi(const u32x4 w) { return (f32x4){__uint_as_float(w.z << 16), __uint_as_float(w.z & 0xffff0000u), __uint_as_float(w.w << 16), __uint_as_float(w.w & 0xffff0000u)}; }
DEV f32x4 sig4(const f32x4 v) { return (f32x4){sigm(v[0]), sigm(v[1]), sigm(v[2]), sigm(v[3])}; }
DEV f32x4 silu4(const f32x4 v) { return (f32x4){silu(v[0]), silu(v[1]), silu(v[2]), silu(v[3])}; }
#define ACC_T f32x4 (&acc)[2][2][4][2]

struct MEpiInProj { static constexpr bool PERM = true; static constexpr bool KEEP_ACC = false; static constexpr bool ROWTAB = false; bf16_t *U, *QKV, *G;
    DEV void operator()(ACC_T, const Unit& u, int wr, int wc, int fr, int fq) const {
        int colt = u.pn * BM; bf16_t* base; int ld; bool sg = false;
        if (colt < 512) { base = U; ld = 512; } else if (colt < 2816) { base = QKV; ld = 2304; colt -= 512; } else { base = G; ld = 2048; colt -= 2816; sg = true; }
        const int row0 = u.pm * BM + wr * 64 + fr, col0 = colt + wc * 32 + 8 * fq;
#pragma unroll
        for (int ai = 0; ai < 2; ++ai)
#pragma unroll
            for (int m = 0; m < 4; ++m) { bf16_t* rowp = base + (size_t)(row0 + ai * HALF + m * 16) * ld + col0;
#pragma unroll
                for (int bj = 0; bj < 2; ++bj) { f32x4 v0 = acc[ai][bj][m][0], v1 = acc[ai][bj][m][1]; if (sg) { v0 = sig4(v0); v1 = sig4(v1); }
                    *(u32x4*)(rowp + bj * HALF) = pack8(v0, v1); }
                asm volatile("" ::: "memory"); }
    } };
struct MEpiMergeF { static constexpr bool PERM = true; static constexpr bool KEEP_ACC = true; static constexpr bool ROWTAB = false; bf16_t* MG; const bf16_t* G;
    DEV void mid(f32x4 (&acc)[2][2][4][2], const Unit& u, int wr, int wc, int fr, int fq) const {
        const int row0 = u.pm * BM + wr * 64 + fr, col0 = u.pn * BM + wc * 32 + 8 * fq;
        u32x4 ga[4], gb[4];
        { const bf16_t* gr = G + (size_t)row0 * 2048 + col0;
          ga[0] = *(const u32x4*)gr; ga[1] = *(const u32x4*)(gr + HALF); ga[2] = *(const u32x4*)(gr + 1024); ga[3] = *(const u32x4*)(gr + 1024 + HALF); }
#pragma unroll
        for (int gi = 0; gi < 8; ++gi) { const int ai = gi >> 2, m = gi & 3;
            if (gi < 7) { const bf16_t* gr = G + (size_t)(row0 + ((gi + 1) >> 2) * HALF + ((gi + 1) & 3) * 16) * 2048 + col0;
                if (gi & 1) { ga[0] = *(const u32x4*)gr; ga[1] = *(const u32x4*)(gr + HALF); ga[2] = *(const u32x4*)(gr + 1024); ga[3] = *(const u32x4*)(gr + 1024 + HALF); }
                else { gb[0] = *(const u32x4*)gr; gb[1] = *(const u32x4*)(gr + HALF); gb[2] = *(const u32x4*)(gr + 1024); gb[3] = *(const u32x4*)(gr + 1024 + HALF); } }
#pragma unroll
            for (int bj = 0; bj < 2; ++bj) { const u32x4 gp_ = (gi & 1) ? gb[bj] : ga[bj], gq_ = (gi & 1) ? gb[2 + bj] : ga[2 + bj];
                const f32x4 pl = unpack_lo(gp_), ph = unpack_hi(gp_), al = unpack_lo(gq_), ah = unpack_hi(gq_);
                acc[ai][bj][m][0] *= (f32x4){pl[0] * __builtin_amdgcn_rcpf(al[0]), pl[1] * __builtin_amdgcn_rcpf(al[1]), pl[2] * __builtin_amdgcn_rcpf(al[2]), pl[3] * __builtin_amdgcn_rcpf(al[3])};
                acc[ai][bj][m][1] *= (f32x4){ph[0] * __builtin_amdgcn_rcpf(ah[0]), ph[1] * __builtin_amdgcn_rcpf(ah[1]), ph[2] * __builtin_amdgcn_rcpf(ah[2]), ph[3] * __builtin_amdgcn_rcpf(ah[3])}; }
            asm volatile("" ::: "memory"); }
    }
    DEV void operator()(f32x4 (&acc)[2][2][4][2], const Unit& u, int wr, int wc, int fr, int fq) const {
        if (u.e == 0) { mid(acc, u, wr, wc, fr, fq); return; }
        const int row0 = u.pm * BM + wr * 64 + fr, col0 = u.pn * BM + wc * 32 + 8 * fq;
        u32x4 ga[2], gb[2];
        { const bf16_t* gr = G + (size_t)row0 * 2048 + 1024 + col0; ga[0] = *(const u32x4*)gr; ga[1] = *(const u32x4*)(gr + HALF); }
#pragma unroll
        for (int gi = 0; gi < 8; ++gi) { const int ai = gi >> 2, m = gi & 3; const size_t r = (size_t)(row0 + ai * HALF + m * 16);
            if (gi < 7) { const bf16_t* gr = G + (size_t)(row0 + ((gi + 1) >> 2) * HALF + ((gi + 1) & 3) * 16) * 2048 + 1024 + col0;
                if (gi & 1) { ga[0] = *(const u32x4*)gr; ga[1] = *(const u32x4*)(gr + HALF); } else { gb[0] = *(const u32x4*)gr; gb[1] = *(const u32x4*)(gr + HALF); } }
#pragma unroll
            for (int bj = 0; bj < 2; ++bj) { const u32x4 gq_ = (gi & 1) ? gb[bj] : ga[bj];
                *(u32x4*)(MG + r * DM + col0 + bj * HALF) = pack8(acc[ai][bj][m][0] * unpack_lo(gq_), acc[ai][bj][m][1] * unpack_hi(gq_)); }
            asm volatile("" ::: "memory"); }
    } };
struct MEpiOutProj { static constexpr bool PERM = false; static constexpr bool KEEP_ACC = false; static constexpr bool ROWTAB = false; const float* x; float* out; const float* mod;
    DEV void operator()(ACC_T, const Unit& u, int wr, int wc, int fr, int fq) const {
        const int row0 = u.pm * BM + wr * 64 + fr, col0 = u.pn * BM + wc * 32 + 4 * fq;
        const float* gm = mod + ((u.pm * BM) / SEQ) * NMOD + 2048 + col0;
        f32x4 gv[4];
#pragma unroll
        for (int q = 0; q < 4; ++q) gv[q] = *(const f32x4*)(gm + (q >> 1) * HALF + (q & 1) * 16);
        f32x4 xa[4], xb[4];
        { const float* xp = x + (size_t)row0 * DM + col0;
#pragma unroll
          for (int q = 0; q < 4; ++q) xa[q] = *(const f32x4*)(xp + (q >> 1) * HALF + (q & 1) * 16); }
#pragma unroll
        for (int gi = 0; gi < 8; ++gi) { const int ai = gi >> 2, m = gi & 3; const size_t r = (size_t)(row0 + ai * HALF + m * 16) * DM + col0;
            if (gi < 7) { const int ai2 = (gi + 1) >> 2, m2 = (gi + 1) & 3; const float* xp = x + (size_t)(row0 + ai2 * HALF + m2 * 16) * DM + col0;
#pragma unroll
                for (int q = 0; q < 4; ++q) { if (gi & 1) xa[q] = *(const f32x4*)(xp + (q >> 1) * HALF + (q & 1) * 16); else xb[q] = *(const f32x4*)(xp + (q >> 1) * HALF + (q & 1) * 16); } }
#pragma unroll
            for (int q = 0; q < 4; ++q) { const f32x4 xv = (gi & 1) ? xb[q] : xa[q];
                *(f32x4*)(out + r + (q >> 1) * HALF + (q & 1) * 16) = xv + gv[q] * acc[ai][q >> 1][m][q & 1]; }
            asm volatile("" ::: "memory"); }
    } };
struct MEpiRouterShared { static constexpr bool PERM = true; static constexpr bool KEEP_ACC = false; static constexpr bool ROWTAB = false; float* LG; bf16_t* HS;
    DEV void operator()(ACC_T, const Unit& u, int wr, int wc, int fr, int fq) const {
        const int row0 = u.pm * BM + wr * 64 + fr, cw = wc * 32 + 8 * fq;
#pragma unroll
        for (int ai = 0; ai < 2; ++ai)
#pragma unroll
            for (int m = 0; m < 4; ++m) { const size_t r = (size_t)(row0 + ai * HALF + m * 16);
                if (u.pn == 0) {
#pragma unroll
                    for (int bj = 0; bj < 2; ++bj)
#pragma unroll
                        for (int n = 0; n < 2; ++n) *(f32x4*)(LG + r * NE + bj * HALF + cw + 4 * n) = acc[ai][bj][m][n];
                } else {
                    const f32x4 v0 = silu4(acc[ai][0][m][0]) * acc[ai][1][m][0], v1 = silu4(acc[ai][0][m][1]) * acc[ai][1][m][1];
                    *(u32x4*)(HS + r * EFF + (u.pn - 1) * HALF + cw) = pack8(v0, v1);
                }
                asm volatile("" ::: "memory"); }
    } };
struct MEpiAct { static constexpr bool PERM = true; static constexpr bool KEEP_ACC = false; static constexpr bool ROWTAB = false; bf16_t* ACT;
    DEV void operator()(ACC_T, const Unit& u, int wr, int wc, int fr, int fq) const {
        const int row0 = u.pm * BM + wr * 64 + fr, cw = u.pn * HALF + wc * 32 + 8 * fq;
#pragma unroll
        for (int ai = 0; ai < 2; ++ai) { if (ai == 1 && u.half) break;
#pragma unroll
            for (int m = 0; m < 4; ++m) { const size_t r = (size_t)(row0 + ai * HALF + m * 16);
                const f32x4 v0 = silu4(acc[ai][0][m][0]) * acc[ai][1][m][0], v1 = silu4(acc[ai][0][m][1]) * acc[ai][1][m][1];
                *(u32x4*)(ACT + r * EFF + cw) = pack8(v0, v1); asm volatile("" ::: "memory"); } }
    } };
constexpr float SLAB_SCALE = 4.f, SLAB_INV = 0.25f;
DEV unsigned pk4_fp8(float a, float b, float c, float d) {
    a = __builtin_amdgcn_fmed3f(a, -440.f, 440.f); b = __builtin_amdgcn_fmed3f(b, -440.f, 440.f); c = __builtin_amdgcn_fmed3f(c, -440.f, 440.f); d = __builtin_amdgcn_fmed3f(d, -440.f, 440.f);
    int w = 0; w = __builtin_amdgcn_cvt_pk_fp8_f32(a, b, w, false); w = __builtin_amdgcn_cvt_pk_fp8_f32(c, d, w, true); return (unsigned)w; }
struct MEpiSlab { static constexpr bool PERM = true; static constexpr bool KEEP_ACC = false; static constexpr bool ROWTAB = true; unsigned char* SLAB; const int* rl; const float* w;
    DEV void prefetch(const Unit& u, LAS unsigned char* tab, int wid, int lane) const {
        const int rr = (wid & 3) * 64 + lane;
        const unsigned* src = (wid < 4) ? (const unsigned*)(rl + u.pm * BM + rr) : (const unsigned*)(w + u.pm * BM + rr);
        __builtin_amdgcn_global_load_lds(src, (LAS unsigned*)(tab + wid * 256), 4, 0, 0);
    }
    DEV void epi_tab(ACC_T, const Unit& u, int wr, int wc, int fr, int fq, const LAS unsigned char* tab) const {
        const int rloc = wr * 64 + fr, c16 = u.pn * BM + wc * 64 + 16 * fq;
#pragma unroll
        for (int ai = 0; ai < 2; ++ai) { if (ai == 1 && u.half) break;
#pragma unroll
            for (int m = 0; m < 4; ++m) { const int rr = rloc + ai * HALF + m * 16;
                const int s = *(const LAS int*)(tab + rr * 4); const float g = *(const LAS float*)(tab + 1024 + rr * 4) * SLAB_SCALE;
                if (s >= 0) { u32x4 o;
                    { const f32x4 a = acc[ai][0][m][0] * g, b = acc[ai][0][m][1] * g; o.x = pk4_fp8(a[0], a[1], a[2], a[3]); o.y = pk4_fp8(b[0], b[1], b[2], b[3]); }
                    { const f32x4 a = acc[ai][1][m][0] * g, b = acc[ai][1][m][1] * g; o.z = pk4_fp8(a[0], a[1], a[2], a[3]); o.w = pk4_fp8(b[0], b[1], b[2], b[3]); }
                    *(u32x4*)(SLAB + (size_t)s * DM + c16) = o; }
                asm volatile("" ::: "memory"); } }
    }
    DEV void operator()(ACC_T, const Unit& u, int wr, int wc, int fr, int fq) const {}
};
DEV void acc4_fp8(f32x4& a, unsigned w) { const auto lo = __builtin_amdgcn_cvt_pk_f32_fp8((int)w, false), hi = __builtin_amdgcn_cvt_pk_f32_fp8((int)w, true); a[0] += lo[0]; a[1] += lo[1]; a[2] += hi[0]; a[3] += hi[1]; }
struct MEpiFinal { static constexpr bool PERM = true; static constexpr bool KEEP_ACC = false; static constexpr bool ROWTAB = false; float* out; const unsigned char* SLAB; const float* mod;
    DEV void operator()(ACC_T, const Unit& u, int wr, int wc, int fr, int fq) const {
        const int row0 = u.pm * BM + wr * 64 + fr, c16 = u.pn * BM + wc * 64 + 16 * fq;
        const float* gm = mod + ((u.pm * BM) / SEQ) * NMOD + 5120 + c16;
#pragma unroll
        for (int ai = 0; ai < 2; ++ai)
#pragma unroll
            for (int m = 0; m < 4; ++m) { const size_t row = (size_t)(row0 + ai * HALF + m * 16);
                const unsigned char* sp = SLAB + row * 8 * DM + c16;
                float* op = out + row * DM + c16;
                u32x4 sw[8]; f32x4 x[4];
#pragma unroll
                for (int k = 0; k < 8; ++k) sw[k] = *(const u32x4*)(sp + (size_t)k * DM);
#pragma unroll
                for (int q = 0; q < 4; ++q) x[q] = *(const f32x4*)(op + 4 * q);
                f32x4 s4[4];
#pragma unroll
                for (int q = 0; q < 4; ++q) s4[q] = (f32x4){0.f, 0.f, 0.f, 0.f};
#pragma unroll
                for (int k = 0; k < 8; ++k) { acc4_fp8(s4[0], sw[k].x); acc4_fp8(s4[1], sw[k].y); acc4_fp8(s4[2], sw[k].z); acc4_fp8(s4[3], sw[k].w); }
                s4[0] = s4[0] * SLAB_INV + acc[ai][0][m][0]; s4[1] = s4[1] * SLAB_INV + acc[ai][0][m][1]; s4[2] = s4[2] * SLAB_INV + acc[ai][1][m][0]; s4[3] = s4[3] * SLAB_INV + acc[ai][1][m][1];
#pragma unroll
                for (int q = 0; q < 4; ++q) *(f32x4*)(op + 4 * q) = x[q] + *(const f32x4*)(gm + 4 * q) * s4[q];
                asm volatile("" ::: "memory"); }
    } };
#undef ACC_T
}

typedef float f32x16 __attribute__((ext_vector_type(16)));
typedef short s16x4 __attribute__((ext_vector_type(4)));
DEV int crow(int r, int hi) { return (r & 3) + 8 * (r >> 2) + 4 * hi; }
DEV unsigned cvtpk(float lo, float hi) { unsigned r; asm("v_cvt_pk_bf16_f32 %0, %1, %2" : "=v"(r) : "v"(lo), "v"(hi)); return r; }
DEV s16x4 vtr(const LAS unsigned char* p) { return __builtin_bit_cast(s16x4, __builtin_amdgcn_ds_read_tr16_b64_v4i16((LAS s16x4*)p)); }
DEV float swap32(float v) { return __shfl_xor(v, 32); }

DEV void normrope_frag(bf16x8 (&f)[4], const LAS float* gt, int hi, float posf) {
    float x[32]; float ss = 0.f;
#pragma unroll
    for (int d0 = 0; d0 < 4; ++d0) { const u32x4 w = __builtin_bit_cast(u32x4, f[d0]);
        x[8 * d0 + 0] = __uint_as_float(w.x << 16); x[8 * d0 + 1] = __uint_as_float(w.x & 0xffff0000u); x[8 * d0 + 2] = __uint_as_float(w.y << 16); x[8 * d0 + 3] = __uint_as_float(w.y & 0xffff0000u);
        x[8 * d0 + 4] = __uint_as_float(w.z << 16); x[8 * d0 + 5] = __uint_as_float(w.z & 0xffff0000u); x[8 * d0 + 6] = __uint_as_float(w.w << 16); x[8 * d0 + 7] = __uint_as_float(w.w & 0xffff0000u); }
#pragma unroll
    for (int i = 0; i < 32; ++i) ss += x[i] * x[i];
    ss += __shfl_xor(ss, 32);
    const float rs = rsqrtf(ss * (1.f / 64.f) + 1e-6f);
#pragma unroll
    for (int d0 = 0; d0 < 4; ++d0) { const f32x4 g0 = *(const LAS f32x4*)(gt + 16 * d0 + 8 * hi), g1 = *(const LAS f32x4*)(gt + 16 * d0 + 8 * hi + 4);
#pragma unroll
        for (int j = 0; j < 4; ++j) { x[8 * d0 + j] *= rs * g0[j]; x[8 * d0 + 4 + j] *= rs * g1[j]; } }
    constexpr float INVF[8] = {1.0f, 0.19392274474868576f, 0.03760603093086393f, 0.007292664737217109f, 0.001414213562373095f, 0.0002742481756762073f, 5.318295896944988e-05f, 1.031338537721246e-05f};
#pragma unroll
    for (int i = 0; i < 8; ++i) {
        const float rev = posf * (INVF[i] * 0.15915494309189535f);
        const float fr = rev - floorf(rev);
        const float cs = __builtin_amdgcn_cosf(fr), sn = __builtin_amdgcn_sinf(fr);
        const float partner = __shfl_xor(x[i], 32);
        x[i] = hi ? (x[i] * cs + partner * sn) : (x[i] * cs - partner * sn);
    }
#pragma unroll
    for (int d0 = 0; d0 < 4; ++d0) { u32x4 w; w.x = cvtpk(x[8 * d0], x[8 * d0 + 1]); w.y = cvtpk(x[8 * d0 + 2], x[8 * d0 + 3]); w.z = cvtpk(x[8 * d0 + 4], x[8 * d0 + 5]); w.w = cvtpk(x[8 * d0 + 6], x[8 * d0 + 7]);
        f[d0] = __builtin_bit_cast(bf16x8, w); }
}

DEV void ph_attn_mfma(const P& p, LAS unsigned char* lds, int bid, int nb) {
    const int tid = otid(); const int lane = tid & 63, wid = __builtin_amdgcn_readfirstlane(tid >> 6), r32 = lane & 31, hi = lane >> 5;
    LAS unsigned char* vl = lds + wid * 16384;
    LAS float* wsf = (LAS float*)(lds + wid * 16384 + 4096);
    LAS float* gtab_q = (LAS float*)(lds + wid * 16384 + 4352);
    LAS bf16_t* ost = (LAS bf16_t*)(lds + wid * 16384 + 8192);
    LAS float* gtab_k = gtab_q + 64;
    gtab_q[lane] = p.q_norm_g[lane]; gtab_k[lane] = p.k_norm_g[lane];
    asm volatile("s_waitcnt lgkmcnt(0)" ::: "memory");
    float gq = fabsf(p.q_norm_g[lane]), gk = fabsf(p.k_norm_g[lane]);
#pragma unroll
    for (int o = 32; o >= 1; o >>= 1) { gq = fmaxf(gq, __shfl_xor(gq, o)); gk = fmaxf(gk, __shfl_xor(gk, o)); }
    constexpr float LOG2E = 1.4426950408889634f, C2 = 0.125f * LOG2E;
    const float nmref = -(8.f * gq * gk * LOG2E);
    const int head = wid & 3, par = wid >> 2;
    const int tq = (lane & 15) >> 2, tp = lane & 3, tcb = (lane >> 4) & 1;
    const LAS unsigned char* vrd = vl + (4 * hi + tq) * 128 + (16 * tcb + 4 * tp) * 2;
    for (int it2 = bid; it2 < NB * 48; it2 += nb) {
        const int it = it2 * 2 + par;
        const int cb = it & 31, g = (it >> 5) % 3, b = it / 96;
        const int dsh = 2 * g, d = 1 << dsh, L = SEQ >> dsh, nbk = L >> 6;
        const int r = cb / nbk, blk = cb % nbk;
        const int h = 4 * g + head, base = b * SEQ;
        const int q0 = 64 * blk;
        const int mqa = q0 + r32, mqb = q0 + 32 + r32;
        bf16x8 qa[4], qb[4];
        { const bf16_t* qp = p.QKV + (size_t)(base + mqa * d + r) * 2304 + h * 64 + hi * 8;
#pragma unroll
          for (int d0 = 0; d0 < 4; ++d0) qa[d0] = *(const bf16x8*)(qp + d0 * 16);
          const bf16_t* qp2 = p.QKV + (size_t)(base + mqb * d + r) * 2304 + h * 64 + hi * 8;
#pragma unroll
          for (int d0 = 0; d0 < 4; ++d0) qb[d0] = *(const bf16x8*)(qp2 + d0 * 16); }
        const float pqa = (float)p.pos[base + mqa * d + r], pqb = (float)p.pos[base + mqb * d + r];
        normrope_frag(qa, gtab_q, hi, pqa); normrope_frag(qb, gtab_q, hi, pqb);
        f32x16 oa0, oa1, ob0, ob1;
#pragma unroll
        for (int i = 0; i < 16; ++i) { oa0[i] = 0.f; oa1[i] = 0.f; ob0[i] = 0.f; ob1[i] = 0.f; }
        float lsa = 0.f, lsb = 0.f;
        const int kb0 = q0 - 64;
#pragma unroll 1
        for (int st = 0; st < 6; ++st) {
            const int k0 = kb0 + 32 * st;
            if (k0 + 31 < 0 || k0 >= L) continue;
            const int mkc = min(max(k0 + r32, 0), L - 1);
            const bf16_t* kp = p.QKV + (size_t)(base + mkc * d + r) * 2304 + 768 + h * 64 + hi * 8;
            bf16x8 kf[4];
#pragma unroll
            for (int d0 = 0; d0 < 4; ++d0) kf[d0] = *(const bf16x8*)(kp + d0 * 16);
            const float kposf = (float)p.pos[base + mkc * d + r];
            u32x4 vreg[4];
#pragma unroll
            for (int i = 0; i < 4; ++i) { const int c = lane + 64 * i, row = c >> 3, ch = c & 7; const int mv = min(max(k0 + row, 0), L - 1);
                vreg[i] = *(const u32x4*)(p.QKV + (size_t)(base + mv * d + r) * 2304 + 1536 + h * 64 + ch * 8); }
            normrope_frag(kf, gtab_k, hi, kposf);
            const bool doa = st < 5, dob = st > 0;
            bf16x8 pa0, pa1, pb0, pb1;
#define ATT_SCORES(QR, MQ, LS, PF0, PF1) do { f32x16 s_; _Pragma("unroll") for (int i = 0; i < 16; ++i) s_[i] = 0.f; \
                _Pragma("unroll") for (int d0 = 0; d0 < 4; ++d0) s_ = __builtin_amdgcn_mfma_f32_32x32x16_bf16(kf[d0], QR[d0], s_, 0, 0, 0); \
                _Pragma("unroll") for (int i = 0; i < 16; ++i) { const int key = k0 + crow(i, hi); const int df = key - (MQ); \
                    const bool valid = (key >= 0) && (key < L) && (df <= 64) && (df >= -64); \
                    const float pv = valid ? __builtin_amdgcn_exp2f(__builtin_fmaf(s_[i], C2, nmref)) : 0.f; LS += pv; s_[i] = pv; } \
                u32x4 w0, w1; w0.x = cvtpk(s_[0], s_[1]); w0.y = cvtpk(s_[2], s_[3]); w0.z = cvtpk(s_[4], s_[5]); w0.w = cvtpk(s_[6], s_[7]); \
                w1.x = cvtpk(s_[8], s_[9]); w1.y = cvtpk(s_[10], s_[11]); w1.z = cvtpk(s_[12], s_[13]); w1.w = cvtpk(s_[14], s_[15]); \
                PF0 = __builtin_bit_cast(bf16x8, w0); PF1 = __builtin_bit_cast(bf16x8, w1); } while (0)
            if (doa) ATT_SCORES(qa, mqa, lsa, pa0, pa1);
            if (dob) ATT_SCORES(qb, mqb, lsb, pb0, pb1);
#undef ATT_SCORES
#pragma unroll
            for (int i = 0; i < 4; ++i) { const int c = lane + 64 * i, row = c >> 3, ch = c & 7; *(LAS u32x4*)(vl + row * 128 + ch * 16) = vreg[i]; }
            asm volatile("s_waitcnt lgkmcnt(0)" ::: "memory");
#pragma unroll
            for (int n = 0; n < 2; ++n)
#pragma unroll
                for (int ks = 0; ks < 2; ++ks) {
                    const s16x4 lo = vtr(vrd + (16 * ks) * 128 + 64 * n), hi4 = vtr(vrd + (16 * ks + 8) * 128 + 64 * n);
                    bf16x8 vf; vf[0] = lo[0]; vf[1] = lo[1]; vf[2] = lo[2]; vf[3] = lo[3]; vf[4] = hi4[0]; vf[5] = hi4[1]; vf[6] = hi4[2]; vf[7] = hi4[3];
                    if (doa) { if (n == 0) oa0 = __builtin_amdgcn_mfma_f32_32x32x16_bf16(ks == 0 ? pa0 : pa1, vf, oa0, 0, 0, 0);
                               else oa1 = __builtin_amdgcn_mfma_f32_32x32x16_bf16(ks == 0 ? pa0 : pa1, vf, oa1, 0, 0, 0); }
                    if (dob) { if (n == 0) ob0 = __builtin_amdgcn_mfma_f32_32x32x16_bf16(ks == 0 ? pb0 : pb1, vf, ob0, 0, 0, 0);
                               else ob1 = __builtin_amdgcn_mfma_f32_32x32x16_bf16(ks == 0 ? pb0 : pb1, vf, ob1, 0, 0, 0); }
                }
            asm volatile("s_waitcnt lgkmcnt(0)" ::: "memory");
        }
        const float lta = lsa + swap32(lsa), ltb = lsb + swap32(lsb);
        if (hi == 0) { wsf[r32] = 1.f / lta; wsf[32 + r32] = 1.f / ltb;
            p.LSUM[((size_t)g * T + (base + mqa * d + r)) * 4 + head] = lta; p.LSUM[((size_t)g * T + (base + mqb * d + r)) * 4 + head] = ltb; }
        asm volatile("s_waitcnt lgkmcnt(0)" ::: "memory");
        LAS bf16_t* ob_ = ost + 4 * hi * 64 + r32;
#pragma unroll
        for (int i = 0; i < 16; ++i) { const int qc = (i & 3) + 8 * (i >> 2); const float ia = wsf[4 * hi + qc];
            ob_[qc * 64] = f2bf(oa0[i] * ia); ob_[qc * 64 + 32] = f2bf(oa1[i] * ia); }
        asm volatile("" ::: "memory");
#pragma unroll
        for (int i = 0; i < 16; ++i) { const int qc = (i & 3) + 8 * (i >> 2); const float ib = wsf[32 + 4 * hi + qc];
            ob_[(32 + qc) * 64] = f2bf(ob0[i] * ib); ob_[(32 + qc) * 64 + 32] = f2bf(ob1[i] * ib); }
        asm volatile("s_waitcnt lgkmcnt(0)" ::: "memory");
        bf16_t* og = p.OG + (size_t)g * T * 256 + head * 64;
#pragma unroll
        for (int i = 0; i < 8; ++i) { const int c = lane + 64 * i, qrow = c >> 3, ch = c & 7;
            const u32x4 w = *(const LAS u32x4*)(ost + qrow * 64 + ch * 8);
            *(u32x4*)(og + (size_t)(base + (q0 + qrow) * d + r) * 256 + ch * 8) = w; }
        asm volatile("s_waitcnt lgkmcnt(0)" ::: "memory");
    }
}
DEV void ph_attn_combine(const P& p, int bid, int nb) {
    const int tid_ = otid();
    for (int i = bid * NTHR + tid_; i < T * 32; i += nb * NTHR) {
        const int t = i >> 5, ch = i & 31, slot = ch >> 3;
        const float l0 = p.LSUM[(size_t)t * 4 + slot], l1 = p.LSUM[((size_t)T + t) * 4 + slot], l2 = p.LSUM[((size_t)2 * T + t) * 4 + slot];
        const float inv = 1.f / (l0 + l1 + l2);
        const u32x4 a = *(const u32x4*)(p.OG + (size_t)t * 256 + ch * 8), b = *(const u32x4*)(p.OG + ((size_t)T + t) * 256 + ch * 8), c = *(const u32x4*)(p.OG + ((size_t)2 * T + t) * 256 + ch * 8);
        const f32x4 lo = (mg::unpack_lo(a) * l0 + mg::unpack_lo(b) * l1 + mg::unpack_lo(c) * l2) * inv;
        const f32x4 hi = (mg::unpack_hi(a) * l0 + mg::unpack_hi(b) * l1 + mg::unpack_hi(c) * l2) * inv;
        *(u32x4*)(p.PL + (size_t)t * 768 + 512 + ch * 8) = mg::pack8(lo, hi);
    }
}

template <class Src>
DEV void transpose_blk(const Src& src, int K, bf16_t* WT0, LAS float* scr, int k0, int lane) {
#pragma unroll 8
    for (int i = 0; i < 32; ++i) { const int kk = 2 * i + (lane >> 5); scr[kk * 33 + (lane & 31)] = src(k0 + kk, lane & 31); }
    asm volatile("s_waitcnt lgkmcnt(0)" ::: "memory");
    const int c = lane & 7;
#pragma unroll
    for (int j = 0; j < 4; ++j) { const int n = (lane >> 3) + 8 * j; const LAS float* s = scr + (8 * c) * 33 + n;
        u32x4 o; o.x = pk2(s[0 * 33], s[1 * 33]); o.y = pk2(s[2 * 33], s[3 * 33]); o.z = pk2(s[4 * 33], s[5 * 33]); o.w = pk2(s[6 * 33], s[7 * 33]);
        *(u32x4*)(WT0 + (size_t)n * K + k0 + 8 * c) = o; }
    asm volatile("s_waitcnt lgkmcnt(0)" ::: "memory");
}
struct SrcCol { const float* W; int ld; DEV float operator()(int k, int j) const { return W[(size_t)k * ld + j]; } };
struct SrcEff { const float *wg, *ls, *wu;
    DEV float operator()(int k, int j) const { const int g = k >> 7; const float* a = wg + (size_t)k * 128; const float* l = ls + g * 128; const float* b = wu + (size_t)(g * 128) * DM + j; float s = 0.f;
#pragma unroll 4
        for (int d = 0; d < 128; ++d) s += a[d] * l[d] * b[(size_t)d * DM]; return s; } };
DEV void tr_plain(const float* W, int K, int N, bf16_t* WT, LAS float* scr, int item, int lane) {
    const int nblk = N / 32, k0 = 64 * (item / nblk), n0 = 32 * (item % nblk);
    transpose_blk(SrcCol{W + n0, N}, K, WT + (size_t)n0 * K, scr, k0, lane);
}
DEV void tr_perm16(const float* W, int K, int N, bf16_t* WT, LAS float* scr, int item, int lane) {
    const int nblk = N / 32, k0 = 64 * (item / nblk), rho0 = 32 * (item % nblk);
    const int tile = rho0 >> 8, bj = (rho0 >> 7) & 1, wc = (rho0 >> 5) & 3;
    const int n0 = tile * 256 + 64 * wc + 8 * bj;
    struct SrcP { const float* W; int ld; DEV float operator()(int k, int dr) const { return W[(size_t)k * ld + 16 * (dr >> 3) + (dr & 7)]; } };
    transpose_blk(SrcP{W + n0, N}, K, WT + (size_t)rho0 * K, scr, k0, lane);
}
DEV void tr_gu(const float* g, const float* u, int K, bf16_t* WT, LAS float* scr, int k0, int rho0, int lane) {
    const int ch0 = (rho0 >> 8) * 128 + (rho0 & 127);
    const float* m = (rho0 & 128) ? u : g;
    transpose_blk(SrcCol{m + ch0, EFF}, K, WT + (size_t)rho0 * K, scr, k0, lane);
}

DEV void ph_prep_small(const P& p, LAS float* scr, int gw, int ngw, int lane) {
    constexpr int I_IN = 16 * (INW / 32), I_EFF = 64 * 16, I_AU = 4 * 32, I_OUT = 16 * 32, I_R = 16 * 8, I_S = 16 * 16, I_SD = 4 * 32;
    constexpr int NIT = I_IN + I_EFF + I_AU + I_OUT + I_R + I_S + I_SD;
    for (int it = gw; it < NIT; it += ngw) {
        int r = it;
        if (r < I_IN) { tr_plain(p.w_in, DM, INW, p.WT_IN, scr, r, lane); continue; } r -= I_IN;
        if (r < I_EFF) {
            const int n = 64 * (r & 15) + lane, k0 = 8 * (r >> 4), g = k0 >> 7;
            const float* a = p.pool_w_grp + (size_t)k0 * 128; const float* l = p.pool_scale + g * 128; const float* b = p.w_pool_up + (size_t)(g * 128) * DM + n;
            float acc[8];
#pragma unroll
            for (int j = 0; j < 8; ++j) acc[j] = 0.f;
#pragma unroll 4
            for (int d = 0; d < 128; ++d) { const float bl = b[(size_t)d * DM] * l[d];
#pragma unroll
                for (int j = 0; j < 8; ++j) acc[j] += a[j * 128 + d] * bl; }
            u32x4 o; o.x = pk2(acc[0], acc[1]); o.y = pk2(acc[2], acc[3]); o.z = pk2(acc[4], acc[5]); o.w = pk2(acc[6], acc[7]);
            *(u32x4*)(p.WT_EFF + (size_t)n * 768 + k0) = o; continue; } r -= I_EFF;
        if (r < I_AU) { const int k0 = 64 * (r / 32), n0 = 32 * (r % 32);
            transpose_blk(SrcCol{p.w_attn_up + n0, DM}, 768, p.WT_EFF + (size_t)n0 * 768 + 512, scr, k0, lane); continue; } r -= I_AU;
        if (r < I_OUT) { tr_plain(p.w_out, DM, DM, p.WT_OUT, scr, r, lane); continue; } r -= I_OUT;
        if (r < I_R) { tr_plain(p.w_router, DM, NE, p.WT_RS, scr, r, lane); continue; } r -= I_R;
        if (r < I_S) { tr_gu(p.w_sg, p.w_su, DM, p.WT_RS + (size_t)256 * DM, scr, 64 * (r / 16), 32 * (r % 16), lane); continue; } r -= I_S;
        tr_perm16(p.w_sd, EFF, DM, p.WT_SD, scr, r, lane);
    }
}
DEV void ph_prep_ed2(const P& p, LAS float* scr, int gw, int ngw, int lane) {
    constexpr int IPE = 4 * 32, NIT = NE * IPE;
    for (int it = gw * 2; it < NIT; it += ngw * 2) {
        const float* src[2]; bf16_t* dst[2]; int k0[2];
#pragma unroll
        for (int q = 0; q < 2; ++q) { const int t_ = it + q, e = t_ / IPE, item = t_ % IPE, nblk = DM / 32; k0[q] = 64 * (item / nblk); const int rho0 = 32 * (item % nblk);
            const int tile = rho0 >> 8, bj = (rho0 >> 7) & 1, wc = (rho0 >> 5) & 3, n0 = tile * 256 + 64 * wc + 8 * bj;
            src[q] = p.w_ed + (size_t)e * EFF * DM + n0; dst[q] = p.WT_ED + (size_t)e * DM * EFF + (size_t)rho0 * EFF; }
        const int dr = lane & 31, cofs = 16 * (dr >> 3) + (dr & 7);
        float v[2][32];
#pragma unroll
        for (int q = 0; q < 2; ++q)
#pragma unroll
            for (int i = 0; i < 32; ++i) v[q][i] = src[q][(size_t)(k0[q] + 2 * i + (lane >> 5)) * DM + cofs];
#pragma unroll
        for (int q = 0; q < 2; ++q)
#pragma unroll
            for (int i = 0; i < 32; ++i) scr[q * 2112 + (2 * i + (lane >> 5)) * 33 + dr] = v[q][i];
        asm volatile("s_waitcnt lgkmcnt(0)" ::: "memory");
        const int c = lane & 7;
#pragma unroll
        for (int q = 0; q < 2; ++q)
#pragma unroll
            for (int j = 0; j < 4; ++j) { const int n = (lane >> 3) + 8 * j; const LAS float* sp = scr + q * 2112 + (8 * c) * 33 + n;
                u32x4 o; o.x = pk2(sp[0 * 33], sp[1 * 33]); o.y = pk2(sp[2 * 33], sp[3 * 33]); o.z = pk2(sp[4 * 33], sp[5 * 33]); o.w = pk2(sp[6 * 33], sp[7 * 33]);
                *(u32x4*)(dst[q] + (size_t)n * EFF + k0[q] + 8 * c) = o; }
        asm volatile("s_waitcnt lgkmcnt(0)" ::: "memory");
    }
}
DEV void ph_prep_ed3(const P& p, LAS float* scr, int gw, int ngw, int lane) {
    constexpr int IPE = 4 * 16;
    for (int it = gw; it < NE * IPE; it += ngw) { const int e = it / IPE, r = it % IPE, k0 = 64 * (r >> 4), cb = r & 15, tile = cb >> 2, wc = cb & 3;
        const float* src = p.w_ed + (size_t)e * EFF * DM + (size_t)k0 * DM + tile * 256 + 64 * wc + lane;
#pragma unroll 16
        for (int k = 0; k < 64; ++k) scr[k * 65 + lane] = src[(size_t)k * DM];
        asm volatile("s_waitcnt lgkmcnt(0)" ::: "memory");
        const int c = lane & 7;
#pragma unroll
        for (int q = 0; q < 8; ++q) { const int j = (lane >> 3) + 8 * q;
            const int rho = tile * 256 + 128 * ((j >> 3) & 1) + 32 * wc + 8 * (j >> 4) + (j & 7);
            const LAS float* sp = scr + (8 * c) * 65 + j;
            u32x4 o; o.x = pk2(sp[0], sp[65]); o.y = pk2(sp[2 * 65], sp[3 * 65]); o.z = pk2(sp[4 * 65], sp[5 * 65]); o.w = pk2(sp[6 * 65], sp[7 * 65]);
            *(u32x4*)(p.WT_ED + (size_t)e * DM * EFF + (size_t)rho * EFF + k0 + 8 * c) = o; }
        asm volatile("s_waitcnt lgkmcnt(0)" ::: "memory");
    }
}
DEV void ph_prep_ed(const P& p, LAS float* scr, int gw, int ngw, int lane) {
    constexpr int IPE = 4 * 32;
    for (int it = gw; it < NE * IPE; it += ngw) { const int e = it / IPE;
        tr_perm16(p.w_ed + (size_t)e * EFF * DM, EFF, DM, p.WT_ED + (size_t)e * DM * EFF, scr, it % IPE, lane); }
}
DEV void ph_prep_egu(const P& p, LAS float* scr, int gw, int ngw, int lane) {
    constexpr int IPE = 16 * 16;
    for (int it = gw; it < NE * IPE; it += ngw) { const int e = it / IPE, r = it % IPE;
        tr_gu(p.w_eg + (size_t)e * DM * EFF, p.w_eu + (size_t)e * DM * EFF, DM, p.WT_EGU + (size_t)e * 512 * DM, scr, 64 * (r / 16), 32 * (r % 16), lane); }
}

constexpr int LDS_BYTES = 156672;
constexpr int LDS_OFF_TAB = 131072;
constexpr int LDS_GTAB = 131072 + 8192;
constexpr int MAXU = 16;
constexpr int LDS_MISC = LDS_GTAB + MAXU * 1024;

DEV void fill_gtab(const P& p, const mg::ExpertOrder& S, LAS unsigned* gtab) {
    const int tid_ = otid();
    for (int i = 0; i < MAXU; ++i) { int pm, pn, e; if (!S.tile_of(i, pm, pn, e)) break;
        if (tid_ < 256) { const int s = p.rowlist[pm * 256 + tid_]; gtab[i * 256 + tid_] = (unsigned)(s < 0 ? 0 : (s >> 3)) * (unsigned)(DM * 2); } }
    __syncthreads();
}

#define GAS __attribute__((address_space(1)))
#define XB_TMO      128
#define XB_XCNT(j)  (256  + 64 * (j))
#define XB_XSUB(j)  (1280 + 64 * (j))
#define XB_XGEN(j)  (2304 + 64 * (j))
#define XB_TOP      3328
#define XB_TOPGEN   3392
#define XCD_BAR_WORDS 3456
#define XB_SPIN_CAP (1u << 18)
DEV unsigned xb_ld(unsigned* p)              { return __hip_atomic_load(p, __ATOMIC_RELAXED, __HIP_MEMORY_SCOPE_AGENT); }
DEV unsigned xb_add(unsigned* p, unsigned v) { return __hip_atomic_fetch_add(p, v, __ATOMIC_RELAXED, __HIP_MEMORY_SCOPE_AGENT); }
DEV unsigned xb_xcc_id() { return (unsigned)__builtin_amdgcn_s_getreg((3 << 11) | 20) & 0xFu; }
#define XB_SPIN(cond, bar) do { unsigned _sp = 0; while (cond) { __builtin_amdgcn_s_sleep(1); \
    if ((++_sp & 255u) == 0u) { if (xb_ld(&(bar)[XB_TMO])) break; if (_sp > XB_SPIN_CAP) { atomicAdd(&(bar)[XB_TMO], 1u); break; } } } } while (0)
struct XcdBarrier { unsigned* bar; unsigned x; volatile LAS unsigned* st; };
DEV XcdBarrier xcd_barrier_post(unsigned* bar, volatile LAS unsigned* st) {
    XcdBarrier b; b.bar = bar; b.x = xb_xcc_id(); b.st = st;
    if (threadIdx.x == 0) (void)xb_add(&bar[XB_XCNT(b.x)], 1u);
    return b;
}
DEV void xcd_barrier_complete(unsigned* bar, unsigned x, unsigned& nloc, unsigned& nx) {
    const unsigned G = gridDim.x * gridDim.y * gridDim.z;
    unsigned sum, cnt, mine, sp = 0u;
    for (;;) {
        sum = 0u; cnt = 0u; mine = 0u;
#pragma unroll
        for (unsigned j = 0; j < 16; ++j) { const unsigned c = xb_ld(&bar[XB_XCNT(j)]); sum += c; cnt += (c > 0u) ? 1u : 0u; mine = (j == x) ? c : mine; }
        if (sum == G) break;
        __builtin_amdgcn_s_sleep(1);
        if ((++sp & 255u) == 0u) { if (xb_ld(&bar[XB_TMO])) break; if (sp > XB_SPIN_CAP) { atomicAdd(&bar[XB_TMO], 1u); break; } }
    }
    nloc = mine > 0u ? mine : 1u; nx = cnt > 0u ? cnt : 1u;
}
DEV void xcd_barrier(const XcdBarrier& b) {
    asm volatile("s_waitcnt vmcnt(0)" ::: "memory");
    __syncthreads();
    if (threadIdx.x == 0) {
        unsigned* bar = b.bar;
        __builtin_amdgcn_s_waitcnt(0);
        unsigned nloc = b.st[0], nx = b.st[1];
        if (nloc == 0u) { xcd_barrier_complete(bar, b.x, nloc, nx); b.st[0] = nloc; b.st[1] = nx; }
        const unsigned old = xb_add(&bar[XB_XSUB(b.x)], 1u);
        const unsigned gen = old / nloc;
        if (old + 1u == (gen + 1u) * nloc) {
            __builtin_amdgcn_fence(__ATOMIC_RELEASE, "agent");
            asm volatile("s_waitcnt vmcnt(0)" ::: "memory");
            const unsigned og = xb_add(&bar[XB_TOP], 1u);
            const unsigned tg = og / nx;
            if (og + 1u == (tg + 1u) * nx) xb_add(&bar[XB_TOPGEN], 1u);
            else XB_SPIN(xb_ld(&bar[XB_TOPGEN]) == tg, bar);
            __builtin_amdgcn_fence(__ATOMIC_ACQUIRE, "agent");
            xb_add(&bar[XB_XGEN(b.x)], 1u);
            asm volatile("s_waitcnt vmcnt(0)" ::: "memory");
        } else {
            XB_SPIN(xb_ld(&bar[XB_XGEN(b.x)]) == gen, bar);
            __builtin_amdgcn_fence(__ATOMIC_ACQUIRE, "agent");
            asm volatile("s_waitcnt vmcnt(0)" ::: "memory");
        }
    }
    __syncthreads();
}

#define STAMP() do { if (TPROBE >= 0) { if (bid == 0 && threadIdx.x == 0) p.ts[nst] = __builtin_amdgcn_s_memrealtime(); ++nst; } } while (0)
#define GSYNC_CG() do { cg::this_grid().sync(); STAMP(); } while (0)
#define GSYNC() do { xcd_barrier(xbar); STAMP(); } while (0)
__global__ void __launch_bounds__(NTHR, 2) fwd_all(P p) {
    extern __shared__ __attribute__((aligned(16))) unsigned char lds_raw[];
    LAS unsigned char* lds = (LAS unsigned char*)lds_raw;
    float* sm = (float*)lds_raw;
    int* off = (int*)(lds_raw + LDS_OFF_TAB);
    const LAS int* offl = (const LAS int*)(lds + LDS_OFF_TAB);
    LAS unsigned* gtab = (LAS unsigned*)(lds + LDS_GTAB);
    const int bid = blockIdx.x, nb = gridDim.x;
    const int tid_ = otid(); const int lane = tid_ & 63, wv = tid_ >> 6;
    LAS float* scr = (LAS float*)(lds + wv * 18432);
    const int gw = bid * NWV + wv, ngw = nb * NWV;
    volatile LAS unsigned* misc = (volatile LAS unsigned*)(lds + LDS_MISC);
    if (threadIdx.x < 2) misc[threadIdx.x] = 0u;
    __syncthreads();
    const XcdBarrier xbar = xcd_barrier_post(p.bar, misc);
    int nst = 0; STAMP();

    ph_mod(p, sm, bid, nb);
    __syncthreads();
    REPEAT(1) ph_prep_small(p, scr, gw, ngw, lane);
#if MF_EXP2
    ph_prep_ed3(p, scr, gw, ngw, lane);
#endif
    GSYNC();
    REPEAT(3) ph_norm(p.x, p.norm1_g, p.mod, 0, 1024, p.XB, bid, nb);
    GSYNC();
#if MF_INPROJ
    REPEAT(4) { mg::DenseOrder S; S.init(p.XB, p.WT_IN, T, INW, DM, nb, bid);
      mg::gemm_phase<mg::MEpiInProj, mg::DenseOrder, false>(lds, gtab, DM, S, mg::MEpiInProj{p.U, p.QKV, p.G}); }
#else
    ngemm_dense<false>(p.XB, DM, p.w_in, nullptr, INW, T, INW, DM, EpiInProj{p.U, p.QKV, p.G}, sm, bid, nb);
#endif
    GSYNC();
#if !MF_ATTN
    ph_qknorm(p, bid, nb);
#endif
    REPEAT(5) ph_pool(p, bid, nb);
#if !MF_ATTN
    GSYNC();
#endif
#if MF_ATTN
    REPEAT(6) ph_attn_mfma(p, lds, bid, nb);
    GSYNC();
    REPEAT(7) ph_attn_combine(p, bid, nb);
#else
    ph_attn(p, bid, nb);
#endif
#if !MF_MERGE
#pragma unroll 1
    for (int g = 0; g < 4; ++g) ngemm_dense<false>(p.PL + g * 128, 512, p.pool_w_grp + g * 128 * 128, nullptr, 128, T, 128, 128, EpiPoolGrp{p.Y, p.pool_scale, g}, sm, bid, nb);
#endif
    GSYNC();
#if MF_MERGE
    REPEAT(8) { mg::PairOrder S; S.D.init(p.PL, p.WT_EFF, T, DM, 768, nb, bid); S.kt0 = 8; S.kt1 = 4;
      mg::gemm_phase<mg::MEpiMergeF, mg::PairOrder, false>(lds, gtab, 768, S, mg::MEpiMergeF{p.XB, p.G}); }
#else
    ngemm_dense<false>(p.Y, 512, p.w_pool_up, nullptr, DM, T, DM, 512, EpiMergeA{p.XB, p.G}, sm, bid, nb);
    GSYNC();
    ngemm_dense<false>(p.O, 256, p.w_attn_up, nullptr, DM, T, DM, 256, EpiMergeB{p.XB, p.G}, sm, bid, nb);
#endif
    GSYNC();
#if MF_OUT
    REPEAT(9) { mg::DenseOrder S; S.init(p.XB, p.WT_OUT, T, DM, DM, nb, bid);
      mg::gemm_phase<mg::MEpiOutProj, mg::DenseOrder, false>(lds, gtab, DM, S, mg::MEpiOutProj{p.x, p.out, p.mod}); }
#else
    ngemm_dense<false>(p.XB, DM, p.w_out, nullptr, DM, T, DM, DM, EpiOutProj{p.x, p.out, p.mod}, sm, bid, nb);
#endif
    GSYNC();
    REPEAT(10) ph_norm(p.out, p.norm2_g, p.mod, 3072, 4096, p.XB, bid, nb);
#if MF_EXP1
    __syncthreads();
    REPEAT(11) ph_prep_egu(p, scr, gw, ngw, lane);
#endif
    GSYNC();
#if MF_ROUTER
    REPEAT(12) { mg::DenseOrder S; S.init(p.XB, p.WT_RS, T, 768, DM, nb, bid);
      mg::gemm_phase<mg::MEpiRouterShared, mg::DenseOrder, false>(lds, gtab, DM, S, mg::MEpiRouterShared{p.LG, p.HS}); }
#else
    ngemm_dense<false>(p.XB, DM, p.w_router, nullptr, NE, T, NE, DM, EpiLogits{p.LG}, sm, bid, nb);
#endif
    GSYNC();
    ph_route(p, (int*)lds_raw, bid, nb);
    GSYNC();
    ph_scatter(p, off, bid, nb);
    GSYNC();
#if MF_EXP1
    REPEAT(13) { load_offsets(p.cnt, off);
      mg::ExpertOrder S{offl, 2, nb, bid, (const char*)p.XB, (const char*)p.WT_EGU, (size_t)512 * DM * 2, (size_t)256 * DM * 2, 0, true, p.rowlist, MAXU};
      S.build_table((LAS int*)(lds + LDS_OFF_TAB), otid()); __syncthreads();
      fill_gtab(p, S, gtab);
      mg::gemm_phase<mg::MEpiAct, mg::ExpertOrder, true>(lds, gtab, DM, S, mg::MEpiAct{p.ACT}); }
#else
    ph_expert1(p, sm, off, bid, nb);
#endif
    GSYNC();
#if MF_EXP2
    REPEAT(14) { load_offsets(p.cnt, off);
      mg::ExpertOrder S{offl, 4, nb, bid, (const char*)p.ACT, (const char*)p.WT_ED, (size_t)DM * EFF * 2, (size_t)256 * EFF * 2, (size_t)256 * EFF * 2, false, p.rowlist, MAXU};
      S.build_table((LAS int*)(lds + LDS_OFF_TAB), otid()); __syncthreads();
      mg::gemm_phase<mg::MEpiSlab, mg::ExpertOrder, false>(lds, gtab, EFF, S, mg::MEpiSlab{(unsigned char*)p.SLAB, p.rowlist, p.roww}); }
#else
    ph_expert2(p, sm, off, bid, nb);
#endif
    GSYNC();
#if !MF_ROUTER
    ngemm_dense<true>(p.XB, DM, p.w_sg, p.w_su, EFF, T, EFF, DM, EpiAct{p.HS}, sm, bid, nb);
    GSYNC();
#endif
#if MF_FINAL
    { mg::DenseOrder S; S.init(p.HS, p.WT_SD, T, DM, EFF, nb, bid);
      mg::gemm_phase<mg::MEpiFinal, mg::DenseOrder, false>(lds, gtab, EFF, S, mg::MEpiFinal{p.out, (const unsigned char*)p.SLAB, p.mod}); }
#else
    ngemm_dense<false>(p.HS, EFF, p.w_sd, nullptr, DM, T, DM, EFF, EpiFinal{p.out, p.SLAB, p.mod}, sm, bid, nb);
#endif
#if TPROBE >= 0
    GSYNC();
    if (bid == 0 && threadIdx.x == 0) { const unsigned long long dt = p.ts[TPROBE + 1] - p.ts[TPROBE]; p.out[0] += (float)dt * 0.01f / TSCALE; }
#endif
}

extern "C" void kernel_launch(void* const* d_in, const int* in_sizes, int n_in, void* d_out, int out_size, void* d_ws, size_t ws_size, hipStream_t stream) {
    static int grid = 0;
    if (grid == 0) {
        int dev = 0, cus = 0;
        (void)hipGetDevice(&dev);
        (void)hipDeviceGetAttribute(&cus, hipDeviceAttributeMultiprocessorCount, dev);
        int per_cu = 0;
        (void)hipFuncSetAttribute((const void*)fwd_all, hipFuncAttributeMaxDynamicSharedMemorySize, LDS_BYTES);
        (void)hipOccupancyMaxActiveBlocksPerMultiprocessor(&per_cu, fwd_all, NTHR, LDS_BYTES);
        if (per_cu < 1) { fprintf(stderr, "kernel_launch: occupancy query says %d blocks/CU\n", per_cu); per_cu = 1; }
        if (per_cu > 1) per_cu = 1;
        grid = cus * per_cu;
        if (ws_size < WS_END) { fprintf(stderr, "kernel_launch: workspace too small (%zu < %zu)\n", ws_size, (size_t)WS_END); grid = -1; }
    }
    if (grid < 0) return;
    P p{};
    const float* const* in = (const float* const*)d_in;
    p.x = in[0]; p.c = in[1]; p.pos = (const int*)d_in[2];
    p.w_ada = in[3]; p.b_ada = in[4]; p.norm1_g = in[5]; p.w_in = in[6]; p.pool_w_grp = in[7]; p.pool_scale = in[8]; p.q_norm_g = in[9]; p.k_norm_g = in[10];
    p.w_pool_up = in[11]; p.w_attn_up = in[12]; p.w_out = in[13]; p.norm2_g = in[14]; p.w_router = in[15]; p.router_bias = in[16];
    p.w_sg = in[17]; p.w_su = in[18]; p.w_sd = in[19]; p.w_eg = in[20]; p.w_eu = in[21]; p.w_ed = in[22];
    p.out = (float*)d_out;
    char* ws = (char*)d_ws;
    p.mod = (float*)(ws + WS_MOD); p.cnt = (int*)(ws + WS_CNT); p.asg_e = (int*)(ws + WS_ASG_E); p.asg_pos = (int*)(ws + WS_ASG_POS);
    p.asg_w = (float*)(ws + WS_ASG_W); p.rowlist = (int*)(ws + WS_ROWLIST);
    p.XB = (bf16_t*)(ws + WS_XB); p.U = (bf16_t*)(ws + WS_U); p.QKV = (bf16_t*)(ws + WS_QKV); p.G = (bf16_t*)(ws + WS_G); p.PL = (bf16_t*)(ws + WS_PL);
    p.Y = (bf16_t*)(ws + WS_Y); p.O = (bf16_t*)(ws + WS_O); p.ACT = (bf16_t*)(ws + WS_ACT); p.SLAB = (bf16_t*)(ws + WS_SLAB); p.HS = (bf16_t*)(ws + WS_HS);
    p.LG = (float*)(ws + WS_ACT);
    p.roww = (float*)(ws + WS_ROWW);
    p.bar = (unsigned*)(ws + WS_BAR); p.ts = (unsigned long long*)(ws + WS_TS);
    p.OG = (bf16_t*)(ws + WS_OG); p.LSUM = (float*)(ws + WS_LSUM);
    p.WT_IN = (bf16_t*)(ws + WS_WT_IN); p.WT_EFF = (bf16_t*)(ws + WS_WT_EFF); p.WT_AU = (bf16_t*)(ws + WS_WT_AU); p.WT_OUT = (bf16_t*)(ws + WS_WT_OUT);
    p.WT_RS = (bf16_t*)(ws + WS_WT_RS); p.WT_SD = (bf16_t*)(ws + WS_WT_SD); p.WT_EGU = (bf16_t*)(ws + WS_WT_EGU); p.WT_ED = (bf16_t*)(ws + WS_WT_ED);
    (void)hipMemsetAsync(ws + WS_BAR, 0, WS_ZERO_BYTES, stream);
    void* args[] = {&p};
    hipError_t e = hipLaunchCooperativeKernel((void*)fwd_all, dim3(grid), dim3(NTHR), args, LDS_BYTES, stream);
    if (e != hipSuccess) fprintf(stderr, "cooperative launch failed: %s (grid %d)\n", hipGetErrorString(e), grid);
}
```

```cpp
#include <hip/hip_runtime.h>
#include <hip/hip_cooperative_groups.h>
#include <stdint.h>
#include <cstdio>
namespace cg = cooperative_groups;

#ifndef ONE_LAUNCH
#define ONE_LAUNCH 0
#endif

typedef unsigned short bf16_t;
#define DEV __device__ __forceinline__
#define LAS __attribute__((address_space(3)))
typedef short bf16x8 __attribute__((ext_vector_type(8)));
typedef float f32x4 __attribute__((ext_vector_type(4)));
typedef unsigned u32x4 __attribute__((ext_vector_type(4)));
typedef unsigned u32x2 __attribute__((ext_vector_type(2)));

#ifndef MF_INPROJ
#define MF_INPROJ 1
#endif
#ifndef MF_MERGE
#define MF_MERGE 1
#endif
#ifndef MF_OUT
#define MF_OUT 1
#endif
#ifndef MF_ROUTER
#define MF_ROUTER 1
#endif
#ifndef MF_EXP1
#define MF_EXP1 1
#endif
#ifndef MF_EXP2
#define MF_EXP2 1
#endif
#ifndef MF_ATTN
#define MF_ATTN 1
#endif
#ifndef DUP
#define DUP 0
#endif
#ifndef TPROBE
#define TPROBE -1
#endif
#ifndef TSCALE
#define TSCALE 10.0f
#endif
#define REPEAT(n) _Pragma("unroll 1") for (int rep_ = 0; rep_ < ((DUP == (n)) ? 2 : 1); ++rep_)
#ifndef MF_FINAL
#define MF_FINAL 1
#endif

constexpr int NB = 16, SEQ = 2048, DM = 1024, T = NB * SEQ;
constexpr int INW = 4864, NMOD = 6144;
constexpr int NE = 256, EFF = 256;
constexpr int NTHR = 512, NWV = 8;
constexpr int NSLOT = T * 8;
constexpr int RMAX = NSLOT + NE * 256;

DEV float bf2f(bf16_t h) { return __uint_as_float(((unsigned)h) << 16); }
typedef __bf16 bf16v2 __attribute__((ext_vector_type(2)));
DEV bf16_t f2bf(float f) { const __bf16 b = (__bf16)f; return __builtin_bit_cast(unsigned short, b); }
DEV unsigned pk2(float lo, float hi) { const bf16v2 v = {(__bf16)lo, (__bf16)hi}; return __builtin_bit_cast(unsigned, v); }
DEV float sigm(float v) { return __builtin_amdgcn_rcpf(1.f + __builtin_amdgcn_exp2f(-1.4426950408889634f * v)); }
DEV float silu(float v) { return v * __builtin_amdgcn_rcpf(1.f + __builtin_amdgcn_exp2f(-1.4426950408889634f * v)); }
DEV int otid() { int t = threadIdx.x; asm volatile("" : "+v"(t)); return t; }
DEV float wave_sum(float v) {
#pragma unroll
    for (int o = 32; o >= 1; o >>= 1) v += __shfl_xor(v, o);
    return v;
}

struct P {
    const float *x, *c; const int* pos;
    const float *w_ada, *b_ada, *norm1_g, *w_in, *pool_w_grp, *pool_scale, *q_norm_g, *k_norm_g, *w_pool_up, *w_attn_up, *w_out, *norm2_g,
        *w_router, *router_bias, *w_sg, *w_su, *w_sd, *w_eg, *w_eu, *w_ed;
    float* out;
    float* mod; int* cnt; int* asg_e; int* asg_pos; float* asg_w; int* rowlist;
    bf16_t *XB, *U, *QKV, *G, *PL, *Y, *O, *ACT, *SLAB, *HS;
    float* LG;
    bf16_t* OG; float* LSUM; unsigned* bar; unsigned long long* ts; float* roww;
    bf16_t *WT_IN, *WT_EFF, *WT_AU, *WT_OUT, *WT_RS, *WT_SD, *WT_EGU, *WT_ED;
};

constexpr size_t MiB = 1u << 20;
constexpr size_t WS_BAR = 640 * 1024, WS_BAR_BYTES = 16384, WS_ZERO_BYTES = 16384 + 65536;
constexpr size_t WS_TS = 800 * 1024;
constexpr size_t WS_MOD = 0, WS_CNT = WS_BAR + WS_BAR_BYTES, WS_ASG_E = 1 * MiB, WS_ASG_POS = 2 * MiB, WS_ASG_W = 3 * MiB, WS_ROWLIST = 4 * MiB, WS_ROWW = 6 * MiB;
constexpr size_t WS_XB = 8 * MiB;
constexpr size_t WS_ACT = 72 * MiB;
constexpr size_t WS_SLAB = 232 * MiB;
constexpr size_t WS_U = 232 * MiB, WS_QKV = 264 * MiB, WS_G = 408 * MiB, WS_PL = 536 * MiB, WS_Y = 568 * MiB, WS_O = 600 * MiB;
constexpr size_t WS_WT_IN = 744 * MiB, WS_WT_EFF = 754 * MiB, WS_WT_AU = 755 * MiB, WS_WT_OUT = 756 * MiB, WS_WT_RS = 758 * MiB, WS_WT_SD = 760 * MiB;
constexpr size_t WS_WT_ED = 762 * MiB;
constexpr size_t WS_WT_EGU = 232 * MiB;
constexpr size_t WS_OG = 616 * MiB, WS_LSUM = 664 * MiB;
constexpr size_t WS_HS = 890 * MiB;
constexpr size_t WS_END = 906 * MiB;

DEV void ph_mod(const P& p, float* sm, int bid, int nb) {
    const int tid_ = otid(); const int lane = tid_ & 63, wv = tid_ >> 6;
    for (int it = bid; it < 96; it += nb) {
        const int k0 = wv * 128, e = it * 64 + lane;
        float acc[16];
#pragma unroll
        for (int b = 0; b < 16; ++b) acc[b] = 0.f;
#pragma unroll 1
        for (int kh = 0; kh < 2; ++kh) {
            float sc[16];
#pragma unroll
            for (int b = 0; b < 16; ++b) sc[b] = silu(p.c[b * DM + k0 + kh * 64 + lane]);
            const float* wp = p.w_ada + (size_t)(k0 + kh * 64) * NMOD + e;
#pragma unroll 8
            for (int kk = 0; kk < 64; ++kk) { const float w = wp[(size_t)kk * NMOD];
#pragma unroll
                for (int b = 0; b < 16; ++b) acc[b] += __uint_as_float(__builtin_amdgcn_readlane(__float_as_uint(sc[b]), kk)) * w; }
        }
        __syncthreads();
#pragma unroll
        for (int b = 0; b < 16; ++b) sm[(wv * 16 + b) * 64 + lane] = acc[b];
        __syncthreads();
#pragma unroll
        for (int j = 0; j < 2; ++j) { const int idx = tid_ + j * NTHR, b = idx >> 6, col = idx & 63; float s = p.b_ada[it * 64 + col];
#pragma unroll
            for (int w = 0; w < 8; ++w) s += sm[(w * 16 + b) * 64 + col];
            p.mod[b * NMOD + it * 64 + col] = s; }
    }
}

DEV void ph_norm(const float* src, const float* g, const float* mod, int shift_off, int scale_off, bf16_t* dst, int bid, int nb) {
    const int tid_ = otid(); const int lane = tid_ & 63, wv = tid_ >> 6;
    for (int row0 = (bid * NWV + wv) * 2; row0 < T; row0 += nb * NWV * 2) {
        float4 v[2][4]; float ss[2] = {0.f, 0.f};
#pragma unroll
        for (int q = 0; q < 2; ++q) { const float4* xr = (const float4*)(src + (size_t)(row0 + q) * DM);
#pragma unroll
            for (int j = 0; j < 4; ++j) v[q][j] = xr[lane + 64 * j]; }
#pragma unroll
        for (int q = 0; q < 2; ++q)
#pragma unroll
            for (int j = 0; j < 4; ++j) ss[q] += v[q][j].x * v[q][j].x + v[q][j].y * v[q][j].y + v[q][j].z * v[q][j].z + v[q][j].w * v[q][j].w;
        const int b = row0 / SEQ;
#pragma unroll
        for (int q = 0; q < 2; ++q) {
            const float r = rsqrtf(wave_sum(ss[q]) * (1.f / DM) + 1e-6f);
#pragma unroll
            for (int j = 0; j < 4; ++j) {
                const int col = (lane + 64 * j) * 4;
                const float4 g4 = *(const float4*)(g + col);
                const float4 sc = *(const float4*)(mod + b * NMOD + scale_off + col);
                const float4 sh = *(const float4*)(mod + b * NMOD + shift_off + col);
                const float o0 = v[q][j].x * r * g4.x * (1.f + sc.x) + sh.x, o1 = v[q][j].y * r * g4.y * (1.f + sc.y) + sh.y;
                const float o2 = v[q][j].z * r * g4.z * (1.f + sc.z) + sh.z, o3 = v[q][j].w * r * g4.w * (1.f + sc.w) + sh.w;
                uint2 w; w.x = pk2(o0, o1); w.y = pk2(o2, o3);
                *(uint2*)(dst + (size_t)(row0 + q) * DM + col) = w;
            }
        }
    }
}

template <bool DUAL, class RowF, class Epi>
DEV void ngemm_tile(const bf16_t* __restrict__ A, int lda, RowF rowf, const float* __restrict__ B, const float* __restrict__ B2, int ldb,
                    int m0, int n0, int K, Epi epi, float* sm) {
    float* As = sm;
    float* Bs = sm + 16 * 132;
    float* Bs2 = Bs + 16 * 64;
    const int tid = otid(), tm = tid >> 4, tn = tid & 15;
    float acc[4][4], acc2[4][4];
#pragma unroll
    for (int i = 0; i < 4; ++i)
#pragma unroll
        for (int j = 0; j < 4; ++j) { acc[i][j] = 0.f; acc2[i][j] = 0.f; }
    const int ar = tid >> 2, ak = (tid & 3) * 4;
    const int arow = rowf(m0 + ar);
    const bf16_t* ap = A + (size_t)(arow < 0 ? 0 : arow) * lda + ak;
    const int bk = tid >> 5, bn = (tid & 31) * 2;
    for (int k0 = 0; k0 < K; k0 += 16) {
        uint2 av = make_uint2(0u, 0u);
        if (arow >= 0) av = *(const uint2*)(ap + k0);
        const float2 bv = *(const float2*)(B + (size_t)(k0 + bk) * ldb + n0 + bn);
        float2 bv2 = make_float2(0.f, 0.f);
        if (DUAL) bv2 = *(const float2*)(B2 + (size_t)(k0 + bk) * ldb + n0 + bn);
        __syncthreads();
        As[(ak + 0) * 132 + ar] = __uint_as_float(av.x << 16);
        As[(ak + 1) * 132 + ar] = __uint_as_float(av.x & 0xffff0000u);
        As[(ak + 2) * 132 + ar] = __uint_as_float(av.y << 16);
        As[(ak + 3) * 132 + ar] = __uint_as_float(av.y & 0xffff0000u);
        Bs[bk * 64 + bn] = bv.x; Bs[bk * 64 + bn + 1] = bv.y;
        if (DUAL) { Bs2[bk * 64 + bn] = bv2.x; Bs2[bk * 64 + bn + 1] = bv2.y; }
        __syncthreads();
#pragma unroll
        for (int kk = 0; kk < 16; ++kk) {
            const float4 a = *(const float4*)&As[kk * 132 + tm * 4];
            const float4 b = *(const float4*)&Bs[kk * 64 + tn * 4];
            const float aa[4] = {a.x, a.y, a.z, a.w}, bb[4] = {b.x, b.y, b.z, b.w};
#pragma unroll
            for (int i = 0; i < 4; ++i)
#pragma unroll
                for (int j = 0; j < 4; ++j) acc[i][j] += aa[i] * bb[j];
            if (DUAL) {
                const float4 b2 = *(const float4*)&Bs2[kk * 64 + tn * 4];
                const float cc[4] = {b2.x, b2.y, b2.z, b2.w};
#pragma unroll
                for (int i = 0; i < 4; ++i)
#pragma unroll
                    for (int j = 0; j < 4; ++j) acc2[i][j] += aa[i] * cc[j];
            }
        }
    }
#pragma unroll
    for (int i = 0; i < 4; ++i)
#pragma unroll
        for (int j = 0; j < 4; ++j) epi(m0 + tm * 4 + i, n0 + tn * 4 + j, acc[i][j], acc2[i][j]);
}

struct RowId { DEV int operator()(int m) const { return m; } };
struct RowTok { const int* rl; DEV int operator()(int m) const { const int s = rl[m]; return s < 0 ? -1 : (s >> 3); } };

template <bool DUAL, class Epi>
DEV void ngemm_dense(const bf16_t* A, int lda, const float* B, const float* B2, int ldb, int M, int N, int K, Epi epi, float* sm, int bid, int nb) {
    const int tn = N / 64, nt = (M / 128) * tn;
    for (int t = bid; t < nt; t += nb) ngemm_tile<DUAL>(A, lda, RowId(), B, B2, ldb, (t / tn) * 128, (t % tn) * 64, K, epi, sm);
}

struct EpiInProj { bf16_t *U, *QKV, *G;
    DEV void operator()(int r, int c, float v, float) const {
        if (c < 512) U[(size_t)r * 512 + c] = f2bf(v);
        else if (c < 2816) QKV[(size_t)r * 2304 + (c - 512)] = f2bf(v);
        else G[(size_t)r * 2048 + (c - 2816)] = f2bf(sigm(v)); } };
struct EpiPoolGrp { bf16_t* Y; const float* ls; int g;
    DEV void operator()(int r, int c, float v, float) const { Y[(size_t)r * 512 + g * 128 + c] = f2bf(v * ls[g * 128 + c]); } };
struct EpiMergeA { bf16_t* MG; const bf16_t* G;
    DEV void operator()(int r, int c, float v, float) const { MG[(size_t)r * DM + c] = f2bf(bf2f(G[(size_t)r * 2048 + c]) * v); } };
struct EpiMergeB { bf16_t* MG; const bf16_t* G;
    DEV void operator()(int r, int c, float v, float) const { const size_t i = (size_t)r * DM + c; MG[i] = f2bf(bf2f(MG[i]) + bf2f(G[(size_t)r * 2048 + 1024 + c]) * v); } };
struct EpiOutProj { const float* x; float* out; const float* mod;
    DEV void operator()(int r, int c, float v, float) const { const size_t i = (size_t)r * DM + c; out[i] = x[i] + mod[(r / SEQ) * NMOD + 2048 + c] * v; } };
struct EpiLogits { float* LG;
    DEV void operator()(int r, int c, float v, float) const { LG[(size_t)r * NE + c] = v; } };
struct EpiAct { bf16_t* ACT;
    DEV void operator()(int r, int c, float v, float v2) const { ACT[(size_t)r * EFF + c] = f2bf(silu(v) * v2); } };
struct EpiSlab { bf16_t* SLAB; const int* rl; const float* w;
    DEV void operator()(int r, int c, float v, float) const { const int s = rl[r]; if (s >= 0) SLAB[(size_t)s * DM + c] = f2bf(v * w[s]); } };
struct EpiFinal { float* out; const bf16_t* SLAB; const float* mod;
    DEV void operator()(int r, int c, float v, float) const {
        float s = v;
#pragma unroll
        for (int k = 0; k < 8; ++k) s += bf2f(SLAB[((size_t)r * 8 + k) * DM + c]);
        const size_t i = (size_t)r * DM + c; out[i] = out[i] + mod[(r / SEQ) * NMOD + 5120 + c] * s; } };

DEV void ph_qknorm(const P& p, int bid, int nb) {
    const int tid_ = otid(); const int lane = tid_ & 63, wv = tid_ >> 6;
    const float gq = p.q_norm_g[lane], gk = p.k_norm_g[lane];
    const float invf = exp2f(-(float)(lane & 7) * (1.f / 8.f) * log2f(500000.f));
    for (int t = bid * NWV + wv; t < T; t += nb * NWV) {
        const float ang = (float)p.pos[t] * invf;
        const float cs = cosf(ang), sn = sinf(ang);
        bf16_t* ptr = p.QKV + (size_t)t * 2304 + lane;
        float v[24];
#pragma unroll
        for (int hh = 0; hh < 24; ++hh) v[hh] = bf2f(ptr[hh * 64]);
#pragma unroll
        for (int hh = 0; hh < 24; ++hh) {
            const float ss = wave_sum(v[hh] * v[hh]);
            float nv = v[hh] * rsqrtf(ss * (1.f / 64.f) + 1e-6f) * (hh < 12 ? gq : gk);
            const float partner = __shfl_xor(nv, 8);
            if (lane < 8) nv = nv * cs - partner * sn;
            else if (lane < 16) nv = nv * cs + partner * sn;
            ptr[hh * 64] = f2bf(nv);
        }
    }
}

template <int R>
DEV void pool_chunk(const unsigned* up, unsigned* op, int s0) {
    constexpr int W = 32 + 2 * R;
    float w0[W], w1[W];
#pragma unroll
    for (int i = 0; i < W; ++i) { const int q = s0 - R + i; const bool ok = (q >= 0) && (q < SEQ); const unsigned w = up[(size_t)min(max(q, 0), SEQ - 1) * 256];
        w0[i] = ok ? __uint_as_float(w << 16) : 0.f; w1[i] = ok ? __uint_as_float(w & 0xffff0000u) : 0.f; }
    float a0 = 0.f, a1 = 0.f;
#pragma unroll
    for (int i = 0; i < 2 * R + 1; ++i) { a0 += w0[i]; a1 += w1[i]; }
#pragma unroll
    for (int j = 0; j < 32; ++j) {
        const int s = s0 + j;
        const int lo = max(s - R, 0), hi = min(s + R, SEQ - 1);
        const float inv = 1.f / (float)(hi - lo + 1);
        op[(size_t)s * 384] = pk2(a0 * inv - w0[j + R], a1 * inv - w1[j + R]);
        if (j < 31) { a0 += w0[j + 2 * R + 1] - w0[j]; a1 += w1[j + 2 * R + 1] - w1[j]; }
    }
}
DEV void ph_pool(const P& p, int bid, int nb) {
    const int tid_ = otid();
    for (int i = bid * NTHR + tid_; i < NB * 64 * 256; i += nb * NTHR) {
        const int cp = i & 255, chunk = (i >> 8) & 63, b = i >> 14;
        const int g = cp >> 6;
        const unsigned* up = (const unsigned*)(p.U + (size_t)b * SEQ * 512) + cp;
        unsigned* op = (unsigned*)(p.PL + (size_t)b * SEQ * 768) + cp;
        const int s0 = chunk * 32;
        if (g == 0) pool_chunk<1>(up, op, s0); else if (g == 1) pool_chunk<2>(up, op, s0); else if (g == 2) pool_chunk<4>(up, op, s0); else pool_chunk<8>(up, op, s0);
    }
}

DEV void ph_attn(const P& p, int bid, int nb) {
    const int tid_ = otid(); const int lane = tid_ & 63, wv = tid_ >> 6;
    for (int it = bid * NWV + wv; it < T * 4; it += nb * NWV) {
        const int t = it >> 2, slot = it & 3;
        const int s = t & (SEQ - 1), base = t - s;
        float M = -1e30f, l = 0.f, acc = 0.f;
#pragma unroll
        for (int g = 0; g < 3; ++g) {
            const int dsh = 2 * g, d = 1 << dsh, L = SEQ >> dsh;
            const int h = 4 * g + slot;
            const int m = s >> dsh, r = s & (d - 1);
            const float q = bf2f(p.QKV[(size_t)t * 2304 + h * 64 + lane]);
            const bf16_t* kb = p.QKV + 768 + h * 64 + lane;
            const bf16_t* vb = p.QKV + 1536 + h * 64 + lane;
#pragma unroll 4
            for (int rel = -64; rel <= 64; ++rel) {
                const int mm = m + rel;
                const bool valid = (mm >= 0) && (mm < L);
                const int mc = valid ? mm : m;
                const size_t tr = (size_t)(base + mc * d + r) * 2304;
                const float kv = bf2f(kb[tr]), vv = bf2f(vb[tr]);
                const float sc = wave_sum(q * kv) * 0.125f;
                if (valid) {
                    const float mn = fmaxf(M, sc);
                    const float f = __expf(M - mn), pe = __expf(sc - mn);
                    l = l * f + pe; acc = acc * f + pe * vv; M = mn;
                }
            }
        }
        p.O[(size_t)t * 256 + slot * 64 + lane] = f2bf(acc / l);
    }
}

DEV void ph_route(const P& p, int* hist, int bid, int nb) {
    const int tid_ = otid(); const int lane = tid_ & 63, wv = tid_ >> 6;
    const int G = lane & 7, tl = lane >> 3;
    float bias[32];
#pragma unroll
    for (int j = 0; j < 8; ++j) { const float4 b4 = *(const float4*)(p.router_bias + G * 32 + 4 * j); bias[4 * j] = b4.x; bias[4 * j + 1] = b4.y; bias[4 * j + 2] = b4.z; bias[4 * j + 3] = b4.w; }
    for (int t0 = (bid * NWV + wv) * 8; t0 < T; t0 += nb * NWV * 8) {
        const int t = t0 + tl;
        float sc[32], v[32];
#pragma unroll
        for (int j = 0; j < 8; ++j) { const float4 lg = *(const float4*)(p.LG + (size_t)t * NE + G * 32 + 4 * j);
            sc[4 * j] = 1.f / (1.f + expf(-lg.x)); sc[4 * j + 1] = 1.f / (1.f + expf(-lg.y)); sc[4 * j + 2] = 1.f / (1.f + expf(-lg.z)); sc[4 * j + 3] = 1.f / (1.f + expf(-lg.w)); }
        float m1 = -INFINITY, m2 = -INFINITY;
#pragma unroll
        for (int j = 0; j < 32; ++j) { v[j] = sc[j] + bias[j]; const float n1 = fmaxf(m1, v[j]), n2 = fmaxf(fminf(m1, v[j]), m2); m1 = n1; m2 = n2; }
        const float gs = m1 + m2;
        int rank = 0;
#pragma unroll
        for (int g2 = 0; g2 < 8; ++g2) { const float o = __shfl(gs, (lane & 56) + g2); rank += ((o > gs) || (o == gs && g2 < G)) ? 1 : 0; }
        const bool gsel = rank < 4;
        int myidx = 0; float myw = 0.f, wsum = 0.f;
#pragma unroll 1
        for (int k = 0; k < 8; ++k) {
            float bv = -INFINITY, bs = 0.f; int bi = 0;
#pragma unroll
            for (int j = 0; j < 32; ++j) { const bool tk = gsel && (v[j] > bv); bv = tk ? v[j] : bv; bs = tk ? sc[j] : bs; bi = tk ? j : bi; }
            int gi = G * 32 + bi;
#define RT_STEP(CTRL) do { const float ov = __uint_as_float(__builtin_amdgcn_update_dpp(0, __float_as_uint(bv), CTRL, 0xf, 0xf, false)), os = __uint_as_float(__builtin_amdgcn_update_dpp(0, __float_as_uint(bs), CTRL, 0xf, 0xf, false)); \
                const int oi = __builtin_amdgcn_update_dpp(0, gi, CTRL, 0xf, 0xf, false); if ((ov > bv) || (ov == bv && oi < gi)) { bv = ov; gi = oi; bs = os; } } while (0)
            RT_STEP(0xB1); RT_STEP(0x4E); RT_STEP(0x141);
#undef RT_STEP
            const int wj = (gi >> 5) == G ? (gi & 31) : -1;
#pragma unroll
            for (int j = 0; j < 32; ++j) v[j] = (j == wj) ? -INFINITY : v[j];
            if (G == k) { myidx = gi; myw = bs; }
            wsum += bs;
        }
        __syncthreads();
        if (tid_ < NE) hist[tid_] = 0;
        __syncthreads();
        const int lpos = atomicAdd(&hist[myidx], 1);
        __syncthreads();
        if (tid_ < NE) { const int c_ = hist[tid_]; hist[NE + tid_] = c_ ? atomicAdd(&p.cnt[tid_ * 64], c_) : 0; }
        __syncthreads();
        const int slot = t * 8 + G;
        p.asg_e[slot] = myidx; p.asg_pos[slot] = hist[NE + myidx] + lpos; p.asg_w[slot] = myw / wsum * 2.5f;
    }
}

DEV void load_offsets(const int* cnt, int* off) {
    const int tid = otid();
    __syncthreads();
    if (tid < NE) { const int c_ = cnt[tid * 64]; off[300 + tid] = (c_ + 255) & ~255; off[600 + tid] = c_; }
    __syncthreads();
    if (tid == 0) { int a = 0; for (int e = 0; e < NE; ++e) { off[e] = a; a += off[300 + e]; } off[NE] = a;
        const int x = blockIdx.x & 7; int tf = 0, th = 0;
        for (int j = 0; j < 32; ++j) { const int n_ = off[600 + x + 8 * j], nt_ = (n_ + 255) >> 8, hh = (nt_ > 0 && n_ - (nt_ - 1) * 256 <= 128) ? 1 : 0;
            off[860 + j] = tf; off[900 + j] = th; tf += nt_ - hh; th += hh; }
        off[860 + 32] = tf; off[900 + 32] = th; }
    __syncthreads();
}
DEV int find_expert(const int* off, int m0) {
    int lo = 0, hi = NE;
    while (hi - lo > 1) { const int mid = (lo + hi) >> 1; if (off[mid] <= m0) lo = mid; else hi = mid; }
    return lo;
}

DEV void ph_scatter(const P& p, int* off, int bid, int nb) {
    load_offsets(p.cnt, off);
    const int tid_ = otid();
    for (int slot = bid * NTHR + tid_; slot < NSLOT; slot += nb * NTHR) { const int r = off[p.asg_e[slot]] + p.asg_pos[slot]; p.rowlist[r] = slot; p.roww[r] = p.asg_w[slot]; }
    for (int e = bid; e < NE; e += nb) {
        const int n = p.cnt[e * 64], pd = (n + 255) & ~255;
        for (int i = n + tid_; i < pd; i += NTHR) { p.rowlist[off[e] + i] = -1; p.roww[off[e] + i] = 0.f; }
    }
}

DEV void ph_expert1(const P& p, float* sm, int* off, int bid, int nb) {
    load_offsets(p.cnt, off);
    const int nrt = off[NE] / 128, nt = nrt * 4;
    for (int t = bid; t < nt; t += nb) {
        const int m0 = (t >> 2) * 128, n0 = (t & 3) * 64, e = find_expert(off, m0);
        ngemm_tile<true>(p.XB, DM, RowTok{p.rowlist}, p.w_eg + (size_t)e * DM * EFF, p.w_eu + (size_t)e * DM * EFF, EFF, m0, n0, DM, EpiAct{p.ACT}, sm);
    }
}
DEV void ph_expert2(const P& p, float* sm, int* off, int bid, int nb) {
    load_offsets(p.cnt, off);
    const int nrt = off[NE] / 128, nt = nrt * 16;
    for (int t = bid; t < nt; t += nb) {
        const int m0 = (t >> 4) * 128, n0 = (t & 15) * 64, e = find_expert(off, m0);
        ngemm_tile<false>(p.ACT, EFF, RowId(), p.w_ed + (size_t)e * EFF * DM, nullptr, DM, m0, n0, EFF, EpiSlab{p.SLAB, p.rowlist, p.asg_w}, sm);
    }
}

namespace mg {
constexpr int BM = 256, BK = 64, HALF = 128, HTB = HALF * BK * 2, STAGE_BYTES = 8 * HTB, NXCD = 8, WGM = 8;
__host__ __device__ __forceinline__ int lds_byte(int r, int c) { const int st = (r >> 4) * 2 + (c >> 5), rr = r & 15, cc = c & 31, ob = rr * 64 + cc * 2; return st * 1024 + (ob ^ (((ob >> 9) & 1) << 5)); }
__host__ __device__ __forceinline__ void stage_rc(int b, int& R, int& C) { const int st = b / 1024, sb = b % 1024, swz = sb ^ (((sb >> 9) & 1) << 5); R = (st >> 1) * 16 + swz / 64; C = (st & 1) * 32 + (swz % 64) / 2; }
__host__ __device__ __forceinline__ int perm32(int rho) { const int n = rho >> 4, i = rho & 15; return 8 * (i >> 2) + 4 * n + (i & 3); }

struct Unit { int pm, pn, e, pad, half, pad2; const char* A; const char* B; };

struct DenseOrder { static constexpr bool HAS_HALF = false;
    int nM, nN, nwg, G, c; const char* A; const char* B; size_t tstep;
    DEV void init(const bf16_t* A_, const bf16_t* B_, int M, int N, int K, int G_, int c_) { nM = M / BM; nN = N / BM; nwg = nM * nN; G = G_; c = c_; A = (const char*)A_; B = (const char*)B_; tstep = (size_t)BM * K * 2; }
    DEV bool next(int i, Unit& u) const {
        const long L = (long)i * G + c; if (L >= nwg) return false;
        int wgid = (int)L; { const int q = nwg / NXCD, r = nwg % NXCD, xcd = wgid % NXCD, off = wgid / NXCD; wgid = (xcd < r ? xcd * (q + 1) : r * (q + 1) + (xcd - r) * q) + off; }
        const int nig = WGM * nN, gid = wgid / nig, fm = gid * WGM, gsz = (nM - fm) < WGM ? (nM - fm) : WGM;
        u.pm = fm + ((wgid % nig) % gsz); u.pn = (wgid % nig) / gsz; u.e = 0; u.pad = 0; u.half = 0; u.pad2 = 0;
        u.A = A + (size_t)u.pm * tstep; u.B = B + (size_t)u.pn * tstep; return true;
    }
};
struct PairOrder { static constexpr bool HAS_HALF = false; DenseOrder D; int kt0, kt1;
    DEV bool next(int i, Unit& u) const { if (!D.next(i >> 1, u)) return false; const int part = i & 1; u.e = part; u.pad = part ? kt1 : kt0;
        if (part) { u.A += (size_t)kt0 * 128; u.B += (size_t)kt0 * 128; } return true; }
};
struct ExpertOrder { static constexpr bool HAS_HALF = true;
    const LAS int* off; int ncol, G, c; const char* A; const char* W; size_t wstride, tstepB, tstepA; bool gather; const int* rl; int maxu;
    DEV bool tile_of(int i, int& pm, int& pn, int& e) const {
        const int x = c & 7, cl = c >> 3, nbx = G >> 3;
        const int Lx = i * nbx + cl; int tx = Lx / ncol; pn = Lx % ncol;
        const int ftot = off[860 + 32], htot = off[900 + 32];
        if (tx >= ftot + htot) return false;
        const bool isf = tx < ftot; const int tb = isf ? 860 : 900; if (!isf) tx -= ftot;
        int lo = 0, hi = 32;
        while (hi - lo > 1) { const int mid = (lo + hi) >> 1; if (off[tb + mid] <= tx) lo = mid; else hi = mid; }
        e = x + 8 * lo;
        const int nfull = off[860 + lo + 1] - off[860 + lo];
        pm = (off[e] >> 8) + (isf ? (tx - off[860 + lo]) : nfull);
        return true;
    }
    static constexpr int UT0 = 1024, UTN = 64;
    DEV void build_table(LAS int* offw, int tid) const {
        if (tid < UTN) { int pm = 0, pn = 0, e = 0; const bool ok = tile_of(tid, pm, pn, e);
            const int hf = ok ? ((off[600 + e] - (pm * BM - off[e]) <= HALF) ? 1 : 0) : 0;
            offw[UT0 + 4 * tid] = pm; offw[UT0 + 4 * tid + 1] = pn; offw[UT0 + 4 * tid + 2] = e | (hf << 16); offw[UT0 + 4 * tid + 3] = ok ? 1 : 0; }
    }
    DEV bool next(int i, Unit& u) const {
        int pm, pn, e, hf;
        if (i < UTN) { if (__builtin_amdgcn_readfirstlane(off[UT0 + 4 * i + 3]) == 0) return false;
            pm = __builtin_amdgcn_readfirstlane(off[UT0 + 4 * i]); pn = __builtin_amdgcn_readfirstlane(off[UT0 + 4 * i + 1]);
            const int eh = __builtin_amdgcn_readfirstlane(off[UT0 + 4 * i + 2]); e = eh & 0xffff; hf = eh >> 16; }
        else { if (!tile_of(i, pm, pn, e)) return false; pm = __builtin_amdgcn_readfirstlane(pm); pn = __builtin_amdgcn_readfirstlane(pn); e = __builtin_amdgcn_readfirstlane(e);
            hf = (__builtin_amdgcn_readfirstlane(off[600 + e]) - (pm * BM - __builtin_amdgcn_readfirstlane(off[e])) <= HALF) ? 1 : 0; }
        u.pm = pm; u.pn = pn; u.e = e; u.pad = 0; u.pad2 = 0; u.half = hf;
        u.A = gather ? A : A + (size_t)pm * tstepA; u.B = W + (size_t)e * wstride + (size_t)pn * tstepB; return true;
    }
};

template <class Epi, class Sched, bool GATHER>
DEV void gemm_phase(LAS unsigned char* lds, const LAS unsigned* gtab, const int K, const Sched& S, const Epi& E) {
    const int tid = otid(), wid = __builtin_amdgcn_readfirstlane(tid >> 6), lane = tid & 63, wr = wid >> 2, wc = wid & 3, fr = lane & 15, fq = lane >> 4;
    const int nt = K / BK;
    int Rr[2], Cc[2]; unsigned voffB[2];
#pragma unroll
    for (int i = 0; i < 2; ++i) { stage_rc(tid * 16 + i * 8192, Rr[i], Cc[i]); const int Rb = Epi::PERM ? ((Rr[i] & ~31) + perm32(Rr[i] & 31)) : Rr[i]; voffB[i] = (unsigned)(Rb * K + Cc[i]) * 2u; }
    const size_t kstep = (size_t)(BK * 2);
    const size_t hstep = (size_t)HALF * K * 2;
    const unsigned ldsw = (unsigned)wid * 1024u;
    const int aoff = lds_byte(wr * 64 + fr, fq * 8), boff = lds_byte(wc * 32 + fr, fq * 8);
#define MG_SA(b, h) (((b) * 2 + (h)) * HTB)
#define MG_SB(b, h) ((4 + (b) * 2 + (h)) * HTB)
#define MG_STAGE(bufoff, gbase, voff) do { _Pragma("unroll") for (int _i = 0; _i < 2; ++_i) \
        __builtin_amdgcn_global_load_lds((const unsigned*)((const char*)(gbase) + (voff)[_i]), (LAS unsigned*)(lds + (bufoff) + ldsw + _i * 8192), 16, 0, 0); } while (0)
#define MG_LDA(dst, b, h) do { _Pragma("unroll") for (int m = 0; m < 4; ++m) _Pragma("unroll") for (int k = 0; k < 2; ++k) dst[m][k] = *(const LAS bf16x8*)(lds + MG_SA(b, h) + aoff + m * 2048 + k * 1024); } while (0)
#define MG_LDB(dst, b, h) do { _Pragma("unroll") for (int n = 0; n < 2; ++n) _Pragma("unroll") for (int k = 0; k < 2; ++k) dst[n][k] = *(const LAS bf16x8*)(lds + MG_SB(b, h) + boff + n * 2048 + k * 1024); } while (0)
#define MG_MMA(ai, bj, At, Bt) do { __builtin_amdgcn_s_setprio(1); _Pragma("unroll") for (int m = 0; m < 4; ++m) _Pragma("unroll") for (int n = 0; n < 2; ++n) _Pragma("unroll") for (int k = 0; k < 2; ++k) \
        acc[ai][bj][m][n] = __builtin_amdgcn_mfma_f32_16x16x32_bf16(Bt[n][k], At[m][k], acc[ai][bj][m][n], 0, 0, 0); __builtin_amdgcn_s_setprio(0); } while (0)
#define MG_WAIT_V(n) asm volatile("s_waitcnt vmcnt(" #n ")" ::: "memory")
#define MG_WAIT_L(n) asm volatile("s_waitcnt lgkmcnt(" #n ")" ::: "memory")
#define MG_BAR __builtin_amdgcn_s_barrier()
#define MG_SCHED __builtin_amdgcn_sched_barrier(0)
    Unit cur, nxt; int ui = 0;
    if (!S.next(0, cur)) return;
    int ntc = cur.pad > 0 ? cur.pad : nt;
    bool hf = Sched::HAS_HALF && (cur.half != 0);
    f32x4 acc[2][2][4][2];
#pragma unroll
    for (int a = 0; a < 2; ++a)
#pragma unroll
        for (int b = 0; b < 2; ++b)
#pragma unroll
            for (int m = 0; m < 4; ++m)
#pragma unroll
                for (int n = 0; n < 2; ++n) acc[a][b][m][n] = (f32x4){0.f, 0.f, 0.f, 0.f};
    bf16x8 At[4][2], B0[2][2], B1[2][2];
    unsigned va0[2], va1[2], na0[2], na1[2];
#pragma unroll
    for (int i = 0; i < 2; ++i) {
        if (GATHER) { va0[i] = gtab[Rr[i]] + (unsigned)Cc[i] * 2u; va1[i] = gtab[HALF + Rr[i]] + (unsigned)Cc[i] * 2u; }
        else { va0[i] = (unsigned)(Rr[i] * K + Cc[i]) * 2u; va1[i] = va0[i] + (unsigned)hstep; }
        na0[i] = va0[i]; na1[i] = va1[i];
    }
    const char* cA = cur.A; const char* cB = cur.B;
    MG_STAGE(MG_SB(0, 0), cB, voffB); MG_STAGE(MG_SB(0, 1), cB + hstep, voffB); MG_STAGE(MG_SA(0, 0), cA, va0); MG_STAGE(MG_SA(0, 1), cA, va1);
    if (wr == 1) MG_BAR;
    MG_WAIT_V(2); MG_BAR;
    MG_STAGE(MG_SB(1, 0), cB + kstep, voffB); MG_STAGE(MG_SA(1, 0), cA + kstep, va0); MG_STAGE(MG_SB(1, 1), cB + hstep + kstep, voffB);
    MG_WAIT_V(6); MG_BAR;
    for (;;) {
        if constexpr (Epi::ROWTAB) E.prefetch(cur, (LAS unsigned char*)gtab + (ui & 1) * 2048, wid, lane);
        const bool has_next = S.next(ui + 1, nxt);
        const char* nA = has_next ? nxt.A : cA; const char* nB = has_next ? nxt.B : cB;
        if constexpr (GATHER) {
            if (has_next) {
                if (ui + 1 < S.maxu) {
#pragma unroll
                    for (int i = 0; i < 2; ++i) { na0[i] = gtab[(ui + 1) * BM + Rr[i]] + (unsigned)Cc[i] * 2u; na1[i] = gtab[(ui + 1) * BM + HALF + Rr[i]] + (unsigned)Cc[i] * 2u; }
                } else {
#pragma unroll
                    for (int i = 0; i < 2; ++i) { const int s0_ = S.rl[nxt.pm * BM + Rr[i]], s1_ = S.rl[nxt.pm * BM + HALF + Rr[i]];
                        na0[i] = (unsigned)(s0_ < 0 ? 0 : (s0_ >> 3)) * (unsigned)(K * 2) + (unsigned)Cc[i] * 2u; na1[i] = (unsigned)(s1_ < 0 ? 0 : (s1_ >> 3)) * (unsigned)(K * 2) + (unsigned)Cc[i] * 2u; }
                }
            }
        }
#pragma unroll 1
        for (int t = 0; t < ntc; t += 2) {
            const bool last = (t == ntc - 2);
            const char* a1 = cA + (size_t)(t + 1) * kstep;
            const char* a2 = last ? nA : cA + (size_t)(t + 2) * kstep; const char* b2 = last ? nB : cB + (size_t)(t + 2) * kstep;
            const char* a3 = a2 + kstep; const char* b3 = b2 + kstep;
            unsigned o0[2], o1[2];
#pragma unroll
            for (int i = 0; i < 2; ++i) { o0[i] = (GATHER && last) ? na0[i] : va0[i]; o1[i] = (GATHER && last) ? na1[i] : va1[i]; }
            MG_LDB(B0, 0, 0); MG_LDB(B1, 0, 1); MG_SCHED; MG_LDA(At, 0, 0); MG_STAGE(MG_SA(1, 1), a1, va1);
            MG_WAIT_V(8); MG_WAIT_L(0); MG_BAR; MG_MMA(0, 0, At, B0); MG_MMA(0, 1, At, B1); MG_BAR; MG_SCHED;
            if (!hf) MG_LDA(At, 0, 1); MG_STAGE(MG_SB(0, 0), b2, voffB); MG_STAGE(MG_SB(0, 1), b2 + hstep, voffB); MG_STAGE(MG_SA(0, 0), a2, o0);
            MG_WAIT_V(8); MG_WAIT_L(0); MG_BAR; if (!hf) { MG_MMA(1, 0, At, B0); MG_MMA(1, 1, At, B1); } MG_BAR; MG_SCHED;
            MG_LDB(B0, 1, 0); MG_LDB(B1, 1, 1); MG_SCHED; MG_LDA(At, 1, 0); MG_STAGE(MG_SA(0, 1), a2, o1);
            MG_WAIT_V(8); MG_WAIT_L(0); MG_BAR; MG_MMA(0, 0, At, B0); MG_MMA(0, 1, At, B1); MG_BAR; MG_SCHED;
            if (!hf) MG_LDA(At, 1, 1); MG_STAGE(MG_SB(1, 0), b3, voffB); MG_STAGE(MG_SB(1, 1), b3 + hstep, voffB); MG_STAGE(MG_SA(1, 0), a3, o0);
            MG_WAIT_V(8); MG_WAIT_L(0); MG_BAR; if (!hf) { MG_MMA(1, 0, At, B0); MG_MMA(1, 1, At, B1); } MG_BAR; MG_SCHED;
        }
        if (wr == 0) MG_BAR;
        if constexpr (Epi::ROWTAB) E.epi_tab(acc, cur, wr, wc, fr, fq, (const LAS unsigned char*)gtab + (ui & 1) * 2048);
        else E(acc, cur, wr, wc, fr, fq);
        if (!has_next) break;
        if (!(Epi::KEEP_ACC && cur.e == 0)) {
#pragma unroll
        for (int a = 0; a < 2; ++a)
#pragma unroll
            for (int b = 0; b < 2; ++b)
#pragma unroll
                for (int m = 0; m < 4; ++m)
#pragma unroll
                    for (int n = 0; n < 2; ++n) acc[a][b][m][n] = (f32x4){0.f, 0.f, 0.f, 0.f};
        }
        cur = nxt; cA = nA; cB = nB; ++ui; ntc = cur.pad > 0 ? cur.pad : nt; hf = Sched::HAS_HALF && (cur.half != 0);
#pragma unroll
        for (int i = 0; i < 2; ++i) { va0[i] = na0[i]; va1[i] = na1[i]; }
        if (wr == 1) MG_BAR;
    }
    MG_WAIT_V(0);
    MG_BAR;
    __syncthreads();
#undef MG_SA
#undef MG_SB
#undef MG_STAGE
#undef MG_LDA
#undef MG_LDB
#undef MG_MMA
#undef MG_WAIT_V
#undef MG_WAIT_L
#undef MG_BAR
#undef MG_SCHED
}

DEV u32x4 pack8(const f32x4 a, const f32x4 b) { u32x4 w; w.x = pk2(a[0], a[1]); w.y = pk2(a[2], a[3]); w.z = pk2(b[0], b[1]); w.w = pk2(b[2], b[3]); return w; }
DEV f32x4 unpack_lo(const u32x4 w) { return (f32x4){__uint_as_float(w.x << 16), __uint_as_float(w.x & 0xffff0000u), __uint_as_float(w.y << 16), __uint_as_float(w.y & 0xffff0000u)}; }
DEV f32x4 unpack_hi(const u32x4 w) { return (f32x4){__uint_as_float(w.z << 16), __uint_as_float(w.z & 0xffff0000u), __uint_as_float(w.w << 16), __uint_as_float(w.w & 0xffff0000u)}; }
DEV f32x4 sig4(const f32x4 v) { return (f32x4){sigm(v[0]), sigm(v[1]), sigm(v[2]), sigm(v[3])}; }
DEV f32x4 silu4(const f32x4 v) { return (f32x4){silu(v[0]), silu(v[1]), silu(v[2]), silu(v[3])}; }
#define ACC_T f32x4 (&acc)[2][2][4][2]

struct MEpiInProj { static constexpr bool PERM = true; static constexpr bool KEEP_ACC = false; static constexpr bool ROWTAB = false; bf16_t *U, *QKV, *G;
    DEV void operator()(ACC_T, const Unit& u, int wr, int wc, int fr, int fq) const {
        int colt = u.pn * BM; bf16_t* base; int ld; bool sg = false;
        if (colt < 512) { base = U; ld = 512; } else if (colt < 2816) { base = QKV; ld = 2304; colt -= 512; } else { base = G; ld = 2048; colt -= 2816; sg = true; }
        const int row0 = u.pm * BM + wr * 64 + fr, col0 = colt + wc * 32 + 8 * fq;
#pragma unroll
        for (int ai = 0; ai < 2; ++ai)
#pragma unroll
            for (int m = 0; m < 4; ++m) { bf16_t* rowp = base + (size_t)(row0 + ai * HALF + m * 16) * ld + col0;
#pragma unroll
                for (int bj = 0; bj < 2; ++bj) { f32x4 v0 = acc[ai][bj][m][0], v1 = acc[ai][bj][m][1]; if (sg) { v0 = sig4(v0); v1 = sig4(v1); }
                    *(u32x4*)(rowp + bj * HALF) = pack8(v0, v1); }
                asm volatile("" ::: "memory"); }
    } };
struct MEpiMergeF { static constexpr bool PERM = true; static constexpr bool KEEP_ACC = true; static constexpr bool ROWTAB = false; bf16_t* MG; const bf16_t* G;
    DEV void mid(f32x4 (&acc)[2][2][4][2], const Unit& u, int wr, int wc, int fr, int fq) const {
        const int row0 = u.pm * BM + wr * 64 + fr, col0 = u.pn * BM + wc * 32 + 8 * fq;
        u32x4 ga[4], gb[4];
        { const bf16_t* gr = G + (size_t)row0 * 2048 + col0;
          ga[0] = *(const u32x4*)gr; ga[1] = *(const u32x4*)(gr + HALF); ga[2] = *(const u32x4*)(gr + 1024); ga[3] = *(const u32x4*)(gr + 1024 + HALF); }
#pragma unroll
        for (int gi = 0; gi < 8; ++gi) { const int ai = gi >> 2, m = gi & 3;
            if (gi < 7) { const bf16_t* gr = G + (size_t)(row0 + ((gi + 1) >> 2) * HALF + ((gi + 1) & 3) * 16) * 2048 + col0;
                if (gi & 1) { ga[0] = *(const u32x4*)gr; ga[1] = *(const u32x4*)(gr + HALF); ga[2] = *(const u32x4*)(gr + 1024); ga[3] = *(const u32x4*)(gr + 1024 + HALF); }
                else { gb[0] = *(const u32x4*)gr; gb[1] = *(const u32x4*)(gr + HALF); gb[2] = *(const u32x4*)(gr + 1024); gb[3] = *(const u32x4*)(gr + 1024 + HALF); } }
#pragma unroll
            for (int bj = 0; bj < 2; ++bj) { const u32x4 gp_ = (gi & 1) ? gb[bj] : ga[bj], gq_ = (gi & 1) ? gb[2 + bj] : ga[2 + bj];
                const f32x4 pl = unpack_lo(gp_), ph = unpack_hi(gp_), al = unpack_lo(gq_), ah = unpack_hi(gq_);
                acc[ai][bj][m][0] *= (f32x4){pl[0] * __builtin_amdgcn_rcpf(al[0]), pl[1] * __builtin_amdgcn_rcpf(al[1]), pl[2] * __builtin_amdgcn_rcpf(al[2]), pl[3] * __builtin_amdgcn_rcpf(al[3])};
                acc[ai][bj][m][1] *= (f32x4){ph[0] * __builtin_amdgcn_rcpf(ah[0]), ph[1] * __builtin_amdgcn_rcpf(ah[1]), ph[2] * __builtin_amdgcn_rcpf(ah[2]), ph[3] * __builtin_amdgcn_rcpf(ah[3])}; }
            asm volatile("" ::: "memory"); }
    }
    DEV void operator()(f32x4 (&acc)[2][2][4][2], const Unit& u, int wr, int wc, int fr, int fq) const {
        if (u.e == 0) { mid(acc, u, wr, wc, fr, fq); return; }
        const int row0 = u.pm * BM + wr * 64 + fr, col0 = u.pn * BM + wc * 32 + 8 * fq;
        u32x4 ga[2], gb[2];
        { const bf16_t* gr = G + (size_t)row0 * 2048 + 1024 + col0; ga[0] = *(const u32x4*)gr; ga[1] = *(const u32x4*)(gr + HALF); }
#pragma unroll
        for (int gi = 0; gi < 8; ++gi) { const int ai = gi >> 2, m = gi & 3; const size_t r = (size_t)(row0 + ai * HALF + m * 16);
            if (gi < 7) { const bf16_t* gr = G + (size_t)(row0 + ((gi + 1) >> 2) * HALF + ((gi + 1) & 3) * 16) * 2048 + 1024 + col0;
                if (gi & 1) { ga[0] = *(const u32x4*)gr; ga[1] = *(const u32x4*)(gr + HALF); } else { gb[0] = *(const u32x4*)gr; gb[1] = *(const u32x4*)(gr + HALF); } }
#pragma unroll
            for (int bj = 0; bj < 2; ++bj) { const u32x4 gq_ = (gi & 1) ? gb[bj] : ga[bj];
                *(u32x4*)(MG + r * DM + col0 + bj * HALF) = pack8(acc[ai][bj][m][0] * unpack_lo(gq_), acc[ai][bj][m][1] * unpack_hi(gq_)); }
            asm volatile("" ::: "memory"); }
    } };
struct MEpiOutProj { static constexpr bool PERM = false; static constexpr bool KEEP_ACC = false; static constexpr bool ROWTAB = false; const float* x; float* out; const float* mod;
    DEV void operator()(ACC_T, const Unit& u, int wr, int wc, int fr, int fq) const {
        const int row0 = u.pm * BM + wr * 64 + fr, col0 = u.pn * BM + wc * 32 + 4 * fq;
        const float* gm = mod + ((u.pm * BM) / SEQ) * NMOD + 2048 + col0;
        f32x4 gv[4];
#pragma unroll
        for (int q = 0; q < 4; ++q) gv[q] = *(const f32x4*)(gm + (q >> 1) * HALF + (q & 1) * 16);
        f32x4 xa[4], xb[4];
        { const float* xp = x + (size_t)row0 * DM + col0;
#pragma unroll
          for (int q = 0; q < 4; ++q) xa[q] = *(const f32x4*)(xp + (q >> 1) * HALF + (q & 1) * 16); }
#pragma unroll
        for (int gi = 0; gi < 8; ++gi) { const int ai = gi >> 2, m = gi & 3; const size_t r = (size_t)(row0 + ai * HALF + m * 16) * DM + col0;
            if (gi < 7) { const int ai2 = (gi + 1) >> 2, m2 = (gi + 1) & 3; const float* xp = x + (size_t)(row0 + ai2 * HALF + m2 * 16) * DM + col0;
#pragma unroll
                for (int q = 0; q < 4; ++q) { if (gi & 1) xa[q] = *(const f32x4*)(xp + (q >> 1) * HALF + (q & 1) * 16); else xb[q] = *(const f32x4*)(xp + (q >> 1) * HALF + (q & 1) * 16); } }
#pragma unroll
            for (int q = 0; q < 4; ++q) { const f32x4 xv = (gi & 1) ? xb[q] : xa[q];
                *(f32x4*)(out + r + (q >> 1) * HALF + (q & 1) * 16) = xv + gv[q] * acc[ai][q >> 1][m][q & 1]; }
            asm volatile("" ::: "memory"); }
    } };
struct MEpiRouterShared { static constexpr bool PERM = true; static constexpr bool KEEP_ACC = false; static constexpr bool ROWTAB = false; float* LG; bf16_t* HS;
    DEV void operator()(ACC_T, const Unit& u, int wr, int wc, int fr, int fq) const {
        const int row0 = u.pm * BM + wr * 64 + fr, cw = wc * 32 + 8 * fq;
#pragma unroll
        for (int ai = 0; ai < 2; ++ai)
#pragma unroll
            for (int m = 0; m < 4; ++m) { const size_t r = (size_t)(row0 + ai * HALF + m * 16);
                if (u.pn == 0) {
#pragma unroll
                    for (int bj = 0; bj < 2; ++bj)
#pragma unroll
                        for (int n = 0; n < 2; ++n) *(f32x4*)(LG + r * NE + bj * HALF + cw + 4 * n) = acc[ai][bj][m][n];
                } else {
                    const f32x4 v0 = silu4(acc[ai][0][m][0]) * acc[ai][1][m][0], v1 = silu4(acc[ai][0][m][1]) * acc[ai][1][m][1];
                    *(u32x4*)(HS + r * EFF + (u.pn - 1) * HALF + cw) = pack8(v0, v1);
                }
                asm volatile("" ::: "memory"); }
    } };
struct MEpiAct { static constexpr bool PERM = true; static constexpr bool KEEP_ACC = false; static constexpr bool ROWTAB = false; bf16_t* ACT;
    DEV void operator()(ACC_T, const Unit& u, int wr, int wc, int fr, int fq) const {
        const int row0 = u.pm * BM + wr * 64 + fr, cw = u.pn * HALF + wc * 32 + 8 * fq;
#pragma unroll
        for (int ai = 0; ai < 2; ++ai) { if (ai == 1 && u.half) break;
#pragma unroll
            for (int m = 0; m < 4; ++m) { const size_t r = (size_t)(row0 + ai * HALF + m * 16);
                const f32x4 v0 = silu4(acc[ai][0][m][0]) * acc[ai][1][m][0], v1 = silu4(acc[ai][0][m][1]) * acc[ai][1][m][1];
                *(u32x4*)(ACT + r * EFF + cw) = pack8(v0, v1); asm volatile("" ::: "memory"); } }
    } };
constexpr float SLAB_SCALE = 4.f, SLAB_INV = 0.25f;
DEV unsigned pk4_fp8(float a, float b, float c, float d) {
    a = __builtin_amdgcn_fmed3f(a, -440.f, 440.f); b = __builtin_amdgcn_fmed3f(b, -440.f, 440.f); c = __builtin_amdgcn_fmed3f(c, -440.f, 440.f); d = __builtin_amdgcn_fmed3f(d, -440.f, 440.f);
    int w = 0; w = __builtin_amdgcn_cvt_pk_fp8_f32(a, b, w, false); w = __builtin_amdgcn_cvt_pk_fp8_f32(c, d, w, true); return (unsigned)w; }
struct MEpiSlab { static constexpr bool PERM = true; static constexpr bool KEEP_ACC = false; static constexpr bool ROWTAB = true; unsigned char* SLAB; const int* rl; const float* w;
    DEV void prefetch(const Unit& u, LAS unsigned char* tab, int wid, int lane) const {
        const int rr = (wid & 3) * 64 + lane;
        const unsigned* src = (wid < 4) ? (const unsigned*)(rl + u.pm * BM + rr) : (const unsigned*)(w + u.pm * BM + rr);
        __builtin_amdgcn_global_load_lds(src, (LAS unsigned*)(tab + wid * 256), 4, 0, 0);
    }
    DEV void epi_tab(ACC_T, const Unit& u, int wr, int wc, int fr, int fq, const LAS unsigned char* tab) const {
        const int rloc = wr * 64 + fr, c16 = u.pn * BM + wc * 64 + 16 * fq;
#pragma unroll
        for (int ai = 0; ai < 2; ++ai) { if (ai == 1 && u.half) break;
#pragma unroll
            for (int m = 0; m < 4; ++m) { const int rr = rloc + ai * HALF + m * 16;
                const int s = *(const LAS int*)(tab + rr * 4); const float g = *(const LAS float*)(tab + 1024 + rr * 4) * SLAB_SCALE;
                if (s >= 0) { u32x4 o;
                    { const f32x4 a = acc[ai][0][m][0] * g, b = acc[ai][0][m][1] * g; o.x = pk4_fp8(a[0], a[1], a[2], a[3]); o.y = pk4_fp8(b[0], b[1], b[2], b[3]); }
                    { const f32x4 a = acc[ai][1][m][0] * g, b = acc[ai][1][m][1] * g; o.z = pk4_fp8(a[0], a[1], a[2], a[3]); o.w = pk4_fp8(b[0], b[1], b[2], b[3]); }
                    *(u32x4*)(SLAB + (size_t)s * DM + c16) = o; }
                asm volatile("" ::: "memory"); } }
    }
    DEV void operator()(ACC_T, const Unit& u, int wr, int wc, int fr, int fq) const {}
};
DEV void acc4_fp8(f32x4& a, unsigned w) { const auto lo = __builtin_amdgcn_cvt_pk_f32_fp8((int)w, false), hi = __builtin_amdgcn_cvt_pk_f32_fp8((int)w, true); a[0] += lo[0]; a[1] += lo[1]; a[2] += hi[0]; a[3] += hi[1]; }
struct MEpiFinal { static constexpr bool PERM = true; static constexpr bool KEEP_ACC = false; static constexpr bool ROWTAB = false; float* out; const unsigned char* SLAB; const float* mod;
    DEV void operator()(ACC_T, const Unit& u, int wr, int wc, int fr, int fq) const {
        const int row0 = u.pm * BM + wr * 64 + fr, c16 = u.pn * BM + wc * 64 + 16 * fq;
        const float* gm = mod + ((u.pm * BM) / SEQ) * NMOD + 5120 + c16;
#pragma unroll
        for (int ai = 0; ai < 2; ++ai)
#pragma unroll
            for (int m = 0; m < 4; ++m) { const size_t row = (size_t)(row0 + ai * HALF + m * 16);
                const unsigned char* sp = SLAB + row * 8 * DM + c16;
                float* op = out + row * DM + c16;
                u32x4 sw[8]; f32x4 x[4];
#pragma unroll
                for (int k = 0; k < 8; ++k) sw[k] = *(const u32x4*)(sp + (size_t)k * DM);
#pragma unroll
                for (int q = 0; q < 4; ++q) x[q] = *(const f32x4*)(op + 4 * q);
                f32x4 s4[4];
#pragma unroll
                for (int q = 0; q < 4; ++q) s4[q] = (f32x4){0.f, 0.f, 0.f, 0.f};
#pragma unroll
                for (int k = 0; k < 8; ++k) { acc4_fp8(s4[0], sw[k].x); acc4_fp8(s4[1], sw[k].y); acc4_fp8(s4[2], sw[k].z); acc4_fp8(s4[3], sw[k].w); }
                s4[0] = s4[0] * SLAB_INV + acc[ai][0][m][0]; s4[1] = s4[1] * SLAB_INV + acc[ai][0][m][1]; s4[2] = s4[2] * SLAB_INV + acc[ai][1][m][0]; s4[3] = s4[3] * SLAB_INV + acc[ai][1][m][1];
#pragma unroll
                for (int q = 0; q < 4; ++q) *(f32x4*)(op + 4 * q) = x[q] + *(const f32x4*)(gm + 4 * q) * s4[q];
                asm volatile("" ::: "memory"); }
    } };
#undef ACC_T
}

typedef float f32x16 __attribute__((ext_vector_type(16)));
typedef short s16x4 __attribute__((ext_vector_type(4)));
DEV int crow(int r, int hi) { return (r & 3) + 8 * (r >> 2) + 4 * hi; }
DEV unsigned cvtpk(float lo, float hi) { unsigned r; asm("v_cvt_pk_bf16_f32 %0, %1, %2" : "=v"(r) : "v"(lo), "v"(hi)); return r; }
DEV s16x4 vtr(const LAS unsigned char* p) { return __builtin_bit_cast(s16x4, __builtin_amdgcn_ds_read_tr16_b64_v4i16((LAS s16x4*)p)); }
DEV float swap32(float v) { const auto rr = __builtin_amdgcn_permlane32_swap(__float_as_uint(v), __float_as_uint(v), false, false); return __uint_as_float((threadIdx.x & 32) ? rr[0] : rr[1]); }

DEV void normrope_frag(bf16x8 (&f)[4], const LAS float* gt, int hi, float posf) {
    float x[32]; float ss = 0.f;
#pragma unroll
    for (int d0 = 0; d0 < 4; ++d0) { const u32x4 w = __builtin_bit_cast(u32x4, f[d0]);
        x[8 * d0 + 0] = __uint_as_float(w.x << 16); x[8 * d0 + 1] = __uint_as_float(w.x & 0xffff0000u); x[8 * d0 + 2] = __uint_as_float(w.y << 16); x[8 * d0 + 3] = __uint_as_float(w.y & 0xffff0000u);
        x[8 * d0 + 4] = __uint_as_float(w.z << 16); x[8 * d0 + 5] = __uint_as_float(w.z & 0xffff0000u); x[8 * d0 + 6] = __uint_as_float(w.w << 16); x[8 * d0 + 7] = __uint_as_float(w.w & 0xffff0000u); }
#pragma unroll
    for (int i = 0; i < 32; ++i) ss += x[i] * x[i];
    ss += swap32(ss);
    const float rs = rsqrtf(ss * (1.f / 64.f) + 1e-6f);
#pragma unroll
    for (int d0 = 0; d0 < 4; ++d0) { const f32x4 g0 = *(const LAS f32x4*)(gt + 16 * d0 + 8 * hi), g1 = *(const LAS f32x4*)(gt + 16 * d0 + 8 * hi + 4);
#pragma unroll
        for (int j = 0; j < 4; ++j) { x[8 * d0 + j] *= rs * g0[j]; x[8 * d0 + 4 + j] *= rs * g1[j]; } }
    constexpr float INVF[8] = {1.0f, 0.19392274474868576f, 0.03760603093086393f, 0.007292664737217109f, 0.001414213562373095f, 0.0002742481756762073f, 5.318295896944988e-05f, 1.031338537721246e-05f};
#pragma unroll
    for (int i = 0; i < 8; ++i) {
        const float rev = posf * (INVF[i] * 0.15915494309189535f);
        const float fr = rev - floorf(rev);
        const float cs = __builtin_amdgcn_cosf(fr), sn = __builtin_amdgcn_sinf(fr);
        const float partner = swap32(x[i]);
        x[i] = hi ? (x[i] * cs + partner * sn) : (x[i] * cs - partner * sn);
    }
#pragma unroll
    for (int d0 = 0; d0 < 4; ++d0) { u32x4 w; w.x = cvtpk(x[8 * d0], x[8 * d0 + 1]); w.y = cvtpk(x[8 * d0 + 2], x[8 * d0 + 3]); w.z = cvtpk(x[8 * d0 + 4], x[8 * d0 + 5]); w.w = cvtpk(x[8 * d0 + 6], x[8 * d0 + 7]);
        f[d0] = __builtin_bit_cast(bf16x8, w); }
}

DEV void ph_attn_mfma(const P& p, LAS unsigned char* lds, int bid, int nb) {
    const int tid = otid(); const int lane = tid & 63, wid = __builtin_amdgcn_readfirstlane(tid >> 6), r32 = lane & 31, hi = lane >> 5;
    LAS unsigned char* vl = lds + wid * 16384;
    LAS float* wsf = (LAS float*)(lds + wid * 16384 + 4096);
    LAS float* gtab_q = (LAS float*)(lds + wid * 16384 + 4352);
    LAS bf16_t* ost = (LAS bf16_t*)(lds + wid * 16384 + 8192);
    LAS float* gtab_k = gtab_q + 64;
    gtab_q[lane] = p.q_norm_g[lane]; gtab_k[lane] = p.k_norm_g[lane];
    asm volatile("s_waitcnt lgkmcnt(0)" ::: "memory");
    float gq = fabsf(p.q_norm_g[lane]), gk = fabsf(p.k_norm_g[lane]);
#pragma unroll
    for (int o = 32; o >= 1; o >>= 1) { gq = fmaxf(gq, __shfl_xor(gq, o)); gk = fmaxf(gk, __shfl_xor(gk, o)); }
    constexpr float LOG2E = 1.4426950408889634f, C2 = 0.125f * LOG2E;
    const float nmref = -(8.f * gq * gk * LOG2E);
    const int head = wid & 3, par = wid >> 2;
    const int tq = (lane & 15) >> 2, tp = lane & 3, tcb = (lane >> 4) & 1;
    const LAS unsigned char* vrd = vl + (4 * hi + tq) * 128 + (16 * tcb + 4 * tp) * 2;
    for (int it2 = bid; it2 < NB * 48; it2 += nb) {
        const int it = it2 * 2 + par;
        const int cb = it & 31, g = (it >> 5) % 3, b = it / 96;
        const int dsh = 2 * g, d = 1 << dsh, L = SEQ >> dsh, nbk = L >> 6;
        const int r = cb / nbk, blk = cb % nbk;
        const int h = 4 * g + head, base = b * SEQ;
        const int q0 = 64 * blk;
        const int mqa = q0 + r32, mqb = q0 + 32 + r32;
        bf16x8 qa[4], qb[4];
        { const bf16_t* qp = p.QKV + (size_t)(base + mqa * d + r) * 2304 + h * 64 + hi * 8;
#pragma unroll
          for (int d0 = 0; d0 < 4; ++d0) qa[d0] = *(const bf16x8*)(qp + d0 * 16);
          const bf16_t* qp2 = p.QKV + (size_t)(base + mqb * d + r) * 2304 + h * 64 + hi * 8;
#pragma unroll
          for (int d0 = 0; d0 < 4; ++d0) qb[d0] = *(const bf16x8*)(qp2 + d0 * 16); }
        const float pqa = (float)p.pos[base + mqa * d + r], pqb = (float)p.pos[base + mqb * d + r];
        normrope_frag(qa, gtab_q, hi, pqa); normrope_frag(qb, gtab_q, hi, pqb);
        f32x16 oa0, oa1, ob0, ob1;
#pragma unroll
        for (int i = 0; i < 16; ++i) { oa0[i] = 0.f; oa1[i] = 0.f; ob0[i] = 0.f; ob1[i] = 0.f; }
        float lsa = 0.f, lsb = 0.f;
        const int kb0 = q0 - 64;
#pragma unroll 1
        for (int st = 0; st < 6; ++st) {
            const int k0 = kb0 + 32 * st;
            if (k0 + 31 < 0 || k0 >= L) continue;
            const int mkc = min(max(k0 + r32, 0), L - 1);
            const bf16_t* kp = p.QKV + (size_t)(base + mkc * d + r) * 2304 + 768 + h * 64 + hi * 8;
            bf16x8 kf[4];
#pragma unroll
            for (int d0 = 0; d0 < 4; ++d0) kf[d0] = *(const bf16x8*)(kp + d0 * 16);
            const float kposf = (float)p.pos[base + mkc * d + r];
            u32x4 vreg[4];
#pragma unroll
            for (int i = 0; i < 4; ++i) { const int c = lane + 64 * i, row = c >> 3, ch = c & 7; const int mv = min(max(k0 + row, 0), L - 1);
                vreg[i] = *(const u32x4*)(p.QKV + (size_t)(base + mv * d + r) * 2304 + 1536 + h * 64 + ch * 8); }
            normrope_frag(kf, gtab_k, hi, kposf);
            const bool doa = st < 5, dob = st > 0;
            bf16x8 pa0, pa1, pb0, pb1;
#define ATT_SCORES(QR, MQ, LS, PF0, PF1) do { f32x16 s_; _Pragma("unroll") for (int i = 0; i < 16; ++i) s_[i] = 0.f; \
                _Pragma("unroll") for (int d0 = 0; d0 < 4; ++d0) s_ = __builtin_amdgcn_mfma_f32_32x32x16_bf16(kf[d0], QR[d0], s_, 0, 0, 0); \
                _Pragma("unroll") for (int i = 0; i < 16; ++i) { const int key = k0 + crow(i, hi); const int df = key - (MQ); \
                    const bool valid = (key >= 0) && (key < L) && (df <= 64) && (df >= -64); \
                    const float pv = valid ? __builtin_amdgcn_exp2f(__builtin_fmaf(s_[i], C2, nmref)) : 0.f; LS += pv; s_[i] = pv; } \
                u32x4 w0, w1; w0.x = cvtpk(s_[0], s_[1]); w0.y = cvtpk(s_[2], s_[3]); w0.z = cvtpk(s_[4], s_[5]); w0.w = cvtpk(s_[6], s_[7]); \
                w1.x = cvtpk(s_[8], s_[9]); w1.y = cvtpk(s_[10], s_[11]); w1.z = cvtpk(s_[12], s_[13]); w1.w = cvtpk(s_[14], s_[15]); \
                PF0 = __builtin_bit_cast(bf16x8, w0); PF1 = __builtin_bit_cast(bf16x8, w1); } while (0)
            if (doa) ATT_SCORES(qa, mqa, lsa, pa0, pa1);
            if (dob) ATT_SCORES(qb, mqb, lsb, pb0, pb1);
#undef ATT_SCORES
#pragma unroll
            for (int i = 0; i < 4; ++i) { const int c = lane + 64 * i, row = c >> 3, ch = c & 7; *(LAS u32x4*)(vl + row * 128 + ch * 16) = vreg[i]; }
            asm volatile("s_waitcnt lgkmcnt(0)" ::: "memory");
#pragma unroll
            for (int n = 0; n < 2; ++n)
#pragma unroll
                for (int ks = 0; ks < 2; ++ks) {
                    const s16x4 lo = vtr(vrd + (16 * ks) * 128 + 64 * n), hi4 = vtr(vrd + (16 * ks + 8) * 128 + 64 * n);
                    bf16x8 vf; vf[0] = lo[0]; vf[1] = lo[1]; vf[2] = lo[2]; vf[3] = lo[3]; vf[4] = hi4[0]; vf[5] = hi4[1]; vf[6] = hi4[2]; vf[7] = hi4[3];
                    if (doa) { if (n == 0) oa0 = __builtin_amdgcn_mfma_f32_32x32x16_bf16(ks == 0 ? pa0 : pa1, vf, oa0, 0, 0, 0);
                               else oa1 = __builtin_amdgcn_mfma_f32_32x32x16_bf16(ks == 0 ? pa0 : pa1, vf, oa1, 0, 0, 0); }
                    if (dob) { if (n == 0) ob0 = __builtin_amdgcn_mfma_f32_32x32x16_bf16(ks == 0 ? pb0 : pb1, vf, ob0, 0, 0, 0);
                               else ob1 = __builtin_amdgcn_mfma_f32_32x32x16_bf16(ks == 0 ? pb0 : pb1, vf, ob1, 0, 0, 0); }
                }
            asm volatile("s_waitcnt lgkmcnt(0)" ::: "memory");
        }
        const float lta = lsa + swap32(lsa), ltb = lsb + swap32(lsb);
        if (hi == 0) { wsf[r32] = 1.f / lta; wsf[32 + r32] = 1.f / ltb;
            p.LSUM[((size_t)g * T + (base + mqa * d + r)) * 4 + head] = lta; p.LSUM[((size_t)g * T + (base + mqb * d + r)) * 4 + head] = ltb; }
        asm volatile("s_waitcnt lgkmcnt(0)" ::: "memory");
        LAS bf16_t* ob_ = ost + 4 * hi * 64 + r32;
#pragma unroll
        for (int i = 0; i < 16; ++i) { const int qc = (i & 3) + 8 * (i >> 2); const float ia = wsf[4 * hi + qc];
            ob_[qc * 64] = f2bf(oa0[i] * ia); ob_[qc * 64 + 32] = f2bf(oa1[i] * ia); }
        asm volatile("" ::: "memory");
#pragma unroll
        for (int i = 0; i < 16; ++i) { const int qc = (i & 3) + 8 * (i >> 2); const float ib = wsf[32 + 4 * hi + qc];
            ob_[(32 + qc) * 64] = f2bf(ob0[i] * ib); ob_[(32 + qc) * 64 + 32] = f2bf(ob1[i] * ib); }
        asm volatile("s_waitcnt lgkmcnt(0)" ::: "memory");
        bf16_t* og = p.OG + (size_t)g * T * 256 + head * 64;
#pragma unroll
        for (int i = 0; i < 8; ++i) { const int c = lane + 64 * i, qrow = c >> 3, ch = c & 7;
            const u32x4 w = *(const LAS u32x4*)(ost + qrow * 64 + ch * 8);
            *(u32x4*)(og + (size_t)(base + (q0 + qrow) * d + r) * 256 + ch * 8) = w; }
        asm volatile("s_waitcnt lgkmcnt(0)" ::: "memory");
    }
}
DEV void ph_attn_combine(const P& p, int bid, int nb) {
    const int tid_ = otid();
    for (int i = bid * NTHR + tid_; i < T * 32; i += nb * NTHR) {
        const int t = i >> 5, ch = i & 31, slot = ch >> 3;
        const float l0 = p.LSUM[(size_t)t * 4 + slot], l1 = p.LSUM[((size_t)T + t) * 4 + slot], l2 = p.LSUM[((size_t)2 * T + t) * 4 + slot];
        const float inv = 1.f / (l0 + l1 + l2);
        const u32x4 a = *(const u32x4*)(p.OG + (size_t)t * 256 + ch * 8), b = *(const u32x4*)(p.OG + ((size_t)T + t) * 256 + ch * 8), c = *(const u32x4*)(p.OG + ((size_t)2 * T + t) * 256 + ch * 8);
        const f32x4 lo = (mg::unpack_lo(a) * l0 + mg::unpack_lo(b) * l1 + mg::unpack_lo(c) * l2) * inv;
        const f32x4 hi = (mg::unpack_hi(a) * l0 + mg::unpack_hi(b) * l1 + mg::unpack_hi(c) * l2) * inv;
        *(u32x4*)(p.PL + (size_t)t * 768 + 512 + ch * 8) = mg::pack8(lo, hi);
    }
}

template <class Src>
DEV void transpose_blk(const Src& src, int K, bf16_t* WT0, LAS float* scr, int k0, int lane) {
#pragma unroll 8
    for (int i = 0; i < 32; ++i) { const int kk = 2 * i + (lane >> 5); scr[kk * 33 + (lane & 31)] = src(k0 + kk, lane & 31); }
    asm volatile("s_waitcnt lgkmcnt(0)" ::: "memory");
    const int c = lane & 7;
#pragma unroll
    for (int j = 0; j < 4; ++j) { const int n = (lane >> 3) + 8 * j; const LAS float* s = scr + (8 * c) * 33 + n;
        u32x4 o; o.x = pk2(s[0 * 33], s[1 * 33]); o.y = pk2(s[2 * 33], s[3 * 33]); o.z = pk2(s[4 * 33], s[5 * 33]); o.w = pk2(s[6 * 33], s[7 * 33]);
        *(u32x4*)(WT0 + (size_t)n * K + k0 + 8 * c) = o; }
    asm volatile("s_waitcnt lgkmcnt(0)" ::: "memory");
}
struct SrcCol { const float* W; int ld; DEV float operator()(int k, int j) const { return W[(size_t)k * ld + j]; } };
struct SrcEff { const float *wg, *ls, *wu;
    DEV float operator()(int k, int j) const { const int g = k >> 7; const float* a = wg + (size_t)k * 128; const float* l = ls + g * 128; const float* b = wu + (size_t)(g * 128) * DM + j; float s = 0.f;
#pragma unroll 4
        for (int d = 0; d < 128; ++d) s += a[d] * l[d] * b[(size_t)d * DM]; return s; } };
DEV void tr_plain(const float* W, int K, int N, bf16_t* WT, LAS float* scr, int item, int lane) {
    const int nblk = N / 32, k0 = 64 * (item / nblk), n0 = 32 * (item % nblk);
    transpose_blk(SrcCol{W + n0, N}, K, WT + (size_t)n0 * K, scr, k0, lane);
}
DEV void tr_perm16(const float* W, int K, int N, bf16_t* WT, LAS float* scr, int item, int lane) {
    const int nblk = N / 32, k0 = 64 * (item / nblk), rho0 = 32 * (item % nblk);
    const int tile = rho0 >> 8, bj = (rho0 >> 7) & 1, wc = (rho0 >> 5) & 3;
    const int n0 = tile * 256 + 64 * wc + 8 * bj;
    struct SrcP { const float* W; int ld; DEV float operator()(int k, int dr) const { return W[(size_t)k * ld + 16 * (dr >> 3) + (dr & 7)]; } };
    transpose_blk(SrcP{W + n0, N}, K, WT + (size_t)rho0 * K, scr, k0, lane);
}
DEV void tr_gu(const float* g, const float* u, int K, bf16_t* WT, LAS float* scr, int k0, int rho0, int lane) {
    const int ch0 = (rho0 >> 8) * 128 + (rho0 & 127);
    const float* m = (rho0 & 128) ? u : g;
    transpose_blk(SrcCol{m + ch0, EFF}, K, WT + (size_t)rho0 * K, scr, k0, lane);
}

DEV void ph_prep_small(const P& p, LAS float* scr, int gw, int ngw, int lane) {
    constexpr int I_IN = 16 * (INW / 32), I_EFF = 64 * 16, I_AU = 4 * 32, I_OUT = 16 * 32, I_R = 16 * 8, I_S = 16 * 16, I_SD = 4 * 32;
    constexpr int NIT = I_IN + I_EFF + I_AU + I_OUT + I_R + I_S + I_SD;
    for (int it = gw; it < NIT; it += ngw) {
        int r = it;
        if (r < I_IN) { tr_plain(p.w_in, DM, INW, p.WT_IN, scr, r, lane); continue; } r -= I_IN;
        if (r < I_EFF) {
            const int n = 64 * (r & 15) + lane, k0 = 8 * (r >> 4), g = k0 >> 7;
            const float* a = p.pool_w_grp + (size_t)k0 * 128; const float* l = p.pool_scale + g * 128; const float* b = p.w_pool_up + (size_t)(g * 128) * DM + n;
            float acc[8];
#pragma unroll
            for (int j = 0; j < 8; ++j) acc[j] = 0.f;
#pragma unroll 4
            for (int d = 0; d < 128; ++d) { const float bl = b[(size_t)d * DM] * l[d];
#pragma unroll
                for (int j = 0; j < 8; ++j) acc[j] += a[j * 128 + d] * bl; }
            u32x4 o; o.x = pk2(acc[0], acc[1]); o.y = pk2(acc[2], acc[3]); o.z = pk2(acc[4], acc[5]); o.w = pk2(acc[6], acc[7]);
            *(u32x4*)(p.WT_EFF + (size_t)n * 768 + k0) = o; continue; } r -= I_EFF;
        if (r < I_AU) { const int k0 = 64 * (r / 32), n0 = 32 * (r % 32);
            transpose_blk(SrcCol{p.w_attn_up + n0, DM}, 768, p.WT_EFF + (size_t)n0 * 768 + 512, scr, k0, lane); continue; } r -= I_AU;
        if (r < I_OUT) { tr_plain(p.w_out, DM, DM, p.WT_OUT, scr, r, lane); continue; } r -= I_OUT;
        if (r < I_R) { tr_plain(p.w_router, DM, NE, p.WT_RS, scr, r, lane); continue; } r -= I_R;
        if (r < I_S) { tr_gu(p.w_sg, p.w_su, DM, p.WT_RS + (size_t)256 * DM, scr, 64 * (r / 16), 32 * (r % 16), lane); continue; } r -= I_S;
        tr_perm16(p.w_sd, EFF, DM, p.WT_SD, scr, r, lane);
    }
}
DEV void ph_prep_ed2(const P& p, LAS float* scr, int gw, int ngw, int lane) {
    constexpr int IPE = 4 * 32, NIT = NE * IPE;
    for (int it = gw * 2; it < NIT; it += ngw * 2) {
        const float* src[2]; bf16_t* dst[2]; int k0[2];
#pragma unroll
        for (int q = 0; q < 2; ++q) { const int t_ = it + q, e = t_ / IPE, item = t_ % IPE, nblk = DM / 32; k0[q] = 64 * (item / nblk); const int rho0 = 32 * (item % nblk);
            const int tile = rho0 >> 8, bj = (rho0 >> 7) & 1, wc = (rho0 >> 5) & 3, n0 = tile * 256 + 64 * wc + 8 * bj;
            src[q] = p.w_ed + (size_t)e * EFF * DM + n0; dst[q] = p.WT_ED + (size_t)e * DM * EFF + (size_t)rho0 * EFF; }
        const int dr = lane & 31, cofs = 16 * (dr >> 3) + (dr & 7);
        float v[2][32];
#pragma unroll
        for (int q = 0; q < 2; ++q)
#pragma unroll
            for (int i = 0; i < 32; ++i) v[q][i] = src[q][(size_t)(k0[q] + 2 * i + (lane >> 5)) * DM + cofs];
#pragma unroll
        for (int q = 0; q < 2; ++q)
#pragma unroll
            for (int i = 0; i < 32; ++i) scr[q * 2112 + (2 * i + (lane >> 5)) * 33 + dr] = v[q][i];
        asm volatile("s_waitcnt lgkmcnt(0)" ::: "memory");
        const int c = lane & 7;
#pragma unroll
        for (int q = 0; q < 2; ++q)
#pragma unroll
            for (int j = 0; j < 4; ++j) { const int n = (lane >> 3) + 8 * j; const LAS float* sp = scr + q * 2112 + (8 * c) * 33 + n;
                u32x4 o; o.x = pk2(sp[0 * 33], sp[1 * 33]); o.y = pk2(sp[2 * 33], sp[3 * 33]); o.z = pk2(sp[4 * 33], sp[5 * 33]); o.w = pk2(sp[6 * 33], sp[7 * 33]);
                *(u32x4*)(dst[q] + (size_t)n * EFF + k0[q] + 8 * c) = o; }
        asm volatile("s_waitcnt lgkmcnt(0)" ::: "memory");
    }
}
DEV void ph_prep_ed3(const P& p, LAS float* scr, int gw, int ngw, int lane) {
    constexpr int IPE = 4 * 16;
    for (int it = gw; it < NE * IPE; it += ngw) { const int e = it / IPE, r = it % IPE, k0 = 64 * (r >> 4), cb = r & 15, tile = cb >> 2, wc = cb & 3;
        const float* src = p.w_ed + (size_t)e * EFF * DM + (size_t)k0 * DM + tile * 256 + 64 * wc + lane;
#pragma unroll 16
        for (int k = 0; k < 64; ++k) scr[k * 65 + lane] = src[(size_t)k * DM];
        asm volatile("s_waitcnt lgkmcnt(0)" ::: "memory");
        const int c = lane & 7;
#pragma unroll
        for (int q = 0; q < 8; ++q) { const int j = (lane >> 3) + 8 * q;
            const int rho = tile * 256 + 128 * ((j >> 3) & 1) + 32 * wc + 8 * (j >> 4) + (j & 7);
            const LAS float* sp = scr + (8 * c) * 65 + j;
            u32x4 o; o.x = pk2(sp[0], sp[65]); o.y = pk2(sp[2 * 65], sp[3 * 65]); o.z = pk2(sp[4 * 65], sp[5 * 65]); o.w = pk2(sp[6 * 65], sp[7 * 65]);
            *(u32x4*)(p.WT_ED + (size_t)e * DM * EFF + (size_t)rho * EFF + k0 + 8 * c) = o; }
        asm volatile("s_waitcnt lgkmcnt(0)" ::: "memory");
    }
}
DEV void ph_prep_ed(const P& p, LAS float* scr, int gw, int ngw, int lane) {
    constexpr int IPE = 4 * 32;
    for (int it = gw; it < NE * IPE; it += ngw) { const int e = it / IPE;
        tr_perm16(p.w_ed + (size_t)e * EFF * DM, EFF, DM, p.WT_ED + (size_t)e * DM * EFF, scr, it % IPE, lane); }
}
DEV void ph_prep_egu(const P& p, LAS float* scr, int gw, int ngw, int lane) {
    constexpr int IPE = 16 * 16;
    for (int it = gw; it < NE * IPE; it += ngw) { const int e = it / IPE, r = it % IPE;
        tr_gu(p.w_eg + (size_t)e * DM * EFF, p.w_eu + (size_t)e * DM * EFF, DM, p.WT_EGU + (size_t)e * 512 * DM, scr, 64 * (r / 16), 32 * (r % 16), lane); }
}

constexpr int LDS_BYTES = 156672;
constexpr int LDS_OFF_TAB = 131072;
constexpr int LDS_GTAB = 131072 + 8192;
constexpr int MAXU = 16;
constexpr int LDS_MISC = LDS_GTAB + MAXU * 1024;

DEV void fill_gtab(const P& p, const mg::ExpertOrder& S, LAS unsigned* gtab) {
    const int tid_ = otid();
    for (int i = 0; i < MAXU; ++i) { int pm, pn, e; if (!S.tile_of(i, pm, pn, e)) break;
        if (tid_ < 256) { const int s = p.rowlist[pm * 256 + tid_]; gtab[i * 256 + tid_] = (unsigned)(s < 0 ? 0 : (s >> 3)) * (unsigned)(DM * 2); } }
    __syncthreads();
}

#define GAS __attribute__((address_space(1)))
#define XB_TMO      128
#define XB_XCNT(j)  (256  + 64 * (j))
#define XB_XSUB(j)  (1280 + 64 * (j))
#define XB_XGEN(j)  (2304 + 64 * (j))
#define XB_TOP      3328
#define XB_TOPGEN   3392
#define XCD_BAR_WORDS 3456
#define XB_SPIN_CAP (1u << 18)
DEV unsigned xb_ld(unsigned* p)              { return __hip_atomic_load(p, __ATOMIC_RELAXED, __HIP_MEMORY_SCOPE_AGENT); }
DEV unsigned xb_add(unsigned* p, unsigned v) { return __hip_atomic_fetch_add(p, v, __ATOMIC_RELAXED, __HIP_MEMORY_SCOPE_AGENT); }
DEV unsigned xb_xcc_id() { return (unsigned)__builtin_amdgcn_s_getreg((3 << 11) | 20) & 0xFu; }
#define XB_SPIN(cond, bar) do { unsigned _sp = 0; while (cond) { __builtin_amdgcn_s_sleep(1); \
    if ((++_sp & 255u) == 0u) { if (xb_ld(&(bar)[XB_TMO])) break; if (_sp > XB_SPIN_CAP) { atomicAdd(&(bar)[XB_TMO], 1u); break; } } } } while (0)
struct XcdBarrier { unsigned* bar; unsigned x; volatile LAS unsigned* st; };
DEV XcdBarrier xcd_barrier_post(unsigned* bar, volatile LAS unsigned* st) {
    XcdBarrier b; b.bar = bar; b.x = xb_xcc_id(); b.st = st;
    if (threadIdx.x == 0) (void)xb_add(&bar[XB_XCNT(b.x)], 1u);
    return b;
}
DEV void xcd_barrier_complete(unsigned* bar, unsigned x, unsigned& nloc, unsigned& nx) {
    const unsigned G = gridDim.x * gridDim.y * gridDim.z;
    unsigned sum, cnt, mine, sp = 0u;
    for (;;) {
        sum = 0u; cnt = 0u; mine = 0u;
#pragma unroll
        for (unsigned j = 0; j < 16; ++j) { const unsigned c = xb_ld(&bar[XB_XCNT(j)]); sum += c; cnt += (c > 0u) ? 1u : 0u; mine = (j == x) ? c : mine; }
        if (sum == G) break;
        __builtin_amdgcn_s_sleep(1);
        if ((++sp & 255u) == 0u) { if (xb_ld(&bar[XB_TMO])) break; if (sp > XB_SPIN_CAP) { atomicAdd(&bar[XB_TMO], 1u); break; } }
    }
    nloc = mine > 0u ? mine : 1u; nx = cnt > 0u ? cnt : 1u;
}
DEV void xcd_barrier(const XcdBarrier& b) {
    asm volatile("s_waitcnt vmcnt(0)" ::: "memory");
    __syncthreads();
    if (threadIdx.x == 0) {
        unsigned* bar = b.bar;
        __builtin_amdgcn_s_waitcnt(0);
        unsigned nloc = b.st[0], nx = b.st[1];
        if (nloc == 0u) { xcd_barrier_complete(bar, b.x, nloc, nx); b.st[0] = nloc; b.st[1] = nx; }
        const unsigned old = xb_add(&bar[XB_XSUB(b.x)], 1u);
        const unsigned gen = old / nloc;
        if (old + 1u == (gen + 1u) * nloc) {
            __builtin_amdgcn_fence(__ATOMIC_RELEASE, "agent");
            asm volatile("s_waitcnt vmcnt(0)" ::: "memory");
            const unsigned og = xb_add(&bar[XB_TOP], 1u);
            const unsigned tg = og / nx;
            if (og + 1u == (tg + 1u) * nx) xb_add(&bar[XB_TOPGEN], 1u);
            else XB_SPIN(xb_ld(&bar[XB_TOPGEN]) == tg, bar);
            __builtin_amdgcn_fence(__ATOMIC_ACQUIRE, "agent");
            xb_add(&bar[XB_XGEN(b.x)], 1u);
            asm volatile("s_waitcnt vmcnt(0)" ::: "memory");
        } else {
            XB_SPIN(xb_ld(&bar[XB_XGEN(b.x)]) == gen, bar);
            __builtin_amdgcn_fence(__ATOMIC_ACQUIRE, "agent");
            asm volatile("s_waitcnt vmcnt(0)" ::: "memory");
        }
    }
    __syncthreads();
}

#define STAMP() do { if (TPROBE >= 0) { if (bid == 0 && threadIdx.x == 0) p.ts[nst] = __builtin_amdgcn_s_memrealtime(); ++nst; } } while (0)
#define GSYNC_CG() do { cg::this_grid().sync(); STAMP(); } while (0)
#define GSYNC() do { xcd_barrier(xbar); STAMP(); } while (0)
__global__ void __launch_bounds__(NTHR, 2) fwd_all(P p) {
    extern __shared__ __attribute__((aligned(16))) unsigned char lds_raw[];
    LAS unsigned char* lds = (LAS unsigned char*)lds_raw;
    float* sm = (float*)lds_raw;
    int* off = (int*)(lds_raw + LDS_OFF_TAB);
    const LAS int* offl = (const LAS int*)(lds + LDS_OFF_TAB);
    LAS unsigned* gtab = (LAS unsigned*)(lds + LDS_GTAB);
    const int bid = blockIdx.x, nb = gridDim.x;
    const int tid_ = otid(); const int lane = tid_ & 63, wv = tid_ >> 6;
    LAS float* scr = (LAS float*)(lds + wv * 18432);
    const int gw = bid * NWV + wv, ngw = nb * NWV;
    volatile LAS unsigned* misc = (volatile LAS unsigned*)(lds + LDS_MISC);
    if (threadIdx.x < 2) misc[threadIdx.x] = 0u;
    __syncthreads();
    const XcdBarrier xbar = xcd_barrier_post(p.bar, misc);
    int nst = 0; STAMP();

    ph_mod(p, sm, bid, nb);
    __syncthreads();
    REPEAT(1) ph_prep_small(p, scr, gw, ngw, lane);
#if MF_EXP2
    ph_prep_ed3(p, scr, gw, ngw, lane);
#endif
    GSYNC();
    REPEAT(3) ph_norm(p.x, p.norm1_g, p.mod, 0, 1024, p.XB, bid, nb);
    GSYNC();
#if MF_INPROJ
    REPEAT(4) { mg::DenseOrder S; S.init(p.XB, p.WT_IN, T, INW, DM, nb, bid);
      mg::gemm_phase<mg::MEpiInProj, mg::DenseOrder, false>(lds, gtab, DM, S, mg::MEpiInProj{p.U, p.QKV, p.G}); }
#else
    ngemm_dense<false>(p.XB, DM, p.w_in, nullptr, INW, T, INW, DM, EpiInProj{p.U, p.QKV, p.G}, sm, bid, nb);
#endif
    GSYNC();
#if !MF_ATTN
    ph_qknorm(p, bid, nb);
#endif
    REPEAT(5) ph_pool(p, bid, nb);
#if !MF_ATTN
    GSYNC();
#endif
#if MF_ATTN
    REPEAT(6) ph_attn_mfma(p, lds, bid, nb);
    GSYNC();
    REPEAT(7) ph_attn_combine(p, bid, nb);
#else
    ph_attn(p, bid, nb);
#endif
#if !MF_MERGE
#pragma unroll 1
    for (int g = 0; g < 4; ++g) ngemm_dense<false>(p.PL + g * 128, 512, p.pool_w_grp + g * 128 * 128, nullptr, 128, T, 128, 128, EpiPoolGrp{p.Y, p.pool_scale, g}, sm, bid, nb);
#endif
    GSYNC();
#if MF_MERGE
    REPEAT(8) { mg::PairOrder S; S.D.init(p.PL, p.WT_EFF, T, DM, 768, nb, bid); S.kt0 = 8; S.kt1 = 4;
      mg::gemm_phase<mg::MEpiMergeF, mg::PairOrder, false>(lds, gtab, 768, S, mg::MEpiMergeF{p.XB, p.G}); }
#else
    ngemm_dense<false>(p.Y, 512, p.w_pool_up, nullptr, DM, T, DM, 512, EpiMergeA{p.XB, p.G}, sm, bid, nb);
    GSYNC();
    ngemm_dense<false>(p.O, 256, p.w_attn_up, nullptr, DM, T, DM, 256, EpiMergeB{p.XB, p.G}, sm, bid, nb);
#endif
    GSYNC();
#if MF_OUT
    REPEAT(9) { mg::DenseOrder S; S.init(p.XB, p.WT_OUT, T, DM, DM, nb, bid);
      mg::gemm_phase<mg::MEpiOutProj, mg::DenseOrder, false>(lds, gtab, DM, S, mg::MEpiOutProj{p.x, p.out, p.mod}); }
#else
    ngemm_dense<false>(p.XB, DM, p.w_out, nullptr, DM, T, DM, DM, EpiOutProj{p.x, p.out, p.mod}, sm, bid, nb);
#endif
    GSYNC();
    REPEAT(10) ph_norm(p.out, p.norm2_g, p.mod, 3072, 4096, p.XB, bid, nb);
#if MF_EXP1
    __syncthreads();
    REPEAT(11) ph_prep_egu(p, scr, gw, ngw, lane);
#endif
    GSYNC();
#if MF_ROUTER
    REPEAT(12) { mg::DenseOrder S; S.init(p.XB, p.WT_RS, T, 768, DM, nb, bid);
      mg::gemm_phase<mg::MEpiRouterShared, mg::DenseOrder, false>(lds, gtab, DM, S, mg::MEpiRouterShared{p.LG, p.HS}); }
#else
    ngemm_dense<false>(p.XB, DM, p.w_router, nullptr, NE, T, NE, DM, EpiLogits{p.LG}, sm, bid, nb);
#endif
    GSYNC();
    ph_route(p, (int*)lds_raw, bid, nb);
    GSYNC();
    ph_scatter(p, off, bid, nb);
    GSYNC();
#if MF_EXP1
    REPEAT(13) { load_offsets(p.cnt, off);
      mg::ExpertOrder S{offl, 2, nb, bid, (const char*)p.XB, (const char*)p.WT_EGU, (size_t)512 * DM * 2, (size_t)256 * DM * 2, 0, true, p.rowlist, MAXU};
      S.build_table((LAS int*)(lds + LDS_OFF_TAB), otid()); __syncthreads();
      fill_gtab(p, S, gtab);
      mg::gemm_phase<mg::MEpiAct, mg::ExpertOrder, true>(lds, gtab, DM, S, mg::MEpiAct{p.ACT}); }
#else
    ph_expert1(p, sm, off, bid, nb);
#endif
    GSYNC();
#if MF_EXP2
    REPEAT(14) { load_offsets(p.cnt, off);
      mg::ExpertOrder S{offl, 4, nb, bid, (const char*)p.ACT, (const char*)p.WT_ED, (size_t)DM * EFF * 2, (size_t)256 * EFF * 2, (size_t)256 * EFF * 2, false, p.rowlist, MAXU};
      S.build_table((LAS int*)(lds + LDS_OFF_TAB), otid()); __syncthreads();
      mg::gemm_phase<mg::MEpiSlab, mg::ExpertOrder, false>(lds, gtab, EFF, S, mg::MEpiSlab{(unsigned char*)p.SLAB, p.rowlist, p.roww}); }
#else
    ph_expert2(p, sm, off, bid, nb);
#endif
    GSYNC();
#if !MF_ROUTER
    ngemm_dense<true>(p.XB, DM, p.w_sg, p.w_su, EFF, T, EFF, DM, EpiAct{p.HS}, sm, bid, nb);
    GSYNC();
#endif
#if MF_FINAL
    { mg::DenseOrder S; S.init(p.HS, p.WT_SD, T, DM, EFF, nb, bid);
      mg::gemm_phase<mg::MEpiFinal, mg::DenseOrder, false>(lds, gtab, EFF, S, mg::MEpiFinal{p.out, (const unsigned char*)p.SLAB, p.mod}); }
#else
    ngemm_dense<false>(p.HS, EFF, p.w_sd, nullptr, DM, T, DM, EFF, EpiFinal{p.out, p.SLAB, p.mod}, sm, bid, nb);
#endif
#if TPROBE >= 0
    GSYNC();
    if (bid == 0 && threadIdx.x == 0) { const unsigned long long dt = p.ts[TPROBE + 1] - p.ts[TPROBE]; p.out[0] += (float)dt * 0.01f / TSCALE; }
#endif
}

extern "C" void kernel_launch(void* const* d_in, const int* in_sizes, int n_in, void* d_out, int out_size, void* d_ws, size_t ws_size, hipStream_t stream) {
    static int grid = 0;
    if (grid == 0) {
        int dev = 0, cus = 0;
        (void)hipGetDevice(&dev);
        (void)hipDeviceGetAttribute(&cus, hipDeviceAttributeMultiprocessorCount, dev);
        int per_cu = 0;
        (void)hipFuncSetAttribute((const void*)fwd_all, hipFuncAttributeMaxDynamicSharedMemorySize, LDS_BYTES);
        (void)hipOccupancyMaxActiveBlocksPerMultiprocessor(&per_cu, fwd_all, NTHR, LDS_BYTES);
        if (per_cu < 1) { fprintf(stderr, "kernel_launch: occupancy query says %d blocks/CU\n", per_cu); per_cu = 1; }
        if (per_cu > 1) per_cu = 1;
        grid = cus * per_cu;
        if (ws_size < WS_END) { fprintf(stderr, "kernel_launch: workspace too small (%zu < %zu)\n", ws_size, (size_t)WS_END); grid = -1; }
    }
    if (grid < 0) return;
    P p{};
    const float* const* in = (const float* const*)d_in;
    p.x = in[0]; p.c = in[1]; p.pos = (const int*)d_in[2];
    p.w_ada = in[3]; p.b_ada = in[4]; p.norm1_g = in[5]; p.w_in = in[6]; p.pool_w_grp = in[7]; p.pool_scale = in[8]; p.q_norm_g = in[9]; p.k_norm_g = in[10];
    p.w_pool_up = in[11]; p.w_attn_up = in[12]; p.w_out = in[13]; p.norm2_g = in[14]; p.w_router = in[15]; p.router_bias = in[16];
    p.w_sg = in[17]; p.w_su = in[18]; p.w_sd = in[19]; p.w_eg = in[20]; p.w_eu = in[21]; p.w_ed = in[22];
    p.out = (float*)d_out;
    char* ws = (char*)d_ws;
    p.mod = (float*)(ws + WS_MOD); p.cnt = (int*)(ws + WS_CNT); p.asg_e = (int*)(ws + WS_ASG_E); p.asg_pos = (int*)(ws + WS_ASG_POS);
    p.asg_w = (float*)(ws + WS_ASG_W); p.rowlist = (int*)(ws + WS_ROWLIST);
    p.XB = (bf16_t*)(ws + WS_XB); p.U = (bf16_t*)(ws + WS_U); p.QKV = (bf16_t*)(ws + WS_QKV); p.G = (bf16_t*)(ws + WS_G); p.PL = (bf16_t*)(ws + WS_PL);
    p.Y = (bf16_t*)(ws + WS_Y); p.O = (bf16_t*)(ws + WS_O); p.ACT = (bf16_t*)(ws + WS_ACT); p.SLAB = (bf16_t*)(ws + WS_SLAB); p.HS = (bf16_t*)(ws + WS_HS);
    p.LG = (float*)(ws + WS_ACT);
    p.roww = (float*)(ws + WS_ROWW);
    p.bar = (unsigned*)(ws + WS_BAR); p.ts = (unsigned long long*)(ws + WS_TS);
    p.OG = (bf16_t*)(ws + WS_OG); p.LSUM = (float*)(ws + WS_LSUM);
    p.WT_IN = (bf16_t*)(ws + WS_WT_IN); p.WT_EFF = (bf16_t*)(ws + WS_WT_EFF); p.WT_AU = (bf16_t*)(ws + WS_WT_AU); p.WT_OUT = (bf16_t*)(ws + WS_WT_OUT);
    p.WT_RS = (bf16_t*)(ws + WS_WT_RS); p.WT_SD = (bf16_t*)(ws + WS_WT_SD); p.WT_EGU = (bf16_t*)(ws + WS_WT_EGU); p.WT_ED = (bf16_t*)(ws + WS_WT_ED);
    (void)hipMemsetAsync(ws + WS_BAR, 0, WS_ZERO_BYTES, stream);
    void* args[] = {&p};
    hipError_t e = hipLaunchCooperativeKernel((void*)fwd_all, dim3(grid), dim3(NTHR), args, LDS_BYTES, stream);
    if (e != hipSuccess) fprintf(stderr, "cooperative launch failed: %s (grid %d)\n", hipGetErrorString(e), grid);
}
```
